# Optimizing an MI355X kernel written in HIP

```python
import jax, jax.numpy as jnp
from jax import lax
import numpy as np

D_MODEL = 2048
BATCH = 1
SEQ = 16384
DEPTH = 1

D_MIX = D_MODEL
D_GMLP = D_MIX // 2
GMLP_GROUPS = 8
GMLP_GROUP_DIM = D_GMLP // GMLP_GROUPS
GMLP_CHUNK = 128
D_MLSTM = D_MIX - D_GMLP
MLSTM_HEADS = 4
MLSTM_HEAD_DIM = D_MLSTM // MLSTM_HEADS
MLSTM_CHUNK = 128
CONV_WIDTH = 4
PEER_HEADS = 8
PEER_N_KEYS = 128
PEER_N_EXPERTS = PEER_N_KEYS * PEER_N_KEYS
PEER_QUERY_DIM = 256
PEER_HALF_DIM = PEER_QUERY_DIM // 2
PEER_TOPK = 16
PEER_TOKEN_BLOCK = 128
N_MOD = 6
EPS = 1e-6
IN_COLS = 2 * D_GMLP + 4 * D_MLSTM + 2 * MLSTM_HEADS
IN_SPLITS = (D_GMLP, 2 * D_GMLP, 2 * D_GMLP + 2 * D_MLSTM,
             2 * D_GMLP + 3 * D_MLSTM, 2 * D_GMLP + 4 * D_MLSTM)

kernel_name = "hybrid_gmlp_mlstm_peer_block"


def rms_norm(x, gain):
    xf = x.astype(jnp.float32)
    y = xf * lax.rsqrt(jnp.mean(xf * xf, axis=-1, keepdims=True) + EPS)
    return (y * gain.astype(jnp.float32)).astype(x.dtype)


def causal_depthwise_conv(x, w, b):
    y = lax.conv_general_dilated(
        x, w[:, None, :].astype(x.dtype), window_strides=(1,),
        padding=[(CONV_WIDTH - 1, 0)], dimension_numbers=("NWC", "WIO", "NWC"),
        feature_group_count=x.shape[-1])
    return y + b


def gmlp_spatial_gating(u, v, norm_g, w_spatial, b_spatial):
    B, S, _ = u.shape
    nc = S // GMLP_CHUNK
    u = u.reshape(B, nc, GMLP_CHUNK, GMLP_GROUPS, GMLP_GROUP_DIM)
    v = rms_norm(v.reshape(B, nc, GMLP_CHUNK, GMLP_GROUPS, GMLP_GROUP_DIM), norm_g)
    pos = jnp.arange(GMLP_CHUNK)
    causal = pos[:, None] >= pos[None, :]
    w = jnp.where(causal, w_spatial, 0)
    mixed = jnp.einsum("gts,bnsgc->bntgc", w, v) + b_spatial.T[None, None, :, :, None]
    return (u * mixed).reshape(B, S, D_GMLP)


def mlstm_chunkwise(q, k, v, i_pre, log_f):
    out_dtype = v.dtype
    q, k, v = (t.astype(jnp.float32) for t in (q, k, v))
    i_pre, log_f = i_pre.astype(jnp.float32), log_f.astype(jnp.float32)
    B, H, S, d = q.shape
    L = MLSTM_CHUNK
    nc = S // L
    q = q * (d ** -0.5)

    def to_chunks(t):
        return jnp.moveaxis(t.reshape(B, H, nc, L, *t.shape[3:]), 2, 0)

    xs = tuple(to_chunks(t) for t in (q, k, v, i_pre, log_f))
    pos = jnp.arange(L)
    causal = pos[:, None] >= pos[None, :]

    def step(carry, inp):
        C, n, m = carry
        qb, kb, vb, ib, fb = inp
        b = jnp.cumsum(fb, axis=-1)
        log_d = jnp.where(causal, b[..., :, None] - b[..., None, :] + ib[..., None, :], -jnp.inf)
        a = b + m[..., None]
        m_comb = jnp.maximum(a, jnp.max(log_d, axis=-1))
        w_intra = jnp.exp(log_d - m_comb[..., None])
        w_inter = jnp.exp(a - m_comb)
        s = jnp.einsum("bhtd,bhsd->bhts", qb, kb) * w_intra
        num = (jnp.einsum("bhts,bhsd->bhtd", s, vb)
               + w_inter[..., None] * jnp.einsum("bhtd,bhde->bhte", qb, C))
        den = jnp.sum(s, axis=-1) + w_inter * jnp.einsum("bhtd,bhd->bht", qb, n)
        h = num / jnp.maximum(jnp.abs(den), jnp.exp(-m_comb))[..., None]
        b_last = b[..., -1]
        log_w = b_last[..., None] - b + ib
        m_new = jnp.maximum(b_last + m, jnp.max(log_w, axis=-1))
        w_state = jnp.exp(log_w - m_new[..., None])
        decay = jnp.exp(b_last + m - m_new)
        C_new = decay[..., None, None] * C + jnp.einsum("bhs,bhsd,bhse->bhde", w_state, kb, vb)
        n_new = decay[..., None] * n + jnp.einsum("bhs,bhsd->bhd", w_state, kb)
        return (C_new, n_new, m_new), h

    init = (jnp.zeros((B, H, d, d), jnp.float32), jnp.zeros((B, H, d), jnp.float32),
            jnp.zeros((B, H), jnp.float32))
    _, h = lax.scan(step, init, xs)
    return jnp.moveaxis(h, 0, 2).reshape(B, H, S, d).astype(out_dtype)


def peer_ffn(h, w_query, sub_keys_1, sub_keys_2, expert_down, expert_up):
    B, S, D = h.shape
    T = B * S
    x = h.reshape(T, D)
    q = (x @ w_query).reshape(T, PEER_HEADS, 2, PEER_HALF_DIM)
    s1 = jnp.einsum("thc,kc->thk", q[:, :, 0], sub_keys_1)
    s2 = jnp.einsum("thc,kc->thk", q[:, :, 1], sub_keys_2)
    v1, i1 = lax.top_k(s1, PEER_TOPK)
    v2, i2 = lax.top_k(s2, PEER_TOPK)
    cand_s = (v1[..., :, None] + v2[..., None, :]).reshape(T, PEER_HEADS, PEER_TOPK * PEER_TOPK)
    cand_i = (i1[..., :, None] * PEER_N_KEYS + i2[..., None, :]).reshape(T, PEER_HEADS, PEER_TOPK * PEER_TOPK)
    top_s, top_pos = lax.top_k(cand_s, PEER_TOPK)
    idx = jnp.take_along_axis(cand_i, top_pos, axis=-1)
    gates = jax.nn.softmax(top_s.astype(jnp.float32), axis=-1).astype(x.dtype)

    nb = T // PEER_TOKEN_BLOCK

    def expert_block(args):
        xb, ib, gb = args
        u = expert_down[ib]
        act = jax.nn.gelu(jnp.einsum("td,thkd->thk", xb, u), approximate=False)
        return jnp.einsum("thk,thkd->td", gb * act, expert_up[ib])

    y = lax.map(expert_block, (x.reshape(nb, PEER_TOKEN_BLOCK, D),
                               idx.reshape(nb, PEER_TOKEN_BLOCK, PEER_HEADS, PEER_TOPK),
                               gates.reshape(nb, PEER_TOKEN_BLOCK, PEER_HEADS, PEER_TOPK)))
    return y.reshape(B, S, D)


def setup_inputs(seed: int = 0) -> dict:
    key = jax.random.key(seed)
    ks = jax.random.split(key, 24)
    nrm = jax.random.normal
    D, H, dh = D_MODEL, MLSTM_HEADS, MLSTM_HEAD_DIM
    b_gates = jnp.concatenate(
        [0.1 * nrm(ks[6], (DEPTH, H)),
         jnp.linspace(3.0, 6.0, H)[None, :] + 0.1 * nrm(ks[7], (DEPTH, H))], axis=-1)
    return {
        "x": nrm(ks[0], (BATCH, SEQ, D)),
        "c": nrm(ks[1], (BATCH, D)),
        "ada_w": nrm(ks[2], (DEPTH, D, N_MOD * D)) * (0.5 * D ** -0.5),
        "ada_b": 0.02 * nrm(ks[3], (DEPTH, N_MOD * D)),
        "norm_mix_g": 1.0 + 0.02 * nrm(ks[4], (DEPTH, D)),
        "w_in": nrm(ks[5], (DEPTH, D, IN_COLS)) * D ** -0.5,
        "b_gates": b_gates,
        "conv_w": nrm(ks[8], (DEPTH, CONV_WIDTH, 2 * D_MLSTM)) * CONV_WIDTH ** -0.5,
        "conv_b": 0.02 * nrm(ks[9], (DEPTH, 2 * D_MLSTM)),
        "gmlp_norm_g": 1.0 + 0.02 * nrm(ks[10], (DEPTH, GMLP_GROUPS, GMLP_GROUP_DIM)),
        "gmlp_w_spatial": nrm(ks[11], (DEPTH, GMLP_GROUPS, GMLP_CHUNK, GMLP_CHUNK)) * (0.5 * GMLP_CHUNK ** -0.5),
        "gmlp_b_spatial": 1.0 + 0.02 * nrm(ks[12], (DEPTH, GMLP_GROUPS, GMLP_CHUNK)),
        "mlstm_norm_g": 1.0 + 0.02 * nrm(ks[13], (DEPTH, H, dh)),
        "w_out": nrm(ks[14], (DEPTH, D_MIX, D)) * D_MIX ** -0.5,
        "norm_ffn_g": 1.0 + 0.02 * nrm(ks[15], (DEPTH, D)),
        "peer_w_query": nrm(ks[16], (DEPTH, D, PEER_HEADS * PEER_QUERY_DIM)) * D ** -0.5,
        "peer_sub_keys_1": nrm(ks[17], (DEPTH, PEER_N_KEYS, PEER_HALF_DIM)) * PEER_HALF_DIM ** -0.5,
        "peer_sub_keys_2": nrm(ks[18], (DEPTH, PEER_N_KEYS, PEER_HALF_DIM)) * PEER_HALF_DIM ** -0.5,
        "peer_expert_down": nrm(ks[19], (DEPTH, PEER_N_EXPERTS, D)) * D ** -0.5,
        "peer_expert_up": nrm(ks[20], (DEPTH, PEER_N_EXPERTS, D)) * PEER_HEADS ** -0.5,
        "final_norm_g": 1.0 + 0.02 * nrm(ks[21], (D,)),
    }


def reference(x, c, ada_w, ada_b, norm_mix_g, w_in, b_gates, conv_w, conv_b, gmlp_norm_g,
              gmlp_w_spatial, gmlp_b_spatial, mlstm_norm_g, w_out, norm_ffn_g, peer_w_query,
              peer_sub_keys_1, peer_sub_keys_2, peer_expert_down, peer_expert_up, final_norm_g):
    B, S, _ = x.shape
    H, dh = MLSTM_HEADS, MLSTM_HEAD_DIM

    def heads(t):
        return t.reshape(B, S, H, dh).transpose(0, 2, 1, 3)

    for l in range(DEPTH):
        mod = jax.nn.silu(c) @ ada_w[l] + ada_b[l]
        shift_m, scale_m, gate_m, shift_f, scale_f, gate_f = jnp.split(mod[:, None, :], N_MOD, axis=-1)

        h = rms_norm(x, norm_mix_g[l]) * (1 + scale_m) + shift_m
        proj = h @ w_in[l]
        u_g, v_g, qk_m, v_m, o_m, if_m = jnp.split(proj, IN_SPLITS, axis=-1)

        y_g = gmlp_spatial_gating(jax.nn.gelu(u_g, approximate=False),
                                  jax.nn.gelu(v_g, approximate=False),
                                  gmlp_norm_g[l], gmlp_w_spatial[l], gmlp_b_spatial[l])

        qk = jax.nn.silu(causal_depthwise_conv(qk_m, conv_w[l], conv_b[l]))
        q_m, k_m = jnp.split(qk, 2, axis=-1)
        i_pre, f_pre = jnp.split(if_m + b_gates[l], 2, axis=-1)
        log_f = jax.nn.log_sigmoid(f_pre.astype(jnp.float32))
        h_m = mlstm_chunkwise(heads(q_m), heads(k_m), heads(v_m),
                              i_pre.transpose(0, 2, 1), log_f.transpose(0, 2, 1))
        h_m = rms_norm(h_m.transpose(0, 2, 1, 3), mlstm_norm_g[l]) * jax.nn.sigmoid(o_m).reshape(B, S, H, dh)
        y_m = h_m.reshape(B, S, D_MLSTM)

        mix = jnp.concatenate([y_g, y_m], axis=-1) @ w_out[l]
        x = x + gate_m * mix

        h = rms_norm(x, norm_ffn_g[l]) * (1 + scale_f) + shift_f
        x = x + gate_f * peer_ffn(h, peer_w_query[l], peer_sub_keys_1[l], peer_sub_keys_2[l],
                                  peer_expert_down[l], peer_expert_up[l])

    return rms_norm(x, final_norm_g)
```

```cpp
#include <hip/hip_runtime.h>
#include <cstdio>
#include <cstdint>
namespace pg8 {
#define PG8_LAS __attribute__((address_space(3)))
typedef unsigned short bf16_t;
typedef short bf16x8 __attribute__((ext_vector_type(8)));
typedef float f32x4 __attribute__((ext_vector_type(4)));
typedef unsigned u32x4 __attribute__((ext_vector_type(4)));
constexpr int BM = 256, BK = 64, HALF = 128, HTB = HALF * BK * 2  , STAGE_BYTES = 8 * HTB, NXCD = 8, WGM = 8;

__host__ __device__ __forceinline__ int lds_byte(int r, int c) { const int st = (r >> 4) * 2 + (c >> 5), rr = r & 15, cc = c & 31, ob = rr * 64 + cc * 2; return st * 1024 + (ob ^ (((ob >> 9) & 1) << 5)); }
__host__ __device__ __forceinline__ void stage_rc(int b, int& R, int& C) { const int st = b / 1024, sb = b % 1024, swz = sb ^ (((sb >> 9) & 1) << 5); R = (st >> 1) * 16 + swz / 64; C = (st & 1) * 32 + (swz % 64) / 2; }
__host__ __device__ __forceinline__ int perm32(int rho) { const int n = rho >> 4, i = rho & 15; return 8 * (i >> 2) + 4 * n + (i & 3); }

struct Unit { int pm, pn; };
struct Gemm { const bf16_t* A; const bf16_t* Bt; int M, N, K; };

struct StaticOrder {
    int nM, nN, nwg, G, c;
    __host__ __device__ void init(int M, int N, int G_, int c_) { nM = M / BM; nN = N / BM; nwg = nM * nN; G = G_; c = c_; }
    __host__ __device__ bool next(int i, Unit& u) const {
        const long L = (long)i * G + c; if (L >= nwg) return false;
        int wgid = (int)L; { const int q = nwg / NXCD, r = nwg % NXCD, xcd = wgid % NXCD, off = wgid / NXCD; wgid = (xcd < r ? xcd * (q + 1) : r * (q + 1) + (xcd - r) * q) + off; }
        const int nig = WGM * nN, gid = wgid / nig, fm = gid * WGM, gsz = (nM - fm) < WGM ? (nM - fm) : WGM;
        u.pm = fm + ((wgid % nig) % gsz); u.pn = (wgid % nig) / gsz; return true;
    }
    __device__ __forceinline__ void a_ready(const Unit&) const {}
    __device__ __forceinline__ void done(const Unit&) const {}
};

__device__ __forceinline__ unsigned cvt_pk_bf16(float lo, float hi) { unsigned r; asm volatile("v_cvt_pk_bf16_f32 %0, %1, %2" : "=v"(r) : "v"(lo), "v"(hi)); return r; }
typedef float f32x2 __attribute__((ext_vector_type(2)));
__device__ __forceinline__ f32x2 gelu_pk(f32x2 v) {
    const f32x2 av = __builtin_elementwise_abs(v), d = av * 0.2316418882f + 1.0f;
    f32x2 t; t.x = __builtin_amdgcn_rcpf(d.x); t.y = __builtin_amdgcn_rcpf(d.y);
    f32x2 q = t * 0.5307027145f + (-0.7265760135f); q = q * t + 0.7107068705f; q = q * t + (-0.142248368f); q = q * t + 0.127414796f; q = q * t;
    const f32x2 s = (v * v) * (-0.72134752044f);
    f32x2 e; e.x = __builtin_amdgcn_exp2f(s.x); e.y = __builtin_amdgcn_exp2f(s.y);
    const f32x2 m = v * (q * e), r = v - m;
    f32x2 o; o.x = v.x < 0.f ? m.x : r.x; o.y = v.y < 0.f ? m.y : r.y; return o;
}

template <int ACT  > struct EpiBf16 {
    static constexpr bool PERM = true, AFTER_DRAIN = false; static_assert(ACT == 0 || ACT == 1, "EpiBf16: ACT is 0 (none) or 1 (gelu_pk)");
    bf16_t* O; int ldc; const float* bias; int split_cols; size_t split_stride; float scale0;
    __device__ __forceinline__ void operator()(const f32x4 (&acc)[2][2][4][2], const Unit& u, int wr, int wc, int fr, int fq) const {
        const int row0 = u.pm * BM + wr * 64 + fr; int colt = u.pn * BM; bf16_t* base = O;
        float sc = 1.f; if (split_cols) { const int t = colt / split_cols; base += (size_t)t * split_stride; colt -= t * split_cols; if (t == 0) sc = scale0; }
        const int col0 = colt + wc * 32 + 8 * fq, bcol0 = u.pn * BM + wc * 32 + 8 * fq;
        f32x4 bv[2][2];
#pragma unroll
        for (int bj = 0; bj < 2; ++bj)
#pragma unroll
            for (int n = 0; n < 2; ++n) bv[bj][n] = bias ? *(const f32x4*)(bias + bcol0 + bj * HALF + 4 * n) : (f32x4){0.f, 0.f, 0.f, 0.f};
#pragma unroll
        for (int ai = 0; ai < 2; ++ai)
#pragma unroll
            for (int m = 0; m < 4; ++m) { bf16_t* rowp = base + (size_t)(row0 + ai * HALF + m * 16) * ldc + col0;
#pragma unroll
                for (int bj = 0; bj < 2; ++bj) { f32x4 v0 = acc[ai][bj][m][0] + bv[bj][0], v1 = acc[ai][bj][m][1] + bv[bj][1];
                    if (ACT == 1) { f32x2 a = gelu_pk((f32x2){v0[0], v0[1]}), b = gelu_pk((f32x2){v0[2], v0[3]}), c = gelu_pk((f32x2){v1[0], v1[1]}), d = gelu_pk((f32x2){v1[2], v1[3]});
                        v0 = (f32x4){a.x, a.y, b.x, b.y}; v1 = (f32x4){c.x, c.y, d.x, d.y}; }
                    v0 = v0 * sc; v1 = v1 * sc; u32x4 w; w.x = cvt_pk_bf16(v0[0], v0[1]); w.y = cvt_pk_bf16(v0[2], v0[3]); w.z = cvt_pk_bf16(v1[0], v1[1]); w.w = cvt_pk_bf16(v1[2], v1[3]);
                    *(u32x4*)(rowp + bj * HALF) = w; } }
    }
};

template <class Epi, class Sched, bool ALIGN_EPI = false, bool SP2 = false>
__device__ __forceinline__ void gemm_phase(PG8_LAS unsigned char* lds, const Gemm g, const Sched& S, const Epi& E) {
    const int tid = threadIdx.x, wid = __builtin_amdgcn_readfirstlane(tid >> 6), lane = tid & 63, wr = wid >> 2, wc = wid & 3, fr = lane & 15, fq = lane >> 4;
    const int K = g.K, nt = K / BK;
    unsigned voffA[2], voffB[2];
#pragma unroll
    for (int i = 0; i < 2; ++i) { int R, C; stage_rc(tid * 16 + i * 8192, R, C); const int Rb = Epi::PERM ? ((R & ~31) + perm32(R & 31)) : R;
        voffA[i] = (unsigned)(R * K + C) * 2u; voffB[i] = (unsigned)(Rb * K + C) * 2u; }
    const size_t kstep = (size_t)(BK * 2);
    const size_t hstep = (size_t)HALF * K * 2;
    const size_t tstep = 2 * hstep;
    const unsigned ldsw = (unsigned)wid * 1024u;
    const int aoff = lds_byte(wr * 64 + fr, fq * 8), boff = lds_byte(wc * 32 + fr, fq * 8);
#define PG8_SA(b, h) (((b) * 2 + (h)) * HTB)
#define PG8_SB(b, h) ((4 + (b) * 2 + (h)) * HTB)
#define PG8_STAGE(bufoff, gbase, voff) do { _Pragma("unroll") for (int _i = 0; _i < 2; ++_i) \
        __builtin_amdgcn_global_load_lds((const unsigned*)((const char*)(gbase) + (voff)[_i]), (PG8_LAS unsigned*)(lds + (bufoff) + ldsw + _i * 8192), 16, 0, 0); } while (0)
#define PG8_LDA(dst, b, h) do { _Pragma("unroll") for (int m = 0; m < 4; ++m) _Pragma("unroll") for (int k = 0; k < 2; ++k) dst[m][k] = *(const PG8_LAS bf16x8*)(lds + PG8_SA(b, h) + aoff + m * 2048 + k * 1024); } while (0)
#define PG8_LDB(dst, b, h) do { _Pragma("unroll") for (int n = 0; n < 2; ++n) _Pragma("unroll") for (int k = 0; k < 2; ++k) dst[n][k] = *(const PG8_LAS bf16x8*)(lds + PG8_SB(b, h) + boff + n * 2048 + k * 1024); } while (0)
#define PG8_MMA(ai, bj, At, Bt) do { __builtin_amdgcn_s_setprio(1); _Pragma("unroll") for (int m = 0; m < 4; ++m) _Pragma("unroll") for (int n = 0; n < 2; ++n) _Pragma("unroll") for (int k = 0; k < 2; ++k) \
        acc[ai][bj][m][n] = __builtin_amdgcn_mfma_f32_16x16x32_bf16(Bt[n][k], At[m][k], acc[ai][bj][m][n], 0, 0, 0); __builtin_amdgcn_s_setprio(0); } while (0)
#define PG8_WAIT_V(n) asm volatile("s_waitcnt vmcnt(" #n ")" ::: "memory")
#define PG8_WAIT_L(n) asm volatile("s_waitcnt lgkmcnt(" #n ")" ::: "memory")
#define PG8_BAR __builtin_amdgcn_s_barrier()
#define PG8_SCHED __builtin_amdgcn_sched_barrier(0)
    Unit cur, nxt; int ui = 0;
    if (!S.next(0, cur)) return;
    f32x4 acc[2][2][4][2];
#pragma unroll
    for (int a = 0; a < 2; ++a)
#pragma unroll
        for (int b = 0; b < 2; ++b)
#pragma unroll
            for (int m = 0; m < 4; ++m)
#pragma unroll
                for (int n = 0; n < 2; ++n) acc[a][b][m][n] = (f32x4){0.f, 0.f, 0.f, 0.f};
    bf16x8 At[4][2], B0[2][2], B1[2][2];
    const char* cA = (const char*)g.A + (size_t)cur.pm * tstep; const char* cB = (const char*)g.Bt + (size_t)cur.pn * tstep;
    S.a_ready(cur);
    if constexpr (SP2) {
        PG8_STAGE(PG8_SB(0, 0), cB, voffB); PG8_STAGE(PG8_SB(0, 1), cB + hstep, voffB); PG8_STAGE(PG8_SA(0, 0), cA, voffA); PG8_STAGE(PG8_SA(0, 1), cA + hstep, voffA);
        if (wr == 1) PG8_BAR;
        PG8_WAIT_V(2); PG8_BAR;
        PG8_STAGE(PG8_SB(1, 0), cB + kstep, voffB); PG8_STAGE(PG8_SA(1, 0), cA + kstep, voffA); PG8_STAGE(PG8_SB(1, 1), cB + hstep + kstep, voffB);
        PG8_WAIT_V(6); PG8_BAR;
    } else {
        PG8_STAGE(PG8_SB(0, 0), cB, voffB); PG8_STAGE(PG8_SA(0, 0), cA, voffA); PG8_STAGE(PG8_SB(0, 1), cB + hstep, voffB); PG8_STAGE(PG8_SA(0, 1), cA + hstep, voffA);
        if (wr == 1) PG8_BAR;
        PG8_WAIT_V(4); PG8_BAR;
        PG8_STAGE(PG8_SB(1, 0), cB + kstep, voffB); PG8_STAGE(PG8_SA(1, 0), cA + kstep, voffA); PG8_STAGE(PG8_SB(1, 1), cB + hstep + kstep, voffB);
        PG8_WAIT_V(6); PG8_BAR;
    }
    for (;;) {
        const bool has_next = S.next(ui + 1, nxt);
        const char* nA = has_next ? (const char*)g.A + (size_t)nxt.pm * tstep : cA; const char* nB = has_next ? (const char*)g.Bt + (size_t)nxt.pn * tstep : cB;
        for (int t = 0; t < nt; t += 2) {
            const bool last = (t == nt - 2);
            const char* a1 = cA + (size_t)(t + 1) * kstep;
            const char* a2 = last ? nA : cA + (size_t)(t + 2) * kstep; const char* b2 = last ? nB : cB + (size_t)(t + 2) * kstep;
            const char* a3 = a2 + kstep; const char* b3 = b2 + kstep;
            if (last && has_next) S.a_ready(nxt);
            if constexpr (SP2) {
            PG8_LDB(B0, 0, 0); PG8_LDB(B1, 0, 1); PG8_SCHED; PG8_LDA(At, 0, 0); PG8_STAGE(PG8_SA(1, 1), a1 + hstep, voffA);
            PG8_WAIT_V(8); PG8_WAIT_L(0); PG8_BAR; PG8_MMA(0, 0, At, B0); PG8_MMA(0, 1, At, B1); PG8_BAR; PG8_SCHED;
            PG8_LDA(At, 0, 1); PG8_STAGE(PG8_SB(0, 0), b2, voffB); PG8_STAGE(PG8_SB(0, 1), b2 + hstep, voffB); PG8_STAGE(PG8_SA(0, 0), a2, voffA);
            PG8_WAIT_V(8); PG8_WAIT_L(0); PG8_BAR; PG8_MMA(1, 0, At, B0); PG8_MMA(1, 1, At, B1); PG8_BAR; PG8_SCHED;
            PG8_LDB(B0, 1, 0); PG8_LDB(B1, 1, 1); PG8_SCHED; PG8_LDA(At, 1, 0); PG8_STAGE(PG8_SA(0, 1), a2 + hstep, voffA);
            PG8_WAIT_V(8); PG8_WAIT_L(0); PG8_BAR; PG8_MMA(0, 0, At, B0); PG8_MMA(0, 1, At, B1); PG8_BAR; PG8_SCHED;
            PG8_LDA(At, 1, 1); PG8_STAGE(PG8_SB(1, 0), b3, voffB); PG8_STAGE(PG8_SB(1, 1), b3 + hstep, voffB); PG8_STAGE(PG8_SA(1, 0), a3, voffA);
            PG8_WAIT_V(8); PG8_WAIT_L(0); PG8_BAR; PG8_MMA(1, 0, At, B0); PG8_MMA(1, 1, At, B1); PG8_BAR; PG8_SCHED;
            } else {
            PG8_LDB(B0, 0, 0); PG8_SCHED; PG8_LDA(At, 0, 0); PG8_STAGE(PG8_SA(1, 1), a1 + hstep, voffA);
            PG8_WAIT_L(8); PG8_BAR; PG8_WAIT_L(0); PG8_MMA(0, 0, At, B0); PG8_BAR; PG8_SCHED;
            PG8_LDB(B1, 0, 1); PG8_STAGE(PG8_SB(0, 0), b2, voffB);
            PG8_BAR; PG8_WAIT_L(0); PG8_MMA(0, 1, At, B1); PG8_BAR;
            PG8_LDA(At, 0, 1); PG8_STAGE(PG8_SA(0, 0), a2, voffA);
            PG8_BAR; PG8_WAIT_L(0); PG8_MMA(1, 0, At, B0); PG8_BAR; PG8_SCHED;
            PG8_STAGE(PG8_SB(0, 1), b2 + hstep, voffB);
            PG8_WAIT_V(6); PG8_BAR; PG8_MMA(1, 1, At, B1); PG8_BAR;
            PG8_LDB(B0, 1, 0); PG8_SCHED; PG8_LDA(At, 1, 0); PG8_STAGE(PG8_SA(0, 1), a2 + hstep, voffA);
            PG8_WAIT_L(8); PG8_BAR; PG8_WAIT_L(0); PG8_MMA(0, 0, At, B0); PG8_BAR; PG8_SCHED;
            PG8_LDB(B1, 1, 1); PG8_STAGE(PG8_SB(1, 0), b3, voffB);
            PG8_BAR; PG8_WAIT_L(0); PG8_MMA(0, 1, At, B1); PG8_BAR;
            PG8_LDA(At, 1, 1); PG8_STAGE(PG8_SA(1, 0), a3, voffA);
            PG8_BAR; PG8_WAIT_L(0); PG8_MMA(1, 0, At, B0); PG8_BAR; PG8_SCHED;
            PG8_STAGE(PG8_SB(1, 1), b3 + hstep, voffB);
            PG8_WAIT_V(6); PG8_BAR; PG8_MMA(1, 1, At, B1); PG8_BAR;
            }
        }
        if constexpr (ALIGN_EPI) { if (wr == 0) PG8_BAR; }
        if constexpr (!Epi::AFTER_DRAIN) { E(acc, cur, wr, wc, fr, fq); S.done(cur); }
        if (!has_next) break;
#pragma unroll
        for (int a = 0; a < 2; ++a)
#pragma unroll
            for (int b = 0; b < 2; ++b)
#pragma unroll
                for (int m = 0; m < 4; ++m)
#pragma unroll
                    for (int n = 0; n < 2; ++n) acc[a][b][m][n] = (f32x4){0.f, 0.f, 0.f, 0.f};
        cur = nxt; cA = nA; cB = nB; ++ui;
        if constexpr (ALIGN_EPI) { if (wr == 1) PG8_BAR; }
    }
    PG8_WAIT_V(0);
    if constexpr (!ALIGN_EPI) { if (wr == 0) PG8_BAR; }
    PG8_BAR;
    if constexpr (Epi::AFTER_DRAIN) { E.fused(acc, cur, wr, wc, fr, fq, lds, wid, lane); S.done(cur); }
#undef PG8_SA
#undef PG8_SB
#undef PG8_STAGE
#undef PG8_LDA
#undef PG8_LDB
#undef PG8_MMA
#undef PG8_WAIT_V
#undef PG8_WAIT_L
#undef PG8_BAR
#undef PG8_SCHED
}
}
namespace pg8 {
struct EpiProj {
    static constexpr bool PERM = true, AFTER_DRAIN = false;
    bf16_t* O; int ldc; int gelu_tiles;
    __device__ __forceinline__ void operator()(const f32x4 (&acc)[2][2][4][2], const Unit& u, int wr, int wc, int fr, int fq) const {
        const int row0 = u.pm * BM + wr * 64 + fr; const int col0 = u.pn * BM + wc * 32 + 8 * fq;
        const bool act = u.pn < gelu_tiles;
#pragma unroll
        for (int ai = 0; ai < 2; ++ai)
#pragma unroll
            for (int m = 0; m < 4; ++m) { bf16_t* rowp = O + (size_t)(row0 + ai * HALF + m * 16) * ldc + col0;
#pragma unroll
                for (int bj = 0; bj < 2; ++bj) { f32x4 v0 = acc[ai][bj][m][0], v1 = acc[ai][bj][m][1];
                    if (act) { f32x2 a = gelu_pk((f32x2){v0[0], v0[1]}), b = gelu_pk((f32x2){v0[2], v0[3]}), c = gelu_pk((f32x2){v1[0], v1[1]}), d = gelu_pk((f32x2){v1[2], v1[3]});
                        v0 = (f32x4){a.x, a.y, b.x, b.y}; v1 = (f32x4){c.x, c.y, d.x, d.y}; }
                    u32x4 w; w.x = cvt_pk_bf16(v0[0], v0[1]); w.y = cvt_pk_bf16(v0[2], v0[3]); w.z = cvt_pk_bf16(v1[0], v1[1]); w.w = cvt_pk_bf16(v1[2], v1[3]);
                    *(u32x4*)(rowp + bj * HALF) = w; } }
    }
};
struct EpiResid {
    static constexpr bool PERM = false, AFTER_DRAIN = false;
    const float* base; const float* gate; float* out; int ldc;
    __device__ __forceinline__ void operator()(const f32x4 (&acc)[2][2][4][2], const Unit& u, int wr, int wc, int fr, int fq) const {
        const int row0 = u.pm * BM + wr * 64 + fr, col0 = u.pn * BM + wc * 32 + 4 * fq;
        f32x4 gv[2][2];
#pragma unroll
        for (int bj = 0; bj < 2; ++bj)
#pragma unroll
            for (int n = 0; n < 2; ++n) gv[bj][n] = *(const f32x4*)(gate + col0 + bj * HALF + n * 16);
#pragma unroll
        for (int ai = 0; ai < 2; ++ai)
#pragma unroll
            for (int m = 0; m < 4; ++m) { const size_t off = (size_t)(row0 + ai * HALF + m * 16) * ldc + col0;
#pragma unroll
                for (int bj = 0; bj < 2; ++bj)
#pragma unroll
                    for (int n = 0; n < 2; ++n) { const f32x4 b = *(const f32x4*)(base + off + bj * HALF + n * 16); *(f32x4*)(out + off + bj * HALF + n * 16) = b + gv[bj][n] * acc[ai][bj][m][n]; } }
    }
};
}
#ifndef PG8_SP2
#define PG8_SP2 true
#endif
#ifndef PG8_ALIGN
#define PG8_ALIGN true
#endif
constexpr int NWAVES = 8;
constexpr int M = 16384, D = 2048;
constexpr int IN_COLS = 6152, NPROJ = 6144;
constexpr int C_UG = 0, C_VG = 1024, C_Q = 2048, C_K = 3072, C_VM = 4096, C_OM = 5120;
constexpr int NHEAD = 4, DH = 256, CH = 128, NCHUNK = M / CH;
constexpr int NEXP = 16384, PH = 8, TOPK = 16, NSEL = PH * TOPK;
constexpr float EPS = 1e-6f;
constexpr int MOD_SHM = 0, MOD_SCM = 2048, MOD_GM = 4096, MOD_SHF = 6144, MOD_SCF = 8192, MOD_GF = 10240, NMOD = 12288;
constexpr int ADA_KC = 16, ADA_KROWS = D / ADA_KC;

constexpr size_t MiB = 1u << 20;
constexpr size_t WS_CTL = 0, CTL_ZERO_BYTES = 1 * MiB;
constexpr size_t WS_MODP = 1 * MiB;
constexpr size_t WS_MODF = WS_MODP + (size_t)ADA_KC * NMOD * 4;
constexpr size_t WS_GATES = 2 * MiB;
constexpr size_t WS_SUMM = 2 * MiB + 512 * 1024;
constexpr size_t WS_MTAB = WS_SUMM + 8192;
constexpr size_t WS_NST = 3 * MiB;
constexpr size_t WS_WIN = 4 * MiB;
constexpr size_t WS_WOUT = 28 * MiB;
constexpr size_t WS_WQ = 36 * MiB;
constexpr size_t WS_IDX = 44 * MiB;
constexpr size_t WS_PG = 52 * MiB;
constexpr size_t WS_HA = 64 * MiB;
constexpr size_t WS_PROJ = 128 * MiB;
constexpr size_t WS_STATE = 320 * MiB;
constexpr size_t WS_ED = 384 * MiB, WS_EU = 448 * MiB;
constexpr size_t WS_END = 512 * MiB;
constexpr int CW_TMO = 0, CW_CODE = 1, CW_BAR = 4096;

constexpr int RING_BYTES = 131072, LDSCTL_OFF = RING_BYTES, MISC_OFF = LDSCTL_OFF + 320, LDS_BYTES = 147456;

#define GAS __attribute__((address_space(1)))
#define LAS __attribute__((address_space(3)))
#define DI __device__ __forceinline__
typedef unsigned short bf16;
typedef unsigned v4u __attribute__((ext_vector_type(4)));
typedef unsigned v2u __attribute__((ext_vector_type(2)));
typedef float f32x4 __attribute__((ext_vector_type(4)));
typedef float f32x16 __attribute__((ext_vector_type(16)));
typedef short bf16x8 __attribute__((ext_vector_type(8)));
typedef GAS unsigned gu32;
#define RLX_AGENT __ATOMIC_RELAXED, __HIP_MEMORY_SCOPE_AGENT
#define LDS_WAIT() asm volatile("s_waitcnt lgkmcnt(0)" ::: "memory")
#define VM_WAIT() asm volatile("s_waitcnt vmcnt(0)" ::: "memory")
#define MFMA32(a, b, c) __builtin_amdgcn_mfma_f32_32x32x16_bf16((a), (b), (c), 0, 0, 0)
DI unsigned f2bf(float f) { unsigned u = __builtin_bit_cast(unsigned, f); return (u + 0x7fffu + ((u >> 16) & 1u)) >> 16; }
DI unsigned pk2(float lo, float hi) { return f2bf(lo) | (f2bf(hi) << 16); }
DI float bflo(unsigned w) { return __builtin_bit_cast(float, w << 16); }
DI float bfhi(unsigned w) { return __builtin_bit_cast(float, w & 0xffff0000u); }
DI float bf2f(unsigned short h) { return __builtin_bit_cast(float, (unsigned)h << 16); }
DI int crow(int reg, int h) { return (reg & 3) + 8 * (reg >> 2) + 4 * h; }
DI float wave_sum(float v) {
#pragma unroll
    for (int o = 1; o < 64; o <<= 1) v += __shfl_xor(v, o);
    return v;
}
DI float wave_max(float v) {
#pragma unroll
    for (int o = 1; o < 64; o <<= 1) v = fmaxf(v, __shfl_xor(v, o));
    return v;
}
DI float silu_f(float v) { return v / (1.0f + __expf(-v)); }
DI float sigmoid_f(float v) { return 1.0f / (1.0f + __expf(-v)); }
DI float gelu_f(float v) { return 0.5f * v * (1.0f + erff(v * 0.70710678118654752f)); }
typedef __bf16 bf16v2 __attribute__((ext_vector_type(2)));
#define DOT2(a, b, c) __builtin_amdgcn_fdot2_f32_bf16(__builtin_bit_cast(bf16v2, (unsigned)(a)), __builtin_bit_cast(bf16v2, (unsigned)(b)), (c), false)
DI f32x16 zero16() { f32x16 z; for (int i = 0; i < 16; ++i) z[i] = 0.f; return z; }
#define XB_TMO      128
#define XB_XCNT(j)  (256  + 64 * (j))
#define XB_XSUB(j)  (1280 + 64 * (j))
#define XB_XGEN(j)  (2304 + 64 * (j))
#define XB_TOP      3328
#define XB_TOPGEN   3392
#define XCD_BAR_WORDS 3456
#define XB_SPIN_CAP (1u << 18)

__device__ __forceinline__ unsigned xb_ld(unsigned* p)              { return __hip_atomic_load(p, __ATOMIC_RELAXED, __HIP_MEMORY_SCOPE_AGENT); }
__device__ __forceinline__ unsigned xb_add(unsigned* p, unsigned v) { return __hip_atomic_fetch_add(p, v, __ATOMIC_RELAXED, __HIP_MEMORY_SCOPE_AGENT); }
__device__ __forceinline__ unsigned xb_xcc_id() { return (unsigned)__builtin_amdgcn_s_getreg((3 << 11) | 20) & 0xFu; }
#define XB_SPIN(cond, bar) do { unsigned _sp = 0; while (cond) { __builtin_amdgcn_s_sleep(1); \
    if ((++_sp & 255u) == 0u) { if (xb_ld(&(bar)[XB_TMO])) break; if (_sp > XB_SPIN_CAP) { atomicAdd(&(bar)[XB_TMO], 1u); break; } } } } while (0)

struct XcdBarrier {
    unsigned* bar; unsigned x;
    volatile LAS unsigned* st;
};

__device__ __forceinline__ XcdBarrier xcd_barrier_post(unsigned* bar, volatile LAS unsigned* st) {
    XcdBarrier b; b.bar = bar; b.x = xb_xcc_id(); b.st = st;
    if (threadIdx.x == 0) (void)xb_add(&bar[XB_XCNT(b.x)], 1u);
    return b;
}
__device__ __forceinline__ void xcd_barrier_complete(unsigned* bar, unsigned x, unsigned& nloc, unsigned& nx) {
    const unsigned G = gridDim.x * gridDim.y * gridDim.z;
    unsigned sum, cnt, mine, sp = 0u;
    for (;;) {
        sum = 0u; cnt = 0u; mine = 0u;
#pragma unroll
        for (unsigned j = 0; j < 16; ++j) { const unsigned c = xb_ld(&bar[XB_XCNT(j)]); sum += c; cnt += (c > 0u) ? 1u : 0u; mine = (j == x) ? c : mine; }
        if (sum == G) break;
        __builtin_amdgcn_s_sleep(1);
        if ((++sp & 255u) == 0u) { if (xb_ld(&bar[XB_TMO])) break; if (sp > XB_SPIN_CAP) { atomicAdd(&bar[XB_TMO], 1u); break; } }
    }
    nloc = mine > 0u ? mine : 1u; nx = cnt > 0u ? cnt : 1u;
}

__device__ __forceinline__ void xcd_barrier(const XcdBarrier& b) {
    asm volatile("s_waitcnt vmcnt(0)" ::: "memory");
    __syncthreads();
    if (threadIdx.x == 0) {
        unsigned* bar = b.bar;
        __builtin_amdgcn_s_waitcnt(0);
        unsigned nloc = b.st[0], nx = b.st[1];
        if (nloc == 0u) { xcd_barrier_complete(bar, b.x, nloc, nx); b.st[0] = nloc; b.st[1] = nx; }
        const unsigned old = xb_add(&bar[XB_XSUB(b.x)], 1u);
        const unsigned gen = old / nloc;
        if (old + 1u == (gen + 1u) * nloc) {
            __builtin_amdgcn_fence(__ATOMIC_RELEASE, "agent");
            asm volatile("s_waitcnt vmcnt(0)" ::: "memory");
            const unsigned og = xb_add(&bar[XB_TOP], 1u);
            const unsigned tg = og / nx;
            if (og + 1u == (tg + 1u) * nx) xb_add(&bar[XB_TOPGEN], 1u);
            else XB_SPIN(xb_ld(&bar[XB_TOPGEN]) == tg, bar);
            __builtin_amdgcn_fence(__ATOMIC_ACQUIRE, "agent");
            xb_add(&bar[XB_XGEN(b.x)], 1u);
            asm volatile("s_waitcnt vmcnt(0)" ::: "memory");
        } else {
            XB_SPIN(xb_ld(&bar[XB_XGEN(b.x)]) == gen, bar);
            __builtin_amdgcn_fence(__ATOMIC_ACQUIRE, "agent");
            asm volatile("s_waitcnt vmcnt(0)" ::: "memory");
        }
    }
    __syncthreads();
}
struct Frame {
    LAS unsigned char* lds;
    volatile LAS unsigned* MISC;
    gu32* ctl;
    int tid, lane, wave, vcu, G;
    const float *x, *c, *ada_w, *ada_b, *norm_mix_g, *w_in, *b_gates, *conv_w, *conv_b, *gmlp_norm_g, *gmlp_w, *gmlp_b, *mlstm_norm_g, *w_out, *norm_ffn_g,
                *wq, *keys1, *keys2, *e_down, *e_up, *final_g;
    float* out;
    float *MODP, *MODF, *GATES, *SUMM, *MTAB, *NST, *PG;
    int* IDX;
    bf16 *WIN, *WOUT, *WQ, *HA, *PROJ, *QB, *STATE, *ED, *EU, *QC, *KC;
};

DI void p0_transpose_item(const float* W, int K, int ldw, int nblk, bf16* WT, LAS float* scr, int item, int lane) {
    const int kb = item / nblk, nb = item % nblk, k0 = 64 * kb, n0 = 32 * nb;
#pragma unroll 8
    for (int i = 0; i < 32; ++i) { const int kk = 2 * i + (lane >> 5); scr[kk * 33 + (lane & 31)] = W[(size_t)(k0 + kk) * ldw + n0 + (lane & 31)]; }
    LDS_WAIT(); asm volatile("" ::: "memory");
    const int c = lane & 7;
#pragma unroll
    for (int j = 0; j < 4; ++j) { const int n = (lane >> 3) + 8 * j; const LAS float* s = scr + (8 * c) * 33 + n;
        v4u o; o.x = pk2(s[0 * 33], s[1 * 33]); o.y = pk2(s[2 * 33], s[3 * 33]); o.z = pk2(s[4 * 33], s[5 * 33]); o.w = pk2(s[6 * 33], s[7 * 33]);
        *(GAS v4u*)(WT + (size_t)(n0 + n) * K + k0 + 8 * c) = o; }
    LDS_WAIT(); asm volatile("" ::: "memory");
}
DI void p0_ada_item(Frame& F, LAS float* scr, int item) {
    const int cc = item % (NMOD / 256), kc = item / (NMOD / 256), k0 = kc * ADA_KROWS, col = cc * 256 + F.lane * 4;
#pragma unroll
    for (int j = 0; j < ADA_KROWS / 64; ++j) scr[F.lane + 64 * j] = silu_f(F.c[k0 + F.lane + 64 * j]);
    LDS_WAIT(); asm volatile("" ::: "memory");
    f32x4 acc = {0.f, 0.f, 0.f, 0.f};
    const float* wp = F.ada_w + (size_t)k0 * NMOD + col;
#pragma unroll 8
    for (int kk = 0; kk < ADA_KROWS; ++kk) { const float s = scr[kk]; const f32x4 w = *(const GAS f32x4*)(wp + (size_t)kk * NMOD); acc += w * s; }
    *(GAS f32x4*)(F.MODP + (size_t)kc * NMOD + col) = acc;
    LDS_WAIT(); asm volatile("" ::: "memory");
}
DI void p0a_phase(Frame& F) {
    LAS float* scr = (LAS float*)(F.lds + F.wave * 16384);
    const int gw = F.vcu * NWAVES + F.wave, NGW = F.G * NWAVES;
    constexpr int I_ADA = (NMOD / 256) * ADA_KC;
    constexpr int I_WIN = (D / 64) * (NPROJ / 32), I_WO = (D / 64) * (D / 32), I_WQ = I_WO;
    constexpr int NITEMS = I_ADA + I_WIN + I_WO + I_WQ;
    for (int it = gw; it < NITEMS; it += NGW) {
        int r = it;
        if (r < I_ADA) { p0_ada_item(F, scr, r); continue; } r -= I_ADA;
        if (r < I_WIN) { p0_transpose_item(F.w_in, D, IN_COLS, NPROJ / 32, F.WIN, scr, r, F.lane); continue; } r -= I_WIN;
        if (r < I_WO) { p0_transpose_item(F.w_out, D, D, D / 32, F.WOUT, scr, r, F.lane); continue; } r -= I_WO;
        p0_transpose_item(F.wq, D, D, D / 32, F.WQ, scr, r, F.lane);
    }
    const size_t NU = (size_t)NEXP * D / 8;
    const size_t gt = (size_t)F.vcu * (NWAVES * 64) + F.tid, NT = (size_t)F.G * NWAVES * 64;
#pragma unroll 1
    for (int tb = 0; tb < 2; ++tb) {
        const float* src = tb ? F.e_up : F.e_down; bf16* dst = tb ? F.EU : F.ED;
#pragma unroll 4
        for (size_t u = gt; u < NU; u += NT) {
            const f32x4 a = *(const GAS f32x4*)(src + u * 8), b = *(const GAS f32x4*)(src + u * 8 + 4);
            v4u o; o.x = pk2(a.x, a.y); o.y = pk2(a.z, a.w); o.z = pk2(b.x, b.y); o.w = pk2(b.z, b.w);
            *(GAS v4u*)(dst + u * 8) = o;
        }
    }
}
DI float mod_final(Frame& F, int col) { float s = F.ada_b[col];
#pragma unroll
    for (int k = 0; k < ADA_KC; ++k) s += F.MODP[(size_t)k * NMOD + col];
    return s; }
DI void norm_tables(Frame& F, const float* g, int col_scale, int col_shift) {
    LAS float* A1 = (LAS float*)(F.lds); LAS float* B1 = (LAS float*)(F.lds + 8192);
#pragma unroll
    for (int i = 0; i < 4; ++i) { const int c = F.tid + 512 * i; A1[c] = g[c] * (1.0f + F.MODF[col_scale + c]); B1[c] = F.MODF[col_shift + c]; }
}
DI void p0b_phase(Frame& F) {
    LAS float* A1 = (LAS float*)(F.lds); LAS float* B1 = (LAS float*)(F.lds + 8192); LAS float* WG = (LAS float*)(F.lds + 16384);
#pragma unroll
    for (int i = 0; i < 4; ++i) { const int c = F.tid + 512 * i; A1[c] = F.norm_mix_g[c] * (1.0f + mod_final(F, MOD_SCM + c)); B1[c] = mod_final(F, MOD_SHM + c); }
    { const int per = (NMOD + F.G - 1) / F.G; const int c = (int)blockIdx.x * per + F.tid; if (F.tid < per && c < NMOD) F.MODF[c] = mod_final(F, c); }
#pragma unroll
    for (int i = 0; i < 4; ++i) { const int k = F.tid + 512 * i; const f32x4 a = *(const GAS f32x4*)(F.w_in + (size_t)k * IN_COLS + NPROJ), b = *(const GAS f32x4*)(F.w_in + (size_t)k * IN_COLS + NPROJ + 4);
        WG[0 * 2048 + k] = a.x; WG[1 * 2048 + k] = a.y; WG[2 * 2048 + k] = a.z; WG[3 * 2048 + k] = a.w; WG[4 * 2048 + k] = b.x; WG[5 * 2048 + k] = b.y; WG[6 * 2048 + k] = b.z; WG[7 * 2048 + k] = b.w; }
    __syncthreads();
    const int rows_per_blk = M / F.G, rows_per_wave = rows_per_blk / NWAVES;
    const int r0 = F.vcu * rows_per_blk + F.wave * rows_per_wave;
    for (int rr = 0; rr < rows_per_wave; ++rr) {
        const int row = r0 + rr;
        const GAS f32x4* xr = (const GAS f32x4*)(F.x + (size_t)row * D) + F.lane;
        f32x4 v[8]; float ss = 0.f;
#pragma unroll
        for (int j = 0; j < 8; ++j) { v[j] = xr[64 * j]; ss += (v[j].x * v[j].x + v[j].y * v[j].y) + (v[j].z * v[j].z + v[j].w * v[j].w); }
        const float rstd = 1.0f / sqrtf(wave_sum(ss) * (1.0f / D) + EPS);
        float gd[8];
#pragma unroll
        for (int g = 0; g < 8; ++g) gd[g] = 0.f;
        GAS v2u* o8 = (GAS v2u*)(F.HA + (size_t)row * D) + F.lane;
#pragma unroll
        for (int j = 0; j < 8; ++j) {
            const f32x4 a = *(const LAS f32x4*)(A1 + 256 * j + 4 * F.lane), b = *(const LAS f32x4*)(B1 + 256 * j + 4 * F.lane);
            const f32x4 h = v[j] * rstd * a + b;
            v2u o; o.x = pk2(h.x, h.y); o.y = pk2(h.z, h.w); o8[64 * j] = o;
#pragma unroll
            for (int g = 0; g < 8; ++g) { const f32x4 w = *(const LAS f32x4*)(WG + g * 2048 + 256 * j + 4 * F.lane); gd[g] += (h.x * w.x + h.y * w.y) + (h.z * w.z + h.w * w.w); }
            asm volatile("" ::: "memory");
        }
#pragma unroll
        for (int g = 0; g < 8; ++g) gd[g] = wave_sum(gd[g]);
        if (F.lane == 0) {
#pragma unroll
            for (int g = 0; g < 8; ++g) { float p = gd[g] + F.b_gates[g];
                if (g >= 4) { p = fminf(p, 0.f) - log1pf(__expf(-fabsf(p))); }
                F.GATES[(size_t)row * 8 + g] = p; }
        }
    }
}
constexpr int IMG_PITCH = 528, M1_WL = 69632, M1_RED = 73728;
DI void m1_item(Frame& F, int hh, int kc) {
    LAS unsigned char* IMG = F.lds; LAS float* WL = (LAS float*)(F.lds + M1_WL); LAS float* RED = (LAS float*)(F.lds + M1_RED);
    const int t0 = kc * CH, lane = F.lane, tid = F.tid;
    if (F.wave == 0) {
        const float* gp = F.GATES + (size_t)(t0 + 2 * lane) * 8;
        const float i0 = gp[hh], lf0 = gp[4 + hh], i1 = gp[8 + hh], lf1 = gp[12 + hh];
        const float p = lf0 + lf1; float inc = p;
#pragma unroll
        for (int o = 1; o < 64; o <<= 1) { const float t = __shfl_up(inc, o); if (lane >= o) inc += t; }
        const float A = __shfl(inc, 63), ex = inc - p, b0 = ex + lf0, b1 = ex + p;
        const float lw0 = A - b0 + i0, lw1 = A - b1 + i1;
        const float B = wave_max(fmaxf(lw0, lw1));
        WL[2 * lane] = __expf(lw0 - B); WL[2 * lane + 1] = __expf(lw1 - B);
        if (lane == 0) { F.SUMM[(hh * NCHUNK + kc) * 2] = A; F.SUMM[(hh * NCHUNK + kc) * 2 + 1] = B; }
    }
    __syncthreads();
    const int dg = tid & 31, sb = tid >> 5;
#pragma unroll 1
    for (int which = 0; which < 2; ++which) {
        const int chb = (which == 0 ? 1024 : 0) + hh * DH + dg * 8;
        const int colb = (which == 0 ? C_K : C_Q) + hh * DH + dg * 8;
        float cw[4][8], cb[8];
#pragma unroll
        for (int j = 0; j < 4; ++j) { const f32x4 a = *(const GAS f32x4*)(F.conv_w + j * 2048 + chb), b = *(const GAS f32x4*)(F.conv_w + j * 2048 + chb + 4);
            cw[j][0] = a.x; cw[j][1] = a.y; cw[j][2] = a.z; cw[j][3] = a.w; cw[j][4] = b.x; cw[j][5] = b.y; cw[j][6] = b.z; cw[j][7] = b.w; }
        { const f32x4 a = *(const GAS f32x4*)(F.conv_b + chb), b = *(const GAS f32x4*)(F.conv_b + chb + 4);
          cb[0] = a.x; cb[1] = a.y; cb[2] = a.z; cb[3] = a.w; cb[4] = b.x; cb[5] = b.y; cb[6] = b.z; cb[7] = b.w; }
        float dnp[8];
#pragma unroll
        for (int e = 0; e < 8; ++e) dnp[e] = 0.f;
#pragma unroll 2
        for (int i = 0; i < 8; ++i) {
            const int s = sb + 16 * i, t = t0 + s;
            float acc[8];
#pragma unroll
            for (int e = 0; e < 8; ++e) acc[e] = cb[e];
#pragma unroll
            for (int j = 0; j < 4; ++j) { const int tt = t - 3 + j;
                v4u w = {0u, 0u, 0u, 0u}; if (tt >= 0) w = *(const GAS v4u*)(F.PROJ + (size_t)tt * NPROJ + colb);
                acc[0] += cw[j][0] * bflo(w.x); acc[1] += cw[j][1] * bfhi(w.x); acc[2] += cw[j][2] * bflo(w.y); acc[3] += cw[j][3] * bfhi(w.y);
                acc[4] += cw[j][4] * bflo(w.z); acc[5] += cw[j][5] * bfhi(w.z); acc[6] += cw[j][6] * bflo(w.w); acc[7] += cw[j][7] * bfhi(w.w); }
#pragma unroll
            for (int e = 0; e < 8; ++e) acc[e] = silu_f(acc[e]);
            if (which == 0) {
                v4u o; o.x = pk2(acc[0], acc[1]); o.y = pk2(acc[2], acc[3]); o.z = pk2(acc[4], acc[5]); o.w = pk2(acc[6], acc[7]);
                *(GAS v4u*)(F.KC + (size_t)t * 1024 + hh * DH + dg * 8) = o;
                const float wl = WL[s];
#pragma unroll
                for (int e = 0; e < 8; ++e) { acc[e] *= wl; dnp[e] += acc[e]; }
                v4u o2; o2.x = pk2(acc[0], acc[1]); o2.y = pk2(acc[2], acc[3]); o2.z = pk2(acc[4], acc[5]); o2.w = pk2(acc[6], acc[7]);
                *(LAS v4u*)(IMG + s * IMG_PITCH + dg * 16) = o2;
            } else {
#pragma unroll
                for (int e = 0; e < 8; ++e) acc[e] *= 0.0625f;
                v4u o; o.x = pk2(acc[0], acc[1]); o.y = pk2(acc[2], acc[3]); o.z = pk2(acc[4], acc[5]); o.w = pk2(acc[6], acc[7]);
                *(GAS v4u*)(F.QC + (size_t)t * 1024 + hh * DH + dg * 8) = o;
            }
        }
        if (which == 0) {
#pragma unroll
            for (int e = 0; e < 8; ++e) RED[sb * 256 + dg * 8 + e] = dnp[e];
        }
    }
    __syncthreads();
    if (tid < 256) { float s = 0.f;
#pragma unroll
        for (int i = 0; i < 16; ++i) s += RED[i * 256 + tid];
        F.NST[(size_t)(hh * NCHUNK + kc) * DH + tid] = s; }
    const int r = lane & 31, h = lane >> 5, e0 = F.wave * 32;
    bf16x8 bf[8];
#pragma unroll
    for (int ks = 0; ks < 8; ++ks) {
        const bf16* vp = F.PROJ + (size_t)(t0 + ks * 16 + 8 * h) * NPROJ + C_VM + hh * DH + e0 + r;
#pragma unroll
        for (int j = 0; j < 8; ++j) bf[ks][j] = (short)vp[(size_t)j * NPROJ];
    }
    bf16* sp = F.STATE + (size_t)(hh * NCHUNK + kc) * (DH * DH) + (size_t)(e0 + r) * DH;
#pragma unroll 1
    for (int dt = 0; dt < 8; ++dt) {
        f32x16 acc = zero16();
#pragma unroll
        for (int ks = 0; ks < 8; ++ks) {
            bf16x8 af; const LAS unsigned char* ip = IMG + (ks * 16 + 8 * h) * IMG_PITCH + (dt * 32 + r) * 2;
#pragma unroll
            for (int j = 0; j < 8; ++j) af[j] = (short)*(const LAS unsigned short*)(ip + j * IMG_PITCH);
            acc = MFMA32(af, bf[ks], acc);
        }
#pragma unroll
        for (int g = 0; g < 4; ++g) { v2u o; o.x = pk2(acc[4 * g], acc[4 * g + 1]); o.y = pk2(acc[4 * g + 2], acc[4 * g + 3]);
            *(GAS v2u*)(sp + dt * 32 + 8 * g + 4 * h) = o; }
    }
    __syncthreads();
}
DI void gmlp_item(Frame& F, int n, int g) {
    LAS float* RSTD = (LAS float*)F.lds;
    const int t0 = n * CH, c0 = g * 128, lane = F.lane, tid = F.tid;
    { const int s = tid >> 2, qd = tid & 3; const bf16* vp = F.PROJ + (size_t)(t0 + s) * NPROJ + C_VG + c0 + qd * 32; float ss = 0.f;
#pragma unroll
        for (int i = 0; i < 4; ++i) { const v4u w = *(const GAS v4u*)(vp + 8 * i);
            const float a0 = bflo(w.x), a1 = bfhi(w.x), a2 = bflo(w.y), a3 = bfhi(w.y), a4 = bflo(w.z), a5 = bfhi(w.z), a6 = bflo(w.w), a7 = bfhi(w.w);
            ss += (a0 * a0 + a1 * a1) + (a2 * a2 + a3 * a3) + (a4 * a4 + a5 * a5) + (a6 * a6 + a7 * a7); }
        ss += __shfl_xor(ss, 1); ss += __shfl_xor(ss, 2);
        if (qd == 0) RSTD[s] = 1.0f / sqrtf(ss * (1.0f / 128.0f) + EPS); }
    __syncthreads();
    const int r = lane & 31, h = lane >> 5, ct = F.wave & 3, tp = F.wave >> 2;
    bf16x8 af[8];
#pragma unroll
    for (int ks = 0; ks < 8; ++ks) {
        const bf16* vp = F.PROJ + (size_t)(t0 + ks * 16 + 8 * h) * NPROJ + C_VG + c0 + ct * 32 + r;
#pragma unroll
        for (int j = 0; j < 8; ++j) af[ks][j] = (short)vp[(size_t)j * NPROJ];
    }
    float ng[16];
#pragma unroll
    for (int reg = 0; reg < 16; ++reg) ng[reg] = F.gmlp_norm_g[g * 128 + ct * 32 + crow(reg, h)];
#pragma unroll 1
    for (int ti = 0; ti < 2; ++ti) {
        const int tt = (ti == 0) ? tp : 3 - tp;
        const int t = tt * 32 + r;
        const float* wrow = F.gmlp_w + (size_t)(g * 128 + t) * 128;
        f32x16 acc = zero16();
#pragma unroll
        for (int ks = 0; ks < 8; ++ks) {
            if (ks <= 2 * tt + 1) {
                const int s0 = ks * 16 + 8 * h;
                const f32x4 wa = *(const GAS f32x4*)(wrow + s0), wb = *(const GAS f32x4*)(wrow + s0 + 4);
                const f32x4 ra = *(const LAS f32x4*)(RSTD + s0), rb = *(const LAS f32x4*)(RSTD + s0 + 4);
                float wv[8] = {wa.x * ra.x, wa.y * ra.y, wa.z * ra.z, wa.w * ra.w, wb.x * rb.x, wb.y * rb.y, wb.z * rb.z, wb.w * rb.w};
#pragma unroll
                for (int j = 0; j < 8; ++j) if (s0 + j > t) wv[j] = 0.f;
                v4u bw; bw.x = pk2(wv[0], wv[1]); bw.y = pk2(wv[2], wv[3]); bw.z = pk2(wv[4], wv[5]); bw.w = pk2(wv[6], wv[7]);
                acc = MFMA32(af[ks], __builtin_bit_cast(bf16x8, bw), acc);
            }
        }
        const float bsp = F.gmlp_b[g * 128 + t];
        const bf16* up = F.PROJ + (size_t)(t0 + t) * NPROJ + C_UG + c0 + ct * 32;
        bf16* yp = F.HA + (size_t)(t0 + t) * D + c0 + ct * 32;
#pragma unroll
        for (int gq = 0; gq < 4; ++gq) { const int cl = 8 * gq + 4 * h;
            const v2u uw = *(const GAS v2u*)(up + cl);
            const float y0 = bflo(uw.x) * (ng[4 * gq] * acc[4 * gq] + bsp), y1 = bfhi(uw.x) * (ng[4 * gq + 1] * acc[4 * gq + 1] + bsp);
            const float y2 = bflo(uw.y) * (ng[4 * gq + 2] * acc[4 * gq + 2] + bsp), y3 = bfhi(uw.y) * (ng[4 * gq + 3] * acc[4 * gq + 3] + bsp);
            v2u o; o.x = pk2(y0, y1); o.y = pk2(y2, y3); *(GAS v2u*)(yp + cl) = o; }
    }
    __syncthreads();
}
DI void p2_phase(Frame& F) {
    constexpr int N_M1 = NHEAD * NCHUNK, N_G = (M / CH) * 8;
    for (int it = (int)blockIdx.x; it < N_M1 + N_G; it += F.G) {
        if (it < N_M1) m1_item(F, it / NCHUNK, it % NCHUNK);
        else { const int j = it - N_M1; gmlp_item(F, j % (M / CH), j / (M / CH)); }
    }
}
DI void p3_phase(Frame& F) {
    LAS float* TAB = (LAS float*)F.lds;
    const int lane = F.lane;
    if (F.wave < NHEAD) {
        const int hh = F.wave; const float* sp = F.SUMM + (size_t)(hh * NCHUNK + 2 * lane) * 2;
        const float A0 = sp[0], B0 = sp[1], A1 = sp[2], B1 = sp[3];
        float ca = A0 + A1, cb = fmaxf(B0 + A1, B1);
        const float pa = ca, pb = cb;
#pragma unroll
        for (int o = 1; o < 64; o <<= 1) { const float ta = __shfl_up(ca, o), tb = __shfl_up(cb, o); if (lane >= o) { cb = fmaxf(tb + ca, cb); ca = ta + ca; } }
        (void)pa; (void)pb;
        float ea = __shfl_up(ca, 1), eb = __shfl_up(cb, 1);
        float m0 = (lane == 0) ? 0.f : fmaxf(ea, eb);
        const float m1 = fmaxf(m0 + A0, B0), m2 = fmaxf(m1 + A1, B1);
        TAB[(hh * NCHUNK + 2 * lane) * 2] = __expf(A0 + m0 - m1); TAB[(hh * NCHUNK + 2 * lane) * 2 + 1] = __expf(B0 - m1);
        TAB[(hh * NCHUNK + 2 * lane + 1) * 2] = __expf(A1 + m1 - m2); TAB[(hh * NCHUNK + 2 * lane + 1) * 2 + 1] = __expf(B1 - m2);
        if (blockIdx.x == 0) { F.MTAB[hh * NCHUNK + 2 * lane] = m0; F.MTAB[hh * NCHUNK + 2 * lane + 1] = m1; }
    }
    __syncthreads();
    const int NT = F.G * NWAVES * 64, gt = (int)blockIdx.x * (NWAVES * 64) + F.tid;
    for (int p = gt; p < NHEAD * (DH * DH / 2); p += NT) {
        const int hh = p / (DH * DH / 2), q = p % (DH * DH / 2);
        GAS unsigned* sp = (GAS unsigned*)(F.STATE + (size_t)hh * NCHUNK * (DH * DH)) + q;
        float s0 = 0.f, s1 = 0.f;
#pragma unroll 1
        for (int k0 = 0; k0 < NCHUNK; k0 += 16) {
            unsigned ld[16];
#pragma unroll
            for (int k = 0; k < 16; ++k) ld[k] = sp[(size_t)(k0 + k) * (DH * DH / 2)];
#pragma unroll
            for (int k = 0; k < 16; ++k) {
                sp[(size_t)(k0 + k) * (DH * DH / 2)] = pk2(s0, s1);
                const float dec = TAB[(hh * NCHUNK + k0 + k) * 2], wb = TAB[(hh * NCHUNK + k0 + k) * 2 + 1];
                s0 = dec * s0 + wb * bflo(ld[k]); s1 = dec * s1 + wb * bfhi(ld[k]);
            }
        }
    }
    for (int p = gt; p < NHEAD * DH; p += NT) {
        const int hh = p / DH, d = p % DH; float* np = F.NST + (size_t)hh * NCHUNK * DH + d; float s = 0.f;
#pragma unroll 8
        for (int k = 0; k < NCHUNK; ++k) { const float ld = np[(size_t)k * DH]; np[(size_t)k * DH] = s; s = TAB[(hh * NCHUNK + k) * 2] * s + TAB[(hh * NCHUNK + k) * 2 + 1] * ld; }
    }
}
DI void m3_item(Frame& F, int hh, int kc) {
    LAS float* GS = (LAS float*)F.lds; LAS float* MX = (LAS float*)(F.lds + 512); LAS float* BT = (LAS float*)(F.lds + 1024);
    LAS float* NK = (LAS float*)(F.lds + 2048); LAS float* XCH = (LAS float*)(F.lds + 4096);
    const int t0 = kc * CH, lane = F.lane, tid = F.tid, item = hh * NCHUNK + kc;
    const float mk = F.MTAB[item];
    if (F.wave == 0) {
        const float* gp = F.GATES + (size_t)(t0 + 2 * lane) * 8;
        const float i0 = gp[hh], lf0 = gp[4 + hh], i1 = gp[8 + hh], lf1 = gp[12 + hh];
        const float p = lf0 + lf1; float inc = p;
#pragma unroll
        for (int o = 1; o < 64; o <<= 1) { const float t = __shfl_up(inc, o); if (lane >= o) inc += t; }
        const float ex = inc - p, b0 = ex + lf0, b1 = ex + p;
        const float g0 = i0 - b0, g1 = i1 - b1;
        float cm = fmaxf(g0, g1);
#pragma unroll
        for (int o = 1; o < 64; o <<= 1) { const float t = __shfl_up(cm, o); if (lane >= o) cm = fmaxf(cm, t); }
        float pm = __shfl_up(cm, 1); if (lane == 0) pm = -INFINITY;
        const float M0 = fmaxf(mk, fmaxf(pm, g0)), M1 = fmaxf(M0, g1);
        GS[2 * lane] = g0; GS[2 * lane + 1] = g1; MX[2 * lane] = M0; MX[2 * lane + 1] = M1; BT[2 * lane] = b0; BT[2 * lane + 1] = b1;
    }
    if (tid < 256) NK[tid] = F.NST[(size_t)item * DH + tid];
    LAS unsigned char* VIMG = F.lds + 8192;
#pragma unroll
    for (int i = 0; i < 8; ++i) { const int c = tid + 512 * i, row = c >> 5, c16 = c & 31;
        *(LAS v4u*)(VIMG + row * IMG_PITCH + c16 * 16) = *(const GAS v4u*)(F.PROJ + (size_t)(t0 + row) * NPROJ + C_VM + hh * DH + c16 * 8); }
    __syncthreads();
    const int r = lane & 31, h = lane >> 5, tt = F.wave & 3, eh = F.wave >> 2;
    const int tl = tt * 32 + r, t = t0 + tl;
    const float Mt = MX[tl], winter = __expf(mk - Mt);
    f32x16 accH[4];
#pragma unroll
    for (int i = 0; i < 4; ++i) accH[i] = zero16();
    float qn = 0.f;
    const bf16* qp = F.QC + (size_t)t * 1024 + hh * DH + 8 * h;
    const bf16* kp = F.KC + (size_t)(t0 + r) * 1024 + hh * DH + 8 * h;
    const bf16* cp = F.STATE + (size_t)item * (DH * DH) + (size_t)(eh * 128 + r) * DH + 8 * h;
#pragma unroll 2
    for (int ks = 0; ks < 16; ++ks) {
        const v4u qw = *(const GAS v4u*)(qp + ks * 16);
        float qv[8] = {bflo(qw.x), bfhi(qw.x), bflo(qw.y), bfhi(qw.y), bflo(qw.z), bfhi(qw.z), bflo(qw.w), bfhi(qw.w)};
        const f32x4 na = *(const LAS f32x4*)(NK + ks * 16 + 8 * h), nb = *(const LAS f32x4*)(NK + ks * 16 + 8 * h + 4);
        qn += (qv[0] * na.x + qv[1] * na.y) + (qv[2] * na.z + qv[3] * na.w) + (qv[4] * nb.x + qv[5] * nb.y) + (qv[6] * nb.z + qv[7] * nb.w);
        v4u q2; q2.x = pk2(qv[0] * winter, qv[1] * winter); q2.y = pk2(qv[2] * winter, qv[3] * winter); q2.z = pk2(qv[4] * winter, qv[5] * winter); q2.w = pk2(qv[6] * winter, qv[7] * winter);
        const bf16x8 q2f = __builtin_bit_cast(bf16x8, q2);
#pragma unroll
        for (int et = 0; et < 4; ++et) { const bf16x8 cf = *(const GAS bf16x8*)(cp + (size_t)et * 32 * DH + ks * 16); accH[et] = MFMA32(cf, q2f, accH[et]); }
    }
    qn += __shfl_xor(qn, 32);
    float den = 0.f;
    const LAS unsigned char* vbase = VIMG + 4 * h * IMG_PITCH + (eh * 128 + r) * 2;
#pragma unroll 1
    for (int st = 0; st <= tt; ++st) {
        f32x16 accS = zero16();
        const bf16* kps = kp + (size_t)st * 32 * 1024;
#pragma unroll 4
        for (int ks = 0; ks < 16; ++ks) { const bf16x8 qf = *(const GAS bf16x8*)(qp + ks * 16); const bf16x8 kf = *(const GAS bf16x8*)(kps + ks * 16); accS = MFMA32(kf, qf, accS); }
        float xv[16];
#pragma unroll
        for (int reg = 0; reg < 16; ++reg) { const int sl = st * 32 + crow(reg, h); float v = accS[reg] * __expf(GS[sl] - Mt); if (sl > tl) v = 0.f; xv[reg] = v; den += v; }
        const LAS unsigned char* vb2 = vbase + st * 32 * IMG_PITCH;
#pragma unroll
        for (int k2 = 0; k2 < 2; ++k2) {
            v4u xw; xw.x = pk2(xv[8 * k2], xv[8 * k2 + 1]); xw.y = pk2(xv[8 * k2 + 2], xv[8 * k2 + 3]); xw.z = pk2(xv[8 * k2 + 4], xv[8 * k2 + 5]); xw.w = pk2(xv[8 * k2 + 6], xv[8 * k2 + 7]);
            const bf16x8 xs = __builtin_bit_cast(bf16x8, xw);
#pragma unroll
            for (int et = 0; et < 4; ++et) {
                bf16x8 vf;
#pragma unroll
                for (int j = 0; j < 8; ++j) vf[j] = (short)*(const LAS unsigned short*)(vb2 + (16 * k2 + 8 * (j >> 2) + (j & 3)) * IMG_PITCH + et * 64);
                accH[et] = MFMA32(vf, xs, accH[et]);
            }
        }
    }
    den += __shfl_xor(den, 32);
    den += winter * qn;
    const float dnm = fmaxf(fabsf(den), __expf(-(BT[tl] + Mt))), inv = 1.0f / dnm;
    float ss = 0.f;
#pragma unroll
    for (int et = 0; et < 4; ++et)
#pragma unroll
        for (int reg = 0; reg < 16; ++reg) { accH[et][reg] *= inv; ss += accH[et][reg] * accH[et][reg]; }
    ss += __shfl_xor(ss, 32);
    if (h == 0) XCH[eh * 128 + tl] = ss;
    __syncthreads();
    const float rstd = 1.0f / sqrtf((XCH[tl] + XCH[128 + tl]) * (1.0f / DH) + EPS);
    const bf16* op = F.PROJ + (size_t)t * NPROJ + C_OM + hh * DH + eh * 128;
    bf16* yp = F.HA + (size_t)t * D + 1024 + hh * DH + eh * 128;
    const float* ngp = F.mlstm_norm_g + hh * DH + eh * 128;
#pragma unroll
    for (int et = 0; et < 4; ++et)
#pragma unroll
        for (int gq = 0; gq < 4; ++gq) { const int el = et * 32 + 8 * gq + 4 * h;
            const v2u ow = *(const GAS v2u*)(op + el); const f32x4 gn = *(const GAS f32x4*)(ngp + el);
            const float y0 = accH[et][4 * gq] * rstd * gn.x * sigmoid_f(bflo(ow.x)), y1 = accH[et][4 * gq + 1] * rstd * gn.y * sigmoid_f(bfhi(ow.x));
            const float y2 = accH[et][4 * gq + 2] * rstd * gn.z * sigmoid_f(bflo(ow.y)), y3 = accH[et][4 * gq + 3] * rstd * gn.w * sigmoid_f(bfhi(ow.y));
            v2u o; o.x = pk2(y0, y1); o.y = pk2(y2, y3); *(GAS v2u*)(yp + el) = o; }
    __syncthreads();
}
DI void p4_phase(Frame& F) {
    for (int it = (int)blockIdx.x; it < NHEAD * NCHUNK; it += F.G) m3_item(F, it / NCHUNK, it % NCHUNK);
}
DI void p6_phase(Frame& F) {
    LAS float* A1 = (LAS float*)(F.lds); LAS float* B1 = (LAS float*)(F.lds + 8192);
    norm_tables(F, F.norm_ffn_g, MOD_SCF, MOD_SHF);
    __syncthreads();
    const int gw = F.vcu * NWAVES + F.wave, NGW = F.G * NWAVES;
    for (int row = gw; row < M; row += NGW) {
        const GAS f32x4* xr = (const GAS f32x4*)(F.out + (size_t)row * D) + F.lane;
        f32x4 v[8]; float ss = 0.f;
#pragma unroll
        for (int j = 0; j < 8; ++j) { v[j] = xr[64 * j]; ss += (v[j].x * v[j].x + v[j].y * v[j].y) + (v[j].z * v[j].z + v[j].w * v[j].w); }
        const float rstd = 1.0f / sqrtf(wave_sum(ss) * (1.0f / D) + EPS);
        GAS v2u* o8 = (GAS v2u*)(F.HA + (size_t)row * D) + F.lane;
#pragma unroll
        for (int j = 0; j < 8; ++j) {
            const f32x4 a = *(const LAS f32x4*)(A1 + 256 * j + 4 * F.lane), b = *(const LAS f32x4*)(B1 + 256 * j + 4 * F.lane);
            const f32x4 h = v[j] * rstd * a + b;
            v2u o; o.x = pk2(h.x, h.y); o.y = pk2(h.z, h.w); o8[64 * j] = o;
        }
    }
}
constexpr int KPITCH = 272, P8_TBL = 69632;
DI void topk_insert(float (&L)[16], float x) {
#pragma unroll
    for (int i = 15; i >= 1; --i) L[i] = __builtin_amdgcn_fmed3f(x, L[i - 1], L[i]);
    L[0] = fmaxf(L[0], x);
}
DI void p8_phase(Frame& F) {
    LAS unsigned char* KIMG = F.lds; LAS unsigned char* TBL = F.lds + P8_TBL + F.wave * 1024;
    const int lane = F.lane, tid = F.tid, r = lane & 31, h = lane >> 5;
#pragma unroll 4
    for (int i = 0; i < 16; ++i) { const int idx = tid * 4 + 2048 * i, side = idx >> 14, rem = idx & 16383, row = rem >> 7, col = rem & 127;
        const f32x4 a = *(const GAS f32x4*)((side ? F.keys2 : F.keys1) + rem);
        v2u o; o.x = pk2(a.x, a.y); o.y = pk2(a.z, a.w); *(LAS v2u*)(KIMG + (side * 128 + row) * KPITCH + col * 2) = o; }
    __syncthreads();
    for (int it = (int)blockIdx.x; it < (M / 256) * PH; it += F.G) {
        const int tile = it / PH, hd = it % PH;
        const int t = tile * 256 + F.wave * 32 + r;
        float L1[16], L2[16];
#pragma unroll 1
        for (int side = 0; side < 2; ++side) {
            f32x16 acc[4];
#pragma unroll
            for (int kt = 0; kt < 4; ++kt) acc[kt] = zero16();
            const bf16* qp = F.QB + (size_t)t * D + hd * 256 + side * 128 + 8 * h;
#pragma unroll
            for (int ks = 0; ks < 8; ++ks) {
                const bf16x8 qf = *(const GAS bf16x8*)(qp + ks * 16);
#pragma unroll
                for (int kt = 0; kt < 4; ++kt) { const bf16x8 kf = *(const LAS bf16x8*)(KIMG + (side * 128 + kt * 32 + r) * KPITCH + (ks * 16 + 8 * h) * 2); acc[kt] = MFMA32(kf, qf, acc[kt]); }
            }
            float L[16];
#pragma unroll
            for (int i = 0; i < 16; ++i) L[i] = -3.0e38f;
#pragma unroll
            for (int kt = 0; kt < 4; ++kt)
#pragma unroll
                for (int reg = 0; reg < 16; ++reg) { const unsigned key = (unsigned)(kt * 32 + crow(reg, h)); const float sv = acc[kt][reg];
                    topk_insert(L, __uint_as_float((__float_as_uint(sv) & ~127u) | key)); }
            float P[16];
#pragma unroll
            for (int i = 0; i < 16; ++i) P[i] = __shfl_xor(L[i], 32);
#pragma unroll
            for (int i = 0; i < 16; ++i) topk_insert(L, P[i]);
            if (side == 0) {
#pragma unroll
                for (int i = 0; i < 16; ++i) L1[i] = L[i];
            } else {
#pragma unroll
                for (int i = 0; i < 16; ++i) L2[i] = L[i];
            }
        }
        if (h == 0) {
#pragma unroll
            for (int w = 0; w < 4; ++w) {
                const unsigned a = (__builtin_bit_cast(unsigned, L1[4 * w]) & 127u) | ((__builtin_bit_cast(unsigned, L1[4 * w + 1]) & 127u) << 8) | ((__builtin_bit_cast(unsigned, L1[4 * w + 2]) & 127u) << 16) | ((__builtin_bit_cast(unsigned, L1[4 * w + 3]) & 127u) << 24);
                const unsigned b = (__builtin_bit_cast(unsigned, L2[4 * w]) & 127u) | ((__builtin_bit_cast(unsigned, L2[4 * w + 1]) & 127u) << 8) | ((__builtin_bit_cast(unsigned, L2[4 * w + 2]) & 127u) << 16) | ((__builtin_bit_cast(unsigned, L2[4 * w + 3]) & 127u) << 24);
                *(LAS unsigned*)(TBL + r * 32 + 4 * w) = a; *(LAS unsigned*)(TBL + r * 32 + 16 + 4 * w) = b;
            }
        }
        float T[16];
#pragma unroll
        for (int i = 0; i < 16; ++i) T[i] = -3.0e38f;
#pragma unroll
        for (int i = 0; i < 16; ++i) {
            const float v1 = __builtin_bit_cast(float, __builtin_bit_cast(unsigned, L1[i]) & ~127u);
#pragma unroll
            for (int j = 0; j < 16; ++j) if ((i + 1) * (j + 1) <= 16) {
                const float v2 = __builtin_bit_cast(float, __builtin_bit_cast(unsigned, L2[j]) & ~127u);
                topk_insert(T, __builtin_bit_cast(float, (__builtin_bit_cast(unsigned, v1 + v2) & ~255u) | (unsigned)(i * 16 + j)));
            }
        }
        LDS_WAIT(); asm volatile("" ::: "memory");
        float ev[16], esum = 0.f;
        const float mx = __builtin_bit_cast(float, __builtin_bit_cast(unsigned, T[0]) & ~255u);
#pragma unroll
        for (int i = 0; i < 16; ++i) { ev[i] = __expf(__builtin_bit_cast(float, __builtin_bit_cast(unsigned, T[i]) & ~255u) - mx); esum += ev[i]; }
        const float einv = 1.0f / esum;
        int eid[8]; float gt[8];
#pragma unroll
        for (int i = 0; i < 8; ++i) { const float tv = h ? T[8 + i] : T[i]; const float e = h ? ev[8 + i] : ev[i];
            const unsigned p = __builtin_bit_cast(unsigned, tv) & 255u;
            const unsigned i1 = *(const LAS unsigned char*)(TBL + r * 32 + (p >> 4)), i2 = *(const LAS unsigned char*)(TBL + r * 32 + 16 + (p & 15u));
            eid[i] = (int)(i1 * 128u + i2); gt[i] = e * einv; }
        int* ip = F.IDX + (size_t)t * NSEL + hd * 16 + 8 * h; float* gp = F.PG + (size_t)t * NSEL + hd * 16 + 8 * h;
        *(GAS v4u*)ip = (v4u){(unsigned)eid[0], (unsigned)eid[1], (unsigned)eid[2], (unsigned)eid[3]}; *(GAS v4u*)(ip + 4) = (v4u){(unsigned)eid[4], (unsigned)eid[5], (unsigned)eid[6], (unsigned)eid[7]};
        *(GAS f32x4*)gp = (f32x4){gt[0], gt[1], gt[2], gt[3]}; *(GAS f32x4*)(gp + 4) = (f32x4){gt[4], gt[5], gt[6], gt[7]};
        LDS_WAIT(); asm volatile("" ::: "memory");
    }
}

DI void p8_alt_phase(Frame& F) {
    const int lane = F.lane;
    const int gw = F.vcu * NWAVES + F.wave, NGW = F.G * NWAVES;
    for (int it = gw; it < (M / 64) * PH; it += NGW) {
        const int tg = it / PH, hd = it % PH, t = tg * 64 + lane;
        float L1[16], L2[16];
#pragma unroll 1
        for (int side = 0; side < 2; ++side) {
            unsigned qw[64];
            const bf16* qp = F.QB + (size_t)t * D + hd * 256 + side * 128;
#pragma unroll
            for (int i = 0; i < 16; ++i) { const v4u w = *(const GAS v4u*)(qp + 8 * i); qw[4 * i] = w.x; qw[4 * i + 1] = w.y; qw[4 * i + 2] = w.z; qw[4 * i + 3] = w.w; }
            float L[16];
#pragma unroll
            for (int i = 0; i < 16; ++i) L[i] = -3.0e38f;
            const float* kb = side ? F.keys2 : F.keys1;
#pragma unroll 1
            for (int key = 0; key < 128; ++key) {
                const float* kr = kb + key * 128; float s = 0.f;
#pragma unroll
                for (int i = 0; i < 64; ++i) s += bflo(qw[i]) * kr[2 * i] + bfhi(qw[i]) * kr[2 * i + 1];
                topk_insert(L, __builtin_bit_cast(float, (__builtin_bit_cast(unsigned, s) & ~127u) | (unsigned)key));
            }
            if (side == 0) {
#pragma unroll
                for (int i = 0; i < 16; ++i) L1[i] = L[i];
            } else {
#pragma unroll
                for (int i = 0; i < 16; ++i) L2[i] = L[i];
            }
        }
        float T[16]; int E[16];
#pragma unroll
        for (int i = 0; i < 16; ++i) { T[i] = -3.0e38f; }
#pragma unroll
        for (int i = 0; i < 16; ++i) {
            const float v1 = __builtin_bit_cast(float, __builtin_bit_cast(unsigned, L1[i]) & ~127u);
#pragma unroll
            for (int j = 0; j < 16; ++j) if ((i + 1) * (j + 1) <= 16) {
                const float v2 = __builtin_bit_cast(float, __builtin_bit_cast(unsigned, L2[j]) & ~127u);
                topk_insert(T, __builtin_bit_cast(float, (__builtin_bit_cast(unsigned, v1 + v2) & ~255u) | (unsigned)(i * 16 + j)));
            }
        }
        float esum = 0.f; float ev[16];
        const float mx = __builtin_bit_cast(float, __builtin_bit_cast(unsigned, T[0]) & ~255u);
#pragma unroll
        for (int i = 0; i < 16; ++i) { ev[i] = __expf(__builtin_bit_cast(float, __builtin_bit_cast(unsigned, T[i]) & ~255u) - mx); esum += ev[i]; }
        const float einv = 1.0f / esum;
#pragma unroll
        for (int i = 0; i < 16; ++i) { const unsigned p = __builtin_bit_cast(unsigned, T[i]) & 255u; unsigned i1 = 0, i2 = 0;
#pragma unroll
            for (int q = 0; q < 16; ++q) { if ((p >> 4) == (unsigned)q) i1 = __builtin_bit_cast(unsigned, L1[q]) & 127u; if ((p & 15u) == (unsigned)q) i2 = __builtin_bit_cast(unsigned, L2[q]) & 127u; }
            E[i] = (int)(i1 * 128u + i2); }
        int* ip = F.IDX + (size_t)t * NSEL + hd * 16; float* gp = F.PG + (size_t)t * NSEL + hd * 16;
#pragma unroll
        for (int i = 0; i < 16; ++i) { ip[i] = E[i]; gp[i] = ev[i] * einv; }
    }
}
template <int STEP> DI void xpose_step(float (&v)[64], int lane) {
#pragma unroll
    for (int i = 0; i < STEP; ++i) { const bool up = (lane & STEP) != 0; const float keep = up ? v[i + STEP] : v[i], send = up ? v[i] : v[i + STEP]; v[i] = keep + __shfl_xor(send, STEP); }
}
DI void p9_phase(Frame& F) {
    LAS float* A2 = (LAS float*)(F.lds); LAS float* B2 = (LAS float*)(F.lds + 8192); LAS float* GF = (LAS float*)(F.lds + 16384); LAS float* FG = (LAS float*)(F.lds + 24576);
    norm_tables(F, F.norm_ffn_g, MOD_SCF, MOD_SHF);
#pragma unroll
    for (int i = 0; i < 4; ++i) { const int c = F.tid + 512 * i; GF[c] = F.MODF[MOD_GF + c]; FG[c] = F.final_g[c]; }
    __syncthreads();
    const int lane = F.lane, gw = F.vcu * NWAVES + F.wave, NGW = F.G * NWAVES;
#pragma unroll 1
    for (int t = gw; t < M; t += NGW) {
        unsigned hb[16];
        {
            float x1[32]; float ss = 0.f;
            const float* xr = F.out + (size_t)t * D + 8 * lane;
#pragma unroll
            for (int jj = 0; jj < 4; ++jj) { const f32x4 a = *(const GAS f32x4*)(xr + 512 * jj), b = *(const GAS f32x4*)(xr + 512 * jj + 4);
                x1[8 * jj] = a.x; x1[8 * jj + 1] = a.y; x1[8 * jj + 2] = a.z; x1[8 * jj + 3] = a.w; x1[8 * jj + 4] = b.x; x1[8 * jj + 5] = b.y; x1[8 * jj + 6] = b.z; x1[8 * jj + 7] = b.w; }
#pragma unroll
            for (int i = 0; i < 32; ++i) ss += x1[i] * x1[i];
            const float rstd = 1.0f / sqrtf(wave_sum(ss) * (1.0f / D) + EPS);
#pragma unroll
            for (int jj = 0; jj < 4; ++jj) { const f32x4 a0 = *(const LAS f32x4*)(A2 + 512 * jj + 8 * lane), a1 = *(const LAS f32x4*)(A2 + 512 * jj + 8 * lane + 4);
                const f32x4 b0 = *(const LAS f32x4*)(B2 + 512 * jj + 8 * lane), b1 = *(const LAS f32x4*)(B2 + 512 * jj + 8 * lane + 4);
                hb[4 * jj] = pk2(x1[8 * jj] * rstd * a0.x + b0.x, x1[8 * jj + 1] * rstd * a0.y + b0.y); hb[4 * jj + 1] = pk2(x1[8 * jj + 2] * rstd * a0.z + b0.z, x1[8 * jj + 3] * rstd * a0.w + b0.w);
                hb[4 * jj + 2] = pk2(x1[8 * jj + 4] * rstd * a1.x + b1.x, x1[8 * jj + 5] * rstd * a1.y + b1.y); hb[4 * jj + 3] = pk2(x1[8 * jj + 6] * rstd * a1.z + b1.z, x1[8 * jj + 7] * rstd * a1.w + b1.w); }
        }
        float out[32];
#pragma unroll
        for (int i = 0; i < 32; ++i) out[i] = 0.f;
#pragma unroll 1
        for (int b = 0; b < 2; ++b) {
            const int myidx = F.IDX[(size_t)t * NSEL + 64 * b + lane]; const float mygate = F.PG[(size_t)t * NSEL + 64 * b + lane];
            float p[64];
#pragma unroll
            for (int k = 0; k < 64; ++k) {
                const int e = __builtin_amdgcn_readlane(myidx, k);
                const bf16* rowp = F.ED + (size_t)e * D + 8 * lane;
                float s0 = 0.f, s1 = 0.f;
#pragma unroll
                for (int jj = 0; jj < 4; ++jj) { const v4u w = *(const GAS v4u*)(rowp + 512 * jj);
                    s0 = DOT2(hb[4 * jj], w.x, s0); s1 = DOT2(hb[4 * jj + 1], w.y, s1); s0 = DOT2(hb[4 * jj + 2], w.z, s0); s1 = DOT2(hb[4 * jj + 3], w.w, s1); }
                p[k] = s0 + s1;
                if ((k & 7) == 7) asm volatile("" ::: "memory");
            }
            xpose_step<32>(p, lane); xpose_step<16>(p, lane); xpose_step<8>(p, lane); xpose_step<4>(p, lane); xpose_step<2>(p, lane); xpose_step<1>(p, lane);
            const float coef = mygate * gelu_f(p[0]);
#pragma unroll 4
            for (int k = 0; k < 64; ++k) {
                const int e = __builtin_amdgcn_readlane(myidx, k); const float c = __builtin_bit_cast(float, __builtin_amdgcn_readlane(__builtin_bit_cast(int, coef), k));
                const bf16* rowp = F.EU + (size_t)e * D + 8 * lane;
#pragma unroll
                for (int jj = 0; jj < 4; ++jj) { const v4u w = *(const GAS v4u*)(rowp + 512 * jj);
                    out[8 * jj] += c * bflo(w.x); out[8 * jj + 1] += c * bfhi(w.x); out[8 * jj + 2] += c * bflo(w.y); out[8 * jj + 3] += c * bfhi(w.y);
                    out[8 * jj + 4] += c * bflo(w.z); out[8 * jj + 5] += c * bfhi(w.z); out[8 * jj + 6] += c * bflo(w.w); out[8 * jj + 7] += c * bfhi(w.w); }
            }
        }
        float s2 = 0.f;
        float* orow = F.out + (size_t)t * D + 8 * lane;
#pragma unroll
        for (int jj = 0; jj < 4; ++jj) { const f32x4 g0 = *(const LAS f32x4*)(GF + 512 * jj + 8 * lane), g1 = *(const LAS f32x4*)(GF + 512 * jj + 8 * lane + 4);
            const f32x4 xa = *(const GAS f32x4*)(orow + 512 * jj), xb = *(const GAS f32x4*)(orow + 512 * jj + 4);
            out[8 * jj] = xa.x + g0.x * out[8 * jj]; out[8 * jj + 1] = xa.y + g0.y * out[8 * jj + 1]; out[8 * jj + 2] = xa.z + g0.z * out[8 * jj + 2]; out[8 * jj + 3] = xa.w + g0.w * out[8 * jj + 3];
            out[8 * jj + 4] = xb.x + g1.x * out[8 * jj + 4]; out[8 * jj + 5] = xb.y + g1.y * out[8 * jj + 5]; out[8 * jj + 6] = xb.z + g1.z * out[8 * jj + 6]; out[8 * jj + 7] = xb.w + g1.w * out[8 * jj + 7]; }
#pragma unroll
        for (int i = 0; i < 32; ++i) s2 += out[i] * out[i];
        const float rstd2 = 1.0f / sqrtf(wave_sum(s2) * (1.0f / D) + EPS);
#pragma unroll
        for (int jj = 0; jj < 4; ++jj) { const f32x4 f0 = *(const LAS f32x4*)(FG + 512 * jj + 8 * lane), f1 = *(const LAS f32x4*)(FG + 512 * jj + 8 * lane + 4);
            *(GAS f32x4*)(orow + 512 * jj) = (f32x4){out[8 * jj] * rstd2 * f0.x, out[8 * jj + 1] * rstd2 * f0.y, out[8 * jj + 2] * rstd2 * f0.z, out[8 * jj + 3] * rstd2 * f0.w};
            *(GAS f32x4*)(orow + 512 * jj + 4) = (f32x4){out[8 * jj + 4] * rstd2 * f1.x, out[8 * jj + 5] * rstd2 * f1.y, out[8 * jj + 6] * rstd2 * f1.z, out[8 * jj + 7] * rstd2 * f1.w}; }
    }
}
struct Args { const float* in[21]; float* out; unsigned char* ws; int ph_lo, ph_hi, li, pad; };
constexpr int N_PHASES = 11;
__global__ void __launch_bounds__(NWAVES * 64, 2) mk_fwd(Args args) {
    extern __shared__ __attribute__((aligned(16))) unsigned char lds[];
    Frame F;
    F.lds = (LAS unsigned char*)lds;
    F.MISC = (volatile LAS unsigned*)(F.lds + MISC_OFF);
    F.tid = threadIdx.x; F.lane = F.tid & 63; F.wave = __builtin_amdgcn_readfirstlane(F.tid >> 6);
    F.G = gridDim.x; { const int bx = blockIdx.x; F.vcu = (F.G % 8 == 0) ? (bx % 8) * (F.G / 8) + bx / 8 : bx; }
    unsigned char* ws = args.ws;
    F.ctl = (gu32*)(ws + WS_CTL);
    F.x = args.in[0]; F.c = args.in[1]; F.ada_w = args.in[2]; F.ada_b = args.in[3]; F.norm_mix_g = args.in[4]; F.w_in = args.in[5]; F.b_gates = args.in[6];
    F.conv_w = args.in[7]; F.conv_b = args.in[8]; F.gmlp_norm_g = args.in[9]; F.gmlp_w = args.in[10]; F.gmlp_b = args.in[11]; F.mlstm_norm_g = args.in[12];
    F.w_out = args.in[13]; F.norm_ffn_g = args.in[14]; F.wq = args.in[15]; F.keys1 = args.in[16]; F.keys2 = args.in[17]; F.e_down = args.in[18]; F.e_up = args.in[19]; F.final_g = args.in[20];
    F.out = args.out;
    F.MODP = (float*)(ws + WS_MODP); F.MODF = (float*)(ws + WS_MODF); F.GATES = (float*)(ws + WS_GATES); F.SUMM = (float*)(ws + WS_SUMM); F.MTAB = (float*)(ws + WS_MTAB);
    F.NST = (float*)(ws + WS_NST); F.PG = (float*)(ws + WS_PG); F.IDX = (int*)(ws + WS_IDX);
    F.WIN = (bf16*)(ws + WS_WIN); F.WOUT = (bf16*)(ws + WS_WOUT); F.WQ = (bf16*)(ws + WS_WQ); F.HA = (bf16*)(ws + WS_HA); F.PROJ = (bf16*)(ws + WS_PROJ); F.QB = (bf16*)(ws + WS_PROJ);
    F.STATE = (bf16*)(ws + WS_STATE); F.ED = (bf16*)(ws + WS_ED); F.EU = (bf16*)(ws + WS_EU);
    F.QC = (bf16*)args.out; F.KC = (bf16*)args.out + (size_t)M * 1024;
    for (int u = F.tid; u < (LDS_BYTES - LDSCTL_OFF) / 4; u += NWAVES * 64) ((LAS unsigned*)(F.lds + LDSCTL_OFF))[u] = 0u;
    __syncthreads();
    const int lo = args.ph_lo, hi = args.ph_hi;
    const bool multi = (hi - lo) > 1;
    XcdBarrier bar; bar.bar = (unsigned*)(F.ctl + CW_BAR) + args.li * XCD_BAR_WORDS; bar.x = 0; bar.st = nullptr;
    if (multi) bar = xcd_barrier_post((unsigned*)(F.ctl + CW_BAR) + args.li * XCD_BAR_WORDS, F.MISC + 8);
#ifndef PH_MASK
#define PH_MASK 0x7ff
#endif
#define IN(k) (((PH_MASK >> (k)) & 1) && lo <= (k) && (k) < hi)
#define SEAM(k) do { if (IN(k) && IN((k) + 1)) xcd_barrier(bar); } while (0)
    if (IN(0)) { p0a_phase(F); } SEAM(0);
    if (IN(1)) { p0b_phase(F); } SEAM(1);
    if (IN(2)) {
        pg8::Gemm g{F.HA, F.WIN, M, NPROJ, D}; pg8::StaticOrder S; S.init(M, NPROJ, F.G, (int)blockIdx.x);
        pg8::EpiProj E{F.PROJ, NPROJ, 2048 / 256};
        pg8::gemm_phase<pg8::EpiProj, pg8::StaticOrder, PG8_ALIGN, PG8_SP2>(F.lds, g, S, E);
    } SEAM(2);
    if (IN(3)) { p2_phase(F); } SEAM(3);
    if (IN(4)) { p3_phase(F); } SEAM(4);
    if (IN(5)) { p4_phase(F); } SEAM(5);
    if (IN(6)) {
        pg8::Gemm g{F.HA, F.WOUT, M, D, D}; pg8::StaticOrder S; S.init(M, D, F.G, (int)blockIdx.x);
        pg8::EpiResid E{F.x, F.MODF + MOD_GM, F.out, D};
        pg8::gemm_phase<pg8::EpiResid, pg8::StaticOrder, PG8_ALIGN, PG8_SP2>(F.lds, g, S, E);
    } SEAM(6);
    if (IN(7)) { p6_phase(F); } SEAM(7);
    if (IN(8)) {
        pg8::Gemm g{F.HA, F.WQ, M, D, D}; pg8::StaticOrder S; S.init(M, D, F.G, (int)blockIdx.x);
        pg8::EpiBf16<0> E{F.QB, D, nullptr, 0, 0, 1.f};
        pg8::gemm_phase<pg8::EpiBf16<0>, pg8::StaticOrder, PG8_ALIGN, PG8_SP2>(F.lds, g, S, E);
    } SEAM(8);
    #ifndef P8_ALT
#define P8_ALT 0
#endif
    if (IN(9)) { if (P8_ALT) p8_alt_phase(F); else p8_phase(F); } SEAM(9);
    if (IN(10)) { p9_phase(F); }
#undef IN
#undef SEAM
}

#ifndef MK_N_LAUNCHES
#define MK_N_LAUNCHES 11
#endif
extern "C" void kernel_launch(void* const* d_in, const int* in_sizes, int n_in, void* d_out, int out_size, void* d_ws, size_t ws_size, hipStream_t stream) {
    static int grid = 0;
    if (grid == 0) {
        if (n_in != 21 || in_sizes[0] != M * D || out_size != M * D || ws_size < WS_END) { fprintf(stderr, "kernel_launch: unexpected shapes (n_in %d, in0 %d, out %d, ws %zu); nothing launched\n", n_in, n_in > 0 ? in_sizes[0] : -1, out_size, ws_size); grid = -1; return; }
        int dev = 0, cus = 0, per_cu = 0;
        if (hipGetDevice(&dev) != hipSuccess || hipDeviceGetAttribute(&cus, hipDeviceAttributeMultiprocessorCount, dev) != hipSuccess) { grid = -1; return; }
        if (hipFuncSetAttribute((const void*)mk_fwd, hipFuncAttributeMaxDynamicSharedMemorySize, LDS_BYTES) != hipSuccess) { fprintf(stderr, "kernel_launch: hipFuncSetAttribute failed\n"); grid = -1; return; }
        if (hipOccupancyMaxActiveBlocksPerMultiprocessor(&per_cu, (const void*)mk_fwd, NWAVES * 64, LDS_BYTES) != hipSuccess || per_cu < 1) { fprintf(stderr, "kernel_launch: occupancy query says %d blocks per CU\n", per_cu); }
        (void)hipGetLastError();
        grid = cus;
    }
    if (grid < 0) return;
    (void)hipMemsetAsync((char*)d_ws + WS_CTL, 0, CTL_ZERO_BYTES, stream);
    Args a{};
    for (int i = 0; i < 21; ++i) a.in[i] = (const float*)d_in[i];
    a.out = (float*)d_out; a.ws = (unsigned char*)d_ws;
    if (MK_N_LAUNCHES == 1) { a.ph_lo = 0; a.ph_hi = N_PHASES; a.li = 0; hipLaunchKernelGGL(mk_fwd, dim3(grid), dim3(NWAVES * 64), LDS_BYTES, stream, a); }
    else for (int li = 0; li < N_PHASES; ++li) { a.ph_lo = li; a.ph_hi = li + 1; a.li = 0; hipLaunchKernelGGL(mk_fwd, dim3(grid), dim3(NWAVES * 64), LDS_BYTES, stream, a); }
}
```

```cpp
#include <hip/hip_runtime.h>
#include <cstdio>
#include <cstdint>
namespace pg8 {
#define PG8_LAS __attribute__((address_space(3)))
typedef unsigned short bf16_t;
typedef short bf16x8 __attribute__((ext_vector_type(8)));
typedef float f32x4 __attribute__((ext_vector_type(4)));
typedef unsigned u32x4 __attribute__((ext_vector_type(4)));
constexpr int BM = 256, BK = 64, HALF = 128, HTB = HALF * BK * 2  , STAGE_BYTES = 8 * HTB, NXCD = 8, WGM = 8;

__host__ __device__ __forceinline__ int lds_byte(int r, int c) { const int st = (r >> 4) * 2 + (c >> 5), rr = r & 15, cc = c & 31, ob = rr * 64 + cc * 2; return st * 1024 + (ob ^ (((ob >> 9) & 1) << 5)); }
__host__ __device__ __forceinline__ void stage_rc(int b, int& R, int& C) { const int st = b / 1024, sb = b % 1024, swz = sb ^ (((sb >> 9) & 1) << 5); R = (st >> 1) * 16 + swz / 64; C = (st & 1) * 32 + (swz % 64) / 2; }
__host__ __device__ __forceinline__ int perm32(int rho) { const int n = rho >> 4, i = rho & 15; return 8 * (i >> 2) + 4 * n + (i & 3); }

struct Unit { int pm, pn; };
struct Gemm { const bf16_t* A; const bf16_t* Bt; int M, N, K; };

struct StaticOrder {
    int nM, nN, nwg, G, c;
    __host__ __device__ void init(int M, int N, int G_, int c_) { nM = M / BM; nN = N / BM; nwg = nM * nN; G = G_; c = c_; }
    __host__ __device__ bool next(int i, Unit& u) const {
        const long L = (long)i * G + c; if (L >= nwg) return false;
        int wgid = (int)L; { const int q = nwg / NXCD, r = nwg % NXCD, xcd = wgid % NXCD, off = wgid / NXCD; wgid = (xcd < r ? xcd * (q + 1) : r * (q + 1) + (xcd - r) * q) + off; }
        const int nig = WGM * nN, gid = wgid / nig, fm = gid * WGM, gsz = (nM - fm) < WGM ? (nM - fm) : WGM;
        u.pm = fm + ((wgid % nig) % gsz); u.pn = (wgid % nig) / gsz; return true;
    }
    __device__ __forceinline__ void a_ready(const Unit&) const {}
    __device__ __forceinline__ void done(const Unit&) const {}
};

__device__ __forceinline__ unsigned cvt_pk_bf16(float lo, float hi) { unsigned r; asm volatile("v_cvt_pk_bf16_f32 %0, %1, %2" : "=v"(r) : "v"(lo), "v"(hi)); return r; }
typedef float f32x2 __attribute__((ext_vector_type(2)));
__device__ __forceinline__ f32x2 gelu_pk(f32x2 v) {
    const f32x2 av = __builtin_elementwise_abs(v), d = av * 0.2316418882f + 1.0f;
    f32x2 t; t.x = __builtin_amdgcn_rcpf(d.x); t.y = __builtin_amdgcn_rcpf(d.y);
    f32x2 q = t * 0.5307027145f + (-0.7265760135f); q = q * t + 0.7107068705f; q = q * t + (-0.142248368f); q = q * t + 0.127414796f; q = q * t;
    const f32x2 s = (v * v) * (-0.72134752044f);
    f32x2 e; e.x = __builtin_amdgcn_exp2f(s.x); e.y = __builtin_amdgcn_exp2f(s.y);
    const f32x2 m = v * (q * e), r = v - m;
    f32x2 o; o.x = v.x < 0.f ? m.x : r.x; o.y = v.y < 0.f ? m.y : r.y; return o;
}

template <int ACT  > struct EpiBf16 {
    static constexpr bool PERM = true, AFTER_DRAIN = false; static_assert(ACT == 0 || ACT == 1, "EpiBf16: ACT is 0 (none) or 1 (gelu_pk)");
    bf16_t* O; int ldc; const float* bias; int split_cols; size_t split_stride; float scale0;
    __device__ __forceinline__ void operator()(const f32x4 (&acc)[2][2][4][2], const Unit& u, int wr, int wc, int fr, int fq) const {
        const int row0 = u.pm * BM + wr * 64 + fr; int colt = u.pn * BM; bf16_t* base = O;
        float sc = 1.f; if (split_cols) { const int t = colt / split_cols; base += (size_t)t * split_stride; colt -= t * split_cols; if (t == 0) sc = scale0; }
        const int col0 = colt + wc * 32 + 8 * fq, bcol0 = u.pn * BM + wc * 32 + 8 * fq;
        f32x4 bv[2][2];
#pragma unroll
        for (int bj = 0; bj < 2; ++bj)
#pragma unroll
            for (int n = 0; n < 2; ++n) bv[bj][n] = bias ? *(const f32x4*)(bias + bcol0 + bj * HALF + 4 * n) : (f32x4){0.f, 0.f, 0.f, 0.f};
#pragma unroll
        for (int ai = 0; ai < 2; ++ai)
#pragma unroll
            for (int m = 0; m < 4; ++m) { bf16_t* rowp = base + (size_t)(row0 + ai * HALF + m * 16) * ldc + col0;
#pragma unroll
                for (int bj = 0; bj < 2; ++bj) { f32x4 v0 = acc[ai][bj][m][0] + bv[bj][0], v1 = acc[ai][bj][m][1] + bv[bj][1];
                    if (ACT == 1) { f32x2 a = gelu_pk((f32x2){v0[0], v0[1]}), b = gelu_pk((f32x2){v0[2], v0[3]}), c = gelu_pk((f32x2){v1[0], v1[1]}), d = gelu_pk((f32x2){v1[2], v1[3]});
                        v0 = (f32x4){a.x, a.y, b.x, b.y}; v1 = (f32x4){c.x, c.y, d.x, d.y}; }
                    v0 = v0 * sc; v1 = v1 * sc; u32x4 w; w.x = cvt_pk_bf16(v0[0], v0[1]); w.y = cvt_pk_bf16(v0[2], v0[3]); w.z = cvt_pk_bf16(v1[0], v1[1]); w.w = cvt_pk_bf16(v1[2], v1[3]);
                    *(u32x4*)(rowp + bj * HALF) = w; } }
    }
};

template <class Epi, class Sched, bool ALIGN_EPI = false, bool SP2 = false>
__device__ __forceinline__ void gemm_phase(PG8_LAS unsigned char* lds, const Gemm g, const Sched& S, const Epi& E) {
    const int tid = threadIdx.x, wid = __builtin_amdgcn_readfirstlane(tid >> 6), lane = tid & 63, wr = wid >> 2, wc = wid & 3, fr = lane & 15, fq = lane >> 4;
    const int K = g.K, nt = K / BK;
    unsigned voffA[2], voffB[2];
#pragma unroll
    for (int i = 0; i < 2; ++i) { int R, C; stage_rc(tid * 16 + i * 8192, R, C); const int Rb = Epi::PERM ? ((R & ~31) + perm32(R & 31)) : R;
        voffA[i] = (unsigned)(R * K + C) * 2u; voffB[i] = (unsigned)(Rb * K + C) * 2u; }
    const size_t kstep = (size_t)(BK * 2);
    const size_t hstep = (size_t)HALF * K * 2;
    const size_t tstep = 2 * hstep;
    const unsigned ldsw = (unsigned)wid * 1024u;
    const int aoff = lds_byte(wr * 64 + fr, fq * 8), boff = lds_byte(wc * 32 + fr, fq * 8);
#define PG8_SA(b, h) (((b) * 2 + (h)) * HTB)
#define PG8_SB(b, h) ((4 + (b) * 2 + (h)) * HTB)
#define PG8_STAGE(bufoff, gbase, voff) do { _Pragma("unroll") for (int _i = 0; _i < 2; ++_i) \
        __builtin_amdgcn_global_load_lds((const unsigned*)((const char*)(gbase) + (voff)[_i]), (PG8_LAS unsigned*)(lds + (bufoff) + ldsw + _i * 8192), 16, 0, 0); } while (0)
#define PG8_LDA(dst, b, h) do { _Pragma("unroll") for (int m = 0; m < 4; ++m) _Pragma("unroll") for (int k = 0; k < 2; ++k) dst[m][k] = *(const PG8_LAS bf16x8*)(lds + PG8_SA(b, h) + aoff + m * 2048 + k * 1024); } while (0)
#define PG8_LDB(dst, b, h) do { _Pragma("unroll") for (int n = 0; n < 2; ++n) _Pragma("unroll") for (int k = 0; k < 2; ++k) dst[n][k] = *(const PG8_LAS bf16x8*)(lds + PG8_SB(b, h) + boff + n * 2048 + k * 1024); } while (0)
#define PG8_MMA(ai, bj, At, Bt) do { __builtin_amdgcn_s_setprio(1); _Pragma("unroll") for (int m = 0; m < 4; ++m) _Pragma("unroll") for (int n = 0; n < 2; ++n) _Pragma("unroll") for (int k = 0; k < 2; ++k) \
        acc[ai][bj][m][n] = __builtin_amdgcn_mfma_f32_16x16x32_bf16(Bt[n][k], At[m][k], acc[ai][bj][m][n], 0, 0, 0); __builtin_amdgcn_s_setprio(0); } while (0)
#define PG8_WAIT_V(n) asm volatile("s_waitcnt vmcnt(" #n ")" ::: "memory")
#define PG8_WAIT_L(n) asm volatile("s_waitcnt lgkmcnt(" #n ")" ::: "memory")
#define PG8_BAR __builtin_amdgcn_s_barrier()
#define PG8_SCHED __builtin_amdgcn_sched_barrier(0)
    Unit cur, nxt; int ui = 0;
    if (!S.next(0, cur)) return;
    f32x4 acc[2][2][4][2];
#pragma unroll
    for (int a = 0; a < 2; ++a)
#pragma unroll
        for (int b = 0; b < 2; ++b)
#pragma unroll
            for (int m = 0; m < 4; ++m)
#pragma unroll
                for (int n = 0; n < 2; ++n) acc[a][b][m][n] = (f32x4){0.f, 0.f, 0.f, 0.f};
    bf16x8 At[4][2], B0[2][2], B1[2][2];
    const char* cA = (const char*)g.A + (size_t)cur.pm * tstep; const char* cB = (const char*)g.Bt + (size_t)cur.pn * tstep;
    S.a_ready(cur);
    if constexpr (SP2) {
        PG8_STAGE(PG8_SB(0, 0), cB, voffB); PG8_STAGE(PG8_SB(0, 1), cB + hstep, voffB); PG8_STAGE(PG8_SA(0, 0), cA, voffA); PG8_STAGE(PG8_SA(0, 1), cA + hstep, voffA);
        if (wr == 1) PG8_BAR;
        PG8_WAIT_V(2); PG8_BAR;
        PG8_STAGE(PG8_SB(1, 0), cB + kstep, voffB); PG8_STAGE(PG8_SA(1, 0), cA + kstep, voffA); PG8_STAGE(PG8_SB(1, 1), cB + hstep + kstep, voffB);
        PG8_WAIT_V(6); PG8_BAR;
    } else {
        PG8_STAGE(PG8_SB(0, 0), cB, voffB); PG8_STAGE(PG8_SA(0, 0), cA, voffA); PG8_STAGE(PG8_SB(0, 1), cB + hstep, voffB); PG8_STAGE(PG8_SA(0, 1), cA + hstep, voffA);
        if (wr == 1) PG8_BAR;
        PG8_WAIT_V(4); PG8_BAR;
        PG8_STAGE(PG8_SB(1, 0), cB + kstep, voffB); PG8_STAGE(PG8_SA(1, 0), cA + kstep, voffA); PG8_STAGE(PG8_SB(1, 1), cB + hstep + kstep, voffB);
        PG8_WAIT_V(6); PG8_BAR;
    }
    for (;;) {
        const bool has_next = S.next(ui + 1, nxt);
        const char* nA = has_next ? (const char*)g.A + (size_t)nxt.pm * tstep : cA; const char* nB = has_next ? (const char*)g.Bt + (size_t)nxt.pn * tstep : cB;
        for (int t = 0; t < nt; t += 2) {
            const bool last = (t == nt - 2);
            const char* a1 = cA + (size_t)(t + 1) * kstep;
            const char* a2 = last ? nA : cA + (size_t)(t + 2) * kstep; const char* b2 = last ? nB : cB + (size_t)(t + 2) * kstep;
            const char* a3 = a2 + kstep; const char* b3 = b2 + kstep;
            if (last && has_next) S.a_ready(nxt);
            if constexpr (SP2) {
            PG8_LDB(B0, 0, 0); PG8_LDB(B1, 0, 1); PG8_SCHED; PG8_LDA(At, 0, 0); PG8_STAGE(PG8_SA(1, 1), a1 + hstep, voffA);
            PG8_WAIT_V(8); PG8_WAIT_L(0); PG8_BAR; PG8_MMA(0, 0, At, B0); PG8_MMA(0, 1, At, B1); PG8_BAR; PG8_SCHED;
            PG8_LDA(At, 0, 1); PG8_STAGE(PG8_SB(0, 0), b2, voffB); PG8_STAGE(PG8_SB(0, 1), b2 + hstep, voffB); PG8_STAGE(PG8_SA(0, 0), a2, voffA);
            PG8_WAIT_V(8); PG8_WAIT_L(0); PG8_BAR; PG8_MMA(1, 0, At, B0); PG8_MMA(1, 1, At, B1); PG8_BAR; PG8_SCHED;
            PG8_LDB(B0, 1, 0); PG8_LDB(B1, 1, 1); PG8_SCHED; PG8_LDA(At, 1, 0); PG8_STAGE(PG8_SA(0, 1), a2 + hstep, voffA);
            PG8_WAIT_V(8); PG8_WAIT_L(0); PG8_BAR; PG8_MMA(0, 0, At, B0); PG8_MMA(0, 1, At, B1); PG8_BAR; PG8_SCHED;
            PG8_LDA(At, 1, 1); PG8_STAGE(PG8_SB(1, 0), b3, voffB); PG8_STAGE(PG8_SB(1, 1), b3 + hstep, voffB); PG8_STAGE(PG8_SA(1, 0), a3, voffA);
            PG8_WAIT_V(8); PG8_WAIT_L(0); PG8_BAR; PG8_MMA(1, 0, At, B0); PG8_MMA(1, 1, At, B1); PG8_BAR; PG8_SCHED;
            } else {
            PG8_LDB(B0, 0, 0); PG8_SCHED; PG8_LDA(At, 0, 0); PG8_STAGE(PG8_SA(1, 1), a1 + hstep, voffA);
            PG8_WAIT_L(8); PG8_BAR; PG8_WAIT_L(0); PG8_MMA(0, 0, At, B0); PG8_BAR; PG8_SCHED;
            PG8_LDB(B1, 0, 1); PG8_STAGE(PG8_SB(0, 0), b2, voffB);
            PG8_BAR; PG8_WAIT_L(0); PG8_MMA(0, 1, At, B1); PG8_BAR;
            PG8_LDA(At, 0, 1); PG8_STAGE(PG8_SA(0, 0), a2, voffA);
            PG8_BAR; PG8_WAIT_L(0); PG8_MMA(1, 0, At, B0); PG8_BAR; PG8_SCHED;
            PG8_STAGE(PG8_SB(0, 1), b2 + hstep, voffB);
            PG8_WAIT_V(6); PG8_BAR; PG8_MMA(1, 1, At, B1); PG8_BAR;
            PG8_LDB(B0, 1, 0); PG8_SCHED; PG8_LDA(At, 1, 0); PG8_STAGE(PG8_SA(0, 1), a2 + hstep, voffA);
            PG8_WAIT_L(8); PG8_BAR; PG8_WAIT_L(0); PG8_MMA(0, 0, At, B0); PG8_BAR; PG8_SCHED;
            PG8_LDB(B1, 1, 1); PG8_STAGE(PG8_SB(1, 0), b3, voffB);
            PG8_BAR; PG8_WAIT_L(0); PG8_MMA(0, 1, At, B1); PG8_BAR;
            PG8_LDA(At, 1, 1); PG8_STAGE(PG8_SA(1, 0), a3, voffA);
            PG8_BAR; PG8_WAIT_L(0); PG8_MMA(1, 0, At, B0); PG8_BAR; PG8_SCHED;
            PG8_STAGE(PG8_SB(1, 1), b3 + hstep, voffB);
            PG8_WAIT_V(6); PG8_BAR; PG8_MMA(1, 1, At, B1); PG8_BAR;
            }
        }
        if constexpr (ALIGN_EPI) { if (wr == 0) PG8_BAR; }
        if constexpr (!Epi::AFTER_DRAIN) { E(acc, cur, wr, wc, fr, fq); S.done(cur); }
        if (!has_next) break;
#pragma unroll
        for (int a = 0; a < 2; ++a)
#pragma unroll
            for (int b = 0; b < 2; ++b)
#pragma unroll
                for (int m = 0; m < 4; ++m)
#pragma unroll
                    for (int n = 0; n < 2; ++n) acc[a][b][m][n] = (f32x4){0.f, 0.f, 0.f, 0.f};
        cur = nxt; cA = nA; cB = nB; ++ui;
        if constexpr (ALIGN_EPI) { if (wr == 1) PG8_BAR; }
    }
    PG8_WAIT_V(0);
    if constexpr (!ALIGN_EPI) { if (wr == 0) PG8_BAR; }
    PG8_BAR;
    if constexpr (Epi::AFTER_DRAIN) { E.fused(acc, cur, wr, wc, fr, fq, lds, wid, lane); S.done(cur); }
#undef PG8_SA
#undef PG8_SB
#undef PG8_STAGE
#undef PG8_LDA
#undef PG8_LDB
#undef PG8_MMA
#undef PG8_WAIT_V
#undef PG8_WAIT_L
#undef PG8_BAR
#undef PG8_SCHED
}
}
namespace pg8 {
struct EpiProj {
    static constexpr bool PERM = true, AFTER_DRAIN = false;
    bf16_t* O; int ldc; int gelu_tiles;
    __device__ __forceinline__ void operator()(const f32x4 (&acc)[2][2][4][2], const Unit& u, int wr, int wc, int fr, int fq) const {
        const int row0 = u.pm * BM + wr * 64 + fr; const int col0 = u.pn * BM + wc * 32 + 8 * fq;
        const bool act = u.pn < gelu_tiles;
#pragma unroll
        for (int ai = 0; ai < 2; ++ai)
#pragma unroll
            for (int m = 0; m < 4; ++m) { bf16_t* rowp = O + (size_t)(row0 + ai * HALF + m * 16) * ldc + col0;
#pragma unroll
                for (int bj = 0; bj < 2; ++bj) { f32x4 v0 = acc[ai][bj][m][0], v1 = acc[ai][bj][m][1];
                    if (act) { f32x2 a = gelu_pk((f32x2){v0[0], v0[1]}), b = gelu_pk((f32x2){v0[2], v0[3]}), c = gelu_pk((f32x2){v1[0], v1[1]}), d = gelu_pk((f32x2){v1[2], v1[3]});
                        v0 = (f32x4){a.x, a.y, b.x, b.y}; v1 = (f32x4){c.x, c.y, d.x, d.y}; }
                    u32x4 w; w.x = cvt_pk_bf16(v0[0], v0[1]); w.y = cvt_pk_bf16(v0[2], v0[3]); w.z = cvt_pk_bf16(v1[0], v1[1]); w.w = cvt_pk_bf16(v1[2], v1[3]);
                    *(u32x4*)(rowp + bj * HALF) = w; } }
    }
};
struct EpiResid {
    static constexpr bool PERM = false, AFTER_DRAIN = false;
    const float* base; const float* gate; float* out; int ldc;
    __device__ __forceinline__ void operator()(const f32x4 (&acc)[2][2][4][2], const Unit& u, int wr, int wc, int fr, int fq) const {
        const int row0 = u.pm * BM + wr * 64 + fr, col0 = u.pn * BM + wc * 32 + 4 * fq;
        f32x4 gv[2][2];
#pragma unroll
        for (int bj = 0; bj < 2; ++bj)
#pragma unroll
            for (int n = 0; n < 2; ++n) gv[bj][n] = *(const f32x4*)(gate + col0 + bj * HALF + n * 16);
#pragma unroll
        for (int ai = 0; ai < 2; ++ai)
#pragma unroll
            for (int m = 0; m < 4; ++m) { const size_t off = (size_t)(row0 + ai * HALF + m * 16) * ldc + col0;
#pragma unroll
                for (int bj = 0; bj < 2; ++bj)
#pragma unroll
                    for (int n = 0; n < 2; ++n) { const f32x4 b = *(const f32x4*)(base + off + bj * HALF + n * 16); *(f32x4*)(out + off + bj * HALF + n * 16) = b + gv[bj][n] * acc[ai][bj][m][n]; } }
    }
};
}
#ifndef PG8_SP2
#define PG8_SP2 true
#endif
#ifndef PG8_ALIGN
#define PG8_ALIGN true
#endif
constexpr int NWAVES = 8;
constexpr int M = 16384, D = 2048;
constexpr int IN_COLS = 6152, NPROJ = 6144;
constexpr int C_UG = 0, C_VG = 1024, C_Q = 2048, C_K = 3072, C_VM = 4096, C_OM = 5120;
constexpr int NHEAD = 4, DH = 256, CH = 128, NCHUNK = M / CH;
constexpr int NEXP = 16384, PH = 8, TOPK = 16, NSEL = PH * TOPK;
constexpr float EPS = 1e-6f;
constexpr int MOD_SHM = 0, MOD_SCM = 2048, MOD_GM = 4096, MOD_SHF = 6144, MOD_SCF = 8192, MOD_GF = 10240, NMOD = 12288;
constexpr int ADA_KC = 16, ADA_KROWS = D / ADA_KC;

constexpr size_t MiB = 1u << 20;
constexpr size_t WS_CTL = 0, CTL_ZERO_BYTES = 1 * MiB;
constexpr size_t WS_MODP = 1 * MiB;
constexpr size_t WS_MODF = WS_MODP + (size_t)ADA_KC * NMOD * 4;
constexpr size_t WS_GATES = 2 * MiB;
constexpr size_t WS_SUMM = 2 * MiB + 512 * 1024;
constexpr size_t WS_MTAB = WS_SUMM + 8192;
constexpr size_t WS_NST = 3 * MiB;
constexpr size_t WS_WIN = 4 * MiB;
constexpr size_t WS_WOUT = 28 * MiB;
constexpr size_t WS_WQ = 36 * MiB;
constexpr size_t WS_IDX = 44 * MiB;
constexpr size_t WS_PG = 52 * MiB;
constexpr size_t WS_HA = 64 * MiB;
constexpr size_t WS_PROJ = 128 * MiB;
constexpr size_t WS_STATE = 320 * MiB;
constexpr size_t WS_ED = 384 * MiB, WS_EU = 416 * MiB;
constexpr size_t WS_SD = 3 * MiB + 512 * 1024, WS_SU = WS_SD + 65536;
constexpr size_t WS_END = 512 * MiB;
constexpr int CW_TMO = 0, CW_CODE = 1, CW_BAR = 4096;

constexpr int RING_BYTES = 131072, LDSCTL_OFF = RING_BYTES, MISC_OFF = LDSCTL_OFF + 320, LDS_BYTES = 147456;

#define GAS __attribute__((address_space(1)))
#define LAS __attribute__((address_space(3)))
#define DI __device__ __forceinline__
typedef unsigned short bf16;
typedef unsigned v4u __attribute__((ext_vector_type(4)));
typedef unsigned v2u __attribute__((ext_vector_type(2)));
typedef float f32x4 __attribute__((ext_vector_type(4)));
typedef float f32x16 __attribute__((ext_vector_type(16)));
typedef short bf16x8 __attribute__((ext_vector_type(8)));
typedef GAS unsigned gu32;
#define RLX_AGENT __ATOMIC_RELAXED, __HIP_MEMORY_SCOPE_AGENT
#define LDS_WAIT() asm volatile("s_waitcnt lgkmcnt(0)" ::: "memory")
#define VM_WAIT() asm volatile("s_waitcnt vmcnt(0)" ::: "memory")
#define MFMA32(a, b, c) __builtin_amdgcn_mfma_f32_32x32x16_bf16((a), (b), (c), 0, 0, 0)
DI unsigned f2bf(float f) { unsigned u = __builtin_bit_cast(unsigned, f); return (u + 0x7fffu + ((u >> 16) & 1u)) >> 16; }
DI unsigned pk2(float lo, float hi) { return f2bf(lo) | (f2bf(hi) << 16); }
DI float bflo(unsigned w) { return __builtin_bit_cast(float, w << 16); }
DI float bfhi(unsigned w) { return __builtin_bit_cast(float, w & 0xffff0000u); }
DI float bf2f(unsigned short h) { return __builtin_bit_cast(float, (unsigned)h << 16); }
DI int crow(int reg, int h) { return (reg & 3) + 8 * (reg >> 2) + 4 * h; }
DI float wave_sum(float v) {
#pragma unroll
    for (int o = 1; o < 64; o <<= 1) v += __shfl_xor(v, o);
    return v;
}
DI float wave_max(float v) {
#pragma unroll
    for (int o = 1; o < 64; o <<= 1) v = fmaxf(v, __shfl_xor(v, o));
    return v;
}
DI float silu_f(float v) { return v / (1.0f + __expf(-v)); }
DI float sigmoid_f(float v) { return 1.0f / (1.0f + __expf(-v)); }
DI float gelu_f(float v) { return 0.5f * v * (1.0f + erff(v * 0.70710678118654752f)); }
typedef __bf16 bf16v2 __attribute__((ext_vector_type(2)));
#define DOT2(a, b, c) __builtin_amdgcn_fdot2_f32_bf16(__builtin_bit_cast(bf16v2, (unsigned)(a)), __builtin_bit_cast(bf16v2, (unsigned)(b)), (c), false)
DI f32x16 zero16() { f32x16 z; for (int i = 0; i < 16; ++i) z[i] = 0.f; return z; }
#define XB_TMO      128
#define XB_XCNT(j)  (256  + 64 * (j))
#define XB_XSUB(j)  (1280 + 64 * (j))
#define XB_XGEN(j)  (2304 + 64 * (j))
#define XB_TOP      3328
#define XB_TOPGEN   3392
#define XCD_BAR_WORDS 3456
#define XB_SPIN_CAP (1u << 18)

__device__ __forceinline__ unsigned xb_ld(unsigned* p)              { return __hip_atomic_load(p, __ATOMIC_RELAXED, __HIP_MEMORY_SCOPE_AGENT); }
__device__ __forceinline__ unsigned xb_add(unsigned* p, unsigned v) { return __hip_atomic_fetch_add(p, v, __ATOMIC_RELAXED, __HIP_MEMORY_SCOPE_AGENT); }
__device__ __forceinline__ unsigned xb_xcc_id() { return (unsigned)__builtin_amdgcn_s_getreg((3 << 11) | 20) & 0xFu; }
#define XB_SPIN(cond, bar) do { unsigned _sp = 0; while (cond) { __builtin_amdgcn_s_sleep(1); \
    if ((++_sp & 255u) == 0u) { if (xb_ld(&(bar)[XB_TMO])) break; if (_sp > XB_SPIN_CAP) { atomicAdd(&(bar)[XB_TMO], 1u); break; } } } } while (0)

struct XcdBarrier {
    unsigned* bar; unsigned x;
    volatile LAS unsigned* st;
};

__device__ __forceinline__ XcdBarrier xcd_barrier_post(unsigned* bar, volatile LAS unsigned* st) {
    XcdBarrier b; b.bar = bar; b.x = xb_xcc_id(); b.st = st;
    if (threadIdx.x == 0) (void)xb_add(&bar[XB_XCNT(b.x)], 1u);
    return b;
}
__device__ __forceinline__ void xcd_barrier_complete(unsigned* bar, unsigned x, unsigned& nloc, unsigned& nx) {
    const unsigned G = gridDim.x * gridDim.y * gridDim.z;
    unsigned sum, cnt, mine, sp = 0u;
    for (;;) {
        sum = 0u; cnt = 0u; mine = 0u;
#pragma unroll
        for (unsigned j = 0; j < 16; ++j) { const unsigned c = xb_ld(&bar[XB_XCNT(j)]); sum += c; cnt += (c > 0u) ? 1u : 0u; mine = (j == x) ? c : mine; }
        if (sum == G) break;
        __builtin_amdgcn_s_sleep(1);
        if ((++sp & 255u) == 0u) { if (xb_ld(&bar[XB_TMO])) break; if (sp > XB_SPIN_CAP) { atomicAdd(&bar[XB_TMO], 1u); break; } }
    }
    nloc = mine > 0u ? mine : 1u; nx = cnt > 0u ? cnt : 1u;
}

__device__ __forceinline__ void xcd_barrier(const XcdBarrier& b) {
    asm volatile("s_waitcnt vmcnt(0)" ::: "memory");
    __syncthreads();
    if (threadIdx.x == 0) {
        unsigned* bar = b.bar;
        __builtin_amdgcn_s_waitcnt(0);
        unsigned nloc = b.st[0], nx = b.st[1];
        if (nloc == 0u) { xcd_barrier_complete(bar, b.x, nloc, nx); b.st[0] = nloc; b.st[1] = nx; }
        const unsigned old = xb_add(&bar[XB_XSUB(b.x)], 1u);
        const unsigned gen = old / nloc;
        if (old + 1u == (gen + 1u) * nloc) {
            __builtin_amdgcn_fence(__ATOMIC_RELEASE, "agent");
            asm volatile("s_waitcnt vmcnt(0)" ::: "memory");
            const unsigned og = xb_add(&bar[XB_TOP], 1u);
            const unsigned tg = og / nx;
            if (og + 1u == (tg + 1u) * nx) xb_add(&bar[XB_TOPGEN], 1u);
            else XB_SPIN(xb_ld(&bar[XB_TOPGEN]) == tg, bar);
            __builtin_amdgcn_fence(__ATOMIC_ACQUIRE, "agent");
            xb_add(&bar[XB_XGEN(b.x)], 1u);
            asm volatile("s_waitcnt vmcnt(0)" ::: "memory");
        } else {
            XB_SPIN(xb_ld(&bar[XB_XGEN(b.x)]) == gen, bar);
            __builtin_amdgcn_fence(__ATOMIC_ACQUIRE, "agent");
            asm volatile("s_waitcnt vmcnt(0)" ::: "memory");
        }
    }
    __syncthreads();
}
struct Frame {
    LAS unsigned char* lds;
    volatile LAS unsigned* MISC;
    gu32* ctl;
    int tid, lane, wave, vcu, G;
    const float *x, *c, *ada_w, *ada_b, *norm_mix_g, *w_in, *b_gates, *conv_w, *conv_b, *gmlp_norm_g, *gmlp_w, *gmlp_b, *mlstm_norm_g, *w_out, *norm_ffn_g,
                *wq, *keys1, *keys2, *e_down, *e_up, *final_g;
    float* out;
    float *MODP, *MODF, *GATES, *SUMM, *MTAB, *NST, *PG;
    int* IDX;
    bf16 *WIN, *WOUT, *WQ, *HA, *PROJ, *QB, *STATE, *QC, *KC;
    unsigned char *ED, *EU; float *SD, *SU;
};

DI void p0_transpose_item(const float* W, int K, int ldw, int nblk, bf16* WT, LAS float* scr, int item, int lane) {
    const int kb = item / nblk, nb = item % nblk, k0 = 64 * kb, n0 = 32 * nb;
#pragma unroll 8
    for (int i = 0; i < 32; ++i) { const int kk = 2 * i + (lane >> 5); scr[kk * 33 + (lane & 31)] = W[(size_t)(k0 + kk) * ldw + n0 + (lane & 31)]; }
    LDS_WAIT(); asm volatile("" ::: "memory");
    const int c = lane & 7;
#pragma unroll
    for (int j = 0; j < 4; ++j) { const int n = (lane >> 3) + 8 * j; const LAS float* s = scr + (8 * c) * 33 + n;
        v4u o; o.x = pk2(s[0 * 33], s[1 * 33]); o.y = pk2(s[2 * 33], s[3 * 33]); o.z = pk2(s[4 * 33], s[5 * 33]); o.w = pk2(s[6 * 33], s[7 * 33]);
        *(GAS v4u*)(WT + (size_t)(n0 + n) * K + k0 + 8 * c) = o; }
    LDS_WAIT(); asm volatile("" ::: "memory");
}
DI void p0_ada_item(Frame& F, LAS float* scr, int item) {
    const int cc = item % (NMOD / 256), kc = item / (NMOD / 256), k0 = kc * ADA_KROWS, col = cc * 256 + F.lane * 4;
#pragma unroll
    for (int j = 0; j < ADA_KROWS / 64; ++j) scr[F.lane + 64 * j] = silu_f(F.c[k0 + F.lane + 64 * j]);
    LDS_WAIT(); asm volatile("" ::: "memory");
    f32x4 acc = {0.f, 0.f, 0.f, 0.f};
    const float* wp = F.ada_w + (size_t)k0 * NMOD + col;
#pragma unroll 8
    for (int kk = 0; kk < ADA_KROWS; ++kk) { const float s = scr[kk]; const f32x4 w = *(const GAS f32x4*)(wp + (size_t)kk * NMOD); acc += w * s; }
    *(GAS f32x4*)(F.MODP + (size_t)kc * NMOD + col) = acc;
    LDS_WAIT(); asm volatile("" ::: "memory");
}
DI void p0a_phase(Frame& F) {
    LAS float* scr = (LAS float*)(F.lds + F.wave * 16384);
    const int gw = F.vcu * NWAVES + F.wave, NGW = F.G * NWAVES;
    constexpr int I_ADA = (NMOD / 256) * ADA_KC;
    constexpr int I_WIN = (D / 64) * (NPROJ / 32), I_WO = (D / 64) * (D / 32), I_WQ = I_WO;
    constexpr int NITEMS = I_ADA + I_WIN + I_WO + I_WQ;
    for (int it = gw; it < NITEMS; it += NGW) {
        int r = it;
        if (r < I_ADA) { p0_ada_item(F, scr, r); continue; } r -= I_ADA;
        if (r < I_WIN) { p0_transpose_item(F.w_in, D, IN_COLS, NPROJ / 32, F.WIN, scr, r, F.lane); continue; } r -= I_WIN;
        if (r < I_WO) { p0_transpose_item(F.w_out, D, D, D / 32, F.WOUT, scr, r, F.lane); continue; } r -= I_WO;
        p0_transpose_item(F.wq, D, D, D / 32, F.WQ, scr, r, F.lane);
    }
#pragma unroll 1
    for (int row = gw; row < 2 * NEXP; row += NGW) {
        const int tb = row >= NEXP, e = row - tb * NEXP;
        const GAS f32x4* src = (const GAS f32x4*)((tb ? F.e_up : F.e_down) + (size_t)e * D) + F.lane;
        f32x4 v[8]; float am = 0.f;
#pragma unroll
        for (int j = 0; j < 8; ++j) { v[j] = src[64 * j]; am = fmaxf(am, fmaxf(fmaxf(fabsf(v[j].x), fabsf(v[j].y)), fmaxf(fabsf(v[j].z), fabsf(v[j].w)))); }
        am = fmaxf(wave_max(am), 1e-30f);
        const float sc = am * (1.0f / 127.0f), inv = 127.0f / am;
        GAS unsigned* dst = (GAS unsigned*)((tb ? F.EU : F.ED) + (size_t)e * D) + F.lane;
        const int off = tb ? 128 : 0;
#pragma unroll
        for (int j = 0; j < 8; ++j) {
            const int q0 = (int)__builtin_rintf(v[j].x * inv) + off, q1 = (int)__builtin_rintf(v[j].y * inv) + off, q2 = (int)__builtin_rintf(v[j].z * inv) + off, q3 = (int)__builtin_rintf(v[j].w * inv) + off;
            dst[64 * j] = (unsigned)(q0 & 255) | ((unsigned)(q1 & 255) << 8) | ((unsigned)(q2 & 255) << 16) | ((unsigned)(q3 & 255) << 24);
        }
        if (F.lane == 0) (tb ? F.SU : F.SD)[e] = sc;
    }
}
DI float mod_final(Frame& F, int col) { float s = F.ada_b[col];
#pragma unroll
    for (int k = 0; k < ADA_KC; ++k) s += F.MODP[(size_t)k * NMOD + col];
    return s; }
DI void norm_tables(Frame& F, const float* g, int col_scale, int col_shift) {
    LAS float* A1 = (LAS float*)(F.lds); LAS float* B1 = (LAS float*)(F.lds + 8192);
#pragma unroll
    for (int i = 0; i < 4; ++i) { const int c = F.tid + 512 * i; A1[c] = g[c] * (1.0f + F.MODF[col_scale + c]); B1[c] = F.MODF[col_shift + c]; }
}
DI void p0b_phase(Frame& F) {
    LAS float* A1 = (LAS float*)(F.lds); LAS float* B1 = (LAS float*)(F.lds + 8192); LAS float* WG = (LAS float*)(F.lds + 16384);
#pragma unroll
    for (int i = 0; i < 4; ++i) { const int c = F.tid + 512 * i; A1[c] = F.norm_mix_g[c] * (1.0f + mod_final(F, MOD_SCM + c)); B1[c] = mod_final(F, MOD_SHM + c); }
    { const int per = (NMOD + F.G - 1) / F.G; const int c = (int)blockIdx.x * per + F.tid; if (F.tid < per && c < NMOD) F.MODF[c] = mod_final(F, c); }
#pragma unroll
    for (int i = 0; i < 4; ++i) { const int k = F.tid + 512 * i; const f32x4 a = *(const GAS f32x4*)(F.w_in + (size_t)k * IN_COLS + NPROJ), b = *(const GAS f32x4*)(F.w_in + (size_t)k * IN_COLS + NPROJ + 4);
        WG[0 * 2048 + k] = a.x; WG[1 * 2048 + k] = a.y; WG[2 * 2048 + k] = a.z; WG[3 * 2048 + k] = a.w; WG[4 * 2048 + k] = b.x; WG[5 * 2048 + k] = b.y; WG[6 * 2048 + k] = b.z; WG[7 * 2048 + k] = b.w; }
    __syncthreads();
    const int rows_per_blk = M / F.G, rows_per_wave = rows_per_blk / NWAVES;
    const int r0 = F.vcu * rows_per_blk + F.wave * rows_per_wave;
    for (int rr = 0; rr < rows_per_wave; ++rr) {
        const int row = r0 + rr;
        const GAS f32x4* xr = (const GAS f32x4*)(F.x + (size_t)row * D) + F.lane;
        f32x4 v[8]; float ss = 0.f;
#pragma unroll
        for (int j = 0; j < 8; ++j) { v[j] = xr[64 * j]; ss += (v[j].x * v[j].x + v[j].y * v[j].y) + (v[j].z * v[j].z + v[j].w * v[j].w); }
        const float rstd = 1.0f / sqrtf(wave_sum(ss) * (1.0f / D) + EPS);
        float gd[8];
#pragma unroll
        for (int g = 0; g < 8; ++g) gd[g] = 0.f;
        GAS v2u* o8 = (GAS v2u*)(F.HA + (size_t)row * D) + F.lane;
#pragma unroll
        for (int j = 0; j < 8; ++j) {
            const f32x4 a = *(const LAS f32x4*)(A1 + 256 * j + 4 * F.lane), b = *(const LAS f32x4*)(B1 + 256 * j + 4 * F.lane);
            const f32x4 h = v[j] * rstd * a + b;
            v2u o; o.x = pk2(h.x, h.y); o.y = pk2(h.z, h.w); o8[64 * j] = o;
#pragma unroll
            for (int g = 0; g < 8; ++g) { const f32x4 w = *(const LAS f32x4*)(WG + g * 2048 + 256 * j + 4 * F.lane); gd[g] += (h.x * w.x + h.y * w.y) + (h.z * w.z + h.w * w.w); }
            asm volatile("" ::: "memory");
        }
#pragma unroll
        for (int g = 0; g < 8; ++g) gd[g] = wave_sum(gd[g]);
        if (F.lane == 0) {
#pragma unroll
            for (int g = 0; g < 8; ++g) { float p = gd[g] + F.b_gates[g];
                if (g >= 4) { p = fminf(p, 0.f) - log1pf(__expf(-fabsf(p))); }
                F.GATES[(size_t)row * 8 + g] = p; }
        }
    }
}
constexpr int IMG_PITCH = 528, M1_WL = 69632, M1_RED = 73728;
DI void m1_item(Frame& F, int hh, int kc) {
    LAS unsigned char* IMG = F.lds; LAS float* WL = (LAS float*)(F.lds + M1_WL); LAS float* RED = (LAS float*)(F.lds + M1_RED);
    const int t0 = kc * CH, lane = F.lane, tid = F.tid;
    if (F.wave == 0) {
        const float* gp = F.GATES + (size_t)(t0 + 2 * lane) * 8;
        const float i0 = gp[hh], lf0 = gp[4 + hh], i1 = gp[8 + hh], lf1 = gp[12 + hh];
        const float p = lf0 + lf1; float inc = p;
#pragma unroll
        for (int o = 1; o < 64; o <<= 1) { const float t = __shfl_up(inc, o); if (lane >= o) inc += t; }
        const float A = __shfl(inc, 63), ex = inc - p, b0 = ex + lf0, b1 = ex + p;
        const float lw0 = A - b0 + i0, lw1 = A - b1 + i1;
        const float B = wave_max(fmaxf(lw0, lw1));
        WL[2 * lane] = __expf(lw0 - B); WL[2 * lane + 1] = __expf(lw1 - B);
        if (lane == 0) { F.SUMM[(hh * NCHUNK + kc) * 2] = A; F.SUMM[(hh * NCHUNK + kc) * 2 + 1] = B; }
    }
    __syncthreads();
    const int dg = tid & 31, sb = tid >> 5;
#pragma unroll 1
    for (int which = 0; which < 2; ++which) {
        const int chb = (which == 0 ? 1024 : 0) + hh * DH + dg * 8;
        const int colb = (which == 0 ? C_K : C_Q) + hh * DH + dg * 8;
        float cw[4][8], cb[8];
#pragma unroll
        for (int j = 0; j < 4; ++j) { const f32x4 a = *(const GAS f32x4*)(F.conv_w + j * 2048 + chb), b = *(const GAS f32x4*)(F.conv_w + j * 2048 + chb + 4);
            cw[j][0] = a.x; cw[j][1] = a.y; cw[j][2] = a.z; cw[j][3] = a.w; cw[j][4] = b.x; cw[j][5] = b.y; cw[j][6] = b.z; cw[j][7] = b.w; }
        { const f32x4 a = *(const GAS f32x4*)(F.conv_b + chb), b = *(const GAS f32x4*)(F.conv_b + chb + 4);
          cb[0] = a.x; cb[1] = a.y; cb[2] = a.z; cb[3] = a.w; cb[4] = b.x; cb[5] = b.y; cb[6] = b.z; cb[7] = b.w; }
        float dnp[8];
#pragma unroll
        for (int e = 0; e < 8; ++e) dnp[e] = 0.f;
#pragma unroll 2
        for (int i = 0; i < 8; ++i) {
            const int s = sb + 16 * i, t = t0 + s;
            float acc[8];
#pragma unroll
            for (int e = 0; e < 8; ++e) acc[e] = cb[e];
#pragma unroll
            for (int j = 0; j < 4; ++j) { const int tt = t - 3 + j;
                v4u w = {0u, 0u, 0u, 0u}; if (tt >= 0) w = *(const GAS v4u*)(F.PROJ + (size_t)tt * NPROJ + colb);
                acc[0] += cw[j][0] * bflo(w.x); acc[1] += cw[j][1] * bfhi(w.x); acc[2] += cw[j][2] * bflo(w.y); acc[3] += cw[j][3] * bfhi(w.y);
                acc[4] += cw[j][4] * bflo(w.z); acc[5] += cw[j][5] * bfhi(w.z); acc[6] += cw[j][6] * bflo(w.w); acc[7] += cw[j][7] * bfhi(w.w); }
#pragma unroll
            for (int e = 0; e < 8; ++e) acc[e] = silu_f(acc[e]);
            if (which == 0) {
                v4u o; o.x = pk2(acc[0], acc[1]); o.y = pk2(acc[2], acc[3]); o.z = pk2(acc[4], acc[5]); o.w = pk2(acc[6], acc[7]);
                *(GAS v4u*)(F.KC + (size_t)t * 1024 + hh * DH + dg * 8) = o;
                const float wl = WL[s];
#pragma unroll
                for (int e = 0; e < 8; ++e) { acc[e] *= wl; dnp[e] += acc[e]; }
                v4u o2; o2.x = pk2(acc[0], acc[1]); o2.y = pk2(acc[2], acc[3]); o2.z = pk2(acc[4], acc[5]); o2.w = pk2(acc[6], acc[7]);
                *(LAS v4u*)(IMG + s * IMG_PITCH + dg * 16) = o2;
            } else {
#pragma unroll
                for (int e = 0; e < 8; ++e) acc[e] *= 0.0625f;
                v4u o; o.x = pk2(acc[0], acc[1]); o.y = pk2(acc[2], acc[3]); o.z = pk2(acc[4], acc[5]); o.w = pk2(acc[6], acc[7]);
                *(GAS v4u*)(F.QC + (size_t)t * 1024 + hh * DH + dg * 8) = o;
            }
        }
        if (which == 0) {
#pragma unroll
            for (int e = 0; e < 8; ++e) RED[sb * 256 + dg * 8 + e] = dnp[e];
        }
    }
    __syncthreads();
    if (tid < 256) { float s = 0.f;
#pragma unroll
        for (int i = 0; i < 16; ++i) s += RED[i * 256 + tid];
        F.NST[(size_t)(hh * NCHUNK + kc) * DH + tid] = s; }
    const int r = lane & 31, h = lane >> 5, e0 = F.wave * 32;
    bf16x8 bf[8];
#pragma unroll
    for (int ks = 0; ks < 8; ++ks) {
        const bf16* vp = F.PROJ + (size_t)(t0 + ks * 16 + 8 * h) * NPROJ + C_VM + hh * DH + e0 + r;
#pragma unroll
        for (int j = 0; j < 8; ++j) bf[ks][j] = (short)vp[(size_t)j * NPROJ];
    }
    bf16* sp = F.STATE + (size_t)(hh * NCHUNK + kc) * (DH * DH) + (size_t)(e0 + r) * DH;
#pragma unroll 1
    for (int dt = 0; dt < 8; ++dt) {
        f32x16 acc = zero16();
#pragma unroll
        for (int ks = 0; ks < 8; ++ks) {
            bf16x8 af; const LAS unsigned char* ip = IMG + (ks * 16 + 8 * h) * IMG_PITCH + (dt * 32 + r) * 2;
#pragma unroll
            for (int j = 0; j < 8; ++j) af[j] = (short)*(const LAS unsigned short*)(ip + j * IMG_PITCH);
            acc = MFMA32(af, bf[ks], acc);
        }
#pragma unroll
        for (int g = 0; g < 4; ++g) { v2u o; o.x = pk2(acc[4 * g], acc[4 * g + 1]); o.y = pk2(acc[4 * g + 2], acc[4 * g + 3]);
            *(GAS v2u*)(sp + dt * 32 + 8 * g + 4 * h) = o; }
    }
    __syncthreads();
}
DI void gmlp_item(Frame& F, int n, int g) {
    LAS float* RSTD = (LAS float*)F.lds;
    const int t0 = n * CH, c0 = g * 128, lane = F.lane, tid = F.tid;
    { const int s = tid >> 2, qd = tid & 3; const bf16* vp = F.PROJ + (size_t)(t0 + s) * NPROJ + C_VG + c0 + qd * 32; float ss = 0.f;
#pragma unroll
        for (int i = 0; i < 4; ++i) { const v4u w = *(const GAS v4u*)(vp + 8 * i);
            const float a0 = bflo(w.x), a1 = bfhi(w.x), a2 = bflo(w.y), a3 = bfhi(w.y), a4 = bflo(w.z), a5 = bfhi(w.z), a6 = bflo(w.w), a7 = bfhi(w.w);
            ss += (a0 * a0 + a1 * a1) + (a2 * a2 + a3 * a3) + (a4 * a4 + a5 * a5) + (a6 * a6 + a7 * a7); }
        ss += __shfl_xor(ss, 1); ss += __shfl_xor(ss, 2);
        if (qd == 0) RSTD[s] = 1.0f / sqrtf(ss * (1.0f / 128.0f) + EPS); }
    __syncthreads();
    const int r = lane & 31, h = lane >> 5, ct = F.wave & 3, tp = F.wave >> 2;
    bf16x8 af[8];
#pragma unroll
    for (int ks = 0; ks < 8; ++ks) {
        const bf16* vp = F.PROJ + (size_t)(t0 + ks * 16 + 8 * h) * NPROJ + C_VG + c0 + ct * 32 + r;
#pragma unroll
        for (int j = 0; j < 8; ++j) af[ks][j] = (short)vp[(size_t)j * NPROJ];
    }
    float ng[16];
#pragma unroll
    for (int reg = 0; reg < 16; ++reg) ng[reg] = F.gmlp_norm_g[g * 128 + ct * 32 + crow(reg, h)];
#pragma unroll 1
    for (int ti = 0; ti < 2; ++ti) {
        const int tt = (ti == 0) ? tp : 3 - tp;
        const int t = tt * 32 + r;
        const float* wrow = F.gmlp_w + (size_t)(g * 128 + t) * 128;
        f32x16 acc = zero16();
#pragma unroll
        for (int ks = 0; ks < 8; ++ks) {
            if (ks <= 2 * tt + 1) {
                const int s0 = ks * 16 + 8 * h;
                const f32x4 wa = *(const GAS f32x4*)(wrow + s0), wb = *(const GAS f32x4*)(wrow + s0 + 4);
                const f32x4 ra = *(const LAS f32x4*)(RSTD + s0), rb = *(const LAS f32x4*)(RSTD + s0 + 4);
                float wv[8] = {wa.x * ra.x, wa.y * ra.y, wa.z * ra.z, wa.w * ra.w, wb.x * rb.x, wb.y * rb.y, wb.z * rb.z, wb.w * rb.w};
#pragma unroll
                for (int j = 0; j < 8; ++j) if (s0 + j > t) wv[j] = 0.f;
                v4u bw; bw.x = pk2(wv[0], wv[1]); bw.y = pk2(wv[2], wv[3]); bw.z = pk2(wv[4], wv[5]); bw.w = pk2(wv[6], wv[7]);
                acc = MFMA32(af[ks], __builtin_bit_cast(bf16x8, bw), acc);
            }
        }
        const float bsp = F.gmlp_b[g * 128 + t];
        const bf16* up = F.PROJ + (size_t)(t0 + t) * NPROJ + C_UG + c0 + ct * 32;
        bf16* yp = F.HA + (size_t)(t0 + t) * D + c0 + ct * 32;
#pragma unroll
        for (int gq = 0; gq < 4; ++gq) { const int cl = 8 * gq + 4 * h;
            const v2u uw = *(const GAS v2u*)(up + cl);
            const float y0 = bflo(uw.x) * (ng[4 * gq] * acc[4 * gq] + bsp), y1 = bfhi(uw.x) * (ng[4 * gq + 1] * acc[4 * gq + 1] + bsp);
            const float y2 = bflo(uw.y) * (ng[4 * gq + 2] * acc[4 * gq + 2] + bsp), y3 = bfhi(uw.y) * (ng[4 * gq + 3] * acc[4 * gq + 3] + bsp);
            v2u o; o.x = pk2(y0, y1); o.y = pk2(y2, y3); *(GAS v2u*)(yp + cl) = o; }
    }
    __syncthreads();
}
DI void p2_phase(Frame& F) {
    constexpr int N_M1 = NHEAD * NCHUNK, N_G = (M / CH) * 8;
    for (int it = (int)blockIdx.x; it < N_M1 + N_G; it += F.G) {
        if (it < N_M1) m1_item(F, it / NCHUNK, it % NCHUNK);
        else { const int j = it - N_M1; gmlp_item(F, j % (M / CH), j / (M / CH)); }
    }
}
DI void p3_phase(Frame& F) {
    LAS float* TAB = (LAS float*)F.lds;
    const int lane = F.lane;
    if (F.wave < NHEAD) {
        const int hh = F.wave; const float* sp = F.SUMM + (size_t)(hh * NCHUNK + 2 * lane) * 2;
        const float A0 = sp[0], B0 = sp[1], A1 = sp[2], B1 = sp[3];
        float ca = A0 + A1, cb = fmaxf(B0 + A1, B1);
        const float pa = ca, pb = cb;
#pragma unroll
        for (int o = 1; o < 64; o <<= 1) { const float ta = __shfl_up(ca, o), tb = __shfl_up(cb, o); if (lane >= o) { cb = fmaxf(tb + ca, cb); ca = ta + ca; } }
        (void)pa; (void)pb;
        float ea = __shfl_up(ca, 1), eb = __shfl_up(cb, 1);
        float m0 = (lane == 0) ? 0.f : fmaxf(ea, eb);
        const float m1 = fmaxf(m0 + A0, B0), m2 = fmaxf(m1 + A1, B1);
        TAB[(hh * NCHUNK + 2 * lane) * 2] = __expf(A0 + m0 - m1); TAB[(hh * NCHUNK + 2 * lane) * 2 + 1] = __expf(B0 - m1);
        TAB[(hh * NCHUNK + 2 * lane + 1) * 2] = __expf(A1 + m1 - m2); TAB[(hh * NCHUNK + 2 * lane + 1) * 2 + 1] = __expf(B1 - m2);
        if (blockIdx.x == 0) { F.MTAB[hh * NCHUNK + 2 * lane] = m0; F.MTAB[hh * NCHUNK + 2 * lane + 1] = m1; }
    }
    __syncthreads();
    const int NT = F.G * NWAVES * 64, gt = (int)blockIdx.x * (NWAVES * 64) + F.tid;
    for (int p = gt; p < NHEAD * (DH * DH / 2); p += NT) {
        const int hh = p / (DH * DH / 2), q = p % (DH * DH / 2);
        GAS unsigned* sp = (GAS unsigned*)(F.STATE + (size_t)hh * NCHUNK * (DH * DH)) + q;
        float s0 = 0.f, s1 = 0.f;
#pragma unroll 1
        for (int k0 = 0; k0 < NCHUNK; k0 += 16) {
            unsigned ld[16];
#pragma unroll
            for (int k = 0; k < 16; ++k) ld[k] = sp[(size_t)(k0 + k) * (DH * DH / 2)];
#pragma unroll
            for (int k = 0; k < 16; ++k) {
                sp[(size_t)(k0 + k) * (DH * DH / 2)] = pk2(s0, s1);
                const float dec = TAB[(hh * NCHUNK + k0 + k) * 2], wb = TAB[(hh * NCHUNK + k0 + k) * 2 + 1];
                s0 = dec * s0 + wb * bflo(ld[k]); s1 = dec * s1 + wb * bfhi(ld[k]);
            }
        }
    }
    for (int p = gt; p < NHEAD * DH; p += NT) {
        const int hh = p / DH, d = p % DH; float* np = F.NST + (size_t)hh * NCHUNK * DH + d; float s = 0.f;
#pragma unroll 8
        for (int k = 0; k < NCHUNK; ++k) { const float ld = np[(size_t)k * DH]; np[(size_t)k * DH] = s; s = TAB[(hh * NCHUNK + k) * 2] * s + TAB[(hh * NCHUNK + k) * 2 + 1] * ld; }
    }
}
DI void m3_item(Frame& F, int hh, int kc) {
    LAS float* GS = (LAS float*)F.lds; LAS float* MX = (LAS float*)(F.lds + 512); LAS float* BT = (LAS float*)(F.lds + 1024);
    LAS float* NK = (LAS float*)(F.lds + 2048); LAS float* XCH = (LAS float*)(F.lds + 4096);
    const int t0 = kc * CH, lane = F.lane, tid = F.tid, item = hh * NCHUNK + kc;
    const float mk = F.MTAB[item];
    if (F.wave == 0) {
        const float* gp = F.GATES + (size_t)(t0 + 2 * lane) * 8;
        const float i0 = gp[hh], lf0 = gp[4 + hh], i1 = gp[8 + hh], lf1 = gp[12 + hh];
        const float p = lf0 + lf1; float inc = p;
#pragma unroll
        for (int o = 1; o < 64; o <<= 1) { const float t = __shfl_up(inc, o); if (lane >= o) inc += t; }
        const float ex = inc - p, b0 = ex + lf0, b1 = ex + p;
        const float g0 = i0 - b0, g1 = i1 - b1;
        float cm = fmaxf(g0, g1);
#pragma unroll
        for (int o = 1; o < 64; o <<= 1) { const float t = __shfl_up(cm, o); if (lane >= o) cm = fmaxf(cm, t); }
        float pm = __shfl_up(cm, 1); if (lane == 0) pm = -INFINITY;
        const float M0 = fmaxf(mk, fmaxf(pm, g0)), M1 = fmaxf(M0, g1);
        GS[2 * lane] = g0; GS[2 * lane + 1] = g1; MX[2 * lane] = M0; MX[2 * lane + 1] = M1; BT[2 * lane] = b0; BT[2 * lane + 1] = b1;
    }
    if (tid < 256) NK[tid] = F.NST[(size_t)item * DH + tid];
    LAS unsigned char* VIMG = F.lds + 8192;
#pragma unroll
    for (int i = 0; i < 8; ++i) { const int c = tid + 512 * i, row = c >> 5, c16 = c & 31;
        *(LAS v4u*)(VIMG + row * IMG_PITCH + c16 * 16) = *(const GAS v4u*)(F.PROJ + (size_t)(t0 + row) * NPROJ + C_VM + hh * DH + c16 * 8); }
    __syncthreads();
    const int r = lane & 31, h = lane >> 5, tt = F.wave & 3, eh = F.wave >> 2;
    const int tl = tt * 32 + r, t = t0 + tl;
    const float Mt = MX[tl], winter = __expf(mk - Mt);
    f32x16 accH[4];
#pragma unroll
    for (int i = 0; i < 4; ++i) accH[i] = zero16();
    float qn = 0.f;
    const bf16* qp = F.QC + (size_t)t * 1024 + hh * DH + 8 * h;
    const bf16* kp = F.KC + (size_t)(t0 + r) * 1024 + hh * DH + 8 * h;
    const bf16* cp = F.STATE + (size_t)item * (DH * DH) + (size_t)(eh * 128 + r) * DH + 8 * h;
#pragma unroll 2
    for (int ks = 0; ks < 16; ++ks) {
        const v4u qw = *(const GAS v4u*)(qp + ks * 16);
        float qv[8] = {bflo(qw.x), bfhi(qw.x), bflo(qw.y), bfhi(qw.y), bflo(qw.z), bfhi(qw.z), bflo(qw.w), bfhi(qw.w)};
        const f32x4 na = *(const LAS f32x4*)(NK + ks * 16 + 8 * h), nb = *(const LAS f32x4*)(NK + ks * 16 + 8 * h + 4);
        qn += (qv[0] * na.x + qv[1] * na.y) + (qv[2] * na.z + qv[3] * na.w) + (qv[4] * nb.x + qv[5] * nb.y) + (qv[6] * nb.z + qv[7] * nb.w);
        v4u q2; q2.x = pk2(qv[0] * winter, qv[1] * winter); q2.y = pk2(qv[2] * winter, qv[3] * winter); q2.z = pk2(qv[4] * winter, qv[5] * winter); q2.w = pk2(qv[6] * winter, qv[7] * winter);
        const bf16x8 q2f = __builtin_bit_cast(bf16x8, q2);
#pragma unroll
        for (int et = 0; et < 4; ++et) { const bf16x8 cf = *(const GAS bf16x8*)(cp + (size_t)et * 32 * DH + ks * 16); accH[et] = MFMA32(cf, q2f, accH[et]); }
    }
    qn += __shfl_xor(qn, 32);
    float den = 0.f;
    const LAS unsigned char* vbase = VIMG + 4 * h * IMG_PITCH + (eh * 128 + r) * 2;
#pragma unroll 1
    for (int st = 0; st <= tt; ++st) {
        f32x16 accS = zero16();
        const bf16* kps = kp + (size_t)st * 32 * 1024;
#pragma unroll 4
        for (int ks = 0; ks < 16; ++ks) { const bf16x8 qf = *(const GAS bf16x8*)(qp + ks * 16); const bf16x8 kf = *(const GAS bf16x8*)(kps + ks * 16); accS = MFMA32(kf, qf, accS); }
        float xv[16];
#pragma unroll
        for (int reg = 0; reg < 16; ++reg) { const int sl = st * 32 + crow(reg, h); float v = accS[reg] * __expf(GS[sl] - Mt); if (sl > tl) v = 0.f; xv[reg] = v; den += v; }
        const LAS unsigned char* vb2 = vbase + st * 32 * IMG_PITCH;
#pragma unroll
        for (int k2 = 0; k2 < 2; ++k2) {
            v4u xw; xw.x = pk2(xv[8 * k2], xv[8 * k2 + 1]); xw.y = pk2(xv[8 * k2 + 2], xv[8 * k2 + 3]); xw.z = pk2(xv[8 * k2 + 4], xv[8 * k2 + 5]); xw.w = pk2(xv[8 * k2 + 6], xv[8 * k2 + 7]);
            const bf16x8 xs = __builtin_bit_cast(bf16x8, xw);
#pragma unroll
            for (int et = 0; et < 4; ++et) {
                bf16x8 vf;
#pragma unroll
                for (int j = 0; j < 8; ++j) vf[j] = (short)*(const LAS unsigned short*)(vb2 + (16 * k2 + 8 * (j >> 2) + (j & 3)) * IMG_PITCH + et * 64);
                accH[et] = MFMA32(vf, xs, accH[et]);
            }
        }
    }
    den += __shfl_xor(den, 32);
    den += winter * qn;
    const float dnm = fmaxf(fabsf(den), __expf(-(BT[tl] + Mt))), inv = 1.0f / dnm;
    float ss = 0.f;
#pragma unroll
    for (int et = 0; et < 4; ++et)
#pragma unroll
        for (int reg = 0; reg < 16; ++reg) { accH[et][reg] *= inv; ss += accH[et][reg] * accH[et][reg]; }
    ss += __shfl_xor(ss, 32);
    if (h == 0) XCH[eh * 128 + tl] = ss;
    __syncthreads();
    const float rstd = 1.0f / sqrtf((XCH[tl] + XCH[128 + tl]) * (1.0f / DH) + EPS);
    const bf16* op = F.PROJ + (size_t)t * NPROJ + C_OM + hh * DH + eh * 128;
    bf16* yp = F.HA + (size_t)t * D + 1024 + hh * DH + eh * 128;
    const float* ngp = F.mlstm_norm_g + hh * DH + eh * 128;
#pragma unroll
    for (int et = 0; et < 4; ++et)
#pragma unroll
        for (int gq = 0; gq < 4; ++gq) { const int el = et * 32 + 8 * gq + 4 * h;
            const v2u ow = *(const GAS v2u*)(op + el); const f32x4 gn = *(const GAS f32x4*)(ngp + el);
            const float y0 = accH[et][4 * gq] * rstd * gn.x * sigmoid_f(bflo(ow.x)), y1 = accH[et][4 * gq + 1] * rstd * gn.y * sigmoid_f(bfhi(ow.x));
            const float y2 = accH[et][4 * gq + 2] * rstd * gn.z * sigmoid_f(bflo(ow.y)), y3 = accH[et][4 * gq + 3] * rstd * gn.w * sigmoid_f(bfhi(ow.y));
            v2u o; o.x = pk2(y0, y1); o.y = pk2(y2, y3); *(GAS v2u*)(yp + el) = o; }
    __syncthreads();
}
DI void p4_phase(Frame& F) {
    for (int it = (int)blockIdx.x; it < NHEAD * NCHUNK; it += F.G) m3_item(F, it / NCHUNK, it % NCHUNK);
}
DI void p6_phase(Frame& F) {
    LAS float* A1 = (LAS float*)(F.lds); LAS float* B1 = (LAS float*)(F.lds + 8192);
    norm_tables(F, F.norm_ffn_g, MOD_SCF, MOD_SHF);
    __syncthreads();
    const int gw = F.vcu * NWAVES + F.wave, NGW = F.G * NWAVES;
    for (int row = gw; row < M; row += NGW) {
        const GAS f32x4* xr = (const GAS f32x4*)(F.out + (size_t)row * D) + F.lane;
        f32x4 v[8]; float ss = 0.f;
#pragma unroll
        for (int j = 0; j < 8; ++j) { v[j] = xr[64 * j]; ss += (v[j].x * v[j].x + v[j].y * v[j].y) + (v[j].z * v[j].z + v[j].w * v[j].w); }
        const float rstd = 1.0f / sqrtf(wave_sum(ss) * (1.0f / D) + EPS);
        GAS v2u* o8 = (GAS v2u*)(F.HA + (size_t)row * D) + F.lane;
#pragma unroll
        for (int j = 0; j < 8; ++j) {
            const f32x4 a = *(const LAS f32x4*)(A1 + 256 * j + 4 * F.lane), b = *(const LAS f32x4*)(B1 + 256 * j + 4 * F.lane);
            const f32x4 h = v[j] * rstd * a + b;
            v2u o; o.x = pk2(h.x, h.y); o.y = pk2(h.z, h.w); o8[64 * j] = o;
        }
    }
}
constexpr int KPITCH = 272, P8_TBL = 69632;
DI void topk_insert(float (&L)[16], float x) {
#pragma unroll
    for (int i = 15; i >= 1; --i) L[i] = __builtin_amdgcn_fmed3f(x, L[i - 1], L[i]);
    L[0] = fmaxf(L[0], x);
}
DI void p8_phase(Frame& F) {
    LAS unsigned char* KIMG = F.lds; LAS unsigned char* TBL = F.lds + P8_TBL + F.wave * 1024;
    const int lane = F.lane, tid = F.tid, r = lane & 31, h = lane >> 5;
#pragma unroll 4
    for (int i = 0; i < 16; ++i) { const int idx = tid * 4 + 2048 * i, side = idx >> 14, rem = idx & 16383, row = rem >> 7, col = rem & 127;
        const f32x4 a = *(const GAS f32x4*)((side ? F.keys2 : F.keys1) + rem);
        v2u o; o.x = pk2(a.x, a.y); o.y = pk2(a.z, a.w); *(LAS v2u*)(KIMG + (side * 128 + row) * KPITCH + col * 2) = o; }
    __syncthreads();
    for (int it = (int)blockIdx.x; it < (M / 256) * PH; it += F.G) {
        const int tile = it / PH, hd = it % PH;
        const int t = tile * 256 + F.wave * 32 + r;
        float L1[16], L2[16];
#pragma unroll 1
        for (int side = 0; side < 2; ++side) {
            f32x16 acc[4];
#pragma unroll
            for (int kt = 0; kt < 4; ++kt) acc[kt] = zero16();
            const bf16* qp = F.QB + (size_t)t * D + hd * 256 + side * 128 + 8 * h;
#pragma unroll
            for (int ks = 0; ks < 8; ++ks) {
                const bf16x8 qf = *(const GAS bf16x8*)(qp + ks * 16);
#pragma unroll
                for (int kt = 0; kt < 4; ++kt) { const bf16x8 kf = *(const LAS bf16x8*)(KIMG + (side * 128 + kt * 32 + r) * KPITCH + (ks * 16 + 8 * h) * 2); acc[kt] = MFMA32(kf, qf, acc[kt]); }
            }
            float L[16];
#pragma unroll
            for (int i = 0; i < 16; ++i) L[i] = -3.0e38f;
#pragma unroll
            for (int kt = 0; kt < 4; ++kt)
#pragma unroll
                for (int reg = 0; reg < 16; ++reg) { const unsigned key = (unsigned)(kt * 32 + crow(reg, h)); const float sv = acc[kt][reg];
                    topk_insert(L, __uint_as_float((__float_as_uint(sv) & ~127u) | key)); }
            float P[16];
#pragma unroll
            for (int i = 0; i < 16; ++i) P[i] = __shfl_xor(L[i], 32);
#pragma unroll
            for (int i = 0; i < 16; ++i) topk_insert(L, P[i]);
            if (side == 0) {
#pragma unroll
                for (int i = 0; i < 16; ++i) L1[i] = L[i];
            } else {
#pragma unroll
                for (int i = 0; i < 16; ++i) L2[i] = L[i];
            }
        }
        if (h == 0) {
#pragma unroll
            for (int w = 0; w < 4; ++w) {
                const unsigned a = (__builtin_bit_cast(unsigned, L1[4 * w]) & 127u) | ((__builtin_bit_cast(unsigned, L1[4 * w + 1]) & 127u) << 8) | ((__builtin_bit_cast(unsigned, L1[4 * w + 2]) & 127u) << 16) | ((__builtin_bit_cast(unsigned, L1[4 * w + 3]) & 127u) << 24);
                const unsigned b = (__builtin_bit_cast(unsigned, L2[4 * w]) & 127u) | ((__builtin_bit_cast(unsigned, L2[4 * w + 1]) & 127u) << 8) | ((__builtin_bit_cast(unsigned, L2[4 * w + 2]) & 127u) << 16) | ((__builtin_bit_cast(unsigned, L2[4 * w + 3]) & 127u) << 24);
                *(LAS unsigned*)(TBL + r * 32 + 4 * w) = a; *(LAS unsigned*)(TBL + r * 32 + 16 + 4 * w) = b;
            }
        }
        float T[16];
#pragma unroll
        for (int i = 0; i < 16; ++i) T[i] = -3.0e38f;
#pragma unroll
        for (int i = 0; i < 16; ++i) {
            const float v1 = __builtin_bit_cast(float, __builtin_bit_cast(unsigned, L1[i]) & ~127u);
#pragma unroll
            for (int j = 0; j < 16; ++j) if ((i + 1) * (j + 1) <= 16) {
                const float v2 = __builtin_bit_cast(float, __builtin_bit_cast(unsigned, L2[j]) & ~127u);
                topk_insert(T, __builtin_bit_cast(float, (__builtin_bit_cast(unsigned, v1 + v2) & ~255u) | (unsigned)(i * 16 + j)));
            }
        }
        LDS_WAIT(); asm volatile("" ::: "memory");
        float ev[16], esum = 0.f;
        const float mx = __builtin_bit_cast(float, __builtin_bit_cast(unsigned, T[0]) & ~255u);
#pragma unroll
        for (int i = 0; i < 16; ++i) { ev[i] = __expf(__builtin_bit_cast(float, __builtin_bit_cast(unsigned, T[i]) & ~255u) - mx); esum += ev[i]; }
        const float einv = 1.0f / esum;
        int eid[8]; float gt[8];
#pragma unroll
        for (int i = 0; i < 8; ++i) { const float tv = h ? T[8 + i] : T[i]; const float e = h ? ev[8 + i] : ev[i];
            const unsigned p = __builtin_bit_cast(unsigned, tv) & 255u;
            const unsigned i1 = *(const LAS unsigned char*)(TBL + r * 32 + (p >> 4)), i2 = *(const LAS unsigned char*)(TBL + r * 32 + 16 + (p & 15u));
            eid[i] = (int)(i1 * 128u + i2); gt[i] = e * einv; }
        int* ip = F.IDX + (size_t)t * NSEL + hd * 16 + 8 * h; float* gp = F.PG + (size_t)t * NSEL + hd * 16 + 8 * h;
        *(GAS v4u*)ip = (v4u){(unsigned)eid[0], (unsigned)eid[1], (unsigned)eid[2], (unsigned)eid[3]}; *(GAS v4u*)(ip + 4) = (v4u){(unsigned)eid[4], (unsigned)eid[5], (unsigned)eid[6], (unsigned)eid[7]};
        *(GAS f32x4*)gp = (f32x4){gt[0], gt[1], gt[2], gt[3]}; *(GAS f32x4*)(gp + 4) = (f32x4){gt[4], gt[5], gt[6], gt[7]};
        LDS_WAIT(); asm volatile("" ::: "memory");
    }
}

DI void p8_alt_phase(Frame& F) {
    const int lane = F.lane;
    const int gw = F.vcu * NWAVES + F.wave, NGW = F.G * NWAVES;
    for (int it = gw; it < (M / 64) * PH; it += NGW) {
        const int tg = it / PH, hd = it % PH, t = tg * 64 + lane;
        float L1[16], L2[16];
#pragma unroll 1
        for (int side = 0; side < 2; ++side) {
            unsigned qw[64];
            const bf16* qp = F.QB + (size_t)t * D + hd * 256 + side * 128;
#pragma unroll
            for (int i = 0; i < 16; ++i) { const v4u w = *(const GAS v4u*)(qp + 8 * i); qw[4 * i] = w.x; qw[4 * i + 1] = w.y; qw[4 * i + 2] = w.z; qw[4 * i + 3] = w.w; }
            float L[16];
#pragma unroll
            for (int i = 0; i < 16; ++i) L[i] = -3.0e38f;
            const float* kb = side ? F.keys2 : F.keys1;
#pragma unroll 1
            for (int key = 0; key < 128; ++key) {
                const float* kr = kb + key * 128; float s = 0.f;
#pragma unroll
                for (int i = 0; i < 64; ++i) s += bflo(qw[i]) * kr[2 * i] + bfhi(qw[i]) * kr[2 * i + 1];
                topk_insert(L, __builtin_bit_cast(float, (__builtin_bit_cast(unsigned, s) & ~127u) | (unsigned)key));
            }
            if (side == 0) {
#pragma unroll
                for (int i = 0; i < 16; ++i) L1[i] = L[i];
            } else {
#pragma unroll
                for (int i = 0; i < 16; ++i) L2[i] = L[i];
            }
        }
        float T[16]; int E[16];
#pragma unroll
        for (int i = 0; i < 16; ++i) { T[i] = -3.0e38f; }
#pragma unroll
        for (int i = 0; i < 16; ++i) {
            const float v1 = __builtin_bit_cast(float, __builtin_bit_cast(unsigned, L1[i]) & ~127u);
#pragma unroll
            for (int j = 0; j < 16; ++j) if ((i + 1) * (j + 1) <= 16) {
                const float v2 = __builtin_bit_cast(float, __builtin_bit_cast(unsigned, L2[j]) & ~127u);
                topk_insert(T, __builtin_bit_cast(float, (__builtin_bit_cast(unsigned, v1 + v2) & ~255u) | (unsigned)(i * 16 + j)));
            }
        }
        float esum = 0.f; float ev[16];
        const float mx = __builtin_bit_cast(float, __builtin_bit_cast(unsigned, T[0]) & ~255u);
#pragma unroll
        for (int i = 0; i < 16; ++i) { ev[i] = __expf(__builtin_bit_cast(float, __builtin_bit_cast(unsigned, T[i]) & ~255u) - mx); esum += ev[i]; }
        const float einv = 1.0f / esum;
#pragma unroll
        for (int i = 0; i < 16; ++i) { const unsigned p = __builtin_bit_cast(unsigned, T[i]) & 255u; unsigned i1 = 0, i2 = 0;
#pragma unroll
            for (int q = 0; q < 16; ++q) { if ((p >> 4) == (unsigned)q) i1 = __builtin_bit_cast(unsigned, L1[q]) & 127u; if ((p & 15u) == (unsigned)q) i2 = __builtin_bit_cast(unsigned, L2[q]) & 127u; }
            E[i] = (int)(i1 * 128u + i2); }
        int* ip = F.IDX + (size_t)t * NSEL + hd * 16; float* gp = F.PG + (size_t)t * NSEL + hd * 16;
#pragma unroll
        for (int i = 0; i < 16; ++i) { ip[i] = E[i]; gp[i] = ev[i] * einv; }
    }
}
template <int STEP> DI void xpose_step_i(int (&v)[64], int lane) {
#pragma unroll
    for (int i = 0; i < STEP; ++i) { const bool up = (lane & STEP) != 0; const int keep = up ? v[i + STEP] : v[i], send = up ? v[i] : v[i + STEP]; v[i] = keep + __shfl_xor(send, STEP); }
}
DI float ub0(unsigned u) { float f; asm("v_cvt_f32_ubyte0 %0, %1" : "=v"(f) : "v"(u)); return f; }
DI float ub1(unsigned u) { float f; asm("v_cvt_f32_ubyte1 %0, %1" : "=v"(f) : "v"(u)); return f; }
DI float ub2(unsigned u) { float f; asm("v_cvt_f32_ubyte2 %0, %1" : "=v"(f) : "v"(u)); return f; }
DI float ub3(unsigned u) { float f; asm("v_cvt_f32_ubyte3 %0, %1" : "=v"(f) : "v"(u)); return f; }
DI void p9_phase(Frame& F) {
    LAS float* A2 = (LAS float*)(F.lds); LAS float* B2 = (LAS float*)(F.lds + 8192); LAS float* GF = (LAS float*)(F.lds + 16384); LAS float* FG = (LAS float*)(F.lds + 24576);
    norm_tables(F, F.norm_ffn_g, MOD_SCF, MOD_SHF);
#pragma unroll
    for (int i = 0; i < 4; ++i) { const int c = F.tid + 512 * i; GF[c] = F.MODF[MOD_GF + c]; FG[c] = F.final_g[c]; }
    __syncthreads();
    const int lane = F.lane, gw = F.vcu * NWAVES + F.wave, NGW = F.G * NWAVES;
#pragma unroll 1
    for (int t = gw; t < M; t += NGW) {
        int hq[8]; float sh;
        {
            float hv[32]; float ss = 0.f;
            const float* xr = F.out + (size_t)t * D + 16 * lane;
#pragma unroll
            for (int jj = 0; jj < 2; ++jj)
#pragma unroll
                for (int q = 0; q < 4; ++q) { const f32x4 a = *(const GAS f32x4*)(xr + 1024 * jj + 4 * q); hv[16 * jj + 4 * q] = a.x; hv[16 * jj + 4 * q + 1] = a.y; hv[16 * jj + 4 * q + 2] = a.z; hv[16 * jj + 4 * q + 3] = a.w; }
#pragma unroll
            for (int i = 0; i < 32; ++i) ss += hv[i] * hv[i];
            const float rstd = 1.0f / sqrtf(wave_sum(ss) * (1.0f / D) + EPS);
            float am = 0.f;
#pragma unroll
            for (int jj = 0; jj < 2; ++jj)
#pragma unroll
                for (int q = 0; q < 4; ++q) { const f32x4 a = *(const LAS f32x4*)(A2 + 1024 * jj + 16 * lane + 4 * q), b = *(const LAS f32x4*)(B2 + 1024 * jj + 16 * lane + 4 * q);
                    const int o = 16 * jj + 4 * q;
                    hv[o] = hv[o] * rstd * a.x + b.x; hv[o + 1] = hv[o + 1] * rstd * a.y + b.y; hv[o + 2] = hv[o + 2] * rstd * a.z + b.z; hv[o + 3] = hv[o + 3] * rstd * a.w + b.w;
                    am = fmaxf(am, fmaxf(fmaxf(fabsf(hv[o]), fabsf(hv[o + 1])), fmaxf(fabsf(hv[o + 2]), fabsf(hv[o + 3])))); }
            am = fmaxf(wave_max(am), 1e-30f); sh = am * (1.0f / 127.0f); const float inv = 127.0f / am;
#pragma unroll
            for (int w = 0; w < 8; ++w) { const int q0 = (int)__builtin_rintf(hv[4 * w] * inv), q1 = (int)__builtin_rintf(hv[4 * w + 1] * inv), q2 = (int)__builtin_rintf(hv[4 * w + 2] * inv), q3 = (int)__builtin_rintf(hv[4 * w + 3] * inv);
                hq[w] = (int)((unsigned)(q0 & 255) | ((unsigned)(q1 & 255) << 8) | ((unsigned)(q2 & 255) << 16) | ((unsigned)(q3 & 255) << 24)); }
        }
        float out[32]; float csum = 0.f;
#pragma unroll
        for (int i = 0; i < 32; ++i) out[i] = 0.f;
#pragma unroll 1
        for (int b = 0; b < 2; ++b) {
            const int myidx = F.IDX[(size_t)t * NSEL + 64 * b + lane]; const float mygate = F.PG[(size_t)t * NSEL + 64 * b + lane];
            const float mysd = F.SD[myidx], mysu = F.SU[myidx];
            int p[64];
#pragma unroll
            for (int k0 = 0; k0 < 64; k0 += 4) {
                v4u w[4][2];
#pragma unroll
                for (int kk = 0; kk < 4; ++kk) { const int e = __builtin_amdgcn_readlane(myidx, k0 + kk); const unsigned char* rowp = F.ED + (size_t)e * D + 16 * lane;
                    w[kk][0] = *(const GAS v4u*)(rowp); w[kk][1] = *(const GAS v4u*)(rowp + 1024); }
#pragma unroll
                for (int kk = 0; kk < 4; ++kk) { int a = 0;
                    a = __builtin_amdgcn_sdot4(hq[0], (int)w[kk][0].x, a, false); a = __builtin_amdgcn_sdot4(hq[1], (int)w[kk][0].y, a, false); a = __builtin_amdgcn_sdot4(hq[2], (int)w[kk][0].z, a, false); a = __builtin_amdgcn_sdot4(hq[3], (int)w[kk][0].w, a, false);
                    a = __builtin_amdgcn_sdot4(hq[4], (int)w[kk][1].x, a, false); a = __builtin_amdgcn_sdot4(hq[5], (int)w[kk][1].y, a, false); a = __builtin_amdgcn_sdot4(hq[6], (int)w[kk][1].z, a, false); a = __builtin_amdgcn_sdot4(hq[7], (int)w[kk][1].w, a, false);
                    p[k0 + kk] = a; }
                asm volatile("" ::: "memory");
            }
            xpose_step_i<32>(p, lane); xpose_step_i<16>(p, lane); xpose_step_i<8>(p, lane); xpose_step_i<4>(p, lane); xpose_step_i<2>(p, lane); xpose_step_i<1>(p, lane);
            const float act = (float)p[0] * (sh * mysd);
            const float coef = mygate * gelu_f(act) * mysu;
            csum += coef;
#pragma unroll 1
            for (int k0 = 0; k0 < 64; k0 += 4) {
                v4u w[4][2]; float c[4];
#pragma unroll
                for (int kk = 0; kk < 4; ++kk) { const int e = __builtin_amdgcn_readlane(myidx, k0 + kk); c[kk] = __builtin_bit_cast(float, __builtin_amdgcn_readlane(__builtin_bit_cast(int, coef), k0 + kk));
                    const unsigned char* rowp = F.EU + (size_t)e * D + 16 * lane;
                    w[kk][0] = *(const GAS v4u*)(rowp); w[kk][1] = *(const GAS v4u*)(rowp + 1024); }
#pragma unroll
                for (int kk = 0; kk < 4; ++kk)
#pragma unroll
                    for (int jj = 0; jj < 2; ++jj) { const v4u u = w[kk][jj]; const int o = 16 * jj; const float cc = c[kk];
                        out[o] += cc * ub0(u.x); out[o + 1] += cc * ub1(u.x); out[o + 2] += cc * ub2(u.x); out[o + 3] += cc * ub3(u.x);
                        out[o + 4] += cc * ub0(u.y); out[o + 5] += cc * ub1(u.y); out[o + 6] += cc * ub2(u.y); out[o + 7] += cc * ub3(u.y);
                        out[o + 8] += cc * ub0(u.z); out[o + 9] += cc * ub1(u.z); out[o + 10] += cc * ub2(u.z); out[o + 11] += cc * ub3(u.z);
                        out[o + 12] += cc * ub0(u.w); out[o + 13] += cc * ub1(u.w); out[o + 14] += cc * ub2(u.w); out[o + 15] += cc * ub3(u.w); }
            }
        }
        const float corr = 128.0f * wave_sum(csum);
        float s2 = 0.f;
        float* orow = F.out + (size_t)t * D + 16 * lane;
#pragma unroll
        for (int jj = 0; jj < 2; ++jj)
#pragma unroll
            for (int q = 0; q < 4; ++q) { const f32x4 g = *(const LAS f32x4*)(GF + 1024 * jj + 16 * lane + 4 * q); const f32x4 xa = *(const GAS f32x4*)(orow + 1024 * jj + 4 * q); const int o = 16 * jj + 4 * q;
                out[o] = xa.x + g.x * (out[o] - corr); out[o + 1] = xa.y + g.y * (out[o + 1] - corr); out[o + 2] = xa.z + g.z * (out[o + 2] - corr); out[o + 3] = xa.w + g.w * (out[o + 3] - corr); }
#pragma unroll
        for (int i = 0; i < 32; ++i) s2 += out[i] * out[i];
        const float rstd2 = 1.0f / sqrtf(wave_sum(s2) * (1.0f / D) + EPS);
#pragma unroll
        for (int jj = 0; jj < 2; ++jj)
#pragma unroll
            for (int q = 0; q < 4; ++q) { const f32x4 f = *(const LAS f32x4*)(FG + 1024 * jj + 16 * lane + 4 * q); const int o = 16 * jj + 4 * q;
                *(GAS f32x4*)(orow + 1024 * jj + 4 * q) = (f32x4){out[o] * rstd2 * f.x, out[o + 1] * rstd2 * f.y, out[o + 2] * rstd2 * f.z, out[o + 3] * rstd2 * f.w}; }
    }
}
struct Args { const float* in[21]; float* out; unsigned char* ws; int ph_lo, ph_hi, li, pad; };
constexpr int N_PHASES = 11;
__global__ void __launch_bounds__(NWAVES * 64, 2) mk_fwd(Args args) {
    extern __shared__ __attribute__((aligned(16))) unsigned char lds[];
    Frame F;
    F.lds = (LAS unsigned char*)lds;
    F.MISC = (volatile LAS unsigned*)(F.lds + MISC_OFF);
    F.tid = threadIdx.x; F.lane = F.tid & 63; F.wave = __builtin_amdgcn_readfirstlane(F.tid >> 6);
    F.G = gridDim.x; { const int bx = blockIdx.x; F.vcu = (F.G % 8 == 0) ? (bx % 8) * (F.G / 8) + bx / 8 : bx; }
    unsigned char* ws = args.ws;
    F.ctl = (gu32*)(ws + WS_CTL);
    F.x = args.in[0]; F.c = args.in[1]; F.ada_w = args.in[2]; F.ada_b = args.in[3]; F.norm_mix_g = args.in[4]; F.w_in = args.in[5]; F.b_gates = args.in[6];
    F.conv_w = args.in[7]; F.conv_b = args.in[8]; F.gmlp_norm_g = args.in[9]; F.gmlp_w = args.in[10]; F.gmlp_b = args.in[11]; F.mlstm_norm_g = args.in[12];
    F.w_out = args.in[13]; F.norm_ffn_g = args.in[14]; F.wq = args.in[15]; F.keys1 = args.in[16]; F.keys2 = args.in[17]; F.e_down = args.in[18]; F.e_up = args.in[19]; F.final_g = args.in[20];
    F.out = args.out;
    F.MODP = (float*)(ws + WS_MODP); F.MODF = (float*)(ws + WS_MODF); F.GATES = (float*)(ws + WS_GATES); F.SUMM = (float*)(ws + WS_SUMM); F.MTAB = (float*)(ws + WS_MTAB);
    F.NST = (float*)(ws + WS_NST); F.PG = (float*)(ws + WS_PG); F.IDX = (int*)(ws + WS_IDX);
    F.WIN = (bf16*)(ws + WS_WIN); F.WOUT = (bf16*)(ws + WS_WOUT); F.WQ = (bf16*)(ws + WS_WQ); F.HA = (bf16*)(ws + WS_HA); F.PROJ = (bf16*)(ws + WS_PROJ); F.QB = (bf16*)(ws + WS_PROJ);
    F.STATE = (bf16*)(ws + WS_STATE); F.ED = ws + WS_ED; F.EU = ws + WS_EU; F.SD = (float*)(ws + WS_SD); F.SU = (float*)(ws + WS_SU);
    F.QC = (bf16*)args.out; F.KC = (bf16*)args.out + (size_t)M * 1024;
    for (int u = F.tid; u < (LDS_BYTES - LDSCTL_OFF) / 4; u += NWAVES * 64) ((LAS unsigned*)(F.lds + LDSCTL_OFF))[u] = 0u;
    __syncthreads();
    const int lo = args.ph_lo, hi = args.ph_hi;
    const bool multi = (hi - lo) > 1;
    XcdBarrier bar; bar.bar = (unsigned*)(F.ctl + CW_BAR) + args.li * XCD_BAR_WORDS; bar.x = 0; bar.st = nullptr;
    if (multi) bar = xcd_barrier_post((unsigned*)(F.ctl + CW_BAR) + args.li * XCD_BAR_WORDS, F.MISC + 8);
#ifndef PH_MASK
#define PH_MASK 0x7ff
#endif
#define IN(k) (((PH_MASK >> (k)) & 1) && lo <= (k) && (k) < hi)
#define SEAM(k) do { if (IN(k) && IN((k) + 1)) xcd_barrier(bar); } while (0)
    if (IN(0)) { p0a_phase(F); } SEAM(0);
    if (IN(1)) { p0b_phase(F); } SEAM(1);
    if (IN(2)) {
        pg8::Gemm g{F.HA, F.WIN, M, NPROJ, D}; pg8::StaticOrder S; S.init(M, NPROJ, F.G, (int)blockIdx.x);
        pg8::EpiProj E{F.PROJ, NPROJ, 2048 / 256};
        pg8::gemm_phase<pg8::EpiProj, pg8::StaticOrder, PG8_ALIGN, PG8_SP2>(F.lds, g, S, E);
    } SEAM(2);
    if (IN(3)) { p2_phase(F); } SEAM(3);
    if (IN(4)) { p3_phase(F); } SEAM(4);
    if (IN(5)) { p4_phase(F); } SEAM(5);
    if (IN(6)) {
        pg8::Gemm g{F.HA, F.WOUT, M, D, D}; pg8::StaticOrder S; S.init(M, D, F.G, (int)blockIdx.x);
        pg8::EpiResid E{F.x, F.MODF + MOD_GM, F.out, D};
        pg8::gemm_phase<pg8::EpiResid, pg8::StaticOrder, PG8_ALIGN, PG8_SP2>(F.lds, g, S, E);
    } SEAM(6);
    if (IN(7)) { p6_phase(F); } SEAM(7);
    if (IN(8)) {
        pg8::Gemm g{F.HA, F.WQ, M, D, D}; pg8::StaticOrder S; S.init(M, D, F.G, (int)blockIdx.x);
        pg8::EpiBf16<0> E{F.QB, D, nullptr, 0, 0, 1.f};
        pg8::gemm_phase<pg8::EpiBf16<0>, pg8::StaticOrder, PG8_ALIGN, PG8_SP2>(F.lds, g, S, E);
    } SEAM(8);
    #ifndef P8_ALT
#define P8_ALT 0
#endif
    if (IN(9)) { if (P8_ALT) p8_alt_phase(F); else p8_phase(F); } SEAM(9);
    if (IN(10)) { p9_phase(F); }
#undef IN
#undef SEAM
}

#ifndef MK_N_LAUNCHES
#define MK_N_LAUNCHES 1
#endif
extern "C" void kernel_launch(void* const* d_in, const int* in_sizes, int n_in, void* d_out, int out_size, void* d_ws, size_t ws_size, hipStream_t stream) {
    static int grid = 0;
    if (grid == 0) {
        if (n_in != 21 || in_sizes[0] != M * D || out_size != M * D || ws_size < WS_END) { fprintf(stderr, "kernel_launch: unexpected shapes (n_in %d, in0 %d, out %d, ws %zu); nothing launched\n", n_in, n_in > 0 ? in_sizes[0] : -1, out_size, ws_size); grid = -1; return; }
        int dev = 0, cus = 0, per_cu = 0;
        if (hipGetDevice(&dev) != hipSuccess || hipDeviceGetAttribute(&cus, hipDeviceAttributeMultiprocessorCount, dev) != hipSuccess) { grid = -1; return; }
        if (hipFuncSetAttribute((const void*)mk_fwd, hipFuncAttributeMaxDynamicSharedMemorySize, LDS_BYTES) != hipSuccess) { fprintf(stderr, "kernel_launch: hipFuncSetAttribute failed\n"); grid = -1; return; }
        if (hipOccupancyMaxActiveBlocksPerMultiprocessor(&per_cu, (const void*)mk_fwd, NWAVES * 64, LDS_BYTES) != hipSuccess || per_cu < 1) { fprintf(stderr, "kernel_launch: occupancy query says %d blocks per CU\n", per_cu); }
        (void)hipGetLastError();
        grid = cus;
    }
    if (grid < 0) return;
    (void)hipMemsetAsync((char*)d_ws + WS_CTL, 0, CTL_ZERO_BYTES, stream);
    Args a{};
    for (int i = 0; i < 21; ++i) a.in[i] = (const float*)d_in[i];
    a.out = (float*)d_out; a.ws = (unsigned char*)d_ws;
    if (MK_N_LAUNCHES == 1) { a.ph_lo = 0; a.ph_hi = N_PHASES; a.li = 0; hipLaunchKernelGGL(mk_fwd, dim3(grid), dim3(NWAVES * 64), LDS_BYTES, stream, a); }
    else for (int li = 0; li < N_PHASES; ++li) { a.ph_lo = li; a.ph_hi = li + 1; a.li = 0; hipLaunchKernelGGL(mk_fwd, dim3(grid), dim3(NWAVES * 64), LDS_BYTES, stream, a); }
}
```

```cpp
#include <hip/hip_runtime.h>
#include <cstdio>
#include <cstdint>
namespace pg8 {
#define PG8_LAS __attribute__((address_space(3)))
typedef unsigned short bf16_t;
typedef short bf16x8 __attribute__((ext_vector_type(8)));
typedef float f32x4 __attribute__((ext_vector_type(4)));
typedef unsigned u32x4 __attribute__((ext_vector_type(4)));
constexpr int BM = 256, BK = 64, HALF = 128, HTB = HALF * BK * 2  , STAGE_BYTES = 8 * HTB, NXCD = 8, WGM = 8;

__host__ __device__ __forceinline__ int lds_byte(int r, int c) { const int st = (r >> 4) * 2 + (c >> 5), rr = r & 15, cc = c & 31, ob = rr * 64 + cc * 2; return st * 1024 + (ob ^ (((ob >> 9) & 1) << 5)); }
__host__ __device__ __forceinline__ void stage_rc(int b, int& R, int& C) { const int st = b / 1024, sb = b % 1024, swz = sb ^ (((sb >> 9) & 1) << 5); R = (st >> 1) * 16 + swz / 64; C = (st & 1) * 32 + (swz % 64) / 2; }
__host__ __device__ __forceinline__ int perm32(int rho) { const int n = rho >> 4, i = rho & 15; return 8 * (i >> 2) + 4 * n + (i & 3); }

struct Unit { int pm, pn; };
struct Gemm { const bf16_t* A; const bf16_t* Bt; int M, N, K; };

struct StaticOrder {
    int nM, nN, nwg, G, c;
    __host__ __device__ void init(int M, int N, int G_, int c_) { nM = M / BM; nN = N / BM; nwg = nM * nN; G = G_; c = c_; }
    __host__ __device__ bool next(int i, Unit& u) const {
        const long L = (long)i * G + c; if (L >= nwg) return false;
        int wgid = (int)L; { const int q = nwg / NXCD, r = nwg % NXCD, xcd = wgid % NXCD, off = wgid / NXCD; wgid = (xcd < r ? xcd * (q + 1) : r * (q + 1) + (xcd - r) * q) + off; }
        const int nig = WGM * nN, gid = wgid / nig, fm = gid * WGM, gsz = (nM - fm) < WGM ? (nM - fm) : WGM;
        u.pm = fm + ((wgid % nig) % gsz); u.pn = (wgid % nig) / gsz; return true;
    }
    __device__ __forceinline__ void a_ready(const Unit&) const {}
    __device__ __forceinline__ void done(const Unit&) const {}
};

__device__ __forceinline__ unsigned cvt_pk_bf16(float lo, float hi) { unsigned r; asm volatile("v_cvt_pk_bf16_f32 %0, %1, %2" : "=v"(r) : "v"(lo), "v"(hi)); return r; }
typedef float f32x2 __attribute__((ext_vector_type(2)));
__device__ __forceinline__ f32x2 gelu_pk(f32x2 v) {
    const f32x2 av = __builtin_elementwise_abs(v), d = av * 0.2316418882f + 1.0f;
    f32x2 t; t.x = __builtin_amdgcn_rcpf(d.x); t.y = __builtin_amdgcn_rcpf(d.y);
    f32x2 q = t * 0.5307027145f + (-0.7265760135f); q = q * t + 0.7107068705f; q = q * t + (-0.142248368f); q = q * t + 0.127414796f; q = q * t;
    const f32x2 s = (v * v) * (-0.72134752044f);
    f32x2 e; e.x = __builtin_amdgcn_exp2f(s.x); e.y = __builtin_amdgcn_exp2f(s.y);
    const f32x2 m = v * (q * e), r = v - m;
    f32x2 o; o.x = v.x < 0.f ? m.x : r.x; o.y = v.y < 0.f ? m.y : r.y; return o;
}

template <int ACT  > struct EpiBf16 {
    static constexpr bool PERM = true, AFTER_DRAIN = false; static_assert(ACT == 0 || ACT == 1, "EpiBf16: ACT is 0 (none) or 1 (gelu_pk)");
    bf16_t* O; int ldc; const float* bias; int split_cols; size_t split_stride; float scale0;
    __device__ __forceinline__ void operator()(const f32x4 (&acc)[2][2][4][2], const Unit& u, int wr, int wc, int fr, int fq) const {
        const int row0 = u.pm * BM + wr * 64 + fr; int colt = u.pn * BM; bf16_t* base = O;
        float sc = 1.f; if (split_cols) { const int t = colt / split_cols; base += (size_t)t * split_stride; colt -= t * split_cols; if (t == 0) sc = scale0; }
        const int col0 = colt + wc * 32 + 8 * fq, bcol0 = u.pn * BM + wc * 32 + 8 * fq;
        f32x4 bv[2][2];
#pragma unroll
        for (int bj = 0; bj < 2; ++bj)
#pragma unroll
            for (int n = 0; n < 2; ++n) bv[bj][n] = bias ? *(const f32x4*)(bias + bcol0 + bj * HALF + 4 * n) : (f32x4){0.f, 0.f, 0.f, 0.f};
#pragma unroll
        for (int ai = 0; ai < 2; ++ai)
#pragma unroll
            for (int m = 0; m < 4; ++m) { bf16_t* rowp = base + (size_t)(row0 + ai * HALF + m * 16) * ldc + col0;
#pragma unroll
                for (int bj = 0; bj < 2; ++bj) { f32x4 v0 = acc[ai][bj][m][0] + bv[bj][0], v1 = acc[ai][bj][m][1] + bv[bj][1];
                    if (ACT == 1) { f32x2 a = gelu_pk((f32x2){v0[0], v0[1]}), b = gelu_pk((f32x2){v0[2], v0[3]}), c = gelu_pk((f32x2){v1[0], v1[1]}), d = gelu_pk((f32x2){v1[2], v1[3]});
                        v0 = (f32x4){a.x, a.y, b.x, b.y}; v1 = (f32x4){c.x, c.y, d.x, d.y}; }
                    v0 = v0 * sc; v1 = v1 * sc; u32x4 w; w.x = cvt_pk_bf16(v0[0], v0[1]); w.y = cvt_pk_bf16(v0[2], v0[3]); w.z = cvt_pk_bf16(v1[0], v1[1]); w.w = cvt_pk_bf16(v1[2], v1[3]);
                    *(u32x4*)(rowp + bj * HALF) = w; } }
    }
};

template <class Epi, class Sched, bool ALIGN_EPI = false, bool SP2 = false>
__device__ __forceinline__ void gemm_phase(PG8_LAS unsigned char* lds, const Gemm g, const Sched& S, const Epi& E) {
    const int tid = threadIdx.x, wid = __builtin_amdgcn_readfirstlane(tid >> 6), lane = tid & 63, wr = wid >> 2, wc = wid & 3, fr = lane & 15, fq = lane >> 4;
    const int K = g.K, nt = K / BK;
    unsigned voffA[2], voffB[2];
#pragma unroll
    for (int i = 0; i < 2; ++i) { int R, C; stage_rc(tid * 16 + i * 8192, R, C); const int Rb = Epi::PERM ? ((R & ~31) + perm32(R & 31)) : R;
        voffA[i] = (unsigned)(R * K + C) * 2u; voffB[i] = (unsigned)(Rb * K + C) * 2u; }
    const size_t kstep = (size_t)(BK * 2);
    const size_t hstep = (size_t)HALF * K * 2;
    const size_t tstep = 2 * hstep;
    const unsigned ldsw = (unsigned)wid * 1024u;
    const int aoff = lds_byte(wr * 64 + fr, fq * 8), boff = lds_byte(wc * 32 + fr, fq * 8);
#define PG8_SA(b, h) (((b) * 2 + (h)) * HTB)
#define PG8_SB(b, h) ((4 + (b) * 2 + (h)) * HTB)
#define PG8_STAGE(bufoff, gbase, voff) do { _Pragma("unroll") for (int _i = 0; _i < 2; ++_i) \
        __builtin_amdgcn_global_load_lds((const unsigned*)((const char*)(gbase) + (voff)[_i]), (PG8_LAS unsigned*)(lds + (bufoff) + ldsw + _i * 8192), 16, 0, 0); } while (0)
#define PG8_LDA(dst, b, h) do { _Pragma("unroll") for (int m = 0; m < 4; ++m) _Pragma("unroll") for (int k = 0; k < 2; ++k) dst[m][k] = *(const PG8_LAS bf16x8*)(lds + PG8_SA(b, h) + aoff + m * 2048 + k * 1024); } while (0)
#define PG8_LDB(dst, b, h) do { _Pragma("unroll") for (int n = 0; n < 2; ++n) _Pragma("unroll") for (int k = 0; k < 2; ++k) dst[n][k] = *(const PG8_LAS bf16x8*)(lds + PG8_SB(b, h) + boff + n * 2048 + k * 1024); } while (0)
#define PG8_MMA(ai, bj, At, Bt) do { __builtin_amdgcn_s_setprio(1); _Pragma("unroll") for (int m = 0; m < 4; ++m) _Pragma("unroll") for (int n = 0; n < 2; ++n) _Pragma("unroll") for (int k = 0; k < 2; ++k) \
        acc[ai][bj][m][n] = __builtin_amdgcn_mfma_f32_16x16x32_bf16(Bt[n][k], At[m][k], acc[ai][bj][m][n], 0, 0, 0); __builtin_amdgcn_s_setprio(0); } while (0)
#define PG8_WAIT_V(n) asm volatile("s_waitcnt vmcnt(" #n ")" ::: "memory")
#define PG8_WAIT_L(n) asm volatile("s_waitcnt lgkmcnt(" #n ")" ::: "memory")
#define PG8_BAR __builtin_amdgcn_s_barrier()
#define PG8_SCHED __builtin_amdgcn_sched_barrier(0)
    Unit cur, nxt; int ui = 0;
    if (!S.next(0, cur)) return;
    f32x4 acc[2][2][4][2];
#pragma unroll
    for (int a = 0; a < 2; ++a)
#pragma unroll
        for (int b = 0; b < 2; ++b)
#pragma unroll
            for (int m = 0; m < 4; ++m)
#pragma unroll
                for (int n = 0; n < 2; ++n) acc[a][b][m][n] = (f32x4){0.f, 0.f, 0.f, 0.f};
    bf16x8 At[4][2], B0[2][2], B1[2][2];
    const char* cA = (const char*)g.A + (size_t)cur.pm * tstep; const char* cB = (const char*)g.Bt + (size_t)cur.pn * tstep;
    S.a_ready(cur);
    if constexpr (SP2) {
        PG8_STAGE(PG8_SB(0, 0), cB, voffB); PG8_STAGE(PG8_SB(0, 1), cB + hstep, voffB); PG8_STAGE(PG8_SA(0, 0), cA, voffA); PG8_STAGE(PG8_SA(0, 1), cA + hstep, voffA);
        if (wr == 1) PG8_BAR;
        PG8_WAIT_V(2); PG8_BAR;
        PG8_STAGE(PG8_SB(1, 0), cB + kstep, voffB); PG8_STAGE(PG8_SA(1, 0), cA + kstep, voffA); PG8_STAGE(PG8_SB(1, 1), cB + hstep + kstep, voffB);
        PG8_WAIT_V(6); PG8_BAR;
    } else {
        PG8_STAGE(PG8_SB(0, 0), cB, voffB); PG8_STAGE(PG8_SA(0, 0), cA, voffA); PG8_STAGE(PG8_SB(0, 1), cB + hstep, voffB); PG8_STAGE(PG8_SA(0, 1), cA + hstep, voffA);
        if (wr == 1) PG8_BAR;
        PG8_WAIT_V(4); PG8_BAR;
        PG8_STAGE(PG8_SB(1, 0), cB + kstep, voffB); PG8_STAGE(PG8_SA(1, 0), cA + kstep, voffA); PG8_STAGE(PG8_SB(1, 1), cB + hstep + kstep, voffB);
        PG8_WAIT_V(6); PG8_BAR;
    }
    for (;;) {
        const bool has_next = S.next(ui + 1, nxt);
        const char* nA = has_next ? (const char*)g.A + (size_t)nxt.pm * tstep : cA; const char* nB = has_next ? (const char*)g.Bt + (size_t)nxt.pn * tstep : cB;
        for (int t = 0; t < nt; t += 2) {
            const bool last = (t == nt - 2);
            const char* a1 = cA + (size_t)(t + 1) * kstep;
            const char* a2 = last ? nA : cA + (size_t)(t + 2) * kstep; const char* b2 = last ? nB : cB + (size_t)(t + 2) * kstep;
            const char* a3 = a2 + kstep; const char* b3 = b2 + kstep;
            if (last && has_next) S.a_ready(nxt);
            if constexpr (SP2) {
            PG8_LDB(B0, 0, 0); PG8_LDB(B1, 0, 1); PG8_SCHED; PG8_LDA(At, 0, 0); PG8_STAGE(PG8_SA(1, 1), a1 + hstep, voffA);
            PG8_WAIT_V(8); PG8_WAIT_L(0); PG8_BAR; PG8_MMA(0, 0, At, B0); PG8_MMA(0, 1, At, B1); PG8_BAR; PG8_SCHED;
            PG8_LDA(At, 0, 1); PG8_STAGE(PG8_SB(0, 0), b2, voffB); PG8_STAGE(PG8_SB(0, 1), b2 + hstep, voffB); PG8_STAGE(PG8_SA(0, 0), a2, voffA);
            PG8_WAIT_V(8); PG8_WAIT_L(0); PG8_BAR; PG8_MMA(1, 0, At, B0); PG8_MMA(1, 1, At, B1); PG8_BAR; PG8_SCHED;
            PG8_LDB(B0, 1, 0); PG8_LDB(B1, 1, 1); PG8_SCHED; PG8_LDA(At, 1, 0); PG8_STAGE(PG8_SA(0, 1), a2 + hstep, voffA);
            PG8_WAIT_V(8); PG8_WAIT_L(0); PG8_BAR; PG8_MMA(0, 0, At, B0); PG8_MMA(0, 1, At, B1); PG8_BAR; PG8_SCHED;
            PG8_LDA(At, 1, 1); PG8_STAGE(PG8_SB(1, 0), b3, voffB); PG8_STAGE(PG8_SB(1, 1), b3 + hstep, voffB); PG8_STAGE(PG8_SA(1, 0), a3, voffA);
            PG8_WAIT_V(8); PG8_WAIT_L(0); PG8_BAR; PG8_MMA(1, 0, At, B0); PG8_MMA(1, 1, At, B1); PG8_BAR; PG8_SCHED;
            } else {
            PG8_LDB(B0, 0, 0); PG8_SCHED; PG8_LDA(At, 0, 0); PG8_STAGE(PG8_SA(1, 1), a1 + hstep, voffA);
            PG8_WAIT_L(8); PG8_BAR; PG8_WAIT_L(0); PG8_MMA(0, 0, At, B0); PG8_BAR; PG8_SCHED;
            PG8_LDB(B1, 0, 1); PG8_STAGE(PG8_SB(0, 0), b2, voffB);
            PG8_BAR; PG8_WAIT_L(0); PG8_MMA(0, 1, At, B1); PG8_BAR;
            PG8_LDA(At, 0, 1); PG8_STAGE(PG8_SA(0, 0), a2, voffA);
            PG8_BAR; PG8_WAIT_L(0); PG8_MMA(1, 0, At, B0); PG8_BAR; PG8_SCHED;
            PG8_STAGE(PG8_SB(0, 1), b2 + hstep, voffB);
            PG8_WAIT_V(6); PG8_BAR; PG8_MMA(1, 1, At, B1); PG8_BAR;
            PG8_LDB(B0, 1, 0); PG8_SCHED; PG8_LDA(At, 1, 0); PG8_STAGE(PG8_SA(0, 1), a2 + hstep, voffA);
            PG8_WAIT_L(8); PG8_BAR; PG8_WAIT_L(0); PG8_MMA(0, 0, At, B0); PG8_BAR; PG8_SCHED;
            PG8_LDB(B1, 1, 1); PG8_STAGE(PG8_SB(1, 0), b3, voffB);
            PG8_BAR; PG8_WAIT_L(0); PG8_MMA(0, 1, At, B1); PG8_BAR;
            PG8_LDA(At, 1, 1); PG8_STAGE(PG8_SA(1, 0), a3, voffA);
            PG8_BAR; PG8_WAIT_L(0); PG8_MMA(1, 0, At, B0); PG8_BAR; PG8_SCHED;
            PG8_STAGE(PG8_SB(1, 1), b3 + hstep, voffB);
            PG8_WAIT_V(6); PG8_BAR; PG8_MMA(1, 1, At, B1); PG8_BAR;
            }
        }
        if constexpr (ALIGN_EPI) { if (wr == 0) PG8_BAR; }
        if constexpr (!Epi::AFTER_DRAIN) { E(acc, cur, wr, wc, fr, fq); S.done(cur); }
        if (!has_next) break;
#pragma unroll
        for (int a = 0; a < 2; ++a)
#pragma unroll
            for (int b = 0; b < 2; ++b)
#pragma unroll
                for (int m = 0; m < 4; ++m)
#pragma unroll
                    for (int n = 0; n < 2; ++n) acc[a][b][m][n] = (f32x4){0.f, 0.f, 0.f, 0.f};
        cur = nxt; cA = nA; cB = nB; ++ui;
        if constexpr (ALIGN_EPI) { if (wr == 1) PG8_BAR; }
    }
    PG8_WAIT_V(0);
    if constexpr (!ALIGN_EPI) { if (wr == 0) PG8_BAR; }
    PG8_BAR;
    if constexpr (Epi::AFTER_DRAIN) { E.fused(acc, cur, wr, wc, fr, fq, lds, wid, lane); S.done(cur); }
#undef PG8_SA
#undef PG8_SB
#undef PG8_STAGE
#undef PG8_LDA
#undef PG8_LDB
#undef PG8_MMA
#undef PG8_WAIT_V
#undef PG8_WAIT_L
#undef PG8_BAR
#undef PG8_SCHED
}
}
namespace pg8 {
struct EpiProj {
    static constexpr bool PERM = true, AFTER_DRAIN = false;
    bf16_t* O; int ldc; int gelu_tiles;
    __device__ __forceinline__ void operator()(const f32x4 (&acc)[2][2][4][2], const Unit& u, int wr, int wc, int fr, int fq) const {
        const int row0 = u.pm * BM + wr * 64 + fr; const int col0 = u.pn * BM + wc * 32 + 8 * fq;
        const bool act = u.pn < gelu_tiles;
#pragma unroll
        for (int ai = 0; ai < 2; ++ai)
#pragma unroll
            for (int m = 0; m < 4; ++m) { bf16_t* rowp = O + (size_t)(row0 + ai * HALF + m * 16) * ldc + col0;
#pragma unroll
                for (int bj = 0; bj < 2; ++bj) { f32x4 v0 = acc[ai][bj][m][0], v1 = acc[ai][bj][m][1];
                    if (act) { f32x2 a = gelu_pk((f32x2){v0[0], v0[1]}), b = gelu_pk((f32x2){v0[2], v0[3]}), c = gelu_pk((f32x2){v1[0], v1[1]}), d = gelu_pk((f32x2){v1[2], v1[3]});
                        v0 = (f32x4){a.x, a.y, b.x, b.y}; v1 = (f32x4){c.x, c.y, d.x, d.y}; }
                    u32x4 w; w.x = cvt_pk_bf16(v0[0], v0[1]); w.y = cvt_pk_bf16(v0[2], v0[3]); w.z = cvt_pk_bf16(v1[0], v1[1]); w.w = cvt_pk_bf16(v1[2], v1[3]);
                    *(u32x4*)(rowp + bj * HALF) = w; } }
    }
};
struct EpiResid {
    static constexpr bool PERM = false, AFTER_DRAIN = false;
    const float* base; const float* gate; float* out; int ldc;
    __device__ __forceinline__ void operator()(const f32x4 (&acc)[2][2][4][2], const Unit& u, int wr, int wc, int fr, int fq) const {
        const int row0 = u.pm * BM + wr * 64 + fr, col0 = u.pn * BM + wc * 32 + 4 * fq;
        f32x4 gv[2][2];
#pragma unroll
        for (int bj = 0; bj < 2; ++bj)
#pragma unroll
            for (int n = 0; n < 2; ++n) gv[bj][n] = *(const f32x4*)(gate + col0 + bj * HALF + n * 16);
#pragma unroll
        for (int ai = 0; ai < 2; ++ai)
#pragma unroll
            for (int m = 0; m < 4; ++m) { const size_t off = (size_t)(row0 + ai * HALF + m * 16) * ldc + col0;
#pragma unroll
                for (int bj = 0; bj < 2; ++bj)
#pragma unroll
                    for (int n = 0; n < 2; ++n) { const f32x4 b = *(const f32x4*)(base + off + bj * HALF + n * 16); *(f32x4*)(out + off + bj * HALF + n * 16) = b + gv[bj][n] * acc[ai][bj][m][n]; } }
    }
};
}
#ifndef PG8_SP2
#define PG8_SP2 true
#endif
#ifndef PG8_ALIGN
#define PG8_ALIGN true
#endif
constexpr int NWAVES = 8;
constexpr int M = 16384, D = 2048;
constexpr int IN_COLS = 6152, NPROJ = 6144;
constexpr int C_UG = 0, C_VG = 1024, C_Q = 2048, C_K = 3072, C_VM = 4096, C_OM = 5120;
constexpr int NHEAD = 4, DH = 256, CH = 128, NCHUNK = M / CH;
constexpr int NEXP = 16384, PH = 8, TOPK = 16, NSEL = PH * TOPK;
constexpr float EPS = 1e-6f;
constexpr int MOD_SHM = 0, MOD_SCM = 2048, MOD_GM = 4096, MOD_SHF = 6144, MOD_SCF = 8192, MOD_GF = 10240, NMOD = 12288;
constexpr int ADA_KC = 16, ADA_KROWS = D / ADA_KC;

constexpr size_t MiB = 1u << 20;
constexpr size_t WS_CTL = 0, CTL_ZERO_BYTES = 1 * MiB;
constexpr size_t WS_MODP = 1 * MiB;
constexpr size_t WS_MODF = WS_MODP + (size_t)ADA_KC * NMOD * 4;
constexpr size_t WS_GATES = 2 * MiB;
constexpr size_t WS_SUMM = 2 * MiB + 512 * 1024;
constexpr size_t WS_MTAB = WS_SUMM + 8192;
constexpr size_t WS_NST = 3 * MiB;
constexpr size_t WS_WIN = 4 * MiB;
constexpr size_t WS_WOUT = 28 * MiB;
constexpr size_t WS_WQ = 36 * MiB;
constexpr size_t WS_IDX = 44 * MiB;
constexpr size_t WS_PG = 52 * MiB;
constexpr size_t WS_HA = 64 * MiB;
constexpr size_t WS_PROJ = 128 * MiB;
constexpr size_t WS_STATE = 320 * MiB;
constexpr size_t WS_ED = 384 * MiB, WS_EU = 416 * MiB;
constexpr size_t WS_SD = 3 * MiB + 512 * 1024, WS_SU = WS_SD + 65536;
constexpr size_t WS_END = 512 * MiB;
constexpr int CW_TMO = 0, CW_CODE = 1, CW_BAR = 4096;

constexpr int RING_BYTES = 131072, LDSCTL_OFF = 151552, MISC_OFF = LDSCTL_OFF + 320, LDS_BYTES = 163840;

#define GAS __attribute__((address_space(1)))
#define LAS __attribute__((address_space(3)))
#define DI __device__ __forceinline__
typedef unsigned short bf16;
typedef unsigned v4u __attribute__((ext_vector_type(4)));
typedef unsigned v2u __attribute__((ext_vector_type(2)));
typedef float f32x4 __attribute__((ext_vector_type(4)));
typedef float f32x16 __attribute__((ext_vector_type(16)));
typedef short bf16x8 __attribute__((ext_vector_type(8)));
typedef GAS unsigned gu32;
#define RLX_AGENT __ATOMIC_RELAXED, __HIP_MEMORY_SCOPE_AGENT
#define LDS_WAIT() asm volatile("s_waitcnt lgkmcnt(0)" ::: "memory")
#define VM_WAIT() asm volatile("s_waitcnt vmcnt(0)" ::: "memory")
#define MFMA32(a, b, c) __builtin_amdgcn_mfma_f32_32x32x16_bf16((a), (b), (c), 0, 0, 0)
DI unsigned f2bf(float f) { unsigned u = __builtin_bit_cast(unsigned, f); return (u + 0x7fffu + ((u >> 16) & 1u)) >> 16; }
DI unsigned pk2(float lo, float hi) { return f2bf(lo) | (f2bf(hi) << 16); }
DI float bflo(unsigned w) { return __builtin_bit_cast(float, w << 16); }
DI float bfhi(unsigned w) { return __builtin_bit_cast(float, w & 0xffff0000u); }
DI float bf2f(unsigned short h) { return __builtin_bit_cast(float, (unsigned)h << 16); }
DI int crow(int reg, int h) { return (reg & 3) + 8 * (reg >> 2) + 4 * h; }
DI float wave_sum(float v) {
#pragma unroll
    for (int o = 1; o < 64; o <<= 1) v += __shfl_xor(v, o);
    return v;
}
DI float wave_max(float v) {
#pragma unroll
    for (int o = 1; o < 64; o <<= 1) v = fmaxf(v, __shfl_xor(v, o));
    return v;
}
DI float silu_f(float v) { return v / (1.0f + __expf(-v)); }
DI float sigmoid_f(float v) { return 1.0f / (1.0f + __expf(-v)); }
DI float gelu_f(float v) { return 0.5f * v * (1.0f + erff(v * 0.70710678118654752f)); }
typedef __bf16 bf16v2 __attribute__((ext_vector_type(2)));
#define DOT2(a, b, c) __builtin_amdgcn_fdot2_f32_bf16(__builtin_bit_cast(bf16v2, (unsigned)(a)), __builtin_bit_cast(bf16v2, (unsigned)(b)), (c), false)
DI f32x16 zero16() { f32x16 z; for (int i = 0; i < 16; ++i) z[i] = 0.f; return z; }
#define XB_TMO      128
#define XB_XCNT(j)  (256  + 64 * (j))
#define XB_XSUB(j)  (1280 + 64 * (j))
#define XB_XGEN(j)  (2304 + 64 * (j))
#define XB_TOP      3328
#define XB_TOPGEN   3392
#define XCD_BAR_WORDS 3456
#define XB_SPIN_CAP (1u << 18)

__device__ __forceinline__ unsigned xb_ld(unsigned* p)              { return __hip_atomic_load(p, __ATOMIC_RELAXED, __HIP_MEMORY_SCOPE_AGENT); }
__device__ __forceinline__ unsigned xb_add(unsigned* p, unsigned v) { return __hip_atomic_fetch_add(p, v, __ATOMIC_RELAXED, __HIP_MEMORY_SCOPE_AGENT); }
__device__ __forceinline__ unsigned xb_xcc_id() { return (unsigned)__builtin_amdgcn_s_getreg((3 << 11) | 20) & 0xFu; }
#define XB_SPIN(cond, bar) do { unsigned _sp = 0; while (cond) { __builtin_amdgcn_s_sleep(1); \
    if ((++_sp & 255u) == 0u) { if (xb_ld(&(bar)[XB_TMO])) break; if (_sp > XB_SPIN_CAP) { atomicAdd(&(bar)[XB_TMO], 1u); break; } } } } while (0)

struct XcdBarrier {
    unsigned* bar; unsigned x;
    volatile LAS unsigned* st;
};

__device__ __forceinline__ XcdBarrier xcd_barrier_post(unsigned* bar, volatile LAS unsigned* st) {
    XcdBarrier b; b.bar = bar; b.x = xb_xcc_id(); b.st = st;
    if (threadIdx.x == 0) (void)xb_add(&bar[XB_XCNT(b.x)], 1u);
    return b;
}
__device__ __forceinline__ void xcd_barrier_complete(unsigned* bar, unsigned x, unsigned& nloc, unsigned& nx) {
    const unsigned G = gridDim.x * gridDim.y * gridDim.z;
    unsigned sum, cnt, mine, sp = 0u;
    for (;;) {
        sum = 0u; cnt = 0u; mine = 0u;
#pragma unroll
        for (unsigned j = 0; j < 16; ++j) { const unsigned c = xb_ld(&bar[XB_XCNT(j)]); sum += c; cnt += (c > 0u) ? 1u : 0u; mine = (j == x) ? c : mine; }
        if (sum == G) break;
        __builtin_amdgcn_s_sleep(1);
        if ((++sp & 255u) == 0u) { if (xb_ld(&bar[XB_TMO])) break; if (sp > XB_SPIN_CAP) { atomicAdd(&bar[XB_TMO], 1u); break; } }
    }
    nloc = mine > 0u ? mine : 1u; nx = cnt > 0u ? cnt : 1u;
}

__device__ __forceinline__ void xcd_barrier(const XcdBarrier& b) {
    asm volatile("s_waitcnt vmcnt(0)" ::: "memory");
    __syncthreads();
    if (threadIdx.x == 0) {
        unsigned* bar = b.bar;
        __builtin_amdgcn_s_waitcnt(0);
        unsigned nloc = b.st[0], nx = b.st[1];
        if (nloc == 0u) { xcd_barrier_complete(bar, b.x, nloc, nx); b.st[0] = nloc; b.st[1] = nx; }
        const unsigned old = xb_add(&bar[XB_XSUB(b.x)], 1u);
        const unsigned gen = old / nloc;
        if (old + 1u == (gen + 1u) * nloc) {
            __builtin_amdgcn_fence(__ATOMIC_RELEASE, "agent");
            asm volatile("s_waitcnt vmcnt(0)" ::: "memory");
            const unsigned og = xb_add(&bar[XB_TOP], 1u);
            const unsigned tg = og / nx;
            if (og + 1u == (tg + 1u) * nx) xb_add(&bar[XB_TOPGEN], 1u);
            else XB_SPIN(xb_ld(&bar[XB_TOPGEN]) == tg, bar);
            __builtin_amdgcn_fence(__ATOMIC_ACQUIRE, "agent");
            xb_add(&bar[XB_XGEN(b.x)], 1u);
            asm volatile("s_waitcnt vmcnt(0)" ::: "memory");
        } else {
            XB_SPIN(xb_ld(&bar[XB_XGEN(b.x)]) == gen, bar);
            __builtin_amdgcn_fence(__ATOMIC_ACQUIRE, "agent");
            asm volatile("s_waitcnt vmcnt(0)" ::: "memory");
        }
    }
    __syncthreads();
}
struct Frame {
    LAS unsigned char* lds;
    volatile LAS unsigned* MISC;
    gu32* ctl;
    int tid, lane, wave, vcu, G;
    const float *x, *c, *ada_w, *ada_b, *norm_mix_g, *w_in, *b_gates, *conv_w, *conv_b, *gmlp_norm_g, *gmlp_w, *gmlp_b, *mlstm_norm_g, *w_out, *norm_ffn_g,
                *wq, *keys1, *keys2, *e_down, *e_up, *final_g;
    float* out;
    float *MODP, *MODF, *GATES, *SUMM, *MTAB, *NST, *PG;
    int* IDX;
    bf16 *WIN, *WOUT, *WQ, *HA, *PROJ, *QB, *STATE, *QC, *KC;
    unsigned char *ED, *EU; float *SD, *SU;
};

DI void p0_transpose_item(const float* W, int K, int ldw, int nblk, bf16* WT, LAS float* scr, int item, int lane) {
    const int kb = item / nblk, nb = item % nblk, k0 = 64 * kb, n0 = 32 * nb;
#pragma unroll 8
    for (int i = 0; i < 32; ++i) { const int kk = 2 * i + (lane >> 5); scr[kk * 33 + (lane & 31)] = W[(size_t)(k0 + kk) * ldw + n0 + (lane & 31)]; }
    LDS_WAIT(); asm volatile("" ::: "memory");
    const int c = lane & 7;
#pragma unroll
    for (int j = 0; j < 4; ++j) { const int n = (lane >> 3) + 8 * j; const LAS float* s = scr + (8 * c) * 33 + n;
        v4u o; o.x = pk2(s[0 * 33], s[1 * 33]); o.y = pk2(s[2 * 33], s[3 * 33]); o.z = pk2(s[4 * 33], s[5 * 33]); o.w = pk2(s[6 * 33], s[7 * 33]);
        *(GAS v4u*)(WT + (size_t)(n0 + n) * K + k0 + 8 * c) = o; }
    LDS_WAIT(); asm volatile("" ::: "memory");
}
DI void p0_ada_item(Frame& F, LAS float* scr, int item) {
    const int cc = item % (NMOD / 256), kc = item / (NMOD / 256), k0 = kc * ADA_KROWS, col = cc * 256 + F.lane * 4;
#pragma unroll
    for (int j = 0; j < ADA_KROWS / 64; ++j) scr[F.lane + 64 * j] = silu_f(F.c[k0 + F.lane + 64 * j]);
    LDS_WAIT(); asm volatile("" ::: "memory");
    f32x4 acc = {0.f, 0.f, 0.f, 0.f};
    const float* wp = F.ada_w + (size_t)k0 * NMOD + col;
#pragma unroll 8
    for (int kk = 0; kk < ADA_KROWS; ++kk) { const float s = scr[kk]; const f32x4 w = *(const GAS f32x4*)(wp + (size_t)kk * NMOD); acc += w * s; }
    *(GAS f32x4*)(F.MODP + (size_t)kc * NMOD + col) = acc;
    LDS_WAIT(); asm volatile("" ::: "memory");
}
DI void p0a_phase(Frame& F) {
    LAS float* scr = (LAS float*)(F.lds + F.wave * 16384);
    const int gw = F.vcu * NWAVES + F.wave, NGW = F.G * NWAVES;
    constexpr int I_ADA = (NMOD / 256) * ADA_KC;
    constexpr int I_WIN = (D / 64) * (NPROJ / 32), I_WO = (D / 64) * (D / 32), I_WQ = I_WO;
    constexpr int NITEMS = I_ADA + I_WIN + I_WO + I_WQ;
    for (int it = gw; it < NITEMS; it += NGW) {
        int r = it;
        if (r < I_ADA) { p0_ada_item(F, scr, r); continue; } r -= I_ADA;
        if (r < I_WIN) { p0_transpose_item(F.w_in, D, IN_COLS, NPROJ / 32, F.WIN, scr, r, F.lane); continue; } r -= I_WIN;
        if (r < I_WO) { p0_transpose_item(F.w_out, D, D, D / 32, F.WOUT, scr, r, F.lane); continue; } r -= I_WO;
        p0_transpose_item(F.wq, D, D, D / 32, F.WQ, scr, r, F.lane);
    }
#pragma unroll 1
    for (int row = gw; row < 2 * NEXP; row += NGW) {
        const int tb = row >= NEXP, e = row - tb * NEXP;
        const GAS f32x4* src = (const GAS f32x4*)((tb ? F.e_up : F.e_down) + (size_t)e * D) + F.lane;
        f32x4 v[8]; float am = 0.f;
#pragma unroll
        for (int j = 0; j < 8; ++j) { v[j] = src[64 * j]; am = fmaxf(am, fmaxf(fmaxf(fabsf(v[j].x), fabsf(v[j].y)), fmaxf(fabsf(v[j].z), fabsf(v[j].w)))); }
        am = fmaxf(wave_max(am), 1e-30f);
        const float sc = am * (1.0f / 127.0f), inv = 127.0f / am;
        GAS unsigned* dst = (GAS unsigned*)((tb ? F.EU : F.ED) + (size_t)e * D) + F.lane;
        const int off = tb ? 128 : 0;
#pragma unroll
        for (int j = 0; j < 8; ++j) {
            const int q0 = (int)__builtin_rintf(v[j].x * inv) + off, q1 = (int)__builtin_rintf(v[j].y * inv) + off, q2 = (int)__builtin_rintf(v[j].z * inv) + off, q3 = (int)__builtin_rintf(v[j].w * inv) + off;
            dst[64 * j] = (unsigned)(q0 & 255) | ((unsigned)(q1 & 255) << 8) | ((unsigned)(q2 & 255) << 16) | ((unsigned)(q3 & 255) << 24);
        }
        if (F.lane == 0) (tb ? F.SU : F.SD)[e] = sc;
    }
}
DI float mod_final(Frame& F, int col) { float s = F.ada_b[col];
#pragma unroll
    for (int k = 0; k < ADA_KC; ++k) s += F.MODP[(size_t)k * NMOD + col];
    return s; }
DI void norm_tables(Frame& F, const float* g, int col_scale, int col_shift) {
    LAS float* A1 = (LAS float*)(F.lds); LAS float* B1 = (LAS float*)(F.lds + 8192);
#pragma unroll
    for (int i = 0; i < 4; ++i) { const int c = F.tid + 512 * i; A1[c] = g[c] * (1.0f + F.MODF[col_scale + c]); B1[c] = F.MODF[col_shift + c]; }
}
DI void p0b_phase(Frame& F) {
    LAS float* A1 = (LAS float*)(F.lds); LAS float* B1 = (LAS float*)(F.lds + 8192); LAS float* WG = (LAS float*)(F.lds + 16384);
#pragma unroll
    for (int i = 0; i < 4; ++i) { const int c = F.tid + 512 * i; A1[c] = F.norm_mix_g[c] * (1.0f + mod_final(F, MOD_SCM + c)); B1[c] = mod_final(F, MOD_SHM + c); }
    { const int per = (NMOD + F.G - 1) / F.G; const int c = (int)blockIdx.x * per + F.tid; if (F.tid < per && c < NMOD) F.MODF[c] = mod_final(F, c); }
#pragma unroll
    for (int i = 0; i < 4; ++i) { const int k = F.tid + 512 * i; const f32x4 a = *(const GAS f32x4*)(F.w_in + (size_t)k * IN_COLS + NPROJ), b = *(const GAS f32x4*)(F.w_in + (size_t)k * IN_COLS + NPROJ + 4);
        WG[0 * 2048 + k] = a.x; WG[1 * 2048 + k] = a.y; WG[2 * 2048 + k] = a.z; WG[3 * 2048 + k] = a.w; WG[4 * 2048 + k] = b.x; WG[5 * 2048 + k] = b.y; WG[6 * 2048 + k] = b.z; WG[7 * 2048 + k] = b.w; }
    __syncthreads();
    const int rows_per_blk = M / F.G, rows_per_wave = rows_per_blk / NWAVES;
    const int r0 = F.vcu * rows_per_blk + F.wave * rows_per_wave;
    for (int rr = 0; rr < rows_per_wave; ++rr) {
        const int row = r0 + rr;
        const GAS f32x4* xr = (const GAS f32x4*)(F.x + (size_t)row * D) + F.lane;
        f32x4 v[8]; float ss = 0.f;
#pragma unroll
        for (int j = 0; j < 8; ++j) { v[j] = xr[64 * j]; ss += (v[j].x * v[j].x + v[j].y * v[j].y) + (v[j].z * v[j].z + v[j].w * v[j].w); }
        const float rstd = 1.0f / sqrtf(wave_sum(ss) * (1.0f / D) + EPS);
        float gd[8];
#pragma unroll
        for (int g = 0; g < 8; ++g) gd[g] = 0.f;
        GAS v2u* o8 = (GAS v2u*)(F.HA + (size_t)row * D) + F.lane;
#pragma unroll
        for (int j = 0; j < 8; ++j) {
            const f32x4 a = *(const LAS f32x4*)(A1 + 256 * j + 4 * F.lane), b = *(const LAS f32x4*)(B1 + 256 * j + 4 * F.lane);
            const f32x4 h = v[j] * rstd * a + b;
            v2u o; o.x = pk2(h.x, h.y); o.y = pk2(h.z, h.w); o8[64 * j] = o;
#pragma unroll
            for (int g = 0; g < 8; ++g) { const f32x4 w = *(const LAS f32x4*)(WG + g * 2048 + 256 * j + 4 * F.lane); gd[g] += (h.x * w.x + h.y * w.y) + (h.z * w.z + h.w * w.w); }
            asm volatile("" ::: "memory");
        }
#pragma unroll
        for (int g = 0; g < 8; ++g) gd[g] = wave_sum(gd[g]);
        if (F.lane == 0) {
#pragma unroll
            for (int g = 0; g < 8; ++g) { float p = gd[g] + F.b_gates[g];
                if (g >= 4) { p = fminf(p, 0.f) - log1pf(__expf(-fabsf(p))); }
                F.GATES[(size_t)row * 8 + g] = p; }
        }
    }
}
constexpr int IMG_PITCH = 528, M1_WL = 69632, M1_RED = 73728;
DI void m1_item(Frame& F, int hh, int kc) {
    LAS unsigned char* IMG = F.lds; LAS float* WL = (LAS float*)(F.lds + M1_WL); LAS float* RED = (LAS float*)(F.lds + M1_RED);
    const int t0 = kc * CH, lane = F.lane, tid = F.tid;
    if (F.wave == 0) {
        const float* gp = F.GATES + (size_t)(t0 + 2 * lane) * 8;
        const float i0 = gp[hh], lf0 = gp[4 + hh], i1 = gp[8 + hh], lf1 = gp[12 + hh];
        const float p = lf0 + lf1; float inc = p;
#pragma unroll
        for (int o = 1; o < 64; o <<= 1) { const float t = __shfl_up(inc, o); if (lane >= o) inc += t; }
        const float A = __shfl(inc, 63), ex = inc - p, b0 = ex + lf0, b1 = ex + p;
        const float lw0 = A - b0 + i0, lw1 = A - b1 + i1;
        const float B = wave_max(fmaxf(lw0, lw1));
        WL[2 * lane] = __expf(lw0 - B); WL[2 * lane + 1] = __expf(lw1 - B);
        if (lane == 0) { F.SUMM[(hh * NCHUNK + kc) * 2] = A; F.SUMM[(hh * NCHUNK + kc) * 2 + 1] = B; }
    }
    __syncthreads();
    const int dg = tid & 31, sb = tid >> 5;
#pragma unroll 1
    for (int which = 0; which < 2; ++which) {
        const int chb = (which == 0 ? 1024 : 0) + hh * DH + dg * 8;
        const int colb = (which == 0 ? C_K : C_Q) + hh * DH + dg * 8;
        float cw[4][8], cb[8];
#pragma unroll
        for (int j = 0; j < 4; ++j) { const f32x4 a = *(const GAS f32x4*)(F.conv_w + j * 2048 + chb), b = *(const GAS f32x4*)(F.conv_w + j * 2048 + chb + 4);
            cw[j][0] = a.x; cw[j][1] = a.y; cw[j][2] = a.z; cw[j][3] = a.w; cw[j][4] = b.x; cw[j][5] = b.y; cw[j][6] = b.z; cw[j][7] = b.w; }
        { const f32x4 a = *(const GAS f32x4*)(F.conv_b + chb), b = *(const GAS f32x4*)(F.conv_b + chb + 4);
          cb[0] = a.x; cb[1] = a.y; cb[2] = a.z; cb[3] = a.w; cb[4] = b.x; cb[5] = b.y; cb[6] = b.z; cb[7] = b.w; }
        float dnp[8];
#pragma unroll
        for (int e = 0; e < 8; ++e) dnp[e] = 0.f;
#pragma unroll 2
        for (int i = 0; i < 8; ++i) {
            const int s = sb + 16 * i, t = t0 + s;
            float acc[8];
#pragma unroll
            for (int e = 0; e < 8; ++e) acc[e] = cb[e];
#pragma unroll
            for (int j = 0; j < 4; ++j) { const int tt = t - 3 + j;
                v4u w = {0u, 0u, 0u, 0u}; if (tt >= 0) w = *(const GAS v4u*)(F.PROJ + (size_t)tt * NPROJ + colb);
                acc[0] += cw[j][0] * bflo(w.x); acc[1] += cw[j][1] * bfhi(w.x); acc[2] += cw[j][2] * bflo(w.y); acc[3] += cw[j][3] * bfhi(w.y);
                acc[4] += cw[j][4] * bflo(w.z); acc[5] += cw[j][5] * bfhi(w.z); acc[6] += cw[j][6] * bflo(w.w); acc[7] += cw[j][7] * bfhi(w.w); }
#pragma unroll
            for (int e = 0; e < 8; ++e) acc[e] = silu_f(acc[e]);
            if (which == 0) {
                v4u o; o.x = pk2(acc[0], acc[1]); o.y = pk2(acc[2], acc[3]); o.z = pk2(acc[4], acc[5]); o.w = pk2(acc[6], acc[7]);
                *(GAS v4u*)(F.KC + (size_t)t * 1024 + hh * DH + dg * 8) = o;
                const float wl = WL[s];
#pragma unroll
                for (int e = 0; e < 8; ++e) { acc[e] *= wl; dnp[e] += acc[e]; }
                v4u o2; o2.x = pk2(acc[0], acc[1]); o2.y = pk2(acc[2], acc[3]); o2.z = pk2(acc[4], acc[5]); o2.w = pk2(acc[6], acc[7]);
                *(LAS v4u*)(IMG + s * IMG_PITCH + dg * 16) = o2;
            } else {
#pragma unroll
                for (int e = 0; e < 8; ++e) acc[e] *= 0.0625f;
                v4u o; o.x = pk2(acc[0], acc[1]); o.y = pk2(acc[2], acc[3]); o.z = pk2(acc[4], acc[5]); o.w = pk2(acc[6], acc[7]);
                *(GAS v4u*)(F.QC + (size_t)t * 1024 + hh * DH + dg * 8) = o;
            }
        }
        if (which == 0) {
#pragma unroll
            for (int e = 0; e < 8; ++e) RED[sb * 256 + dg * 8 + e] = dnp[e];
        }
    }
    __syncthreads();
    if (tid < 256) { float s = 0.f;
#pragma unroll
        for (int i = 0; i < 16; ++i) s += RED[i * 256 + tid];
        F.NST[(size_t)(hh * NCHUNK + kc) * DH + tid] = s; }
    const int r = lane & 31, h = lane >> 5, e0 = F.wave * 32;
    bf16x8 bf[8];
#pragma unroll
    for (int ks = 0; ks < 8; ++ks) {
        const bf16* vp = F.PROJ + (size_t)(t0 + ks * 16 + 8 * h) * NPROJ + C_VM + hh * DH + e0 + r;
#pragma unroll
        for (int j = 0; j < 8; ++j) bf[ks][j] = (short)vp[(size_t)j * NPROJ];
    }
    bf16* sp = F.STATE + (size_t)(hh * NCHUNK + kc) * (DH * DH) + (size_t)(e0 + r) * DH;
#pragma unroll 1
    for (int dt = 0; dt < 8; ++dt) {
        f32x16 acc = zero16();
#pragma unroll
        for (int ks = 0; ks < 8; ++ks) {
            bf16x8 af; const LAS unsigned char* ip = IMG + (ks * 16 + 8 * h) * IMG_PITCH + (dt * 32 + r) * 2;
#pragma unroll
            for (int j = 0; j < 8; ++j) af[j] = (short)*(const LAS unsigned short*)(ip + j * IMG_PITCH);
            acc = MFMA32(af, bf[ks], acc);
        }
#pragma unroll
        for (int g = 0; g < 4; ++g) { v2u o; o.x = pk2(acc[4 * g], acc[4 * g + 1]); o.y = pk2(acc[4 * g + 2], acc[4 * g + 3]);
            *(GAS v2u*)(sp + dt * 32 + 8 * g + 4 * h) = o; }
    }
    __syncthreads();
}
DI void gmlp_item(Frame& F, int n, int g) {
    LAS float* RSTD = (LAS float*)F.lds;
    const int t0 = n * CH, c0 = g * 128, lane = F.lane, tid = F.tid;
    { const int s = tid >> 2, qd = tid & 3; const bf16* vp = F.PROJ + (size_t)(t0 + s) * NPROJ + C_VG + c0 + qd * 32; float ss = 0.f;
#pragma unroll
        for (int i = 0; i < 4; ++i) { const v4u w = *(const GAS v4u*)(vp + 8 * i);
            const float a0 = bflo(w.x), a1 = bfhi(w.x), a2 = bflo(w.y), a3 = bfhi(w.y), a4 = bflo(w.z), a5 = bfhi(w.z), a6 = bflo(w.w), a7 = bfhi(w.w);
            ss += (a0 * a0 + a1 * a1) + (a2 * a2 + a3 * a3) + (a4 * a4 + a5 * a5) + (a6 * a6 + a7 * a7); }
        ss += __shfl_xor(ss, 1); ss += __shfl_xor(ss, 2);
        if (qd == 0) RSTD[s] = 1.0f / sqrtf(ss * (1.0f / 128.0f) + EPS); }
    __syncthreads();
    const int r = lane & 31, h = lane >> 5, ct = F.wave & 3, tp = F.wave >> 2;
    bf16x8 af[8];
#pragma unroll
    for (int ks = 0; ks < 8; ++ks) {
        const bf16* vp = F.PROJ + (size_t)(t0 + ks * 16 + 8 * h) * NPROJ + C_VG + c0 + ct * 32 + r;
#pragma unroll
        for (int j = 0; j < 8; ++j) af[ks][j] = (short)vp[(size_t)j * NPROJ];
    }
    float ng[16];
#pragma unroll
    for (int reg = 0; reg < 16; ++reg) ng[reg] = F.gmlp_norm_g[g * 128 + ct * 32 + crow(reg, h)];
#pragma unroll 1
    for (int ti = 0; ti < 2; ++ti) {
        const int tt = (ti == 0) ? tp : 3 - tp;
        const int t = tt * 32 + r;
        const float* wrow = F.gmlp_w + (size_t)(g * 128 + t) * 128;
        f32x16 acc = zero16();
#pragma unroll
        for (int ks = 0; ks < 8; ++ks) {
            if (ks <= 2 * tt + 1) {
                const int s0 = ks * 16 + 8 * h;
                const f32x4 wa = *(const GAS f32x4*)(wrow + s0), wb = *(const GAS f32x4*)(wrow + s0 + 4);
                const f32x4 ra = *(const LAS f32x4*)(RSTD + s0), rb = *(const LAS f32x4*)(RSTD + s0 + 4);
                float wv[8] = {wa.x * ra.x, wa.y * ra.y, wa.z * ra.z, wa.w * ra.w, wb.x * rb.x, wb.y * rb.y, wb.z * rb.z, wb.w * rb.w};
#pragma unroll
                for (int j = 0; j < 8; ++j) if (s0 + j > t) wv[j] = 0.f;
                v4u bw; bw.x = pk2(wv[0], wv[1]); bw.y = pk2(wv[2], wv[3]); bw.z = pk2(wv[4], wv[5]); bw.w = pk2(wv[6], wv[7]);
                acc = MFMA32(af[ks], __builtin_bit_cast(bf16x8, bw), acc);
            }
        }
        const float bsp = F.gmlp_b[g * 128 + t];
        const bf16* up = F.PROJ + (size_t)(t0 + t) * NPROJ + C_UG + c0 + ct * 32;
        bf16* yp = F.HA + (size_t)(t0 + t) * D + c0 + ct * 32;
#pragma unroll
        for (int gq = 0; gq < 4; ++gq) { const int cl = 8 * gq + 4 * h;
            const v2u uw = *(const GAS v2u*)(up + cl);
            const float y0 = bflo(uw.x) * (ng[4 * gq] * acc[4 * gq] + bsp), y1 = bfhi(uw.x) * (ng[4 * gq + 1] * acc[4 * gq + 1] + bsp);
            const float y2 = bflo(uw.y) * (ng[4 * gq + 2] * acc[4 * gq + 2] + bsp), y3 = bfhi(uw.y) * (ng[4 * gq + 3] * acc[4 * gq + 3] + bsp);
            v2u o; o.x = pk2(y0, y1); o.y = pk2(y2, y3); *(GAS v2u*)(yp + cl) = o; }
    }
    __syncthreads();
}
DI void p2_phase(Frame& F) {
    constexpr int N_M1 = NHEAD * NCHUNK, N_G = (M / CH) * 8;
    for (int it = (int)blockIdx.x; it < N_M1 + N_G; it += F.G) {
        if (it < N_M1) m1_item(F, it / NCHUNK, it % NCHUNK);
        else { const int j = it - N_M1; gmlp_item(F, j % (M / CH), j / (M / CH)); }
    }
}
DI void p3_phase(Frame& F) {
    LAS float* TAB = (LAS float*)F.lds;
    const int lane = F.lane;
    if (F.wave < NHEAD) {
        const int hh = F.wave; const float* sp = F.SUMM + (size_t)(hh * NCHUNK + 2 * lane) * 2;
        const float A0 = sp[0], B0 = sp[1], A1 = sp[2], B1 = sp[3];
        float ca = A0 + A1, cb = fmaxf(B0 + A1, B1);
        const float pa = ca, pb = cb;
#pragma unroll
        for (int o = 1; o < 64; o <<= 1) { const float ta = __shfl_up(ca, o), tb = __shfl_up(cb, o); if (lane >= o) { cb = fmaxf(tb + ca, cb); ca = ta + ca; } }
        (void)pa; (void)pb;
        float ea = __shfl_up(ca, 1), eb = __shfl_up(cb, 1);
        float m0 = (lane == 0) ? 0.f : fmaxf(ea, eb);
        const float m1 = fmaxf(m0 + A0, B0), m2 = fmaxf(m1 + A1, B1);
        TAB[(hh * NCHUNK + 2 * lane) * 2] = __expf(A0 + m0 - m1); TAB[(hh * NCHUNK + 2 * lane) * 2 + 1] = __expf(B0 - m1);
        TAB[(hh * NCHUNK + 2 * lane + 1) * 2] = __expf(A1 + m1 - m2); TAB[(hh * NCHUNK + 2 * lane + 1) * 2 + 1] = __expf(B1 - m2);
        if (blockIdx.x == 0) { F.MTAB[hh * NCHUNK + 2 * lane] = m0; F.MTAB[hh * NCHUNK + 2 * lane + 1] = m1; }
    }
    __syncthreads();
    const int NT = F.G * NWAVES * 64, gt = (int)blockIdx.x * (NWAVES * 64) + F.tid;
    for (int p = gt; p < NHEAD * (DH * DH / 2); p += NT) {
        const int hh = p / (DH * DH / 2), q = p % (DH * DH / 2);
        GAS unsigned* sp = (GAS unsigned*)(F.STATE + (size_t)hh * NCHUNK * (DH * DH)) + q;
        float s0 = 0.f, s1 = 0.f;
#pragma unroll 1
        for (int k0 = 0; k0 < NCHUNK; k0 += 16) {
            unsigned ld[16];
#pragma unroll
            for (int k = 0; k < 16; ++k) ld[k] = sp[(size_t)(k0 + k) * (DH * DH / 2)];
#pragma unroll
            for (int k = 0; k < 16; ++k) {
                sp[(size_t)(k0 + k) * (DH * DH / 2)] = pk2(s0, s1);
                const float dec = TAB[(hh * NCHUNK + k0 + k) * 2], wb = TAB[(hh * NCHUNK + k0 + k) * 2 + 1];
                s0 = dec * s0 + wb * bflo(ld[k]); s1 = dec * s1 + wb * bfhi(ld[k]);
            }
        }
    }
    for (int p = gt; p < NHEAD * DH; p += NT) {
        const int hh = p / DH, d = p % DH; float* np = F.NST + (size_t)hh * NCHUNK * DH + d; float s = 0.f;
#pragma unroll 8
        for (int k = 0; k < NCHUNK; ++k) { const float ld = np[(size_t)k * DH]; np[(size_t)k * DH] = s; s = TAB[(hh * NCHUNK + k) * 2] * s + TAB[(hh * NCHUNK + k) * 2 + 1] * ld; }
    }
}
DI void m3_item(Frame& F, int hh, int kc) {
    LAS float* GS = (LAS float*)F.lds; LAS float* MX = (LAS float*)(F.lds + 512); LAS float* BT = (LAS float*)(F.lds + 1024);
    LAS float* NK = (LAS float*)(F.lds + 2048); LAS float* XCH = (LAS float*)(F.lds + 4096);
    const int t0 = kc * CH, lane = F.lane, tid = F.tid, item = hh * NCHUNK + kc;
    const float mk = F.MTAB[item];
    if (F.wave == 0) {
        const float* gp = F.GATES + (size_t)(t0 + 2 * lane) * 8;
        const float i0 = gp[hh], lf0 = gp[4 + hh], i1 = gp[8 + hh], lf1 = gp[12 + hh];
        const float p = lf0 + lf1; float inc = p;
#pragma unroll
        for (int o = 1; o < 64; o <<= 1) { const float t = __shfl_up(inc, o); if (lane >= o) inc += t; }
        const float ex = inc - p, b0 = ex + lf0, b1 = ex + p;
        const float g0 = i0 - b0, g1 = i1 - b1;
        float cm = fmaxf(g0, g1);
#pragma unroll
        for (int o = 1; o < 64; o <<= 1) { const float t = __shfl_up(cm, o); if (lane >= o) cm = fmaxf(cm, t); }
        float pm = __shfl_up(cm, 1); if (lane == 0) pm = -INFINITY;
        const float M0 = fmaxf(mk, fmaxf(pm, g0)), M1 = fmaxf(M0, g1);
        GS[2 * lane] = g0; GS[2 * lane + 1] = g1; MX[2 * lane] = M0; MX[2 * lane + 1] = M1; BT[2 * lane] = b0; BT[2 * lane + 1] = b1;
    }
    if (tid < 256) NK[tid] = F.NST[(size_t)item * DH + tid];
    LAS unsigned char* VIMG = F.lds + 8192;
#pragma unroll
    for (int i = 0; i < 8; ++i) { const int c = tid + 512 * i, row = c >> 5, c16 = c & 31;
        *(LAS v4u*)(VIMG + row * IMG_PITCH + c16 * 16) = *(const GAS v4u*)(F.PROJ + (size_t)(t0 + row) * NPROJ + C_VM + hh * DH + c16 * 8); }
    __syncthreads();
    const int r = lane & 31, h = lane >> 5, tt = F.wave & 3, eh = F.wave >> 2;
    const int tl = tt * 32 + r, t = t0 + tl;
    const float Mt = MX[tl], winter = __expf(mk - Mt);
    f32x16 accH[4];
#pragma unroll
    for (int i = 0; i < 4; ++i) accH[i] = zero16();
    float qn = 0.f;
    const bf16* qp = F.QC + (size_t)t * 1024 + hh * DH + 8 * h;
    const bf16* kp = F.KC + (size_t)(t0 + r) * 1024 + hh * DH + 8 * h;
    const bf16* cp = F.STATE + (size_t)item * (DH * DH) + (size_t)(eh * 128 + r) * DH + 8 * h;
#pragma unroll 2
    for (int ks = 0; ks < 16; ++ks) {
        const v4u qw = *(const GAS v4u*)(qp + ks * 16);
        float qv[8] = {bflo(qw.x), bfhi(qw.x), bflo(qw.y), bfhi(qw.y), bflo(qw.z), bfhi(qw.z), bflo(qw.w), bfhi(qw.w)};
        const f32x4 na = *(const LAS f32x4*)(NK + ks * 16 + 8 * h), nb = *(const LAS f32x4*)(NK + ks * 16 + 8 * h + 4);
        qn += (qv[0] * na.x + qv[1] * na.y) + (qv[2] * na.z + qv[3] * na.w) + (qv[4] * nb.x + qv[5] * nb.y) + (qv[6] * nb.z + qv[7] * nb.w);
        v4u q2; q2.x = pk2(qv[0] * winter, qv[1] * winter); q2.y = pk2(qv[2] * winter, qv[3] * winter); q2.z = pk2(qv[4] * winter, qv[5] * winter); q2.w = pk2(qv[6] * winter, qv[7] * winter);
        const bf16x8 q2f = __builtin_bit_cast(bf16x8, q2);
#pragma unroll
        for (int et = 0; et < 4; ++et) { const bf16x8 cf = *(const GAS bf16x8*)(cp + (size_t)et * 32 * DH + ks * 16); accH[et] = MFMA32(cf, q2f, accH[et]); }
    }
    qn += __shfl_xor(qn, 32);
    float den = 0.f;
    const LAS unsigned char* vbase = VIMG + 4 * h * IMG_PITCH + (eh * 128 + r) * 2;
#pragma unroll 1
    for (int st = 0; st <= tt; ++st) {
        f32x16 accS = zero16();
        const bf16* kps = kp + (size_t)st * 32 * 1024;
#pragma unroll 4
        for (int ks = 0; ks < 16; ++ks) { const bf16x8 qf = *(const GAS bf16x8*)(qp + ks * 16); const bf16x8 kf = *(const GAS bf16x8*)(kps + ks * 16); accS = MFMA32(kf, qf, accS); }
        float xv[16];
#pragma unroll
        for (int reg = 0; reg < 16; ++reg) { const int sl = st * 32 + crow(reg, h); float v = accS[reg] * __expf(GS[sl] - Mt); if (sl > tl) v = 0.f; xv[reg] = v; den += v; }
        const LAS unsigned char* vb2 = vbase + st * 32 * IMG_PITCH;
#pragma unroll
        for (int k2 = 0; k2 < 2; ++k2) {
            v4u xw; xw.x = pk2(xv[8 * k2], xv[8 * k2 + 1]); xw.y = pk2(xv[8 * k2 + 2], xv[8 * k2 + 3]); xw.z = pk2(xv[8 * k2 + 4], xv[8 * k2 + 5]); xw.w = pk2(xv[8 * k2 + 6], xv[8 * k2 + 7]);
            const bf16x8 xs = __builtin_bit_cast(bf16x8, xw);
#pragma unroll
            for (int et = 0; et < 4; ++et) {
                bf16x8 vf;
#pragma unroll
                for (int j = 0; j < 8; ++j) vf[j] = (short)*(const LAS unsigned short*)(vb2 + (16 * k2 + 8 * (j >> 2) + (j & 3)) * IMG_PITCH + et * 64);
                accH[et] = MFMA32(vf, xs, accH[et]);
            }
        }
    }
    den += __shfl_xor(den, 32);
    den += winter * qn;
    const float dnm = fmaxf(fabsf(den), __expf(-(BT[tl] + Mt))), inv = 1.0f / dnm;
    float ss = 0.f;
#pragma unroll
    for (int et = 0; et < 4; ++et)
#pragma unroll
        for (int reg = 0; reg < 16; ++reg) { accH[et][reg] *= inv; ss += accH[et][reg] * accH[et][reg]; }
    ss += __shfl_xor(ss, 32);
    if (h == 0) XCH[eh * 128 + tl] = ss;
    __syncthreads();
    const float rstd = 1.0f / sqrtf((XCH[tl] + XCH[128 + tl]) * (1.0f / DH) + EPS);
    const bf16* op = F.PROJ + (size_t)t * NPROJ + C_OM + hh * DH + eh * 128;
    bf16* yp = F.HA + (size_t)t * D + 1024 + hh * DH + eh * 128;
    const float* ngp = F.mlstm_norm_g + hh * DH + eh * 128;
#pragma unroll
    for (int et = 0; et < 4; ++et)
#pragma unroll
        for (int gq = 0; gq < 4; ++gq) { const int el = et * 32 + 8 * gq + 4 * h;
            const v2u ow = *(const GAS v2u*)(op + el); const f32x4 gn = *(const GAS f32x4*)(ngp + el);
            const float y0 = accH[et][4 * gq] * rstd * gn.x * sigmoid_f(bflo(ow.x)), y1 = accH[et][4 * gq + 1] * rstd * gn.y * sigmoid_f(bfhi(ow.x));
            const float y2 = accH[et][4 * gq + 2] * rstd * gn.z * sigmoid_f(bflo(ow.y)), y3 = accH[et][4 * gq + 3] * rstd * gn.w * sigmoid_f(bfhi(ow.y));
            v2u o; o.x = pk2(y0, y1); o.y = pk2(y2, y3); *(GAS v2u*)(yp + el) = o; }
    __syncthreads();
}
DI void p4_phase(Frame& F) {
    for (int it = (int)blockIdx.x; it < NHEAD * NCHUNK; it += F.G) m3_item(F, it / NCHUNK, it % NCHUNK);
}
DI void p6_phase(Frame& F) {
    LAS float* A1 = (LAS float*)(F.lds); LAS float* B1 = (LAS float*)(F.lds + 8192);
    norm_tables(F, F.norm_ffn_g, MOD_SCF, MOD_SHF);
    __syncthreads();
    const int gw = F.vcu * NWAVES + F.wave, NGW = F.G * NWAVES;
    for (int row = gw; row < M; row += NGW) {
        const GAS f32x4* xr = (const GAS f32x4*)(F.out + (size_t)row * D) + F.lane;
        f32x4 v[8]; float ss = 0.f;
#pragma unroll
        for (int j = 0; j < 8; ++j) { v[j] = xr[64 * j]; ss += (v[j].x * v[j].x + v[j].y * v[j].y) + (v[j].z * v[j].z + v[j].w * v[j].w); }
        const float rstd = 1.0f / sqrtf(wave_sum(ss) * (1.0f / D) + EPS);
        GAS v2u* o8 = (GAS v2u*)(F.HA + (size_t)row * D) + F.lane;
#pragma unroll
        for (int j = 0; j < 8; ++j) {
            const f32x4 a = *(const LAS f32x4*)(A1 + 256 * j + 4 * F.lane), b = *(const LAS f32x4*)(B1 + 256 * j + 4 * F.lane);
            const f32x4 h = v[j] * rstd * a + b;
            v2u o; o.x = pk2(h.x, h.y); o.y = pk2(h.z, h.w); o8[64 * j] = o;
        }
    }
}
constexpr int KPITCH = 272, P8_TBL = 69632;
DI void topk_insert(float (&L)[16], float x) {
#pragma unroll
    for (int i = 15; i >= 1; --i) L[i] = __builtin_amdgcn_fmed3f(x, L[i - 1], L[i]);
    L[0] = fmaxf(L[0], x);
}
DI void p8_phase(Frame& F) {
    LAS unsigned char* KIMG = F.lds; LAS unsigned char* TBL = F.lds + P8_TBL + F.wave * 1024;
    const int lane = F.lane, tid = F.tid, r = lane & 31, h = lane >> 5;
#pragma unroll 4
    for (int i = 0; i < 16; ++i) { const int idx = tid * 4 + 2048 * i, side = idx >> 14, rem = idx & 16383, row = rem >> 7, col = rem & 127;
        const f32x4 a = *(const GAS f32x4*)((side ? F.keys2 : F.keys1) + rem);
        v2u o; o.x = pk2(a.x, a.y); o.y = pk2(a.z, a.w); *(LAS v2u*)(KIMG + (side * 128 + row) * KPITCH + col * 2) = o; }
    __syncthreads();
    for (int it = (int)blockIdx.x; it < (M / 256) * PH; it += F.G) {
        const int tile = it / PH, hd = it % PH;
        const int t = tile * 256 + F.wave * 32 + r;
        float L1[16], L2[16];
#pragma unroll 1
        for (int side = 0; side < 2; ++side) {
            f32x16 acc[4];
#pragma unroll
            for (int kt = 0; kt < 4; ++kt) acc[kt] = zero16();
            const bf16* qp = F.QB + (size_t)t * D + hd * 256 + side * 128 + 8 * h;
#pragma unroll
            for (int ks = 0; ks < 8; ++ks) {
                const bf16x8 qf = *(const GAS bf16x8*)(qp + ks * 16);
#pragma unroll
                for (int kt = 0; kt < 4; ++kt) { const bf16x8 kf = *(const LAS bf16x8*)(KIMG + (side * 128 + kt * 32 + r) * KPITCH + (ks * 16 + 8 * h) * 2); acc[kt] = MFMA32(kf, qf, acc[kt]); }
            }
            float L[16];
#pragma unroll
            for (int i = 0; i < 16; ++i) L[i] = -3.0e38f;
#pragma unroll
            for (int kt = 0; kt < 4; ++kt)
#pragma unroll
                for (int reg = 0; reg < 16; ++reg) { const unsigned key = (unsigned)(kt * 32 + crow(reg, h)); const float sv = acc[kt][reg];
                    topk_insert(L, __uint_as_float((__float_as_uint(sv) & ~127u) | key)); }
            float P[16];
#pragma unroll
            for (int i = 0; i < 16; ++i) P[i] = __shfl_xor(L[i], 32);
#pragma unroll
            for (int i = 0; i < 16; ++i) topk_insert(L, P[i]);
            if (side == 0) {
#pragma unroll
                for (int i = 0; i < 16; ++i) L1[i] = L[i];
            } else {
#pragma unroll
                for (int i = 0; i < 16; ++i) L2[i] = L[i];
            }
        }
        if (h == 0) {
#pragma unroll
            for (int w = 0; w < 4; ++w) {
                const unsigned a = (__builtin_bit_cast(unsigned, L1[4 * w]) & 127u) | ((__builtin_bit_cast(unsigned, L1[4 * w + 1]) & 127u) << 8) | ((__builtin_bit_cast(unsigned, L1[4 * w + 2]) & 127u) << 16) | ((__builtin_bit_cast(unsigned, L1[4 * w + 3]) & 127u) << 24);
                const unsigned b = (__builtin_bit_cast(unsigned, L2[4 * w]) & 127u) | ((__builtin_bit_cast(unsigned, L2[4 * w + 1]) & 127u) << 8) | ((__builtin_bit_cast(unsigned, L2[4 * w + 2]) & 127u) << 16) | ((__builtin_bit_cast(unsigned, L2[4 * w + 3]) & 127u) << 24);
                *(LAS unsigned*)(TBL + r * 32 + 4 * w) = a; *(LAS unsigned*)(TBL + r * 32 + 16 + 4 * w) = b;
            }
        }
        float T[16];
#pragma unroll
        for (int i = 0; i < 16; ++i) T[i] = -3.0e38f;
#pragma unroll
        for (int i = 0; i < 16; ++i) {
            const float v1 = __builtin_bit_cast(float, __builtin_bit_cast(unsigned, L1[i]) & ~127u);
#pragma unroll
            for (int j = 0; j < 16; ++j) if ((i + 1) * (j + 1) <= 16) {
                const float v2 = __builtin_bit_cast(float, __builtin_bit_cast(unsigned, L2[j]) & ~127u);
                topk_insert(T, __builtin_bit_cast(float, (__builtin_bit_cast(unsigned, v1 + v2) & ~255u) | (unsigned)(i * 16 + j)));
            }
        }
        LDS_WAIT(); asm volatile("" ::: "memory");
        float ev[16], esum = 0.f;
        const float mx = __builtin_bit_cast(float, __builtin_bit_cast(unsigned, T[0]) & ~255u);
#pragma unroll
        for (int i = 0; i < 16; ++i) { ev[i] = __expf(__builtin_bit_cast(float, __builtin_bit_cast(unsigned, T[i]) & ~255u) - mx); esum += ev[i]; }
        const float einv = 1.0f / esum;
        int eid[8]; float gt[8];
#pragma unroll
        for (int i = 0; i < 8; ++i) { const float tv = h ? T[8 + i] : T[i]; const float e = h ? ev[8 + i] : ev[i];
            const unsigned p = __builtin_bit_cast(unsigned, tv) & 255u;
            const unsigned i1 = *(const LAS unsigned char*)(TBL + r * 32 + (p >> 4)), i2 = *(const LAS unsigned char*)(TBL + r * 32 + 16 + (p & 15u));
            eid[i] = (int)(i1 * 128u + i2); gt[i] = e * einv; }
        int* ip = F.IDX + (size_t)t * NSEL + hd * 16 + 8 * h; float* gp = F.PG + (size_t)t * NSEL + hd * 16 + 8 * h;
        *(GAS v4u*)ip = (v4u){(unsigned)eid[0], (unsigned)eid[1], (unsigned)eid[2], (unsigned)eid[3]}; *(GAS v4u*)(ip + 4) = (v4u){(unsigned)eid[4], (unsigned)eid[5], (unsigned)eid[6], (unsigned)eid[7]};
        *(GAS f32x4*)gp = (f32x4){gt[0], gt[1], gt[2], gt[3]}; *(GAS f32x4*)(gp + 4) = (f32x4){gt[4], gt[5], gt[6], gt[7]};
        LDS_WAIT(); asm volatile("" ::: "memory");
    }
}

DI void p8_alt_phase(Frame& F) {
    const int lane = F.lane;
    const int gw = F.vcu * NWAVES + F.wave, NGW = F.G * NWAVES;
    for (int it = gw; it < (M / 64) * PH; it += NGW) {
        const int tg = it / PH, hd = it % PH, t = tg * 64 + lane;
        float L1[16], L2[16];
#pragma unroll 1
        for (int side = 0; side < 2; ++side) {
            unsigned qw[64];
            const bf16* qp = F.QB + (size_t)t * D + hd * 256 + side * 128;
#pragma unroll
            for (int i = 0; i < 16; ++i) { const v4u w = *(const GAS v4u*)(qp + 8 * i); qw[4 * i] = w.x; qw[4 * i + 1] = w.y; qw[4 * i + 2] = w.z; qw[4 * i + 3] = w.w; }
            float L[16];
#pragma unroll
            for (int i = 0; i < 16; ++i) L[i] = -3.0e38f;
            const float* kb = side ? F.keys2 : F.keys1;
#pragma unroll 1
            for (int key = 0; key < 128; ++key) {
                const float* kr = kb + key * 128; float s = 0.f;
#pragma unroll
                for (int i = 0; i < 64; ++i) s += bflo(qw[i]) * kr[2 * i] + bfhi(qw[i]) * kr[2 * i + 1];
                topk_insert(L, __builtin_bit_cast(float, (__builtin_bit_cast(unsigned, s) & ~127u) | (unsigned)key));
            }
            if (side == 0) {
#pragma unroll
                for (int i = 0; i < 16; ++i) L1[i] = L[i];
            } else {
#pragma unroll
                for (int i = 0; i < 16; ++i) L2[i] = L[i];
            }
        }
        float T[16]; int E[16];
#pragma unroll
        for (int i = 0; i < 16; ++i) { T[i] = -3.0e38f; }
#pragma unroll
        for (int i = 0; i < 16; ++i) {
            const float v1 = __builtin_bit_cast(float, __builtin_bit_cast(unsigned, L1[i]) & ~127u);
#pragma unroll
            for (int j = 0; j < 16; ++j) if ((i + 1) * (j + 1) <= 16) {
                const float v2 = __builtin_bit_cast(float, __builtin_bit_cast(unsigned, L2[j]) & ~127u);
                topk_insert(T, __builtin_bit_cast(float, (__builtin_bit_cast(unsigned, v1 + v2) & ~255u) | (unsigned)(i * 16 + j)));
            }
        }
        float esum = 0.f; float ev[16];
        const float mx = __builtin_bit_cast(float, __builtin_bit_cast(unsigned, T[0]) & ~255u);
#pragma unroll
        for (int i = 0; i < 16; ++i) { ev[i] = __expf(__builtin_bit_cast(float, __builtin_bit_cast(unsigned, T[i]) & ~255u) - mx); esum += ev[i]; }
        const float einv = 1.0f / esum;
#pragma unroll
        for (int i = 0; i < 16; ++i) { const unsigned p = __builtin_bit_cast(unsigned, T[i]) & 255u; unsigned i1 = 0, i2 = 0;
#pragma unroll
            for (int q = 0; q < 16; ++q) { if ((p >> 4) == (unsigned)q) i1 = __builtin_bit_cast(unsigned, L1[q]) & 127u; if ((p & 15u) == (unsigned)q) i2 = __builtin_bit_cast(unsigned, L2[q]) & 127u; }
            E[i] = (int)(i1 * 128u + i2); }
        int* ip = F.IDX + (size_t)t * NSEL + hd * 16; float* gp = F.PG + (size_t)t * NSEL + hd * 16;
#pragma unroll
        for (int i = 0; i < 16; ++i) { ip[i] = E[i]; gp[i] = ev[i] * einv; }
    }
}
template <int STEP> DI void xpose_step_i(int (&v)[64], int lane) {
#pragma unroll
    for (int i = 0; i < STEP; ++i) { const bool up = (lane & STEP) != 0; const int keep = up ? v[i + STEP] : v[i], send = up ? v[i] : v[i + STEP]; v[i] = keep + __shfl_xor(send, STEP); }
}
DI float ub0(unsigned u) { float f; asm("v_cvt_f32_ubyte0 %0, %1" : "=v"(f) : "v"(u)); return f; }
DI float ub1(unsigned u) { float f; asm("v_cvt_f32_ubyte1 %0, %1" : "=v"(f) : "v"(u)); return f; }
DI float ub2(unsigned u) { float f; asm("v_cvt_f32_ubyte2 %0, %1" : "=v"(f) : "v"(u)); return f; }
DI float ub3(unsigned u) { float f; asm("v_cvt_f32_ubyte3 %0, %1" : "=v"(f) : "v"(u)); return f; }
DI void p9_phase(Frame& F) {
    LAS float* A2 = (LAS float*)(F.lds); LAS float* B2 = (LAS float*)(F.lds + 8192); LAS float* GF = (LAS float*)(F.lds + 16384); LAS float* FG = (LAS float*)(F.lds + 24576);
    norm_tables(F, F.norm_ffn_g, MOD_SCF, MOD_SHF);
#pragma unroll
    for (int i = 0; i < 4; ++i) { const int c = F.tid + 512 * i; GF[c] = F.MODF[MOD_GF + c]; FG[c] = F.final_g[c]; }
    __syncthreads();
    const int lane = F.lane, gw = F.vcu * NWAVES + F.wave, NGW = F.G * NWAVES;
#pragma unroll 1
    for (int t = gw; t < M; t += NGW) {
        int hq[8]; float sh;
        {
            float hv[32]; float ss = 0.f;
            const float* xr = F.out + (size_t)t * D + 16 * lane;
#pragma unroll
            for (int jj = 0; jj < 2; ++jj)
#pragma unroll
                for (int q = 0; q < 4; ++q) { const f32x4 a = *(const GAS f32x4*)(xr + 1024 * jj + 4 * q); hv[16 * jj + 4 * q] = a.x; hv[16 * jj + 4 * q + 1] = a.y; hv[16 * jj + 4 * q + 2] = a.z; hv[16 * jj + 4 * q + 3] = a.w; }
#pragma unroll
            for (int i = 0; i < 32; ++i) ss += hv[i] * hv[i];
            const float rstd = 1.0f / sqrtf(wave_sum(ss) * (1.0f / D) + EPS);
            float am = 0.f;
#pragma unroll
            for (int jj = 0; jj < 2; ++jj)
#pragma unroll
                for (int q = 0; q < 4; ++q) { const f32x4 a = *(const LAS f32x4*)(A2 + 1024 * jj + 16 * lane + 4 * q), b = *(const LAS f32x4*)(B2 + 1024 * jj + 16 * lane + 4 * q);
                    const int o = 16 * jj + 4 * q;
                    hv[o] = hv[o] * rstd * a.x + b.x; hv[o + 1] = hv[o + 1] * rstd * a.y + b.y; hv[o + 2] = hv[o + 2] * rstd * a.z + b.z; hv[o + 3] = hv[o + 3] * rstd * a.w + b.w;
                    am = fmaxf(am, fmaxf(fmaxf(fabsf(hv[o]), fabsf(hv[o + 1])), fmaxf(fabsf(hv[o + 2]), fabsf(hv[o + 3])))); }
            am = fmaxf(wave_max(am), 1e-30f); sh = am * (1.0f / 127.0f); const float inv = 127.0f / am;
#pragma unroll
            for (int w = 0; w < 8; ++w) { const int q0 = (int)__builtin_rintf(hv[4 * w] * inv), q1 = (int)__builtin_rintf(hv[4 * w + 1] * inv), q2 = (int)__builtin_rintf(hv[4 * w + 2] * inv), q3 = (int)__builtin_rintf(hv[4 * w + 3] * inv);
                hq[w] = (int)((unsigned)(q0 & 255) | ((unsigned)(q1 & 255) << 8) | ((unsigned)(q2 & 255) << 16) | ((unsigned)(q3 & 255) << 24)); }
        }
        float out[32]; float csum = 0.f;
#pragma unroll
        for (int i = 0; i < 32; ++i) out[i] = 0.f;
#pragma unroll 1
        for (int b = 0; b < 2; ++b) {
            const int myidx = F.IDX[(size_t)t * NSEL + 64 * b + lane]; const float mygate = F.PG[(size_t)t * NSEL + 64 * b + lane];
            const float mysd = F.SD[myidx], mysu = F.SU[myidx];
            int p[64];
#pragma unroll
            for (int k0 = 0; k0 < 64; k0 += 4) {
                v4u w[4][2];
#pragma unroll
                for (int kk = 0; kk < 4; ++kk) { const int e = __builtin_amdgcn_readlane(myidx, k0 + kk); const unsigned char* rowp = F.ED + (size_t)e * D + 16 * lane;
                    w[kk][0] = *(const GAS v4u*)(rowp); w[kk][1] = *(const GAS v4u*)(rowp + 1024); }
#pragma unroll
                for (int kk = 0; kk < 4; ++kk) { int a = 0;
                    a = __builtin_amdgcn_sdot4(hq[0], (int)w[kk][0].x, a, false); a = __builtin_amdgcn_sdot4(hq[1], (int)w[kk][0].y, a, false); a = __builtin_amdgcn_sdot4(hq[2], (int)w[kk][0].z, a, false); a = __builtin_amdgcn_sdot4(hq[3], (int)w[kk][0].w, a, false);
                    a = __builtin_amdgcn_sdot4(hq[4], (int)w[kk][1].x, a, false); a = __builtin_amdgcn_sdot4(hq[5], (int)w[kk][1].y, a, false); a = __builtin_amdgcn_sdot4(hq[6], (int)w[kk][1].z, a, false); a = __builtin_amdgcn_sdot4(hq[7], (int)w[kk][1].w, a, false);
                    p[k0 + kk] = a; }
                asm volatile("" ::: "memory");
            }
            xpose_step_i<32>(p, lane); xpose_step_i<16>(p, lane); xpose_step_i<8>(p, lane); xpose_step_i<4>(p, lane); xpose_step_i<2>(p, lane); xpose_step_i<1>(p, lane);
            const float act = (float)p[0] * (sh * mysd);
            const float coef = mygate * gelu_f(act) * mysu;
            csum += coef;
#pragma unroll 1
            for (int k0 = 0; k0 < 64; k0 += 4) {
                v4u w[4][2]; float c[4];
#pragma unroll
                for (int kk = 0; kk < 4; ++kk) { const int e = __builtin_amdgcn_readlane(myidx, k0 + kk); c[kk] = __builtin_bit_cast(float, __builtin_amdgcn_readlane(__builtin_bit_cast(int, coef), k0 + kk));
                    const unsigned char* rowp = F.EU + (size_t)e * D + 16 * lane;
                    w[kk][0] = *(const GAS v4u*)(rowp); w[kk][1] = *(const GAS v4u*)(rowp + 1024); }
#pragma unroll
                for (int kk = 0; kk < 4; ++kk)
#pragma unroll
                    for (int jj = 0; jj < 2; ++jj) { const v4u u = w[kk][jj]; const int o = 16 * jj; const float cc = c[kk];
                        out[o] += cc * ub0(u.x); out[o + 1] += cc * ub1(u.x); out[o + 2] += cc * ub2(u.x); out[o + 3] += cc * ub3(u.x);
                        out[o + 4] += cc * ub0(u.y); out[o + 5] += cc * ub1(u.y); out[o + 6] += cc * ub2(u.y); out[o + 7] += cc * ub3(u.y);
                        out[o + 8] += cc * ub0(u.z); out[o + 9] += cc * ub1(u.z); out[o + 10] += cc * ub2(u.z); out[o + 11] += cc * ub3(u.z);
                        out[o + 12] += cc * ub0(u.w); out[o + 13] += cc * ub1(u.w); out[o + 14] += cc * ub2(u.w); out[o + 15] += cc * ub3(u.w); }
            }
        }
        const float corr = 128.0f * wave_sum(csum);
        float s2 = 0.f;
        float* orow = F.out + (size_t)t * D + 16 * lane;
#pragma unroll
        for (int jj = 0; jj < 2; ++jj)
#pragma unroll
            for (int q = 0; q < 4; ++q) { const f32x4 g = *(const LAS f32x4*)(GF + 1024 * jj + 16 * lane + 4 * q); const f32x4 xa = *(const GAS f32x4*)(orow + 1024 * jj + 4 * q); const int o = 16 * jj + 4 * q;
                out[o] = xa.x + g.x * (out[o] - corr); out[o + 1] = xa.y + g.y * (out[o + 1] - corr); out[o + 2] = xa.z + g.z * (out[o + 2] - corr); out[o + 3] = xa.w + g.w * (out[o + 3] - corr); }
#pragma unroll
        for (int i = 0; i < 32; ++i) s2 += out[i] * out[i];
        const float rstd2 = 1.0f / sqrtf(wave_sum(s2) * (1.0f / D) + EPS);
#pragma unroll
        for (int jj = 0; jj < 2; ++jj)
#pragma unroll
            for (int q = 0; q < 4; ++q) { const f32x4 f = *(const LAS f32x4*)(FG + 1024 * jj + 16 * lane + 4 * q); const int o = 16 * jj + 4 * q;
                *(GAS f32x4*)(orow + 1024 * jj + 4 * q) = (f32x4){out[o] * rstd2 * f.x, out[o + 1] * rstd2 * f.y, out[o + 2] * rstd2 * f.z, out[o + 3] * rstd2 * f.w}; }
    }
}
constexpr int P9_IDX = 131072, P9_SH = 147456, P9_CORR = 147712, P9_GF = 32768, P9_FG = 40960, P9_SSQ = 49152, NSLICE = 16, SLICE_B = 128;
#ifndef NSLICE_A
#define NSLICE_A NSLICE
#endif
#ifndef NSLICE_C
#define NSLICE_C NSLICE
#endif
template <int N, int MASK> DI void red_step_i(int (&v)[8], int lane) {
#pragma unroll
    for (int i = 0; i < N / 2; ++i) { const bool up = (lane & MASK) != 0; const int keep = up ? v[i + N / 2] : v[i], send = up ? v[i] : v[i + N / 2]; v[i] = keep + __shfl_xor(send, MASK); }
}
template <int N, int MASK> DI void red_step_f(float (&v)[16], int lane) {
#pragma unroll
    for (int i = 0; i < N / 2; ++i) { const bool up = (lane & MASK) != 0; const float keep = up ? v[i + N / 2] : v[i], send = up ? v[i] : v[i + N / 2]; v[i] = keep + __shfl_xor(send, MASK); }
}
typedef _Float16 h2v __attribute__((ext_vector_type(2)));
DI void acc4(float& o0, float& o1, float& o2, float& o3, unsigned u, float c) {
    const h2v p = __builtin_bit_cast(h2v, __builtin_amdgcn_perm(u, 0x64646464u, 0x01050004u));
    const h2v q = __builtin_bit_cast(h2v, __builtin_amdgcn_perm(u, 0x64646464u, 0x01070006u));
    o0 = __builtin_fmaf((float)p.x, c, o0); o1 = __builtin_fmaf((float)p.y, c, o1); o2 = __builtin_fmaf((float)q.x, c, o2); o3 = __builtin_fmaf((float)q.y, c, o3);
}
DI void p9v2_phase(Frame& F) {
    LAS unsigned char* HQ = F.lds; LAS float* A2 = (LAS float*)(F.lds + P9_IDX); LAS float* B2 = (LAS float*)(F.lds + P9_IDX + 8192);
    LAS unsigned short* IDX16 = (LAS unsigned short*)(F.lds + P9_IDX); LAS float* SH = (LAS float*)(F.lds + P9_SH); LAS float* CORR = (LAS float*)(F.lds + P9_CORR);
    LAS float* COEF = (LAS float*)F.lds; LAS float* GF = (LAS float*)(F.lds + P9_GF); LAS float* FG = (LAS float*)(F.lds + P9_FG);
    const int lane = F.lane, tid = F.tid, c8 = lane & 7, g = lane >> 3;
#pragma unroll 1
    for (int tb = (int)blockIdx.x * 64; tb < M; tb += F.G * 64) {
#pragma unroll
        for (int i = 0; i < 4; ++i) { const int c = tid + 512 * i; A2[c] = F.norm_ffn_g[c] * (1.0f + F.MODF[MOD_SCF + c]); B2[c] = F.MODF[MOD_SHF + c]; }
        __syncthreads();
#pragma unroll 1
        for (int j = 0; j < 8; ++j) {
            const int tl = F.wave * 8 + j, t = tb + tl;
            float hv[32]; float ss = 0.f;
            const float* xr = F.out + (size_t)t * D + 16 * lane;
#pragma unroll
            for (int jj = 0; jj < 2; ++jj)
#pragma unroll
                for (int q = 0; q < 4; ++q) { const f32x4 a = *(const GAS f32x4*)(xr + 1024 * jj + 4 * q); hv[16 * jj + 4 * q] = a.x; hv[16 * jj + 4 * q + 1] = a.y; hv[16 * jj + 4 * q + 2] = a.z; hv[16 * jj + 4 * q + 3] = a.w; }
#pragma unroll
            for (int i = 0; i < 32; ++i) ss += hv[i] * hv[i];
            const float rstd = 1.0f / sqrtf(wave_sum(ss) * (1.0f / D) + EPS);
            float am = 0.f;
#pragma unroll
            for (int jj = 0; jj < 2; ++jj)
#pragma unroll
                for (int q = 0; q < 4; ++q) { const f32x4 a = *(const LAS f32x4*)(A2 + 1024 * jj + 16 * lane + 4 * q), b = *(const LAS f32x4*)(B2 + 1024 * jj + 16 * lane + 4 * q);
                    const int o = 16 * jj + 4 * q;
                    hv[o] = hv[o] * rstd * a.x + b.x; hv[o + 1] = hv[o + 1] * rstd * a.y + b.y; hv[o + 2] = hv[o + 2] * rstd * a.z + b.z; hv[o + 3] = hv[o + 3] * rstd * a.w + b.w;
                    am = fmaxf(am, fmaxf(fmaxf(fabsf(hv[o]), fabsf(hv[o + 1])), fmaxf(fabsf(hv[o + 2]), fabsf(hv[o + 3])))); }
            am = fmaxf(wave_max(am), 1e-30f); const float inv = 127.0f / am;
            if (lane == 0) SH[tl] = am * (1.0f / 127.0f);
#pragma unroll
            for (int jj = 0; jj < 2; ++jj) { v4u o;
#pragma unroll
                for (int q = 0; q < 4; ++q) { const int b = 16 * jj + 4 * q;
                    const int q0 = (int)__builtin_rintf(hv[b] * inv), q1 = (int)__builtin_rintf(hv[b + 1] * inv), q2 = (int)__builtin_rintf(hv[b + 2] * inv), q3 = (int)__builtin_rintf(hv[b + 3] * inv);
                    o[q] = (unsigned)(q0 & 255) | ((unsigned)(q1 & 255) << 8) | ((unsigned)(q2 & 255) << 16) | ((unsigned)(q3 & 255) << 24); }
                *(LAS v4u*)(HQ + tl * 2048 + 1024 * jj + 16 * lane) = o; }
        }
        __syncthreads();
#pragma unroll
        for (int i = 0; i < 16; ++i) { const int q = tid + 512 * i; IDX16[q] = (unsigned short)F.IDX[(size_t)tb * NSEL + q]; }
        __syncthreads();
        int P[8][2];
#pragma unroll
        for (int j = 0; j < 8; ++j) { P[j][0] = 0; P[j][1] = 0; }
#pragma unroll 1
        for (int s = 0; s < NSLICE_A; ++s) {
            const unsigned char* eb = F.ED + s * SLICE_B;
#pragma unroll
            for (int j = 0; j < 8; ++j) {
                const int tl = F.wave * 8 + j;
                const v4u hq = *(const LAS v4u*)(HQ + tl * 2048 + s * SLICE_B + c8 * 16);
#pragma unroll
                for (int h = 0; h < 2; ++h) {
                    v4u w[8];
#pragma unroll
                    for (int i = 0; i < 8; ++i) { const unsigned e = IDX16[tl * 128 + 64 * h + 8 * i + g]; w[i] = *(const GAS v4u*)(eb + (e * 2048u + (unsigned)(c8 * 16))); }
                    int a[8];
#pragma unroll
                    for (int i = 0; i < 8; ++i) { int d = 0; const v4u ww = w[i];
                        d = __builtin_amdgcn_sdot4((int)hq.x, (int)ww.x, d, false); d = __builtin_amdgcn_sdot4((int)hq.y, (int)ww.y, d, false); d = __builtin_amdgcn_sdot4((int)hq.z, (int)ww.z, d, false); d = __builtin_amdgcn_sdot4((int)hq.w, (int)ww.w, d, false); a[i] = d; }
                    red_step_i<8, 4>(a, lane); red_step_i<4, 2>(a, lane); red_step_i<2, 1>(a, lane);
                    P[j][h] += a[0];
                    asm volatile("" ::: "memory");
                }
            }
        }
        __syncthreads();
        LAS int* PI = (LAS int*)F.lds;
#pragma unroll
        for (int j = 0; j < 8; ++j) { const int tl = F.wave * 8 + j; PI[tl * 128 + 8 * c8 + g] = P[j][0]; PI[tl * 128 + 64 + 8 * c8 + g] = P[j][1]; }
#pragma unroll
        for (int i = 0; i < 4; ++i) { const int c = tid + 512 * i; GF[c] = F.MODF[MOD_GF + c]; FG[c] = F.final_g[c]; }
        LAS float* SSQL = (LAS float*)(F.lds + P9_SSQ);
#pragma unroll 1
        for (int j = 0; j < 8; ++j) { const int tl = F.wave * 8 + j, t = tb + tl; const float sh = SH[tl]; float sum = 0.f;
#pragma unroll
            for (int h = 0; h < 2; ++h) { const int k = 64 * h + lane; const unsigned e = IDX16[tl * 128 + k];
                const float act = (float)PI[tl * 128 + k] * (sh * F.SD[e]); const float cfv = F.PG[(size_t)t * NSEL + k] * gelu_f(act) * F.SU[e]; COEF[tl * 128 + k] = cfv; sum += cfv; }
            sum = 1152.0f * wave_sum(sum); if (lane == 0) CORR[tl] = sum;     SSQL[tl * 64 + lane] = 0.f; }
        __syncthreads();
        const int cb = c8 * 16 + ((lane >> 5) & 1) * 8 + ((lane >> 4) & 1) * 4 + ((lane >> 3) & 1) * 2;
#pragma unroll 1
        for (int s = 0; s < NSLICE_C; ++s) {
            const unsigned char* eb = F.EU + s * SLICE_B;
#pragma unroll 1
            for (int j = 0; j < 8; ++j) {
                const int tl = F.wave * 8 + j, t = tb + tl;
                float o[16];
#pragma unroll
                for (int b = 0; b < 16; ++b) o[b] = 0.f;
#pragma unroll
                for (int h = 0; h < 2; ++h) {
                    v4u w[8]; float c[8];
#pragma unroll
                    for (int i = 0; i < 8; ++i) { const unsigned e = IDX16[tl * 128 + 64 * h + 8 * i + g]; c[i] = COEF[tl * 128 + 64 * h + 8 * i + g]; w[i] = *(const GAS v4u*)(eb + (e * 2048u + (unsigned)(c8 * 16))); }
#pragma unroll
                    for (int i = 0; i < 8; ++i) { const v4u u = w[i]; const float cc = c[i];
                        acc4(o[0], o[1], o[2], o[3], u.x, cc); acc4(o[4], o[5], o[6], o[7], u.y, cc); acc4(o[8], o[9], o[10], o[11], u.z, cc); acc4(o[12], o[13], o[14], o[15], u.w, cc); }
                }
                red_step_f<16, 32>(o, lane); red_step_f<8, 16>(o, lane); red_step_f<4, 8>(o, lane);
                const int col = s * SLICE_B + cb; const float corr = CORR[tl];
                float* xp = F.out + (size_t)t * D + col;
                typedef float f32x2 __attribute__((ext_vector_type(2)));
                const f32x2 xv = *(const GAS f32x2*)xp;
                const float y0 = xv.x + GF[col] * (o[0] - corr), y1 = xv.y + GF[col + 1] * (o[1] - corr);
                SSQL[tl * 64 + lane] += y0 * y0 + y1 * y1;
                *(GAS f32x2*)xp = (f32x2){y0, y1};
            }
        }
#pragma unroll 1
        for (int j = 0; j < 8; ++j) {
            const int tl = F.wave * 8 + j, t = tb + tl;
            const float rstd2 = 1.0f / sqrtf(wave_sum(SSQL[tl * 64 + lane]) * (1.0f / D) + EPS);
            GAS f32x4* orow = (GAS f32x4*)(F.out + (size_t)t * D) + lane;
#pragma unroll
            for (int q = 0; q < 8; ++q) { const f32x4 v = orow[64 * q]; const f32x4 f = *(const LAS f32x4*)(FG + 256 * q + 4 * lane); orow[64 * q] = v * rstd2 * f; }
        }
        __syncthreads();
    }
}
struct Args { const float* in[21]; float* out; unsigned char* ws; int ph_lo, ph_hi, li, pad; };
constexpr int N_PHASES = 11;
__global__ void __launch_bounds__(NWAVES * 64, 2) mk_fwd(Args args) {
    extern __shared__ __attribute__((aligned(16))) unsigned char lds[];
    Frame F;
    F.lds = (LAS unsigned char*)lds;
    F.MISC = (volatile LAS unsigned*)(F.lds + MISC_OFF);
    F.tid = threadIdx.x; F.lane = F.tid & 63; F.wave = __builtin_amdgcn_readfirstlane(F.tid >> 6);
    F.G = gridDim.x; { const int bx = blockIdx.x; F.vcu = (F.G % 8 == 0) ? (bx % 8) * (F.G / 8) + bx / 8 : bx; }
    unsigned char* ws = args.ws;
    F.ctl = (gu32*)(ws + WS_CTL);
    F.x = args.in[0]; F.c = args.in[1]; F.ada_w = args.in[2]; F.ada_b = args.in[3]; F.norm_mix_g = args.in[4]; F.w_in = args.in[5]; F.b_gates = args.in[6];
    F.conv_w = args.in[7]; F.conv_b = args.in[8]; F.gmlp_norm_g = args.in[9]; F.gmlp_w = args.in[10]; F.gmlp_b = args.in[11]; F.mlstm_norm_g = args.in[12];
    F.w_out = args.in[13]; F.norm_ffn_g = args.in[14]; F.wq = args.in[15]; F.keys1 = args.in[16]; F.keys2 = args.in[17]; F.e_down = args.in[18]; F.e_up = args.in[19]; F.final_g = args.in[20];
    F.out = args.out;
    F.MODP = (float*)(ws + WS_MODP); F.MODF = (float*)(ws + WS_MODF); F.GATES = (float*)(ws + WS_GATES); F.SUMM = (float*)(ws + WS_SUMM); F.MTAB = (float*)(ws + WS_MTAB);
    F.NST = (float*)(ws + WS_NST); F.PG = (float*)(ws + WS_PG); F.IDX = (int*)(ws + WS_IDX);
    F.WIN = (bf16*)(ws + WS_WIN); F.WOUT = (bf16*)(ws + WS_WOUT); F.WQ = (bf16*)(ws + WS_WQ); F.HA = (bf16*)(ws + WS_HA); F.PROJ = (bf16*)(ws + WS_PROJ); F.QB = (bf16*)(ws + WS_PROJ);
    F.STATE = (bf16*)(ws + WS_STATE); F.ED = ws + WS_ED; F.EU = ws + WS_EU; F.SD = (float*)(ws + WS_SD); F.SU = (float*)(ws + WS_SU);
    F.QC = (bf16*)args.out; F.KC = (bf16*)args.out + (size_t)M * 1024;
    for (int u = F.tid; u < (LDS_BYTES - LDSCTL_OFF) / 4; u += NWAVES * 64) ((LAS unsigned*)(F.lds + LDSCTL_OFF))[u] = 0u;
    __syncthreads();
    const int lo = args.ph_lo, hi = args.ph_hi;
    const bool multi = (hi - lo) > 1;
    XcdBarrier bar; bar.bar = (unsigned*)(F.ctl + CW_BAR) + args.li * XCD_BAR_WORDS; bar.x = 0; bar.st = nullptr;
    if (multi) bar = xcd_barrier_post((unsigned*)(F.ctl + CW_BAR) + args.li * XCD_BAR_WORDS, F.MISC + 8);
#ifndef PH_MASK
#define PH_MASK 0x7ff
#endif
#define IN(k) (((PH_MASK >> (k)) & 1) && lo <= (k) && (k) < hi)
#define SEAM(k) do { if (IN(k) && IN((k) + 1)) xcd_barrier(bar); } while (0)
    if (IN(0)) { p0a_phase(F); } SEAM(0);
    if (IN(1)) { p0b_phase(F); } SEAM(1);
    if (IN(2)) {
        pg8::Gemm g{F.HA, F.WIN, M, NPROJ, D}; pg8::StaticOrder S; S.init(M, NPROJ, F.G, (int)blockIdx.x);
        pg8::EpiProj E{F.PROJ, NPROJ, 2048 / 256};
        pg8::gemm_phase<pg8::EpiProj, pg8::StaticOrder, PG8_ALIGN, PG8_SP2>(F.lds, g, S, E);
    } SEAM(2);
    if (IN(3)) { p2_phase(F); } SEAM(3);
    if (IN(4)) { p3_phase(F); } SEAM(4);
    if (IN(5)) { p4_phase(F); } SEAM(5);
    if (IN(6)) {
        pg8::Gemm g{F.HA, F.WOUT, M, D, D}; pg8::StaticOrder S; S.init(M, D, F.G, (int)blockIdx.x);
        pg8::EpiResid E{F.x, F.MODF + MOD_GM, F.out, D};
        pg8::gemm_phase<pg8::EpiResid, pg8::StaticOrder, PG8_ALIGN, PG8_SP2>(F.lds, g, S, E);
    } SEAM(6);
    if (IN(7)) { p6_phase(F); } SEAM(7);
    if (IN(8)) {
        pg8::Gemm g{F.HA, F.WQ, M, D, D}; pg8::StaticOrder S; S.init(M, D, F.G, (int)blockIdx.x);
        pg8::EpiBf16<0> E{F.QB, D, nullptr, 0, 0, 1.f};
        pg8::gemm_phase<pg8::EpiBf16<0>, pg8::StaticOrder, PG8_ALIGN, PG8_SP2>(F.lds, g, S, E);
    } SEAM(8);
    #ifndef P8_ALT
#define P8_ALT 0
#endif
    if (IN(9)) { if (P8_ALT) p8_alt_phase(F); else p8_phase(F); } SEAM(9);
    #ifndef P9_V2
#define P9_V2 1
#endif
    if (IN(10)) { if (P9_V2) p9v2_phase(F); else p9_phase(F); }
#undef IN
#undef SEAM
}

#ifndef MK_N_LAUNCHES
#define MK_N_LAUNCHES 1
#endif
extern "C" void kernel_launch(void* const* d_in, const int* in_sizes, int n_in, void* d_out, int out_size, void* d_ws, size_t ws_size, hipStream_t stream) {
    static int grid = 0;
    if (grid == 0) {
        if (n_in != 21 || in_sizes[0] != M * D || out_size != M * D || ws_size < WS_END) { fprintf(stderr, "kernel_launch: unexpected shapes (n_in %d, in0 %d, out %d, ws %zu); nothing launched\n", n_in, n_in > 0 ? in_sizes[0] : -1, out_size, ws_size); grid = -1; return; }
        int dev = 0, cus = 0, per_cu = 0;
        if (hipGetDevice(&dev) != hipSuccess || hipDeviceGetAttribute(&cus, hipDeviceAttributeMultiprocessorCount, dev) != hipSuccess) { grid = -1; return; }
        if (hipFuncSetAttribute((const void*)mk_fwd, hipFuncAttributeMaxDynamicSharedMemorySize, LDS_BYTES) != hipSuccess) { fprintf(stderr, "kernel_launch: hipFuncSetAttribute failed\n"); grid = -1; return; }
        if (hipOccupancyMaxActiveBlocksPerMultiprocessor(&per_cu, (const void*)mk_fwd, NWAVES * 64, LDS_BYTES) != hipSuccess || per_cu < 1) { fprintf(stderr, "kernel_launch: occupancy query says %d blocks per CU\n", per_cu); }
        (void)hipGetLastError();
        grid = cus;
    }
    if (grid < 0) return;
    (void)hipMemsetAsync((char*)d_ws + WS_CTL, 0, CTL_ZERO_BYTES, stream);
    Args a{};
    for (int i = 0; i < 21; ++i) a.in[i] = (const float*)d_in[i];
    a.out = (float*)d_out; a.ws = (unsigned char*)d_ws;
    if (MK_N_LAUNCHES == 1) { a.ph_lo = 0; a.ph_hi = N_PHASES; a.li = 0; hipLaunchKernelGGL(mk_fwd, dim3(grid), dim3(NWAVES * 64), LDS_BYTES, stream, a); }
    else for (int li = 0; li < N_PHASES; ++li) { a.ph_lo = li; a.ph_hi = li + 1; a.li = 0; hipLaunchKernelGGL(mk_fwd, dim3(grid), dim3(NWAVES * 64), LDS_BYTES, stream, a); }
}
```

```cpp
#include <hip/hip_runtime.h>
#include <cstdio>
#include <cstdint>
namespace pg8 {
#define PG8_LAS __attribute__((address_space(3)))
typedef unsigned short bf16_t;
typedef short bf16x8 __attribute__((ext_vector_type(8)));
typedef float f32x4 __attribute__((ext_vector_type(4)));
typedef unsigned u32x4 __attribute__((ext_vector_type(4)));
constexpr int BM = 256, BK = 64, HALF = 128, HTB = HALF * BK * 2  , STAGE_BYTES = 8 * HTB, NXCD = 8, WGM = 8;

__host__ __device__ __forceinline__ int lds_byte(int r, int c) { const int st = (r >> 4) * 2 + (c >> 5), rr = r & 15, cc = c & 31, ob = rr * 64 + cc * 2; return st * 1024 + (ob ^ (((ob >> 9) & 1) << 5)); }
__host__ __device__ __forceinline__ void stage_rc(int b, int& R, int& C) { const int st = b / 1024, sb = b % 1024, swz = sb ^ (((sb >> 9) & 1) << 5); R = (st >> 1) * 16 + swz / 64; C = (st & 1) * 32 + (swz % 64) / 2; }
__host__ __device__ __forceinline__ int perm32(int rho) { const int n = rho >> 4, i = rho & 15; return 8 * (i >> 2) + 4 * n + (i & 3); }

struct Unit { int pm, pn; };
struct Gemm { const bf16_t* A; const bf16_t* Bt; int M, N, K; };

struct StaticOrder {
    int nM, nN, nwg, G, c;
    __host__ __device__ void init(int M, int N, int G_, int c_) { nM = M / BM; nN = N / BM; nwg = nM * nN; G = G_; c = c_; }
    __host__ __device__ bool next(int i, Unit& u) const {
        const long L = (long)i * G + c; if (L >= nwg) return false;
        int wgid = (int)L; { const int q = nwg / NXCD, r = nwg % NXCD, xcd = wgid % NXCD, off = wgid / NXCD; wgid = (xcd < r ? xcd * (q + 1) : r * (q + 1) + (xcd - r) * q) + off; }
        const int nig = WGM * nN, gid = wgid / nig, fm = gid * WGM, gsz = (nM - fm) < WGM ? (nM - fm) : WGM;
        u.pm = fm + ((wgid % nig) % gsz); u.pn = (wgid % nig) / gsz; return true;
    }
    __device__ __forceinline__ void a_ready(const Unit&) const {}
    __device__ __forceinline__ void done(const Unit&) const {}
};

__device__ __forceinline__ unsigned cvt_pk_bf16(float lo, float hi) { unsigned r; asm volatile("v_cvt_pk_bf16_f32 %0, %1, %2" : "=v"(r) : "v"(lo), "v"(hi)); return r; }
typedef float f32x2 __attribute__((ext_vector_type(2)));
__device__ __forceinline__ f32x2 gelu_pk(f32x2 v) {
    const f32x2 av = __builtin_elementwise_abs(v), d = av * 0.2316418882f + 1.0f;
    f32x2 t; t.x = __builtin_amdgcn_rcpf(d.x); t.y = __builtin_amdgcn_rcpf(d.y);
    f32x2 q = t * 0.5307027145f + (-0.7265760135f); q = q * t + 0.7107068705f; q = q * t + (-0.142248368f); q = q * t + 0.127414796f; q = q * t;
    const f32x2 s = (v * v) * (-0.72134752044f);
    f32x2 e; e.x = __builtin_amdgcn_exp2f(s.x); e.y = __builtin_amdgcn_exp2f(s.y);
    const f32x2 m = v * (q * e), r = v - m;
    f32x2 o; o.x = v.x < 0.f ? m.x : r.x; o.y = v.y < 0.f ? m.y : r.y; return o;
}

template <int ACT  > struct EpiBf16 {
    static constexpr bool PERM = true, AFTER_DRAIN = false; static_assert(ACT == 0 || ACT == 1, "EpiBf16: ACT is 0 (none) or 1 (gelu_pk)");
    bf16_t* O; int ldc; const float* bias; int split_cols; size_t split_stride; float scale0;
    __device__ __forceinline__ void operator()(const f32x4 (&acc)[2][2][4][2], const Unit& u, int wr, int wc, int fr, int fq) const {
        const int row0 = u.pm * BM + wr * 64 + fr; int colt = u.pn * BM; bf16_t* base = O;
        float sc = 1.f; if (split_cols) { const int t = colt / split_cols; base += (size_t)t * split_stride; colt -= t * split_cols; if (t == 0) sc = scale0; }
        const int col0 = colt + wc * 32 + 8 * fq, bcol0 = u.pn * BM + wc * 32 + 8 * fq;
        f32x4 bv[2][2];
#pragma unroll
        for (int bj = 0; bj < 2; ++bj)
#pragma unroll
            for (int n = 0; n < 2; ++n) bv[bj][n] = bias ? *(const f32x4*)(bias + bcol0 + bj * HALF + 4 * n) : (f32x4){0.f, 0.f, 0.f, 0.f};
#pragma unroll
        for (int ai = 0; ai < 2; ++ai)
#pragma unroll
            for (int m = 0; m < 4; ++m) { bf16_t* rowp = base + (size_t)(row0 + ai * HALF + m * 16) * ldc + col0;
#pragma unroll
                for (int bj = 0; bj < 2; ++bj) { f32x4 v0 = acc[ai][bj][m][0] + bv[bj][0], v1 = acc[ai][bj][m][1] + bv[bj][1];
                    if (ACT == 1) { f32x2 a = gelu_pk((f32x2){v0[0], v0[1]}), b = gelu_pk((f32x2){v0[2], v0[3]}), c = gelu_pk((f32x2){v1[0], v1[1]}), d = gelu_pk((f32x2){v1[2], v1[3]});
                        v0 = (f32x4){a.x, a.y, b.x, b.y}; v1 = (f32x4){c.x, c.y, d.x, d.y}; }
                    v0 = v0 * sc; v1 = v1 * sc; u32x4 w; w.x = cvt_pk_bf16(v0[0], v0[1]); w.y = cvt_pk_bf16(v0[2], v0[3]); w.z = cvt_pk_bf16(v1[0], v1[1]); w.w = cvt_pk_bf16(v1[2], v1[3]);
                    *(u32x4*)(rowp + bj * HALF) = w; } }
    }
};

template <class Epi, class Sched, bool ALIGN_EPI = false, bool SP2 = false>
__device__ __forceinline__ void gemm_phase(PG8_LAS unsigned char* lds, const Gemm g, const Sched& S, const Epi& E) {
    const int tid = threadIdx.x, wid = __builtin_amdgcn_readfirstlane(tid >> 6), lane = tid & 63, wr = wid >> 2, wc = wid & 3, fr = lane & 15, fq = lane >> 4;
    const int K = g.K, nt = K / BK;
    unsigned voffA[2], voffB[2];
#pragma unroll
    for (int i = 0; i < 2; ++i) { int R, C; stage_rc(tid * 16 + i * 8192, R, C); const int Rb = Epi::PERM ? ((R & ~31) + perm32(R & 31)) : R;
        voffA[i] = (unsigned)(R * K + C) * 2u; voffB[i] = (unsigned)(Rb * K + C) * 2u; }
    const size_t kstep = (size_t)(BK * 2);
    const size_t hstep = (size_t)HALF * K * 2;
    const size_t tstep = 2 * hstep;
    const unsigned ldsw = (unsigned)wid * 1024u;
    const int aoff = lds_byte(wr * 64 + fr, fq * 8), boff = lds_byte(wc * 32 + fr, fq * 8);
#define PG8_SA(b, h) (((b) * 2 + (h)) * HTB)
#define PG8_SB(b, h) ((4 + (b) * 2 + (h)) * HTB)
#define PG8_STAGE(bufoff, gbase, voff) do { _Pragma("unroll") for (int _i = 0; _i < 2; ++_i) \
        __builtin_amdgcn_global_load_lds((const unsigned*)((const char*)(gbase) + (voff)[_i]), (PG8_LAS unsigned*)(lds + (bufoff) + ldsw + _i * 8192), 16, 0, 0); } while (0)
#define PG8_LDA(dst, b, h) do { _Pragma("unroll") for (int m = 0; m < 4; ++m) _Pragma("unroll") for (int k = 0; k < 2; ++k) dst[m][k] = *(const PG8_LAS bf16x8*)(lds + PG8_SA(b, h) + aoff + m * 2048 + k * 1024); } while (0)
#define PG8_LDB(dst, b, h) do { _Pragma("unroll") for (int n = 0; n < 2; ++n) _Pragma("unroll") for (int k = 0; k < 2; ++k) dst[n][k] = *(const PG8_LAS bf16x8*)(lds + PG8_SB(b, h) + boff + n * 2048 + k * 1024); } while (0)
#define PG8_MMA(ai, bj, At, Bt) do { __builtin_amdgcn_s_setprio(1); _Pragma("unroll") for (int m = 0; m < 4; ++m) _Pragma("unroll") for (int n = 0; n < 2; ++n) _Pragma("unroll") for (int k = 0; k < 2; ++k) \
        acc[ai][bj][m][n] = __builtin_amdgcn_mfma_f32_16x16x32_bf16(Bt[n][k], At[m][k], acc[ai][bj][m][n], 0, 0, 0); __builtin_amdgcn_s_setprio(0); } while (0)
#define PG8_WAIT_V(n) asm volatile("s_waitcnt vmcnt(" #n ")" ::: "memory")
#define PG8_WAIT_L(n) asm volatile("s_waitcnt lgkmcnt(" #n ")" ::: "memory")
#define PG8_BAR __builtin_amdgcn_s_barrier()
#define PG8_SCHED __builtin_amdgcn_sched_barrier(0)
    Unit cur, nxt; int ui = 0;
    if (!S.next(0, cur)) return;
    f32x4 acc[2][2][4][2];
#pragma unroll
    for (int a = 0; a < 2; ++a)
#pragma unroll
        for (int b = 0; b < 2; ++b)
#pragma unroll
            for (int m = 0; m < 4; ++m)
#pragma unroll
                for (int n = 0; n < 2; ++n) acc[a][b][m][n] = (f32x4){0.f, 0.f, 0.f, 0.f};
    bf16x8 At[4][2], B0[2][2], B1[2][2];
    const char* cA = (const char*)g.A + (size_t)cur.pm * tstep; const char* cB = (const char*)g.Bt + (size_t)cur.pn * tstep;
    S.a_ready(cur);
    if constexpr (SP2) {
        PG8_STAGE(PG8_SB(0, 0), cB, voffB); PG8_STAGE(PG8_SB(0, 1), cB + hstep, voffB); PG8_STAGE(PG8_SA(0, 0), cA, voffA); PG8_STAGE(PG8_SA(0, 1), cA + hstep, voffA);
        if (wr == 1) PG8_BAR;
        PG8_WAIT_V(2); PG8_BAR;
        PG8_STAGE(PG8_SB(1, 0), cB + kstep, voffB); PG8_STAGE(PG8_SA(1, 0), cA + kstep, voffA); PG8_STAGE(PG8_SB(1, 1), cB + hstep + kstep, voffB);
        PG8_WAIT_V(6); PG8_BAR;
    } else {
        PG8_STAGE(PG8_SB(0, 0), cB, voffB); PG8_STAGE(PG8_SA(0, 0), cA, voffA); PG8_STAGE(PG8_SB(0, 1), cB + hstep, voffB); PG8_STAGE(PG8_SA(0, 1), cA + hstep, voffA);
        if (wr == 1) PG8_BAR;
        PG8_WAIT_V(4); PG8_BAR;
        PG8_STAGE(PG8_SB(1, 0), cB + kstep, voffB); PG8_STAGE(PG8_SA(1, 0), cA + kstep, voffA); PG8_STAGE(PG8_SB(1, 1), cB + hstep + kstep, voffB);
        PG8_WAIT_V(6); PG8_BAR;
    }
    for (;;) {
        const bool has_next = S.next(ui + 1, nxt);
        const char* nA = has_next ? (const char*)g.A + (size_t)nxt.pm * tstep : cA; const char* nB = has_next ? (const char*)g.Bt + (size_t)nxt.pn * tstep : cB;
        for (int t = 0; t < nt; t += 2) {
            const bool last = (t == nt - 2);
            const char* a1 = cA + (size_t)(t + 1) * kstep;
            const char* a2 = last ? nA : cA + (size_t)(t + 2) * kstep; const char* b2 = last ? nB : cB + (size_t)(t + 2) * kstep;
            const char* a3 = a2 + kstep; const char* b3 = b2 + kstep;
            if (last && has_next) S.a_ready(nxt);
            if constexpr (SP2) {
            PG8_LDB(B0, 0, 0); PG8_LDB(B1, 0, 1); PG8_SCHED; PG8_LDA(At, 0, 0); PG8_STAGE(PG8_SA(1, 1), a1 + hstep, voffA);
            PG8_WAIT_V(8); PG8_WAIT_L(0); PG8_BAR; PG8_MMA(0, 0, At, B0); PG8_MMA(0, 1, At, B1); PG8_BAR; PG8_SCHED;
            PG8_LDA(At, 0, 1); PG8_STAGE(PG8_SB(0, 0), b2, voffB); PG8_STAGE(PG8_SB(0, 1), b2 + hstep, voffB); PG8_STAGE(PG8_SA(0, 0), a2, voffA);
            PG8_WAIT_V(8); PG8_WAIT_L(0); PG8_BAR; PG8_MMA(1, 0, At, B0); PG8_MMA(1, 1, At, B1); PG8_BAR; PG8_SCHED;
            PG8_LDB(B0, 1, 0); PG8_LDB(B1, 1, 1); PG8_SCHED; PG8_LDA(At, 1, 0); PG8_STAGE(PG8_SA(0, 1), a2 + hstep, voffA);
            PG8_WAIT_V(8); PG8_WAIT_L(0); PG8_BAR; PG8_MMA(0, 0, At, B0); PG8_MMA(0, 1, At, B1); PG8_BAR; PG8_SCHED;
            PG8_LDA(At, 1, 1); PG8_STAGE(PG8_SB(1, 0), b3, voffB); PG8_STAGE(PG8_SB(1, 1), b3 + hstep, voffB); PG8_STAGE(PG8_SA(1, 0), a3, voffA);
            PG8_WAIT_V(8); PG8_WAIT_L(0); PG8_BAR; PG8_MMA(1, 0, At, B0); PG8_MMA(1, 1, At, B1); PG8_BAR; PG8_SCHED;
            } else {
            PG8_LDB(B0, 0, 0); PG8_SCHED; PG8_LDA(At, 0, 0); PG8_STAGE(PG8_SA(1, 1), a1 + hstep, voffA);
            PG8_WAIT_L(8); PG8_BAR; PG8_WAIT_L(0); PG8_MMA(0, 0, At, B0); PG8_BAR; PG8_SCHED;
            PG8_LDB(B1, 0, 1); PG8_STAGE(PG8_SB(0, 0), b2, voffB);
            PG8_BAR; PG8_WAIT_L(0); PG8_MMA(0, 1, At, B1); PG8_BAR;
            PG8_LDA(At, 0, 1); PG8_STAGE(PG8_SA(0, 0), a2, voffA);
            PG8_BAR; PG8_WAIT_L(0); PG8_MMA(1, 0, At, B0); PG8_BAR; PG8_SCHED;
            PG8_STAGE(PG8_SB(0, 1), b2 + hstep, voffB);
            PG8_WAIT_V(6); PG8_BAR; PG8_MMA(1, 1, At, B1); PG8_BAR;
            PG8_LDB(B0, 1, 0); PG8_SCHED; PG8_LDA(At, 1, 0); PG8_STAGE(PG8_SA(0, 1), a2 + hstep, voffA);
            PG8_WAIT_L(8); PG8_BAR; PG8_WAIT_L(0); PG8_MMA(0, 0, At, B0); PG8_BAR; PG8_SCHED;
            PG8_LDB(B1, 1, 1); PG8_STAGE(PG8_SB(1, 0), b3, voffB);
            PG8_BAR; PG8_WAIT_L(0); PG8_MMA(0, 1, At, B1); PG8_BAR;
            PG8_LDA(At, 1, 1); PG8_STAGE(PG8_SA(1, 0), a3, voffA);
            PG8_BAR; PG8_WAIT_L(0); PG8_MMA(1, 0, At, B0); PG8_BAR; PG8_SCHED;
            PG8_STAGE(PG8_SB(1, 1), b3 + hstep, voffB);
            PG8_WAIT_V(6); PG8_BAR; PG8_MMA(1, 1, At, B1); PG8_BAR;
            }
        }
        if constexpr (ALIGN_EPI) { if (wr == 0) PG8_BAR; }
        if constexpr (!Epi::AFTER_DRAIN) { E(acc, cur, wr, wc, fr, fq); S.done(cur); }
        if (!has_next) break;
#pragma unroll
        for (int a = 0; a < 2; ++a)
#pragma unroll
            for (int b = 0; b < 2; ++b)
#pragma unroll
                for (int m = 0; m < 4; ++m)
#pragma unroll
                    for (int n = 0; n < 2; ++n) acc[a][b][m][n] = (f32x4){0.f, 0.f, 0.f, 0.f};
        cur = nxt; cA = nA; cB = nB; ++ui;
        if constexpr (ALIGN_EPI) { if (wr == 1) PG8_BAR; }
    }
    PG8_WAIT_V(0);
    if constexpr (!ALIGN_EPI) { if (wr == 0) PG8_BAR; }
    PG8_BAR;
    if constexpr (Epi::AFTER_DRAIN) { E.fused(acc, cur, wr, wc, fr, fq, lds, wid, lane); S.done(cur); }
#undef PG8_SA
#undef PG8_SB
#undef PG8_STAGE
#undef PG8_LDA
#undef PG8_LDB
#undef PG8_MMA
#undef PG8_WAIT_V
#undef PG8_WAIT_L
#undef PG8_BAR
#undef PG8_SCHED
}
}
namespace pg8 {
struct EpiProj {
    static constexpr bool PERM = true, AFTER_DRAIN = false;
    bf16_t* O; int ldc; int gelu_tiles;
    __device__ __forceinline__ void operator()(const f32x4 (&acc)[2][2][4][2], const Unit& u, int wr, int wc, int fr, int fq) const {
        const int row0 = u.pm * BM + wr * 64 + fr; const int col0 = u.pn * BM + wc * 32 + 8 * fq;
        const bool act = u.pn < gelu_tiles;
#pragma unroll
        for (int ai = 0; ai < 2; ++ai)
#pragma unroll
            for (int m = 0; m < 4; ++m) { bf16_t* rowp = O + (size_t)(row0 + ai * HALF + m * 16) * ldc + col0;
#pragma unroll
                for (int bj = 0; bj < 2; ++bj) { f32x4 v0 = acc[ai][bj][m][0], v1 = acc[ai][bj][m][1];
                    if (act) { f32x2 a = gelu_pk((f32x2){v0[0], v0[1]}), b = gelu_pk((f32x2){v0[2], v0[3]}), c = gelu_pk((f32x2){v1[0], v1[1]}), d = gelu_pk((f32x2){v1[2], v1[3]});
                        v0 = (f32x4){a.x, a.y, b.x, b.y}; v1 = (f32x4){c.x, c.y, d.x, d.y}; }
                    u32x4 w; w.x = cvt_pk_bf16(v0[0], v0[1]); w.y = cvt_pk_bf16(v0[2], v0[3]); w.z = cvt_pk_bf16(v1[0], v1[1]); w.w = cvt_pk_bf16(v1[2], v1[3]);
                    *(u32x4*)(rowp + bj * HALF) = w; } }
    }
};
struct EpiResid {
    static constexpr bool PERM = false, AFTER_DRAIN = false;
    const float* base; const float* gate; float* out; int ldc;
    __device__ __forceinline__ void operator()(const f32x4 (&acc)[2][2][4][2], const Unit& u, int wr, int wc, int fr, int fq) const {
        const int row0 = u.pm * BM + wr * 64 + fr, col0 = u.pn * BM + wc * 32 + 4 * fq;
        f32x4 gv[2][2];
#pragma unroll
        for (int bj = 0; bj < 2; ++bj)
#pragma unroll
            for (int n = 0; n < 2; ++n) gv[bj][n] = *(const f32x4*)(gate + col0 + bj * HALF + n * 16);
#pragma unroll
        for (int ai = 0; ai < 2; ++ai)
#pragma unroll
            for (int m = 0; m < 4; ++m) { const size_t off = (size_t)(row0 + ai * HALF + m * 16) * ldc + col0;
#pragma unroll
                for (int bj = 0; bj < 2; ++bj)
#pragma unroll
                    for (int n = 0; n < 2; ++n) { const f32x4 b = *(const f32x4*)(base + off + bj * HALF + n * 16); *(f32x4*)(out + off + bj * HALF + n * 16) = b + gv[bj][n] * acc[ai][bj][m][n]; } }
    }
};
struct EpiResid2 {
    static constexpr bool PERM = true, AFTER_DRAIN = false;
    const float* base; const float* gate; float* out; bf16_t* xb; float* ssq; int ldc;
    __device__ __forceinline__ void operator()(const f32x4 (&acc)[2][2][4][2], const Unit& u, int wr, int wc, int fr, int fq) const {
        const int row0 = u.pm * BM + wr * 64 + fr, col0 = u.pn * BM + wc * 32 + 8 * fq;
        f32x4 gv[2][2];
#pragma unroll
        for (int bj = 0; bj < 2; ++bj)
#pragma unroll
            for (int n = 0; n < 2; ++n) gv[bj][n] = *(const f32x4*)(gate + col0 + bj * HALF + 4 * n);
#pragma unroll
        for (int ai = 0; ai < 2; ++ai)
#pragma unroll
            for (int m = 0; m < 4; ++m) { const int row = row0 + ai * HALF + m * 16; const size_t off = (size_t)row * ldc + col0; float ss = 0.f;
#pragma unroll
                for (int bj = 0; bj < 2; ++bj) {
                    const f32x4 b0 = *(const f32x4*)(base + off + bj * HALF), b1 = *(const f32x4*)(base + off + bj * HALF + 4);
                    const f32x4 v0 = b0 + gv[bj][0] * acc[ai][bj][m][0], v1 = b1 + gv[bj][1] * acc[ai][bj][m][1];
                    *(f32x4*)(out + off + bj * HALF) = v0; *(f32x4*)(out + off + bj * HALF + 4) = v1;
                    ss += (v0[0] * v0[0] + v0[1] * v0[1]) + (v0[2] * v0[2] + v0[3] * v0[3]) + (v1[0] * v1[0] + v1[1] * v1[1]) + (v1[2] * v1[2] + v1[3] * v1[3]);
                    u32x4 w; w.x = cvt_pk_bf16(v0[0], v0[1]); w.y = cvt_pk_bf16(v0[2], v0[3]); w.z = cvt_pk_bf16(v1[0], v1[1]); w.w = cvt_pk_bf16(v1[2], v1[3]);
                    *(u32x4*)(xb + off + bj * HALF) = w; }
                ss += __shfl_xor(ss, 16); ss += __shfl_xor(ss, 32);
                if (fq == 0) ssq[(size_t)row * 32 + u.pn * 4 + wc] = ss; }
    }
};
struct EpiQ {
    static constexpr bool PERM = true, AFTER_DRAIN = false;
    bf16_t* O; int ldc; const float* bias; const PG8_LAS float* rstd;
    __device__ __forceinline__ void operator()(const f32x4 (&acc)[2][2][4][2], const Unit& u, int wr, int wc, int fr, int fq) const {
        const int lrow0 = wr * 64 + fr, col0 = u.pn * BM + wc * 32 + 8 * fq;
        f32x4 bv[2][2];
#pragma unroll
        for (int bj = 0; bj < 2; ++bj)
#pragma unroll
            for (int n = 0; n < 2; ++n) bv[bj][n] = *(const f32x4*)(bias + col0 + bj * HALF + 4 * n);
#pragma unroll
        for (int ai = 0; ai < 2; ++ai)
#pragma unroll
            for (int m = 0; m < 4; ++m) { const int lrow = lrow0 + ai * HALF + m * 16; const float rs = rstd[(u.pm & 1) * BM + lrow];
                bf16_t* rowp = O + (size_t)(u.pm * BM + lrow) * ldc + col0;
#pragma unroll
                for (int bj = 0; bj < 2; ++bj) { const f32x4 v0 = acc[ai][bj][m][0] * rs + bv[bj][0], v1 = acc[ai][bj][m][1] * rs + bv[bj][1];
                    u32x4 w; w.x = cvt_pk_bf16(v0[0], v0[1]); w.y = cvt_pk_bf16(v0[2], v0[3]); w.z = cvt_pk_bf16(v1[0], v1[1]); w.w = cvt_pk_bf16(v1[2], v1[3]);
                    *(u32x4*)(rowp + bj * HALF) = w; } }
    }
};
}
#ifndef PG8_SP2
#define PG8_SP2 true
#endif
#ifndef PG8_ALIGN
#define PG8_ALIGN true
#endif
constexpr int NWAVES = 8;
constexpr int M = 16384, D = 2048;
constexpr int IN_COLS = 6152, NPROJ = 6144;
constexpr int C_UG = 0, C_VG = 1024, C_Q = 2048, C_K = 3072, C_VM = 4096, C_OM = 5120;
constexpr int NHEAD = 4, DH = 256, CH = 128, NCHUNK = M / CH;
constexpr int NEXP = 16384, PH = 8, TOPK = 16, NSEL = PH * TOPK;
constexpr float EPS = 1e-6f;
constexpr int MOD_SHM = 0, MOD_SCM = 2048, MOD_GM = 4096, MOD_SHF = 6144, MOD_SCF = 8192, MOD_GF = 10240, NMOD = 12288;
constexpr int ADA_KC = 16, ADA_KROWS = D / ADA_KC;

constexpr size_t MiB = 1u << 20;
constexpr size_t WS_CTL = 0, CTL_ZERO_BYTES = 1 * MiB;
constexpr size_t WS_MODP = 1 * MiB;
constexpr size_t WS_MODF = WS_MODP + (size_t)ADA_KC * NMOD * 4;
constexpr size_t WS_GATES = 2 * MiB;
constexpr size_t WS_SUMM = 2 * MiB + 512 * 1024;
constexpr size_t WS_MTAB = WS_SUMM + 8192;
constexpr size_t WS_NST = 3 * MiB;
constexpr size_t WS_WIN = 4 * MiB;
constexpr size_t WS_WOUT = 28 * MiB;
constexpr size_t WS_WQ = 36 * MiB;
constexpr size_t WS_IDX = 44 * MiB;
constexpr size_t WS_PG = 52 * MiB;
constexpr size_t WS_SSQP = 60 * MiB;
constexpr size_t WS_BQP = 62 * MiB, WS_BIASQ = 62 * MiB + 512 * 1024;
constexpr size_t WS_HA = 64 * MiB;
constexpr size_t WS_PROJ = 128 * MiB;
constexpr size_t WS_X1 = 192 * MiB;
constexpr size_t WS_STATE = 320 * MiB;
constexpr size_t WS_ED = 384 * MiB, WS_EU = 416 * MiB;
constexpr size_t WS_SD = 3 * MiB + 512 * 1024, WS_SU = WS_SD + 65536;
constexpr size_t WS_END = 512 * MiB;
constexpr int CW_TMO = 0, CW_CODE = 1, CW_BAR = 4096;

constexpr int RING_BYTES = 131072, LDSCTL_OFF = 151552, MISC_OFF = LDSCTL_OFF + 320, LDS_BYTES = 163840;

#define GAS __attribute__((address_space(1)))
#define LAS __attribute__((address_space(3)))
#define DI __device__ __forceinline__
typedef unsigned short bf16;
typedef unsigned v4u __attribute__((ext_vector_type(4)));
typedef unsigned v2u __attribute__((ext_vector_type(2)));
typedef float f32x4 __attribute__((ext_vector_type(4)));
typedef float f32x16 __attribute__((ext_vector_type(16)));
typedef short bf16x8 __attribute__((ext_vector_type(8)));
typedef GAS unsigned gu32;
#define RLX_AGENT __ATOMIC_RELAXED, __HIP_MEMORY_SCOPE_AGENT
#define LDS_WAIT() asm volatile("s_waitcnt lgkmcnt(0)" ::: "memory")
#define VM_WAIT() asm volatile("s_waitcnt vmcnt(0)" ::: "memory")
#define MFMA32(a, b, c) __builtin_amdgcn_mfma_f32_32x32x16_bf16((a), (b), (c), 0, 0, 0)
DI unsigned f2bf(float f) { unsigned u = __builtin_bit_cast(unsigned, f); return (u + 0x7fffu + ((u >> 16) & 1u)) >> 16; }
DI unsigned pk2(float lo, float hi) { return f2bf(lo) | (f2bf(hi) << 16); }
DI float bflo(unsigned w) { return __builtin_bit_cast(float, w << 16); }
DI float bfhi(unsigned w) { return __builtin_bit_cast(float, w & 0xffff0000u); }
DI float bf2f(unsigned short h) { return __builtin_bit_cast(float, (unsigned)h << 16); }
DI int crow(int reg, int h) { return (reg & 3) + 8 * (reg >> 2) + 4 * h; }
DI float wave_sum(float v) {
#pragma unroll
    for (int o = 1; o < 64; o <<= 1) v += __shfl_xor(v, o);
    return v;
}
DI float wave_max(float v) {
#pragma unroll
    for (int o = 1; o < 64; o <<= 1) v = fmaxf(v, __shfl_xor(v, o));
    return v;
}
DI float silu_f(float v) { return v / (1.0f + __expf(-v)); }
DI float sigmoid_f(float v) { return 1.0f / (1.0f + __expf(-v)); }
DI float gelu_f(float v) { return 0.5f * v * (1.0f + erff(v * 0.70710678118654752f)); }
typedef __bf16 bf16v2 __attribute__((ext_vector_type(2)));
#define DOT2(a, b, c) __builtin_amdgcn_fdot2_f32_bf16(__builtin_bit_cast(bf16v2, (unsigned)(a)), __builtin_bit_cast(bf16v2, (unsigned)(b)), (c), false)
DI f32x16 zero16() { f32x16 z; for (int i = 0; i < 16; ++i) z[i] = 0.f; return z; }
#define XB_TMO      128
#define XB_XCNT(j)  (256  + 64 * (j))
#define XB_XSUB(j)  (1280 + 64 * (j))
#define XB_XGEN(j)  (2304 + 64 * (j))
#define XB_TOP      3328
#define XB_TOPGEN   3392
#define XCD_BAR_WORDS 3456
#define XB_SPIN_CAP (1u << 18)

__device__ __forceinline__ unsigned xb_ld(unsigned* p)              { return __hip_atomic_load(p, __ATOMIC_RELAXED, __HIP_MEMORY_SCOPE_AGENT); }
__device__ __forceinline__ unsigned xb_add(unsigned* p, unsigned v) { return __hip_atomic_fetch_add(p, v, __ATOMIC_RELAXED, __HIP_MEMORY_SCOPE_AGENT); }
__device__ __forceinline__ unsigned xb_xcc_id() { return (unsigned)__builtin_amdgcn_s_getreg((3 << 11) | 20) & 0xFu; }
#define XB_SPIN(cond, bar) do { unsigned _sp = 0; while (cond) { __builtin_amdgcn_s_sleep(1); \
    if ((++_sp & 255u) == 0u) { if (xb_ld(&(bar)[XB_TMO])) break; if (_sp > XB_SPIN_CAP) { atomicAdd(&(bar)[XB_TMO], 1u); break; } } } } while (0)

struct XcdBarrier {
    unsigned* bar; unsigned x;
    volatile LAS unsigned* st;
};

__device__ __forceinline__ XcdBarrier xcd_barrier_post(unsigned* bar, volatile LAS unsigned* st) {
    XcdBarrier b; b.bar = bar; b.x = xb_xcc_id(); b.st = st;
    if (threadIdx.x == 0) (void)xb_add(&bar[XB_XCNT(b.x)], 1u);
    return b;
}
__device__ __forceinline__ void xcd_barrier_complete(unsigned* bar, unsigned x, unsigned& nloc, unsigned& nx) {
    const unsigned G = gridDim.x * gridDim.y * gridDim.z;
    unsigned sum, cnt, mine, sp = 0u;
    for (;;) {
        sum = 0u; cnt = 0u; mine = 0u;
#pragma unroll
        for (unsigned j = 0; j < 16; ++j) { const unsigned c = xb_ld(&bar[XB_XCNT(j)]); sum += c; cnt += (c > 0u) ? 1u : 0u; mine = (j == x) ? c : mine; }
        if (sum == G) break;
        __builtin_amdgcn_s_sleep(1);
        if ((++sp & 255u) == 0u) { if (xb_ld(&bar[XB_TMO])) break; if (sp > XB_SPIN_CAP) { atomicAdd(&bar[XB_TMO], 1u); break; } }
    }
    nloc = mine > 0u ? mine : 1u; nx = cnt > 0u ? cnt : 1u;
}

__device__ __forceinline__ void xcd_barrier(const XcdBarrier& b) {
    asm volatile("s_waitcnt vmcnt(0)" ::: "memory");
    __syncthreads();
    if (threadIdx.x == 0) {
        unsigned* bar = b.bar;
        __builtin_amdgcn_s_waitcnt(0);
        unsigned nloc = b.st[0], nx = b.st[1];
        if (nloc == 0u) { xcd_barrier_complete(bar, b.x, nloc, nx); b.st[0] = nloc; b.st[1] = nx; }
        const unsigned old = xb_add(&bar[XB_XSUB(b.x)], 1u);
        const unsigned gen = old / nloc;
        if (old + 1u == (gen + 1u) * nloc) {
            __builtin_amdgcn_fence(__ATOMIC_RELEASE, "agent");
            asm volatile("s_waitcnt vmcnt(0)" ::: "memory");
            const unsigned og = xb_add(&bar[XB_TOP], 1u);
            const unsigned tg = og / nx;
            if (og + 1u == (tg + 1u) * nx) xb_add(&bar[XB_TOPGEN], 1u);
            else XB_SPIN(xb_ld(&bar[XB_TOPGEN]) == tg, bar);
            __builtin_amdgcn_fence(__ATOMIC_ACQUIRE, "agent");
            xb_add(&bar[XB_XGEN(b.x)], 1u);
            asm volatile("s_waitcnt vmcnt(0)" ::: "memory");
        } else {
            XB_SPIN(xb_ld(&bar[XB_XGEN(b.x)]) == gen, bar);
            __builtin_amdgcn_fence(__ATOMIC_ACQUIRE, "agent");
            asm volatile("s_waitcnt vmcnt(0)" ::: "memory");
        }
    }
    __syncthreads();
}
struct Frame {
    LAS unsigned char* lds;
    volatile LAS unsigned* MISC;
    gu32* ctl;
    int tid, lane, wave, vcu, G;
    const float *x, *c, *ada_w, *ada_b, *norm_mix_g, *w_in, *b_gates, *conv_w, *conv_b, *gmlp_norm_g, *gmlp_w, *gmlp_b, *mlstm_norm_g, *w_out, *norm_ffn_g,
                *wq, *keys1, *keys2, *e_down, *e_up, *final_g;
    float* out;
    float *MODP, *MODF, *GATES, *SUMM, *MTAB, *NST, *PG;
    int* IDX;
    bf16 *WIN, *WOUT, *WQ, *HA, *PROJ, *QB, *STATE, *QC, *KC;
    unsigned char *ED, *EU; float *SD, *SU;
    float *X1, *SSQP, *BQP, *BIASQ; bf16* X1B;
};

DI void p0_transpose_item(const float* W, int K, int ldw, int nblk, bf16* WT, LAS float* scr, int item, int lane) {
    const int kb = item / nblk, nb = item % nblk, k0 = 64 * kb, n0 = 32 * nb;
#pragma unroll 8
    for (int i = 0; i < 32; ++i) { const int kk = 2 * i + (lane >> 5); scr[kk * 33 + (lane & 31)] = W[(size_t)(k0 + kk) * ldw + n0 + (lane & 31)]; }
    LDS_WAIT(); asm volatile("" ::: "memory");
    const int c = lane & 7;
#pragma unroll
    for (int j = 0; j < 4; ++j) { const int n = (lane >> 3) + 8 * j; const LAS float* s = scr + (8 * c) * 33 + n;
        v4u o; o.x = pk2(s[0 * 33], s[1 * 33]); o.y = pk2(s[2 * 33], s[3 * 33]); o.z = pk2(s[4 * 33], s[5 * 33]); o.w = pk2(s[6 * 33], s[7 * 33]);
        *(GAS v4u*)(WT + (size_t)(n0 + n) * K + k0 + 8 * c) = o; }
    LDS_WAIT(); asm volatile("" ::: "memory");
}
DI void p0_ada_item(Frame& F, LAS float* scr, int item) {
    const int cc = item % (NMOD / 256), kc = item / (NMOD / 256), k0 = kc * ADA_KROWS, col = cc * 256 + F.lane * 4;
#pragma unroll
    for (int j = 0; j < ADA_KROWS / 64; ++j) scr[F.lane + 64 * j] = silu_f(F.c[k0 + F.lane + 64 * j]);
    LDS_WAIT(); asm volatile("" ::: "memory");
    f32x4 acc = {0.f, 0.f, 0.f, 0.f};
    const float* wp = F.ada_w + (size_t)k0 * NMOD + col;
#pragma unroll 8
    for (int kk = 0; kk < ADA_KROWS; ++kk) { const float s = scr[kk]; const f32x4 w = *(const GAS f32x4*)(wp + (size_t)kk * NMOD); acc += w * s; }
    *(GAS f32x4*)(F.MODP + (size_t)kc * NMOD + col) = acc;
    LDS_WAIT(); asm volatile("" ::: "memory");
}
DI void p0a_phase(Frame& F) {
    LAS float* scr = (LAS float*)(F.lds + F.wave * 16384);
    const int gw = F.wave * F.G + F.vcu, NGW = F.G * NWAVES;
    constexpr int I_ADA = (NMOD / 256) * ADA_KC;
    constexpr int I_WIN = (D / 64) * (NPROJ / 32), I_WO = (D / 64) * (D / 32);
    constexpr int NITEMS = I_ADA + I_WIN + I_WO;
    for (int it = gw; it < NITEMS; it += NGW) {
        int r = it;
        if (r < I_ADA) { p0_ada_item(F, scr, r); continue; } r -= I_ADA;
        if (r < I_WIN) { p0_transpose_item(F.w_in, D, IN_COLS, NPROJ / 32, F.WIN, scr, r, F.lane); continue; } r -= I_WIN;
        p0_transpose_item(F.w_out, D, D, D / 32, F.WOUT, scr, r, F.lane);
    }
#pragma unroll 1
    for (int row = gw; row < 2 * NEXP; row += NGW) {
        const int tb = row >= NEXP, e = row - tb * NEXP;
        const GAS f32x4* src = (const GAS f32x4*)((tb ? F.e_up : F.e_down) + (size_t)e * D) + F.lane;
        f32x4 v[8]; float am = 0.f;
#pragma unroll
        for (int j = 0; j < 8; ++j) { v[j] = src[64 * j]; am = fmaxf(am, fmaxf(fmaxf(fabsf(v[j].x), fabsf(v[j].y)), fmaxf(fabsf(v[j].z), fabsf(v[j].w)))); }
        am = fmaxf(wave_max(am), 1e-30f);
        const float sc = am * (1.0f / 127.0f), inv = 127.0f / am;
        GAS unsigned* dst = (GAS unsigned*)((tb ? F.EU : F.ED) + (size_t)e * D) + F.lane;
        const int off = tb ? 128 : 0;
#pragma unroll
        for (int j = 0; j < 8; ++j) {
            const int q0 = (int)__builtin_rintf(v[j].x * inv) + off, q1 = (int)__builtin_rintf(v[j].y * inv) + off, q2 = (int)__builtin_rintf(v[j].z * inv) + off, q3 = (int)__builtin_rintf(v[j].w * inv) + off;
            dst[64 * j] = (unsigned)(q0 & 255) | ((unsigned)(q1 & 255) << 8) | ((unsigned)(q2 & 255) << 16) | ((unsigned)(q3 & 255) << 24);
        }
        if (F.lane == 0) (tb ? F.SU : F.SD)[e] = sc;
    }
}
DI float mod_final(Frame& F, int col) { float s = F.ada_b[col];
#pragma unroll
    for (int k = 0; k < ADA_KC; ++k) s += F.MODP[(size_t)k * NMOD + col];
    return s; }
DI void norm_tables(Frame& F, const float* g, int col_scale, int col_shift) {
    LAS float* A1 = (LAS float*)(F.lds); LAS float* B1 = (LAS float*)(F.lds + 8192);
#pragma unroll
    for (int i = 0; i < 4; ++i) { const int c = F.tid + 512 * i; A1[c] = g[c] * (1.0f + F.MODF[col_scale + c]); B1[c] = F.MODF[col_shift + c]; }
}
DI void p0_wq_item(Frame& F, LAS float* scr, int item) {
    const int lane = F.lane, nblk = D / 32, kb = item / nblk, nb = item % nblk, k0 = 64 * kb, n0 = 32 * nb;
    LAS float* gsl = scr + 64 * 33; LAS float* shl = gsl + 64;
    gsl[lane] = F.norm_ffn_g[k0 + lane] * (1.0f + mod_final(F, MOD_SCF + k0 + lane)); shl[lane] = mod_final(F, MOD_SHF + k0 + lane);
    LDS_WAIT(); asm volatile("" ::: "memory");
    float bp = 0.f;
#pragma unroll 8
    for (int i = 0; i < 32; ++i) { const int kk = 2 * i + (lane >> 5); const float w = F.wq[(size_t)(k0 + kk) * D + n0 + (lane & 31)]; scr[kk * 33 + (lane & 31)] = w * gsl[kk]; bp += w * shl[kk]; }
    bp += __shfl_xor(bp, 32);
    if (lane < 32) F.BQP[(size_t)kb * D + n0 + lane] = bp;
    LDS_WAIT(); asm volatile("" ::: "memory");
    const int c = lane & 7;
#pragma unroll
    for (int j = 0; j < 4; ++j) { const int n = (lane >> 3) + 8 * j; const LAS float* sp = scr + (8 * c) * 33 + n;
        v4u o; o.x = pk2(sp[0 * 33], sp[1 * 33]); o.y = pk2(sp[2 * 33], sp[3 * 33]); o.z = pk2(sp[4 * 33], sp[5 * 33]); o.w = pk2(sp[6 * 33], sp[7 * 33]);
        *(GAS v4u*)(F.WQ + (size_t)(n0 + n) * D + k0 + 8 * c) = o; }
    LDS_WAIT(); asm volatile("" ::: "memory");
}
DI void p0b_phase(Frame& F) {
    LAS float* A1 = (LAS float*)(F.lds); LAS float* B1 = (LAS float*)(F.lds + 8192); LAS float* WG = (LAS float*)(F.lds + 16384);
#pragma unroll
    for (int i = 0; i < 4; ++i) { const int c = F.tid + 512 * i; A1[c] = F.norm_mix_g[c] * (1.0f + mod_final(F, MOD_SCM + c)); B1[c] = mod_final(F, MOD_SHM + c); }
    { const int per = (NMOD + F.G - 1) / F.G; const int c = (int)blockIdx.x * per + F.tid; if (F.tid < per && c < NMOD) F.MODF[c] = mod_final(F, c); }
#pragma unroll
    for (int i = 0; i < 4; ++i) { const int k = F.tid + 512 * i; const f32x4 a = *(const GAS f32x4*)(F.w_in + (size_t)k * IN_COLS + NPROJ), b = *(const GAS f32x4*)(F.w_in + (size_t)k * IN_COLS + NPROJ + 4);
        WG[0 * 2048 + k] = a.x; WG[1 * 2048 + k] = a.y; WG[2 * 2048 + k] = a.z; WG[3 * 2048 + k] = a.w; WG[4 * 2048 + k] = b.x; WG[5 * 2048 + k] = b.y; WG[6 * 2048 + k] = b.z; WG[7 * 2048 + k] = b.w; }
    __syncthreads();
    const int gw = F.vcu * NWAVES + F.wave, NGW = F.G * NWAVES;
    f32x4 vn[8];
    { const GAS f32x4* xr = (const GAS f32x4*)(F.x + (size_t)gw * D) + F.lane;
#pragma unroll
      for (int j = 0; j < 8; ++j) vn[j] = xr[64 * j]; }
#pragma unroll 1
    for (int row = gw; row < M; row += NGW) {
        f32x4 v[8]; float ss = 0.f;
#pragma unroll
        for (int j = 0; j < 8; ++j) { v[j] = vn[j]; ss += (v[j].x * v[j].x + v[j].y * v[j].y) + (v[j].z * v[j].z + v[j].w * v[j].w); }
        if (row + NGW < M) { const GAS f32x4* xr = (const GAS f32x4*)(F.x + (size_t)(row + NGW) * D) + F.lane;
#pragma unroll
            for (int j = 0; j < 8; ++j) vn[j] = xr[64 * j]; }
        const float rstd = 1.0f / sqrtf(wave_sum(ss) * (1.0f / D) + EPS);
        float gd[8];
#pragma unroll
        for (int g = 0; g < 8; ++g) gd[g] = 0.f;
        GAS v2u* o8 = (GAS v2u*)(F.HA + (size_t)row * D) + F.lane;
#pragma unroll
        for (int j = 0; j < 8; ++j) {
            const f32x4 a = *(const LAS f32x4*)(A1 + 256 * j + 4 * F.lane), b = *(const LAS f32x4*)(B1 + 256 * j + 4 * F.lane);
            const f32x4 h = v[j] * rstd * a + b;
            v2u o; o.x = pk2(h.x, h.y); o.y = pk2(h.z, h.w); o8[64 * j] = o;
#pragma unroll
            for (int g = 0; g < 8; ++g) { const f32x4 w = *(const LAS f32x4*)(WG + g * 2048 + 256 * j + 4 * F.lane); gd[g] += (h.x * w.x + h.y * w.y) + (h.z * w.z + h.w * w.w); }
            asm volatile("" ::: "memory");
        }
#pragma unroll
        for (int g = 0; g < 8; ++g) gd[g] = wave_sum(gd[g]);
        if (F.lane == 0) {
#pragma unroll
            for (int g = 0; g < 8; ++g) { float p = gd[g] + F.b_gates[g];
                if (g >= 4) { p = fminf(p, 0.f) - log1pf(__expf(-fabsf(p))); }
                F.GATES[(size_t)row * 8 + g] = p; }
        }
    }
    __syncthreads();
    {
        LAS float* scr = (LAS float*)(F.lds + F.wave * 8960);
        for (int it = F.wave * F.G + F.vcu; it < (D / 64) * (D / 32); it += NGW) p0_wq_item(F, scr, it);
    }
}
constexpr int IMG_PITCH = 576, M1_WL = 73728, M1_RED = 74240;
typedef short s16x4 __attribute__((ext_vector_type(4)));
DI bf16x8 tr_frag(const LAS unsigned char* p, int off_lo, int off_hi) {
    const s16x4 lo = __builtin_amdgcn_ds_read_tr16_b64_v4i16((LAS s16x4*)(p + off_lo));
    const s16x4 hi = __builtin_amdgcn_ds_read_tr16_b64_v4i16((LAS s16x4*)(p + off_hi));
    return __builtin_shufflevector(lo, hi, 0, 1, 2, 3, 4, 5, 6, 7);
}
DI float bfel(const v4u& w, int e) { const unsigned d = w[e >> 1]; return (e & 1) ? bfhi(d) : bflo(d); }
DI void m1_item(Frame& F, int hh, int kc) {
    LAS unsigned char* IMG = F.lds; LAS float* WL = (LAS float*)(F.lds + M1_WL); LAS float* RED = (LAS float*)(F.lds + M1_RED);
    const int t0 = kc * CH, lane = F.lane, tid = F.tid;
    if (F.wave == 0) {
        const float* gp = F.GATES + (size_t)(t0 + 2 * lane) * 8;
        const float i0 = gp[hh], lf0 = gp[4 + hh], i1 = gp[8 + hh], lf1 = gp[12 + hh];
        const float p = lf0 + lf1; float inc = p;
#pragma unroll
        for (int o = 1; o < 64; o <<= 1) { const float t = __shfl_up(inc, o); if (lane >= o) inc += t; }
        const float A = __shfl(inc, 63), ex = inc - p, b0 = ex + lf0, b1 = ex + p;
        const float lw0 = A - b0 + i0, lw1 = A - b1 + i1;
        const float B = wave_max(fmaxf(lw0, lw1));
        WL[2 * lane] = __expf(lw0 - B); WL[2 * lane + 1] = __expf(lw1 - B);
        if (lane == 0) { F.SUMM[(hh * NCHUNK + kc) * 2] = A; F.SUMM[(hh * NCHUNK + kc) * 2 + 1] = B; }
    }
    __syncthreads();
    const int dg = tid & 31, sg = tid >> 5;
#pragma unroll 1
    for (int which = 0; which < 2; ++which) {
        const int chb = (which == 0 ? 1024 : 0) + hh * DH + dg * 8;
        const int colb = (which == 0 ? C_K : C_Q) + hh * DH + dg * 8;
        v4u raw[11];
#pragma unroll
        for (int rr = 0; rr < 11; ++rr) { const int tt = t0 + sg * 8 - 3 + rr; raw[rr] = (v4u){0u, 0u, 0u, 0u}; if (tt >= 0) raw[rr] = *(const GAS v4u*)(F.PROJ + (size_t)tt * NPROJ + colb); }
        float wl[8];
#pragma unroll
        for (int i = 0; i < 8; ++i) wl[i] = (which == 0) ? WL[sg * 8 + i] : 0.0625f;
        v4u o1[8], o2[8];
#pragma unroll
        for (int dw = 0; dw < 4; ++dw) {
            typedef float f32x2 __attribute__((ext_vector_type(2)));
            f32x2 cw[4];
#pragma unroll
            for (int j = 0; j < 4; ++j) cw[j] = *(const GAS f32x2*)(F.conv_w + j * 2048 + chb + 2 * dw);
            const f32x2 cb = *(const GAS f32x2*)(F.conv_b + chb + 2 * dw);
            float xl[11], xh[11];
#pragma unroll
            for (int rr = 0; rr < 11; ++rr) { xl[rr] = bflo(raw[rr][dw]); xh[rr] = bfhi(raw[rr][dw]); }
            float d0 = 0.f, d1 = 0.f;
#pragma unroll
            for (int i = 0; i < 8; ++i) {
                float a0 = cb.x, a1 = cb.y;
#pragma unroll
                for (int j = 0; j < 4; ++j) { a0 += cw[j].x * xl[i + j]; a1 += cw[j].y * xh[i + j]; }
                a0 = silu_f(a0); a1 = silu_f(a1);
                if (which == 0) { o1[i][dw] = pk2(a0, a1); a0 *= wl[i]; a1 *= wl[i]; d0 += a0; d1 += a1; o2[i][dw] = pk2(a0, a1); }
                else { o1[i][dw] = pk2(a0 * wl[i], a1 * wl[i]); }
            }
            if (which == 0) { RED[sg * 256 + dg * 8 + 2 * dw] = d0; RED[sg * 256 + dg * 8 + 2 * dw + 1] = d1; }
            asm volatile("" ::: "memory");
        }
#pragma unroll
        for (int i = 0; i < 8; ++i) { const int s = sg * 8 + i, t = t0 + s;
            if (which == 0) { *(GAS v4u*)(F.KC + (size_t)t * 1024 + hh * DH + dg * 8) = o1[i]; *(LAS v4u*)(IMG + s * IMG_PITCH + dg * 16) = o2[i]; }
            else { *(GAS v4u*)(F.QC + (size_t)t * 1024 + hh * DH + dg * 8) = o1[i]; } }
    }
    __syncthreads();
    if (tid < 256) { float s = 0.f;
#pragma unroll
        for (int i = 0; i < 16; ++i) s += RED[i * 256 + tid];
        F.NST[(size_t)(hh * NCHUNK + kc) * DH + tid] = s; }
    const int r = lane & 31, h = lane >> 5, e0 = F.wave * 32;
    bf16x8 bf[8];
#pragma unroll
    for (int ks = 0; ks < 8; ++ks) {
        const bf16* vp = F.PROJ + (size_t)(t0 + ks * 16 + 8 * h) * NPROJ + C_VM + hh * DH + e0 + r;
#pragma unroll
        for (int j = 0; j < 8; ++j) bf[ks][j] = (short)vp[(size_t)j * NPROJ];
    }
    bf16* sp = F.STATE + (size_t)(hh * NCHUNK + kc) * (DH * DH) + (size_t)(e0 + r) * DH;
    const LAS unsigned char* trb = IMG + (8 * h + ((lane & 15) >> 2)) * IMG_PITCH + (16 * ((lane >> 4) & 1) + 4 * (lane & 3)) * 2;
#pragma unroll 1
    for (int dt = 0; dt < 8; ++dt) {
        f32x16 acc = zero16();
#pragma unroll
        for (int ks = 0; ks < 8; ++ks) { const bf16x8 af = tr_frag(trb + dt * 64, ks * 16 * IMG_PITCH, ks * 16 * IMG_PITCH + 4 * IMG_PITCH); acc = MFMA32(af, bf[ks], acc); }
#pragma unroll
        for (int g = 0; g < 4; ++g) { v2u o; o.x = pk2(acc[4 * g], acc[4 * g + 1]); o.y = pk2(acc[4 * g + 2], acc[4 * g + 3]);
            *(GAS v2u*)(sp + dt * 32 + 8 * g + 4 * h) = o; }
    }
    __syncthreads();
}
DI void gmlp_item(Frame& F, int n, int g) {
    LAS float* RSTD = (LAS float*)F.lds;
    const int t0 = n * CH, c0 = g * 128, lane = F.lane, tid = F.tid;
    { const int s = tid >> 2, qd = tid & 3; const bf16* vp = F.PROJ + (size_t)(t0 + s) * NPROJ + C_VG + c0 + qd * 32; float ss = 0.f;
#pragma unroll
        for (int i = 0; i < 4; ++i) { const v4u w = *(const GAS v4u*)(vp + 8 * i);
            const float a0 = bflo(w.x), a1 = bfhi(w.x), a2 = bflo(w.y), a3 = bfhi(w.y), a4 = bflo(w.z), a5 = bfhi(w.z), a6 = bflo(w.w), a7 = bfhi(w.w);
            ss += (a0 * a0 + a1 * a1) + (a2 * a2 + a3 * a3) + (a4 * a4 + a5 * a5) + (a6 * a6 + a7 * a7); }
        ss += __shfl_xor(ss, 1); ss += __shfl_xor(ss, 2);
        if (qd == 0) RSTD[s] = 1.0f / sqrtf(ss * (1.0f / 128.0f) + EPS); }
    __syncthreads();
    const int r = lane & 31, h = lane >> 5, ct = F.wave & 3, tp = F.wave >> 2;
    bf16x8 af[8];
#pragma unroll
    for (int ks = 0; ks < 8; ++ks) {
        const bf16* vp = F.PROJ + (size_t)(t0 + ks * 16 + 8 * h) * NPROJ + C_VG + c0 + ct * 32 + r;
#pragma unroll
        for (int j = 0; j < 8; ++j) af[ks][j] = (short)vp[(size_t)j * NPROJ];
    }
    float ng[16];
#pragma unroll
    for (int reg = 0; reg < 16; ++reg) ng[reg] = F.gmlp_norm_g[g * 128 + ct * 32 + crow(reg, h)];
#pragma unroll 1
    for (int ti = 0; ti < 2; ++ti) {
        const int tt = (ti == 0) ? tp : 3 - tp;
        const int t = tt * 32 + r;
        const float* wrow = F.gmlp_w + (size_t)(g * 128 + t) * 128;
        f32x16 acc = zero16();
#pragma unroll
        for (int ks = 0; ks < 8; ++ks) {
            if (ks <= 2 * tt + 1) {
                const int s0 = ks * 16 + 8 * h;
                const f32x4 wa = *(const GAS f32x4*)(wrow + s0), wb = *(const GAS f32x4*)(wrow + s0 + 4);
                const f32x4 ra = *(const LAS f32x4*)(RSTD + s0), rb = *(const LAS f32x4*)(RSTD + s0 + 4);
                float wv[8] = {wa.x * ra.x, wa.y * ra.y, wa.z * ra.z, wa.w * ra.w, wb.x * rb.x, wb.y * rb.y, wb.z * rb.z, wb.w * rb.w};
#pragma unroll
                for (int j = 0; j < 8; ++j) if (s0 + j > t) wv[j] = 0.f;
                v4u bw; bw.x = pk2(wv[0], wv[1]); bw.y = pk2(wv[2], wv[3]); bw.z = pk2(wv[4], wv[5]); bw.w = pk2(wv[6], wv[7]);
                acc = MFMA32(af[ks], __builtin_bit_cast(bf16x8, bw), acc);
            }
        }
        const float bsp = F.gmlp_b[g * 128 + t];
        const bf16* up = F.PROJ + (size_t)(t0 + t) * NPROJ + C_UG + c0 + ct * 32;
        bf16* yp = F.HA + (size_t)(t0 + t) * D + c0 + ct * 32;
#pragma unroll
        for (int gq = 0; gq < 4; ++gq) { const int cl = 8 * gq + 4 * h;
            const v2u uw = *(const GAS v2u*)(up + cl);
            const float y0 = bflo(uw.x) * (ng[4 * gq] * acc[4 * gq] + bsp), y1 = bfhi(uw.x) * (ng[4 * gq + 1] * acc[4 * gq + 1] + bsp);
            const float y2 = bflo(uw.y) * (ng[4 * gq + 2] * acc[4 * gq + 2] + bsp), y3 = bfhi(uw.y) * (ng[4 * gq + 3] * acc[4 * gq + 3] + bsp);
            v2u o; o.x = pk2(y0, y1); o.y = pk2(y2, y3); *(GAS v2u*)(yp + cl) = o; }
    }
    __syncthreads();
}
DI void p2_phase(Frame& F) {
    constexpr int N_M1 = NHEAD * NCHUNK, N_G = (M / CH) * 8;
#pragma unroll 1
    for (int it = (int)blockIdx.x; it < N_M1; it += F.G) m1_item(F, it / NCHUNK, it % NCHUNK);
#pragma unroll 1
    for (int j = (int)blockIdx.x; j < N_G; j += F.G) gmlp_item(F, j % (M / CH), j / (M / CH));
}
DI void p3_phase(Frame& F) {
    LAS float* TAB = (LAS float*)F.lds;
    const int lane = F.lane;
    if (F.wave < NHEAD) {
        const int hh = F.wave; const float* sp = F.SUMM + (size_t)(hh * NCHUNK + 2 * lane) * 2;
        const float A0 = sp[0], B0 = sp[1], A1 = sp[2], B1 = sp[3];
        float ca = A0 + A1, cb = fmaxf(B0 + A1, B1);
        const float pa = ca, pb = cb;
#pragma unroll
        for (int o = 1; o < 64; o <<= 1) { const float ta = __shfl_up(ca, o), tb = __shfl_up(cb, o); if (lane >= o) { cb = fmaxf(tb + ca, cb); ca = ta + ca; } }
        (void)pa; (void)pb;
        float ea = __shfl_up(ca, 1), eb = __shfl_up(cb, 1);
        float m0 = (lane == 0) ? 0.f : fmaxf(ea, eb);
        const float m1 = fmaxf(m0 + A0, B0), m2 = fmaxf(m1 + A1, B1);
        TAB[(hh * NCHUNK + 2 * lane) * 2] = __expf(A0 + m0 - m1); TAB[(hh * NCHUNK + 2 * lane) * 2 + 1] = __expf(B0 - m1);
        TAB[(hh * NCHUNK + 2 * lane + 1) * 2] = __expf(A1 + m1 - m2); TAB[(hh * NCHUNK + 2 * lane + 1) * 2 + 1] = __expf(B1 - m2);
        if (blockIdx.x == 0) { F.MTAB[hh * NCHUNK + 2 * lane] = m0; F.MTAB[hh * NCHUNK + 2 * lane + 1] = m1; }
    }
    __syncthreads();
    const int NT = F.G * NWAVES * 64, gt = (int)blockIdx.x * (NWAVES * 64) + F.tid;
    if (gt < D) { float b = 0.f;
#pragma unroll 8
        for (int k = 0; k < D / 64; ++k) b += F.BQP[(size_t)k * D + gt];
        F.BIASQ[gt] = b; }
    for (int p = gt; p < NHEAD * (DH * DH / 2); p += NT) {
        const int hh = p / (DH * DH / 2), q = p % (DH * DH / 2);
        GAS unsigned* sp = (GAS unsigned*)(F.STATE + (size_t)hh * NCHUNK * (DH * DH)) + q;
        float s0 = 0.f, s1 = 0.f;
#pragma unroll 1
        for (int k0 = 0; k0 < NCHUNK; k0 += 16) {
            unsigned ld[16];
#pragma unroll
            for (int k = 0; k < 16; ++k) ld[k] = sp[(size_t)(k0 + k) * (DH * DH / 2)];
#pragma unroll
            for (int k = 0; k < 16; ++k) {
                sp[(size_t)(k0 + k) * (DH * DH / 2)] = pk2(s0, s1);
                const float dec = TAB[(hh * NCHUNK + k0 + k) * 2], wb = TAB[(hh * NCHUNK + k0 + k) * 2 + 1];
                s0 = dec * s0 + wb * bflo(ld[k]); s1 = dec * s1 + wb * bfhi(ld[k]);
            }
        }
    }
    for (int p = gt; p < NHEAD * DH; p += NT) {
        const int hh = p / DH, d = p % DH; float* np = F.NST + (size_t)hh * NCHUNK * DH + d; float s = 0.f;
#pragma unroll 8
        for (int k = 0; k < NCHUNK; ++k) { const float ld = np[(size_t)k * DH]; np[(size_t)k * DH] = s; s = TAB[(hh * NCHUNK + k) * 2] * s + TAB[(hh * NCHUNK + k) * 2 + 1] * ld; }
    }
}
constexpr int M3_VIMG = 8192, M3_QIMG = 81920, QPITCH = 528;
DI void m3_item(Frame& F, int hh, int kc) {
    LAS float* GS = (LAS float*)F.lds; LAS float* MX = (LAS float*)(F.lds + 512); LAS float* BT = (LAS float*)(F.lds + 1024);
    LAS float* NK = (LAS float*)(F.lds + 2048); LAS float* XCH = (LAS float*)(F.lds + 4096);
    LAS unsigned char* VIMG = F.lds + M3_VIMG; LAS unsigned char* QIMG = F.lds + M3_QIMG;
    const int t0 = kc * CH, lane = F.lane, tid = F.tid, item = hh * NCHUNK + kc;
    const float mk = F.MTAB[item];
    if (F.wave == 0) {
        const float* gp = F.GATES + (size_t)(t0 + 2 * lane) * 8;
        const float i0 = gp[hh], lf0 = gp[4 + hh], i1 = gp[8 + hh], lf1 = gp[12 + hh];
        const float p = lf0 + lf1; float inc = p;
#pragma unroll
        for (int o = 1; o < 64; o <<= 1) { const float t = __shfl_up(inc, o); if (lane >= o) inc += t; }
        const float ex = inc - p, b0 = ex + lf0, b1 = ex + p;
        const float g0 = i0 - b0, g1 = i1 - b1;
        float cm = fmaxf(g0, g1);
#pragma unroll
        for (int o = 1; o < 64; o <<= 1) { const float t = __shfl_up(cm, o); if (lane >= o) cm = fmaxf(cm, t); }
        float pm = __shfl_up(cm, 1); if (lane == 0) pm = -INFINITY;
        const float M0 = fmaxf(mk, fmaxf(pm, g0)), M1 = fmaxf(M0, g1);
        GS[2 * lane] = g0; GS[2 * lane + 1] = g1; MX[2 * lane] = M0; MX[2 * lane + 1] = M1; BT[2 * lane] = b0; BT[2 * lane + 1] = b1;
    }
    if (tid < 256) NK[tid] = F.NST[(size_t)item * DH + tid];
    unsigned touch;
    {
        const unsigned* c0 = (const unsigned*)(F.STATE + (size_t)item * (DH * DH)) + (size_t)tid * 32;
        const unsigned* k0 = (const unsigned*)(F.KC + (size_t)(t0 + (tid >> 2)) * 1024 + hh * DH) + (tid & 3) * 32;
        touch = *(const volatile unsigned*)c0; touch = *(const volatile unsigned*)(c0 + 512 * 32); touch = *(const volatile unsigned*)k0;
    }
    {
        v4u tv[8], tq[8];
#pragma unroll
        for (int i = 0; i < 8; ++i) { const int c = tid + 512 * i, row = c >> 5, c16 = c & 31;
            tv[i] = *(const GAS v4u*)(F.PROJ + (size_t)(t0 + row) * NPROJ + C_VM + hh * DH + c16 * 8); tq[i] = *(const GAS v4u*)(F.QC + (size_t)(t0 + row) * 1024 + hh * DH + c16 * 8); }
#pragma unroll
        for (int i = 0; i < 8; ++i) { const int c = tid + 512 * i, row = c >> 5, c16 = c & 31;
            *(LAS v4u*)(VIMG + row * IMG_PITCH + c16 * 16) = tv[i]; *(LAS v4u*)(QIMG + row * QPITCH + c16 * 16) = tq[i]; }
    }
    (void)touch;
    __syncthreads();
    const int r = lane & 31, h = lane >> 5, tt = F.wave & 3, eh = F.wave >> 2;
    const int tl = tt * 32 + r, t = t0 + tl;
    const float Mt = MX[tl], winter = __expf(mk - Mt);
    f32x16 accH[4];
#pragma unroll
    for (int i = 0; i < 4; ++i) accH[i] = zero16();
    float qn = 0.f;
    const LAS unsigned char* qb = QIMG + tl * QPITCH + 16 * h;
    const bf16* kp = F.KC + (size_t)(t0 + r) * 1024 + hh * DH + 8 * h;
    const bf16* cp = F.STATE + (size_t)item * (DH * DH) + (size_t)(eh * 128 + r) * DH + 8 * h;
#ifndef M3_NOQC
    {
#pragma unroll 2
        for (int ks = 0; ks < 16; ++ks) {
            const v4u qw = *(const LAS v4u*)(qb + 32 * ks);
            float qv[8] = {bflo(qw.x), bfhi(qw.x), bflo(qw.y), bfhi(qw.y), bflo(qw.z), bfhi(qw.z), bflo(qw.w), bfhi(qw.w)};
            const f32x4 na = *(const LAS f32x4*)(NK + ks * 16 + 8 * h), nb = *(const LAS f32x4*)(NK + ks * 16 + 8 * h + 4);
            qn += (qv[0] * na.x + qv[1] * na.y) + (qv[2] * na.z + qv[3] * na.w) + (qv[4] * nb.x + qv[5] * nb.y) + (qv[6] * nb.z + qv[7] * nb.w);
            v4u q2; q2.x = pk2(qv[0] * winter, qv[1] * winter); q2.y = pk2(qv[2] * winter, qv[3] * winter); q2.z = pk2(qv[4] * winter, qv[5] * winter); q2.w = pk2(qv[6] * winter, qv[7] * winter);
            const bf16x8 q2f = __builtin_bit_cast(bf16x8, q2);
#pragma unroll
            for (int et = 0; et < 4; ++et) { const bf16x8 cf = *(const GAS bf16x8*)(cp + (size_t)et * 32 * DH + ks * 16); accH[et] = MFMA32(cf, q2f, accH[et]); }
        }
    }
#endif
    qn += __shfl_xor(qn, 32);
    float den = 0.f;
    const LAS unsigned char* vtr = VIMG + (4 * h + ((lane & 15) >> 2)) * IMG_PITCH + (eh * 128 + 16 * ((lane >> 4) & 1) + 4 * (lane & 3)) * 2;
#ifdef M3_NOST
    for (int st = 0; st < 0; ++st) {
#else
#pragma unroll 1
    for (int st = 0; st <= tt; ++st) {
#endif
        f32x16 accS = zero16();
        const bf16* kps = kp + (size_t)st * 32 * 1024;
#pragma unroll 4
        for (int ks = 0; ks < 16; ++ks) { const bf16x8 kf = *(const GAS bf16x8*)(kps + ks * 16); const bf16x8 qf = *(const LAS bf16x8*)(qb + 32 * ks); accS = MFMA32(kf, qf, accS); }
        float xv[16];
#pragma unroll
        for (int reg = 0; reg < 16; ++reg) { const int sl = st * 32 + crow(reg, h); float v = accS[reg] * __expf(GS[sl] - Mt); if (sl > tl) v = 0.f; xv[reg] = v; den += v; }
        const LAS unsigned char* vb2 = vtr + st * 32 * IMG_PITCH;
#pragma unroll
        for (int k2 = 0; k2 < 2; ++k2) {
            v4u xw; xw.x = pk2(xv[8 * k2], xv[8 * k2 + 1]); xw.y = pk2(xv[8 * k2 + 2], xv[8 * k2 + 3]); xw.z = pk2(xv[8 * k2 + 4], xv[8 * k2 + 5]); xw.w = pk2(xv[8 * k2 + 6], xv[8 * k2 + 7]);
            const bf16x8 xs = __builtin_bit_cast(bf16x8, xw);
#pragma unroll
            for (int et = 0; et < 4; ++et) {
                const bf16x8 vf = tr_frag(vb2 + et * 64, 16 * k2 * IMG_PITCH, 16 * k2 * IMG_PITCH + 8 * IMG_PITCH);
                accH[et] = MFMA32(vf, xs, accH[et]);
            }
        }
    }
    den += __shfl_xor(den, 32);
    den += winter * qn;
    const float dnm = fmaxf(fabsf(den), __expf(-(BT[tl] + Mt))), inv = 1.0f / dnm;
    float ss = 0.f;
#pragma unroll
    for (int et = 0; et < 4; ++et)
#pragma unroll
        for (int reg = 0; reg < 16; ++reg) { accH[et][reg] *= inv; ss += accH[et][reg] * accH[et][reg]; }
    ss += __shfl_xor(ss, 32);
    if (h == 0) XCH[eh * 128 + tl] = ss;
    __syncthreads();
    const float rstd = 1.0f / sqrtf((XCH[tl] + XCH[128 + tl]) * (1.0f / DH) + EPS);
    const bf16* op = F.PROJ + (size_t)t * NPROJ + C_OM + hh * DH + eh * 128;
    bf16* yp = F.HA + (size_t)t * D + 1024 + hh * DH + eh * 128;
    const float* ngp = F.mlstm_norm_g + hh * DH + eh * 128;
#pragma unroll
    for (int et = 0; et < 4; ++et)
#pragma unroll
        for (int gq = 0; gq < 4; ++gq) { const int el = et * 32 + 8 * gq + 4 * h;
            const v2u ow = *(const GAS v2u*)(op + el); const f32x4 gn = *(const GAS f32x4*)(ngp + el);
            const float y0 = accH[et][4 * gq] * rstd * gn.x * sigmoid_f(bflo(ow.x)), y1 = accH[et][4 * gq + 1] * rstd * gn.y * sigmoid_f(bfhi(ow.x));
            const float y2 = accH[et][4 * gq + 2] * rstd * gn.z * sigmoid_f(bflo(ow.y)), y3 = accH[et][4 * gq + 3] * rstd * gn.w * sigmoid_f(bfhi(ow.y));
            v2u o; o.x = pk2(y0, y1); o.y = pk2(y2, y3); *(GAS v2u*)(yp + el) = o; }
    __syncthreads();
}
DI void p4_phase(Frame& F) {
    for (int it = (int)blockIdx.x; it < NHEAD * NCHUNK; it += F.G) m3_item(F, it / NCHUNK, it % NCHUNK);
}
DI void p6_phase(Frame& F) {
    LAS float* A1 = (LAS float*)(F.lds); LAS float* B1 = (LAS float*)(F.lds + 8192);
    norm_tables(F, F.norm_ffn_g, MOD_SCF, MOD_SHF);
    __syncthreads();
    const int gw = F.vcu * NWAVES + F.wave, NGW = F.G * NWAVES;
    for (int row = gw; row < M; row += NGW) {
        const GAS f32x4* xr = (const GAS f32x4*)(F.X1 + (size_t)row * D) + F.lane;
        f32x4 v[8]; float ss = 0.f;
#pragma unroll
        for (int j = 0; j < 8; ++j) { v[j] = xr[64 * j]; ss += (v[j].x * v[j].x + v[j].y * v[j].y) + (v[j].z * v[j].z + v[j].w * v[j].w); }
        const float rstd = 1.0f / sqrtf(wave_sum(ss) * (1.0f / D) + EPS);
        GAS v2u* o8 = (GAS v2u*)(F.HA + (size_t)row * D) + F.lane;
#pragma unroll
        for (int j = 0; j < 8; ++j) {
            const f32x4 a = *(const LAS f32x4*)(A1 + 256 * j + 4 * F.lane), b = *(const LAS f32x4*)(B1 + 256 * j + 4 * F.lane);
            const f32x4 h = v[j] * rstd * a + b;
            v2u o; o.x = pk2(h.x, h.y); o.y = pk2(h.z, h.w); o8[64 * j] = o;
        }
    }
}
constexpr int KPITCH = 272, P8_TBL = 69632;
DI void topk_insert(float (&L)[16], float x) {
#pragma unroll
    for (int i = 15; i >= 1; --i) L[i] = __builtin_amdgcn_fmed3f(x, L[i - 1], L[i]);
    L[0] = fmaxf(L[0], x);
}
DI void p8_phase(Frame& F) {
    LAS unsigned char* KIMG = F.lds; LAS unsigned char* TBL = F.lds + P8_TBL + F.wave * 1024;
    const int lane = F.lane, tid = F.tid, r = lane & 31, h = lane >> 5;
#pragma unroll 4
    for (int i = 0; i < 16; ++i) { const int idx = tid * 4 + 2048 * i, side = idx >> 14, rem = idx & 16383, row = rem >> 7, col = rem & 127;
        const f32x4 a = *(const GAS f32x4*)((side ? F.keys2 : F.keys1) + rem);
        v2u o; o.x = pk2(a.x, a.y); o.y = pk2(a.z, a.w); *(LAS v2u*)(KIMG + (side * 128 + row) * KPITCH + col * 2) = o; }
    __syncthreads();
    for (int it = (int)blockIdx.x; it < (M / 256) * PH; it += F.G) {
        const int tile = it / PH, hd = it % PH;
        const int t = tile * 256 + F.wave * 32 + r;
        float L1[16], L2[16];
#pragma unroll 1
        for (int side = 0; side < 2; ++side) {
            f32x16 acc[4];
#pragma unroll
            for (int kt = 0; kt < 4; ++kt) acc[kt] = zero16();
            const bf16* qp = F.QB + (size_t)t * D + hd * 256 + side * 128 + 8 * h;
#pragma unroll
            for (int ks = 0; ks < 8; ++ks) {
                const bf16x8 qf = *(const GAS bf16x8*)(qp + ks * 16);
#pragma unroll
                for (int kt = 0; kt < 4; ++kt) { const bf16x8 kf = *(const LAS bf16x8*)(KIMG + (side * 128 + kt * 32 + r) * KPITCH + (ks * 16 + 8 * h) * 2); acc[kt] = MFMA32(kf, qf, acc[kt]); }
            }
            float L[16];
#pragma unroll
            for (int i = 0; i < 16; ++i) L[i] = -3.0e38f;
#pragma unroll
            for (int kt = 0; kt < 4; ++kt)
#pragma unroll
                for (int reg = 0; reg < 16; ++reg) { const unsigned key = (unsigned)(kt * 32 + crow(reg, h)); const float sv = acc[kt][reg];
                    topk_insert(L, __uint_as_float((__float_as_uint(sv) & ~127u) | key)); }
            float P[16];
#pragma unroll
            for (int i = 0; i < 16; ++i) P[i] = __shfl_xor(L[i], 32);
#pragma unroll
            for (int i = 0; i < 16; ++i) topk_insert(L, P[i]);
            if (side == 0) {
#pragma unroll
                for (int i = 0; i < 16; ++i) L1[i] = L[i];
            } else {
#pragma unroll
                for (int i = 0; i < 16; ++i) L2[i] = L[i];
            }
        }
        if (h == 0) {
#pragma unroll
            for (int w = 0; w < 4; ++w) {
                const unsigned a = (__builtin_bit_cast(unsigned, L1[4 * w]) & 127u) | ((__builtin_bit_cast(unsigned, L1[4 * w + 1]) & 127u) << 8) | ((__builtin_bit_cast(unsigned, L1[4 * w + 2]) & 127u) << 16) | ((__builtin_bit_cast(unsigned, L1[4 * w + 3]) & 127u) << 24);
                const unsigned b = (__builtin_bit_cast(unsigned, L2[4 * w]) & 127u) | ((__builtin_bit_cast(unsigned, L2[4 * w + 1]) & 127u) << 8) | ((__builtin_bit_cast(unsigned, L2[4 * w + 2]) & 127u) << 16) | ((__builtin_bit_cast(unsigned, L2[4 * w + 3]) & 127u) << 24);
                *(LAS unsigned*)(TBL + r * 32 + 4 * w) = a; *(LAS unsigned*)(TBL + r * 32 + 16 + 4 * w) = b;
            }
        }
        float T[16];
#pragma unroll
        for (int i = 0; i < 16; ++i) T[i] = -3.0e38f;
#pragma unroll
        for (int i = 0; i < 16; ++i) {
            const float v1 = __builtin_bit_cast(float, __builtin_bit_cast(unsigned, L1[i]) & ~127u);
#pragma unroll
            for (int j = 0; j < 16; ++j) if ((i + 1) * (j + 1) <= 16) {
                const float v2 = __builtin_bit_cast(float, __builtin_bit_cast(unsigned, L2[j]) & ~127u);
                topk_insert(T, __builtin_bit_cast(float, (__builtin_bit_cast(unsigned, v1 + v2) & ~255u) | (unsigned)(i * 16 + j)));
            }
        }
        LDS_WAIT(); asm volatile("" ::: "memory");
        float ev[16], esum = 0.f;
        const float mx = __builtin_bit_cast(float, __builtin_bit_cast(unsigned, T[0]) & ~255u);
#pragma unroll
        for (int i = 0; i < 16; ++i) { ev[i] = __expf(__builtin_bit_cast(float, __builtin_bit_cast(unsigned, T[i]) & ~255u) - mx); esum += ev[i]; }
        const float einv = 1.0f / esum;
        int eid[8]; float gt[8];
#pragma unroll
        for (int i = 0; i < 8; ++i) { const float tv = h ? T[8 + i] : T[i]; const float e = h ? ev[8 + i] : ev[i];
            const unsigned p = __builtin_bit_cast(unsigned, tv) & 255u;
            const unsigned i1 = *(const LAS unsigned char*)(TBL + r * 32 + (p >> 4)), i2 = *(const LAS unsigned char*)(TBL + r * 32 + 16 + (p & 15u));
            eid[i] = (int)(i1 * 128u + i2); gt[i] = e * einv; }
        int* ip = F.IDX + (size_t)t * NSEL + hd * 16 + 8 * h; float* gp = F.PG + (size_t)t * NSEL + hd * 16 + 8 * h;
        *(GAS v4u*)ip = (v4u){(unsigned)eid[0], (unsigned)eid[1], (unsigned)eid[2], (unsigned)eid[3]}; *(GAS v4u*)(ip + 4) = (v4u){(unsigned)eid[4], (unsigned)eid[5], (unsigned)eid[6], (unsigned)eid[7]};
        *(GAS f32x4*)gp = (f32x4){gt[0], gt[1], gt[2], gt[3]}; *(GAS f32x4*)(gp + 4) = (f32x4){gt[4], gt[5], gt[6], gt[7]};
        LDS_WAIT(); asm volatile("" ::: "memory");
    }
}

DI void p8_alt_phase(Frame& F) {
    const int lane = F.lane;
    const int gw = F.vcu * NWAVES + F.wave, NGW = F.G * NWAVES;
    for (int it = gw; it < (M / 64) * PH; it += NGW) {
        const int tg = it / PH, hd = it % PH, t = tg * 64 + lane;
        float L1[16], L2[16];
#pragma unroll 1
        for (int side = 0; side < 2; ++side) {
            unsigned qw[64];
            const bf16* qp = F.QB + (size_t)t * D + hd * 256 + side * 128;
#pragma unroll
            for (int i = 0; i < 16; ++i) { const v4u w = *(const GAS v4u*)(qp + 8 * i); qw[4 * i] = w.x; qw[4 * i + 1] = w.y; qw[4 * i + 2] = w.z; qw[4 * i + 3] = w.w; }
            float L[16];
#pragma unroll
            for (int i = 0; i < 16; ++i) L[i] = -3.0e38f;
            const float* kb = side ? F.keys2 : F.keys1;
#pragma unroll 1
            for (int key = 0; key < 128; ++key) {
                const float* kr = kb + key * 128; float s = 0.f;
#pragma unroll
                for (int i = 0; i < 64; ++i) s += bflo(qw[i]) * kr[2 * i] + bfhi(qw[i]) * kr[2 * i + 1];
                topk_insert(L, __builtin_bit_cast(float, (__builtin_bit_cast(unsigned, s) & ~127u) | (unsigned)key));
            }
            if (side == 0) {
#pragma unroll
                for (int i = 0; i < 16; ++i) L1[i] = L[i];
            } else {
#pragma unroll
                for (int i = 0; i < 16; ++i) L2[i] = L[i];
            }
        }
        float T[16]; int E[16];
#pragma unroll
        for (int i = 0; i < 16; ++i) { T[i] = -3.0e38f; }
#pragma unroll
        for (int i = 0; i < 16; ++i) {
            const float v1 = __builtin_bit_cast(float, __builtin_bit_cast(unsigned, L1[i]) & ~127u);
#pragma unroll
            for (int j = 0; j < 16; ++j) if ((i + 1) * (j + 1) <= 16) {
                const float v2 = __builtin_bit_cast(float, __builtin_bit_cast(unsigned, L2[j]) & ~127u);
                topk_insert(T, __builtin_bit_cast(float, (__builtin_bit_cast(unsigned, v1 + v2) & ~255u) | (unsigned)(i * 16 + j)));
            }
        }
        float esum = 0.f; float ev[16];
        const float mx = __builtin_bit_cast(float, __builtin_bit_cast(unsigned, T[0]) & ~255u);
#pragma unroll
        for (int i = 0; i < 16; ++i) { ev[i] = __expf(__builtin_bit_cast(float, __builtin_bit_cast(unsigned, T[i]) & ~255u) - mx); esum += ev[i]; }
        const float einv = 1.0f / esum;
#pragma unroll
        for (int i = 0; i < 16; ++i) { const unsigned p = __builtin_bit_cast(unsigned, T[i]) & 255u; unsigned i1 = 0, i2 = 0;
#pragma unroll
            for (int q = 0; q < 16; ++q) { if ((p >> 4) == (unsigned)q) i1 = __builtin_bit_cast(unsigned, L1[q]) & 127u; if ((p & 15u) == (unsigned)q) i2 = __builtin_bit_cast(unsigned, L2[q]) & 127u; }
            E[i] = (int)(i1 * 128u + i2); }
        int* ip = F.IDX + (size_t)t * NSEL + hd * 16; float* gp = F.PG + (size_t)t * NSEL + hd * 16;
#pragma unroll
        for (int i = 0; i < 16; ++i) { ip[i] = E[i]; gp[i] = ev[i] * einv; }
    }
}
template <int STEP> DI void xpose_step_i(int (&v)[64], int lane) {
#pragma unroll
    for (int i = 0; i < STEP; ++i) { const bool up = (lane & STEP) != 0; const int keep = up ? v[i + STEP] : v[i], send = up ? v[i] : v[i + STEP]; v[i] = keep + __shfl_xor(send, STEP); }
}
DI float ub0(unsigned u) { float f; asm("v_cvt_f32_ubyte0 %0, %1" : "=v"(f) : "v"(u)); return f; }
DI float ub1(unsigned u) { float f; asm("v_cvt_f32_ubyte1 %0, %1" : "=v"(f) : "v"(u)); return f; }
DI float ub2(unsigned u) { float f; asm("v_cvt_f32_ubyte2 %0, %1" : "=v"(f) : "v"(u)); return f; }
DI float ub3(unsigned u) { float f; asm("v_cvt_f32_ubyte3 %0, %1" : "=v"(f) : "v"(u)); return f; }
DI void p9_phase(Frame& F) {
    LAS float* A2 = (LAS float*)(F.lds); LAS float* B2 = (LAS float*)(F.lds + 8192); LAS float* GF = (LAS float*)(F.lds + 16384); LAS float* FG = (LAS float*)(F.lds + 24576);
    norm_tables(F, F.norm_ffn_g, MOD_SCF, MOD_SHF);
#pragma unroll
    for (int i = 0; i < 4; ++i) { const int c = F.tid + 512 * i; GF[c] = F.MODF[MOD_GF + c]; FG[c] = F.final_g[c]; }
    __syncthreads();
    const int lane = F.lane, gw = F.vcu * NWAVES + F.wave, NGW = F.G * NWAVES;
#pragma unroll 1
    for (int t = gw; t < M; t += NGW) {
        int hq[8]; float sh;
        {
            float hv[32]; float ss = 0.f;
            const float* xr = F.X1 + (size_t)t * D + 16 * lane;
#pragma unroll
            for (int jj = 0; jj < 2; ++jj)
#pragma unroll
                for (int q = 0; q < 4; ++q) { const f32x4 a = *(const GAS f32x4*)(xr + 1024 * jj + 4 * q); hv[16 * jj + 4 * q] = a.x; hv[16 * jj + 4 * q + 1] = a.y; hv[16 * jj + 4 * q + 2] = a.z; hv[16 * jj + 4 * q + 3] = a.w; }
#pragma unroll
            for (int i = 0; i < 32; ++i) ss += hv[i] * hv[i];
            const float rstd = 1.0f / sqrtf(wave_sum(ss) * (1.0f / D) + EPS);
            float am = 0.f;
#pragma unroll
            for (int jj = 0; jj < 2; ++jj)
#pragma unroll
                for (int q = 0; q < 4; ++q) { const f32x4 a = *(const LAS f32x4*)(A2 + 1024 * jj + 16 * lane + 4 * q), b = *(const LAS f32x4*)(B2 + 1024 * jj + 16 * lane + 4 * q);
                    const int o = 16 * jj + 4 * q;
                    hv[o] = hv[o] * rstd * a.x + b.x; hv[o + 1] = hv[o + 1] * rstd * a.y + b.y; hv[o + 2] = hv[o + 2] * rstd * a.z + b.z; hv[o + 3] = hv[o + 3] * rstd * a.w + b.w;
                    am = fmaxf(am, fmaxf(fmaxf(fabsf(hv[o]), fabsf(hv[o + 1])), fmaxf(fabsf(hv[o + 2]), fabsf(hv[o + 3])))); }
            am = fmaxf(wave_max(am), 1e-30f); sh = am * (1.0f / 127.0f); const float inv = 127.0f / am;
#pragma unroll
            for (int w = 0; w < 8; ++w) { const int q0 = (int)__builtin_rintf(hv[4 * w] * inv), q1 = (int)__builtin_rintf(hv[4 * w + 1] * inv), q2 = (int)__builtin_rintf(hv[4 * w + 2] * inv), q3 = (int)__builtin_rintf(hv[4 * w + 3] * inv);
                hq[w] = (int)((unsigned)(q0 & 255) | ((unsigned)(q1 & 255) << 8) | ((unsigned)(q2 & 255) << 16) | ((unsigned)(q3 & 255) << 24)); }
        }
        float out[32]; float csum = 0.f;
#pragma unroll
        for (int i = 0; i < 32; ++i) out[i] = 0.f;
#pragma unroll 1
        for (int b = 0; b < 2; ++b) {
            const int myidx = F.IDX[(size_t)t * NSEL + 64 * b + lane]; const float mygate = F.PG[(size_t)t * NSEL + 64 * b + lane];
            const float mysd = F.SD[myidx], mysu = F.SU[myidx];
            int p[64];
#pragma unroll
            for (int k0 = 0; k0 < 64; k0 += 4) {
                v4u w[4][2];
#pragma unroll
                for (int kk = 0; kk < 4; ++kk) { const int e = __builtin_amdgcn_readlane(myidx, k0 + kk); const unsigned char* rowp = F.ED + (size_t)e * D + 16 * lane;
                    w[kk][0] = *(const GAS v4u*)(rowp); w[kk][1] = *(const GAS v4u*)(rowp + 1024); }
#pragma unroll
                for (int kk = 0; kk < 4; ++kk) { int a = 0;
                    a = __builtin_amdgcn_sdot4(hq[0], (int)w[kk][0].x, a, false); a = __builtin_amdgcn_sdot4(hq[1], (int)w[kk][0].y, a, false); a = __builtin_amdgcn_sdot4(hq[2], (int)w[kk][0].z, a, false); a = __builtin_amdgcn_sdot4(hq[3], (int)w[kk][0].w, a, false);
                    a = __builtin_amdgcn_sdot4(hq[4], (int)w[kk][1].x, a, false); a = __builtin_amdgcn_sdot4(hq[5], (int)w[kk][1].y, a, false); a = __builtin_amdgcn_sdot4(hq[6], (int)w[kk][1].z, a, false); a = __builtin_amdgcn_sdot4(hq[7], (int)w[kk][1].w, a, false);
                    p[k0 + kk] = a; }
                asm volatile("" ::: "memory");
            }
            xpose_step_i<32>(p, lane); xpose_step_i<16>(p, lane); xpose_step_i<8>(p, lane); xpose_step_i<4>(p, lane); xpose_step_i<2>(p, lane); xpose_step_i<1>(p, lane);
            const float act = (float)p[0] * (sh * mysd);
            const float coef = mygate * gelu_f(act) * mysu;
            csum += coef;
#pragma unroll 1
            for (int k0 = 0; k0 < 64; k0 += 4) {
                v4u w[4][2]; float c[4];
#pragma unroll
                for (int kk = 0; kk < 4; ++kk) { const int e = __builtin_amdgcn_readlane(myidx, k0 + kk); c[kk] = __builtin_bit_cast(float, __builtin_amdgcn_readlane(__builtin_bit_cast(int, coef), k0 + kk));
                    const unsigned char* rowp = F.EU + (size_t)e * D + 16 * lane;
                    w[kk][0] = *(const GAS v4u*)(rowp); w[kk][1] = *(const GAS v4u*)(rowp + 1024); }
#pragma unroll
                for (int kk = 0; kk < 4; ++kk)
#pragma unroll
                    for (int jj = 0; jj < 2; ++jj) { const v4u u = w[kk][jj]; const int o = 16 * jj; const float cc = c[kk];
                        out[o] += cc * ub0(u.x); out[o + 1] += cc * ub1(u.x); out[o + 2] += cc * ub2(u.x); out[o + 3] += cc * ub3(u.x);
                        out[o + 4] += cc * ub0(u.y); out[o + 5] += cc * ub1(u.y); out[o + 6] += cc * ub2(u.y); out[o + 7] += cc * ub3(u.y);
                        out[o + 8] += cc * ub0(u.z); out[o + 9] += cc * ub1(u.z); out[o + 10] += cc * ub2(u.z); out[o + 11] += cc * ub3(u.z);
                        out[o + 12] += cc * ub0(u.w); out[o + 13] += cc * ub1(u.w); out[o + 14] += cc * ub2(u.w); out[o + 15] += cc * ub3(u.w); }
            }
        }
        const float corr = 128.0f * wave_sum(csum);
        float s2 = 0.f;
        float* orow = F.out + (size_t)t * D + 16 * lane;
#pragma unroll
        for (int jj = 0; jj < 2; ++jj)
#pragma unroll
            for (int q = 0; q < 4; ++q) { const f32x4 g = *(const LAS f32x4*)(GF + 1024 * jj + 16 * lane + 4 * q); const f32x4 xa = *(const GAS f32x4*)(orow + 1024 * jj + 4 * q); const int o = 16 * jj + 4 * q;
                out[o] = xa.x + g.x * (out[o] - corr); out[o + 1] = xa.y + g.y * (out[o + 1] - corr); out[o + 2] = xa.z + g.z * (out[o + 2] - corr); out[o + 3] = xa.w + g.w * (out[o + 3] - corr); }
#pragma unroll
        for (int i = 0; i < 32; ++i) s2 += out[i] * out[i];
        const float rstd2 = 1.0f / sqrtf(wave_sum(s2) * (1.0f / D) + EPS);
#pragma unroll
        for (int jj = 0; jj < 2; ++jj)
#pragma unroll
            for (int q = 0; q < 4; ++q) { const f32x4 f = *(const LAS f32x4*)(FG + 1024 * jj + 16 * lane + 4 * q); const int o = 16 * jj + 4 * q;
                *(GAS f32x4*)(orow + 1024 * jj + 4 * q) = (f32x4){out[o] * rstd2 * f.x, out[o + 1] * rstd2 * f.y, out[o + 2] * rstd2 * f.z, out[o + 3] * rstd2 * f.w}; }
    }
}
constexpr int P9_IDX = 131072, P9_SH = 147456, P9_CORR = 147712, P9_GF = 32768, P9_FG = 40960, P9_SSQ = 49152, NSLICE = 16, SLICE_B = 128;
#ifndef NSLICE_A
#define NSLICE_A NSLICE
#endif
#ifndef NSLICE_C
#define NSLICE_C NSLICE
#endif
template <int N, int MASK> DI void red_step_i(int (&v)[8], int lane) {
#pragma unroll
    for (int i = 0; i < N / 2; ++i) { const bool up = (lane & MASK) != 0; const int keep = up ? v[i + N / 2] : v[i], send = up ? v[i] : v[i + N / 2]; v[i] = keep + __shfl_xor(send, MASK); }
}
template <int N, int MASK> DI void red_step_f(float (&v)[16], int lane) {
#pragma unroll
    for (int i = 0; i < N / 2; ++i) { const bool up = (lane & MASK) != 0; const float keep = up ? v[i + N / 2] : v[i], send = up ? v[i] : v[i + N / 2]; v[i] = keep + __shfl_xor(send, MASK); }
}
typedef _Float16 h2v __attribute__((ext_vector_type(2)));
DI void acc4(float& o0, float& o1, float& o2, float& o3, unsigned u, float c) {
    const h2v p = __builtin_bit_cast(h2v, __builtin_amdgcn_perm(u, 0x64646464u, 0x01050004u));
    const h2v q = __builtin_bit_cast(h2v, __builtin_amdgcn_perm(u, 0x64646464u, 0x01070006u));
    o0 = __builtin_fmaf((float)p.x, c, o0); o1 = __builtin_fmaf((float)p.y, c, o1); o2 = __builtin_fmaf((float)q.x, c, o2); o3 = __builtin_fmaf((float)q.y, c, o3);
}
DI void p9v2_phase(Frame& F) {
    LAS unsigned char* HQ = F.lds; LAS float* A2 = (LAS float*)(F.lds + P9_IDX); LAS float* B2 = (LAS float*)(F.lds + P9_IDX + 8192);
    LAS unsigned short* IDX16 = (LAS unsigned short*)(F.lds + P9_IDX); LAS float* SH = (LAS float*)(F.lds + P9_SH); LAS float* CORR = (LAS float*)(F.lds + P9_CORR);
    LAS float* COEF = (LAS float*)F.lds; LAS float* GF = (LAS float*)(F.lds + P9_GF); LAS float* FG = (LAS float*)(F.lds + P9_FG);
    const int lane = F.lane, tid = F.tid, c8 = lane & 7, g = lane >> 3;
#pragma unroll 1
    for (int tb = (int)blockIdx.x * 64; tb < M; tb += F.G * 64) {
#pragma unroll
        for (int i = 0; i < 4; ++i) { const int c = tid + 512 * i; A2[c] = F.norm_ffn_g[c] * (1.0f + F.MODF[MOD_SCF + c]); B2[c] = F.MODF[MOD_SHF + c]; }
        __syncthreads();
#pragma unroll 1
        for (int j = 0; j < 8; ++j) {
            const int tl = F.wave * 8 + j, t = tb + tl;
            float hv[32]; float ss = 0.f;
            const float* xr = F.X1 + (size_t)t * D + 16 * lane;
#pragma unroll
            for (int jj = 0; jj < 2; ++jj)
#pragma unroll
                for (int q = 0; q < 4; ++q) { const f32x4 a = *(const GAS f32x4*)(xr + 1024 * jj + 4 * q); hv[16 * jj + 4 * q] = a.x; hv[16 * jj + 4 * q + 1] = a.y; hv[16 * jj + 4 * q + 2] = a.z; hv[16 * jj + 4 * q + 3] = a.w; }
#pragma unroll
            for (int i = 0; i < 32; ++i) ss += hv[i] * hv[i];
            const float rstd = 1.0f / sqrtf(wave_sum(ss) * (1.0f / D) + EPS);
            float am = 0.f;
#pragma unroll
            for (int jj = 0; jj < 2; ++jj)
#pragma unroll
                for (int q = 0; q < 4; ++q) { const f32x4 a = *(const LAS f32x4*)(A2 + 1024 * jj + 16 * lane + 4 * q), b = *(const LAS f32x4*)(B2 + 1024 * jj + 16 * lane + 4 * q);
                    const int o = 16 * jj + 4 * q;
                    hv[o] = hv[o] * rstd * a.x + b.x; hv[o + 1] = hv[o + 1] * rstd * a.y + b.y; hv[o + 2] = hv[o + 2] * rstd * a.z + b.z; hv[o + 3] = hv[o + 3] * rstd * a.w + b.w;
                    am = fmaxf(am, fmaxf(fmaxf(fabsf(hv[o]), fabsf(hv[o + 1])), fmaxf(fabsf(hv[o + 2]), fabsf(hv[o + 3])))); }
            am = fmaxf(wave_max(am), 1e-30f); const float inv = 127.0f / am;
            if (lane == 0) SH[tl] = am * (1.0f / 127.0f);
#pragma unroll
            for (int jj = 0; jj < 2; ++jj) { v4u o;
#pragma unroll
                for (int q = 0; q < 4; ++q) { const int b = 16 * jj + 4 * q;
                    const int q0 = (int)__builtin_rintf(hv[b] * inv), q1 = (int)__builtin_rintf(hv[b + 1] * inv), q2 = (int)__builtin_rintf(hv[b + 2] * inv), q3 = (int)__builtin_rintf(hv[b + 3] * inv);
                    o[q] = (unsigned)(q0 & 255) | ((unsigned)(q1 & 255) << 8) | ((unsigned)(q2 & 255) << 16) | ((unsigned)(q3 & 255) << 24); }
                *(LAS v4u*)(HQ + tl * 2048 + 1024 * jj + 16 * lane) = o; }
        }
        __syncthreads();
#pragma unroll
        for (int i = 0; i < 16; ++i) { const int q = tid + 512 * i; IDX16[q] = (unsigned short)F.IDX[(size_t)tb * NSEL + q]; }
        __syncthreads();
        int P[8][2];
#pragma unroll
        for (int j = 0; j < 8; ++j) { P[j][0] = 0; P[j][1] = 0; }
#pragma unroll 1
        for (int s = 0; s < NSLICE_A; ++s) {
            const unsigned char* eb = F.ED + s * SLICE_B;
            const unsigned lo = (unsigned)(c8 * 16);
            v4u wA[8], wB[8];
#define P9A_LOAD(W, J, H) do { _Pragma("unroll") for (int i = 0; i < 8; ++i) { const unsigned e = IDX16[(F.wave * 8 + (J)) * 128 + 64 * (H) + 8 * i + g]; W[i] = *(const GAS v4u*)(eb + (e * 2048u + lo)); } } while (0)
#define P9A_COMP(W, J, H) do { const v4u hq = *(const LAS v4u*)(HQ + (F.wave * 8 + (J)) * 2048 + s * SLICE_B + c8 * 16); int a[8]; \
                _Pragma("unroll") for (int i = 0; i < 8; ++i) { int d = 0; const v4u ww = W[i]; \
                    d = __builtin_amdgcn_sdot4((int)hq.x, (int)ww.x, d, false); d = __builtin_amdgcn_sdot4((int)hq.y, (int)ww.y, d, false); d = __builtin_amdgcn_sdot4((int)hq.z, (int)ww.z, d, false); d = __builtin_amdgcn_sdot4((int)hq.w, (int)ww.w, d, false); a[i] = d; } \
                red_step_i<8, 4>(a, lane); red_step_i<4, 2>(a, lane); red_step_i<2, 1>(a, lane); P[J][H] += a[0]; asm volatile("" ::: "memory"); } while (0)
            P9A_LOAD(wA, 0, 0);
#pragma unroll
            for (int j = 0; j < 8; ++j) {
                P9A_LOAD(wB, j, 1);
                P9A_COMP(wA, j, 0);
                if (j < 7) P9A_LOAD(wA, j + 1, 0);
                P9A_COMP(wB, j, 1);
            }
#undef P9A_LOAD
#undef P9A_COMP
        }
        __syncthreads();
        LAS int* PI = (LAS int*)F.lds;
#pragma unroll
        for (int j = 0; j < 8; ++j) { const int tl = F.wave * 8 + j; PI[tl * 128 + 8 * c8 + g] = P[j][0]; PI[tl * 128 + 64 + 8 * c8 + g] = P[j][1]; }
#pragma unroll
        for (int i = 0; i < 4; ++i) { const int c = tid + 512 * i; GF[c] = F.MODF[MOD_GF + c]; FG[c] = F.final_g[c]; }
        LAS float* SSQL = (LAS float*)(F.lds + P9_SSQ);
#pragma unroll 1
        for (int j = 0; j < 8; ++j) { const int tl = F.wave * 8 + j, t = tb + tl; const float sh = SH[tl]; float sum = 0.f;
#pragma unroll
            for (int h = 0; h < 2; ++h) { const int k = 64 * h + lane; const unsigned e = IDX16[tl * 128 + k];
                const float act = (float)PI[tl * 128 + k] * (sh * F.SD[e]); const float cfv = F.PG[(size_t)t * NSEL + k] * gelu_f(act) * F.SU[e]; COEF[tl * 128 + k] = cfv; sum += cfv; }
            sum = 1152.0f * wave_sum(sum); if (lane == 0) CORR[tl] = sum;     SSQL[tl * 64 + lane] = 0.f; }
        __syncthreads();
        const int cb = c8 * 16 + ((lane >> 5) & 1) * 8 + ((lane >> 4) & 1) * 4 + ((lane >> 3) & 1) * 2;
#pragma unroll 1
        for (int s = 0; s < NSLICE_C; ++s) {
            const unsigned char* eb = F.EU + s * SLICE_B;
            const unsigned lo = (unsigned)(c8 * 16);
            v4u wA[8], wB[8]; float cA[8], cB[8];
#define P9C_LOAD(W, C, TL, H) do { _Pragma("unroll") for (int i = 0; i < 8; ++i) { const unsigned e = IDX16[(TL) * 128 + 64 * (H) + 8 * i + g]; C[i] = COEF[(TL) * 128 + 64 * (H) + 8 * i + g]; W[i] = *(const GAS v4u*)(eb + (e * 2048u + lo)); } } while (0)
#define P9C_ACC(W, C) do { _Pragma("unroll") for (int i = 0; i < 8; ++i) { unsigned ux = W[i].x, uy = W[i].y, uz = W[i].z, uw = W[i].w; const float cc = C[i]; \
                asm volatile("" : "+v"(ux), "+v"(uy), "+v"(uz), "+v"(uw));      \
                acc4(o[0], o[1], o[2], o[3], ux, cc); acc4(o[4], o[5], o[6], o[7], uy, cc); acc4(o[8], o[9], o[10], o[11], uz, cc); acc4(o[12], o[13], o[14], o[15], uw, cc); \
                asm volatile("" : "+v"(o[0]), "+v"(o[1]), "+v"(o[2]), "+v"(o[3]), "+v"(o[4]), "+v"(o[5]), "+v"(o[6]), "+v"(o[7]), "+v"(o[8]), "+v"(o[9]), "+v"(o[10]), "+v"(o[11]), "+v"(o[12]), "+v"(o[13]), "+v"(o[14]), "+v"(o[15])); } \
                asm volatile("" ::: "memory"); } while (0)
            P9C_LOAD(wA, cA, F.wave * 8, 0);
#pragma unroll 1
            for (int j = 0; j < 8; ++j) {
                const int tl = F.wave * 8 + j, t = tb + tl;
                float o[16];
#pragma unroll
                for (int b = 0; b < 16; ++b) o[b] = 0.f;
                P9C_LOAD(wB, cB, tl, 1);
                P9C_ACC(wA, cA);
                if (j < 7) P9C_LOAD(wA, cA, tl + 1, 0);
                P9C_ACC(wB, cB);
                red_step_f<16, 32>(o, lane); red_step_f<8, 16>(o, lane); red_step_f<4, 8>(o, lane);
                const int col = s * SLICE_B + cb; const float corr = CORR[tl];
                float* xp = F.out + (size_t)t * D + col; const float* x1p = F.X1 + (size_t)t * D + col;
                typedef float f32x2 __attribute__((ext_vector_type(2)));
                const f32x2 xv = *(const GAS f32x2*)x1p;
                const float y0 = xv.x + GF[col] * (o[0] - corr), y1 = xv.y + GF[col + 1] * (o[1] - corr);
                SSQL[tl * 64 + lane] += y0 * y0 + y1 * y1;
                *(GAS f32x2*)xp = (f32x2){y0, y1};
            }
#undef P9C_LOAD
#undef P9C_ACC
        }
#pragma unroll 1
        for (int j = 0; j < 8; ++j) {
            const int tl = F.wave * 8 + j, t = tb + tl;
            const float rstd2 = 1.0f / sqrtf(wave_sum(SSQL[tl * 64 + lane]) * (1.0f / D) + EPS);
            GAS f32x4* orow = (GAS f32x4*)(F.out + (size_t)t * D) + lane;
#pragma unroll
            for (int q = 0; q < 8; ++q) { const f32x4 v = orow[64 * q]; const f32x4 f = *(const LAS f32x4*)(FG + 256 * q + 4 * lane); orow[64 * q] = v * rstd2 * f; }
        }
        __syncthreads();
    }
}
struct Args { const float* in[21]; float* out; unsigned char* ws; int ph_lo, ph_hi, li, pad; };
constexpr int N_PHASES = 10;
__global__ void __launch_bounds__(NWAVES * 64, 2) mk_fwd(Args args) {
    extern __shared__ __attribute__((aligned(16))) unsigned char lds[];
    Frame F;
    F.lds = (LAS unsigned char*)lds;
    F.MISC = (volatile LAS unsigned*)(F.lds + MISC_OFF);
    F.tid = threadIdx.x; F.lane = F.tid & 63; F.wave = __builtin_amdgcn_readfirstlane(F.tid >> 6);
    F.G = gridDim.x; { const int bx = blockIdx.x; F.vcu = (F.G % 8 == 0) ? (bx % 8) * (F.G / 8) + bx / 8 : bx; }
    unsigned char* ws = args.ws;
    F.ctl = (gu32*)(ws + WS_CTL);
    F.x = args.in[0]; F.c = args.in[1]; F.ada_w = args.in[2]; F.ada_b = args.in[3]; F.norm_mix_g = args.in[4]; F.w_in = args.in[5]; F.b_gates = args.in[6];
    F.conv_w = args.in[7]; F.conv_b = args.in[8]; F.gmlp_norm_g = args.in[9]; F.gmlp_w = args.in[10]; F.gmlp_b = args.in[11]; F.mlstm_norm_g = args.in[12];
    F.w_out = args.in[13]; F.norm_ffn_g = args.in[14]; F.wq = args.in[15]; F.keys1 = args.in[16]; F.keys2 = args.in[17]; F.e_down = args.in[18]; F.e_up = args.in[19]; F.final_g = args.in[20];
    F.out = args.out;
    F.MODP = (float*)(ws + WS_MODP); F.MODF = (float*)(ws + WS_MODF); F.GATES = (float*)(ws + WS_GATES); F.SUMM = (float*)(ws + WS_SUMM); F.MTAB = (float*)(ws + WS_MTAB);
    F.NST = (float*)(ws + WS_NST); F.PG = (float*)(ws + WS_PG); F.IDX = (int*)(ws + WS_IDX);
    F.WIN = (bf16*)(ws + WS_WIN); F.WOUT = (bf16*)(ws + WS_WOUT); F.WQ = (bf16*)(ws + WS_WQ); F.HA = (bf16*)(ws + WS_HA); F.PROJ = (bf16*)(ws + WS_PROJ); F.QB = (bf16*)(ws + WS_PROJ);
    F.STATE = (bf16*)(ws + WS_STATE); F.ED = ws + WS_ED; F.EU = ws + WS_EU; F.SD = (float*)(ws + WS_SD); F.SU = (float*)(ws + WS_SU);
    F.X1 = (float*)(ws + WS_X1); F.SSQP = (float*)(ws + WS_SSQP); F.BQP = (float*)(ws + WS_BQP); F.BIASQ = (float*)(ws + WS_BIASQ); F.X1B = (bf16*)(ws + WS_STATE);
    F.QC = (bf16*)args.out; F.KC = (bf16*)args.out + (size_t)M * 1024;
    for (int u = F.tid; u < (LDS_BYTES - LDSCTL_OFF) / 4; u += NWAVES * 64) ((LAS unsigned*)(F.lds + LDSCTL_OFF))[u] = 0u;
    __syncthreads();
    const int lo = args.ph_lo, hi = args.ph_hi;
    const bool multi = (hi - lo) > 1;
    XcdBarrier bar; bar.bar = (unsigned*)(F.ctl + CW_BAR) + args.li * XCD_BAR_WORDS; bar.x = 0; bar.st = nullptr;
    if (multi) bar = xcd_barrier_post((unsigned*)(F.ctl + CW_BAR) + args.li * XCD_BAR_WORDS, F.MISC + 8);
#ifndef PH_MASK
#define PH_MASK 0x7ff
#endif
#define IN(k) (((PH_MASK >> (k)) & 1) && lo <= (k) && (k) < hi)
#define SEAM(k) do { if (IN(k) && IN((k) + 1)) xcd_barrier(bar); } while (0)
    if (IN(0)) { p0a_phase(F); } SEAM(0);
    if (IN(1)) { p0b_phase(F); } SEAM(1);
    if (IN(2)) {
        pg8::Gemm g{F.HA, F.WIN, M, NPROJ, D}; pg8::StaticOrder S; S.init(M, NPROJ, F.G, (int)blockIdx.x);
        pg8::EpiProj E{F.PROJ, NPROJ, 2048 / 256};
        pg8::gemm_phase<pg8::EpiProj, pg8::StaticOrder, PG8_ALIGN, PG8_SP2>(F.lds, g, S, E);
    } SEAM(2);
    if (IN(3)) { p2_phase(F); } SEAM(3);
    if (IN(4)) { p3_phase(F); } SEAM(4);
    if (IN(5)) { p4_phase(F); } SEAM(5);
    if (IN(6)) {
        pg8::Gemm g{F.HA, F.WOUT, M, D, D}; pg8::StaticOrder S; S.init(M, D, F.G, (int)blockIdx.x);
        pg8::EpiResid2 E{F.x, F.MODF + MOD_GM, F.X1, F.X1B, F.SSQP, D};
        pg8::gemm_phase<pg8::EpiResid2, pg8::StaticOrder, PG8_ALIGN, PG8_SP2>(F.lds, g, S, E);
    } SEAM(6);
    if (IN(7)) {
        pg8::Gemm g{F.X1B, F.WQ, M, D, D}; pg8::StaticOrder S; S.init(M, D, F.G, (int)blockIdx.x);
        LAS float* RSTDL = (LAS float*)(F.lds + RING_BYTES);
        { pg8::Unit u; for (int i = 0; S.next(i, u); ++i) { if (F.tid < 256) { const float* sp = F.SSQP + (size_t)(u.pm * 256 + F.tid) * 32; float ss = 0.f;
#pragma unroll
                    for (int q = 0; q < 8; ++q) { const f32x4 v = *(const GAS f32x4*)(sp + 4 * q); ss += (v.x + v.y) + (v.z + v.w); }
                    RSTDL[(u.pm & 1) * 256 + F.tid] = 1.0f / sqrtf(ss * (1.0f / D) + EPS); } } }
        __syncthreads();
        pg8::EpiQ E{F.QB, D, F.BIASQ, RSTDL};
        pg8::gemm_phase<pg8::EpiQ, pg8::StaticOrder, PG8_ALIGN, PG8_SP2>(F.lds, g, S, E);
    } SEAM(7);
#ifndef P8_ALT
#define P8_ALT 0
#endif
    if (IN(8)) { if (P8_ALT) p8_alt_phase(F); else p8_phase(F); } SEAM(8);
#ifndef P9_V2
#define P9_V2 1
#endif
    if (IN(9)) { if (P9_V2) p9v2_phase(F); else p9_phase(F); }
#undef IN
#undef SEAM
}

#ifndef MK_N_LAUNCHES
#define MK_N_LAUNCHES 1
#endif
extern "C" void kernel_launch(void* const* d_in, const int* in_sizes, int n_in, void* d_out, int out_size, void* d_ws, size_t ws_size, hipStream_t stream) {
    static int grid = 0;
    if (grid == 0) {
        if (n_in != 21 || in_sizes[0] != M * D || out_size != M * D || ws_size < WS_END) { fprintf(stderr, "kernel_launch: unexpected shapes (n_in %d, in0 %d, out %d, ws %zu); nothing launched\n", n_in, n_in > 0 ? in_sizes[0] : -1, out_size, ws_size); grid = -1; return; }
        int dev = 0, cus = 0, per_cu = 0;
        if (hipGetDevice(&dev) != hipSuccess || hipDeviceGetAttribute(&cus, hipDeviceAttributeMultiprocessorCount, dev) != hipSuccess) { grid = -1; return; }
        if (hipFuncSetAttribute((const void*)mk_fwd, hipFuncAttributeMaxDynamicSharedMemorySize, LDS_BYTES) != hipSuccess) { fprintf(stderr, "kernel_launch: hipFuncSetAttribute failed\n"); grid = -1; return; }
        if (hipOccupancyMaxActiveBlocksPerMultiprocessor(&per_cu, (const void*)mk_fwd, NWAVES * 64, LDS_BYTES) != hipSuccess || per_cu < 1) { fprintf(stderr, "kernel_launch: occupancy query says %d blocks per CU\n", per_cu); }
        (void)hipGetLastError();
        grid = cus;
    }
    if (grid < 0) return;
    (void)hipMemsetAsync((char*)d_ws + WS_CTL, 0, CTL_ZERO_BYTES, stream);
    Args a{};
    for (int i = 0; i < 21; ++i) a.in[i] = (const float*)d_in[i];
    a.out = (float*)d_out; a.ws = (unsigned char*)d_ws;
    if (MK_N_LAUNCHES == 1) { a.ph_lo = 0; a.ph_hi = N_PHASES; a.li = 0; hipLaunchKernelGGL(mk_fwd, dim3(grid), dim3(NWAVES * 64), LDS_BYTES, stream, a); }
    else for (int li = 0; li < N_PHASES; ++li) { a.ph_lo = li; a.ph_hi = li + 1; a.li = 0; hipLaunchKernelGGL(mk_fwd, dim3(grid), dim3(NWAVES * 64), LDS_BYTES, stream, a); }
}
```

```cpp
#include <hip/hip_runtime.h>
#include <cstdio>
#include <cstdint>
namespace pg8 {
#define PG8_LAS __attribute__((address_space(3)))
typedef unsigned short bf16_t;
typedef short bf16x8 __attribute__((ext_vector_type(8)));
typedef float f32x4 __attribute__((ext_vector_type(4)));
typedef unsigned u32x4 __attribute__((ext_vector_type(4)));
constexpr int BM = 256, BK = 64, HALF = 128, HTB = HALF * BK * 2  , STAGE_BYTES = 8 * HTB, NXCD = 8, WGM = 8;

__host__ __device__ __forceinline__ int lds_byte(int r, int c) { const int st = (r >> 4) * 2 + (c >> 5), rr = r & 15, cc = c & 31, ob = rr * 64 + cc * 2; return st * 1024 + (ob ^ (((ob >> 9) & 1) << 5)); }
__host__ __device__ __forceinline__ void stage_rc(int b, int& R, int& C) { const int st = b / 1024, sb = b % 1024, swz = sb ^ (((sb >> 9) & 1) << 5); R = (st >> 1) * 16 + swz / 64; C = (st & 1) * 32 + (swz % 64) / 2; }
__host__ __device__ __forceinline__ int perm32(int rho) { const int n = rho >> 4, i = rho & 15; return 8 * (i >> 2) + 4 * n + (i & 3); }

struct Unit { int pm, pn; };
struct Gemm { const bf16_t* A; const bf16_t* Bt; int M, N, K; };

struct StaticOrder {
    int nM, nN, nwg, G, c;
    __host__ __device__ void init(int M, int N, int G_, int c_) { nM = M / BM; nN = N / BM; nwg = nM * nN; G = G_; c = c_; }
    __host__ __device__ bool next(int i, Unit& u) const {
        const long L = (long)i * G + c; if (L >= nwg) return false;
        int wgid = (int)L; { const int q = nwg / NXCD, r = nwg % NXCD, xcd = wgid % NXCD, off = wgid / NXCD; wgid = (xcd < r ? xcd * (q + 1) : r * (q + 1) + (xcd - r) * q) + off; }
        const int nig = WGM * nN, gid = wgid / nig, fm = gid * WGM, gsz = (nM - fm) < WGM ? (nM - fm) : WGM;
        u.pm = fm + ((wgid % nig) % gsz); u.pn = (wgid % nig) / gsz; return true;
    }
    __device__ __forceinline__ void a_ready(const Unit&) const {}
    __device__ __forceinline__ void done(const Unit&) const {}
};

__device__ __forceinline__ unsigned cvt_pk_bf16(float lo, float hi) { unsigned r; asm volatile("v_cvt_pk_bf16_f32 %0, %1, %2" : "=v"(r) : "v"(lo), "v"(hi)); return r; }
typedef float f32x2 __attribute__((ext_vector_type(2)));
__device__ __forceinline__ f32x2 gelu_pk(f32x2 v) {
    const f32x2 av = __builtin_elementwise_abs(v), d = av * 0.2316418882f + 1.0f;
    f32x2 t; t.x = __builtin_amdgcn_rcpf(d.x); t.y = __builtin_amdgcn_rcpf(d.y);
    f32x2 q = t * 0.5307027145f + (-0.7265760135f); q = q * t + 0.7107068705f; q = q * t + (-0.142248368f); q = q * t + 0.127414796f; q = q * t;
    const f32x2 s = (v * v) * (-0.72134752044f);
    f32x2 e; e.x = __builtin_amdgcn_exp2f(s.x); e.y = __builtin_amdgcn_exp2f(s.y);
    const f32x2 m = v * (q * e), r = v - m;
    f32x2 o; o.x = v.x < 0.f ? m.x : r.x; o.y = v.y < 0.f ? m.y : r.y; return o;
}

template <int ACT  > struct EpiBf16 {
    static constexpr bool PERM = true, AFTER_DRAIN = false; static_assert(ACT == 0 || ACT == 1, "EpiBf16: ACT is 0 (none) or 1 (gelu_pk)");
    bf16_t* O; int ldc; const float* bias; int split_cols; size_t split_stride; float scale0;
    __device__ __forceinline__ void operator()(const f32x4 (&acc)[2][2][4][2], const Unit& u, int wr, int wc, int fr, int fq) const {
        const int row0 = u.pm * BM + wr * 64 + fr; int colt = u.pn * BM; bf16_t* base = O;
        float sc = 1.f; if (split_cols) { const int t = colt / split_cols; base += (size_t)t * split_stride; colt -= t * split_cols; if (t == 0) sc = scale0; }
        const int col0 = colt + wc * 32 + 8 * fq, bcol0 = u.pn * BM + wc * 32 + 8 * fq;
        f32x4 bv[2][2];
#pragma unroll
        for (int bj = 0; bj < 2; ++bj)
#pragma unroll
            for (int n = 0; n < 2; ++n) bv[bj][n] = bias ? *(const f32x4*)(bias + bcol0 + bj * HALF + 4 * n) : (f32x4){0.f, 0.f, 0.f, 0.f};
#pragma unroll
        for (int ai = 0; ai < 2; ++ai)
#pragma unroll
            for (int m = 0; m < 4; ++m) { bf16_t* rowp = base + (size_t)(row0 + ai * HALF + m * 16) * ldc + col0;
#pragma unroll
                for (int bj = 0; bj < 2; ++bj) { f32x4 v0 = acc[ai][bj][m][0] + bv[bj][0], v1 = acc[ai][bj][m][1] + bv[bj][1];
                    if (ACT == 1) { f32x2 a = gelu_pk((f32x2){v0[0], v0[1]}), b = gelu_pk((f32x2){v0[2], v0[3]}), c = gelu_pk((f32x2){v1[0], v1[1]}), d = gelu_pk((f32x2){v1[2], v1[3]});
                        v0 = (f32x4){a.x, a.y, b.x, b.y}; v1 = (f32x4){c.x, c.y, d.x, d.y}; }
                    v0 = v0 * sc; v1 = v1 * sc; u32x4 w; w.x = cvt_pk_bf16(v0[0], v0[1]); w.y = cvt_pk_bf16(v0[2], v0[3]); w.z = cvt_pk_bf16(v1[0], v1[1]); w.w = cvt_pk_bf16(v1[2], v1[3]);
                    *(u32x4*)(rowp + bj * HALF) = w; } }
    }
};

template <class Epi, class Sched, bool ALIGN_EPI = false, bool SP2 = false>
__device__ __forceinline__ void gemm_phase(PG8_LAS unsigned char* lds, const Gemm g, const Sched& S, const Epi& E) {
    const int tid = threadIdx.x, wid = __builtin_amdgcn_readfirstlane(tid >> 6), lane = tid & 63, wr = wid >> 2, wc = wid & 3, fr = lane & 15, fq = lane >> 4;
    const int K = g.K, nt = K / BK;
    unsigned voffA[2], voffB[2];
#pragma unroll
    for (int i = 0; i < 2; ++i) { int R, C; stage_rc(tid * 16 + i * 8192, R, C); const int Rb = Epi::PERM ? ((R & ~31) + perm32(R & 31)) : R;
        voffA[i] = (unsigned)(R * K + C) * 2u; voffB[i] = (unsigned)(Rb * K + C) * 2u; }
    const size_t kstep = (size_t)(BK * 2);
    const size_t hstep = (size_t)HALF * K * 2;
    const size_t tstep = 2 * hstep;
    const unsigned ldsw = (unsigned)wid * 1024u;
    const int aoff = lds_byte(wr * 64 + fr, fq * 8), boff = lds_byte(wc * 32 + fr, fq * 8);
#define PG8_SA(b, h) (((b) * 2 + (h)) * HTB)
#define PG8_SB(b, h) ((4 + (b) * 2 + (h)) * HTB)
#define PG8_STAGE(bufoff, gbase, voff) do { _Pragma("unroll") for (int _i = 0; _i < 2; ++_i) \
        __builtin_amdgcn_global_load_lds((const unsigned*)((const char*)(gbase) + (voff)[_i]), (PG8_LAS unsigned*)(lds + (bufoff) + ldsw + _i * 8192), 16, 0, 0); } while (0)
#define PG8_LDA(dst, b, h) do { _Pragma("unroll") for (int m = 0; m < 4; ++m) _Pragma("unroll") for (int k = 0; k < 2; ++k) dst[m][k] = *(const PG8_LAS bf16x8*)(lds + PG8_SA(b, h) + aoff + m * 2048 + k * 1024); } while (0)
#define PG8_LDB(dst, b, h) do { _Pragma("unroll") for (int n = 0; n < 2; ++n) _Pragma("unroll") for (int k = 0; k < 2; ++k) dst[n][k] = *(const PG8_LAS bf16x8*)(lds + PG8_SB(b, h) + boff + n * 2048 + k * 1024); } while (0)
#define PG8_MMA(ai, bj, At, Bt) do { __builtin_amdgcn_s_setprio(1); _Pragma("unroll") for (int m = 0; m < 4; ++m) _Pragma("unroll") for (int n = 0; n < 2; ++n) _Pragma("unroll") for (int k = 0; k < 2; ++k) \
        acc[ai][bj][m][n] = __builtin_amdgcn_mfma_f32_16x16x32_bf16(Bt[n][k], At[m][k], acc[ai][bj][m][n], 0, 0, 0); __builtin_amdgcn_s_setprio(0); } while (0)
#define PG8_WAIT_V(n) asm volatile("s_waitcnt vmcnt(" #n ")" ::: "memory")
#define PG8_WAIT_L(n) asm volatile("s_waitcnt lgkmcnt(" #n ")" ::: "memory")
#define PG8_BAR __builtin_amdgcn_s_barrier()
#define PG8_SCHED __builtin_amdgcn_sched_barrier(0)
    Unit cur, nxt; int ui = 0;
    if (!S.next(0, cur)) return;
    f32x4 acc[2][2][4][2];
#pragma unroll
    for (int a = 0; a < 2; ++a)
#pragma unroll
        for (int b = 0; b < 2; ++b)
#pragma unroll
            for (int m = 0; m < 4; ++m)
#pragma unroll
                for (int n = 0; n < 2; ++n) acc[a][b][m][n] = (f32x4){0.f, 0.f, 0.f, 0.f};
    bf16x8 At[4][2], B0[2][2], B1[2][2];
    const char* cA = (const char*)g.A + (size_t)cur.pm * tstep; const char* cB = (const char*)g.Bt + (size_t)cur.pn * tstep;
    S.a_ready(cur);
    if constexpr (SP2) {
        PG8_STAGE(PG8_SB(0, 0), cB, voffB); PG8_STAGE(PG8_SB(0, 1), cB + hstep, voffB); PG8_STAGE(PG8_SA(0, 0), cA, voffA); PG8_STAGE(PG8_SA(0, 1), cA + hstep, voffA);
        if (wr == 1) PG8_BAR;
        PG8_WAIT_V(2); PG8_BAR;
        PG8_STAGE(PG8_SB(1, 0), cB + kstep, voffB); PG8_STAGE(PG8_SA(1, 0), cA + kstep, voffA); PG8_STAGE(PG8_SB(1, 1), cB + hstep + kstep, voffB);
        PG8_WAIT_V(6); PG8_BAR;
    } else {
        PG8_STAGE(PG8_SB(0, 0), cB, voffB); PG8_STAGE(PG8_SA(0, 0), cA, voffA); PG8_STAGE(PG8_SB(0, 1), cB + hstep, voffB); PG8_STAGE(PG8_SA(0, 1), cA + hstep, voffA);
        if (wr == 1) PG8_BAR;
        PG8_WAIT_V(4); PG8_BAR;
        PG8_STAGE(PG8_SB(1, 0), cB + kstep, voffB); PG8_STAGE(PG8_SA(1, 0), cA + kstep, voffA); PG8_STAGE(PG8_SB(1, 1), cB + hstep + kstep, voffB);
        PG8_WAIT_V(6); PG8_BAR;
    }
    for (;;) {
        const bool has_next = S.next(ui + 1, nxt);
        const char* nA = has_next ? (const char*)g.A + (size_t)nxt.pm * tstep : cA; const char* nB = has_next ? (const char*)g.Bt + (size_t)nxt.pn * tstep : cB;
        for (int t = 0; t < nt; t += 2) {
            const bool last = (t == nt - 2);
            const char* a1 = cA + (size_t)(t + 1) * kstep;
            const char* a2 = last ? nA : cA + (size_t)(t + 2) * kstep; const char* b2 = last ? nB : cB + (size_t)(t + 2) * kstep;
            const char* a3 = a2 + kstep; const char* b3 = b2 + kstep;
            if (last && has_next) S.a_ready(nxt);
            if constexpr (SP2) {
            PG8_LDB(B0, 0, 0); PG8_LDB(B1, 0, 1); PG8_SCHED; PG8_LDA(At, 0, 0); PG8_STAGE(PG8_SA(1, 1), a1 + hstep, voffA);
            PG8_WAIT_V(8); PG8_WAIT_L(0); PG8_BAR; PG8_MMA(0, 0, At, B0); PG8_MMA(0, 1, At, B1); PG8_BAR; PG8_SCHED;
            PG8_LDA(At, 0, 1); PG8_STAGE(PG8_SB(0, 0), b2, voffB); PG8_STAGE(PG8_SB(0, 1), b2 + hstep, voffB); PG8_STAGE(PG8_SA(0, 0), a2, voffA);
            PG8_WAIT_V(8); PG8_WAIT_L(0); PG8_BAR; PG8_MMA(1, 0, At, B0); PG8_MMA(1, 1, At, B1); PG8_BAR; PG8_SCHED;
            PG8_LDB(B0, 1, 0); PG8_LDB(B1, 1, 1); PG8_SCHED; PG8_LDA(At, 1, 0); PG8_STAGE(PG8_SA(0, 1), a2 + hstep, voffA);
            PG8_WAIT_V(8); PG8_WAIT_L(0); PG8_BAR; PG8_MMA(0, 0, At, B0); PG8_MMA(0, 1, At, B1); PG8_BAR; PG8_SCHED;
            PG8_LDA(At, 1, 1); PG8_STAGE(PG8_SB(1, 0), b3, voffB); PG8_STAGE(PG8_SB(1, 1), b3 + hstep, voffB); PG8_STAGE(PG8_SA(1, 0), a3, voffA);
            PG8_WAIT_V(8); PG8_WAIT_L(0); PG8_BAR; PG8_MMA(1, 0, At, B0); PG8_MMA(1, 1, At, B1); PG8_BAR; PG8_SCHED;
            } else {
            PG8_LDB(B0, 0, 0); PG8_SCHED; PG8_LDA(At, 0, 0); PG8_STAGE(PG8_SA(1, 1), a1 + hstep, voffA);
            PG8_WAIT_L(8); PG8_BAR; PG8_WAIT_L(0); PG8_MMA(0, 0, At, B0); PG8_BAR; PG8_SCHED;
            PG8_LDB(B1, 0, 1); PG8_STAGE(PG8_SB(0, 0), b2, voffB);
            PG8_BAR; PG8_WAIT_L(0); PG8_MMA(0, 1, At, B1); PG8_BAR;
            PG8_LDA(At, 0, 1); PG8_STAGE(PG8_SA(0, 0), a2, voffA);
            PG8_BAR; PG8_WAIT_L(0); PG8_MMA(1, 0, At, B0); PG8_BAR; PG8_SCHED;
            PG8_STAGE(PG8_SB(0, 1), b2 + hstep, voffB);
            PG8_WAIT_V(6); PG8_BAR; PG8_MMA(1, 1, At, B1); PG8_BAR;
            PG8_LDB(B0, 1, 0); PG8_SCHED; PG8_LDA(At, 1, 0); PG8_STAGE(PG8_SA(0, 1), a2 + hstep, voffA);
            PG8_WAIT_L(8); PG8_BAR; PG8_WAIT_L(0); PG8_MMA(0, 0, At, B0); PG8_BAR; PG8_SCHED;
            PG8_LDB(B1, 1, 1); PG8_STAGE(PG8_SB(1, 0), b3, voffB);
            PG8_BAR; PG8_WAIT_L(0); PG8_MMA(0, 1, At, B1); PG8_BAR;
            PG8_LDA(At, 1, 1); PG8_STAGE(PG8_SA(1, 0), a3, voffA);
            PG8_BAR; PG8_WAIT_L(0); PG8_MMA(1, 0, At, B0); PG8_BAR; PG8_SCHED;
            PG8_STAGE(PG8_SB(1, 1), b3 + hstep, voffB);
            PG8_WAIT_V(6); PG8_BAR; PG8_MMA(1, 1, At, B1); PG8_BAR;
            }
        }
        if constexpr (ALIGN_EPI) { if (wr == 0) PG8_BAR; }
        if constexpr (!Epi::AFTER_DRAIN) { E(acc, cur, wr, wc, fr, fq); S.done(cur); }
        if (!has_next) break;
#pragma unroll
        for (int a = 0; a < 2; ++a)
#pragma unroll
            for (int b = 0; b < 2; ++b)
#pragma unroll
                for (int m = 0; m < 4; ++m)
#pragma unroll
                    for (int n = 0; n < 2; ++n) acc[a][b][m][n] = (f32x4){0.f, 0.f, 0.f, 0.f};
        cur = nxt; cA = nA; cB = nB; ++ui;
        if constexpr (ALIGN_EPI) { if (wr == 1) PG8_BAR; }
    }
    PG8_WAIT_V(0);
    if constexpr (!ALIGN_EPI) { if (wr == 0) PG8_BAR; }
    PG8_BAR;
    if constexpr (Epi::AFTER_DRAIN) { E.fused(acc, cur, wr, wc, fr, fq, lds, wid, lane); S.done(cur); }
#undef PG8_SA
#undef PG8_SB
#undef PG8_STAGE
#undef PG8_LDA
#undef PG8_LDB
#undef PG8_MMA
#undef PG8_WAIT_V
#undef PG8_WAIT_L
#undef PG8_BAR
#undef PG8_SCHED
}
}
namespace pg8 {
struct EpiProj {
    static constexpr bool PERM = true, AFTER_DRAIN = false;
    bf16_t* O; int ldc; int gelu_tiles;
    __device__ __forceinline__ void operator()(const f32x4 (&acc)[2][2][4][2], const Unit& u, int wr, int wc, int fr, int fq) const {
        const int row0 = u.pm * BM + wr * 64 + fr; const int col0 = u.pn * BM + wc * 32 + 8 * fq;
        const bool act = u.pn < gelu_tiles;
#pragma unroll
        for (int ai = 0; ai < 2; ++ai)
#pragma unroll
            for (int m = 0; m < 4; ++m) { bf16_t* rowp = O + (size_t)(row0 + ai * HALF + m * 16) * ldc + col0;
#pragma unroll
                for (int bj = 0; bj < 2; ++bj) { f32x4 v0 = acc[ai][bj][m][0], v1 = acc[ai][bj][m][1];
                    if (act) { f32x2 a = gelu_pk((f32x2){v0[0], v0[1]}), b = gelu_pk((f32x2){v0[2], v0[3]}), c = gelu_pk((f32x2){v1[0], v1[1]}), d = gelu_pk((f32x2){v1[2], v1[3]});
                        v0 = (f32x4){a.x, a.y, b.x, b.y}; v1 = (f32x4){c.x, c.y, d.x, d.y}; }
                    u32x4 w; w.x = cvt_pk_bf16(v0[0], v0[1]); w.y = cvt_pk_bf16(v0[2], v0[3]); w.z = cvt_pk_bf16(v1[0], v1[1]); w.w = cvt_pk_bf16(v1[2], v1[3]);
                    *(u32x4*)(rowp + bj * HALF) = w; } }
    }
};
struct EpiResid {
    static constexpr bool PERM = false, AFTER_DRAIN = false;
    const float* base; const float* gate; float* out; int ldc;
    __device__ __forceinline__ void operator()(const f32x4 (&acc)[2][2][4][2], const Unit& u, int wr, int wc, int fr, int fq) const {
        const int row0 = u.pm * BM + wr * 64 + fr, col0 = u.pn * BM + wc * 32 + 4 * fq;
        f32x4 gv[2][2];
#pragma unroll
        for (int bj = 0; bj < 2; ++bj)
#pragma unroll
            for (int n = 0; n < 2; ++n) gv[bj][n] = *(const f32x4*)(gate + col0 + bj * HALF + n * 16);
#pragma unroll
        for (int ai = 0; ai < 2; ++ai)
#pragma unroll
            for (int m = 0; m < 4; ++m) { const size_t off = (size_t)(row0 + ai * HALF + m * 16) * ldc + col0;
#pragma unroll
                for (int bj = 0; bj < 2; ++bj)
#pragma unroll
                    for (int n = 0; n < 2; ++n) { const f32x4 b = *(const f32x4*)(base + off + bj * HALF + n * 16); *(f32x4*)(out + off + bj * HALF + n * 16) = b + gv[bj][n] * acc[ai][bj][m][n]; } }
    }
};
struct EpiResid2 {
    static constexpr bool PERM = true, AFTER_DRAIN = false;
    const float* base; const float* gate; bf16_t* xb; float* ssq; int ldc;
    __device__ __forceinline__ void operator()(const f32x4 (&acc)[2][2][4][2], const Unit& u, int wr, int wc, int fr, int fq) const {
        const int row0 = u.pm * BM + wr * 64 + fr, col0 = u.pn * BM + wc * 32 + 8 * fq;
        f32x4 gv[2][2];
#pragma unroll
        for (int bj = 0; bj < 2; ++bj)
#pragma unroll
            for (int n = 0; n < 2; ++n) gv[bj][n] = *(const f32x4*)(gate + col0 + bj * HALF + 4 * n);
#pragma unroll
        for (int ai = 0; ai < 2; ++ai)
#pragma unroll
            for (int m = 0; m < 4; ++m) { const int row = row0 + ai * HALF + m * 16; const size_t off = (size_t)row * ldc + col0; float ss = 0.f;
#pragma unroll
                for (int bj = 0; bj < 2; ++bj) {
                    const f32x4 b0 = *(const f32x4*)(base + off + bj * HALF), b1 = *(const f32x4*)(base + off + bj * HALF + 4);
                    const f32x4 v0 = b0 + gv[bj][0] * acc[ai][bj][m][0], v1 = b1 + gv[bj][1] * acc[ai][bj][m][1];
                    ss += (v0[0] * v0[0] + v0[1] * v0[1]) + (v0[2] * v0[2] + v0[3] * v0[3]) + (v1[0] * v1[0] + v1[1] * v1[1]) + (v1[2] * v1[2] + v1[3] * v1[3]);
                    u32x4 w; w.x = cvt_pk_bf16(v0[0], v0[1]); w.y = cvt_pk_bf16(v0[2], v0[3]); w.z = cvt_pk_bf16(v1[0], v1[1]); w.w = cvt_pk_bf16(v1[2], v1[3]);
                    *(u32x4*)(xb + off + bj * HALF) = w; }
                ss += __shfl_xor(ss, 16); ss += __shfl_xor(ss, 32);
                if (fq == 0) ssq[(size_t)row * 32 + u.pn * 4 + wc] = ss; }
    }
};
struct EpiQ {
    static constexpr bool PERM = true, AFTER_DRAIN = false;
    bf16_t* O; int ldc; const float* bias; const PG8_LAS float* rstd;
    __device__ __forceinline__ void operator()(const f32x4 (&acc)[2][2][4][2], const Unit& u, int wr, int wc, int fr, int fq) const {
        const int lrow0 = wr * 64 + fr, col0 = u.pn * BM + wc * 32 + 8 * fq;
        f32x4 bv[2][2];
#pragma unroll
        for (int bj = 0; bj < 2; ++bj)
#pragma unroll
            for (int n = 0; n < 2; ++n) bv[bj][n] = *(const f32x4*)(bias + col0 + bj * HALF + 4 * n);
#pragma unroll
        for (int ai = 0; ai < 2; ++ai)
#pragma unroll
            for (int m = 0; m < 4; ++m) { const int lrow = lrow0 + ai * HALF + m * 16; const float rs = rstd[(u.pm & 1) * BM + lrow];
                bf16_t* rowp = O + (size_t)(u.pm * BM + lrow) * ldc + col0;
#pragma unroll
                for (int bj = 0; bj < 2; ++bj) { const f32x4 v0 = acc[ai][bj][m][0] * rs + bv[bj][0], v1 = acc[ai][bj][m][1] * rs + bv[bj][1];
                    u32x4 w; w.x = cvt_pk_bf16(v0[0], v0[1]); w.y = cvt_pk_bf16(v0[2], v0[3]); w.z = cvt_pk_bf16(v1[0], v1[1]); w.w = cvt_pk_bf16(v1[2], v1[3]);
                    *(u32x4*)(rowp + bj * HALF) = w; } }
    }
};
}
#ifndef PG8_SP2
#define PG8_SP2 true
#endif
#ifndef PG8_ALIGN
#define PG8_ALIGN true
#endif
constexpr int NWAVES = 8;
constexpr int M = 16384, D = 2048;
constexpr int IN_COLS = 6152, NPROJ = 6144;
constexpr int C_UG = 0, C_VG = 1024, C_Q = 2048, C_K = 3072, C_VM = 4096, C_OM = 5120;
constexpr int NHEAD = 4, DH = 256, CH = 128, NCHUNK = M / CH;
constexpr int NEXP = 16384, PH = 8, TOPK = 16, NSEL = PH * TOPK;
constexpr float EPS = 1e-6f;
constexpr int MOD_SHM = 0, MOD_SCM = 2048, MOD_GM = 4096, MOD_SHF = 6144, MOD_SCF = 8192, MOD_GF = 10240, NMOD = 12288;
constexpr int ADA_KC = 16, ADA_KROWS = D / ADA_KC;

constexpr size_t MiB = 1u << 20;
constexpr size_t WS_CTL = 0, CTL_ZERO_BYTES = 1 * MiB;
constexpr size_t WS_MODP = 1 * MiB;
constexpr size_t WS_MODF = WS_MODP + (size_t)ADA_KC * NMOD * 4;
constexpr size_t WS_GATES = 2 * MiB;
constexpr size_t WS_SUMM = 2 * MiB + 512 * 1024;
constexpr size_t WS_MTAB = WS_SUMM + 8192;
constexpr size_t WS_NST = 3 * MiB;
constexpr size_t WS_WIN = 4 * MiB;
constexpr size_t WS_WOUT = 28 * MiB;
constexpr size_t WS_WQ = 36 * MiB;
constexpr size_t WS_IDX = 44 * MiB;
constexpr size_t WS_PG = 52 * MiB;
constexpr size_t WS_SSQP = 60 * MiB;
constexpr size_t WS_BQP = 62 * MiB, WS_BIASQ = 62 * MiB + 512 * 1024;
constexpr size_t WS_HA = 64 * MiB;
constexpr size_t WS_PROJ = 128 * MiB;
constexpr size_t WS_X1 = 192 * MiB;
constexpr size_t WS_STATE = 320 * MiB;
constexpr size_t WS_ED = 384 * MiB, WS_EU = 416 * MiB;
constexpr size_t WS_SD = 3 * MiB + 512 * 1024, WS_SU = WS_SD + 65536;
constexpr size_t WS_END = 512 * MiB;
constexpr int CW_TMO = 0, CW_CODE = 1, CW_BAR = 4096;

constexpr int RING_BYTES = 131072, LDSCTL_OFF = 151552, MISC_OFF = LDSCTL_OFF + 320, LDS_BYTES = 163840;

#define GAS __attribute__((address_space(1)))
#define LAS __attribute__((address_space(3)))
#define DI __device__ __forceinline__
typedef unsigned short bf16;
typedef unsigned v4u __attribute__((ext_vector_type(4)));
typedef unsigned v2u __attribute__((ext_vector_type(2)));
typedef float f32x4 __attribute__((ext_vector_type(4)));
typedef float f32x16 __attribute__((ext_vector_type(16)));
typedef short bf16x8 __attribute__((ext_vector_type(8)));
typedef GAS unsigned gu32;
#define RLX_AGENT __ATOMIC_RELAXED, __HIP_MEMORY_SCOPE_AGENT
#define LDS_WAIT() asm volatile("s_waitcnt lgkmcnt(0)" ::: "memory")
#define VM_WAIT() asm volatile("s_waitcnt vmcnt(0)" ::: "memory")
#define MFMA32(a, b, c) __builtin_amdgcn_mfma_f32_32x32x16_bf16((a), (b), (c), 0, 0, 0)
DI unsigned f2bf(float f) { unsigned u = __builtin_bit_cast(unsigned, f); return (u + 0x7fffu + ((u >> 16) & 1u)) >> 16; }
DI unsigned pk2(float lo, float hi) { return f2bf(lo) | (f2bf(hi) << 16); }
DI float bflo(unsigned w) { return __builtin_bit_cast(float, w << 16); }
DI float bfhi(unsigned w) { return __builtin_bit_cast(float, w & 0xffff0000u); }
DI float bf2f(unsigned short h) { return __builtin_bit_cast(float, (unsigned)h << 16); }
DI int crow(int reg, int h) { return (reg & 3) + 8 * (reg >> 2) + 4 * h; }
DI float wave_sum(float v) {
#pragma unroll
    for (int o = 1; o < 64; o <<= 1) v += __shfl_xor(v, o);
    return v;
}
DI float wave_max(float v) {
#pragma unroll
    for (int o = 1; o < 64; o <<= 1) v = fmaxf(v, __shfl_xor(v, o));
    return v;
}
DI float silu_f(float v) { return v / (1.0f + __expf(-v)); }
DI float sigmoid_f(float v) { return 1.0f / (1.0f + __expf(-v)); }
DI float gelu_f(float v) { return 0.5f * v * (1.0f + erff(v * 0.70710678118654752f)); }
typedef __bf16 bf16v2 __attribute__((ext_vector_type(2)));
#define DOT2(a, b, c) __builtin_amdgcn_fdot2_f32_bf16(__builtin_bit_cast(bf16v2, (unsigned)(a)), __builtin_bit_cast(bf16v2, (unsigned)(b)), (c), false)
DI f32x16 zero16() { f32x16 z; for (int i = 0; i < 16; ++i) z[i] = 0.f; return z; }
#define XB_TMO      128
#define XB_XCNT(j)  (256  + 64 * (j))
#define XB_XSUB(j)  (1280 + 64 * (j))
#define XB_XGEN(j)  (2304 + 64 * (j))
#define XB_TOP      3328
#define XB_TOPGEN   3392
#define XCD_BAR_WORDS 3456
#define XB_SPIN_CAP (1u << 18)

__device__ __forceinline__ unsigned xb_ld(unsigned* p)              { return __hip_atomic_load(p, __ATOMIC_RELAXED, __HIP_MEMORY_SCOPE_AGENT); }
__device__ __forceinline__ unsigned xb_add(unsigned* p, unsigned v) { return __hip_atomic_fetch_add(p, v, __ATOMIC_RELAXED, __HIP_MEMORY_SCOPE_AGENT); }
__device__ __forceinline__ unsigned xb_xcc_id() { return (unsigned)__builtin_amdgcn_s_getreg((3 << 11) | 20) & 0xFu; }
#define XB_SPIN(cond, bar) do { unsigned _sp = 0; while (cond) { __builtin_amdgcn_s_sleep(1); \
    if ((++_sp & 255u) == 0u) { if (xb_ld(&(bar)[XB_TMO])) break; if (_sp > XB_SPIN_CAP) { atomicAdd(&(bar)[XB_TMO], 1u); break; } } } } while (0)

struct XcdBarrier {
    unsigned* bar; unsigned x;
    volatile LAS unsigned* st;
};

__device__ __forceinline__ XcdBarrier xcd_barrier_post(unsigned* bar, volatile LAS unsigned* st) {
    XcdBarrier b; b.bar = bar; b.x = xb_xcc_id(); b.st = st;
    if (threadIdx.x == 0) (void)xb_add(&bar[XB_XCNT(b.x)], 1u);
    return b;
}
__device__ __forceinline__ void xcd_barrier_complete(unsigned* bar, unsigned x, unsigned& nloc, unsigned& nx) {
    const unsigned G = gridDim.x * gridDim.y * gridDim.z;
    unsigned sum, cnt, mine, sp = 0u;
    for (;;) {
        sum = 0u; cnt = 0u; mine = 0u;
#pragma unroll
        for (unsigned j = 0; j < 16; ++j) { const unsigned c = xb_ld(&bar[XB_XCNT(j)]); sum += c; cnt += (c > 0u) ? 1u : 0u; mine = (j == x) ? c : mine; }
        if (sum == G) break;
        __builtin_amdgcn_s_sleep(1);
        if ((++sp & 255u) == 0u) { if (xb_ld(&bar[XB_TMO])) break; if (sp > XB_SPIN_CAP) { atomicAdd(&bar[XB_TMO], 1u); break; } }
    }
    nloc = mine > 0u ? mine : 1u; nx = cnt > 0u ? cnt : 1u;
}

__device__ __forceinline__ void xcd_barrier(const XcdBarrier& b) {
    asm volatile("s_waitcnt vmcnt(0)" ::: "memory");
    __syncthreads();
    if (threadIdx.x == 0) {
        unsigned* bar = b.bar;
        __builtin_amdgcn_s_waitcnt(0);
        unsigned nloc = b.st[0], nx = b.st[1];
        if (nloc == 0u) { xcd_barrier_complete(bar, b.x, nloc, nx); b.st[0] = nloc; b.st[1] = nx; }
        const unsigned old = xb_add(&bar[XB_XSUB(b.x)], 1u);
        const unsigned gen = old / nloc;
        if (old + 1u == (gen + 1u) * nloc) {
            __builtin_amdgcn_fence(__ATOMIC_RELEASE, "agent");
            asm volatile("s_waitcnt vmcnt(0)" ::: "memory");
            const unsigned og = xb_add(&bar[XB_TOP], 1u);
            const unsigned tg = og / nx;
            if (og + 1u == (tg + 1u) * nx) xb_add(&bar[XB_TOPGEN], 1u);
            else XB_SPIN(xb_ld(&bar[XB_TOPGEN]) == tg, bar);
            __builtin_amdgcn_fence(__ATOMIC_ACQUIRE, "agent");
            xb_add(&bar[XB_XGEN(b.x)], 1u);
            asm volatile("s_waitcnt vmcnt(0)" ::: "memory");
        } else {
            XB_SPIN(xb_ld(&bar[XB_XGEN(b.x)]) == gen, bar);
            __builtin_amdgcn_fence(__ATOMIC_ACQUIRE, "agent");
            asm volatile("s_waitcnt vmcnt(0)" ::: "memory");
        }
    }
    __syncthreads();
}
struct Frame {
    LAS unsigned char* lds;
    volatile LAS unsigned* MISC;
    gu32* ctl;
    int tid, lane, wave, vcu, G;
    const float *x, *c, *ada_w, *ada_b, *norm_mix_g, *w_in, *b_gates, *conv_w, *conv_b, *gmlp_norm_g, *gmlp_w, *gmlp_b, *mlstm_norm_g, *w_out, *norm_ffn_g,
                *wq, *keys1, *keys2, *e_down, *e_up, *final_g;
    float* out;
    float *MODP, *MODF, *GATES, *SUMM, *MTAB, *NST, *PG;
    int* IDX;
    bf16 *WIN, *WOUT, *WQ, *HA, *PROJ, *QB, *STATE, *QC, *KC;
    unsigned char *ED, *EU; float *SD, *SU;
    float *SSQP, *BQP, *BIASQ; bf16* X1B;
};

DI void p0_transpose_item(const float* W, int K, int ldw, int nblk, bf16* WT, LAS float* scr, int item, int lane) {
    const int kb = item / nblk, nb = item % nblk, k0 = 64 * kb, n0 = 32 * nb;
#pragma unroll 8
    for (int i = 0; i < 32; ++i) { const int kk = 2 * i + (lane >> 5); scr[kk * 33 + (lane & 31)] = W[(size_t)(k0 + kk) * ldw + n0 + (lane & 31)]; }
    LDS_WAIT(); asm volatile("" ::: "memory");
    const int c = lane & 7;
#pragma unroll
    for (int j = 0; j < 4; ++j) { const int n = (lane >> 3) + 8 * j; const LAS float* s = scr + (8 * c) * 33 + n;
        v4u o; o.x = pk2(s[0 * 33], s[1 * 33]); o.y = pk2(s[2 * 33], s[3 * 33]); o.z = pk2(s[4 * 33], s[5 * 33]); o.w = pk2(s[6 * 33], s[7 * 33]);
        *(GAS v4u*)(WT + (size_t)(n0 + n) * K + k0 + 8 * c) = o; }
    LDS_WAIT(); asm volatile("" ::: "memory");
}
DI void p0_ada_item(Frame& F, LAS float* scr, int item) {
    const int cc = item % (NMOD / 256), kc = item / (NMOD / 256), k0 = kc * ADA_KROWS, col = cc * 256 + F.lane * 4;
#pragma unroll
    for (int j = 0; j < ADA_KROWS / 64; ++j) scr[F.lane + 64 * j] = silu_f(F.c[k0 + F.lane + 64 * j]);
    LDS_WAIT(); asm volatile("" ::: "memory");
    f32x4 acc = {0.f, 0.f, 0.f, 0.f};
    const float* wp = F.ada_w + (size_t)k0 * NMOD + col;
#pragma unroll 8
    for (int kk = 0; kk < ADA_KROWS; ++kk) { const float s = scr[kk]; const f32x4 w = *(const GAS f32x4*)(wp + (size_t)kk * NMOD); acc += w * s; }
    *(GAS f32x4*)(F.MODP + (size_t)kc * NMOD + col) = acc;
    LDS_WAIT(); asm volatile("" ::: "memory");
}
DI void p0a_phase(Frame& F) {
    LAS float* scr = (LAS float*)(F.lds + F.wave * 16384);
    const int gw = F.wave * F.G + F.vcu, NGW = F.G * NWAVES;
    constexpr int I_ADA = (NMOD / 256) * ADA_KC;
    constexpr int I_WIN = (D / 64) * (NPROJ / 32), I_WO = (D / 64) * (D / 32);
    constexpr int NITEMS = I_ADA + I_WIN + I_WO;
    for (int it = gw; it < NITEMS; it += NGW) {
        int r = it;
        if (r < I_ADA) { p0_ada_item(F, scr, r); continue; } r -= I_ADA;
        if (r < I_WIN) { p0_transpose_item(F.w_in, D, IN_COLS, NPROJ / 32, F.WIN, scr, r, F.lane); continue; } r -= I_WIN;
        p0_transpose_item(F.w_out, D, D, D / 32, F.WOUT, scr, r, F.lane);
    }
#pragma unroll 1
    for (int row = gw; row < 2 * NEXP; row += NGW) {
        const int tb = row >= NEXP, e = row - tb * NEXP;
        const GAS f32x4* src = (const GAS f32x4*)((tb ? F.e_up : F.e_down) + (size_t)e * D) + F.lane;
        f32x4 v[8]; float am = 0.f;
#pragma unroll
        for (int j = 0; j < 8; ++j) { v[j] = src[64 * j]; am = fmaxf(am, fmaxf(fmaxf(fabsf(v[j].x), fabsf(v[j].y)), fmaxf(fabsf(v[j].z), fabsf(v[j].w)))); }
        am = fmaxf(wave_max(am), 1e-30f);
        const float sc = am * (1.0f / 127.0f), inv = 127.0f / am;
        GAS unsigned* dst = (GAS unsigned*)((tb ? F.EU : F.ED) + (size_t)e * D) + F.lane;
        const int off = tb ? 128 : 0;
#pragma unroll
        for (int j = 0; j < 8; ++j) {
            const int q0 = (int)__builtin_rintf(v[j].x * inv) + off, q1 = (int)__builtin_rintf(v[j].y * inv) + off, q2 = (int)__builtin_rintf(v[j].z * inv) + off, q3 = (int)__builtin_rintf(v[j].w * inv) + off;
            dst[64 * j] = (unsigned)(q0 & 255) | ((unsigned)(q1 & 255) << 8) | ((unsigned)(q2 & 255) << 16) | ((unsigned)(q3 & 255) << 24);
        }
        if (F.lane == 0) (tb ? F.SU : F.SD)[e] = sc;
    }
}
DI float mod_final(Frame& F, int col) { float s = F.ada_b[col];
#pragma unroll
    for (int k = 0; k < ADA_KC; ++k) s += F.MODP[(size_t)k * NMOD + col];
    return s; }
DI void norm_tables(Frame& F, const float* g, int col_scale, int col_shift) {
    LAS float* A1 = (LAS float*)(F.lds); LAS float* B1 = (LAS float*)(F.lds + 8192);
#pragma unroll
    for (int i = 0; i < 4; ++i) { const int c = F.tid + 512 * i; A1[c] = g[c] * (1.0f + F.MODF[col_scale + c]); B1[c] = F.MODF[col_shift + c]; }
}
DI void p0_wq_item(Frame& F, LAS float* scr, int item) {
    const int lane = F.lane, nblk = D / 32, kb = item / nblk, nb = item % nblk, k0 = 64 * kb, n0 = 32 * nb;
    LAS float* gsl = scr + 64 * 33; LAS float* shl = gsl + 64;
    gsl[lane] = F.norm_ffn_g[k0 + lane] * (1.0f + mod_final(F, MOD_SCF + k0 + lane)); shl[lane] = mod_final(F, MOD_SHF + k0 + lane);
    LDS_WAIT(); asm volatile("" ::: "memory");
    float bp = 0.f;
#pragma unroll 8
    for (int i = 0; i < 32; ++i) { const int kk = 2 * i + (lane >> 5); const float w = F.wq[(size_t)(k0 + kk) * D + n0 + (lane & 31)]; scr[kk * 33 + (lane & 31)] = w * gsl[kk]; bp += w * shl[kk]; }
    bp += __shfl_xor(bp, 32);
    if (lane < 32) F.BQP[(size_t)kb * D + n0 + lane] = bp;
    LDS_WAIT(); asm volatile("" ::: "memory");
    const int c = lane & 7;
#pragma unroll
    for (int j = 0; j < 4; ++j) { const int n = (lane >> 3) + 8 * j; const LAS float* sp = scr + (8 * c) * 33 + n;
        v4u o; o.x = pk2(sp[0 * 33], sp[1 * 33]); o.y = pk2(sp[2 * 33], sp[3 * 33]); o.z = pk2(sp[4 * 33], sp[5 * 33]); o.w = pk2(sp[6 * 33], sp[7 * 33]);
        *(GAS v4u*)(F.WQ + (size_t)(n0 + n) * D + k0 + 8 * c) = o; }
    LDS_WAIT(); asm volatile("" ::: "memory");
}
DI void p0b_phase(Frame& F) {
    LAS float* A1 = (LAS float*)(F.lds); LAS float* B1 = (LAS float*)(F.lds + 8192); LAS float* WG = (LAS float*)(F.lds + 16384);
#pragma unroll
    for (int i = 0; i < 4; ++i) { const int c = F.tid + 512 * i; A1[c] = F.norm_mix_g[c] * (1.0f + mod_final(F, MOD_SCM + c)); B1[c] = mod_final(F, MOD_SHM + c); }
    { const int per = (NMOD + F.G - 1) / F.G; const int c = (int)blockIdx.x * per + F.tid; if (F.tid < per && c < NMOD) F.MODF[c] = mod_final(F, c); }
#pragma unroll
    for (int i = 0; i < 4; ++i) { const int k = F.tid + 512 * i; const f32x4 a = *(const GAS f32x4*)(F.w_in + (size_t)k * IN_COLS + NPROJ), b = *(const GAS f32x4*)(F.w_in + (size_t)k * IN_COLS + NPROJ + 4);
        WG[0 * 2048 + k] = a.x; WG[1 * 2048 + k] = a.y; WG[2 * 2048 + k] = a.z; WG[3 * 2048 + k] = a.w; WG[4 * 2048 + k] = b.x; WG[5 * 2048 + k] = b.y; WG[6 * 2048 + k] = b.z; WG[7 * 2048 + k] = b.w; }
    __syncthreads();
    const int gw = F.vcu * NWAVES + F.wave, NGW = F.G * NWAVES;
    f32x4 vn[8];
    { const GAS f32x4* xr = (const GAS f32x4*)(F.x + (size_t)gw * D) + F.lane;
#pragma unroll
      for (int j = 0; j < 8; ++j) vn[j] = xr[64 * j]; }
#pragma unroll 1
    for (int row = gw; row < M; row += NGW) {
        f32x4 v[8]; float ss = 0.f;
#pragma unroll
        for (int j = 0; j < 8; ++j) { v[j] = vn[j]; ss += (v[j].x * v[j].x + v[j].y * v[j].y) + (v[j].z * v[j].z + v[j].w * v[j].w); }
        if (row + NGW < M) { const GAS f32x4* xr = (const GAS f32x4*)(F.x + (size_t)(row + NGW) * D) + F.lane;
#pragma unroll
            for (int j = 0; j < 8; ++j) vn[j] = xr[64 * j]; }
        const float rstd = 1.0f / sqrtf(wave_sum(ss) * (1.0f / D) + EPS);
        float gd[8];
#pragma unroll
        for (int g = 0; g < 8; ++g) gd[g] = 0.f;
        GAS v2u* o8 = (GAS v2u*)(F.HA + (size_t)row * D) + F.lane;
#pragma unroll
        for (int j = 0; j < 8; ++j) {
            const f32x4 a = *(const LAS f32x4*)(A1 + 256 * j + 4 * F.lane), b = *(const LAS f32x4*)(B1 + 256 * j + 4 * F.lane);
            const f32x4 h = v[j] * rstd * a + b;
            v2u o; o.x = pk2(h.x, h.y); o.y = pk2(h.z, h.w); o8[64 * j] = o;
#pragma unroll
            for (int g = 0; g < 8; ++g) { const f32x4 w = *(const LAS f32x4*)(WG + g * 2048 + 256 * j + 4 * F.lane); gd[g] += (h.x * w.x + h.y * w.y) + (h.z * w.z + h.w * w.w); }
            asm volatile("" ::: "memory");
        }
#pragma unroll
        for (int g = 0; g < 8; ++g) gd[g] = wave_sum(gd[g]);
        if (F.lane == 0) {
#pragma unroll
            for (int g = 0; g < 8; ++g) { float p = gd[g] + F.b_gates[g];
                if (g >= 4) { p = fminf(p, 0.f) - log1pf(__expf(-fabsf(p))); }
                F.GATES[(size_t)row * 8 + g] = p; }
        }
    }
    __syncthreads();
    {
        LAS float* scr = (LAS float*)(F.lds + F.wave * 8960);
        for (int it = F.wave * F.G + F.vcu; it < (D / 64) * (D / 32); it += NGW) p0_wq_item(F, scr, it);
    }
}
constexpr int IMG_PITCH = 576, M1_WL = 73728, M1_RED = 74240;
typedef short s16x4 __attribute__((ext_vector_type(4)));
DI bf16x8 tr_frag(const LAS unsigned char* p, int off_lo, int off_hi) {
    const s16x4 lo = __builtin_amdgcn_ds_read_tr16_b64_v4i16((LAS s16x4*)(p + off_lo));
    const s16x4 hi = __builtin_amdgcn_ds_read_tr16_b64_v4i16((LAS s16x4*)(p + off_hi));
    return __builtin_shufflevector(lo, hi, 0, 1, 2, 3, 4, 5, 6, 7);
}
DI float bfel(const v4u& w, int e) { const unsigned d = w[e >> 1]; return (e & 1) ? bfhi(d) : bflo(d); }
DI void m1_item(Frame& F, int hh, int kc) {
    LAS unsigned char* IMG = F.lds; LAS float* WL = (LAS float*)(F.lds + M1_WL); LAS float* RED = (LAS float*)(F.lds + M1_RED);
    const int t0 = kc * CH, lane = F.lane, tid = F.tid;
    if (F.wave == 0) {
        const float* gp = F.GATES + (size_t)(t0 + 2 * lane) * 8;
        const float i0 = gp[hh], lf0 = gp[4 + hh], i1 = gp[8 + hh], lf1 = gp[12 + hh];
        const float p = lf0 + lf1; float inc = p;
#pragma unroll
        for (int o = 1; o < 64; o <<= 1) { const float t = __shfl_up(inc, o); if (lane >= o) inc += t; }
        const float A = __shfl(inc, 63), ex = inc - p, b0 = ex + lf0, b1 = ex + p;
        const float lw0 = A - b0 + i0, lw1 = A - b1 + i1;
        const float B = wave_max(fmaxf(lw0, lw1));
        WL[2 * lane] = __expf(lw0 - B); WL[2 * lane + 1] = __expf(lw1 - B);
        if (lane == 0) { F.SUMM[(hh * NCHUNK + kc) * 2] = A; F.SUMM[(hh * NCHUNK + kc) * 2 + 1] = B; }
    }
    __syncthreads();
    const int dg = tid & 31, sg = tid >> 5;
#pragma unroll 1
    for (int which = 0; which < 2; ++which) {
        const int chb = (which == 0 ? 1024 : 0) + hh * DH + dg * 8;
        const int colb = (which == 0 ? C_K : C_Q) + hh * DH + dg * 8;
        v4u raw[11];
#pragma unroll
        for (int rr = 0; rr < 11; ++rr) { const int tt = t0 + sg * 8 - 3 + rr; raw[rr] = (v4u){0u, 0u, 0u, 0u}; if (tt >= 0) raw[rr] = *(const GAS v4u*)(F.PROJ + (size_t)tt * NPROJ + colb); }
        float wl[8];
#pragma unroll
        for (int i = 0; i < 8; ++i) wl[i] = (which == 0) ? WL[sg * 8 + i] : 0.0625f;
        v4u o1[8], o2[8];
#pragma unroll
        for (int dw = 0; dw < 4; ++dw) {
            typedef float f32x2 __attribute__((ext_vector_type(2)));
            f32x2 cw[4];
#pragma unroll
            for (int j = 0; j < 4; ++j) cw[j] = *(const GAS f32x2*)(F.conv_w + j * 2048 + chb + 2 * dw);
            const f32x2 cb = *(const GAS f32x2*)(F.conv_b + chb + 2 * dw);
            float xl[11], xh[11];
#pragma unroll
            for (int rr = 0; rr < 11; ++rr) { xl[rr] = bflo(raw[rr][dw]); xh[rr] = bfhi(raw[rr][dw]); }
            float d0 = 0.f, d1 = 0.f;
#pragma unroll
            for (int i = 0; i < 8; ++i) {
                float a0 = cb.x, a1 = cb.y;
#pragma unroll
                for (int j = 0; j < 4; ++j) { a0 += cw[j].x * xl[i + j]; a1 += cw[j].y * xh[i + j]; }
                a0 = silu_f(a0); a1 = silu_f(a1);
                if (which == 0) { o1[i][dw] = pk2(a0, a1); a0 *= wl[i]; a1 *= wl[i]; d0 += a0; d1 += a1; o2[i][dw] = pk2(a0, a1); }
                else { o1[i][dw] = pk2(a0 * wl[i], a1 * wl[i]); }
            }
            if (which == 0) { RED[sg * 256 + dg * 8 + 2 * dw] = d0; RED[sg * 256 + dg * 8 + 2 * dw + 1] = d1; }
            asm volatile("" ::: "memory");
        }
#pragma unroll
        for (int i = 0; i < 8; ++i) { const int s = sg * 8 + i, t = t0 + s;
            if (which == 0) { *(GAS v4u*)(F.KC + (size_t)t * 1024 + hh * DH + dg * 8) = o1[i]; *(LAS v4u*)(IMG + s * IMG_PITCH + dg * 16) = o2[i]; }
            else { *(GAS v4u*)(F.QC + (size_t)t * 1024 + hh * DH + dg * 8) = o1[i]; } }
    }
    __syncthreads();
    if (tid < 256) { float s = 0.f;
#pragma unroll
        for (int i = 0; i < 16; ++i) s += RED[i * 256 + tid];
        F.NST[(size_t)(hh * NCHUNK + kc) * DH + tid] = s; }
    const int r = lane & 31, h = lane >> 5, e0 = F.wave * 32;
    bf16x8 bf[8];
#pragma unroll
    for (int ks = 0; ks < 8; ++ks) {
        const bf16* vp = F.PROJ + (size_t)(t0 + ks * 16 + 8 * h) * NPROJ + C_VM + hh * DH + e0 + r;
#pragma unroll
        for (int j = 0; j < 8; ++j) bf[ks][j] = (short)vp[(size_t)j * NPROJ];
    }
    bf16* sp = F.STATE + (size_t)(hh * NCHUNK + kc) * (DH * DH) + (size_t)(e0 + r) * DH;
    const LAS unsigned char* trb = IMG + (8 * h + ((lane & 15) >> 2)) * IMG_PITCH + (16 * ((lane >> 4) & 1) + 4 * (lane & 3)) * 2;
#pragma unroll 1
    for (int dt = 0; dt < 8; ++dt) {
        f32x16 acc = zero16();
#pragma unroll
        for (int ks = 0; ks < 8; ++ks) { const bf16x8 af = tr_frag(trb + dt * 64, ks * 16 * IMG_PITCH, ks * 16 * IMG_PITCH + 4 * IMG_PITCH); acc = MFMA32(af, bf[ks], acc); }
#pragma unroll
        for (int g = 0; g < 4; ++g) { v2u o; o.x = pk2(acc[4 * g], acc[4 * g + 1]); o.y = pk2(acc[4 * g + 2], acc[4 * g + 3]);
            *(GAS v2u*)(sp + dt * 32 + 8 * g + 4 * h) = o; }
    }
    __syncthreads();
}
DI void gmlp_item(Frame& F, int n, int g) {
    LAS float* RSTD = (LAS float*)F.lds;
    const int t0 = n * CH, c0 = g * 128, lane = F.lane, tid = F.tid;
    { const int s = tid >> 2, qd = tid & 3; const bf16* vp = F.PROJ + (size_t)(t0 + s) * NPROJ + C_VG + c0 + qd * 32; float ss = 0.f;
#pragma unroll
        for (int i = 0; i < 4; ++i) { const v4u w = *(const GAS v4u*)(vp + 8 * i);
            const float a0 = bflo(w.x), a1 = bfhi(w.x), a2 = bflo(w.y), a3 = bfhi(w.y), a4 = bflo(w.z), a5 = bfhi(w.z), a6 = bflo(w.w), a7 = bfhi(w.w);
            ss += (a0 * a0 + a1 * a1) + (a2 * a2 + a3 * a3) + (a4 * a4 + a5 * a5) + (a6 * a6 + a7 * a7); }
        ss += __shfl_xor(ss, 1); ss += __shfl_xor(ss, 2);
        if (qd == 0) RSTD[s] = 1.0f / sqrtf(ss * (1.0f / 128.0f) + EPS); }
    __syncthreads();
    const int r = lane & 31, h = lane >> 5, ct = F.wave & 3, tp = F.wave >> 2;
    bf16x8 af[8];
#pragma unroll
    for (int ks = 0; ks < 8; ++ks) {
        const bf16* vp = F.PROJ + (size_t)(t0 + ks * 16 + 8 * h) * NPROJ + C_VG + c0 + ct * 32 + r;
#pragma unroll
        for (int j = 0; j < 8; ++j) af[ks][j] = (short)vp[(size_t)j * NPROJ];
    }
    float ng[16];
#pragma unroll
    for (int reg = 0; reg < 16; ++reg) ng[reg] = F.gmlp_norm_g[g * 128 + ct * 32 + crow(reg, h)];
#pragma unroll 1
    for (int ti = 0; ti < 2; ++ti) {
        const int tt = (ti == 0) ? tp : 3 - tp;
        const int t = tt * 32 + r;
        const float* wrow = F.gmlp_w + (size_t)(g * 128 + t) * 128;
        f32x16 acc = zero16();
#pragma unroll
        for (int ks = 0; ks < 8; ++ks) {
            if (ks <= 2 * tt + 1) {
                const int s0 = ks * 16 + 8 * h;
                const f32x4 wa = *(const GAS f32x4*)(wrow + s0), wb = *(const GAS f32x4*)(wrow + s0 + 4);
                const f32x4 ra = *(const LAS f32x4*)(RSTD + s0), rb = *(const LAS f32x4*)(RSTD + s0 + 4);
                float wv[8] = {wa.x * ra.x, wa.y * ra.y, wa.z * ra.z, wa.w * ra.w, wb.x * rb.x, wb.y * rb.y, wb.z * rb.z, wb.w * rb.w};
#pragma unroll
                for (int j = 0; j < 8; ++j) if (s0 + j > t) wv[j] = 0.f;
                v4u bw; bw.x = pk2(wv[0], wv[1]); bw.y = pk2(wv[2], wv[3]); bw.z = pk2(wv[4], wv[5]); bw.w = pk2(wv[6], wv[7]);
                acc = MFMA32(af[ks], __builtin_bit_cast(bf16x8, bw), acc);
            }
        }
        const float bsp = F.gmlp_b[g * 128 + t];
        const bf16* up = F.PROJ + (size_t)(t0 + t) * NPROJ + C_UG + c0 + ct * 32;
        bf16* yp = F.HA + (size_t)(t0 + t) * D + c0 + ct * 32;
#pragma unroll
        for (int gq = 0; gq < 4; ++gq) { const int cl = 8 * gq + 4 * h;
            const v2u uw = *(const GAS v2u*)(up + cl);
            const float y0 = bflo(uw.x) * (ng[4 * gq] * acc[4 * gq] + bsp), y1 = bfhi(uw.x) * (ng[4 * gq + 1] * acc[4 * gq + 1] + bsp);
            const float y2 = bflo(uw.y) * (ng[4 * gq + 2] * acc[4 * gq + 2] + bsp), y3 = bfhi(uw.y) * (ng[4 * gq + 3] * acc[4 * gq + 3] + bsp);
            v2u o; o.x = pk2(y0, y1); o.y = pk2(y2, y3); *(GAS v2u*)(yp + cl) = o; }
    }
    __syncthreads();
}
DI void p2_phase(Frame& F) {
    constexpr int N_M1 = NHEAD * NCHUNK, N_G = (M / CH) * 8;
#pragma unroll 1
    for (int it = (int)blockIdx.x; it < N_M1; it += F.G) m1_item(F, it / NCHUNK, it % NCHUNK);
#pragma unroll 1
    for (int j = (int)blockIdx.x; j < N_G; j += F.G) gmlp_item(F, j % (M / CH), j / (M / CH));
}
DI void p3_phase(Frame& F) {
    LAS float* TAB = (LAS float*)F.lds;
    const int lane = F.lane;
    if (F.wave < NHEAD) {
        const int hh = F.wave; const float* sp = F.SUMM + (size_t)(hh * NCHUNK + 2 * lane) * 2;
        const float A0 = sp[0], B0 = sp[1], A1 = sp[2], B1 = sp[3];
        float ca = A0 + A1, cb = fmaxf(B0 + A1, B1);
        const float pa = ca, pb = cb;
#pragma unroll
        for (int o = 1; o < 64; o <<= 1) { const float ta = __shfl_up(ca, o), tb = __shfl_up(cb, o); if (lane >= o) { cb = fmaxf(tb + ca, cb); ca = ta + ca; } }
        (void)pa; (void)pb;
        float ea = __shfl_up(ca, 1), eb = __shfl_up(cb, 1);
        float m0 = (lane == 0) ? 0.f : fmaxf(ea, eb);
        const float m1 = fmaxf(m0 + A0, B0), m2 = fmaxf(m1 + A1, B1);
        TAB[(hh * NCHUNK + 2 * lane) * 2] = __expf(A0 + m0 - m1); TAB[(hh * NCHUNK + 2 * lane) * 2 + 1] = __expf(B0 - m1);
        TAB[(hh * NCHUNK + 2 * lane + 1) * 2] = __expf(A1 + m1 - m2); TAB[(hh * NCHUNK + 2 * lane + 1) * 2 + 1] = __expf(B1 - m2);
        if (blockIdx.x == 0) { F.MTAB[hh * NCHUNK + 2 * lane] = m0; F.MTAB[hh * NCHUNK + 2 * lane + 1] = m1; }
    }
    __syncthreads();
    const int NT = F.G * NWAVES * 64, gt = (int)blockIdx.x * (NWAVES * 64) + F.tid;
    if (gt < D) { float b = 0.f;
#pragma unroll 8
        for (int k = 0; k < D / 64; ++k) b += F.BQP[(size_t)k * D + gt];
        F.BIASQ[gt] = b; }
    for (int p = gt; p < NHEAD * (DH * DH / 2); p += NT) {
        const int hh = p / (DH * DH / 2), q = p % (DH * DH / 2);
        GAS unsigned* sp = (GAS unsigned*)(F.STATE + (size_t)hh * NCHUNK * (DH * DH)) + q;
        float s0 = 0.f, s1 = 0.f;
#pragma unroll 1
        for (int k0 = 0; k0 < NCHUNK; k0 += 16) {
            unsigned ld[16];
#pragma unroll
            for (int k = 0; k < 16; ++k) ld[k] = sp[(size_t)(k0 + k) * (DH * DH / 2)];
#pragma unroll
            for (int k = 0; k < 16; ++k) {
                sp[(size_t)(k0 + k) * (DH * DH / 2)] = pk2(s0, s1);
                const float dec = TAB[(hh * NCHUNK + k0 + k) * 2], wb = TAB[(hh * NCHUNK + k0 + k) * 2 + 1];
                s0 = dec * s0 + wb * bflo(ld[k]); s1 = dec * s1 + wb * bfhi(ld[k]);
            }
        }
    }
    for (int p = gt; p < NHEAD * DH; p += NT) {
        const int hh = p / DH, d = p % DH; float* np = F.NST + (size_t)hh * NCHUNK * DH + d; float s = 0.f;
#pragma unroll 8
        for (int k = 0; k < NCHUNK; ++k) { const float ld = np[(size_t)k * DH]; np[(size_t)k * DH] = s; s = TAB[(hh * NCHUNK + k) * 2] * s + TAB[(hh * NCHUNK + k) * 2 + 1] * ld; }
    }
}
constexpr int M3_VIMG = 8192, M3_QIMG = 81920, QPITCH = 528;
DI void m3_item(Frame& F, int hh, int kc) {
    LAS float* GS = (LAS float*)F.lds; LAS float* MX = (LAS float*)(F.lds + 512); LAS float* BT = (LAS float*)(F.lds + 1024);
    LAS float* NK = (LAS float*)(F.lds + 2048); LAS float* XCH = (LAS float*)(F.lds + 4096);
    LAS unsigned char* VIMG = F.lds + M3_VIMG; LAS unsigned char* QIMG = F.lds + M3_QIMG;
    const int t0 = kc * CH, lane = F.lane, tid = F.tid, item = hh * NCHUNK + kc;
    const float mk = F.MTAB[item];
    if (F.wave == 0) {
        const float* gp = F.GATES + (size_t)(t0 + 2 * lane) * 8;
        const float i0 = gp[hh], lf0 = gp[4 + hh], i1 = gp[8 + hh], lf1 = gp[12 + hh];
        const float p = lf0 + lf1; float inc = p;
#pragma unroll
        for (int o = 1; o < 64; o <<= 1) { const float t = __shfl_up(inc, o); if (lane >= o) inc += t; }
        const float ex = inc - p, b0 = ex + lf0, b1 = ex + p;
        const float g0 = i0 - b0, g1 = i1 - b1;
        float cm = fmaxf(g0, g1);
#pragma unroll
        for (int o = 1; o < 64; o <<= 1) { const float t = __shfl_up(cm, o); if (lane >= o) cm = fmaxf(cm, t); }
        float pm = __shfl_up(cm, 1); if (lane == 0) pm = -INFINITY;
        const float M0 = fmaxf(mk, fmaxf(pm, g0)), M1 = fmaxf(M0, g1);
        GS[2 * lane] = g0; GS[2 * lane + 1] = g1; MX[2 * lane] = M0; MX[2 * lane + 1] = M1; BT[2 * lane] = b0; BT[2 * lane + 1] = b1;
    }
    if (tid < 256) NK[tid] = F.NST[(size_t)item * DH + tid];
    unsigned touch;
    {
        const unsigned* c0 = (const unsigned*)(F.STATE + (size_t)item * (DH * DH)) + (size_t)tid * 32;
        const unsigned* k0 = (const unsigned*)(F.KC + (size_t)(t0 + (tid >> 2)) * 1024 + hh * DH) + (tid & 3) * 32;
        touch = *(const volatile unsigned*)c0; touch = *(const volatile unsigned*)(c0 + 512 * 32); touch = *(const volatile unsigned*)k0;
    }
    {
        v4u tv[8], tq[8];
#pragma unroll
        for (int i = 0; i < 8; ++i) { const int c = tid + 512 * i, row = c >> 5, c16 = c & 31;
            tv[i] = *(const GAS v4u*)(F.PROJ + (size_t)(t0 + row) * NPROJ + C_VM + hh * DH + c16 * 8); tq[i] = *(const GAS v4u*)(F.QC + (size_t)(t0 + row) * 1024 + hh * DH + c16 * 8); }
#pragma unroll
        for (int i = 0; i < 8; ++i) { const int c = tid + 512 * i, row = c >> 5, c16 = c & 31;
            *(LAS v4u*)(VIMG + row * IMG_PITCH + c16 * 16) = tv[i]; *(LAS v4u*)(QIMG + row * QPITCH + c16 * 16) = tq[i]; }
    }
    (void)touch;
    __syncthreads();
    const int r = lane & 31, h = lane >> 5, tt = F.wave & 3, eh = F.wave >> 2;
    const int tl = tt * 32 + r, t = t0 + tl;
    const float Mt = MX[tl], winter = __expf(mk - Mt);
    f32x16 accH[4];
#pragma unroll
    for (int i = 0; i < 4; ++i) accH[i] = zero16();
    float qn = 0.f;
    const LAS unsigned char* qb = QIMG + tl * QPITCH + 16 * h;
    const bf16* kp = F.KC + (size_t)(t0 + r) * 1024 + hh * DH + 8 * h;
    const bf16* cp = F.STATE + (size_t)item * (DH * DH) + (size_t)(eh * 128 + r) * DH + 8 * h;
#ifndef M3_NOQC
    {
#pragma unroll 2
        for (int ks = 0; ks < 16; ++ks) {
            const v4u qw = *(const LAS v4u*)(qb + 32 * ks);
            float qv[8] = {bflo(qw.x), bfhi(qw.x), bflo(qw.y), bfhi(qw.y), bflo(qw.z), bfhi(qw.z), bflo(qw.w), bfhi(qw.w)};
            const f32x4 na = *(const LAS f32x4*)(NK + ks * 16 + 8 * h), nb = *(const LAS f32x4*)(NK + ks * 16 + 8 * h + 4);
            qn += (qv[0] * na.x + qv[1] * na.y) + (qv[2] * na.z + qv[3] * na.w) + (qv[4] * nb.x + qv[5] * nb.y) + (qv[6] * nb.z + qv[7] * nb.w);
            v4u q2; q2.x = pk2(qv[0] * winter, qv[1] * winter); q2.y = pk2(qv[2] * winter, qv[3] * winter); q2.z = pk2(qv[4] * winter, qv[5] * winter); q2.w = pk2(qv[6] * winter, qv[7] * winter);
            const bf16x8 q2f = __builtin_bit_cast(bf16x8, q2);
#pragma unroll
            for (int et = 0; et < 4; ++et) { const bf16x8 cf = *(const GAS bf16x8*)(cp + (size_t)et * 32 * DH + ks * 16); accH[et] = MFMA32(cf, q2f, accH[et]); }
        }
    }
#endif
    qn += __shfl_xor(qn, 32);
    float den = 0.f;
    const LAS unsigned char* vtr = VIMG + (4 * h + ((lane & 15) >> 2)) * IMG_PITCH + (eh * 128 + 16 * ((lane >> 4) & 1) + 4 * (lane & 3)) * 2;
#ifdef M3_NOST
    for (int st = 0; st < 0; ++st) {
#else
#pragma unroll 1
    for (int st = 0; st <= tt; ++st) {
#endif
        f32x16 accS = zero16();
        const bf16* kps = kp + (size_t)st * 32 * 1024;
#pragma unroll 4
        for (int ks = 0; ks < 16; ++ks) { const bf16x8 kf = *(const GAS bf16x8*)(kps + ks * 16); const bf16x8 qf = *(const LAS bf16x8*)(qb + 32 * ks); accS = MFMA32(kf, qf, accS); }
        float xv[16];
#pragma unroll
        for (int reg = 0; reg < 16; ++reg) { const int sl = st * 32 + crow(reg, h); float v = accS[reg] * __expf(GS[sl] - Mt); if (sl > tl) v = 0.f; xv[reg] = v; den += v; }
        const LAS unsigned char* vb2 = vtr + st * 32 * IMG_PITCH;
#pragma unroll
        for (int k2 = 0; k2 < 2; ++k2) {
            v4u xw; xw.x = pk2(xv[8 * k2], xv[8 * k2 + 1]); xw.y = pk2(xv[8 * k2 + 2], xv[8 * k2 + 3]); xw.z = pk2(xv[8 * k2 + 4], xv[8 * k2 + 5]); xw.w = pk2(xv[8 * k2 + 6], xv[8 * k2 + 7]);
            const bf16x8 xs = __builtin_bit_cast(bf16x8, xw);
#pragma unroll
            for (int et = 0; et < 4; ++et) {
                const bf16x8 vf = tr_frag(vb2 + et * 64, 16 * k2 * IMG_PITCH, 16 * k2 * IMG_PITCH + 8 * IMG_PITCH);
                accH[et] = MFMA32(vf, xs, accH[et]);
            }
        }
    }
    den += __shfl_xor(den, 32);
    den += winter * qn;
    const float dnm = fmaxf(fabsf(den), __expf(-(BT[tl] + Mt))), inv = 1.0f / dnm;
    float ss = 0.f;
#pragma unroll
    for (int et = 0; et < 4; ++et)
#pragma unroll
        for (int reg = 0; reg < 16; ++reg) { accH[et][reg] *= inv; ss += accH[et][reg] * accH[et][reg]; }
    ss += __shfl_xor(ss, 32);
    if (h == 0) XCH[eh * 128 + tl] = ss;
    __syncthreads();
    const float rstd = 1.0f / sqrtf((XCH[tl] + XCH[128 + tl]) * (1.0f / DH) + EPS);
    const bf16* op = F.PROJ + (size_t)t * NPROJ + C_OM + hh * DH + eh * 128;
    bf16* yp = F.HA + (size_t)t * D + 1024 + hh * DH + eh * 128;
    const float* ngp = F.mlstm_norm_g + hh * DH + eh * 128;
#pragma unroll
    for (int et = 0; et < 4; ++et)
#pragma unroll
        for (int gq = 0; gq < 4; ++gq) { const int el = et * 32 + 8 * gq + 4 * h;
            const v2u ow = *(const GAS v2u*)(op + el); const f32x4 gn = *(const GAS f32x4*)(ngp + el);
            const float y0 = accH[et][4 * gq] * rstd * gn.x * sigmoid_f(bflo(ow.x)), y1 = accH[et][4 * gq + 1] * rstd * gn.y * sigmoid_f(bfhi(ow.x));
            const float y2 = accH[et][4 * gq + 2] * rstd * gn.z * sigmoid_f(bflo(ow.y)), y3 = accH[et][4 * gq + 3] * rstd * gn.w * sigmoid_f(bfhi(ow.y));
            v2u o; o.x = pk2(y0, y1); o.y = pk2(y2, y3); *(GAS v2u*)(yp + el) = o; }
    __syncthreads();
}
DI void p4_phase(Frame& F) {
    for (int it = (int)blockIdx.x; it < NHEAD * NCHUNK; it += F.G) m3_item(F, it / NCHUNK, it % NCHUNK);
}
constexpr int KPITCH = 272, P8_TBL = 69632;
DI void topk_insert(float (&L)[16], float x) {
#pragma unroll
    for (int i = 15; i >= 1; --i) L[i] = __builtin_amdgcn_fmed3f(x, L[i - 1], L[i]);
    L[0] = fmaxf(L[0], x);
}
DI void p8_phase(Frame& F) {
    LAS unsigned char* KIMG = F.lds; LAS unsigned char* TBL = F.lds + P8_TBL + F.wave * 1024;
    const int lane = F.lane, tid = F.tid, r = lane & 31, h = lane >> 5;
#pragma unroll 4
    for (int i = 0; i < 16; ++i) { const int idx = tid * 4 + 2048 * i, side = idx >> 14, rem = idx & 16383, row = rem >> 7, col = rem & 127;
        const f32x4 a = *(const GAS f32x4*)((side ? F.keys2 : F.keys1) + rem);
        v2u o; o.x = pk2(a.x, a.y); o.y = pk2(a.z, a.w); *(LAS v2u*)(KIMG + (side * 128 + row) * KPITCH + col * 2) = o; }
    __syncthreads();
    for (int it = (int)blockIdx.x; it < (M / 256) * PH; it += F.G) {
        const int tile = it / PH, hd = it % PH;
        const int t = tile * 256 + F.wave * 32 + r;
        float L1[16], L2[16];
#pragma unroll 1
        for (int side = 0; side < 2; ++side) {
            f32x16 acc[4];
#pragma unroll
            for (int kt = 0; kt < 4; ++kt) acc[kt] = zero16();
            const bf16* qp = F.QB + (size_t)t * D + hd * 256 + side * 128 + 8 * h;
#pragma unroll
            for (int ks = 0; ks < 8; ++ks) {
                const bf16x8 qf = *(const GAS bf16x8*)(qp + ks * 16);
#pragma unroll
                for (int kt = 0; kt < 4; ++kt) { const bf16x8 kf = *(const LAS bf16x8*)(KIMG + (side * 128 + kt * 32 + r) * KPITCH + (ks * 16 + 8 * h) * 2); acc[kt] = MFMA32(kf, qf, acc[kt]); }
            }
            float L[16];
#pragma unroll
            for (int i = 0; i < 16; ++i) L[i] = -3.0e38f;
#pragma unroll
            for (int kt = 0; kt < 4; ++kt)
#pragma unroll
                for (int reg = 0; reg < 16; ++reg) { const unsigned key = (unsigned)(kt * 32 + crow(reg, h)); const float sv = acc[kt][reg];
                    topk_insert(L, __uint_as_float((__float_as_uint(sv) & ~127u) | key)); }
            float P[16];
#pragma unroll
            for (int i = 0; i < 16; ++i) P[i] = __shfl_xor(L[i], 32);
#pragma unroll
            for (int i = 0; i < 16; ++i) topk_insert(L, P[i]);
            if (side == 0) {
#pragma unroll
                for (int i = 0; i < 16; ++i) L1[i] = L[i];
            } else {
#pragma unroll
                for (int i = 0; i < 16; ++i) L2[i] = L[i];
            }
        }
        if (h == 0) {
#pragma unroll
            for (int w = 0; w < 4; ++w) {
                const unsigned a = (__builtin_bit_cast(unsigned, L1[4 * w]) & 127u) | ((__builtin_bit_cast(unsigned, L1[4 * w + 1]) & 127u) << 8) | ((__builtin_bit_cast(unsigned, L1[4 * w + 2]) & 127u) << 16) | ((__builtin_bit_cast(unsigned, L1[4 * w + 3]) & 127u) << 24);
                const unsigned b = (__builtin_bit_cast(unsigned, L2[4 * w]) & 127u) | ((__builtin_bit_cast(unsigned, L2[4 * w + 1]) & 127u) << 8) | ((__builtin_bit_cast(unsigned, L2[4 * w + 2]) & 127u) << 16) | ((__builtin_bit_cast(unsigned, L2[4 * w + 3]) & 127u) << 24);
                *(LAS unsigned*)(TBL + r * 32 + 4 * w) = a; *(LAS unsigned*)(TBL + r * 32 + 16 + 4 * w) = b;
            }
        }
        float T[16];
#pragma unroll
        for (int i = 0; i < 16; ++i) T[i] = -3.0e38f;
#pragma unroll
        for (int i = 0; i < 16; ++i) {
            const float v1 = __builtin_bit_cast(float, __builtin_bit_cast(unsigned, L1[i]) & ~127u);
#pragma unroll
            for (int j = 0; j < 16; ++j) if ((i + 1) * (j + 1) <= 16) {
                const float v2 = __builtin_bit_cast(float, __builtin_bit_cast(unsigned, L2[j]) & ~127u);
                topk_insert(T, __builtin_bit_cast(float, (__builtin_bit_cast(unsigned, v1 + v2) & ~255u) | (unsigned)(i * 16 + j)));
            }
        }
        LDS_WAIT(); asm volatile("" ::: "memory");
        float ev[16], esum = 0.f;
        const float mx = __builtin_bit_cast(float, __builtin_bit_cast(unsigned, T[0]) & ~255u);
#pragma unroll
        for (int i = 0; i < 16; ++i) { ev[i] = __expf(__builtin_bit_cast(float, __builtin_bit_cast(unsigned, T[i]) & ~255u) - mx); esum += ev[i]; }
        const float einv = 1.0f / esum;
        int eid[8]; float gt[8];
#pragma unroll
        for (int i = 0; i < 8; ++i) { const float tv = h ? T[8 + i] : T[i]; const float e = h ? ev[8 + i] : ev[i];
            const unsigned p = __builtin_bit_cast(unsigned, tv) & 255u;
            const unsigned i1 = *(const LAS unsigned char*)(TBL + r * 32 + (p >> 4)), i2 = *(const LAS unsigned char*)(TBL + r * 32 + 16 + (p & 15u));
            eid[i] = (int)(i1 * 128u + i2); gt[i] = e * einv; }
        int* ip = F.IDX + (size_t)t * NSEL + hd * 16 + 8 * h; float* gp = F.PG + (size_t)t * NSEL + hd * 16 + 8 * h;
        *(GAS v4u*)ip = (v4u){(unsigned)eid[0], (unsigned)eid[1], (unsigned)eid[2], (unsigned)eid[3]}; *(GAS v4u*)(ip + 4) = (v4u){(unsigned)eid[4], (unsigned)eid[5], (unsigned)eid[6], (unsigned)eid[7]};
        *(GAS f32x4*)gp = (f32x4){gt[0], gt[1], gt[2], gt[3]}; *(GAS f32x4*)(gp + 4) = (f32x4){gt[4], gt[5], gt[6], gt[7]};
        LDS_WAIT(); asm volatile("" ::: "memory");
    }
}
constexpr int P9_IDX = 131072, P9_SH = 147456, P9_CORR = 147712, P9_GF = 32768, P9_FG = 40960, P9_SSQ = 49152, NSLICE = 16, SLICE_B = 128;
#ifndef NSLICE_A
#define NSLICE_A NSLICE
#endif
#ifndef NSLICE_C
#define NSLICE_C NSLICE
#endif
template <int N, int MASK> DI void red_step_i(int (&v)[8], int lane) {
#pragma unroll
    for (int i = 0; i < N / 2; ++i) { const bool up = (lane & MASK) != 0; const int keep = up ? v[i + N / 2] : v[i], send = up ? v[i] : v[i + N / 2]; v[i] = keep + __shfl_xor(send, MASK); }
}
template <int N, int MASK> DI void red_step_f(float (&v)[16], int lane) {
#pragma unroll
    for (int i = 0; i < N / 2; ++i) { const bool up = (lane & MASK) != 0; const float keep = up ? v[i + N / 2] : v[i], send = up ? v[i] : v[i + N / 2]; v[i] = keep + __shfl_xor(send, MASK); }
}
typedef _Float16 h2v __attribute__((ext_vector_type(2)));
DI void acc4(float& o0, float& o1, float& o2, float& o3, unsigned u, float c) {
    const h2v p = __builtin_bit_cast(h2v, __builtin_amdgcn_perm(u, 0x64646464u, 0x01050004u));
    const h2v q = __builtin_bit_cast(h2v, __builtin_amdgcn_perm(u, 0x64646464u, 0x01070006u));
    o0 = __builtin_fmaf((float)p.x, c, o0); o1 = __builtin_fmaf((float)p.y, c, o1); o2 = __builtin_fmaf((float)q.x, c, o2); o3 = __builtin_fmaf((float)q.y, c, o3);
}
DI void p9v2_phase(Frame& F) {
    LAS unsigned char* HQ = F.lds; LAS float* A2 = (LAS float*)(F.lds + P9_IDX); LAS float* B2 = (LAS float*)(F.lds + P9_IDX + 8192);
    LAS unsigned short* IDX16 = (LAS unsigned short*)(F.lds + P9_IDX); LAS float* SH = (LAS float*)(F.lds + P9_SH); LAS float* CORR = (LAS float*)(F.lds + P9_CORR);
    LAS float* COEF = (LAS float*)F.lds; LAS float* GF = (LAS float*)(F.lds + P9_GF); LAS float* FG = (LAS float*)(F.lds + P9_FG);
    const int lane = F.lane, tid = F.tid, c8 = lane & 7, g = lane >> 3;
#pragma unroll 1
    for (int tb = (int)blockIdx.x * 64; tb < M; tb += F.G * 64) {
#pragma unroll
        for (int i = 0; i < 4; ++i) { const int c = tid + 512 * i; A2[c] = F.norm_ffn_g[c] * (1.0f + F.MODF[MOD_SCF + c]); B2[c] = F.MODF[MOD_SHF + c]; }
        __syncthreads();
#pragma unroll 1
        for (int j = 0; j < 8; ++j) {
            const int tl = F.wave * 8 + j, t = tb + tl;
            float hv[32]; float ss = 0.f;
            const bf16* xr = F.X1B + (size_t)t * D + 16 * lane;
#pragma unroll
            for (int jj = 0; jj < 2; ++jj)
#pragma unroll
                for (int q = 0; q < 2; ++q) { const v4u a = *(const GAS v4u*)(xr + 1024 * jj + 8 * q); const int o = 16 * jj + 8 * q;
                    hv[o] = bflo(a.x); hv[o + 1] = bfhi(a.x); hv[o + 2] = bflo(a.y); hv[o + 3] = bfhi(a.y); hv[o + 4] = bflo(a.z); hv[o + 5] = bfhi(a.z); hv[o + 6] = bflo(a.w); hv[o + 7] = bfhi(a.w); }
#pragma unroll
            for (int i = 0; i < 32; ++i) ss += hv[i] * hv[i];
            const float rstd = 1.0f / sqrtf(wave_sum(ss) * (1.0f / D) + EPS);
            float am = 0.f;
#pragma unroll
            for (int jj = 0; jj < 2; ++jj)
#pragma unroll
                for (int q = 0; q < 4; ++q) { const f32x4 a = *(const LAS f32x4*)(A2 + 1024 * jj + 16 * lane + 4 * q), b = *(const LAS f32x4*)(B2 + 1024 * jj + 16 * lane + 4 * q);
                    const int o = 16 * jj + 4 * q;
                    hv[o] = hv[o] * rstd * a.x + b.x; hv[o + 1] = hv[o + 1] * rstd * a.y + b.y; hv[o + 2] = hv[o + 2] * rstd * a.z + b.z; hv[o + 3] = hv[o + 3] * rstd * a.w + b.w;
                    am = fmaxf(am, fmaxf(fmaxf(fabsf(hv[o]), fabsf(hv[o + 1])), fmaxf(fabsf(hv[o + 2]), fabsf(hv[o + 3])))); }
            am = fmaxf(wave_max(am), 1e-30f); const float inv = 127.0f / am;
            if (lane == 0) SH[tl] = am * (1.0f / 127.0f);
#pragma unroll
            for (int jj = 0; jj < 2; ++jj) { v4u o;
#pragma unroll
                for (int q = 0; q < 4; ++q) { const int b = 16 * jj + 4 * q;
                    const int q0 = (int)__builtin_rintf(hv[b] * inv), q1 = (int)__builtin_rintf(hv[b + 1] * inv), q2 = (int)__builtin_rintf(hv[b + 2] * inv), q3 = (int)__builtin_rintf(hv[b + 3] * inv);
                    o[q] = (unsigned)(q0 & 255) | ((unsigned)(q1 & 255) << 8) | ((unsigned)(q2 & 255) << 16) | ((unsigned)(q3 & 255) << 24); }
                *(LAS v4u*)(HQ + tl * 2048 + 1024 * jj + 16 * lane) = o; }
        }
        __syncthreads();
#pragma unroll
        for (int i = 0; i < 16; ++i) { const int q = tid + 512 * i; IDX16[q] = (unsigned short)F.IDX[(size_t)tb * NSEL + q]; }
        __syncthreads();
        int P[8][2];
#pragma unroll
        for (int j = 0; j < 8; ++j) { P[j][0] = 0; P[j][1] = 0; }
#pragma unroll 1
        for (int s = 0; s < NSLICE_A; ++s) {
            const unsigned char* eb = F.ED + s * SLICE_B;
            const unsigned lo = (unsigned)(c8 * 16);
            v4u wA[8], wB[8];
#define P9A_LOAD(W, J, H) do { _Pragma("unroll") for (int i = 0; i < 8; ++i) { const unsigned e = IDX16[(F.wave * 8 + (J)) * 128 + 64 * (H) + 8 * i + g]; W[i] = *(const GAS v4u*)(eb + (e * 2048u + lo)); } } while (0)
#define P9A_COMP(W, J, H) do { const v4u hq = *(const LAS v4u*)(HQ + (F.wave * 8 + (J)) * 2048 + s * SLICE_B + c8 * 16); int a[8]; \
                _Pragma("unroll") for (int i = 0; i < 8; ++i) { int d = 0; const v4u ww = W[i]; \
                    d = __builtin_amdgcn_sdot4((int)hq.x, (int)ww.x, d, false); d = __builtin_amdgcn_sdot4((int)hq.y, (int)ww.y, d, false); d = __builtin_amdgcn_sdot4((int)hq.z, (int)ww.z, d, false); d = __builtin_amdgcn_sdot4((int)hq.w, (int)ww.w, d, false); a[i] = d; } \
                red_step_i<8, 4>(a, lane); red_step_i<4, 2>(a, lane); red_step_i<2, 1>(a, lane); P[J][H] += a[0]; asm volatile("" ::: "memory"); } while (0)
            P9A_LOAD(wA, 0, 0);
#pragma unroll
            for (int j = 0; j < 8; ++j) {
                P9A_LOAD(wB, j, 1);
                P9A_COMP(wA, j, 0);
                if (j < 7) P9A_LOAD(wA, j + 1, 0);
                P9A_COMP(wB, j, 1);
            }
#undef P9A_LOAD
#undef P9A_COMP
        }
        __syncthreads();
        LAS int* PI = (LAS int*)F.lds;
#pragma unroll
        for (int j = 0; j < 8; ++j) { const int tl = F.wave * 8 + j; PI[tl * 128 + 8 * c8 + g] = P[j][0]; PI[tl * 128 + 64 + 8 * c8 + g] = P[j][1]; }
#pragma unroll
        for (int i = 0; i < 4; ++i) { const int c = tid + 512 * i; GF[c] = F.MODF[MOD_GF + c]; FG[c] = F.final_g[c]; }
        LAS float* SSQL = (LAS float*)(F.lds + P9_SSQ);
#pragma unroll 1
        for (int j = 0; j < 8; ++j) { const int tl = F.wave * 8 + j, t = tb + tl; const float sh = SH[tl]; float sum = 0.f;
#pragma unroll
            for (int h = 0; h < 2; ++h) { const int k = 64 * h + lane; const unsigned e = IDX16[tl * 128 + k];
                const float act = (float)PI[tl * 128 + k] * (sh * F.SD[e]); const float cfv = F.PG[(size_t)t * NSEL + k] * gelu_f(act) * F.SU[e]; COEF[tl * 128 + k] = cfv; sum += cfv; }
            sum = 1152.0f * wave_sum(sum); if (lane == 0) CORR[tl] = sum;     SSQL[tl * 64 + lane] = 0.f; }
        __syncthreads();
        const int cb = c8 * 16 + ((lane >> 5) & 1) * 8 + ((lane >> 4) & 1) * 4 + ((lane >> 3) & 1) * 2;
#pragma unroll 1
        for (int s = 0; s < NSLICE_C; ++s) {
            const unsigned char* eb = F.EU + s * SLICE_B;
            const unsigned lo = (unsigned)(c8 * 16);
            v4u wA[8], wB[8]; float cA[8], cB[8];
#define P9C_LOAD(W, C, TL, H) do { _Pragma("unroll") for (int i = 0; i < 8; ++i) { const unsigned e = IDX16[(TL) * 128 + 64 * (H) + 8 * i + g]; C[i] = COEF[(TL) * 128 + 64 * (H) + 8 * i + g]; W[i] = *(const GAS v4u*)(eb + (e * 2048u + lo)); } } while (0)
#define P9C_ACC(W, C) do { _Pragma("unroll") for (int i = 0; i < 8; ++i) { unsigned ux = W[i].x, uy = W[i].y, uz = W[i].z, uw = W[i].w; const float cc = C[i]; \
                asm volatile("" : "+v"(ux), "+v"(uy), "+v"(uz), "+v"(uw));      \
                acc4(o[0], o[1], o[2], o[3], ux, cc); acc4(o[4], o[5], o[6], o[7], uy, cc); acc4(o[8], o[9], o[10], o[11], uz, cc); acc4(o[12], o[13], o[14], o[15], uw, cc); \
                asm volatile("" : "+v"(o[0]), "+v"(o[1]), "+v"(o[2]), "+v"(o[3]), "+v"(o[4]), "+v"(o[5]), "+v"(o[6]), "+v"(o[7]), "+v"(o[8]), "+v"(o[9]), "+v"(o[10]), "+v"(o[11]), "+v"(o[12]), "+v"(o[13]), "+v"(o[14]), "+v"(o[15])); } \
                asm volatile("" ::: "memory"); } while (0)
            P9C_LOAD(wA, cA, F.wave * 8, 0);
#pragma unroll 1
            for (int j = 0; j < 8; ++j) {
                const int tl = F.wave * 8 + j, t = tb + tl;
                float o[16];
#pragma unroll
                for (int b = 0; b < 16; ++b) o[b] = 0.f;
                P9C_LOAD(wB, cB, tl, 1);
                P9C_ACC(wA, cA);
                if (j < 7) P9C_LOAD(wA, cA, tl + 1, 0);
                P9C_ACC(wB, cB);
                red_step_f<16, 32>(o, lane); red_step_f<8, 16>(o, lane); red_step_f<4, 8>(o, lane);
                const int col = s * SLICE_B + cb; const float corr = CORR[tl];
                float* xp = F.out + (size_t)t * D + col;
                typedef float f32x2 __attribute__((ext_vector_type(2)));
                const unsigned xw = *(const GAS unsigned*)(F.X1B + (size_t)t * D + col);
                const float y0 = bflo(xw) + GF[col] * (o[0] - corr), y1 = bfhi(xw) + GF[col + 1] * (o[1] - corr);
                SSQL[tl * 64 + lane] += y0 * y0 + y1 * y1;
                *(GAS f32x2*)xp = (f32x2){y0, y1};
            }
#undef P9C_LOAD
#undef P9C_ACC
        }
#pragma unroll 1
        for (int j = 0; j < 8; ++j) {
            const int tl = F.wave * 8 + j, t = tb + tl;
            const float rstd2 = 1.0f / sqrtf(wave_sum(SSQL[tl * 64 + lane]) * (1.0f / D) + EPS);
            GAS f32x4* orow = (GAS f32x4*)(F.out + (size_t)t * D) + lane;
#pragma unroll
            for (int q = 0; q < 8; ++q) { const f32x4 v = orow[64 * q]; const f32x4 f = *(const LAS f32x4*)(FG + 256 * q + 4 * lane); orow[64 * q] = v * rstd2 * f; }
        }
        __syncthreads();
    }
}
struct Args { const float* in[21]; float* out; unsigned char* ws; int ph_lo, ph_hi, li, pad; };
constexpr int N_PHASES = 10;
__global__ void __launch_bounds__(NWAVES * 64, 2) mk_fwd(Args args) {
    extern __shared__ __attribute__((aligned(16))) unsigned char lds[];
    Frame F;
    F.lds = (LAS unsigned char*)lds;
    F.MISC = (volatile LAS unsigned*)(F.lds + MISC_OFF);
    F.tid = threadIdx.x; F.lane = F.tid & 63; F.wave = __builtin_amdgcn_readfirstlane(F.tid >> 6);
    F.G = gridDim.x; { const int bx = blockIdx.x; F.vcu = (F.G % 8 == 0) ? (bx % 8) * (F.G / 8) + bx / 8 : bx; }
    unsigned char* ws = args.ws;
    F.ctl = (gu32*)(ws + WS_CTL);
    F.x = args.in[0]; F.c = args.in[1]; F.ada_w = args.in[2]; F.ada_b = args.in[3]; F.norm_mix_g = args.in[4]; F.w_in = args.in[5]; F.b_gates = args.in[6];
    F.conv_w = args.in[7]; F.conv_b = args.in[8]; F.gmlp_norm_g = args.in[9]; F.gmlp_w = args.in[10]; F.gmlp_b = args.in[11]; F.mlstm_norm_g = args.in[12];
    F.w_out = args.in[13]; F.norm_ffn_g = args.in[14]; F.wq = args.in[15]; F.keys1 = args.in[16]; F.keys2 = args.in[17]; F.e_down = args.in[18]; F.e_up = args.in[19]; F.final_g = args.in[20];
    F.out = args.out;
    F.MODP = (float*)(ws + WS_MODP); F.MODF = (float*)(ws + WS_MODF); F.GATES = (float*)(ws + WS_GATES); F.SUMM = (float*)(ws + WS_SUMM); F.MTAB = (float*)(ws + WS_MTAB);
    F.NST = (float*)(ws + WS_NST); F.PG = (float*)(ws + WS_PG); F.IDX = (int*)(ws + WS_IDX);
    F.WIN = (bf16*)(ws + WS_WIN); F.WOUT = (bf16*)(ws + WS_WOUT); F.WQ = (bf16*)(ws + WS_WQ); F.HA = (bf16*)(ws + WS_HA); F.PROJ = (bf16*)(ws + WS_PROJ); F.QB = (bf16*)(ws + WS_PROJ);
    F.STATE = (bf16*)(ws + WS_STATE); F.ED = ws + WS_ED; F.EU = ws + WS_EU; F.SD = (float*)(ws + WS_SD); F.SU = (float*)(ws + WS_SU);
    F.SSQP = (float*)(ws + WS_SSQP); F.BQP = (float*)(ws + WS_BQP); F.BIASQ = (float*)(ws + WS_BIASQ); F.X1B = (bf16*)(ws + WS_STATE);
    F.QC = (bf16*)args.out; F.KC = (bf16*)args.out + (size_t)M * 1024;
    for (int u = F.tid; u < (LDS_BYTES - LDSCTL_OFF) / 4; u += NWAVES * 64) ((LAS unsigned*)(F.lds + LDSCTL_OFF))[u] = 0u;
    __syncthreads();
    const int lo = args.ph_lo, hi = args.ph_hi;
    const bool multi = (hi - lo) > 1;
    XcdBarrier bar; bar.bar = (unsigned*)(F.ctl + CW_BAR) + args.li * XCD_BAR_WORDS; bar.x = 0; bar.st = nullptr;
    if (multi) bar = xcd_barrier_post((unsigned*)(F.ctl + CW_BAR) + args.li * XCD_BAR_WORDS, F.MISC + 8);
#ifndef PH_MASK
#define PH_MASK 0x7ff
#endif
#define IN(k) (((PH_MASK >> (k)) & 1) && lo <= (k) && (k) < hi)
#define SEAM(k) do { if (IN(k) && IN((k) + 1)) xcd_barrier(bar); } while (0)
    if (IN(0)) { p0a_phase(F); } SEAM(0);
    if (IN(1)) { p0b_phase(F); } SEAM(1);
    if (IN(2)) {
        pg8::Gemm g{F.HA, F.WIN, M, NPROJ, D}; pg8::StaticOrder S; S.init(M, NPROJ, F.G, (int)blockIdx.x);
        pg8::EpiProj E{F.PROJ, NPROJ, 2048 / 256};
        pg8::gemm_phase<pg8::EpiProj, pg8::StaticOrder, PG8_ALIGN, PG8_SP2>(F.lds, g, S, E);
    } SEAM(2);
    if (IN(3)) { p2_phase(F); } SEAM(3);
    if (IN(4)) { p3_phase(F); } SEAM(4);
    if (IN(5)) { p4_phase(F); } SEAM(5);
    if (IN(6)) {
        pg8::Gemm g{F.HA, F.WOUT, M, D, D}; pg8::StaticOrder S; S.init(M, D, F.G, (int)blockIdx.x);
        pg8::EpiResid2 E{F.x, F.MODF + MOD_GM, F.X1B, F.SSQP, D};
        pg8::gemm_phase<pg8::EpiResid2, pg8::StaticOrder, PG8_ALIGN, PG8_SP2>(F.lds, g, S, E);
    } SEAM(6);
    if (IN(7)) {
        pg8::Gemm g{F.X1B, F.WQ, M, D, D}; pg8::StaticOrder S; S.init(M, D, F.G, (int)blockIdx.x);
        LAS float* RSTDL = (LAS float*)(F.lds + RING_BYTES);
        { pg8::Unit u; for (int i = 0; S.next(i, u); ++i) { if (F.tid < 256) { const float* sp = F.SSQP + (size_t)(u.pm * 256 + F.tid) * 32; float ss = 0.f;
#pragma unroll
                    for (int q = 0; q < 8; ++q) { const f32x4 v = *(const GAS f32x4*)(sp + 4 * q); ss += (v.x + v.y) + (v.z + v.w); }
                    RSTDL[(u.pm & 1) * 256 + F.tid] = 1.0f / sqrtf(ss * (1.0f / D) + EPS); } } }
        __syncthreads();
        pg8::EpiQ E{F.QB, D, F.BIASQ, RSTDL};
        pg8::gemm_phase<pg8::EpiQ, pg8::StaticOrder, PG8_ALIGN, PG8_SP2>(F.lds, g, S, E);
    } SEAM(7);
#ifndef P8_ALT
#define P8_ALT 0
#endif
    if (IN(8)) { p8_phase(F); } SEAM(8);
#ifndef P9_V2
#define P9_V2 1
#endif
    if (IN(9)) { p9v2_phase(F); }
#undef IN
#undef SEAM
}

#ifndef MK_N_LAUNCHES
#define MK_N_LAUNCHES 1
#endif
extern "C" void kernel_launch(void* const* d_in, const int* in_sizes, int n_in, void* d_out, int out_size, void* d_ws, size_t ws_size, hipStream_t stream) {
    static int grid = 0;
    if (grid == 0) {
        if (n_in != 21 || in_sizes[0] != M * D || out_size != M * D || ws_size < WS_END) { fprintf(stderr, "kernel_launch: unexpected shapes (n_in %d, in0 %d, out %d, ws %zu); nothing launched\n", n_in, n_in > 0 ? in_sizes[0] : -1, out_size, ws_size); grid = -1; return; }
        int dev = 0, cus = 0, per_cu = 0;
        if (hipGetDevice(&dev) != hipSuccess || hipDeviceGetAttribute(&cus, hipDeviceAttributeMultiprocessorCount, dev) != hipSuccess) { grid = -1; return; }
        if (hipFuncSetAttribute((const void*)mk_fwd, hipFuncAttributeMaxDynamicSharedMemorySize, LDS_BYTES) != hipSuccess) { fprintf(stderr, "kernel_launch: hipFuncSetAttribute failed\n"); grid = -1; return; }
        if (hipOccupancyMaxActiveBlocksPerMultiprocessor(&per_cu, (const void*)mk_fwd, NWAVES * 64, LDS_BYTES) != hipSuccess || per_cu < 1) { fprintf(stderr, "kernel_launch: occupancy query says %d blocks per CU\n", per_cu); }
        (void)hipGetLastError();
        grid = cus;
    }
    if (grid < 0) return;
    (void)hipMemsetAsync((char*)d_ws + WS_CTL, 0, CTL_ZERO_BYTES, stream);
    Args a{};
    for (int i = 0; i < 21; ++i) a.in[i] = (const float*)d_in[i];
    a.out = (float*)d_out; a.ws = (unsigned char*)d_ws;
    if (MK_N_LAUNCHES == 1) { a.ph_lo = 0; a.ph_hi = N_PHASES; a.li = 0; hipLaunchKernelGGL(mk_fwd, dim3(grid), dim3(NWAVES * 64), LDS_BYTES, stream, a); }
    else for (int li = 0; li < N_PHASES; ++li) { a.ph_lo = li; a.ph_hi = li + 1; a.li = 0; hipLaunchKernelGGL(mk_fwd, dim3(grid), dim3(NWAVES * 64), LDS_BYTES, stream, a); }
}
```

```cpp
#include <hip/hip_runtime.h>
#include <cstdio>
#include <cstdint>
namespace pg8 {
#define PG8_LAS __attribute__((address_space(3)))
typedef unsigned short bf16_t;
typedef short bf16x8 __attribute__((ext_vector_type(8)));
typedef float f32x4 __attribute__((ext_vector_type(4)));
typedef unsigned u32x4 __attribute__((ext_vector_type(4)));
constexpr int BM = 256, BK = 64, HALF = 128, HTB = HALF * BK * 2  , STAGE_BYTES = 8 * HTB, NXCD = 8, WGM = 8;

__host__ __device__ __forceinline__ int lds_byte(int r, int c) { const int st = (r >> 4) * 2 + (c >> 5), rr = r & 15, cc = c & 31, ob = rr * 64 + cc * 2; return st * 1024 + (ob ^ (((ob >> 9) & 1) << 5)); }
__host__ __device__ __forceinline__ void stage_rc(int b, int& R, int& C) { const int st = b / 1024, sb = b % 1024, swz = sb ^ (((sb >> 9) & 1) << 5); R = (st >> 1) * 16 + swz / 64; C = (st & 1) * 32 + (swz % 64) / 2; }
__host__ __device__ __forceinline__ int perm32(int rho) { const int n = rho >> 4, i = rho & 15; return 8 * (i >> 2) + 4 * n + (i & 3); }

struct Unit { int pm, pn; };
struct Gemm { const bf16_t* A; const bf16_t* Bt; int M, N, K; };

struct StaticOrder {
    int nM, nN, nwg, G, c;
    __host__ __device__ void init(int M, int N, int G_, int c_) { nM = M / BM; nN = N / BM; nwg = nM * nN; G = G_; c = c_; }
    __host__ __device__ bool next(int i, Unit& u) const {
        const long L = (long)i * G + c; if (L >= nwg) return false;
        int wgid = (int)L; { const int q = nwg / NXCD, r = nwg % NXCD, xcd = wgid % NXCD, off = wgid / NXCD; wgid = (xcd < r ? xcd * (q + 1) : r * (q + 1) + (xcd - r) * q) + off; }
        const int nig = WGM * nN, gid = wgid / nig, fm = gid * WGM, gsz = (nM - fm) < WGM ? (nM - fm) : WGM;
        u.pm = fm + ((wgid % nig) % gsz); u.pn = (wgid % nig) / gsz; return true;
    }
    __device__ __forceinline__ void a_ready(const Unit&) const {}
    __device__ __forceinline__ void done(const Unit&) const {}
};

__device__ __forceinline__ unsigned cvt_pk_bf16(float lo, float hi) { unsigned r; asm volatile("v_cvt_pk_bf16_f32 %0, %1, %2" : "=v"(r) : "v"(lo), "v"(hi)); return r; }
typedef float f32x2 __attribute__((ext_vector_type(2)));
__device__ __forceinline__ f32x2 gelu_pk(f32x2 v) {
    const f32x2 av = __builtin_elementwise_abs(v), d = av * 0.2316418882f + 1.0f;
    f32x2 t; t.x = __builtin_amdgcn_rcpf(d.x); t.y = __builtin_amdgcn_rcpf(d.y);
    f32x2 q = t * 0.5307027145f + (-0.7265760135f); q = q * t + 0.7107068705f; q = q * t + (-0.142248368f); q = q * t + 0.127414796f; q = q * t;
    const f32x2 s = (v * v) * (-0.72134752044f);
    f32x2 e; e.x = __builtin_amdgcn_exp2f(s.x); e.y = __builtin_amdgcn_exp2f(s.y);
    const f32x2 m = v * (q * e), r = v - m;
    f32x2 o; o.x = v.x < 0.f ? m.x : r.x; o.y = v.y < 0.f ? m.y : r.y; return o;
}

template <int ACT  > struct EpiBf16 {
    static constexpr bool PERM = true, AFTER_DRAIN = false; static_assert(ACT == 0 || ACT == 1, "EpiBf16: ACT is 0 (none) or 1 (gelu_pk)");
    bf16_t* O; int ldc; const float* bias; int split_cols; size_t split_stride; float scale0;
    __device__ __forceinline__ void operator()(const f32x4 (&acc)[2][2][4][2], const Unit& u, int wr, int wc, int fr, int fq) const {
        const int row0 = u.pm * BM + wr * 64 + fr; int colt = u.pn * BM; bf16_t* base = O;
        float sc = 1.f; if (split_cols) { const int t = colt / split_cols; base += (size_t)t * split_stride; colt -= t * split_cols; if (t == 0) sc = scale0; }
        const int col0 = colt + wc * 32 + 8 * fq, bcol0 = u.pn * BM + wc * 32 + 8 * fq;
        f32x4 bv[2][2];
#pragma unroll
        for (int bj = 0; bj < 2; ++bj)
#pragma unroll
            for (int n = 0; n < 2; ++n) bv[bj][n] = bias ? *(const f32x4*)(bias + bcol0 + bj * HALF + 4 * n) : (f32x4){0.f, 0.f, 0.f, 0.f};
#pragma unroll
        for (int ai = 0; ai < 2; ++ai)
#pragma unroll
            for (int m = 0; m < 4; ++m) { bf16_t* rowp = base + (size_t)(row0 + ai * HALF + m * 16) * ldc + col0;
#pragma unroll
                for (int bj = 0; bj < 2; ++bj) { f32x4 v0 = acc[ai][bj][m][0] + bv[bj][0], v1 = acc[ai][bj][m][1] + bv[bj][1];
                    if (ACT == 1) { f32x2 a = gelu_pk((f32x2){v0[0], v0[1]}), b = gelu_pk((f32x2){v0[2], v0[3]}), c = gelu_pk((f32x2){v1[0], v1[1]}), d = gelu_pk((f32x2){v1[2], v1[3]});
                        v0 = (f32x4){a.x, a.y, b.x, b.y}; v1 = (f32x4){c.x, c.y, d.x, d.y}; }
                    v0 = v0 * sc; v1 = v1 * sc; u32x4 w; w.x = cvt_pk_bf16(v0[0], v0[1]); w.y = cvt_pk_bf16(v0[2], v0[3]); w.z = cvt_pk_bf16(v1[0], v1[1]); w.w = cvt_pk_bf16(v1[2], v1[3]);
                    *(u32x4*)(rowp + bj * HALF) = w; } }
    }
};

template <class Epi, class Sched, bool ALIGN_EPI = false, bool SP2 = false>
__device__ __forceinline__ void gemm_phase(PG8_LAS unsigned char* lds, const Gemm g, const Sched& S, const Epi& E) {
    const int tid = threadIdx.x, wid = __builtin_amdgcn_readfirstlane(tid >> 6), lane = tid & 63, wr = wid >> 2, wc = wid & 3, fr = lane & 15, fq = lane >> 4;
    const int K = g.K, nt = K / BK;
    unsigned voffA[2], voffB[2];
#pragma unroll
    for (int i = 0; i < 2; ++i) { int R, C; stage_rc(tid * 16 + i * 8192, R, C); const int Rb = Epi::PERM ? ((R & ~31) + perm32(R & 31)) : R;
        voffA[i] = (unsigned)(R * K + C) * 2u; voffB[i] = (unsigned)(Rb * K + C) * 2u; }
    const size_t kstep = (size_t)(BK * 2);
    const size_t hstep = (size_t)HALF * K * 2;
    const size_t tstep = 2 * hstep;
    const unsigned ldsw = (unsigned)wid * 1024u;
    const int aoff = lds_byte(wr * 64 + fr, fq * 8), boff = lds_byte(wc * 32 + fr, fq * 8);
#define PG8_SA(b, h) (((b) * 2 + (h)) * HTB)
#define PG8_SB(b, h) ((4 + (b) * 2 + (h)) * HTB)
#define PG8_STAGE(bufoff, gbase, voff) do { _Pragma("unroll") for (int _i = 0; _i < 2; ++_i) \
        __builtin_amdgcn_global_load_lds((const unsigned*)((const char*)(gbase) + (voff)[_i]), (PG8_LAS unsigned*)(lds + (bufoff) + ldsw + _i * 8192), 16, 0, 0); } while (0)
#define PG8_LDA(dst, b, h) do { _Pragma("unroll") for (int m = 0; m < 4; ++m) _Pragma("unroll") for (int k = 0; k < 2; ++k) dst[m][k] = *(const PG8_LAS bf16x8*)(lds + PG8_SA(b, h) + aoff + m * 2048 + k * 1024); } while (0)
#define PG8_LDB(dst, b, h) do { _Pragma("unroll") for (int n = 0; n < 2; ++n) _Pragma("unroll") for (int k = 0; k < 2; ++k) dst[n][k] = *(const PG8_LAS bf16x8*)(lds + PG8_SB(b, h) + boff + n * 2048 + k * 1024); } while (0)
#define PG8_MMA(ai, bj, At, Bt) do { __builtin_amdgcn_s_setprio(1); _Pragma("unroll") for (int m = 0; m < 4; ++m) _Pragma("unroll") for (int n = 0; n < 2; ++n) _Pragma("unroll") for (int k = 0; k < 2; ++k) \
        acc[ai][bj][m][n] = __builtin_amdgcn_mfma_f32_16x16x32_bf16(Bt[n][k], At[m][k], acc[ai][bj][m][n], 0, 0, 0); __builtin_amdgcn_s_setprio(0); } while (0)
#define PG8_WAIT_V(n) asm volatile("s_waitcnt vmcnt(" #n ")" ::: "memory")
#define PG8_WAIT_L(n) asm volatile("s_waitcnt lgkmcnt(" #n ")" ::: "memory")
#define PG8_BAR __builtin_amdgcn_s_barrier()
#define PG8_SCHED __builtin_amdgcn_sched_barrier(0)
    Unit cur, nxt; int ui = 0;
    if (!S.next(0, cur)) return;
    f32x4 acc[2][2][4][2];
#pragma unroll
    for (int a = 0; a < 2; ++a)
#pragma unroll
        for (int b = 0; b < 2; ++b)
#pragma unroll
            for (int m = 0; m < 4; ++m)
#pragma unroll
                for (int n = 0; n < 2; ++n) acc[a][b][m][n] = (f32x4){0.f, 0.f, 0.f, 0.f};
    bf16x8 At[4][2], B0[2][2], B1[2][2];
    const char* cA = (const char*)g.A + (size_t)cur.pm * tstep; const char* cB = (const char*)g.Bt + (size_t)cur.pn * tstep;
    S.a_ready(cur);
    if constexpr (SP2) {
        PG8_STAGE(PG8_SB(0, 0), cB, voffB); PG8_STAGE(PG8_SB(0, 1), cB + hstep, voffB); PG8_STAGE(PG8_SA(0, 0), cA, voffA); PG8_STAGE(PG8_SA(0, 1), cA + hstep, voffA);
        if (wr == 1) PG8_BAR;
        PG8_WAIT_V(2); PG8_BAR;
        PG8_STAGE(PG8_SB(1, 0), cB + kstep, voffB); PG8_STAGE(PG8_SA(1, 0), cA + kstep, voffA); PG8_STAGE(PG8_SB(1, 1), cB + hstep + kstep, voffB);
        PG8_WAIT_V(6); PG8_BAR;
    } else {
        PG8_STAGE(PG8_SB(0, 0), cB, voffB); PG8_STAGE(PG8_SA(0, 0), cA, voffA); PG8_STAGE(PG8_SB(0, 1), cB + hstep, voffB); PG8_STAGE(PG8_SA(0, 1), cA + hstep, voffA);
        if (wr == 1) PG8_BAR;
        PG8_WAIT_V(4); PG8_BAR;
        PG8_STAGE(PG8_SB(1, 0), cB + kstep, voffB); PG8_STAGE(PG8_SA(1, 0), cA + kstep, voffA); PG8_STAGE(PG8_SB(1, 1), cB + hstep + kstep, voffB);
        PG8_WAIT_V(6); PG8_BAR;
    }
    for (;;) {
        const bool has_next = S.next(ui + 1, nxt);
        const char* nA = has_next ? (const char*)g.A + (size_t)nxt.pm * tstep : cA; const char* nB = has_next ? (const char*)g.Bt + (size_t)nxt.pn * tstep : cB;
        for (int t = 0; t < nt; t += 2) {
            const bool last = (t == nt - 2);
            const char* a1 = cA + (size_t)(t + 1) * kstep;
            const char* a2 = last ? nA : cA + (size_t)(t + 2) * kstep; const char* b2 = last ? nB : cB + (size_t)(t + 2) * kstep;
            const char* a3 = a2 + kstep; const char* b3 = b2 + kstep;
            if (last && has_next) S.a_ready(nxt);
            if constexpr (SP2) {
            PG8_LDB(B0, 0, 0); PG8_LDB(B1, 0, 1); PG8_SCHED; PG8_LDA(At, 0, 0); PG8_STAGE(PG8_SA(1, 1), a1 + hstep, voffA);
            PG8_WAIT_V(8); PG8_WAIT_L(0); PG8_BAR; PG8_MMA(0, 0, At, B0); PG8_MMA(0, 1, At, B1); PG8_BAR; PG8_SCHED;
            PG8_LDA(At, 0, 1); PG8_STAGE(PG8_SB(0, 0), b2, voffB); PG8_STAGE(PG8_SB(0, 1), b2 + hstep, voffB); PG8_STAGE(PG8_SA(0, 0), a2, voffA);
            PG8_WAIT_V(8); PG8_WAIT_L(0); PG8_BAR; PG8_MMA(1, 0, At, B0); PG8_MMA(1, 1, At, B1); PG8_BAR; PG8_SCHED;
            PG8_LDB(B0, 1, 0); PG8_LDB(B1, 1, 1); PG8_SCHED; PG8_LDA(At, 1, 0); PG8_STAGE(PG8_SA(0, 1), a2 + hstep, voffA);
            PG8_WAIT_V(8); PG8_WAIT_L(0); PG8_BAR; PG8_MMA(0, 0, At, B0); PG8_MMA(0, 1, At, B1); PG8_BAR; PG8_SCHED;
            PG8_LDA(At, 1, 1); PG8_STAGE(PG8_SB(1, 0), b3, voffB); PG8_STAGE(PG8_SB(1, 1), b3 + hstep, voffB); PG8_STAGE(PG8_SA(1, 0), a3, voffA);
            PG8_WAIT_V(8); PG8_WAIT_L(0); PG8_BAR; PG8_MMA(1, 0, At, B0); PG8_MMA(1, 1, At, B1); PG8_BAR; PG8_SCHED;
            } else {
            PG8_LDB(B0, 0, 0); PG8_SCHED; PG8_LDA(At, 0, 0); PG8_STAGE(PG8_SA(1, 1), a1 + hstep, voffA);
            PG8_WAIT_L(8); PG8_BAR; PG8_WAIT_L(0); PG8_MMA(0, 0, At, B0); PG8_BAR; PG8_SCHED;
            PG8_LDB(B1, 0, 1); PG8_STAGE(PG8_SB(0, 0), b2, voffB);
            PG8_BAR; PG8_WAIT_L(0); PG8_MMA(0, 1, At, B1); PG8_BAR;
            PG8_LDA(At, 0, 1); PG8_STAGE(PG8_SA(0, 0), a2, voffA);
            PG8_BAR; PG8_WAIT_L(0); PG8_MMA(1, 0, At, B0); PG8_BAR; PG8_SCHED;
            PG8_STAGE(PG8_SB(0, 1), b2 + hstep, voffB);
            PG8_WAIT_V(6); PG8_BAR; PG8_MMA(1, 1, At, B1); PG8_BAR;
            PG8_LDB(B0, 1, 0); PG8_SCHED; PG8_LDA(At, 1, 0); PG8_STAGE(PG8_SA(0, 1), a2 + hstep, voffA);
            PG8_WAIT_L(8); PG8_BAR; PG8_WAIT_L(0); PG8_MMA(0, 0, At, B0); PG8_BAR; PG8_SCHED;
            PG8_LDB(B1, 1, 1); PG8_STAGE(PG8_SB(1, 0), b3, voffB);
            PG8_BAR; PG8_WAIT_L(0); PG8_MMA(0, 1, At, B1); PG8_BAR;
            PG8_LDA(At, 1, 1); PG8_STAGE(PG8_SA(1, 0), a3, voffA);
            PG8_BAR; PG8_WAIT_L(0); PG8_MMA(1, 0, At, B0); PG8_BAR; PG8_SCHED;
            PG8_STAGE(PG8_SB(1, 1), b3 + hstep, voffB);
            PG8_WAIT_V(6); PG8_BAR; PG8_MMA(1, 1, At, B1); PG8_BAR;
            }
        }
        if constexpr (ALIGN_EPI) { if (wr == 0) PG8_BAR; }
        if constexpr (!Epi::AFTER_DRAIN) { E(acc, cur, wr, wc, fr, fq); S.done(cur); }
        if (!has_next) break;
#pragma unroll
        for (int a = 0; a < 2; ++a)
#pragma unroll
            for (int b = 0; b < 2; ++b)
#pragma unroll
                for (int m = 0; m < 4; ++m)
#pragma unroll
                    for (int n = 0; n < 2; ++n) acc[a][b][m][n] = (f32x4){0.f, 0.f, 0.f, 0.f};
        cur = nxt; cA = nA; cB = nB; ++ui;
        if constexpr (ALIGN_EPI) { if (wr == 1) PG8_BAR; }
    }
    PG8_WAIT_V(0);
    if constexpr (!ALIGN_EPI) { if (wr == 0) PG8_BAR; }
    PG8_BAR;
    if constexpr (Epi::AFTER_DRAIN) { E.fused(acc, cur, wr, wc, fr, fq, lds, wid, lane); S.done(cur); }
#undef PG8_SA
#undef PG8_SB
#undef PG8_STAGE
#undef PG8_LDA
#undef PG8_LDB
#undef PG8_MMA
#undef PG8_WAIT_V
#undef PG8_WAIT_L
#undef PG8_BAR
#undef PG8_SCHED
}
}
namespace pg8 {
struct EpiProj {
    static constexpr bool PERM = true, AFTER_DRAIN = false;
    bf16_t* O; int ldc; int gelu_tiles;
    __device__ __forceinline__ void operator()(const f32x4 (&acc)[2][2][4][2], const Unit& u, int wr, int wc, int fr, int fq) const {
        const int row0 = u.pm * BM + wr * 64 + fr; const int col0 = u.pn * BM + wc * 32 + 8 * fq;
        const bool act = u.pn < gelu_tiles;
#pragma unroll
        for (int ai = 0; ai < 2; ++ai)
#pragma unroll
            for (int m = 0; m < 4; ++m) { bf16_t* rowp = O + (size_t)(row0 + ai * HALF + m * 16) * ldc + col0;
#pragma unroll
                for (int bj = 0; bj < 2; ++bj) { f32x4 v0 = acc[ai][bj][m][0], v1 = acc[ai][bj][m][1];
                    if (act) { f32x2 a = gelu_pk((f32x2){v0[0], v0[1]}), b = gelu_pk((f32x2){v0[2], v0[3]}), c = gelu_pk((f32x2){v1[0], v1[1]}), d = gelu_pk((f32x2){v1[2], v1[3]});
                        v0 = (f32x4){a.x, a.y, b.x, b.y}; v1 = (f32x4){c.x, c.y, d.x, d.y}; }
                    u32x4 w; w.x = cvt_pk_bf16(v0[0], v0[1]); w.y = cvt_pk_bf16(v0[2], v0[3]); w.z = cvt_pk_bf16(v1[0], v1[1]); w.w = cvt_pk_bf16(v1[2], v1[3]);
                    *(u32x4*)(rowp + bj * HALF) = w; } }
    }
};
struct EpiResid {
    static constexpr bool PERM = false, AFTER_DRAIN = false;
    const float* base; const float* gate; float* out; int ldc;
    __device__ __forceinline__ void operator()(const f32x4 (&acc)[2][2][4][2], const Unit& u, int wr, int wc, int fr, int fq) const {
        const int row0 = u.pm * BM + wr * 64 + fr, col0 = u.pn * BM + wc * 32 + 4 * fq;
        f32x4 gv[2][2];
#pragma unroll
        for (int bj = 0; bj < 2; ++bj)
#pragma unroll
            for (int n = 0; n < 2; ++n) gv[bj][n] = *(const f32x4*)(gate + col0 + bj * HALF + n * 16);
#pragma unroll
        for (int ai = 0; ai < 2; ++ai)
#pragma unroll
            for (int m = 0; m < 4; ++m) { const size_t off = (size_t)(row0 + ai * HALF + m * 16) * ldc + col0;
#pragma unroll
                for (int bj = 0; bj < 2; ++bj)
#pragma unroll
                    for (int n = 0; n < 2; ++n) { const f32x4 b = *(const f32x4*)(base + off + bj * HALF + n * 16); *(f32x4*)(out + off + bj * HALF + n * 16) = b + gv[bj][n] * acc[ai][bj][m][n]; } }
    }
};
struct EpiResid2 {
    static constexpr bool PERM = true, AFTER_DRAIN = false;
    const float* base; const float* gate; bf16_t* xb; float* ssq; int ldc;
    __device__ __forceinline__ void operator()(const f32x4 (&acc)[2][2][4][2], const Unit& u, int wr, int wc, int fr, int fq) const {
        const int row0 = u.pm * BM + wr * 64 + fr, col0 = u.pn * BM + wc * 32 + 8 * fq;
        f32x4 gv[2][2];
#pragma unroll
        for (int bj = 0; bj < 2; ++bj)
#pragma unroll
            for (int n = 0; n < 2; ++n) gv[bj][n] = *(const f32x4*)(gate + col0 + bj * HALF + 4 * n);
#pragma unroll
        for (int ai = 0; ai < 2; ++ai)
#pragma unroll
            for (int m = 0; m < 4; ++m) { const int row = row0 + ai * HALF + m * 16; const size_t off = (size_t)row * ldc + col0; float ss = 0.f;
#pragma unroll
                for (int bj = 0; bj < 2; ++bj) {
                    const f32x4 b0 = *(const f32x4*)(base + off + bj * HALF), b1 = *(const f32x4*)(base + off + bj * HALF + 4);
                    const f32x4 v0 = b0 + gv[bj][0] * acc[ai][bj][m][0], v1 = b1 + gv[bj][1] * acc[ai][bj][m][1];
                    ss += (v0[0] * v0[0] + v0[1] * v0[1]) + (v0[2] * v0[2] + v0[3] * v0[3]) + (v1[0] * v1[0] + v1[1] * v1[1]) + (v1[2] * v1[2] + v1[3] * v1[3]);
                    u32x4 w; w.x = cvt_pk_bf16(v0[0], v0[1]); w.y = cvt_pk_bf16(v0[2], v0[3]); w.z = cvt_pk_bf16(v1[0], v1[1]); w.w = cvt_pk_bf16(v1[2], v1[3]);
                    *(u32x4*)(xb + off + bj * HALF) = w; }
                ss += __shfl_xor(ss, 16); ss += __shfl_xor(ss, 32);
                if (fq == 0) ssq[(size_t)row * 32 + u.pn * 4 + wc] = ss; }
    }
};
struct EpiQ {
    static constexpr bool PERM = true, AFTER_DRAIN = false;
    bf16_t* O; int ldc; const float* bias; const PG8_LAS float* rstd;
    __device__ __forceinline__ void operator()(const f32x4 (&acc)[2][2][4][2], const Unit& u, int wr, int wc, int fr, int fq) const {
        const int lrow0 = wr * 64 + fr, col0 = u.pn * BM + wc * 32 + 8 * fq;
        f32x4 bv[2][2];
#pragma unroll
        for (int bj = 0; bj < 2; ++bj)
#pragma unroll
            for (int n = 0; n < 2; ++n) bv[bj][n] = *(const f32x4*)(bias + col0 + bj * HALF + 4 * n);
#pragma unroll
        for (int ai = 0; ai < 2; ++ai)
#pragma unroll
            for (int m = 0; m < 4; ++m) { const int lrow = lrow0 + ai * HALF + m * 16; const float rs = rstd[(u.pm & 1) * BM + lrow];
                bf16_t* rowp = O + (size_t)(u.pm * BM + lrow) * ldc + col0;
#pragma unroll
                for (int bj = 0; bj < 2; ++bj) { const f32x4 v0 = acc[ai][bj][m][0] * rs + bv[bj][0], v1 = acc[ai][bj][m][1] * rs + bv[bj][1];
                    u32x4 w; w.x = cvt_pk_bf16(v0[0], v0[1]); w.y = cvt_pk_bf16(v0[2], v0[3]); w.z = cvt_pk_bf16(v1[0], v1[1]); w.w = cvt_pk_bf16(v1[2], v1[3]);
                    *(u32x4*)(rowp + bj * HALF) = w; } }
    }
};
}
#ifndef PG8_SP2
#define PG8_SP2 true
#endif
#ifndef PG8_ALIGN
#define PG8_ALIGN true
#endif
constexpr int NWAVES = 8;
constexpr int M = 16384, D = 2048;
constexpr int IN_COLS = 6152, NWIN = 6144, NPROJ = 5120;
constexpr int C_UG = 0, C_VG = 1024, C_Q = 2048, C_K = 3072, C_OM = 4096;
constexpr int WROW_VM = 5120;
constexpr int NHEAD = 4, DH = 256, CH = 128, NCHUNK = M / CH;
constexpr int NEXP = 16384, PH = 8, TOPK = 16, NSEL = PH * TOPK;
constexpr float EPS = 1e-6f;
constexpr int MOD_SHM = 0, MOD_SCM = 2048, MOD_GM = 4096, MOD_SHF = 6144, MOD_SCF = 8192, MOD_GF = 10240, NMOD = 12288;
constexpr int ADA_KC = 16, ADA_KROWS = D / ADA_KC;

constexpr size_t MiB = 1u << 20;
constexpr size_t WS_CTL = 0, CTL_ZERO_BYTES = 1 * MiB;
constexpr size_t WS_MODP = 1 * MiB;
constexpr size_t WS_MODF = WS_MODP + (size_t)ADA_KC * NMOD * 4;
constexpr size_t WS_GATES = 2 * MiB;
constexpr size_t WS_SUMM = 2 * MiB + 512 * 1024;
constexpr size_t WS_MTAB = WS_SUMM + 8192;
constexpr size_t WS_NST = 3 * MiB;
constexpr size_t WS_WIN = 4 * MiB;
constexpr size_t WS_WOUT = 28 * MiB;
constexpr size_t WS_WQ = 36 * MiB;
constexpr size_t WS_IDX = 44 * MiB;
constexpr size_t WS_PG = 52 * MiB;
constexpr size_t WS_SSQP = 60 * MiB;
constexpr size_t WS_BQP = 62 * MiB, WS_BIASQ = 62 * MiB + 512 * 1024;
constexpr size_t WS_HA = 64 * MiB;
constexpr size_t WS_PROJ = 128 * MiB;
constexpr size_t WS_VT = 288 * MiB;
constexpr size_t WS_X1 = 192 * MiB;
constexpr size_t WS_STATE = 320 * MiB;
constexpr size_t WS_ED = 384 * MiB, WS_EU = 416 * MiB;
constexpr size_t WS_SD = 3 * MiB + 512 * 1024, WS_SU = WS_SD + 65536;
constexpr size_t WS_END = 512 * MiB;
constexpr int CW_TMO = 0, CW_CODE = 1, CW_BAR = 4096;

constexpr int RING_BYTES = 131072, LDSCTL_OFF = 163328, MISC_OFF = LDSCTL_OFF + 320, LDS_BYTES = 163840;

#define GAS __attribute__((address_space(1)))
#define LAS __attribute__((address_space(3)))
#define DI __device__ __forceinline__
typedef unsigned short bf16;
typedef unsigned v4u __attribute__((ext_vector_type(4)));
typedef unsigned v2u __attribute__((ext_vector_type(2)));
typedef float f32x4 __attribute__((ext_vector_type(4)));
typedef float f32x16 __attribute__((ext_vector_type(16)));
typedef short bf16x8 __attribute__((ext_vector_type(8)));
typedef GAS unsigned gu32;
#define RLX_AGENT __ATOMIC_RELAXED, __HIP_MEMORY_SCOPE_AGENT
#define LDS_WAIT() asm volatile("s_waitcnt lgkmcnt(0)" ::: "memory")
#define VM_WAIT() asm volatile("s_waitcnt vmcnt(0)" ::: "memory")
#define MFMA32(a, b, c) __builtin_amdgcn_mfma_f32_32x32x16_bf16((a), (b), (c), 0, 0, 0)
DI unsigned f2bf(float f) { unsigned u = __builtin_bit_cast(unsigned, f); return (u + 0x7fffu + ((u >> 16) & 1u)) >> 16; }
DI unsigned pk2(float lo, float hi) { return f2bf(lo) | (f2bf(hi) << 16); }
DI float bflo(unsigned w) { return __builtin_bit_cast(float, w << 16); }
DI float bfhi(unsigned w) { return __builtin_bit_cast(float, w & 0xffff0000u); }
DI float bf2f(unsigned short h) { return __builtin_bit_cast(float, (unsigned)h << 16); }
DI int crow(int reg, int h) { return (reg & 3) + 8 * (reg >> 2) + 4 * h; }
DI float wave_sum(float v) {
#pragma unroll
    for (int o = 1; o < 64; o <<= 1) v += __shfl_xor(v, o);
    return v;
}
DI float wave_max(float v) {
#pragma unroll
    for (int o = 1; o < 64; o <<= 1) v = fmaxf(v, __shfl_xor(v, o));
    return v;
}
DI float silu_f(float v) { return v / (1.0f + __expf(-v)); }
DI float sigmoid_f(float v) { return 1.0f / (1.0f + __expf(-v)); }
DI float gelu_f(float v) { return 0.5f * v * (1.0f + erff(v * 0.70710678118654752f)); }
typedef __bf16 bf16v2 __attribute__((ext_vector_type(2)));
#define DOT2(a, b, c) __builtin_amdgcn_fdot2_f32_bf16(__builtin_bit_cast(bf16v2, (unsigned)(a)), __builtin_bit_cast(bf16v2, (unsigned)(b)), (c), false)
DI f32x16 zero16() { f32x16 z; for (int i = 0; i < 16; ++i) z[i] = 0.f; return z; }
#define XB_TMO      128
#define XB_XCNT(j)  (256  + 64 * (j))
#define XB_XSUB(j)  (1280 + 64 * (j))
#define XB_XGEN(j)  (2304 + 64 * (j))
#define XB_TOP      3328
#define XB_TOPGEN   3392
#define XCD_BAR_WORDS 3456
#define XB_SPIN_CAP (1u << 18)

__device__ __forceinline__ unsigned xb_ld(unsigned* p)              { return __hip_atomic_load(p, __ATOMIC_RELAXED, __HIP_MEMORY_SCOPE_AGENT); }
__device__ __forceinline__ unsigned xb_add(unsigned* p, unsigned v) { return __hip_atomic_fetch_add(p, v, __ATOMIC_RELAXED, __HIP_MEMORY_SCOPE_AGENT); }
__device__ __forceinline__ unsigned xb_xcc_id() { return (unsigned)__builtin_amdgcn_s_getreg((3 << 11) | 20) & 0xFu; }
#define XB_SPIN(cond, bar) do { unsigned _sp = 0; while (cond) { __builtin_amdgcn_s_sleep(1); \
    if ((++_sp & 255u) == 0u) { if (xb_ld(&(bar)[XB_TMO])) break; if (_sp > XB_SPIN_CAP) { atomicAdd(&(bar)[XB_TMO], 1u); break; } } } } while (0)

struct XcdBarrier {
    unsigned* bar; unsigned x;
    volatile LAS unsigned* st;
};

__device__ __forceinline__ XcdBarrier xcd_barrier_post(unsigned* bar, volatile LAS unsigned* st) {
    XcdBarrier b; b.bar = bar; b.x = xb_xcc_id(); b.st = st;
    if (threadIdx.x == 0) (void)xb_add(&bar[XB_XCNT(b.x)], 1u);
    return b;
}
__device__ __forceinline__ void xcd_barrier_complete(unsigned* bar, unsigned x, unsigned& nloc, unsigned& nx) {
    const unsigned G = gridDim.x * gridDim.y * gridDim.z;
    unsigned sum, cnt, mine, sp = 0u;
    for (;;) {
        sum = 0u; cnt = 0u; mine = 0u;
#pragma unroll
        for (unsigned j = 0; j < 16; ++j) { const unsigned c = xb_ld(&bar[XB_XCNT(j)]); sum += c; cnt += (c > 0u) ? 1u : 0u; mine = (j == x) ? c : mine; }
        if (sum == G) break;
        __builtin_amdgcn_s_sleep(1);
        if ((++sp & 255u) == 0u) { if (xb_ld(&bar[XB_TMO])) break; if (sp > XB_SPIN_CAP) { atomicAdd(&bar[XB_TMO], 1u); break; } }
    }
    nloc = mine > 0u ? mine : 1u; nx = cnt > 0u ? cnt : 1u;
}

__device__ __forceinline__ void xcd_barrier(const XcdBarrier& b) {
    asm volatile("s_waitcnt vmcnt(0)" ::: "memory");
    __syncthreads();
    if (threadIdx.x == 0) {
        unsigned* bar = b.bar;
        __builtin_amdgcn_s_waitcnt(0);
        unsigned nloc = b.st[0], nx = b.st[1];
        if (nloc == 0u) { xcd_barrier_complete(bar, b.x, nloc, nx); b.st[0] = nloc; b.st[1] = nx; }
        const unsigned old = xb_add(&bar[XB_XSUB(b.x)], 1u);
        const unsigned gen = old / nloc;
        if (old + 1u == (gen + 1u) * nloc) {
            __builtin_amdgcn_fence(__ATOMIC_RELEASE, "agent");
            asm volatile("s_waitcnt vmcnt(0)" ::: "memory");
            const unsigned og = xb_add(&bar[XB_TOP], 1u);
            const unsigned tg = og / nx;
            if (og + 1u == (tg + 1u) * nx) xb_add(&bar[XB_TOPGEN], 1u);
            else XB_SPIN(xb_ld(&bar[XB_TOPGEN]) == tg, bar);
            __builtin_amdgcn_fence(__ATOMIC_ACQUIRE, "agent");
            xb_add(&bar[XB_XGEN(b.x)], 1u);
            asm volatile("s_waitcnt vmcnt(0)" ::: "memory");
        } else {
            XB_SPIN(xb_ld(&bar[XB_XGEN(b.x)]) == gen, bar);
            __builtin_amdgcn_fence(__ATOMIC_ACQUIRE, "agent");
            asm volatile("s_waitcnt vmcnt(0)" ::: "memory");
        }
    }
    __syncthreads();
}
struct Frame {
    LAS unsigned char* lds;
    volatile LAS unsigned* MISC;
    gu32* ctl;
    int tid, lane, wave, vcu, G;
    const float *x, *c, *ada_w, *ada_b, *norm_mix_g, *w_in, *b_gates, *conv_w, *conv_b, *gmlp_norm_g, *gmlp_w, *gmlp_b, *mlstm_norm_g, *w_out, *norm_ffn_g,
                *wq, *keys1, *keys2, *e_down, *e_up, *final_g;
    float* out;
    float *MODP, *MODF, *GATES, *SUMM, *MTAB, *NST, *PG;
    int* IDX;
    bf16 *WIN, *WOUT, *WQ, *HA, *PROJ, *QB, *STATE, *QC, *KC, *VT;
    unsigned char *ED, *EU; float *SD, *SU;
    float *SSQP, *BQP, *BIASQ; bf16* X1B;
};

DI void p0_transpose_item(const float* W, int K, int ldw, int nblk, bf16* WT, LAS float* scr, int item, int lane, bool vm_last = false) {
    const int kb = item / nblk, nb = item % nblk, k0 = 64 * kb, n0 = 32 * nb;
    const int d0 = !vm_last ? n0 : (n0 < 4096 ? n0 : (n0 < 5120 ? n0 + 1024 : n0 - 1024));
#pragma unroll 8
    for (int i = 0; i < 32; ++i) { const int kk = 2 * i + (lane >> 5); scr[kk * 33 + (lane & 31)] = W[(size_t)(k0 + kk) * ldw + n0 + (lane & 31)]; }
    LDS_WAIT(); asm volatile("" ::: "memory");
    const int c = lane & 7;
#pragma unroll
    for (int j = 0; j < 4; ++j) { const int n = (lane >> 3) + 8 * j; const LAS float* s = scr + (8 * c) * 33 + n;
        v4u o; o.x = pk2(s[0 * 33], s[1 * 33]); o.y = pk2(s[2 * 33], s[3 * 33]); o.z = pk2(s[4 * 33], s[5 * 33]); o.w = pk2(s[6 * 33], s[7 * 33]);
        *(GAS v4u*)(WT + (size_t)(d0 + n) * K + k0 + 8 * c) = o; }
    LDS_WAIT(); asm volatile("" ::: "memory");
}
DI void p0_ada_item(Frame& F, LAS float* scr, int item) {
    const int cc = item % (NMOD / 256), kc = item / (NMOD / 256), k0 = kc * ADA_KROWS, col = cc * 256 + F.lane * 4;
#pragma unroll
    for (int j = 0; j < ADA_KROWS / 64; ++j) scr[F.lane + 64 * j] = silu_f(F.c[k0 + F.lane + 64 * j]);
    LDS_WAIT(); asm volatile("" ::: "memory");
    f32x4 acc = {0.f, 0.f, 0.f, 0.f};
    const float* wp = F.ada_w + (size_t)k0 * NMOD + col;
#pragma unroll 8
    for (int kk = 0; kk < ADA_KROWS; ++kk) { const float s = scr[kk]; const f32x4 w = *(const GAS f32x4*)(wp + (size_t)kk * NMOD); acc += w * s; }
    *(GAS f32x4*)(F.MODP + (size_t)kc * NMOD + col) = acc;
    LDS_WAIT(); asm volatile("" ::: "memory");
}
DI void p0a_phase(Frame& F) {
    LAS float* scr = (LAS float*)(F.lds + F.wave * 16384);
    const int gw = F.wave * F.G + F.vcu, NGW = F.G * NWAVES;
    constexpr int I_ADA = (NMOD / 256) * ADA_KC;
    constexpr int I_WIN = (D / 64) * (NWIN / 32), I_WO = (D / 64) * (D / 32);
    constexpr int NITEMS = I_ADA + I_WIN + I_WO;
    for (int it = gw; it < NITEMS; it += NGW) {
        int r = it;
        if (r < I_ADA) { p0_ada_item(F, scr, r); continue; } r -= I_ADA;
        if (r < I_WIN) { p0_transpose_item(F.w_in, D, IN_COLS, NWIN / 32, F.WIN, scr, r, F.lane, true); continue; } r -= I_WIN;
        p0_transpose_item(F.w_out, D, D, D / 32, F.WOUT, scr, r, F.lane);
    }
#pragma unroll 1
    for (int row = gw; row < 2 * NEXP; row += NGW) {
        const int tb = row >= NEXP, e = row - tb * NEXP;
        const GAS f32x4* src = (const GAS f32x4*)((tb ? F.e_up : F.e_down) + (size_t)e * D) + F.lane;
        f32x4 v[8]; float am = 0.f;
#pragma unroll
        for (int j = 0; j < 8; ++j) { v[j] = src[64 * j]; am = fmaxf(am, fmaxf(fmaxf(fabsf(v[j].x), fabsf(v[j].y)), fmaxf(fabsf(v[j].z), fabsf(v[j].w)))); }
        am = fmaxf(wave_max(am), 1e-30f);
        const float sc = am * (1.0f / 127.0f), inv = 127.0f / am;
        GAS unsigned* dst = (GAS unsigned*)((tb ? F.EU : F.ED) + (size_t)e * D) + F.lane;
        const int off = tb ? 128 : 0;
#pragma unroll
        for (int j = 0; j < 8; ++j) {
            const int q0 = (int)__builtin_rintf(v[j].x * inv) + off, q1 = (int)__builtin_rintf(v[j].y * inv) + off, q2 = (int)__builtin_rintf(v[j].z * inv) + off, q3 = (int)__builtin_rintf(v[j].w * inv) + off;
            dst[64 * j] = (unsigned)(q0 & 255) | ((unsigned)(q1 & 255) << 8) | ((unsigned)(q2 & 255) << 16) | ((unsigned)(q3 & 255) << 24);
        }
        if (F.lane == 0) (tb ? F.SU : F.SD)[e] = sc;
    }
}
DI float mod_final(Frame& F, int col) { float s = F.ada_b[col];
#pragma unroll
    for (int k = 0; k < ADA_KC; ++k) s += F.MODP[(size_t)k * NMOD + col];
    return s; }
DI void norm_tables(Frame& F, const float* g, int col_scale, int col_shift) {
    LAS float* A1 = (LAS float*)(F.lds); LAS float* B1 = (LAS float*)(F.lds + 8192);
#pragma unroll
    for (int i = 0; i < 4; ++i) { const int c = F.tid + 512 * i; A1[c] = g[c] * (1.0f + F.MODF[col_scale + c]); B1[c] = F.MODF[col_shift + c]; }
}
DI void p0_wq_item(Frame& F, LAS float* scr, int item) {
    const int lane = F.lane, nblk = D / 32, kb = item / nblk, nb = item % nblk, k0 = 64 * kb, n0 = 32 * nb;
    LAS float* gsl = scr + 64 * 33; LAS float* shl = gsl + 64;
    gsl[lane] = F.norm_ffn_g[k0 + lane] * (1.0f + mod_final(F, MOD_SCF + k0 + lane)); shl[lane] = mod_final(F, MOD_SHF + k0 + lane);
    LDS_WAIT(); asm volatile("" ::: "memory");
    float bp = 0.f;
#pragma unroll 8
    for (int i = 0; i < 32; ++i) { const int kk = 2 * i + (lane >> 5); const float w = F.wq[(size_t)(k0 + kk) * D + n0 + (lane & 31)]; scr[kk * 33 + (lane & 31)] = w * gsl[kk]; bp += w * shl[kk]; }
    bp += __shfl_xor(bp, 32);
    if (lane < 32) F.BQP[(size_t)kb * D + n0 + lane] = bp;
    LDS_WAIT(); asm volatile("" ::: "memory");
    const int c = lane & 7;
#pragma unroll
    for (int j = 0; j < 4; ++j) { const int n = (lane >> 3) + 8 * j; const LAS float* sp = scr + (8 * c) * 33 + n;
        v4u o; o.x = pk2(sp[0 * 33], sp[1 * 33]); o.y = pk2(sp[2 * 33], sp[3 * 33]); o.z = pk2(sp[4 * 33], sp[5 * 33]); o.w = pk2(sp[6 * 33], sp[7 * 33]);
        *(GAS v4u*)(F.WQ + (size_t)(n0 + n) * D + k0 + 8 * c) = o; }
    LDS_WAIT(); asm volatile("" ::: "memory");
}
DI void p0b_phase(Frame& F) {
    LAS float* A1 = (LAS float*)(F.lds); LAS float* B1 = (LAS float*)(F.lds + 8192); LAS float* WG = (LAS float*)(F.lds + 16384);
#pragma unroll
    for (int i = 0; i < 4; ++i) { const int c = F.tid + 512 * i; A1[c] = F.norm_mix_g[c] * (1.0f + mod_final(F, MOD_SCM + c)); B1[c] = mod_final(F, MOD_SHM + c); }
    { const int per = (NMOD + F.G - 1) / F.G; const int c = (int)blockIdx.x * per + F.tid; if (F.tid < per && c < NMOD) F.MODF[c] = mod_final(F, c); }
#pragma unroll
    for (int i = 0; i < 4; ++i) { const int k = F.tid + 512 * i; const f32x4 a = *(const GAS f32x4*)(F.w_in + (size_t)k * IN_COLS + NWIN), b = *(const GAS f32x4*)(F.w_in + (size_t)k * IN_COLS + NWIN + 4);
        WG[0 * 2048 + k] = a.x; WG[1 * 2048 + k] = a.y; WG[2 * 2048 + k] = a.z; WG[3 * 2048 + k] = a.w; WG[4 * 2048 + k] = b.x; WG[5 * 2048 + k] = b.y; WG[6 * 2048 + k] = b.z; WG[7 * 2048 + k] = b.w; }
    __syncthreads();
    const int gw = F.vcu * NWAVES + F.wave, NGW = F.G * NWAVES;
    f32x4 vn[8];
    { const GAS f32x4* xr = (const GAS f32x4*)(F.x + (size_t)gw * D) + F.lane;
#pragma unroll
      for (int j = 0; j < 8; ++j) vn[j] = xr[64 * j]; }
#pragma unroll 1
    for (int row = gw; row < M; row += NGW) {
        f32x4 v[8]; float ss = 0.f;
#pragma unroll
        for (int j = 0; j < 8; ++j) { v[j] = vn[j]; ss += (v[j].x * v[j].x + v[j].y * v[j].y) + (v[j].z * v[j].z + v[j].w * v[j].w); }
        if (row + NGW < M) { const GAS f32x4* xr = (const GAS f32x4*)(F.x + (size_t)(row + NGW) * D) + F.lane;
#pragma unroll
            for (int j = 0; j < 8; ++j) vn[j] = xr[64 * j]; }
        const float rstd = 1.0f / sqrtf(wave_sum(ss) * (1.0f / D) + EPS);
        float gd[8];
#pragma unroll
        for (int g = 0; g < 8; ++g) gd[g] = 0.f;
        GAS v2u* o8 = (GAS v2u*)(F.HA + (size_t)row * D) + F.lane;
#pragma unroll
        for (int j = 0; j < 8; ++j) {
            const f32x4 a = *(const LAS f32x4*)(A1 + 256 * j + 4 * F.lane), b = *(const LAS f32x4*)(B1 + 256 * j + 4 * F.lane);
            const f32x4 h = v[j] * rstd * a + b;
            v2u o; o.x = pk2(h.x, h.y); o.y = pk2(h.z, h.w); o8[64 * j] = o;
#pragma unroll
            for (int g = 0; g < 8; ++g) { const f32x4 w = *(const LAS f32x4*)(WG + g * 2048 + 256 * j + 4 * F.lane); gd[g] += (h.x * w.x + h.y * w.y) + (h.z * w.z + h.w * w.w); }
            asm volatile("" ::: "memory");
        }
#pragma unroll
        for (int g = 0; g < 8; ++g) gd[g] = wave_sum(gd[g]);
        if (F.lane == 0) {
#pragma unroll
            for (int g = 0; g < 8; ++g) { float p = gd[g] + F.b_gates[g];
                if (g >= 4) { p = fminf(p, 0.f) - log1pf(__expf(-fabsf(p))); }
                F.GATES[(size_t)row * 8 + g] = p; }
        }
    }
    __syncthreads();
    {
        LAS float* scr = (LAS float*)(F.lds + F.wave * 8960);
        for (int it = F.wave * F.G + F.vcu; it < (D / 64) * (D / 32); it += NGW) p0_wq_item(F, scr, it);
    }
}
constexpr int IMG_PITCH = 576, M1_WL = 73728, M1_RED = 74240;
typedef short s16x4 __attribute__((ext_vector_type(4)));
DI bf16x8 tr_frag(const LAS unsigned char* p, int off_lo, int off_hi) {
    const s16x4 lo = __builtin_amdgcn_ds_read_tr16_b64_v4i16((LAS s16x4*)(p + off_lo));
    const s16x4 hi = __builtin_amdgcn_ds_read_tr16_b64_v4i16((LAS s16x4*)(p + off_hi));
    return __builtin_shufflevector(lo, hi, 0, 1, 2, 3, 4, 5, 6, 7);
}
DI float bfel(const v4u& w, int e) { const unsigned d = w[e >> 1]; return (e & 1) ? bfhi(d) : bflo(d); }
DI void m1_item(Frame& F, int hh, int kc) {
    LAS unsigned char* IMG = F.lds; LAS float* WL = (LAS float*)(F.lds + M1_WL); LAS float* RED = (LAS float*)(F.lds + M1_RED);
    const int t0 = kc * CH, lane = F.lane, tid = F.tid;
    if (F.wave == 0) {
        const float* gp = F.GATES + (size_t)(t0 + 2 * lane) * 8;
        const float i0 = gp[hh], lf0 = gp[4 + hh], i1 = gp[8 + hh], lf1 = gp[12 + hh];
        const float p = lf0 + lf1; float inc = p;
#pragma unroll
        for (int o = 1; o < 64; o <<= 1) { const float t = __shfl_up(inc, o); if (lane >= o) inc += t; }
        const float A = __shfl(inc, 63), ex = inc - p, b0 = ex + lf0, b1 = ex + p;
        const float lw0 = A - b0 + i0, lw1 = A - b1 + i1;
        const float B = wave_max(fmaxf(lw0, lw1));
        WL[2 * lane] = __expf(lw0 - B); WL[2 * lane + 1] = __expf(lw1 - B);
        if (lane == 0) { F.SUMM[(hh * NCHUNK + kc) * 2] = A; F.SUMM[(hh * NCHUNK + kc) * 2 + 1] = B; }
    }
    __syncthreads();
    const int dg = tid & 31, sg = tid >> 5;
#pragma unroll 1
    for (int which = 0; which < 2; ++which) {
        const int chb = (which == 0 ? 1024 : 0) + hh * DH + dg * 8;
        const int colb = (which == 0 ? C_K : C_Q) + hh * DH + dg * 8;
        v4u raw[11];
#pragma unroll
        for (int rr = 0; rr < 11; ++rr) { const int tt = t0 + sg * 8 - 3 + rr; raw[rr] = (v4u){0u, 0u, 0u, 0u}; if (tt >= 0) raw[rr] = *(const GAS v4u*)(F.PROJ + (size_t)tt * NPROJ + colb); }
        float wl[8];
#pragma unroll
        for (int i = 0; i < 8; ++i) wl[i] = (which == 0) ? WL[sg * 8 + i] : 0.0625f;
        v4u o1[8], o2[8];
#pragma unroll
        for (int dw = 0; dw < 4; ++dw) {
            typedef float f32x2 __attribute__((ext_vector_type(2)));
            f32x2 cw[4];
#pragma unroll
            for (int j = 0; j < 4; ++j) cw[j] = *(const GAS f32x2*)(F.conv_w + j * 2048 + chb + 2 * dw);
            const f32x2 cb = *(const GAS f32x2*)(F.conv_b + chb + 2 * dw);
            float xl[11], xh[11];
#pragma unroll
            for (int rr = 0; rr < 11; ++rr) { xl[rr] = bflo(raw[rr][dw]); xh[rr] = bfhi(raw[rr][dw]); }
            float d0 = 0.f, d1 = 0.f;
#pragma unroll
            for (int i = 0; i < 8; ++i) {
                float a0 = cb.x, a1 = cb.y;
#pragma unroll
                for (int j = 0; j < 4; ++j) { a0 += cw[j].x * xl[i + j]; a1 += cw[j].y * xh[i + j]; }
                a0 = silu_f(a0); a1 = silu_f(a1);
                if (which == 0) { o1[i][dw] = pk2(a0, a1); a0 *= wl[i]; a1 *= wl[i]; d0 += a0; d1 += a1; o2[i][dw] = pk2(a0, a1); }
                else { o1[i][dw] = pk2(a0 * wl[i], a1 * wl[i]); }
            }
            if (which == 0) { RED[sg * 256 + dg * 8 + 2 * dw] = d0; RED[sg * 256 + dg * 8 + 2 * dw + 1] = d1; }
            asm volatile("" ::: "memory");
        }
#pragma unroll
        for (int i = 0; i < 8; ++i) { const int s = sg * 8 + i, t = t0 + s;
            if (which == 0) { *(GAS v4u*)(F.KC + (size_t)t * 1024 + hh * DH + dg * 8) = o1[i]; *(LAS v4u*)(IMG + s * IMG_PITCH + dg * 16) = o2[i]; }
            else { *(GAS v4u*)(F.QC + (size_t)t * 1024 + hh * DH + dg * 8) = o1[i]; } }
    }
    __syncthreads();
    if (tid < 256) { float s = 0.f;
#pragma unroll
        for (int i = 0; i < 16; ++i) s += RED[i * 256 + tid];
        F.NST[(size_t)(hh * NCHUNK + kc) * DH + tid] = s; }
    const int r = lane & 31, h = lane >> 5, e0 = F.wave * 32;
    bf16x8 bf[8];
#pragma unroll
    for (int ks = 0; ks < 8; ++ks) {
        bf[ks] = *(const GAS bf16x8*)(F.VT + (size_t)(hh * DH + e0 + r) * M + t0 + ks * 16 + 8 * h);
    }
    bf16* sp = F.STATE + (size_t)(hh * NCHUNK + kc) * (DH * DH) + (size_t)(e0 + r) * DH;
    const LAS unsigned char* trb = IMG + (8 * h + ((lane & 15) >> 2)) * IMG_PITCH + (16 * ((lane >> 4) & 1) + 4 * (lane & 3)) * 2;
#pragma unroll 1
    for (int dt = 0; dt < 8; ++dt) {
        f32x16 acc = zero16();
#pragma unroll
        for (int ks = 0; ks < 8; ++ks) { const bf16x8 af = tr_frag(trb + dt * 64, ks * 16 * IMG_PITCH, ks * 16 * IMG_PITCH + 4 * IMG_PITCH); acc = MFMA32(af, bf[ks], acc); }
#pragma unroll
        for (int g = 0; g < 4; ++g) { v2u o; o.x = pk2(acc[4 * g], acc[4 * g + 1]); o.y = pk2(acc[4 * g + 2], acc[4 * g + 3]);
            *(GAS v2u*)(sp + dt * 32 + 8 * g + 4 * h) = o; }
    }
    __syncthreads();
}
DI void gmlp_item(Frame& F, int n, int g) {
    LAS float* RSTD = (LAS float*)F.lds;
    const int t0 = n * CH, c0 = g * 128, lane = F.lane, tid = F.tid;
    { const int s = tid >> 2, qd = tid & 3; const bf16* vp = F.PROJ + (size_t)(t0 + s) * NPROJ + C_VG + c0 + qd * 32; float ss = 0.f;
#pragma unroll
        for (int i = 0; i < 4; ++i) { const v4u w = *(const GAS v4u*)(vp + 8 * i);
            const float a0 = bflo(w.x), a1 = bfhi(w.x), a2 = bflo(w.y), a3 = bfhi(w.y), a4 = bflo(w.z), a5 = bfhi(w.z), a6 = bflo(w.w), a7 = bfhi(w.w);
            ss += (a0 * a0 + a1 * a1) + (a2 * a2 + a3 * a3) + (a4 * a4 + a5 * a5) + (a6 * a6 + a7 * a7); }
        ss += __shfl_xor(ss, 1); ss += __shfl_xor(ss, 2);
        if (qd == 0) RSTD[s] = 1.0f / sqrtf(ss * (1.0f / 128.0f) + EPS); }
    __syncthreads();
    const int r = lane & 31, h = lane >> 5, ct = F.wave & 3, tp = F.wave >> 2;
    bf16x8 af[8];
#pragma unroll
    for (int ks = 0; ks < 8; ++ks) {
        const bf16* vp = F.PROJ + (size_t)(t0 + ks * 16 + 8 * h) * NPROJ + C_VG + c0 + ct * 32 + r;
#pragma unroll
        for (int j = 0; j < 8; ++j) af[ks][j] = (short)vp[(size_t)j * NPROJ];
    }
    float ng[16];
#pragma unroll
    for (int reg = 0; reg < 16; ++reg) ng[reg] = F.gmlp_norm_g[g * 128 + ct * 32 + crow(reg, h)];
#pragma unroll 1
    for (int ti = 0; ti < 2; ++ti) {
        const int tt = (ti == 0) ? tp : 3 - tp;
        const int t = tt * 32 + r;
        const float* wrow = F.gmlp_w + (size_t)(g * 128 + t) * 128;
        f32x16 acc = zero16();
#pragma unroll
        for (int ks = 0; ks < 8; ++ks) {
            if (ks <= 2 * tt + 1) {
                const int s0 = ks * 16 + 8 * h;
                const f32x4 wa = *(const GAS f32x4*)(wrow + s0), wb = *(const GAS f32x4*)(wrow + s0 + 4);
                const f32x4 ra = *(const LAS f32x4*)(RSTD + s0), rb = *(const LAS f32x4*)(RSTD + s0 + 4);
                float wv[8] = {wa.x * ra.x, wa.y * ra.y, wa.z * ra.z, wa.w * ra.w, wb.x * rb.x, wb.y * rb.y, wb.z * rb.z, wb.w * rb.w};
#pragma unroll
                for (int j = 0; j < 8; ++j) if (s0 + j > t) wv[j] = 0.f;
                v4u bw; bw.x = pk2(wv[0], wv[1]); bw.y = pk2(wv[2], wv[3]); bw.z = pk2(wv[4], wv[5]); bw.w = pk2(wv[6], wv[7]);
                acc = MFMA32(af[ks], __builtin_bit_cast(bf16x8, bw), acc);
            }
        }
        const float bsp = F.gmlp_b[g * 128 + t];
        const bf16* up = F.PROJ + (size_t)(t0 + t) * NPROJ + C_UG + c0 + ct * 32;
        bf16* yp = F.HA + (size_t)(t0 + t) * D + c0 + ct * 32;
#pragma unroll
        for (int gq = 0; gq < 4; ++gq) { const int cl = 8 * gq + 4 * h;
            const v2u uw = *(const GAS v2u*)(up + cl);
            const float y0 = bflo(uw.x) * (ng[4 * gq] * acc[4 * gq] + bsp), y1 = bfhi(uw.x) * (ng[4 * gq + 1] * acc[4 * gq + 1] + bsp);
            const float y2 = bflo(uw.y) * (ng[4 * gq + 2] * acc[4 * gq + 2] + bsp), y3 = bfhi(uw.y) * (ng[4 * gq + 3] * acc[4 * gq + 3] + bsp);
            v2u o; o.x = pk2(y0, y1); o.y = pk2(y2, y3); *(GAS v2u*)(yp + cl) = o; }
    }
    __syncthreads();
}
DI void p2_phase(Frame& F) {
    constexpr int N_M1 = NHEAD * NCHUNK, N_G = (M / CH) * 8;
#pragma unroll 1
    for (int it = (int)blockIdx.x; it < N_M1; it += F.G) m1_item(F, it / NCHUNK, it % NCHUNK);
#pragma unroll 1
    for (int j = (int)blockIdx.x; j < N_G; j += F.G) gmlp_item(F, j % (M / CH), j / (M / CH));
}
DI void p3_phase(Frame& F) {
    LAS float* TAB = (LAS float*)F.lds;
    const int lane = F.lane;
    if (F.wave < NHEAD) {
        const int hh = F.wave; const float* sp = F.SUMM + (size_t)(hh * NCHUNK + 2 * lane) * 2;
        const float A0 = sp[0], B0 = sp[1], A1 = sp[2], B1 = sp[3];
        float ca = A0 + A1, cb = fmaxf(B0 + A1, B1);
        const float pa = ca, pb = cb;
#pragma unroll
        for (int o = 1; o < 64; o <<= 1) { const float ta = __shfl_up(ca, o), tb = __shfl_up(cb, o); if (lane >= o) { cb = fmaxf(tb + ca, cb); ca = ta + ca; } }
        (void)pa; (void)pb;
        float ea = __shfl_up(ca, 1), eb = __shfl_up(cb, 1);
        float m0 = (lane == 0) ? 0.f : fmaxf(ea, eb);
        const float m1 = fmaxf(m0 + A0, B0), m2 = fmaxf(m1 + A1, B1);
        TAB[(hh * NCHUNK + 2 * lane) * 2] = __expf(A0 + m0 - m1); TAB[(hh * NCHUNK + 2 * lane) * 2 + 1] = __expf(B0 - m1);
        TAB[(hh * NCHUNK + 2 * lane + 1) * 2] = __expf(A1 + m1 - m2); TAB[(hh * NCHUNK + 2 * lane + 1) * 2 + 1] = __expf(B1 - m2);
        if (blockIdx.x == 0) { F.MTAB[hh * NCHUNK + 2 * lane] = m0; F.MTAB[hh * NCHUNK + 2 * lane + 1] = m1; }
    }
    __syncthreads();
    const int NT = F.G * NWAVES * 64, gt = (int)blockIdx.x * (NWAVES * 64) + F.tid;
    if (gt < D) { float b = 0.f;
#pragma unroll 8
        for (int k = 0; k < D / 64; ++k) b += F.BQP[(size_t)k * D + gt];
        F.BIASQ[gt] = b; }
    for (int p = gt; p < NHEAD * (DH * DH / 2); p += NT) {
        const int hh = p / (DH * DH / 2), q = p % (DH * DH / 2);
        GAS unsigned* sp = (GAS unsigned*)(F.STATE + (size_t)hh * NCHUNK * (DH * DH)) + q;
        float s0 = 0.f, s1 = 0.f;
#pragma unroll 1
        for (int k0 = 0; k0 < NCHUNK; k0 += 16) {
            unsigned ld[16];
#pragma unroll
            for (int k = 0; k < 16; ++k) ld[k] = sp[(size_t)(k0 + k) * (DH * DH / 2)];
#pragma unroll
            for (int k = 0; k < 16; ++k) {
                sp[(size_t)(k0 + k) * (DH * DH / 2)] = pk2(s0, s1);
                const float dec = TAB[(hh * NCHUNK + k0 + k) * 2], wb = TAB[(hh * NCHUNK + k0 + k) * 2 + 1];
                s0 = dec * s0 + wb * bflo(ld[k]); s1 = dec * s1 + wb * bfhi(ld[k]);
            }
        }
    }
    for (int p = gt; p < NHEAD * DH; p += NT) {
        const int hh = p / DH, d = p % DH; float* np = F.NST + (size_t)hh * NCHUNK * DH + d; float s = 0.f;
#pragma unroll 8
        for (int k = 0; k < NCHUNK; ++k) { const float ld = np[(size_t)k * DH]; np[(size_t)k * DH] = s; s = TAB[(hh * NCHUNK + k) * 2] * s + TAB[(hh * NCHUNK + k) * 2 + 1] * ld; }
    }
}
constexpr int M3_QI = 8192, M3_R2 = 75776, M3_QP = 528, M3_CP = 272, M3_VP = 264;
static_assert(M3_R2 + 256 * M3_CP <= LDSCTL_OFF, "P4 LDS map");
DI void m3_item(Frame& F, int hh, int kc) {
    LAS float* GS = (LAS float*)F.lds; LAS float* MX = GS + 128; LAS float* BT = GS + 256; LAS float* NK = GS + 384; LAS float* XCH = GS + 640;
    LAS unsigned char* QI = F.lds + M3_QI; LAS unsigned char* R2 = F.lds + M3_R2;
    const int t0 = kc * CH, lane = F.lane, tid = F.tid, item = hh * NCHUNK + kc;
    const float mk = F.MTAB[item];
    const bf16* cbase = F.STATE + (size_t)item * (DH * DH);
    const bf16* kbase = F.KC + (size_t)t0 * 1024 + hh * DH;
    const bf16* qbase = F.QC + (size_t)t0 * 1024 + hh * DH;
    const bf16* vbase = F.VT + (size_t)(hh * DH) * M + t0;
    {
        v4u tk[8], tq[8];
#pragma unroll
        for (int i = 0; i < 8; ++i) { const int p = tid + 512 * i; tk[i] = *(const GAS v4u*)(kbase + (size_t)(p >> 5) * 1024 + (p & 31) * 8); tq[i] = *(const GAS v4u*)(qbase + (size_t)(p >> 5) * 1024 + (p & 31) * 8); }
        if (F.wave == 0) {
            const float* gp = F.GATES + (size_t)(t0 + 2 * lane) * 8;
            const float i0 = gp[hh], lf0 = gp[4 + hh], i1 = gp[8 + hh], lf1 = gp[12 + hh];
            const float p = lf0 + lf1; float inc = p;
#pragma unroll
            for (int o = 1; o < 64; o <<= 1) { const float t = __shfl_up(inc, o); if (lane >= o) inc += t; }
            const float ex = inc - p, b0 = ex + lf0, b1 = ex + p;
            const float g0 = i0 - b0, g1 = i1 - b1;
            float cm = fmaxf(g0, g1);
#pragma unroll
            for (int o = 1; o < 64; o <<= 1) { const float t = __shfl_up(cm, o); if (lane >= o) cm = fmaxf(cm, t); }
            float pm = __shfl_up(cm, 1); if (lane == 0) pm = -INFINITY;
            const float M0 = fmaxf(mk, fmaxf(pm, g0)), M1 = fmaxf(M0, g1);
            GS[2 * lane] = g0; GS[2 * lane + 1] = g1; MX[2 * lane] = M0; MX[2 * lane + 1] = M1; BT[2 * lane] = b0; BT[2 * lane + 1] = b1;
        }
        if (tid < 256) NK[tid] = F.NST[(size_t)item * DH + tid];
#pragma unroll
        for (int i = 0; i < 8; ++i) { const int p = tid + 512 * i; *(LAS v4u*)(R2 + (p >> 5) * M3_QP + (p & 31) * 16) = tk[i]; *(LAS v4u*)(QI + (p >> 5) * M3_QP + (p & 31) * 16) = tq[i]; }
    }
    __syncthreads();
    const int r = lane & 31, h = lane >> 5, tt = F.wave & 3, eh = F.wave >> 2;
    const int tl = tt * 32 + r, t = t0 + tl;
    const float Mt = MX[tl], winter = __expf(mk - Mt);
    const LAS unsigned char* qrow = QI + tl * M3_QP + 16 * h;
    const LAS float* GSh = GS + 4 * h; int tlo = tl - 4 * h; asm volatile("" : "+v"(tlo));
    bf16x8 xs[4][2]; float den = 0.f;
#pragma unroll
    for (int st = 0; st < 4; ++st) {
        if (st <= tt) {
            f32x16 accS = zero16();
            const LAS unsigned char* krow = R2 + (st * 32 + r) * M3_QP + 16 * h;
#pragma unroll 4
            for (int ks = 0; ks < 16; ++ks) { const bf16x8 kf = *(const LAS bf16x8*)(krow + 32 * ks); const bf16x8 qf = *(const LAS bf16x8*)(qrow + 32 * ks); accS = MFMA32(kf, qf, accS); }
            float xv[16];
#pragma unroll
            for (int reg = 0; reg < 16; ++reg) { const int sc = st * 32 + (reg & 3) + 8 * (reg >> 2); float v = accS[reg] * __expf(GSh[sc] - Mt); if (sc > tlo) v = 0.f; xv[reg] = v; den += v; }
#pragma unroll
            for (int k2 = 0; k2 < 2; ++k2) { v4u xw; xw.x = pk2(xv[8 * k2], xv[8 * k2 + 1]); xw.y = pk2(xv[8 * k2 + 2], xv[8 * k2 + 3]); xw.z = pk2(xv[8 * k2 + 4], xv[8 * k2 + 5]); xw.w = pk2(xv[8 * k2 + 6], xv[8 * k2 + 7]);
                xs[st][k2] = __builtin_bit_cast(bf16x8, xw); }
        } else { xs[st][0] = (bf16x8){0, 0, 0, 0, 0, 0, 0, 0}; xs[st][1] = xs[st][0]; }
        asm volatile("" ::: "memory");
    }
    f32x16 accH[4];
#pragma unroll
    for (int i = 0; i < 4; ++i) accH[i] = zero16();
    float qn = 0.f;
#pragma unroll 1
    for (int hf = 0; hf < 2; ++hf) {
        v4u tc[8];
#pragma unroll
        for (int i = 0; i < 8; ++i) { const int p = tid + 512 * i; tc[i] = *(const GAS v4u*)(cbase + (size_t)(p >> 4) * DH + hf * 128 + (p & 15) * 8); }
        __syncthreads();
#pragma unroll
        for (int i = 0; i < 8; ++i) { const int p = tid + 512 * i; *(LAS v4u*)(R2 + (p >> 4) * M3_CP + (p & 15) * 16) = tc[i]; }
        __syncthreads();
        const LAS unsigned char* crow0 = R2 + (eh * 128 + r) * M3_CP + 16 * h;
#pragma unroll 2
        for (int ks = 0; ks < 8; ++ks) {
            const int kg = hf * 8 + ks;
            const v4u qw = *(const LAS v4u*)(qrow + 32 * kg);
            float qv[8] = {bflo(qw.x), bfhi(qw.x), bflo(qw.y), bfhi(qw.y), bflo(qw.z), bfhi(qw.z), bflo(qw.w), bfhi(qw.w)};
            const f32x4 na = *(const LAS f32x4*)(NK + kg * 16 + 8 * h), nb = *(const LAS f32x4*)(NK + kg * 16 + 8 * h + 4);
            qn += (qv[0] * na.x + qv[1] * na.y) + (qv[2] * na.z + qv[3] * na.w) + (qv[4] * nb.x + qv[5] * nb.y) + (qv[6] * nb.z + qv[7] * nb.w);
            v4u q2; q2.x = pk2(qv[0] * winter, qv[1] * winter); q2.y = pk2(qv[2] * winter, qv[3] * winter); q2.z = pk2(qv[4] * winter, qv[5] * winter); q2.w = pk2(qv[6] * winter, qv[7] * winter);
            const bf16x8 q2f = __builtin_bit_cast(bf16x8, q2);
#pragma unroll
            for (int et = 0; et < 4; ++et) { const bf16x8 cf = *(const LAS bf16x8*)(crow0 + et * 32 * M3_CP + 32 * ks); accH[et] = MFMA32(cf, q2f, accH[et]); }
        }
    }
    qn += __shfl_xor(qn, 32);
    {
        v4u tv[8];
#pragma unroll
        for (int i = 0; i < 8; ++i) { const int p = tid + 512 * i; tv[i] = *(const GAS v4u*)(vbase + (size_t)(p >> 4) * M + (p & 15) * 8); }
        __syncthreads();
#pragma unroll
        for (int i = 0; i < 8; ++i) { const int p = tid + 512 * i; LAS unsigned char* d = R2 + (p >> 4) * M3_VP + (p & 15) * 16;
            *(LAS v2u*)d = (v2u){tv[i].x, tv[i].y}; *(LAS v2u*)(d + 8) = (v2u){tv[i].z, tv[i].w}; }
    }
    __syncthreads();
    const LAS unsigned char* vrow0 = R2 + (eh * 128 + r) * M3_VP + 8 * h;
#pragma unroll
    for (int st = 0; st < 4; ++st) if (st <= tt) {
#pragma unroll
        for (int k2 = 0; k2 < 2; ++k2)
#pragma unroll
            for (int et = 0; et < 4; ++et) {
                const LAS unsigned char* vp = vrow0 + et * 32 * M3_VP + (st * 32 + 16 * k2) * 2;
                const v2u lo = *(const LAS v2u*)vp, hi = *(const LAS v2u*)(vp + 16);
                v4u vw; vw.x = lo.x; vw.y = lo.y; vw.z = hi.x; vw.w = hi.y;
                accH[et] = MFMA32(__builtin_bit_cast(bf16x8, vw), xs[st][k2], accH[et]);
                asm volatile("" ::: "memory");
            }
    }
    den += __shfl_xor(den, 32);
    den += winter * qn;
    const float dnm = fmaxf(fabsf(den), __expf(-(BT[tl] + Mt))), inv = 1.0f / dnm;
    float ss = 0.f;
#pragma unroll
    for (int et = 0; et < 4; ++et)
#pragma unroll
        for (int reg = 0; reg < 16; ++reg) { accH[et][reg] *= inv; ss += accH[et][reg] * accH[et][reg]; }
    ss += __shfl_xor(ss, 32);
    if (h == 0) XCH[eh * 128 + tl] = ss;
    const bf16* op = F.PROJ + (size_t)t * NPROJ + C_OM + hh * DH + eh * 128;
    __syncthreads();
    const float rstd = 1.0f / sqrtf((XCH[tl] + XCH[128 + tl]) * (1.0f / DH) + EPS);
    bf16* yp = F.HA + (size_t)t * D + 1024 + hh * DH + eh * 128;
    const float* ngp = F.mlstm_norm_g + hh * DH + eh * 128;
#pragma unroll
    for (int et = 0; et < 4; ++et)
#pragma unroll
        for (int gq = 0; gq < 4; ++gq) { const int el = et * 32 + 8 * gq + 4 * h;
            const v2u ow = *(const GAS v2u*)(op + el); const f32x4 gn = *(const GAS f32x4*)(ngp + el);
            const float y0 = accH[et][4 * gq] * rstd * gn.x * sigmoid_f(bflo(ow.x)), y1 = accH[et][4 * gq + 1] * rstd * gn.y * sigmoid_f(bfhi(ow.x));
            const float y2 = accH[et][4 * gq + 2] * rstd * gn.z * sigmoid_f(bflo(ow.y)), y3 = accH[et][4 * gq + 3] * rstd * gn.w * sigmoid_f(bfhi(ow.y));
            v2u o; o.x = pk2(y0, y1); o.y = pk2(y2, y3); *(GAS v2u*)(yp + el) = o; }
    __syncthreads();
}
DI void p4_phase(Frame& F) {
    for (int it = (int)blockIdx.x; it < NHEAD * NCHUNK; it += F.G) m3_item(F, it / NCHUNK, it % NCHUNK);
}
constexpr int KPITCH = 272, P8_TBL = 69632;
DI void topk_insert(float (&L)[16], float x) {
#pragma unroll
    for (int i = 15; i >= 1; --i) L[i] = __builtin_amdgcn_fmed3f(x, L[i - 1], L[i]);
    L[0] = fmaxf(L[0], x);
}
DI void p8_phase(Frame& F) {
    LAS unsigned char* KIMG = F.lds; LAS unsigned char* TBL = F.lds + P8_TBL + F.wave * 1024;
    const int lane = F.lane, tid = F.tid, r = lane & 31, h = lane >> 5;
#pragma unroll 4
    for (int i = 0; i < 16; ++i) { const int idx = tid * 4 + 2048 * i, side = idx >> 14, rem = idx & 16383, row = rem >> 7, col = rem & 127;
        const f32x4 a = *(const GAS f32x4*)((side ? F.keys2 : F.keys1) + rem);
        v2u o; o.x = pk2(a.x, a.y); o.y = pk2(a.z, a.w); *(LAS v2u*)(KIMG + (side * 128 + row) * KPITCH + col * 2) = o; }
    __syncthreads();
    for (int it = (int)blockIdx.x; it < (M / 256) * PH; it += F.G) {
        const int tile = it / PH, hd = it % PH;
        const int t = tile * 256 + F.wave * 32 + r;
        float L1[16], L2[16];
#pragma unroll 1
        for (int side = 0; side < 2; ++side) {
            f32x16 acc[4];
#pragma unroll
            for (int kt = 0; kt < 4; ++kt) acc[kt] = zero16();
            const bf16* qp = F.QB + (size_t)t * D + hd * 256 + side * 128 + 8 * h;
#pragma unroll
            for (int ks = 0; ks < 8; ++ks) {
                const bf16x8 qf = *(const GAS bf16x8*)(qp + ks * 16);
#pragma unroll
                for (int kt = 0; kt < 4; ++kt) { const bf16x8 kf = *(const LAS bf16x8*)(KIMG + (side * 128 + kt * 32 + r) * KPITCH + (ks * 16 + 8 * h) * 2); acc[kt] = MFMA32(kf, qf, acc[kt]); }
            }
            float L[16];
#pragma unroll
            for (int i = 0; i < 16; ++i) L[i] = -3.0e38f;
#pragma unroll
            for (int kt = 0; kt < 4; ++kt)
#pragma unroll
                for (int reg = 0; reg < 16; ++reg) { const unsigned key = (unsigned)(kt * 32 + crow(reg, h)); const float sv = acc[kt][reg];
                    topk_insert(L, __uint_as_float((__float_as_uint(sv) & ~127u) | key)); }
            float P[16];
#pragma unroll
            for (int i = 0; i < 16; ++i) P[i] = __shfl_xor(L[i], 32);
#pragma unroll
            for (int i = 0; i < 16; ++i) topk_insert(L, P[i]);
            if (side == 0) {
#pragma unroll
                for (int i = 0; i < 16; ++i) L1[i] = L[i];
            } else {
#pragma unroll
                for (int i = 0; i < 16; ++i) L2[i] = L[i];
            }
        }
        if (h == 0) {
#pragma unroll
            for (int w = 0; w < 4; ++w) {
                const unsigned a = (__builtin_bit_cast(unsigned, L1[4 * w]) & 127u) | ((__builtin_bit_cast(unsigned, L1[4 * w + 1]) & 127u) << 8) | ((__builtin_bit_cast(unsigned, L1[4 * w + 2]) & 127u) << 16) | ((__builtin_bit_cast(unsigned, L1[4 * w + 3]) & 127u) << 24);
                const unsigned b = (__builtin_bit_cast(unsigned, L2[4 * w]) & 127u) | ((__builtin_bit_cast(unsigned, L2[4 * w + 1]) & 127u) << 8) | ((__builtin_bit_cast(unsigned, L2[4 * w + 2]) & 127u) << 16) | ((__builtin_bit_cast(unsigned, L2[4 * w + 3]) & 127u) << 24);
                *(LAS unsigned*)(TBL + r * 32 + 4 * w) = a; *(LAS unsigned*)(TBL + r * 32 + 16 + 4 * w) = b;
            }
        }
        float T[16];
#pragma unroll
        for (int i = 0; i < 16; ++i) T[i] = -3.0e38f;
#pragma unroll
        for (int i = 0; i < 16; ++i) {
            const float v1 = __builtin_bit_cast(float, __builtin_bit_cast(unsigned, L1[i]) & ~127u);
#pragma unroll
            for (int j = 0; j < 16; ++j) if ((i + 1) * (j + 1) <= 16) {
                const float v2 = __builtin_bit_cast(float, __builtin_bit_cast(unsigned, L2[j]) & ~127u);
                topk_insert(T, __builtin_bit_cast(float, (__builtin_bit_cast(unsigned, v1 + v2) & ~255u) | (unsigned)(i * 16 + j)));
            }
        }
        LDS_WAIT(); asm volatile("" ::: "memory");
        float ev[16], esum = 0.f;
        const float mx = __builtin_bit_cast(float, __builtin_bit_cast(unsigned, T[0]) & ~255u);
#pragma unroll
        for (int i = 0; i < 16; ++i) { ev[i] = __expf(__builtin_bit_cast(float, __builtin_bit_cast(unsigned, T[i]) & ~255u) - mx); esum += ev[i]; }
        const float einv = 1.0f / esum;
        int eid[8]; float gt[8];
#pragma unroll
        for (int i = 0; i < 8; ++i) { const float tv = h ? T[8 + i] : T[i]; const float e = h ? ev[8 + i] : ev[i];
            const unsigned p = __builtin_bit_cast(unsigned, tv) & 255u;
            const unsigned i1 = *(const LAS unsigned char*)(TBL + r * 32 + (p >> 4)), i2 = *(const LAS unsigned char*)(TBL + r * 32 + 16 + (p & 15u));
            eid[i] = (int)(i1 * 128u + i2); gt[i] = e * einv; }
        int* ip = F.IDX + (size_t)t * NSEL + hd * 16 + 8 * h; float* gp = F.PG + (size_t)t * NSEL + hd * 16 + 8 * h;
        *(GAS v4u*)ip = (v4u){(unsigned)eid[0], (unsigned)eid[1], (unsigned)eid[2], (unsigned)eid[3]}; *(GAS v4u*)(ip + 4) = (v4u){(unsigned)eid[4], (unsigned)eid[5], (unsigned)eid[6], (unsigned)eid[7]};
        *(GAS f32x4*)gp = (f32x4){gt[0], gt[1], gt[2], gt[3]}; *(GAS f32x4*)(gp + 4) = (f32x4){gt[4], gt[5], gt[6], gt[7]};
        LDS_WAIT(); asm volatile("" ::: "memory");
    }
}
constexpr int P9_IDX = 131072, P9_SH = 147456, P9_CORR = 147712, P9_GF = 32768, P9_FG = 40960, P9_SSQ = 49152, NSLICE = 16, SLICE_B = 128;
#ifndef NSLICE_A
#define NSLICE_A NSLICE
#endif
#ifndef NSLICE_C
#define NSLICE_C NSLICE
#endif
template <int N, int MASK> DI void red_step_i(int (&v)[8], int lane) {
#pragma unroll
    for (int i = 0; i < N / 2; ++i) { const bool up = (lane & MASK) != 0; const int keep = up ? v[i + N / 2] : v[i], send = up ? v[i] : v[i + N / 2]; v[i] = keep + __shfl_xor(send, MASK); }
}
template <int N, int MASK> DI void red_step_f(float (&v)[16], int lane) {
#pragma unroll
    for (int i = 0; i < N / 2; ++i) { const bool up = (lane & MASK) != 0; const float keep = up ? v[i + N / 2] : v[i], send = up ? v[i] : v[i + N / 2]; v[i] = keep + __shfl_xor(send, MASK); }
}
typedef _Float16 h2v __attribute__((ext_vector_type(2)));
DI void acc4(float& o0, float& o1, float& o2, float& o3, unsigned u, float c) {
    const h2v p = __builtin_bit_cast(h2v, __builtin_amdgcn_perm(u, 0x64646464u, 0x01050004u));
    const h2v q = __builtin_bit_cast(h2v, __builtin_amdgcn_perm(u, 0x64646464u, 0x01070006u));
    o0 = __builtin_fmaf((float)p.x, c, o0); o1 = __builtin_fmaf((float)p.y, c, o1); o2 = __builtin_fmaf((float)q.x, c, o2); o3 = __builtin_fmaf((float)q.y, c, o3);
}
DI void p9v2_phase(Frame& F) {
    LAS unsigned char* HQ = F.lds; LAS float* A2 = (LAS float*)(F.lds + P9_IDX); LAS float* B2 = (LAS float*)(F.lds + P9_IDX + 8192);
    LAS unsigned short* IDX16 = (LAS unsigned short*)(F.lds + P9_IDX); LAS float* SH = (LAS float*)(F.lds + P9_SH); LAS float* CORR = (LAS float*)(F.lds + P9_CORR);
    LAS float* COEF = (LAS float*)F.lds; LAS float* GF = (LAS float*)(F.lds + P9_GF); LAS float* FG = (LAS float*)(F.lds + P9_FG);
    const int lane = F.lane, tid = F.tid, c8 = lane & 7, g = lane >> 3;
#pragma unroll 1
    for (int tb = (int)blockIdx.x * 64; tb < M; tb += F.G * 64) {
#pragma unroll
        for (int i = 0; i < 4; ++i) { const int c = tid + 512 * i; A2[c] = F.norm_ffn_g[c] * (1.0f + F.MODF[MOD_SCF + c]); B2[c] = F.MODF[MOD_SHF + c]; }
        __syncthreads();
#pragma unroll 1
        for (int j = 0; j < 8; ++j) {
            const int tl = F.wave * 8 + j, t = tb + tl;
            float hv[32]; float ss = 0.f;
            const bf16* xr = F.X1B + (size_t)t * D + 16 * lane;
#pragma unroll
            for (int jj = 0; jj < 2; ++jj)
#pragma unroll
                for (int q = 0; q < 2; ++q) { const v4u a = *(const GAS v4u*)(xr + 1024 * jj + 8 * q); const int o = 16 * jj + 8 * q;
                    hv[o] = bflo(a.x); hv[o + 1] = bfhi(a.x); hv[o + 2] = bflo(a.y); hv[o + 3] = bfhi(a.y); hv[o + 4] = bflo(a.z); hv[o + 5] = bfhi(a.z); hv[o + 6] = bflo(a.w); hv[o + 7] = bfhi(a.w); }
#pragma unroll
            for (int i = 0; i < 32; ++i) ss += hv[i] * hv[i];
            const float rstd = 1.0f / sqrtf(wave_sum(ss) * (1.0f / D) + EPS);
            float am = 0.f;
#pragma unroll
            for (int jj = 0; jj < 2; ++jj)
#pragma unroll
                for (int q = 0; q < 4; ++q) { const f32x4 a = *(const LAS f32x4*)(A2 + 1024 * jj + 16 * lane + 4 * q), b = *(const LAS f32x4*)(B2 + 1024 * jj + 16 * lane + 4 * q);
                    const int o = 16 * jj + 4 * q;
                    hv[o] = hv[o] * rstd * a.x + b.x; hv[o + 1] = hv[o + 1] * rstd * a.y + b.y; hv[o + 2] = hv[o + 2] * rstd * a.z + b.z; hv[o + 3] = hv[o + 3] * rstd * a.w + b.w;
                    am = fmaxf(am, fmaxf(fmaxf(fabsf(hv[o]), fabsf(hv[o + 1])), fmaxf(fabsf(hv[o + 2]), fabsf(hv[o + 3])))); }
            am = fmaxf(wave_max(am), 1e-30f); const float inv = 127.0f / am;
            if (lane == 0) SH[tl] = am * (1.0f / 127.0f);
#pragma unroll
            for (int jj = 0; jj < 2; ++jj) { v4u o;
#pragma unroll
                for (int q = 0; q < 4; ++q) { const int b = 16 * jj + 4 * q;
                    const int q0 = (int)__builtin_rintf(hv[b] * inv), q1 = (int)__builtin_rintf(hv[b + 1] * inv), q2 = (int)__builtin_rintf(hv[b + 2] * inv), q3 = (int)__builtin_rintf(hv[b + 3] * inv);
                    o[q] = (unsigned)(q0 & 255) | ((unsigned)(q1 & 255) << 8) | ((unsigned)(q2 & 255) << 16) | ((unsigned)(q3 & 255) << 24); }
                *(LAS v4u*)(HQ + tl * 2048 + 1024 * jj + 16 * lane) = o; }
        }
        __syncthreads();
#pragma unroll
        for (int i = 0; i < 16; ++i) { const int q = tid + 512 * i; IDX16[q] = (unsigned short)F.IDX[(size_t)tb * NSEL + q]; }
        __syncthreads();
        int P[8][2];
#pragma unroll
        for (int j = 0; j < 8; ++j) { P[j][0] = 0; P[j][1] = 0; }
#pragma unroll 1
        for (int s = 0; s < NSLICE_A; ++s) {
            const unsigned char* eb = F.ED + s * SLICE_B;
            const unsigned lo = (unsigned)(c8 * 16);
            v4u wA[8], wB[8];
#define P9A_LOAD(W, J, H) do { _Pragma("unroll") for (int i = 0; i < 8; ++i) { const unsigned e = IDX16[(F.wave * 8 + (J)) * 128 + 64 * (H) + 8 * i + g]; W[i] = *(const GAS v4u*)(eb + (e * 2048u + lo)); } } while (0)
#define P9A_COMP(W, J, H) do { const v4u hq = *(const LAS v4u*)(HQ + (F.wave * 8 + (J)) * 2048 + s * SLICE_B + c8 * 16); int a[8]; \
                _Pragma("unroll") for (int i = 0; i < 8; ++i) { int d = 0; const v4u ww = W[i]; \
                    d = __builtin_amdgcn_sdot4((int)hq.x, (int)ww.x, d, false); d = __builtin_amdgcn_sdot4((int)hq.y, (int)ww.y, d, false); d = __builtin_amdgcn_sdot4((int)hq.z, (int)ww.z, d, false); d = __builtin_amdgcn_sdot4((int)hq.w, (int)ww.w, d, false); a[i] = d; } \
                red_step_i<8, 4>(a, lane); red_step_i<4, 2>(a, lane); red_step_i<2, 1>(a, lane); P[J][H] += a[0]; asm volatile("" ::: "memory"); } while (0)
            P9A_LOAD(wA, 0, 0);
#pragma unroll
            for (int j = 0; j < 8; ++j) {
                P9A_LOAD(wB, j, 1);
                P9A_COMP(wA, j, 0);
                if (j < 7) P9A_LOAD(wA, j + 1, 0);
                P9A_COMP(wB, j, 1);
            }
#undef P9A_LOAD
#undef P9A_COMP
        }
        __syncthreads();
        LAS int* PI = (LAS int*)F.lds;
#pragma unroll
        for (int j = 0; j < 8; ++j) { const int tl = F.wave * 8 + j; PI[tl * 128 + 8 * c8 + g] = P[j][0]; PI[tl * 128 + 64 + 8 * c8 + g] = P[j][1]; }
#pragma unroll
        for (int i = 0; i < 4; ++i) { const int c = tid + 512 * i; GF[c] = F.MODF[MOD_GF + c]; FG[c] = F.final_g[c]; }
        LAS float* SSQL = (LAS float*)(F.lds + P9_SSQ);
#pragma unroll 1
        for (int j = 0; j < 8; ++j) { const int tl = F.wave * 8 + j, t = tb + tl; const float sh = SH[tl]; float sum = 0.f;
#pragma unroll
            for (int h = 0; h < 2; ++h) { const int k = 64 * h + lane; const unsigned e = IDX16[tl * 128 + k];
                const float act = (float)PI[tl * 128 + k] * (sh * F.SD[e]); const float cfv = F.PG[(size_t)t * NSEL + k] * gelu_f(act) * F.SU[e]; COEF[tl * 128 + k] = cfv; sum += cfv; }
            sum = 1152.0f * wave_sum(sum); if (lane == 0) CORR[tl] = sum;     SSQL[tl * 64 + lane] = 0.f; }
        __syncthreads();
        const int cb = c8 * 16 + ((lane >> 5) & 1) * 8 + ((lane >> 4) & 1) * 4 + ((lane >> 3) & 1) * 2;
#pragma unroll 1
        for (int s = 0; s < NSLICE_C; ++s) {
            const unsigned char* eb = F.EU + s * SLICE_B;
            const unsigned lo = (unsigned)(c8 * 16);
            v4u wA[8], wB[8]; float cA[8], cB[8];
#define P9C_LOAD(W, C, TL, H) do { _Pragma("unroll") for (int i = 0; i < 8; ++i) { const unsigned e = IDX16[(TL) * 128 + 64 * (H) + 8 * i + g]; C[i] = COEF[(TL) * 128 + 64 * (H) + 8 * i + g]; W[i] = *(const GAS v4u*)(eb + (e * 2048u + lo)); } } while (0)
#define P9C_ACC(W, C) do { _Pragma("unroll") for (int i = 0; i < 8; ++i) { unsigned ux = W[i].x, uy = W[i].y, uz = W[i].z, uw = W[i].w; const float cc = C[i]; \
                asm volatile("" : "+v"(ux), "+v"(uy), "+v"(uz), "+v"(uw));      \
                acc4(o[0], o[1], o[2], o[3], ux, cc); acc4(o[4], o[5], o[6], o[7], uy, cc); acc4(o[8], o[9], o[10], o[11], uz, cc); acc4(o[12], o[13], o[14], o[15], uw, cc); \
                asm volatile("" : "+v"(o[0]), "+v"(o[1]), "+v"(o[2]), "+v"(o[3]), "+v"(o[4]), "+v"(o[5]), "+v"(o[6]), "+v"(o[7]), "+v"(o[8]), "+v"(o[9]), "+v"(o[10]), "+v"(o[11]), "+v"(o[12]), "+v"(o[13]), "+v"(o[14]), "+v"(o[15])); } \
                asm volatile("" ::: "memory"); } while (0)
            P9C_LOAD(wA, cA, F.wave * 8, 0);
#pragma unroll 1
            for (int j = 0; j < 8; ++j) {
                const int tl = F.wave * 8 + j, t = tb + tl;
                float o[16];
#pragma unroll
                for (int b = 0; b < 16; ++b) o[b] = 0.f;
                P9C_LOAD(wB, cB, tl, 1);
                P9C_ACC(wA, cA);
                if (j < 7) P9C_LOAD(wA, cA, tl + 1, 0);
                P9C_ACC(wB, cB);
                red_step_f<16, 32>(o, lane); red_step_f<8, 16>(o, lane); red_step_f<4, 8>(o, lane);
                const int col = s * SLICE_B + cb; const float corr = CORR[tl];
                GAS unsigned* xp = (GAS unsigned*)(F.X1B + (size_t)t * D + col);
                const unsigned xw = *xp;
                const float y0 = bflo(xw) + GF[col] * (o[0] - corr), y1 = bfhi(xw) + GF[col + 1] * (o[1] - corr);
                const unsigned yw = pk2(y0, y1); const float r0 = bflo(yw), r1 = bfhi(yw);
                SSQL[tl * 64 + lane] += r0 * r0 + r1 * r1;
                *xp = yw;
            }
#undef P9C_LOAD
#undef P9C_ACC
        }
#pragma unroll 1
        for (int j = 0; j < 8; ++j) {
            const int tl = F.wave * 8 + j, t = tb + tl;
            const float rstd2 = 1.0f / sqrtf(wave_sum(SSQL[tl * 64 + lane]) * (1.0f / D) + EPS);
            const GAS v2u* xrow = (const GAS v2u*)(F.X1B + (size_t)t * D) + lane; GAS f32x4* orow = (GAS f32x4*)(F.out + (size_t)t * D) + lane;
#pragma unroll
            for (int q = 0; q < 8; ++q) { const v2u w = xrow[64 * q]; const f32x4 f = *(const LAS f32x4*)(FG + 256 * q + 4 * lane);
                orow[64 * q] = (f32x4){bflo(w.x) * rstd2 * f.x, bfhi(w.x) * rstd2 * f.y, bflo(w.y) * rstd2 * f.z, bfhi(w.y) * rstd2 * f.w}; }
        }
        __syncthreads();
    }
}
struct Args { const float* in[21]; float* out; unsigned char* ws; int ph_lo, ph_hi, li, pad; };
constexpr int N_PHASES = 10;
__global__ void __launch_bounds__(NWAVES * 64, 2) mk_fwd(Args args) {
    extern __shared__ __attribute__((aligned(16))) unsigned char lds[];
    Frame F;
    F.lds = (LAS unsigned char*)lds;
    F.MISC = (volatile LAS unsigned*)(F.lds + MISC_OFF);
    F.tid = threadIdx.x; F.lane = F.tid & 63; F.wave = __builtin_amdgcn_readfirstlane(F.tid >> 6);
    F.G = gridDim.x; { const int bx = blockIdx.x; F.vcu = (F.G % 8 == 0) ? (bx % 8) * (F.G / 8) + bx / 8 : bx; }
    unsigned char* ws = args.ws;
    F.ctl = (gu32*)(ws + WS_CTL);
    F.x = args.in[0]; F.c = args.in[1]; F.ada_w = args.in[2]; F.ada_b = args.in[3]; F.norm_mix_g = args.in[4]; F.w_in = args.in[5]; F.b_gates = args.in[6];
    F.conv_w = args.in[7]; F.conv_b = args.in[8]; F.gmlp_norm_g = args.in[9]; F.gmlp_w = args.in[10]; F.gmlp_b = args.in[11]; F.mlstm_norm_g = args.in[12];
    F.w_out = args.in[13]; F.norm_ffn_g = args.in[14]; F.wq = args.in[15]; F.keys1 = args.in[16]; F.keys2 = args.in[17]; F.e_down = args.in[18]; F.e_up = args.in[19]; F.final_g = args.in[20];
    F.out = args.out;
    F.MODP = (float*)(ws + WS_MODP); F.MODF = (float*)(ws + WS_MODF); F.GATES = (float*)(ws + WS_GATES); F.SUMM = (float*)(ws + WS_SUMM); F.MTAB = (float*)(ws + WS_MTAB);
    F.NST = (float*)(ws + WS_NST); F.PG = (float*)(ws + WS_PG); F.IDX = (int*)(ws + WS_IDX);
    F.WIN = (bf16*)(ws + WS_WIN); F.WOUT = (bf16*)(ws + WS_WOUT); F.WQ = (bf16*)(ws + WS_WQ); F.HA = (bf16*)(ws + WS_HA); F.PROJ = (bf16*)(ws + WS_PROJ); F.QB = (bf16*)(ws + WS_PROJ);
    F.STATE = (bf16*)(ws + WS_STATE); F.VT = (bf16*)(ws + WS_VT); F.ED = ws + WS_ED; F.EU = ws + WS_EU; F.SD = (float*)(ws + WS_SD); F.SU = (float*)(ws + WS_SU);
    F.SSQP = (float*)(ws + WS_SSQP); F.BQP = (float*)(ws + WS_BQP); F.BIASQ = (float*)(ws + WS_BIASQ); F.X1B = (bf16*)(ws + WS_STATE);
    F.QC = (bf16*)args.out; F.KC = (bf16*)args.out + (size_t)M * 1024;
    for (int u = F.tid; u < (LDS_BYTES - LDSCTL_OFF) / 4; u += NWAVES * 64) ((LAS unsigned*)(F.lds + LDSCTL_OFF))[u] = 0u;
    __syncthreads();
    const int lo = args.ph_lo, hi = args.ph_hi;
    const bool multi = (hi - lo) > 1;
    XcdBarrier bar; bar.bar = (unsigned*)(F.ctl + CW_BAR) + args.li * XCD_BAR_WORDS; bar.x = 0; bar.st = nullptr;
    if (multi) bar = xcd_barrier_post((unsigned*)(F.ctl + CW_BAR) + args.li * XCD_BAR_WORDS, F.MISC + 8);
#ifndef PH_MASK
#define PH_MASK 0x7ff
#endif
#define IN(k) (((PH_MASK >> (k)) & 1) && lo <= (k) && (k) < hi)
#define SEAM(k) do { if (IN(k) && IN((k) + 1)) xcd_barrier(bar); } while (0)
    if (IN(0)) { p0a_phase(F); } SEAM(0);
    if (IN(1)) { p0b_phase(F); } SEAM(1);
    if (IN(2)) {
        { pg8::Gemm g{F.HA, F.WIN, M, NPROJ, D}; pg8::StaticOrder S; S.init(M, NPROJ, F.G, (int)blockIdx.x);
          pg8::EpiProj E{F.PROJ, NPROJ, 2048 / 256};
          pg8::gemm_phase<pg8::EpiProj, pg8::StaticOrder, PG8_ALIGN, PG8_SP2>(F.lds, g, S, E); }
        {
          pg8::Gemm g{F.WIN + (size_t)WROW_VM * D, F.HA, 1024, M, D}; pg8::StaticOrder S; S.init(1024, M, F.G, (int)blockIdx.x);
          pg8::EpiBf16<0> E{F.VT, M, nullptr, 0, 0, 1.f};
          pg8::gemm_phase<pg8::EpiBf16<0>, pg8::StaticOrder, PG8_ALIGN, PG8_SP2>(F.lds, g, S, E); }
    } SEAM(2);
    if (IN(3)) { p2_phase(F); } SEAM(3);
    if (IN(4)) { p3_phase(F); } SEAM(4);
    if (IN(5)) { p4_phase(F); } SEAM(5);
    if (IN(6)) {
        pg8::Gemm g{F.HA, F.WOUT, M, D, D}; pg8::StaticOrder S; S.init(M, D, F.G, (int)blockIdx.x);
        pg8::EpiResid2 E{F.x, F.MODF + MOD_GM, F.X1B, F.SSQP, D};
        pg8::gemm_phase<pg8::EpiResid2, pg8::StaticOrder, PG8_ALIGN, PG8_SP2>(F.lds, g, S, E);
    } SEAM(6);
    if (IN(7)) {
        pg8::Gemm g{F.X1B, F.WQ, M, D, D}; pg8::StaticOrder S; S.init(M, D, F.G, (int)blockIdx.x);
        LAS float* RSTDL = (LAS float*)(F.lds + RING_BYTES);
        { pg8::Unit u; for (int i = 0; S.next(i, u); ++i) { if (F.tid < 256) { const float* sp = F.SSQP + (size_t)(u.pm * 256 + F.tid) * 32; float ss = 0.f;
#pragma unroll
                    for (int q = 0; q < 8; ++q) { const f32x4 v = *(const GAS f32x4*)(sp + 4 * q); ss += (v.x + v.y) + (v.z + v.w); }
                    RSTDL[(u.pm & 1) * 256 + F.tid] = 1.0f / sqrtf(ss * (1.0f / D) + EPS); } } }
        __syncthreads();
        pg8::EpiQ E{F.QB, D, F.BIASQ, RSTDL};
        pg8::gemm_phase<pg8::EpiQ, pg8::StaticOrder, PG8_ALIGN, PG8_SP2>(F.lds, g, S, E);
    } SEAM(7);
#ifndef P8_ALT
#define P8_ALT 0
#endif
    if (IN(8)) { p8_phase(F); } SEAM(8);
#ifndef P9_V2
#define P9_V2 1
#endif
    if (IN(9)) { p9v2_phase(F); }
#undef IN
#undef SEAM
}

#ifndef MK_N_LAUNCHES
#define MK_N_LAUNCHES 1
#endif
extern "C" void kernel_launch(void* const* d_in, const int* in_sizes, int n_in, void* d_out, int out_size, void* d_ws, size_t ws_size, hipStream_t stream) {
    static int grid = 0;
    if (grid == 0) {
        if (n_in != 21 || in_sizes[0] != M * D || out_size != M * D || ws_size < WS_END) { fprintf(stderr, "kernel_launch: unexpected shapes (n_in %d, in0 %d, out %d, ws %zu); nothing launched\n", n_in, n_in > 0 ? in_sizes[0] : -1, out_size, ws_size); grid = -1; return; }
        int dev = 0, cus = 0, per_cu = 0;
        if (hipGetDevice(&dev) != hipSuccess || hipDeviceGetAttribute(&cus, hipDeviceAttributeMultiprocessorCount, dev) != hipSuccess) { grid = -1; return; }
        if (hipFuncSetAttribute((const void*)mk_fwd, hipFuncAttributeMaxDynamicSharedMemorySize, LDS_BYTES) != hipSuccess) { fprintf(stderr, "kernel_launch: hipFuncSetAttribute failed\n"); grid = -1; return; }
        if (hipOccupancyMaxActiveBlocksPerMultiprocessor(&per_cu, (const void*)mk_fwd, NWAVES * 64, LDS_BYTES) != hipSuccess || per_cu < 1) { fprintf(stderr, "kernel_launch: occupancy query says %d blocks per CU\n", per_cu); }
        (void)hipGetLastError();
        grid = cus;
    }
    if (grid < 0) return;
    (void)hipMemsetAsync((char*)d_ws + WS_CTL, 0, CTL_ZERO_BYTES, stream);
    Args a{};
    for (int i = 0; i < 21; ++i) a.in[i] = (const float*)d_in[i];
    a.out = (float*)d_out; a.ws = (unsigned char*)d_ws;
    if (MK_N_LAUNCHES == 1) { a.ph_lo = 0; a.ph_hi = N_PHASES; a.li = 0; hipLaunchKernelGGL(mk_fwd, dim3(grid), dim3(NWAVES * 64), LDS_BYTES, stream, a); }
    else for (int li = 0; li < N_PHASES; ++li) { a.ph_lo = li; a.ph_hi = li + 1; a.li = 0; hipLaunchKernelGGL(mk_fwd, dim3(grid), dim3(NWAVES * 64), LDS_BYTES, stream, a); }
}
```

```cpp
#include <hip/hip_runtime.h>
#include <cstdio>
#include <cstdint>
namespace pg8 {
#define PG8_LAS __attribute__((address_space(3)))
typedef unsigned short bf16_t;
typedef short bf16x8 __attribute__((ext_vector_type(8)));
typedef float f32x4 __attribute__((ext_vector_type(4)));
typedef unsigned u32x4 __attribute__((ext_vector_type(4)));
constexpr int BM = 256, BK = 64, HALF = 128, HTB = HALF * BK * 2  , STAGE_BYTES = 8 * HTB, NXCD = 8, WGM = 8;

__host__ __device__ __forceinline__ int lds_byte(int r, int c) { const int st = (r >> 4) * 2 + (c >> 5), rr = r & 15, cc = c & 31, ob = rr * 64 + cc * 2; return st * 1024 + (ob ^ (((ob >> 9) & 1) << 5)); }
__host__ __device__ __forceinline__ void stage_rc(int b, int& R, int& C) { const int st = b / 1024, sb = b % 1024, swz = sb ^ (((sb >> 9) & 1) << 5); R = (st >> 1) * 16 + swz / 64; C = (st & 1) * 32 + (swz % 64) / 2; }
__host__ __device__ __forceinline__ int perm32(int rho) { const int n = rho >> 4, i = rho & 15; return 8 * (i >> 2) + 4 * n + (i & 3); }

struct Unit { int pm, pn; };
struct Gemm { const bf16_t* A; const bf16_t* Bt; int M, N, K; };

struct StaticOrder {
    int nM, nN, nwg, G, c;
    __host__ __device__ void init(int M, int N, int G_, int c_) { nM = M / BM; nN = N / BM; nwg = nM * nN; G = G_; c = c_; }
    __host__ __device__ bool next(int i, Unit& u) const {
        const long L = (long)i * G + c; if (L >= nwg) return false;
        int wgid = (int)L; { const int q = nwg / NXCD, r = nwg % NXCD, xcd = wgid % NXCD, off = wgid / NXCD; wgid = (xcd < r ? xcd * (q + 1) : r * (q + 1) + (xcd - r) * q) + off; }
        const int nig = WGM * nN, gid = wgid / nig, fm = gid * WGM, gsz = (nM - fm) < WGM ? (nM - fm) : WGM;
        u.pm = fm + ((wgid % nig) % gsz); u.pn = (wgid % nig) / gsz; return true;
    }
    __device__ __forceinline__ void a_ready(const Unit&) const {}
    __device__ __forceinline__ void done(const Unit&) const {}
};

__device__ __forceinline__ unsigned cvt_pk_bf16(float lo, float hi) { unsigned r; asm volatile("v_cvt_pk_bf16_f32 %0, %1, %2" : "=v"(r) : "v"(lo), "v"(hi)); return r; }
typedef float f32x2 __attribute__((ext_vector_type(2)));
__device__ __forceinline__ f32x2 gelu_pk(f32x2 v) {
    const f32x2 av = __builtin_elementwise_abs(v), d = av * 0.2316418882f + 1.0f;
    f32x2 t; t.x = __builtin_amdgcn_rcpf(d.x); t.y = __builtin_amdgcn_rcpf(d.y);
    f32x2 q = t * 0.5307027145f + (-0.7265760135f); q = q * t + 0.7107068705f; q = q * t + (-0.142248368f); q = q * t + 0.127414796f; q = q * t;
    const f32x2 s = (v * v) * (-0.72134752044f);
    f32x2 e; e.x = __builtin_amdgcn_exp2f(s.x); e.y = __builtin_amdgcn_exp2f(s.y);
    const f32x2 m = v * (q * e), r = v - m;
    f32x2 o; o.x = v.x < 0.f ? m.x : r.x; o.y = v.y < 0.f ? m.y : r.y; return o;
}

template <int ACT  > struct EpiBf16 {
    static constexpr bool PERM = true, AFTER_DRAIN = false; static_assert(ACT == 0 || ACT == 1, "EpiBf16: ACT is 0 (none) or 1 (gelu_pk)");
    bf16_t* O; int ldc; const float* bias; int split_cols; size_t split_stride; float scale0;
    __device__ __forceinline__ void operator()(const f32x4 (&acc)[2][2][4][2], const Unit& u, int wr, int wc, int fr, int fq) const {
        const int row0 = u.pm * BM + wr * 64 + fr; int colt = u.pn * BM; bf16_t* base = O;
        float sc = 1.f; if (split_cols) { const int t = colt / split_cols; base += (size_t)t * split_stride; colt -= t * split_cols; if (t == 0) sc = scale0; }
        const int col0 = colt + wc * 32 + 8 * fq, bcol0 = u.pn * BM + wc * 32 + 8 * fq;
        f32x4 bv[2][2];
#pragma unroll
        for (int bj = 0; bj < 2; ++bj)
#pragma unroll
            for (int n = 0; n < 2; ++n) bv[bj][n] = bias ? *(const f32x4*)(bias + bcol0 + bj * HALF + 4 * n) : (f32x4){0.f, 0.f, 0.f, 0.f};
#pragma unroll
        for (int ai = 0; ai < 2; ++ai)
#pragma unroll
            for (int m = 0; m < 4; ++m) { bf16_t* rowp = base + (size_t)(row0 + ai * HALF + m * 16) * ldc + col0;
#pragma unroll
                for (int bj = 0; bj < 2; ++bj) { f32x4 v0 = acc[ai][bj][m][0] + bv[bj][0], v1 = acc[ai][bj][m][1] + bv[bj][1];
                    if (ACT == 1) { f32x2 a = gelu_pk((f32x2){v0[0], v0[1]}), b = gelu_pk((f32x2){v0[2], v0[3]}), c = gelu_pk((f32x2){v1[0], v1[1]}), d = gelu_pk((f32x2){v1[2], v1[3]});
                        v0 = (f32x4){a.x, a.y, b.x, b.y}; v1 = (f32x4){c.x, c.y, d.x, d.y}; }
                    v0 = v0 * sc; v1 = v1 * sc; u32x4 w; w.x = cvt_pk_bf16(v0[0], v0[1]); w.y = cvt_pk_bf16(v0[2], v0[3]); w.z = cvt_pk_bf16(v1[0], v1[1]); w.w = cvt_pk_bf16(v1[2], v1[3]);
                    *(u32x4*)(rowp + bj * HALF) = w; } }
    }
};

template <class Epi, class Sched, bool ALIGN_EPI = false, bool SP2 = false>
__device__ __forceinline__ void gemm_phase(PG8_LAS unsigned char* lds, const Gemm g, const Sched& S, const Epi& E) {
    const int tid = threadIdx.x, wid = __builtin_amdgcn_readfirstlane(tid >> 6), lane = tid & 63, wr = wid >> 2, wc = wid & 3, fr = lane & 15, fq = lane >> 4;
    const int K = g.K, nt = K / BK;
    unsigned voffA[2], voffB[2];
#pragma unroll
    for (int i = 0; i < 2; ++i) { int R, C; stage_rc(tid * 16 + i * 8192, R, C); const int Rb = Epi::PERM ? ((R & ~31) + perm32(R & 31)) : R;
        voffA[i] = (unsigned)(R * K + C) * 2u; voffB[i] = (unsigned)(Rb * K + C) * 2u; }
    const size_t kstep = (size_t)(BK * 2);
    const size_t hstep = (size_t)HALF * K * 2;
    const size_t tstep = 2 * hstep;
    const unsigned ldsw = (unsigned)wid * 1024u;
    const int aoff = lds_byte(wr * 64 + fr, fq * 8), boff = lds_byte(wc * 32 + fr, fq * 8);
#define PG8_SA(b, h) (((b) * 2 + (h)) * HTB)
#define PG8_SB(b, h) ((4 + (b) * 2 + (h)) * HTB)
#define PG8_STAGE(bufoff, gbase, voff) do { _Pragma("unroll") for (int _i = 0; _i < 2; ++_i) \
        __builtin_amdgcn_global_load_lds((const unsigned*)((const char*)(gbase) + (voff)[_i]), (PG8_LAS unsigned*)(lds + (bufoff) + ldsw + _i * 8192), 16, 0, 0); } while (0)
#define PG8_LDA(dst, b, h) do { _Pragma("unroll") for (int m = 0; m < 4; ++m) _Pragma("unroll") for (int k = 0; k < 2; ++k) dst[m][k] = *(const PG8_LAS bf16x8*)(lds + PG8_SA(b, h) + aoff + m * 2048 + k * 1024); } while (0)
#define PG8_LDB(dst, b, h) do { _Pragma("unroll") for (int n = 0; n < 2; ++n) _Pragma("unroll") for (int k = 0; k < 2; ++k) dst[n][k] = *(const PG8_LAS bf16x8*)(lds + PG8_SB(b, h) + boff + n * 2048 + k * 1024); } while (0)
#define PG8_MMA(ai, bj, At, Bt) do { __builtin_amdgcn_s_setprio(1); _Pragma("unroll") for (int m = 0; m < 4; ++m) _Pragma("unroll") for (int n = 0; n < 2; ++n) _Pragma("unroll") for (int k = 0; k < 2; ++k) \
        acc[ai][bj][m][n] = __builtin_amdgcn_mfma_f32_16x16x32_bf16(Bt[n][k], At[m][k], acc[ai][bj][m][n], 0, 0, 0); __builtin_amdgcn_s_setprio(0); } while (0)
#define PG8_WAIT_V(n) asm volatile("s_waitcnt vmcnt(" #n ")" ::: "memory")
#define PG8_WAIT_L(n) asm volatile("s_waitcnt lgkmcnt(" #n ")" ::: "memory")
#define PG8_BAR __builtin_amdgcn_s_barrier()
#define PG8_SCHED __builtin_amdgcn_sched_barrier(0)
    Unit cur, nxt; int ui = 0;
    if (!S.next(0, cur)) return;
    f32x4 acc[2][2][4][2];
#pragma unroll
    for (int a = 0; a < 2; ++a)
#pragma unroll
        for (int b = 0; b < 2; ++b)
#pragma unroll
            for (int m = 0; m < 4; ++m)
#pragma unroll
                for (int n = 0; n < 2; ++n) acc[a][b][m][n] = (f32x4){0.f, 0.f, 0.f, 0.f};
    bf16x8 At[4][2], B0[2][2], B1[2][2];
    const char* cA = (const char*)g.A + (size_t)cur.pm * tstep; const char* cB = (const char*)g.Bt + (size_t)cur.pn * tstep;
    S.a_ready(cur);
    if constexpr (SP2) {
        PG8_STAGE(PG8_SB(0, 0), cB, voffB); PG8_STAGE(PG8_SB(0, 1), cB + hstep, voffB); PG8_STAGE(PG8_SA(0, 0), cA, voffA); PG8_STAGE(PG8_SA(0, 1), cA + hstep, voffA);
        if (wr == 1) PG8_BAR;
        PG8_WAIT_V(2); PG8_BAR;
        PG8_STAGE(PG8_SB(1, 0), cB + kstep, voffB); PG8_STAGE(PG8_SA(1, 0), cA + kstep, voffA); PG8_STAGE(PG8_SB(1, 1), cB + hstep + kstep, voffB);
        PG8_WAIT_V(6); PG8_BAR;
    } else {
        PG8_STAGE(PG8_SB(0, 0), cB, voffB); PG8_STAGE(PG8_SA(0, 0), cA, voffA); PG8_STAGE(PG8_SB(0, 1), cB + hstep, voffB); PG8_STAGE(PG8_SA(0, 1), cA + hstep, voffA);
        if (wr == 1) PG8_BAR;
        PG8_WAIT_V(4); PG8_BAR;
        PG8_STAGE(PG8_SB(1, 0), cB + kstep, voffB); PG8_STAGE(PG8_SA(1, 0), cA + kstep, voffA); PG8_STAGE(PG8_SB(1, 1), cB + hstep + kstep, voffB);
        PG8_WAIT_V(6); PG8_BAR;
    }
    for (;;) {
        const bool has_next = S.next(ui + 1, nxt);
        const char* nA = has_next ? (const char*)g.A + (size_t)nxt.pm * tstep : cA; const char* nB = has_next ? (const char*)g.Bt + (size_t)nxt.pn * tstep : cB;
        for (int t = 0; t < nt; t += 2) {
            const bool last = (t == nt - 2);
            const char* a1 = cA + (size_t)(t + 1) * kstep;
            const char* a2 = last ? nA : cA + (size_t)(t + 2) * kstep; const char* b2 = last ? nB : cB + (size_t)(t + 2) * kstep;
            const char* a3 = a2 + kstep; const char* b3 = b2 + kstep;
            if (last && has_next) S.a_ready(nxt);
            if constexpr (SP2) {
            PG8_LDB(B0, 0, 0); PG8_LDB(B1, 0, 1); PG8_SCHED; PG8_LDA(At, 0, 0); PG8_STAGE(PG8_SA(1, 1), a1 + hstep, voffA);
            PG8_WAIT_V(8); PG8_WAIT_L(0); PG8_BAR; PG8_MMA(0, 0, At, B0); PG8_MMA(0, 1, At, B1); PG8_BAR; PG8_SCHED;
            PG8_LDA(At, 0, 1); PG8_STAGE(PG8_SB(0, 0), b2, voffB); PG8_STAGE(PG8_SB(0, 1), b2 + hstep, voffB); PG8_STAGE(PG8_SA(0, 0), a2, voffA);
            PG8_WAIT_V(8); PG8_WAIT_L(0); PG8_BAR; PG8_MMA(1, 0, At, B0); PG8_MMA(1, 1, At, B1); PG8_BAR; PG8_SCHED;
            PG8_LDB(B0, 1, 0); PG8_LDB(B1, 1, 1); PG8_SCHED; PG8_LDA(At, 1, 0); PG8_STAGE(PG8_SA(0, 1), a2 + hstep, voffA);
            PG8_WAIT_V(8); PG8_WAIT_L(0); PG8_BAR; PG8_MMA(0, 0, At, B0); PG8_MMA(0, 1, At, B1); PG8_BAR; PG8_SCHED;
            PG8_LDA(At, 1, 1); PG8_STAGE(PG8_SB(1, 0), b3, voffB); PG8_STAGE(PG8_SB(1, 1), b3 + hstep, voffB); PG8_STAGE(PG8_SA(1, 0), a3, voffA);
            PG8_WAIT_V(8); PG8_WAIT_L(0); PG8_BAR; PG8_MMA(1, 0, At, B0); PG8_MMA(1, 1, At, B1); PG8_BAR; PG8_SCHED;
            } else {
            PG8_LDB(B0, 0, 0); PG8_SCHED; PG8_LDA(At, 0, 0); PG8_STAGE(PG8_SA(1, 1), a1 + hstep, voffA);
            PG8_WAIT_L(8); PG8_BAR; PG8_WAIT_L(0); PG8_MMA(0, 0, At, B0); PG8_BAR; PG8_SCHED;
            PG8_LDB(B1, 0, 1); PG8_STAGE(PG8_SB(0, 0), b2, voffB);
            PG8_BAR; PG8_WAIT_L(0); PG8_MMA(0, 1, At, B1); PG8_BAR;
            PG8_LDA(At, 0, 1); PG8_STAGE(PG8_SA(0, 0), a2, voffA);
            PG8_BAR; PG8_WAIT_L(0); PG8_MMA(1, 0, At, B0); PG8_BAR; PG8_SCHED;
            PG8_STAGE(PG8_SB(0, 1), b2 + hstep, voffB);
            PG8_WAIT_V(6); PG8_BAR; PG8_MMA(1, 1, At, B1); PG8_BAR;
            PG8_LDB(B0, 1, 0); PG8_SCHED; PG8_LDA(At, 1, 0); PG8_STAGE(PG8_SA(0, 1), a2 + hstep, voffA);
            PG8_WAIT_L(8); PG8_BAR; PG8_WAIT_L(0); PG8_MMA(0, 0, At, B0); PG8_BAR; PG8_SCHED;
            PG8_LDB(B1, 1, 1); PG8_STAGE(PG8_SB(1, 0), b3, voffB);
            PG8_BAR; PG8_WAIT_L(0); PG8_MMA(0, 1, At, B1); PG8_BAR;
            PG8_LDA(At, 1, 1); PG8_STAGE(PG8_SA(1, 0), a3, voffA);
            PG8_BAR; PG8_WAIT_L(0); PG8_MMA(1, 0, At, B0); PG8_BAR; PG8_SCHED;
            PG8_STAGE(PG8_SB(1, 1), b3 + hstep, voffB);
            PG8_WAIT_V(6); PG8_BAR; PG8_MMA(1, 1, At, B1); PG8_BAR;
            }
        }
        if constexpr (ALIGN_EPI) { if (wr == 0) PG8_BAR; }
        if constexpr (!Epi::AFTER_DRAIN) { E(acc, cur, wr, wc, fr, fq); S.done(cur); }
        if (!has_next) break;
#pragma unroll
        for (int a = 0; a < 2; ++a)
#pragma unroll
            for (int b = 0; b < 2; ++b)
#pragma unroll
                for (int m = 0; m < 4; ++m)
#pragma unroll
                    for (int n = 0; n < 2; ++n) acc[a][b][m][n] = (f32x4){0.f, 0.f, 0.f, 0.f};
        cur = nxt; cA = nA; cB = nB; ++ui;
        if constexpr (ALIGN_EPI) { if (wr == 1) PG8_BAR; }
    }
    PG8_WAIT_V(0);
    if constexpr (!ALIGN_EPI) { if (wr == 0) PG8_BAR; }
    PG8_BAR;
    if constexpr (Epi::AFTER_DRAIN) { E.fused(acc, cur, wr, wc, fr, fq, lds, wid, lane); S.done(cur); }
#undef PG8_SA
#undef PG8_SB
#undef PG8_STAGE
#undef PG8_LDA
#undef PG8_LDB
#undef PG8_MMA
#undef PG8_WAIT_V
#undef PG8_WAIT_L
#undef PG8_BAR
#undef PG8_SCHED
}
}
namespace pg8 {
struct EpiProj {
    static constexpr bool PERM = true, AFTER_DRAIN = false;
    bf16_t* O; int ldc; int gelu_tiles;
    __device__ __forceinline__ void operator()(const f32x4 (&acc)[2][2][4][2], const Unit& u, int wr, int wc, int fr, int fq) const {
        const int row0 = u.pm * BM + wr * 64 + fr; const int col0 = u.pn * BM + wc * 32 + 8 * fq;
        const bool act = u.pn < gelu_tiles;
#pragma unroll
        for (int ai = 0; ai < 2; ++ai)
#pragma unroll
            for (int m = 0; m < 4; ++m) { bf16_t* rowp = O + (size_t)(row0 + ai * HALF + m * 16) * ldc + col0;
#pragma unroll
                for (int bj = 0; bj < 2; ++bj) { f32x4 v0 = acc[ai][bj][m][0], v1 = acc[ai][bj][m][1];
                    if (act) { f32x2 a = gelu_pk((f32x2){v0[0], v0[1]}), b = gelu_pk((f32x2){v0[2], v0[3]}), c = gelu_pk((f32x2){v1[0], v1[1]}), d = gelu_pk((f32x2){v1[2], v1[3]});
                        v0 = (f32x4){a.x, a.y, b.x, b.y}; v1 = (f32x4){c.x, c.y, d.x, d.y}; }
                    u32x4 w; w.x = cvt_pk_bf16(v0[0], v0[1]); w.y = cvt_pk_bf16(v0[2], v0[3]); w.z = cvt_pk_bf16(v1[0], v1[1]); w.w = cvt_pk_bf16(v1[2], v1[3]);
                    *(u32x4*)(rowp + bj * HALF) = w; } }
    }
};
struct EpiResid {
    static constexpr bool PERM = false, AFTER_DRAIN = false;
    const float* base; const float* gate; float* out; int ldc;
    __device__ __forceinline__ void operator()(const f32x4 (&acc)[2][2][4][2], const Unit& u, int wr, int wc, int fr, int fq) const {
        const int row0 = u.pm * BM + wr * 64 + fr, col0 = u.pn * BM + wc * 32 + 4 * fq;
        f32x4 gv[2][2];
#pragma unroll
        for (int bj = 0; bj < 2; ++bj)
#pragma unroll
            for (int n = 0; n < 2; ++n) gv[bj][n] = *(const f32x4*)(gate + col0 + bj * HALF + n * 16);
#pragma unroll
        for (int ai = 0; ai < 2; ++ai)
#pragma unroll
            for (int m = 0; m < 4; ++m) { const size_t off = (size_t)(row0 + ai * HALF + m * 16) * ldc + col0;
#pragma unroll
                for (int bj = 0; bj < 2; ++bj)
#pragma unroll
                    for (int n = 0; n < 2; ++n) { const f32x4 b = *(const f32x4*)(base + off + bj * HALF + n * 16); *(f32x4*)(out + off + bj * HALF + n * 16) = b + gv[bj][n] * acc[ai][bj][m][n]; } }
    }
};
struct EpiResid2 {
    static constexpr bool PERM = true, AFTER_DRAIN = false;
    const float* base; const float* gate; bf16_t* xb; float* ssq; int ldc;
    __device__ __forceinline__ void operator()(const f32x4 (&acc)[2][2][4][2], const Unit& u, int wr, int wc, int fr, int fq) const {
        const int row0 = u.pm * BM + wr * 64 + fr, col0 = u.pn * BM + wc * 32 + 8 * fq;
        f32x4 gv[2][2];
#pragma unroll
        for (int bj = 0; bj < 2; ++bj)
#pragma unroll
            for (int n = 0; n < 2; ++n) gv[bj][n] = *(const f32x4*)(gate + col0 + bj * HALF + 4 * n);
#pragma unroll
        for (int ai = 0; ai < 2; ++ai)
#pragma unroll
            for (int m = 0; m < 4; ++m) { const int row = row0 + ai * HALF + m * 16; const size_t off = (size_t)row * ldc + col0; float ss = 0.f;
#pragma unroll
                for (int bj = 0; bj < 2; ++bj) {
                    const f32x4 b0 = *(const f32x4*)(base + off + bj * HALF), b1 = *(const f32x4*)(base + off + bj * HALF + 4);
                    const f32x4 v0 = b0 + gv[bj][0] * acc[ai][bj][m][0], v1 = b1 + gv[bj][1] * acc[ai][bj][m][1];
                    ss += (v0[0] * v0[0] + v0[1] * v0[1]) + (v0[2] * v0[2] + v0[3] * v0[3]) + (v1[0] * v1[0] + v1[1] * v1[1]) + (v1[2] * v1[2] + v1[3] * v1[3]);
                    u32x4 w; w.x = cvt_pk_bf16(v0[0], v0[1]); w.y = cvt_pk_bf16(v0[2], v0[3]); w.z = cvt_pk_bf16(v1[0], v1[1]); w.w = cvt_pk_bf16(v1[2], v1[3]);
                    *(u32x4*)(xb + off + bj * HALF) = w; }
                ss += __shfl_xor(ss, 16); ss += __shfl_xor(ss, 32);
                if (fq == 0) ssq[(size_t)row * 32 + u.pn * 4 + wc] = ss; }
    }
};
struct EpiQ {
    static constexpr bool PERM = true, AFTER_DRAIN = false;
    bf16_t* O; int ldc; const float* bias; const PG8_LAS float* rstd;
    __device__ __forceinline__ void operator()(const f32x4 (&acc)[2][2][4][2], const Unit& u, int wr, int wc, int fr, int fq) const {
        const int lrow0 = wr * 64 + fr, col0 = u.pn * BM + wc * 32 + 8 * fq;
        f32x4 bv[2][2];
#pragma unroll
        for (int bj = 0; bj < 2; ++bj)
#pragma unroll
            for (int n = 0; n < 2; ++n) bv[bj][n] = *(const f32x4*)(bias + col0 + bj * HALF + 4 * n);
#pragma unroll
        for (int ai = 0; ai < 2; ++ai)
#pragma unroll
            for (int m = 0; m < 4; ++m) { const int lrow = lrow0 + ai * HALF + m * 16; const float rs = rstd[(u.pm & 1) * BM + lrow];
                bf16_t* rowp = O + (size_t)(u.pm * BM + lrow) * ldc + col0;
#pragma unroll
                for (int bj = 0; bj < 2; ++bj) { const f32x4 v0 = acc[ai][bj][m][0] * rs + bv[bj][0], v1 = acc[ai][bj][m][1] * rs + bv[bj][1];
                    u32x4 w; w.x = cvt_pk_bf16(v0[0], v0[1]); w.y = cvt_pk_bf16(v0[2], v0[3]); w.z = cvt_pk_bf16(v1[0], v1[1]); w.w = cvt_pk_bf16(v1[2], v1[3]);
                    *(u32x4*)(rowp + bj * HALF) = w; } }
    }
};
}
#ifndef PG8_SP2
#define PG8_SP2 true
#endif
#ifndef PG8_ALIGN
#define PG8_ALIGN true
#endif
constexpr int NWAVES = 8;
constexpr int M = 16384, D = 2048;
constexpr int IN_COLS = 6152, NWIN = 6144, NPROJ = 5120;
constexpr int C_UG = 0, C_VG = 1024, C_Q = 2048, C_K = 3072, C_OM = 4096;
constexpr int WROW_VM = 5120;
constexpr int NHEAD = 4, DH = 256, CH = 128, NCHUNK = M / CH;
constexpr int NEXP = 16384, PH = 8, TOPK = 16, NSEL = PH * TOPK;
constexpr float EPS = 1e-6f;
constexpr int MOD_SHM = 0, MOD_SCM = 2048, MOD_GM = 4096, MOD_SHF = 6144, MOD_SCF = 8192, MOD_GF = 10240, NMOD = 12288;
constexpr int ADA_KC = 16, ADA_KROWS = D / ADA_KC;

constexpr size_t MiB = 1u << 20;
constexpr size_t WS_CTL = 0, CTL_ZERO_BYTES = 1 * MiB;
constexpr size_t WS_MODP = 1 * MiB;
constexpr size_t WS_MODF = WS_MODP + (size_t)ADA_KC * NMOD * 4;
constexpr size_t WS_GATES = 2 * MiB;
constexpr size_t WS_SUMM = 2 * MiB + 512 * 1024;
constexpr size_t WS_MTAB = WS_SUMM + 8192;
constexpr size_t WS_NST = 3 * MiB;
constexpr size_t WS_WIN = 4 * MiB;
constexpr size_t WS_WOUT = 28 * MiB;
constexpr size_t WS_WQ = 36 * MiB;
constexpr size_t WS_IDX = 44 * MiB;
constexpr size_t WS_PG = 52 * MiB;
constexpr size_t WS_SSQP = 60 * MiB;
constexpr size_t WS_BQP = 62 * MiB, WS_BIASQ = 62 * MiB + 512 * 1024;
constexpr size_t WS_HA = 64 * MiB;
constexpr size_t WS_PROJ = 128 * MiB;
constexpr size_t WS_VT = 288 * MiB;
constexpr size_t WS_X1 = 192 * MiB;
constexpr size_t WS_STATE = 320 * MiB;
constexpr size_t WS_ED = 384 * MiB, WS_EU = 416 * MiB;
constexpr size_t WS_SD = 3 * MiB + 512 * 1024, WS_SU = WS_SD + 65536;
constexpr size_t WS_END = 512 * MiB;
constexpr int CW_TMO = 0, CW_CODE = 1, CW_BAR = 4096;

constexpr int RING_BYTES = 131072, LDSCTL_OFF = 163328, MISC_OFF = LDSCTL_OFF + 320, LDS_BYTES = 163840;

#define GAS __attribute__((address_space(1)))
#define LAS __attribute__((address_space(3)))
#define DI __device__ __forceinline__
typedef unsigned short bf16;
typedef unsigned v4u __attribute__((ext_vector_type(4)));
typedef unsigned v2u __attribute__((ext_vector_type(2)));
typedef float f32x4 __attribute__((ext_vector_type(4)));
typedef float f32x16 __attribute__((ext_vector_type(16)));
typedef short bf16x8 __attribute__((ext_vector_type(8)));
typedef GAS unsigned gu32;
#define RLX_AGENT __ATOMIC_RELAXED, __HIP_MEMORY_SCOPE_AGENT
#define LDS_WAIT() asm volatile("s_waitcnt lgkmcnt(0)" ::: "memory")
#define VM_WAIT() asm volatile("s_waitcnt vmcnt(0)" ::: "memory")
#define MFMA32(a, b, c) __builtin_amdgcn_mfma_f32_32x32x16_bf16((a), (b), (c), 0, 0, 0)
DI unsigned f2bf(float f) { unsigned u = __builtin_bit_cast(unsigned, f); return (u + 0x7fffu + ((u >> 16) & 1u)) >> 16; }
DI unsigned pk2(float lo, float hi) { return f2bf(lo) | (f2bf(hi) << 16); }
DI float bflo(unsigned w) { return __builtin_bit_cast(float, w << 16); }
DI float bfhi(unsigned w) { return __builtin_bit_cast(float, w & 0xffff0000u); }
DI float bf2f(unsigned short h) { return __builtin_bit_cast(float, (unsigned)h << 16); }
DI int crow(int reg, int h) { return (reg & 3) + 8 * (reg >> 2) + 4 * h; }
DI float wave_sum(float v) {
#pragma unroll
    for (int o = 1; o < 64; o <<= 1) v += __shfl_xor(v, o);
    return v;
}
DI float wave_max(float v) {
#pragma unroll
    for (int o = 1; o < 64; o <<= 1) v = fmaxf(v, __shfl_xor(v, o));
    return v;
}
DI float silu_f(float v) { return v / (1.0f + __expf(-v)); }
DI float sigmoid_f(float v) { return 1.0f / (1.0f + __expf(-v)); }
DI float gelu_f(float v) { return 0.5f * v * (1.0f + erff(v * 0.70710678118654752f)); }
typedef __bf16 bf16v2 __attribute__((ext_vector_type(2)));
#define DOT2(a, b, c) __builtin_amdgcn_fdot2_f32_bf16(__builtin_bit_cast(bf16v2, (unsigned)(a)), __builtin_bit_cast(bf16v2, (unsigned)(b)), (c), false)
DI f32x16 zero16() { f32x16 z; for (int i = 0; i < 16; ++i) z[i] = 0.f; return z; }
#define XB_TMO      128
#define XB_XCNT(j)  (256  + 64 * (j))
#define XB_XSUB(j)  (1280 + 64 * (j))
#define XB_XGEN(j)  (2304 + 64 * (j))
#define XB_TOP      3328
#define XB_TOPGEN   3392
#define XCD_BAR_WORDS 3456
#define XB_SPIN_CAP (1u << 18)

__device__ __forceinline__ unsigned xb_ld(unsigned* p)              { return __hip_atomic_load(p, __ATOMIC_RELAXED, __HIP_MEMORY_SCOPE_AGENT); }
__device__ __forceinline__ unsigned xb_add(unsigned* p, unsigned v) { return __hip_atomic_fetch_add(p, v, __ATOMIC_RELAXED, __HIP_MEMORY_SCOPE_AGENT); }
__device__ __forceinline__ unsigned xb_xcc_id() { return (unsigned)__builtin_amdgcn_s_getreg((3 << 11) | 20) & 0xFu; }
#define XB_SPIN(cond, bar) do { unsigned _sp = 0; while (cond) { __builtin_amdgcn_s_sleep(1); \
    if ((++_sp & 255u) == 0u) { if (xb_ld(&(bar)[XB_TMO])) break; if (_sp > XB_SPIN_CAP) { atomicAdd(&(bar)[XB_TMO], 1u); break; } } } } while (0)

struct XcdBarrier {
    unsigned* bar; unsigned x;
    volatile LAS unsigned* st;
};

__device__ __forceinline__ XcdBarrier xcd_barrier_post(unsigned* bar, volatile LAS unsigned* st) {
    XcdBarrier b; b.bar = bar; b.x = xb_xcc_id(); b.st = st;
    if (threadIdx.x == 0) (void)xb_add(&bar[XB_XCNT(b.x)], 1u);
    return b;
}
__device__ __forceinline__ void xcd_barrier_complete(unsigned* bar, unsigned x, unsigned& nloc, unsigned& nx) {
    const unsigned G = gridDim.x * gridDim.y * gridDim.z;
    unsigned sum, cnt, mine, sp = 0u;
    for (;;) {
        sum = 0u; cnt = 0u; mine = 0u;
#pragma unroll
        for (unsigned j = 0; j < 16; ++j) { const unsigned c = xb_ld(&bar[XB_XCNT(j)]); sum += c; cnt += (c > 0u) ? 1u : 0u; mine = (j == x) ? c : mine; }
        if (sum == G) break;
        __builtin_amdgcn_s_sleep(1);
        if ((++sp & 255u) == 0u) { if (xb_ld(&bar[XB_TMO])) break; if (sp > XB_SPIN_CAP) { atomicAdd(&bar[XB_TMO], 1u); break; } }
    }
    nloc = mine > 0u ? mine : 1u; nx = cnt > 0u ? cnt : 1u;
}

__device__ __forceinline__ void xcd_barrier(const XcdBarrier& b) {
    asm volatile("s_waitcnt vmcnt(0)" ::: "memory");
    __syncthreads();
    if (threadIdx.x == 0) {
        unsigned* bar = b.bar;
        __builtin_amdgcn_s_waitcnt(0);
        unsigned nloc = b.st[0], nx = b.st[1];
        if (nloc == 0u) { xcd_barrier_complete(bar, b.x, nloc, nx); b.st[0] = nloc; b.st[1] = nx; }
        const unsigned old = xb_add(&bar[XB_XSUB(b.x)], 1u);
        const unsigned gen = old / nloc;
        if (old + 1u == (gen + 1u) * nloc) {
            __builtin_amdgcn_fence(__ATOMIC_RELEASE, "agent");
            asm volatile("s_waitcnt vmcnt(0)" ::: "memory");
            const unsigned og = xb_add(&bar[XB_TOP], 1u);
            const unsigned tg = og / nx;
            if (og + 1u == (tg + 1u) * nx) xb_add(&bar[XB_TOPGEN], 1u);
            else XB_SPIN(xb_ld(&bar[XB_TOPGEN]) == tg, bar);
            __builtin_amdgcn_fence(__ATOMIC_ACQUIRE, "agent");
            xb_add(&bar[XB_XGEN(b.x)], 1u);
            asm volatile("s_waitcnt vmcnt(0)" ::: "memory");
        } else {
            XB_SPIN(xb_ld(&bar[XB_XGEN(b.x)]) == gen, bar);
            __builtin_amdgcn_fence(__ATOMIC_ACQUIRE, "agent");
            asm volatile("s_waitcnt vmcnt(0)" ::: "memory");
        }
    }
    __syncthreads();
}
struct Frame {
    LAS unsigned char* lds;
    volatile LAS unsigned* MISC;
    gu32* ctl;
    int tid, lane, wave, vcu, G;
    const float *x, *c, *ada_w, *ada_b, *norm_mix_g, *w_in, *b_gates, *conv_w, *conv_b, *gmlp_norm_g, *gmlp_w, *gmlp_b, *mlstm_norm_g, *w_out, *norm_ffn_g,
                *wq, *keys1, *keys2, *e_down, *e_up, *final_g;
    float* out;
    float *MODP, *MODF, *GATES, *SUMM, *MTAB, *NST, *PG;
    int* IDX;
    bf16 *WIN, *WOUT, *WQ, *HA, *PROJ, *QB, *STATE, *QC, *KC, *VT;
    unsigned char *ED, *EU; float *SD, *SU;
    float *SSQP, *BQP, *BIASQ; bf16* X1B;
};

DI void p0_transpose_item(const float* W, int K, int ldw, int nblk, bf16* WT, LAS float* scr, int item, int lane, bool vm_last = false) {
    const int kb = item / nblk, nb = item % nblk, k0 = 64 * kb, n0 = 32 * nb;
    const int d0 = !vm_last ? n0 : (n0 < 4096 ? n0 : (n0 < 5120 ? n0 + 1024 : n0 - 1024));
#pragma unroll 8
    for (int i = 0; i < 32; ++i) { const int kk = 2 * i + (lane >> 5); scr[kk * 33 + (lane & 31)] = W[(size_t)(k0 + kk) * ldw + n0 + (lane & 31)]; }
    LDS_WAIT(); asm volatile("" ::: "memory");
    const int c = lane & 7;
#pragma unroll
    for (int j = 0; j < 4; ++j) { const int n = (lane >> 3) + 8 * j; const LAS float* s = scr + (8 * c) * 33 + n;
        v4u o; o.x = pk2(s[0 * 33], s[1 * 33]); o.y = pk2(s[2 * 33], s[3 * 33]); o.z = pk2(s[4 * 33], s[5 * 33]); o.w = pk2(s[6 * 33], s[7 * 33]);
        *(GAS v4u*)(WT + (size_t)(d0 + n) * K + k0 + 8 * c) = o; }
    LDS_WAIT(); asm volatile("" ::: "memory");
}
DI void p0_ada_item(Frame& F, LAS float* scr, int item) {
    const int cc = item % (NMOD / 256), kc = item / (NMOD / 256), k0 = kc * ADA_KROWS, col = cc * 256 + F.lane * 4;
#pragma unroll
    for (int j = 0; j < ADA_KROWS / 64; ++j) scr[F.lane + 64 * j] = silu_f(F.c[k0 + F.lane + 64 * j]);
    LDS_WAIT(); asm volatile("" ::: "memory");
    f32x4 acc = {0.f, 0.f, 0.f, 0.f};
    const float* wp = F.ada_w + (size_t)k0 * NMOD + col;
#pragma unroll 8
    for (int kk = 0; kk < ADA_KROWS; ++kk) { const float s = scr[kk]; const f32x4 w = *(const GAS f32x4*)(wp + (size_t)kk * NMOD); acc += w * s; }
    *(GAS f32x4*)(F.MODP + (size_t)kc * NMOD + col) = acc;
    LDS_WAIT(); asm volatile("" ::: "memory");
}
DI void p0a_phase(Frame& F) {
    LAS float* scr = (LAS float*)(F.lds + F.wave * 16384);
    const int gw = F.wave * F.G + F.vcu, NGW = F.G * NWAVES;
    constexpr int I_ADA = (NMOD / 256) * ADA_KC;
    constexpr int I_WIN = (D / 64) * (NWIN / 32), I_WO = (D / 64) * (D / 32);
    constexpr int NITEMS = I_ADA + I_WIN + I_WO;
    for (int it = gw; it < NITEMS; it += NGW) {
        int r = it;
        if (r < I_ADA) { p0_ada_item(F, scr, r); continue; } r -= I_ADA;
        if (r < I_WIN) { p0_transpose_item(F.w_in, D, IN_COLS, NWIN / 32, F.WIN, scr, r, F.lane, true); continue; } r -= I_WIN;
        p0_transpose_item(F.w_out, D, D, D / 32, F.WOUT, scr, r, F.lane);
    }
#pragma unroll 1
    for (int row = gw; row < 2 * NEXP; row += NGW) {
        const int tb = row >= NEXP, e = row - tb * NEXP;
        const GAS f32x4* src = (const GAS f32x4*)((tb ? F.e_up : F.e_down) + (size_t)e * D) + F.lane;
        f32x4 v[8]; float am = 0.f;
#pragma unroll
        for (int j = 0; j < 8; ++j) { v[j] = src[64 * j]; am = fmaxf(am, fmaxf(fmaxf(fabsf(v[j].x), fabsf(v[j].y)), fmaxf(fabsf(v[j].z), fabsf(v[j].w)))); }
        am = fmaxf(wave_max(am), 1e-30f);
        const float sc = am * (1.0f / 127.0f), inv = 127.0f / am;
        GAS unsigned* dst = (GAS unsigned*)((tb ? F.EU : F.ED) + (size_t)e * D) + F.lane;
        const int off = tb ? 128 : 0;
#pragma unroll
        for (int j = 0; j < 8; ++j) {
            const int q0 = (int)__builtin_rintf(v[j].x * inv) + off, q1 = (int)__builtin_rintf(v[j].y * inv) + off, q2 = (int)__builtin_rintf(v[j].z * inv) + off, q3 = (int)__builtin_rintf(v[j].w * inv) + off;
            dst[64 * j] = (unsigned)(q0 & 255) | ((unsigned)(q1 & 255) << 8) | ((unsigned)(q2 & 255) << 16) | ((unsigned)(q3 & 255) << 24);
        }
        if (F.lane == 0) (tb ? F.SU : F.SD)[e] = sc;
    }
}
DI float mod_final(Frame& F, int col) { float s = F.ada_b[col];
#pragma unroll
    for (int k = 0; k < ADA_KC; ++k) s += F.MODP[(size_t)k * NMOD + col];
    return s; }
DI void norm_tables(Frame& F, const float* g, int col_scale, int col_shift) {
    LAS float* A1 = (LAS float*)(F.lds); LAS float* B1 = (LAS float*)(F.lds + 8192);
#pragma unroll
    for (int i = 0; i < 4; ++i) { const int c = F.tid + 512 * i; A1[c] = g[c] * (1.0f + F.MODF[col_scale + c]); B1[c] = F.MODF[col_shift + c]; }
}
DI void p0_wq_item(Frame& F, LAS float* scr, int item) {
    const int lane = F.lane, nblk = D / 32, kb = item / nblk, nb = item % nblk, k0 = 64 * kb, n0 = 32 * nb;
    LAS float* gsl = scr + 64 * 33; LAS float* shl = gsl + 64;
    gsl[lane] = F.norm_ffn_g[k0 + lane] * (1.0f + mod_final(F, MOD_SCF + k0 + lane)); shl[lane] = mod_final(F, MOD_SHF + k0 + lane);
    LDS_WAIT(); asm volatile("" ::: "memory");
    float bp = 0.f;
#pragma unroll 8
    for (int i = 0; i < 32; ++i) { const int kk = 2 * i + (lane >> 5); const float w = F.wq[(size_t)(k0 + kk) * D + n0 + (lane & 31)]; scr[kk * 33 + (lane & 31)] = w * gsl[kk]; bp += w * shl[kk]; }
    bp += __shfl_xor(bp, 32);
    if (lane < 32) F.BQP[(size_t)kb * D + n0 + lane] = bp;
    LDS_WAIT(); asm volatile("" ::: "memory");
    const int c = lane & 7;
#pragma unroll
    for (int j = 0; j < 4; ++j) { const int n = (lane >> 3) + 8 * j; const LAS float* sp = scr + (8 * c) * 33 + n;
        v4u o; o.x = pk2(sp[0 * 33], sp[1 * 33]); o.y = pk2(sp[2 * 33], sp[3 * 33]); o.z = pk2(sp[4 * 33], sp[5 * 33]); o.w = pk2(sp[6 * 33], sp[7 * 33]);
        *(GAS v4u*)(F.WQ + (size_t)(n0 + n) * D + k0 + 8 * c) = o; }
    LDS_WAIT(); asm volatile("" ::: "memory");
}
DI void p0b_phase(Frame& F) {
    LAS float* A1 = (LAS float*)(F.lds); LAS float* B1 = (LAS float*)(F.lds + 8192); LAS float* WG = (LAS float*)(F.lds + 16384);
#pragma unroll
    for (int i = 0; i < 4; ++i) { const int c = F.tid + 512 * i; A1[c] = F.norm_mix_g[c] * (1.0f + mod_final(F, MOD_SCM + c)); B1[c] = mod_final(F, MOD_SHM + c); }
    { const int per = (NMOD + F.G - 1) / F.G; const int c = (int)blockIdx.x * per + F.tid; if (F.tid < per && c < NMOD) F.MODF[c] = mod_final(F, c); }
#pragma unroll
    for (int i = 0; i < 4; ++i) { const int k = F.tid + 512 * i; const f32x4 a = *(const GAS f32x4*)(F.w_in + (size_t)k * IN_COLS + NWIN), b = *(const GAS f32x4*)(F.w_in + (size_t)k * IN_COLS + NWIN + 4);
        WG[0 * 2048 + k] = a.x; WG[1 * 2048 + k] = a.y; WG[2 * 2048 + k] = a.z; WG[3 * 2048 + k] = a.w; WG[4 * 2048 + k] = b.x; WG[5 * 2048 + k] = b.y; WG[6 * 2048 + k] = b.z; WG[7 * 2048 + k] = b.w; }
    __syncthreads();
    const int gw = F.vcu * NWAVES + F.wave, NGW = F.G * NWAVES;
    f32x4 vn[8];
    { const GAS f32x4* xr = (const GAS f32x4*)(F.x + (size_t)gw * D) + F.lane;
#pragma unroll
      for (int j = 0; j < 8; ++j) vn[j] = xr[64 * j]; }
#pragma unroll 1
    for (int row = gw; row < M; row += NGW) {
        f32x4 v[8]; float ss = 0.f;
#pragma unroll
        for (int j = 0; j < 8; ++j) { v[j] = vn[j]; ss += (v[j].x * v[j].x + v[j].y * v[j].y) + (v[j].z * v[j].z + v[j].w * v[j].w); }
        if (row + NGW < M) { const GAS f32x4* xr = (const GAS f32x4*)(F.x + (size_t)(row + NGW) * D) + F.lane;
#pragma unroll
            for (int j = 0; j < 8; ++j) vn[j] = xr[64 * j]; }
        const float rstd = 1.0f / sqrtf(wave_sum(ss) * (1.0f / D) + EPS);
        float gd[8];
#pragma unroll
        for (int g = 0; g < 8; ++g) gd[g] = 0.f;
        GAS v2u* o8 = (GAS v2u*)(F.HA + (size_t)row * D) + F.lane;
#pragma unroll
        for (int j = 0; j < 8; ++j) {
            const f32x4 a = *(const LAS f32x4*)(A1 + 256 * j + 4 * F.lane), b = *(const LAS f32x4*)(B1 + 256 * j + 4 * F.lane);
            const f32x4 h = v[j] * rstd * a + b;
            v2u o; o.x = pk2(h.x, h.y); o.y = pk2(h.z, h.w); o8[64 * j] = o;
#pragma unroll
            for (int g = 0; g < 8; ++g) { const f32x4 w = *(const LAS f32x4*)(WG + g * 2048 + 256 * j + 4 * F.lane); gd[g] += (h.x * w.x + h.y * w.y) + (h.z * w.z + h.w * w.w); }
            asm volatile("" ::: "memory");
        }
#pragma unroll
        for (int g = 0; g < 8; ++g) gd[g] = wave_sum(gd[g]);
        if (F.lane == 0) {
#pragma unroll
            for (int g = 0; g < 8; ++g) { float p = gd[g] + F.b_gates[g];
                if (g >= 4) { p = fminf(p, 0.f) - log1pf(__expf(-fabsf(p))); }
                F.GATES[(size_t)row * 8 + g] = p; }
        }
    }
    __syncthreads();
    {
        LAS float* scr = (LAS float*)(F.lds + F.wave * 8960);
        for (int it = F.wave * F.G + F.vcu; it < (D / 64) * (D / 32); it += NGW) p0_wq_item(F, scr, it);
    }
}
constexpr int IMG_PITCH = 576, M1_WL = 73728, M1_RED = 74240, M1_OB = 90624;
typedef short s16x4 __attribute__((ext_vector_type(4)));
DI bf16x8 tr_frag(const LAS unsigned char* p, int off_lo, int off_hi) {
    const s16x4 lo = __builtin_amdgcn_ds_read_tr16_b64_v4i16((LAS s16x4*)(p + off_lo));
    const s16x4 hi = __builtin_amdgcn_ds_read_tr16_b64_v4i16((LAS s16x4*)(p + off_hi));
    return __builtin_shufflevector(lo, hi, 0, 1, 2, 3, 4, 5, 6, 7);
}
DI float bfel(const v4u& w, int e) { const unsigned d = w[e >> 1]; return (e & 1) ? bfhi(d) : bflo(d); }
DI void m1_item(Frame& F, int hh, int kc) {
    LAS unsigned char* IMG = F.lds; LAS float* WL = (LAS float*)(F.lds + M1_WL); LAS float* RED = (LAS float*)(F.lds + M1_RED);
    const int t0 = kc * CH, lane = F.lane, tid = F.tid;
    if (F.wave == 0) {
        const float* gp = F.GATES + (size_t)(t0 + 2 * lane) * 8;
        const float i0 = gp[hh], lf0 = gp[4 + hh], i1 = gp[8 + hh], lf1 = gp[12 + hh];
        const float p = lf0 + lf1; float inc = p;
#pragma unroll
        for (int o = 1; o < 64; o <<= 1) { const float t = __shfl_up(inc, o); if (lane >= o) inc += t; }
        const float A = __shfl(inc, 63), ex = inc - p, b0 = ex + lf0, b1 = ex + p;
        const float lw0 = A - b0 + i0, lw1 = A - b1 + i1;
        const float B = wave_max(fmaxf(lw0, lw1));
        WL[2 * lane] = __expf(lw0 - B); WL[2 * lane + 1] = __expf(lw1 - B);
        if (lane == 0) { F.SUMM[(hh * NCHUNK + kc) * 2] = A; F.SUMM[(hh * NCHUNK + kc) * 2 + 1] = B; }
    }
    __syncthreads();
    const int dg = tid & 31, sg = tid >> 5;
#pragma unroll 1
    for (int which = 0; which < 2; ++which) {
        const int chb = (which == 0 ? 1024 : 0) + hh * DH + dg * 8;
        const int colb = (which == 0 ? C_K : C_Q) + hh * DH + dg * 8;
        v4u raw[11];
#pragma unroll
        for (int rr = 0; rr < 11; ++rr) { const int tt = t0 + sg * 8 - 3 + rr; raw[rr] = (v4u){0u, 0u, 0u, 0u}; if (tt >= 0) raw[rr] = *(const GAS v4u*)(F.PROJ + (size_t)tt * NPROJ + colb); }
        float wl[8];
#pragma unroll
        for (int i = 0; i < 8; ++i) wl[i] = (which == 0) ? WL[sg * 8 + i] : 0.0625f;
        v4u o1[8], o2[8];
#pragma unroll
        for (int dw = 0; dw < 4; ++dw) {
            typedef float f32x2 __attribute__((ext_vector_type(2)));
            f32x2 cw[4];
#pragma unroll
            for (int j = 0; j < 4; ++j) cw[j] = *(const GAS f32x2*)(F.conv_w + j * 2048 + chb + 2 * dw);
            const f32x2 cb = *(const GAS f32x2*)(F.conv_b + chb + 2 * dw);
            float xl[11], xh[11];
#pragma unroll
            for (int rr = 0; rr < 11; ++rr) { xl[rr] = bflo(raw[rr][dw]); xh[rr] = bfhi(raw[rr][dw]); }
            float d0 = 0.f, d1 = 0.f;
#pragma unroll
            for (int i = 0; i < 8; ++i) {
                float a0 = cb.x, a1 = cb.y;
#pragma unroll
                for (int j = 0; j < 4; ++j) { a0 += cw[j].x * xl[i + j]; a1 += cw[j].y * xh[i + j]; }
                a0 = silu_f(a0); a1 = silu_f(a1);
                if (which == 0) { o1[i][dw] = pk2(a0, a1); a0 *= wl[i]; a1 *= wl[i]; d0 += a0; d1 += a1; o2[i][dw] = pk2(a0, a1); }
                else { o1[i][dw] = pk2(a0 * wl[i], a1 * wl[i]); }
            }
            if (which == 0) { RED[sg * 256 + dg * 8 + 2 * dw] = d0; RED[sg * 256 + dg * 8 + 2 * dw + 1] = d1; }
            asm volatile("" ::: "memory");
        }
#pragma unroll
        for (int i = 0; i < 8; ++i) { const int s = sg * 8 + i, t = t0 + s;
            if (which == 0) { *(GAS v4u*)(F.KC + (size_t)t * 1024 + hh * DH + dg * 8) = o1[i]; *(LAS v4u*)(IMG + s * IMG_PITCH + dg * 16) = o2[i]; }
            else { *(GAS v4u*)(F.QC + (size_t)t * 1024 + hh * DH + dg * 8) = o1[i]; } }
    }
    __syncthreads();
    if (tid < 256) { float s = 0.f;
#pragma unroll
        for (int i = 0; i < 16; ++i) s += RED[i * 256 + tid];
        F.NST[(size_t)(hh * NCHUNK + kc) * DH + tid] = s; }
    const int r = lane & 31, h = lane >> 5, e0 = F.wave * 32;
    bf16x8 bf[8];
#pragma unroll
    for (int ks = 0; ks < 8; ++ks) {
        bf[ks] = *(const GAS bf16x8*)(F.VT + (size_t)(hh * DH + e0 + r) * M + t0 + ks * 16 + 8 * h);
    }
    const LAS unsigned char* trb = IMG + (8 * h + ((lane & 15) >> 2)) * IMG_PITCH + (16 * ((lane >> 4) & 1) + 4 * (lane & 3)) * 2;
    LAS unsigned char* OB = F.lds + M1_OB + F.wave * (32 * 144);
#pragma unroll 1
    for (int dp = 0; dp < 4; ++dp) {
#pragma unroll
        for (int d2 = 0; d2 < 2; ++d2) {
            const int dt = 2 * dp + d2;
            f32x16 acc = zero16();
#pragma unroll
            for (int ks = 0; ks < 8; ++ks) { const bf16x8 af = tr_frag(trb + dt * 64, ks * 16 * IMG_PITCH, ks * 16 * IMG_PITCH + 4 * IMG_PITCH); acc = MFMA32(af, bf[ks], acc); }
#pragma unroll
            for (int g = 0; g < 4; ++g) { v2u o; o.x = pk2(acc[4 * g], acc[4 * g + 1]); o.y = pk2(acc[4 * g + 2], acc[4 * g + 3]);
                *(LAS v2u*)(OB + r * 144 + (d2 * 32 + 8 * g + 4 * h) * 2) = o; }
        }
        LDS_WAIT(); asm volatile("" ::: "memory");
#pragma unroll
        for (int i = 0; i < 4; ++i) { const int q = lane + 64 * i, row = q >> 3, c16 = q & 7;
            *(GAS v4u*)(F.STATE + (size_t)(hh * NCHUNK + kc) * (DH * DH) + (size_t)(e0 + row) * DH + dp * 64 + c16 * 8) = *(const LAS v4u*)(OB + row * 144 + c16 * 16); }
        LDS_WAIT(); asm volatile("" ::: "memory");
    }
    __syncthreads();
}
constexpr int G_WI = 0, G_VI = 34816, G_UI = 75776, G_WP = 272, G_VP = 320, G_UP = 272;
DI void gmlp_block(Frame& F, int g, int n0, int nch) {
    LAS unsigned char* WI = F.lds + G_WI; LAS unsigned char* VI = F.lds + G_VI; LAS unsigned char* UI = F.lds + G_UI;
    const int c0 = g * 128, lane = F.lane, tid = F.tid;
    {
#pragma unroll
        for (int i = 0; i < 8; ++i) { const int p = tid + 512 * i, t = p >> 5, s4 = (p & 31) * 4;
            const f32x4 w = *(const GAS f32x4*)(F.gmlp_w + (size_t)(g * 128 + t) * 128 + s4);
            v2u o; o.x = pk2(s4 <= t ? w.x : 0.f, s4 + 1 <= t ? w.y : 0.f); o.y = pk2(s4 + 2 <= t ? w.z : 0.f, s4 + 3 <= t ? w.w : 0.f);
            *(LAS v2u*)(WI + t * G_WP + s4 * 2) = o; }
    }
    v4u tv[4], tu[4];
#define G_LOAD(N) do { _Pragma("unroll") for (int i = 0; i < 4; ++i) { const int p = tid + 512 * i; const bf16* rowp = F.PROJ + (size_t)((N) * CH + (p >> 4)) * NPROJ + c0 + (p & 15) * 8; \
        tv[i] = *(const GAS v4u*)(rowp + C_VG); tu[i] = *(const GAS v4u*)(rowp + C_UG); } } while (0)
    G_LOAD(n0);
    const int r = lane & 31, h = lane >> 5, ct = F.wave & 3, tp = F.wave >> 2;
    float ng[16];
#pragma unroll
    for (int reg = 0; reg < 16; ++reg) ng[reg] = F.gmlp_norm_g[g * 128 + ct * 32 + crow(reg, h)];
    const LAS unsigned char* trb = VI + (8 * h + ((lane & 15) >> 2)) * G_VP + (ct * 32 + 16 * ((lane >> 4) & 1) + 4 * (lane & 3)) * 2;
#pragma unroll 1
    for (int ci = 0; ci < nch; ++ci) {
        const int n = n0 + ci, t0 = n * CH;
#pragma unroll
        for (int i = 0; i < 4; ++i) { const int p = tid + 512 * i, row = p >> 4, c16 = p & 15; const v4u w = tv[i];
            float a[8] = {bflo(w.x), bfhi(w.x), bflo(w.y), bfhi(w.y), bflo(w.z), bfhi(w.z), bflo(w.w), bfhi(w.w)};
            float ss = (a[0] * a[0] + a[1] * a[1]) + (a[2] * a[2] + a[3] * a[3]) + (a[4] * a[4] + a[5] * a[5]) + (a[6] * a[6] + a[7] * a[7]);
            ss += __shfl_xor(ss, 1); ss += __shfl_xor(ss, 2); ss += __shfl_xor(ss, 4); ss += __shfl_xor(ss, 8);
            const float rs = 1.0f / sqrtf(ss * (1.0f / 128.0f) + EPS);
            v4u o; o.x = pk2(a[0] * rs, a[1] * rs); o.y = pk2(a[2] * rs, a[3] * rs); o.z = pk2(a[4] * rs, a[5] * rs); o.w = pk2(a[6] * rs, a[7] * rs);
            *(LAS v4u*)(VI + row * G_VP + c16 * 16) = o; *(LAS v4u*)(UI + row * G_UP + c16 * 16) = tu[i]; }
        __syncthreads();
        if (ci + 1 < nch) G_LOAD(n + 1);
#pragma unroll 1
        for (int ti = 0; ti < 2; ++ti) {
            const int tt = (ti == 0) ? tp : 3 - tp;
            const int t = tt * 32 + r;
            const LAS unsigned char* wrow = WI + t * G_WP + 16 * h;
            f32x16 acc = zero16();
#pragma unroll
            for (int ks = 0; ks < 8; ++ks) if (ks <= 2 * tt + 1) {
                const bf16x8 af = tr_frag(trb, ks * 16 * G_VP, ks * 16 * G_VP + 4 * G_VP);
                const bf16x8 bw = *(const LAS bf16x8*)(wrow + 32 * ks);
                acc = MFMA32(af, bw, acc);
            }
            const float bsp = F.gmlp_b[g * 128 + t];
            LAS unsigned char* urow = UI + t * G_UP + (ct * 32 + 4 * h) * 2;
#pragma unroll
            for (int gq = 0; gq < 4; ++gq) { LAS v2u* up = (LAS v2u*)(urow + 16 * gq);
                const v2u uw = *up;
                const float y0 = bflo(uw.x) * (ng[4 * gq] * acc[4 * gq] + bsp), y1 = bfhi(uw.x) * (ng[4 * gq + 1] * acc[4 * gq + 1] + bsp);
                const float y2 = bflo(uw.y) * (ng[4 * gq + 2] * acc[4 * gq + 2] + bsp), y3 = bfhi(uw.y) * (ng[4 * gq + 3] * acc[4 * gq + 3] + bsp);
                v2u o; o.x = pk2(y0, y1); o.y = pk2(y2, y3); *up = o; }
        }
        __syncthreads();
#pragma unroll
        for (int i = 0; i < 4; ++i) { const int p = tid + 512 * i, row = p >> 4, c16 = p & 15;
            *(GAS v4u*)(F.HA + (size_t)(t0 + row) * D + c0 + c16 * 8) = *(const LAS v4u*)(UI + row * G_UP + c16 * 16); }
        __syncthreads();
    }
#undef G_LOAD
}
DI void p2_phase(Frame& F) {
    constexpr int N_M1 = NHEAD * NCHUNK;
#pragma unroll 1
    for (int it = (int)blockIdx.x; it < N_M1; it += F.G) m1_item(F, it / NCHUNK, it % NCHUNK);
    { const int per = (8 * (M / CH) + F.G - 1) / F.G;
      const int first = (int)blockIdx.x * per;
      if (first < 8 * (M / CH)) { const int g = first / (M / CH), n0 = first % (M / CH); int nch = per; if (n0 + nch > M / CH) nch = M / CH - n0; gmlp_block(F, g, n0, nch); } }
}
DI void p3_phase(Frame& F) {
    LAS float* TAB = (LAS float*)F.lds;
    const int lane = F.lane;
    if (F.wave < NHEAD) {
        const int hh = F.wave; const float* sp = F.SUMM + (size_t)(hh * NCHUNK + 2 * lane) * 2;
        const float A0 = sp[0], B0 = sp[1], A1 = sp[2], B1 = sp[3];
        float ca = A0 + A1, cb = fmaxf(B0 + A1, B1);
        const float pa = ca, pb = cb;
#pragma unroll
        for (int o = 1; o < 64; o <<= 1) { const float ta = __shfl_up(ca, o), tb = __shfl_up(cb, o); if (lane >= o) { cb = fmaxf(tb + ca, cb); ca = ta + ca; } }
        (void)pa; (void)pb;
        float ea = __shfl_up(ca, 1), eb = __shfl_up(cb, 1);
        float m0 = (lane == 0) ? 0.f : fmaxf(ea, eb);
        const float m1 = fmaxf(m0 + A0, B0), m2 = fmaxf(m1 + A1, B1);
        TAB[(hh * NCHUNK + 2 * lane) * 2] = __expf(A0 + m0 - m1); TAB[(hh * NCHUNK + 2 * lane) * 2 + 1] = __expf(B0 - m1);
        TAB[(hh * NCHUNK + 2 * lane + 1) * 2] = __expf(A1 + m1 - m2); TAB[(hh * NCHUNK + 2 * lane + 1) * 2 + 1] = __expf(B1 - m2);
        if (blockIdx.x == 0) { F.MTAB[hh * NCHUNK + 2 * lane] = m0; F.MTAB[hh * NCHUNK + 2 * lane + 1] = m1; }
    }
    __syncthreads();
    const int NT = F.G * NWAVES * 64, gt = (int)blockIdx.x * (NWAVES * 64) + F.tid;
    if (gt < D) { float b = 0.f;
#pragma unroll 8
        for (int k = 0; k < D / 64; ++k) b += F.BQP[(size_t)k * D + gt];
        F.BIASQ[gt] = b; }
    for (int p = gt; p < NHEAD * (DH * DH / 2); p += NT) {
        const int hh = p / (DH * DH / 2), q = p % (DH * DH / 2);
        GAS unsigned* sp = (GAS unsigned*)(F.STATE + (size_t)hh * NCHUNK * (DH * DH)) + q;
        float s0 = 0.f, s1 = 0.f;
#pragma unroll 1
        for (int k0 = 0; k0 < NCHUNK; k0 += 16) {
            unsigned ld[16];
#pragma unroll
            for (int k = 0; k < 16; ++k) ld[k] = sp[(size_t)(k0 + k) * (DH * DH / 2)];
#pragma unroll
            for (int k = 0; k < 16; ++k) {
                sp[(size_t)(k0 + k) * (DH * DH / 2)] = pk2(s0, s1);
                const float dec = TAB[(hh * NCHUNK + k0 + k) * 2], wb = TAB[(hh * NCHUNK + k0 + k) * 2 + 1];
                s0 = dec * s0 + wb * bflo(ld[k]); s1 = dec * s1 + wb * bfhi(ld[k]);
            }
        }
    }
    for (int p = gt; p < NHEAD * DH; p += NT) {
        const int hh = p / DH, d = p % DH; float* np = F.NST + (size_t)hh * NCHUNK * DH + d; float s = 0.f;
#pragma unroll 8
        for (int k = 0; k < NCHUNK; ++k) { const float ld = np[(size_t)k * DH]; np[(size_t)k * DH] = s; s = TAB[(hh * NCHUNK + k) * 2] * s + TAB[(hh * NCHUNK + k) * 2 + 1] * ld; }
    }
}
constexpr int M3_QI = 8192, M3_R2 = 75776, M3_QP = 528, M3_CP = 272, M3_VP = 264;
static_assert(M3_R2 + 256 * M3_CP <= LDSCTL_OFF, "P4 LDS map");
DI void m3_item(Frame& F, int hh, int kc) {
    LAS float* GS = (LAS float*)F.lds; LAS float* MX = GS + 128; LAS float* BT = GS + 256; LAS float* NK = GS + 384; LAS float* XCH = GS + 640;
    LAS unsigned char* QI = F.lds + M3_QI; LAS unsigned char* R2 = F.lds + M3_R2;
    int tid = F.tid; asm volatile("" : "+v"(tid));
    const int t0 = kc * CH, lane = F.lane, item = hh * NCHUNK + kc;
    const float mk = F.MTAB[item];
    const bf16* cbase = F.STATE + (size_t)item * (DH * DH);
    const bf16* kbase = F.KC + (size_t)t0 * 1024 + hh * DH;
    const bf16* qbase = F.QC + (size_t)t0 * 1024 + hh * DH;
    const bf16* vbase = F.VT + (size_t)(hh * DH) * M + t0;
    {
        v4u tk[8], tq[8];
#pragma unroll
        for (int i = 0; i < 8; ++i) { const int p = tid + 512 * i; tk[i] = *(const GAS v4u*)(kbase + (size_t)(p >> 5) * 1024 + (p & 31) * 8); tq[i] = *(const GAS v4u*)(qbase + (size_t)(p >> 5) * 1024 + (p & 31) * 8); }
        if (F.wave == 0) {
            const float* gp = F.GATES + (size_t)(t0 + 2 * lane) * 8;
            const float i0 = gp[hh], lf0 = gp[4 + hh], i1 = gp[8 + hh], lf1 = gp[12 + hh];
            const float p = lf0 + lf1; float inc = p;
#pragma unroll
            for (int o = 1; o < 64; o <<= 1) { const float t = __shfl_up(inc, o); if (lane >= o) inc += t; }
            const float ex = inc - p, b0 = ex + lf0, b1 = ex + p;
            const float g0 = i0 - b0, g1 = i1 - b1;
            float cm = fmaxf(g0, g1);
#pragma unroll
            for (int o = 1; o < 64; o <<= 1) { const float t = __shfl_up(cm, o); if (lane >= o) cm = fmaxf(cm, t); }
            float pm = __shfl_up(cm, 1); if (lane == 0) pm = -INFINITY;
            const float M0 = fmaxf(mk, fmaxf(pm, g0)), M1 = fmaxf(M0, g1);
            GS[2 * lane] = g0; GS[2 * lane + 1] = g1; MX[2 * lane] = M0; MX[2 * lane + 1] = M1; BT[2 * lane] = b0; BT[2 * lane + 1] = b1;
        }
        if (tid < 256) NK[tid] = F.NST[(size_t)item * DH + tid];
#pragma unroll
        for (int i = 0; i < 8; ++i) { const int p = tid + 512 * i; *(LAS v4u*)(R2 + (p >> 5) * M3_QP + (p & 31) * 16) = tk[i]; *(LAS v4u*)(QI + (p >> 5) * M3_QP + (p & 31) * 16) = tq[i]; }
    }
    __syncthreads();
    const int r = lane & 31, h = lane >> 5, tt = F.wave & 3, eh = F.wave >> 2;
    const int tl = tt * 32 + r, t = t0 + tl;
    const float Mt = MX[tl], winter = __expf(mk - Mt);
    const LAS unsigned char* qrow = QI + tl * M3_QP + 16 * h;
    const LAS float* GSh = GS + 4 * h; int tlo = tl - 4 * h; asm volatile("" : "+v"(tlo));
    bf16x8 xs[4][2]; float den = 0.f;
#pragma unroll
    for (int st = 0; st < 4; ++st) {
        if (st <= tt) {
            f32x16 accS = zero16();
            const LAS unsigned char* krow = R2 + (st * 32 + r) * M3_QP + 16 * h;
#pragma unroll 4
            for (int ks = 0; ks < 16; ++ks) { const bf16x8 kf = *(const LAS bf16x8*)(krow + 32 * ks); const bf16x8 qf = *(const LAS bf16x8*)(qrow + 32 * ks); accS = MFMA32(kf, qf, accS); }
            float xv[16];
#pragma unroll
            for (int reg = 0; reg < 16; ++reg) { const int sc = st * 32 + (reg & 3) + 8 * (reg >> 2); float v = accS[reg] * __expf(GSh[sc] - Mt); if (sc > tlo) v = 0.f; xv[reg] = v; den += v; }
#pragma unroll
            for (int k2 = 0; k2 < 2; ++k2) { v4u xw; xw.x = pk2(xv[8 * k2], xv[8 * k2 + 1]); xw.y = pk2(xv[8 * k2 + 2], xv[8 * k2 + 3]); xw.z = pk2(xv[8 * k2 + 4], xv[8 * k2 + 5]); xw.w = pk2(xv[8 * k2 + 6], xv[8 * k2 + 7]);
                xs[st][k2] = __builtin_bit_cast(bf16x8, xw); }
        } else { xs[st][0] = (bf16x8){0, 0, 0, 0, 0, 0, 0, 0}; xs[st][1] = xs[st][0]; }
        asm volatile("" ::: "memory");
    }
    f32x16 accH[4];
#pragma unroll
    for (int i = 0; i < 4; ++i) accH[i] = zero16();
    float qn = 0.f;
#pragma unroll 1
    for (int hf = 0; hf < 2; ++hf) {
        v4u tc[8];
#pragma unroll
        for (int i = 0; i < 8; ++i) { const int p = tid + 512 * i; tc[i] = *(const GAS v4u*)(cbase + (size_t)(p >> 4) * DH + hf * 128 + (p & 15) * 8); }
        __syncthreads();
#pragma unroll
        for (int i = 0; i < 8; ++i) { const int p = tid + 512 * i; *(LAS v4u*)(R2 + (p >> 4) * M3_CP + (p & 15) * 16) = tc[i]; }
        __syncthreads();
        const LAS unsigned char* crow0 = R2 + (eh * 128 + r) * M3_CP + 16 * h;
#pragma unroll 2
        for (int ks = 0; ks < 8; ++ks) {
            const int kg = hf * 8 + ks;
            const v4u qw = *(const LAS v4u*)(qrow + 32 * kg);
            float qv[8] = {bflo(qw.x), bfhi(qw.x), bflo(qw.y), bfhi(qw.y), bflo(qw.z), bfhi(qw.z), bflo(qw.w), bfhi(qw.w)};
            const f32x4 na = *(const LAS f32x4*)(NK + kg * 16 + 8 * h), nb = *(const LAS f32x4*)(NK + kg * 16 + 8 * h + 4);
            qn += (qv[0] * na.x + qv[1] * na.y) + (qv[2] * na.z + qv[3] * na.w) + (qv[4] * nb.x + qv[5] * nb.y) + (qv[6] * nb.z + qv[7] * nb.w);
            v4u q2; q2.x = pk2(qv[0] * winter, qv[1] * winter); q2.y = pk2(qv[2] * winter, qv[3] * winter); q2.z = pk2(qv[4] * winter, qv[5] * winter); q2.w = pk2(qv[6] * winter, qv[7] * winter);
            const bf16x8 q2f = __builtin_bit_cast(bf16x8, q2);
#pragma unroll
            for (int et = 0; et < 4; ++et) { const bf16x8 cf = *(const LAS bf16x8*)(crow0 + et * 32 * M3_CP + 32 * ks); accH[et] = MFMA32(cf, q2f, accH[et]); }
        }
    }
    qn += __shfl_xor(qn, 32);
    {
        v4u tv[8];
#pragma unroll
        for (int i = 0; i < 8; ++i) { const int p = tid + 512 * i; tv[i] = *(const GAS v4u*)(vbase + (size_t)(p >> 4) * M + (p & 15) * 8); }
        __syncthreads();
#pragma unroll
        for (int i = 0; i < 8; ++i) { const int p = tid + 512 * i; LAS unsigned char* d = R2 + (p >> 4) * M3_VP + (p & 15) * 16;
            *(LAS v2u*)d = (v2u){tv[i].x, tv[i].y}; *(LAS v2u*)(d + 8) = (v2u){tv[i].z, tv[i].w}; }
    }
    __syncthreads();
    const LAS unsigned char* vrow0 = R2 + (eh * 128 + r) * M3_VP + 8 * h;
#pragma unroll
    for (int st = 0; st < 4; ++st) if (st <= tt) {
#pragma unroll
        for (int k2 = 0; k2 < 2; ++k2)
#pragma unroll
            for (int et = 0; et < 4; ++et) {
                const LAS unsigned char* vp = vrow0 + et * 32 * M3_VP + (st * 32 + 16 * k2) * 2;
                const v2u lo = *(const LAS v2u*)vp, hi = *(const LAS v2u*)(vp + 16);
                v4u vw; vw.x = lo.x; vw.y = lo.y; vw.z = hi.x; vw.w = hi.y;
                accH[et] = MFMA32(__builtin_bit_cast(bf16x8, vw), xs[st][k2], accH[et]);
                asm volatile("" ::: "memory");
            }
    }
    v4u to[8];
    { const bf16* obase = F.PROJ + (size_t)t0 * NPROJ + C_OM + hh * DH;
#pragma unroll
      for (int i = 0; i < 8; ++i) { const int p = tid + 512 * i; to[i] = *(const GAS v4u*)(obase + (size_t)(p >> 5) * NPROJ + (p & 31) * 8); } }
    den += __shfl_xor(den, 32);
    den += winter * qn;
    const float dnm = fmaxf(fabsf(den), __expf(-(BT[tl] + Mt))), inv = 1.0f / dnm;
    float ss = 0.f;
#pragma unroll
    for (int et = 0; et < 4; ++et)
#pragma unroll
        for (int reg = 0; reg < 16; ++reg) { accH[et][reg] *= inv; ss += accH[et][reg] * accH[et][reg]; }
    ss += __shfl_xor(ss, 32);
    if (h == 0) XCH[eh * 128 + tl] = ss;
#pragma unroll
    for (int i = 0; i < 8; ++i) { const int p = tid + 512 * i; *(LAS v4u*)(QI + (p >> 5) * M3_QP + (p & 31) * 16) = to[i]; }
    __syncthreads();
    const float rstd = 1.0f / sqrtf((XCH[tl] + XCH[128 + tl]) * (1.0f / DH) + EPS);
    LAS unsigned char* orow = QI + tl * M3_QP + (eh * 128 + 4 * h) * 2;
    const float* ngp = F.mlstm_norm_g + hh * DH + eh * 128;
#pragma unroll
    for (int et = 0; et < 4; ++et)
#pragma unroll
        for (int gq = 0; gq < 4; ++gq) { const int el = et * 32 + 8 * gq + 4 * h; LAS v2u* op = (LAS v2u*)(orow + (et * 32 + 8 * gq) * 2);
            const v2u ow = *op; const f32x4 gn = *(const GAS f32x4*)(ngp + el);
            const float y0 = accH[et][4 * gq] * rstd * gn.x * sigmoid_f(bflo(ow.x)), y1 = accH[et][4 * gq + 1] * rstd * gn.y * sigmoid_f(bfhi(ow.x));
            const float y2 = accH[et][4 * gq + 2] * rstd * gn.z * sigmoid_f(bflo(ow.y)), y3 = accH[et][4 * gq + 3] * rstd * gn.w * sigmoid_f(bfhi(ow.y));
            v2u o; o.x = pk2(y0, y1); o.y = pk2(y2, y3); *op = o; }
    __syncthreads();
#pragma unroll
    for (int i = 0; i < 8; ++i) { const int p = tid + 512 * i, row = p >> 5, c16 = p & 31;
        *(GAS v4u*)(F.HA + (size_t)(t0 + row) * D + 1024 + hh * DH + c16 * 8) = *(const LAS v4u*)(QI + row * M3_QP + c16 * 16); }
    __syncthreads();
}
DI void p4_phase(Frame& F) {
    for (int it = (int)blockIdx.x; it < NHEAD * NCHUNK; it += F.G) m3_item(F, it / NCHUNK, it % NCHUNK);
}
constexpr int KPITCH = 272, P8_TBL = 69632;
DI void topk_insert(float (&L)[16], float x) {
#pragma unroll
    for (int i = 15; i >= 1; --i) L[i] = __builtin_amdgcn_fmed3f(x, L[i - 1], L[i]);
    L[0] = fmaxf(L[0], x);
}
DI void p8_phase(Frame& F) {
    LAS unsigned char* KIMG = F.lds; LAS unsigned char* TBL = F.lds + P8_TBL + F.wave * 1024;
    const int lane = F.lane, tid = F.tid, r = lane & 31, h = lane >> 5;
#pragma unroll 4
    for (int i = 0; i < 16; ++i) { const int idx = tid * 4 + 2048 * i, side = idx >> 14, rem = idx & 16383, row = rem >> 7, col = rem & 127;
        const f32x4 a = *(const GAS f32x4*)((side ? F.keys2 : F.keys1) + rem);
        v2u o; o.x = pk2(a.x, a.y); o.y = pk2(a.z, a.w); *(LAS v2u*)(KIMG + (side * 128 + row) * KPITCH + col * 2) = o; }
    __syncthreads();
    for (int it = (int)blockIdx.x; it < (M / 256) * PH; it += F.G) {
        const int tile = it / PH, hd = it % PH;
        const int t = tile * 256 + F.wave * 32 + r;
        float L1[16], L2[16];
#pragma unroll 1
        for (int side = 0; side < 2; ++side) {
            f32x16 acc[4];
#pragma unroll
            for (int kt = 0; kt < 4; ++kt) acc[kt] = zero16();
            const bf16* qp = F.QB + (size_t)t * D + hd * 256 + side * 128 + 8 * h;
#pragma unroll
            for (int ks = 0; ks < 8; ++ks) {
                const bf16x8 qf = *(const GAS bf16x8*)(qp + ks * 16);
#pragma unroll
                for (int kt = 0; kt < 4; ++kt) { const bf16x8 kf = *(const LAS bf16x8*)(KIMG + (side * 128 + kt * 32 + r) * KPITCH + (ks * 16 + 8 * h) * 2); acc[kt] = MFMA32(kf, qf, acc[kt]); }
            }
            float L[16];
#pragma unroll
            for (int i = 0; i < 16; ++i) L[i] = -3.0e38f;
#pragma unroll
            for (int kt = 0; kt < 4; ++kt)
#pragma unroll
                for (int reg = 0; reg < 16; ++reg) { const unsigned key = (unsigned)(kt * 32 + crow(reg, h)); const float sv = acc[kt][reg];
                    topk_insert(L, __uint_as_float((__float_as_uint(sv) & ~127u) | key)); }
            float P[16];
#pragma unroll
            for (int i = 0; i < 16; ++i) P[i] = __shfl_xor(L[i], 32);
#pragma unroll
            for (int i = 0; i < 16; ++i) topk_insert(L, P[i]);
            if (side == 0) {
#pragma unroll
                for (int i = 0; i < 16; ++i) L1[i] = L[i];
            } else {
#pragma unroll
                for (int i = 0; i < 16; ++i) L2[i] = L[i];
            }
        }
        if (h == 0) {
#pragma unroll
            for (int w = 0; w < 4; ++w) {
                const unsigned a = (__builtin_bit_cast(unsigned, L1[4 * w]) & 127u) | ((__builtin_bit_cast(unsigned, L1[4 * w + 1]) & 127u) << 8) | ((__builtin_bit_cast(unsigned, L1[4 * w + 2]) & 127u) << 16) | ((__builtin_bit_cast(unsigned, L1[4 * w + 3]) & 127u) << 24);
                const unsigned b = (__builtin_bit_cast(unsigned, L2[4 * w]) & 127u) | ((__builtin_bit_cast(unsigned, L2[4 * w + 1]) & 127u) << 8) | ((__builtin_bit_cast(unsigned, L2[4 * w + 2]) & 127u) << 16) | ((__builtin_bit_cast(unsigned, L2[4 * w + 3]) & 127u) << 24);
                *(LAS unsigned*)(TBL + r * 32 + 4 * w) = a; *(LAS unsigned*)(TBL + r * 32 + 16 + 4 * w) = b;
            }
        }
        float T[16];
#pragma unroll
        for (int i = 0; i < 16; ++i) T[i] = -3.0e38f;
#pragma unroll
        for (int i = 0; i < 16; ++i) {
            const float v1 = __builtin_bit_cast(float, __builtin_bit_cast(unsigned, L1[i]) & ~127u);
#pragma unroll
            for (int j = 0; j < 16; ++j) if ((i + 1) * (j + 1) <= 16) {
                const float v2 = __builtin_bit_cast(float, __builtin_bit_cast(unsigned, L2[j]) & ~127u);
                topk_insert(T, __builtin_bit_cast(float, (__builtin_bit_cast(unsigned, v1 + v2) & ~255u) | (unsigned)(i * 16 + j)));
            }
        }
        LDS_WAIT(); asm volatile("" ::: "memory");
        float ev[16], esum = 0.f;
        const float mx = __builtin_bit_cast(float, __builtin_bit_cast(unsigned, T[0]) & ~255u);
#pragma unroll
        for (int i = 0; i < 16; ++i) { ev[i] = __expf(__builtin_bit_cast(float, __builtin_bit_cast(unsigned, T[i]) & ~255u) - mx); esum += ev[i]; }
        const float einv = 1.0f / esum;
        int eid[8]; float gt[8];
#pragma unroll
        for (int i = 0; i < 8; ++i) { const float tv = h ? T[8 + i] : T[i]; const float e = h ? ev[8 + i] : ev[i];
            const unsigned p = __builtin_bit_cast(unsigned, tv) & 255u;
            const unsigned i1 = *(const LAS unsigned char*)(TBL + r * 32 + (p >> 4)), i2 = *(const LAS unsigned char*)(TBL + r * 32 + 16 + (p & 15u));
            eid[i] = (int)(i1 * 128u + i2); gt[i] = e * einv; }
        int* ip = F.IDX + (size_t)t * NSEL + hd * 16 + 8 * h; float* gp = F.PG + (size_t)t * NSEL + hd * 16 + 8 * h;
        *(GAS v4u*)ip = (v4u){(unsigned)eid[0], (unsigned)eid[1], (unsigned)eid[2], (unsigned)eid[3]}; *(GAS v4u*)(ip + 4) = (v4u){(unsigned)eid[4], (unsigned)eid[5], (unsigned)eid[6], (unsigned)eid[7]};
        *(GAS f32x4*)gp = (f32x4){gt[0], gt[1], gt[2], gt[3]}; *(GAS f32x4*)(gp + 4) = (f32x4){gt[4], gt[5], gt[6], gt[7]};
        LDS_WAIT(); asm volatile("" ::: "memory");
    }
}
constexpr int P9_IDX = 131072, P9_SH = 147456, P9_CORR = 147712, P9_GF = 32768, P9_FG = 40960, P9_SSQ = 49152, NSLICE = 16, SLICE_B = 128;
#ifndef NSLICE_A
#define NSLICE_A NSLICE
#endif
#ifndef NSLICE_C
#define NSLICE_C NSLICE
#endif
template <int N, int MASK> DI void red_step_i(int (&v)[8], int lane) {
#pragma unroll
    for (int i = 0; i < N / 2; ++i) { const bool up = (lane & MASK) != 0; const int keep = up ? v[i + N / 2] : v[i], send = up ? v[i] : v[i + N / 2]; v[i] = keep + __shfl_xor(send, MASK); }
}
template <int N, int MASK> DI void red_step_f(float (&v)[16], int lane) {
#pragma unroll
    for (int i = 0; i < N / 2; ++i) { const bool up = (lane & MASK) != 0; const float keep = up ? v[i + N / 2] : v[i], send = up ? v[i] : v[i + N / 2]; v[i] = keep + __shfl_xor(send, MASK); }
}
typedef _Float16 h2v __attribute__((ext_vector_type(2)));
DI void acc4(float& o0, float& o1, float& o2, float& o3, unsigned u, float c) {
    const h2v p = __builtin_bit_cast(h2v, __builtin_amdgcn_perm(u, 0x64646464u, 0x01050004u));
    const h2v q = __builtin_bit_cast(h2v, __builtin_amdgcn_perm(u, 0x64646464u, 0x01070006u));
    o0 = __builtin_fmaf((float)p.x, c, o0); o1 = __builtin_fmaf((float)p.y, c, o1); o2 = __builtin_fmaf((float)q.x, c, o2); o3 = __builtin_fmaf((float)q.y, c, o3);
}
DI void p9v2_phase(Frame& F) {
    LAS unsigned char* HQ = F.lds; LAS float* A2 = (LAS float*)(F.lds + P9_IDX); LAS float* B2 = (LAS float*)(F.lds + P9_IDX + 8192);
    LAS unsigned short* IDX16 = (LAS unsigned short*)(F.lds + P9_IDX); LAS float* SH = (LAS float*)(F.lds + P9_SH); LAS float* CORR = (LAS float*)(F.lds + P9_CORR);
    LAS float* COEF = (LAS float*)F.lds; LAS float* GF = (LAS float*)(F.lds + P9_GF); LAS float* FG = (LAS float*)(F.lds + P9_FG);
    const int lane = F.lane, tid = F.tid, c8 = lane & 7, g = lane >> 3;
#pragma unroll 1
    for (int tb = (int)blockIdx.x * 64; tb < M; tb += F.G * 64) {
#pragma unroll
        for (int i = 0; i < 4; ++i) { const int c = tid + 512 * i; A2[c] = F.norm_ffn_g[c] * (1.0f + F.MODF[MOD_SCF + c]); B2[c] = F.MODF[MOD_SHF + c]; }
        __syncthreads();
#pragma unroll 1
        for (int j = 0; j < 8; ++j) {
            const int tl = F.wave * 8 + j, t = tb + tl;
            float hv[32]; float ss = 0.f;
            const bf16* xr = F.X1B + (size_t)t * D + 16 * lane;
#pragma unroll
            for (int jj = 0; jj < 2; ++jj)
#pragma unroll
                for (int q = 0; q < 2; ++q) { const v4u a = *(const GAS v4u*)(xr + 1024 * jj + 8 * q); const int o = 16 * jj + 8 * q;
                    hv[o] = bflo(a.x); hv[o + 1] = bfhi(a.x); hv[o + 2] = bflo(a.y); hv[o + 3] = bfhi(a.y); hv[o + 4] = bflo(a.z); hv[o + 5] = bfhi(a.z); hv[o + 6] = bflo(a.w); hv[o + 7] = bfhi(a.w); }
#pragma unroll
            for (int i = 0; i < 32; ++i) ss += hv[i] * hv[i];
            const float rstd = 1.0f / sqrtf(wave_sum(ss) * (1.0f / D) + EPS);
            float am = 0.f;
#pragma unroll
            for (int jj = 0; jj < 2; ++jj)
#pragma unroll
                for (int q = 0; q < 4; ++q) { const f32x4 a = *(const LAS f32x4*)(A2 + 1024 * jj + 16 * lane + 4 * q), b = *(const LAS f32x4*)(B2 + 1024 * jj + 16 * lane + 4 * q);
                    const int o = 16 * jj + 4 * q;
                    hv[o] = hv[o] * rstd * a.x + b.x; hv[o + 1] = hv[o + 1] * rstd * a.y + b.y; hv[o + 2] = hv[o + 2] * rstd * a.z + b.z; hv[o + 3] = hv[o + 3] * rstd * a.w + b.w;
                    am = fmaxf(am, fmaxf(fmaxf(fabsf(hv[o]), fabsf(hv[o + 1])), fmaxf(fabsf(hv[o + 2]), fabsf(hv[o + 3])))); }
            am = fmaxf(wave_max(am), 1e-30f); const float inv = 127.0f / am;
            if (lane == 0) SH[tl] = am * (1.0f / 127.0f);
#pragma unroll
            for (int jj = 0; jj < 2; ++jj) { v4u o;
#pragma unroll
                for (int q = 0; q < 4; ++q) { const int b = 16 * jj + 4 * q;
                    const int q0 = (int)__builtin_rintf(hv[b] * inv), q1 = (int)__builtin_rintf(hv[b + 1] * inv), q2 = (int)__builtin_rintf(hv[b + 2] * inv), q3 = (int)__builtin_rintf(hv[b + 3] * inv);
                    o[q] = (unsigned)(q0 & 255) | ((unsigned)(q1 & 255) << 8) | ((unsigned)(q2 & 255) << 16) | ((unsigned)(q3 & 255) << 24); }
                *(LAS v4u*)(HQ + tl * 2048 + 1024 * jj + 16 * lane) = o; }
        }
        __syncthreads();
#pragma unroll
        for (int i = 0; i < 16; ++i) { const int q = tid + 512 * i; IDX16[q] = (unsigned short)F.IDX[(size_t)tb * NSEL + q]; }
        __syncthreads();
        int P[8][2];
#pragma unroll
        for (int j = 0; j < 8; ++j) { P[j][0] = 0; P[j][1] = 0; }
#pragma unroll 1
        for (int s = 0; s < NSLICE_A; ++s) {
            const unsigned char* eb = F.ED + s * SLICE_B;
            const unsigned lo = (unsigned)(c8 * 16);
            v4u wA[8], wB[8];
#define P9A_LOAD(W, J, H) do { _Pragma("unroll") for (int i = 0; i < 8; ++i) { const unsigned e = IDX16[(F.wave * 8 + (J)) * 128 + 64 * (H) + 8 * i + g]; W[i] = *(const GAS v4u*)(eb + (e * 2048u + lo)); } } while (0)
#define P9A_COMP(W, J, H) do { const v4u hq = *(const LAS v4u*)(HQ + (F.wave * 8 + (J)) * 2048 + s * SLICE_B + c8 * 16); int a[8]; \
                _Pragma("unroll") for (int i = 0; i < 8; ++i) { int d = 0; const v4u ww = W[i]; \
                    d = __builtin_amdgcn_sdot4((int)hq.x, (int)ww.x, d, false); d = __builtin_amdgcn_sdot4((int)hq.y, (int)ww.y, d, false); d = __builtin_amdgcn_sdot4((int)hq.z, (int)ww.z, d, false); d = __builtin_amdgcn_sdot4((int)hq.w, (int)ww.w, d, false); a[i] = d; } \
                red_step_i<8, 4>(a, lane); red_step_i<4, 2>(a, lane); red_step_i<2, 1>(a, lane); P[J][H] += a[0]; asm volatile("" ::: "memory"); } while (0)
            P9A_LOAD(wA, 0, 0);
#pragma unroll
            for (int j = 0; j < 8; ++j) {
                P9A_LOAD(wB, j, 1);
                P9A_COMP(wA, j, 0);
                if (j < 7) P9A_LOAD(wA, j + 1, 0);
                P9A_COMP(wB, j, 1);
            }
#undef P9A_LOAD
#undef P9A_COMP
        }
        __syncthreads();
        LAS int* PI = (LAS int*)F.lds;
#pragma unroll
        for (int j = 0; j < 8; ++j) { const int tl = F.wave * 8 + j; PI[tl * 128 + 8 * c8 + g] = P[j][0]; PI[tl * 128 + 64 + 8 * c8 + g] = P[j][1]; }
#pragma unroll
        for (int i = 0; i < 4; ++i) { const int c = tid + 512 * i; GF[c] = F.MODF[MOD_GF + c]; FG[c] = F.final_g[c]; }
        LAS float* SSQL = (LAS float*)(F.lds + P9_SSQ);
#pragma unroll 1
        for (int j = 0; j < 8; ++j) { const int tl = F.wave * 8 + j, t = tb + tl; const float sh = SH[tl]; float sum = 0.f;
#pragma unroll
            for (int h = 0; h < 2; ++h) { const int k = 64 * h + lane; const unsigned e = IDX16[tl * 128 + k];
                const float act = (float)PI[tl * 128 + k] * (sh * F.SD[e]); const float cfv = F.PG[(size_t)t * NSEL + k] * gelu_f(act) * F.SU[e]; COEF[tl * 128 + k] = cfv; sum += cfv; }
            sum = 1152.0f * wave_sum(sum); if (lane == 0) CORR[tl] = sum;     SSQL[tl * 64 + lane] = 0.f; }
        __syncthreads();
        const int cb = c8 * 16 + ((lane >> 5) & 1) * 8 + ((lane >> 4) & 1) * 4 + ((lane >> 3) & 1) * 2;
#pragma unroll 1
        for (int s = 0; s < NSLICE_C; ++s) {
            const unsigned char* eb = F.EU + s * SLICE_B;
            const unsigned lo = (unsigned)(c8 * 16);
            v4u wA[8], wB[8]; float cA[8], cB[8];
#define P9C_LOAD(W, C, TL, H) do { _Pragma("unroll") for (int i = 0; i < 8; ++i) { const unsigned e = IDX16[(TL) * 128 + 64 * (H) + 8 * i + g]; C[i] = COEF[(TL) * 128 + 64 * (H) + 8 * i + g]; W[i] = *(const GAS v4u*)(eb + (e * 2048u + lo)); } } while (0)
#define P9C_ACC(W, C) do { _Pragma("unroll") for (int i = 0; i < 8; ++i) { unsigned ux = W[i].x, uy = W[i].y, uz = W[i].z, uw = W[i].w; const float cc = C[i]; \
                asm volatile("" : "+v"(ux), "+v"(uy), "+v"(uz), "+v"(uw));      \
                acc4(o[0], o[1], o[2], o[3], ux, cc); acc4(o[4], o[5], o[6], o[7], uy, cc); acc4(o[8], o[9], o[10], o[11], uz, cc); acc4(o[12], o[13], o[14], o[15], uw, cc); \
                asm volatile("" : "+v"(o[0]), "+v"(o[1]), "+v"(o[2]), "+v"(o[3]), "+v"(o[4]), "+v"(o[5]), "+v"(o[6]), "+v"(o[7]), "+v"(o[8]), "+v"(o[9]), "+v"(o[10]), "+v"(o[11]), "+v"(o[12]), "+v"(o[13]), "+v"(o[14]), "+v"(o[15])); } \
                asm volatile("" ::: "memory"); } while (0)
            P9C_LOAD(wA, cA, F.wave * 8, 0);
#pragma unroll 1
            for (int j = 0; j < 8; ++j) {
                const int tl = F.wave * 8 + j, t = tb + tl;
                float o[16];
#pragma unroll
                for (int b = 0; b < 16; ++b) o[b] = 0.f;
                P9C_LOAD(wB, cB, tl, 1);
                P9C_ACC(wA, cA);
                if (j < 7) P9C_LOAD(wA, cA, tl + 1, 0);
                P9C_ACC(wB, cB);
                red_step_f<16, 32>(o, lane); red_step_f<8, 16>(o, lane); red_step_f<4, 8>(o, lane);
                const int col = s * SLICE_B + cb; const float corr = CORR[tl];
                GAS unsigned* xp = (GAS unsigned*)(F.X1B + (size_t)t * D + col);
                const unsigned xw = *xp;
                const float y0 = bflo(xw) + GF[col] * (o[0] - corr), y1 = bfhi(xw) + GF[col + 1] * (o[1] - corr);
                const unsigned yw = pk2(y0, y1); const float r0 = bflo(yw), r1 = bfhi(yw);
                SSQL[tl * 64 + lane] += r0 * r0 + r1 * r1;
                *xp = yw;
            }
#undef P9C_LOAD
#undef P9C_ACC
        }
#pragma unroll 1
        for (int j = 0; j < 8; ++j) {
            const int tl = F.wave * 8 + j, t = tb + tl;
            const float rstd2 = 1.0f / sqrtf(wave_sum(SSQL[tl * 64 + lane]) * (1.0f / D) + EPS);
            const GAS v2u* xrow = (const GAS v2u*)(F.X1B + (size_t)t * D) + lane; GAS f32x4* orow = (GAS f32x4*)(F.out + (size_t)t * D) + lane;
#pragma unroll
            for (int q = 0; q < 8; ++q) { const v2u w = xrow[64 * q]; const f32x4 f = *(const LAS f32x4*)(FG + 256 * q + 4 * lane);
                orow[64 * q] = (f32x4){bflo(w.x) * rstd2 * f.x, bfhi(w.x) * rstd2 * f.y, bflo(w.y) * rstd2 * f.z, bfhi(w.y) * rstd2 * f.w}; }
        }
        __syncthreads();
    }
}
struct Args { const float* in[21]; float* out; unsigned char* ws; int ph_lo, ph_hi, li, pad; };
constexpr int N_PHASES = 10;
__global__ void __launch_bounds__(NWAVES * 64, 2) mk_fwd(Args args) {
    extern __shared__ __attribute__((aligned(16))) unsigned char lds[];
    Frame F;
    F.lds = (LAS unsigned char*)lds;
    F.MISC = (volatile LAS unsigned*)(F.lds + MISC_OFF);
    F.tid = threadIdx.x; F.lane = F.tid & 63; F.wave = __builtin_amdgcn_readfirstlane(F.tid >> 6);
    F.G = gridDim.x; { const int bx = blockIdx.x; F.vcu = (F.G % 8 == 0) ? (bx % 8) * (F.G / 8) + bx / 8 : bx; }
    unsigned char* ws = args.ws;
    F.ctl = (gu32*)(ws + WS_CTL);
    F.x = args.in[0]; F.c = args.in[1]; F.ada_w = args.in[2]; F.ada_b = args.in[3]; F.norm_mix_g = args.in[4]; F.w_in = args.in[5]; F.b_gates = args.in[6];
    F.conv_w = args.in[7]; F.conv_b = args.in[8]; F.gmlp_norm_g = args.in[9]; F.gmlp_w = args.in[10]; F.gmlp_b = args.in[11]; F.mlstm_norm_g = args.in[12];
    F.w_out = args.in[13]; F.norm_ffn_g = args.in[14]; F.wq = args.in[15]; F.keys1 = args.in[16]; F.keys2 = args.in[17]; F.e_down = args.in[18]; F.e_up = args.in[19]; F.final_g = args.in[20];
    F.out = args.out;
    F.MODP = (float*)(ws + WS_MODP); F.MODF = (float*)(ws + WS_MODF); F.GATES = (float*)(ws + WS_GATES); F.SUMM = (float*)(ws + WS_SUMM); F.MTAB = (float*)(ws + WS_MTAB);
    F.NST = (float*)(ws + WS_NST); F.PG = (float*)(ws + WS_PG); F.IDX = (int*)(ws + WS_IDX);
    F.WIN = (bf16*)(ws + WS_WIN); F.WOUT = (bf16*)(ws + WS_WOUT); F.WQ = (bf16*)(ws + WS_WQ); F.HA = (bf16*)(ws + WS_HA); F.PROJ = (bf16*)(ws + WS_PROJ); F.QB = (bf16*)(ws + WS_PROJ);
    F.STATE = (bf16*)(ws + WS_STATE); F.VT = (bf16*)(ws + WS_VT); F.ED = ws + WS_ED; F.EU = ws + WS_EU; F.SD = (float*)(ws + WS_SD); F.SU = (float*)(ws + WS_SU);
    F.SSQP = (float*)(ws + WS_SSQP); F.BQP = (float*)(ws + WS_BQP); F.BIASQ = (float*)(ws + WS_BIASQ); F.X1B = (bf16*)(ws + WS_STATE);
    F.QC = (bf16*)args.out; F.KC = (bf16*)args.out + (size_t)M * 1024;
    for (int u = F.tid; u < (LDS_BYTES - LDSCTL_OFF) / 4; u += NWAVES * 64) ((LAS unsigned*)(F.lds + LDSCTL_OFF))[u] = 0u;
    __syncthreads();
    const int lo = args.ph_lo, hi = args.ph_hi;
    const bool multi = (hi - lo) > 1;
    XcdBarrier bar; bar.bar = (unsigned*)(F.ctl + CW_BAR) + args.li * XCD_BAR_WORDS; bar.x = 0; bar.st = nullptr;
    if (multi) bar = xcd_barrier_post((unsigned*)(F.ctl + CW_BAR) + args.li * XCD_BAR_WORDS, F.MISC + 8);
#ifndef PH_MASK
#define PH_MASK 0x7ff
#endif
#define IN(k) (((PH_MASK >> (k)) & 1) && lo <= (k) && (k) < hi)
#define SEAM(k) do { if (IN(k) && IN((k) + 1)) xcd_barrier(bar); } while (0)
    if (IN(0)) { p0a_phase(F); } SEAM(0);
    if (IN(1)) { p0b_phase(F); } SEAM(1);
    if (IN(2)) {
        { pg8::Gemm g{F.HA, F.WIN, M, NPROJ, D}; pg8::StaticOrder S; S.init(M, NPROJ, F.G, (int)blockIdx.x);
          pg8::EpiProj E{F.PROJ, NPROJ, 2048 / 256};
          pg8::gemm_phase<pg8::EpiProj, pg8::StaticOrder, PG8_ALIGN, PG8_SP2>(F.lds, g, S, E); }
        {
          pg8::Gemm g{F.WIN + (size_t)WROW_VM * D, F.HA, 1024, M, D}; pg8::StaticOrder S; S.init(1024, M, F.G, (int)blockIdx.x);
          pg8::EpiBf16<0> E{F.VT, M, nullptr, 0, 0, 1.f};
          pg8::gemm_phase<pg8::EpiBf16<0>, pg8::StaticOrder, PG8_ALIGN, PG8_SP2>(F.lds, g, S, E); }
    } SEAM(2);
    if (IN(3)) { p2_phase(F); } SEAM(3);
    if (IN(4)) { p3_phase(F); } SEAM(4);
    if (IN(5)) { p4_phase(F); } SEAM(5);
    if (IN(6)) {
        pg8::Gemm g{F.HA, F.WOUT, M, D, D}; pg8::StaticOrder S; S.init(M, D, F.G, (int)blockIdx.x);
        pg8::EpiResid2 E{F.x, F.MODF + MOD_GM, F.X1B, F.SSQP, D};
        pg8::gemm_phase<pg8::EpiResid2, pg8::StaticOrder, PG8_ALIGN, PG8_SP2>(F.lds, g, S, E);
    } SEAM(6);
    if (IN(7)) {
        pg8::Gemm g{F.X1B, F.WQ, M, D, D}; pg8::StaticOrder S; S.init(M, D, F.G, (int)blockIdx.x);
        LAS float* RSTDL = (LAS float*)(F.lds + RING_BYTES);
        { pg8::Unit u; for (int i = 0; S.next(i, u); ++i) { if (F.tid < 256) { const float* sp = F.SSQP + (size_t)(u.pm * 256 + F.tid) * 32; float ss = 0.f;
#pragma unroll
                    for (int q = 0; q < 8; ++q) { const f32x4 v = *(const GAS f32x4*)(sp + 4 * q); ss += (v.x + v.y) + (v.z + v.w); }
                    RSTDL[(u.pm & 1) * 256 + F.tid] = 1.0f / sqrtf(ss * (1.0f / D) + EPS); } } }
        __syncthreads();
        pg8::EpiQ E{F.QB, D, F.BIASQ, RSTDL};
        pg8::gemm_phase<pg8::EpiQ, pg8::StaticOrder, PG8_ALIGN, PG8_SP2>(F.lds, g, S, E);
    } SEAM(7);
#ifndef P8_ALT
#define P8_ALT 0
#endif
    if (IN(8)) { p8_phase(F); } SEAM(8);
#ifndef P9_V2
#define P9_V2 1
#endif
    if (IN(9)) { p9v2_phase(F); }
#undef IN
#undef SEAM
}

#ifndef MK_N_LAUNCHES
#define MK_N_LAUNCHES 1
#endif
extern "C" void kernel_launch(void* const* d_in, const int* in_sizes, int n_in, void* d_out, int out_size, void* d_ws, size_t ws_size, hipStream_t stream) {
    static int grid = 0;
    if (grid == 0) {
        if (n_in != 21 || in_sizes[0] != M * D || out_size != M * D || ws_size < WS_END) { fprintf(stderr, "kernel_launch: unexpected shapes (n_in %d, in0 %d, out %d, ws %zu); nothing launched\n", n_in, n_in > 0 ? in_sizes[0] : -1, out_size, ws_size); grid = -1; return; }
        int dev = 0, cus = 0, per_cu = 0;
        if (hipGetDevice(&dev) != hipSuccess || hipDeviceGetAttribute(&cus, hipDeviceAttributeMultiprocessorCount, dev) != hipSuccess) { grid = -1; return; }
        if (hipFuncSetAttribute((const void*)mk_fwd, hipFuncAttributeMaxDynamicSharedMemorySize, LDS_BYTES) != hipSuccess) { fprintf(stderr, "kernel_launch: hipFuncSetAttribute failed\n"); grid = -1; return; }
        if (hipOccupancyMaxActiveBlocksPerMultiprocessor(&per_cu, (const void*)mk_fwd, NWAVES * 64, LDS_BYTES) != hipSuccess || per_cu < 1) { fprintf(stderr, "kernel_launch: occupancy query says %d blocks per CU\n", per_cu); }
        (void)hipGetLastError();
        grid = cus;
    }
    if (grid < 0) return;
    (void)hipMemsetAsync((char*)d_ws + WS_CTL, 0, CTL_ZERO_BYTES, stream);
    Args a{};
    for (int i = 0; i < 21; ++i) a.in[i] = (const float*)d_in[i];
    a.out = (float*)d_out; a.ws = (unsigned char*)d_ws;
    if (MK_N_LAUNCHES == 1) { a.ph_lo = 0; a.ph_hi = N_PHASES; a.li = 0; hipLaunchKernelGGL(mk_fwd, dim3(grid), dim3(NWAVES * 64), LDS_BYTES, stream, a); }
    else for (int li = 0; li < N_PHASES; ++li) { a.ph_lo = li; a.ph_hi = li + 1; a.li = 0; hipLaunchKernelGGL(mk_fwd, dim3(grid), dim3(NWAVES * 64), LDS_BYTES, stream, a); }
}
```

```cpp
#include <hip/hip_runtime.h>
#include <cstdio>
#include <cstdint>
namespace pg8 {
#define PG8_LAS __attribute__((address_space(3)))
typedef unsigned short bf16_t;
typedef short bf16x8 __attribute__((ext_vector_type(8)));
typedef float f32x4 __attribute__((ext_vector_type(4)));
typedef unsigned u32x4 __attribute__((ext_vector_type(4)));
constexpr int BM = 256, BK = 64, HALF = 128, HTB = HALF * BK * 2  , STAGE_BYTES = 8 * HTB, NXCD = 8, WGM = 8;

__host__ __device__ __forceinline__ int lds_byte(int r, int c) { const int st = (r >> 4) * 2 + (c >> 5), rr = r & 15, cc = c & 31, ob = rr * 64 + cc * 2; return st * 1024 + (ob ^ (((ob >> 9) & 1) << 5)); }
__host__ __device__ __forceinline__ void stage_rc(int b, int& R, int& C) { const int st = b / 1024, sb = b % 1024, swz = sb ^ (((sb >> 9) & 1) << 5); R = (st >> 1) * 16 + swz / 64; C = (st & 1) * 32 + (swz % 64) / 2; }
__host__ __device__ __forceinline__ int perm32(int rho) { const int n = rho >> 4, i = rho & 15; return 8 * (i >> 2) + 4 * n + (i & 3); }

struct Unit { int pm, pn; };
struct Gemm { const bf16_t* A; const bf16_t* Bt; int M, N, K; };

struct StaticOrder {
    int nM, nN, nwg, G, c;
    __host__ __device__ void init(int M, int N, int G_, int c_) { nM = M / BM; nN = N / BM; nwg = nM * nN; G = G_; c = c_; }
    __host__ __device__ bool next(int i, Unit& u) const {
        const long L = (long)i * G + c; if (L >= nwg) return false;
        int wgid = (int)L; { const int q = nwg / NXCD, r = nwg % NXCD, xcd = wgid % NXCD, off = wgid / NXCD; wgid = (xcd < r ? xcd * (q + 1) : r * (q + 1) + (xcd - r) * q) + off; }
        const int nig = WGM * nN, gid = wgid / nig, fm = gid * WGM, gsz = (nM - fm) < WGM ? (nM - fm) : WGM;
        u.pm = fm + ((wgid % nig) % gsz); u.pn = (wgid % nig) / gsz; return true;
    }
    __device__ __forceinline__ void a_ready(const Unit&) const {}
    __device__ __forceinline__ void done(const Unit&) const {}
};

__device__ __forceinline__ unsigned cvt_pk_bf16(float lo, float hi) { unsigned r; asm volatile("v_cvt_pk_bf16_f32 %0, %1, %2" : "=v"(r) : "v"(lo), "v"(hi)); return r; }
typedef float f32x2 __attribute__((ext_vector_type(2)));
__device__ __forceinline__ f32x2 gelu_pk(f32x2 v) {
    const f32x2 av = __builtin_elementwise_abs(v), d = av * 0.2316418882f + 1.0f;
    f32x2 t; t.x = __builtin_amdgcn_rcpf(d.x); t.y = __builtin_amdgcn_rcpf(d.y);
    f32x2 q = t * 0.5307027145f + (-0.7265760135f); q = q * t + 0.7107068705f; q = q * t + (-0.142248368f); q = q * t + 0.127414796f; q = q * t;
    const f32x2 s = (v * v) * (-0.72134752044f);
    f32x2 e; e.x = __builtin_amdgcn_exp2f(s.x); e.y = __builtin_amdgcn_exp2f(s.y);
    const f32x2 m = v * (q * e), r = v - m;
    f32x2 o; o.x = v.x < 0.f ? m.x : r.x; o.y = v.y < 0.f ? m.y : r.y; return o;
}

template <int ACT  > struct EpiBf16 {
    static constexpr bool PERM = true, AFTER_DRAIN = false; static_assert(ACT == 0 || ACT == 1, "EpiBf16: ACT is 0 (none) or 1 (gelu_pk)");
    bf16_t* O; int ldc; const float* bias; int split_cols; size_t split_stride; float scale0;
    __device__ __forceinline__ void operator()(const f32x4 (&acc)[2][2][4][2], const Unit& u, int wr, int wc, int fr, int fq) const {
        const int row0 = u.pm * BM + wr * 64 + fr; int colt = u.pn * BM; bf16_t* base = O;
        float sc = 1.f; if (split_cols) { const int t = colt / split_cols; base += (size_t)t * split_stride; colt -= t * split_cols; if (t == 0) sc = scale0; }
        const int col0 = colt + wc * 32 + 8 * fq, bcol0 = u.pn * BM + wc * 32 + 8 * fq;
        f32x4 bv[2][2];
#pragma unroll
        for (int bj = 0; bj < 2; ++bj)
#pragma unroll
            for (int n = 0; n < 2; ++n) bv[bj][n] = bias ? *(const f32x4*)(bias + bcol0 + bj * HALF + 4 * n) : (f32x4){0.f, 0.f, 0.f, 0.f};
#pragma unroll
        for (int ai = 0; ai < 2; ++ai)
#pragma unroll
            for (int m = 0; m < 4; ++m) { bf16_t* rowp = base + (size_t)(row0 + ai * HALF + m * 16) * ldc + col0;
#pragma unroll
                for (int bj = 0; bj < 2; ++bj) { f32x4 v0 = acc[ai][bj][m][0] + bv[bj][0], v1 = acc[ai][bj][m][1] + bv[bj][1];
                    if (ACT == 1) { f32x2 a = gelu_pk((f32x2){v0[0], v0[1]}), b = gelu_pk((f32x2){v0[2], v0[3]}), c = gelu_pk((f32x2){v1[0], v1[1]}), d = gelu_pk((f32x2){v1[2], v1[3]});
                        v0 = (f32x4){a.x, a.y, b.x, b.y}; v1 = (f32x4){c.x, c.y, d.x, d.y}; }
                    v0 = v0 * sc; v1 = v1 * sc; u32x4 w; w.x = cvt_pk_bf16(v0[0], v0[1]); w.y = cvt_pk_bf16(v0[2], v0[3]); w.z = cvt_pk_bf16(v1[0], v1[1]); w.w = cvt_pk_bf16(v1[2], v1[3]);
                    *(u32x4*)(rowp + bj * HALF) = w; } }
    }
};

template <class Epi, class Sched, bool ALIGN_EPI = false, bool SP2 = false>
__device__ __forceinline__ void gemm_phase(PG8_LAS unsigned char* lds, const Gemm g, const Sched& S, const Epi& E) {
    const int tid = threadIdx.x, wid = __builtin_amdgcn_readfirstlane(tid >> 6), lane = tid & 63, wr = wid >> 2, wc = wid & 3, fr = lane & 15, fq = lane >> 4;
    const int K = g.K, nt = K / BK;
    unsigned voffA[2], voffB[2];
#pragma unroll
    for (int i = 0; i < 2; ++i) { int R, C; stage_rc(tid * 16 + i * 8192, R, C); const int Rb = Epi::PERM ? ((R & ~31) + perm32(R & 31)) : R;
        voffA[i] = (unsigned)(R * K + C) * 2u; voffB[i] = (unsigned)(Rb * K + C) * 2u; }
    const size_t kstep = (size_t)(BK * 2);
    const size_t hstep = (size_t)HALF * K * 2;
    const size_t tstep = 2 * hstep;
    const unsigned ldsw = (unsigned)wid * 1024u;
    const int aoff = lds_byte(wr * 64 + fr, fq * 8), boff = lds_byte(wc * 32 + fr, fq * 8);
#define PG8_SA(b, h) (((b) * 2 + (h)) * HTB)
#define PG8_SB(b, h) ((4 + (b) * 2 + (h)) * HTB)
#define PG8_STAGE(bufoff, gbase, voff) do { _Pragma("unroll") for (int _i = 0; _i < 2; ++_i) \
        __builtin_amdgcn_global_load_lds((const unsigned*)((const char*)(gbase) + (voff)[_i]), (PG8_LAS unsigned*)(lds + (bufoff) + ldsw + _i * 8192), 16, 0, 0); } while (0)
#define PG8_LDA(dst, b, h) do { _Pragma("unroll") for (int m = 0; m < 4; ++m) _Pragma("unroll") for (int k = 0; k < 2; ++k) dst[m][k] = *(const PG8_LAS bf16x8*)(lds + PG8_SA(b, h) + aoff + m * 2048 + k * 1024); } while (0)
#define PG8_LDB(dst, b, h) do { _Pragma("unroll") for (int n = 0; n < 2; ++n) _Pragma("unroll") for (int k = 0; k < 2; ++k) dst[n][k] = *(const PG8_LAS bf16x8*)(lds + PG8_SB(b, h) + boff + n * 2048 + k * 1024); } while (0)
#define PG8_MMA(ai, bj, At, Bt) do { __builtin_amdgcn_s_setprio(1); _Pragma("unroll") for (int m = 0; m < 4; ++m) _Pragma("unroll") for (int n = 0; n < 2; ++n) _Pragma("unroll") for (int k = 0; k < 2; ++k) \
        acc[ai][bj][m][n] = __builtin_amdgcn_mfma_f32_16x16x32_bf16(Bt[n][k], At[m][k], acc[ai][bj][m][n], 0, 0, 0); __builtin_amdgcn_s_setprio(0); } while (0)
#define PG8_WAIT_V(n) asm volatile("s_waitcnt vmcnt(" #n ")" ::: "memory")
#define PG8_WAIT_L(n) asm volatile("s_waitcnt lgkmcnt(" #n ")" ::: "memory")
#define PG8_BAR __builtin_amdgcn_s_barrier()
#define PG8_SCHED __builtin_amdgcn_sched_barrier(0)
    Unit cur, nxt; int ui = 0;
    if (!S.next(0, cur)) return;
    f32x4 acc[2][2][4][2];
#pragma unroll
    for (int a = 0; a < 2; ++a)
#pragma unroll
        for (int b = 0; b < 2; ++b)
#pragma unroll
            for (int m = 0; m < 4; ++m)
#pragma unroll
                for (int n = 0; n < 2; ++n) acc[a][b][m][n] = (f32x4){0.f, 0.f, 0.f, 0.f};
    bf16x8 At[4][2], B0[2][2], B1[2][2];
    const char* cA = (const char*)g.A + (size_t)cur.pm * tstep; const char* cB = (const char*)g.Bt + (size_t)cur.pn * tstep;
    S.a_ready(cur);
    if constexpr (SP2) {
        PG8_STAGE(PG8_SB(0, 0), cB, voffB); PG8_STAGE(PG8_SB(0, 1), cB + hstep, voffB); PG8_STAGE(PG8_SA(0, 0), cA, voffA); PG8_STAGE(PG8_SA(0, 1), cA + hstep, voffA);
        if (wr == 1) PG8_BAR;
        PG8_WAIT_V(2); PG8_BAR;
        PG8_STAGE(PG8_SB(1, 0), cB + kstep, voffB); PG8_STAGE(PG8_SA(1, 0), cA + kstep, voffA); PG8_STAGE(PG8_SB(1, 1), cB + hstep + kstep, voffB);
        PG8_WAIT_V(6); PG8_BAR;
    } else {
        PG8_STAGE(PG8_SB(0, 0), cB, voffB); PG8_STAGE(PG8_SA(0, 0), cA, voffA); PG8_STAGE(PG8_SB(0, 1), cB + hstep, voffB); PG8_STAGE(PG8_SA(0, 1), cA + hstep, voffA);
        if (wr == 1) PG8_BAR;
        PG8_WAIT_V(4); PG8_BAR;
        PG8_STAGE(PG8_SB(1, 0), cB + kstep, voffB); PG8_STAGE(PG8_SA(1, 0), cA + kstep, voffA); PG8_STAGE(PG8_SB(1, 1), cB + hstep + kstep, voffB);
        PG8_WAIT_V(6); PG8_BAR;
    }
    for (;;) {
        const bool has_next = S.next(ui + 1, nxt);
        const char* nA = has_next ? (const char*)g.A + (size_t)nxt.pm * tstep : cA; const char* nB = has_next ? (const char*)g.Bt + (size_t)nxt.pn * tstep : cB;
        for (int t = 0; t < nt; t += 2) {
            const bool last = (t == nt - 2);
            const char* a1 = cA + (size_t)(t + 1) * kstep;
            const char* a2 = last ? nA : cA + (size_t)(t + 2) * kstep; const char* b2 = last ? nB : cB + (size_t)(t + 2) * kstep;
            const char* a3 = a2 + kstep; const char* b3 = b2 + kstep;
            if (last && has_next) S.a_ready(nxt);
            if constexpr (SP2) {
            PG8_LDB(B0, 0, 0); PG8_LDB(B1, 0, 1); PG8_SCHED; PG8_LDA(At, 0, 0); PG8_STAGE(PG8_SA(1, 1), a1 + hstep, voffA);
            PG8_WAIT_V(8); PG8_WAIT_L(0); PG8_BAR; PG8_MMA(0, 0, At, B0); PG8_MMA(0, 1, At, B1); PG8_BAR; PG8_SCHED;
            PG8_LDA(At, 0, 1); PG8_STAGE(PG8_SB(0, 0), b2, voffB); PG8_STAGE(PG8_SB(0, 1), b2 + hstep, voffB); PG8_STAGE(PG8_SA(0, 0), a2, voffA);
            PG8_WAIT_V(8); PG8_WAIT_L(0); PG8_BAR; PG8_MMA(1, 0, At, B0); PG8_MMA(1, 1, At, B1); PG8_BAR; PG8_SCHED;
            PG8_LDB(B0, 1, 0); PG8_LDB(B1, 1, 1); PG8_SCHED; PG8_LDA(At, 1, 0); PG8_STAGE(PG8_SA(0, 1), a2 + hstep, voffA);
            PG8_WAIT_V(8); PG8_WAIT_L(0); PG8_BAR; PG8_MMA(0, 0, At, B0); PG8_MMA(0, 1, At, B1); PG8_BAR; PG8_SCHED;
            PG8_LDA(At, 1, 1); PG8_STAGE(PG8_SB(1, 0), b3, voffB); PG8_STAGE(PG8_SB(1, 1), b3 + hstep, voffB); PG8_STAGE(PG8_SA(1, 0), a3, voffA);
            PG8_WAIT_V(8); PG8_WAIT_L(0); PG8_BAR; PG8_MMA(1, 0, At, B0); PG8_MMA(1, 1, At, B1); PG8_BAR; PG8_SCHED;
            } else {
            PG8_LDB(B0, 0, 0); PG8_SCHED; PG8_LDA(At, 0, 0); PG8_STAGE(PG8_SA(1, 1), a1 + hstep, voffA);
            PG8_WAIT_L(8); PG8_BAR; PG8_WAIT_L(0); PG8_MMA(0, 0, At, B0); PG8_BAR; PG8_SCHED;
            PG8_LDB(B1, 0, 1); PG8_STAGE(PG8_SB(0, 0), b2, voffB);
            PG8_BAR; PG8_WAIT_L(0); PG8_MMA(0, 1, At, B1); PG8_BAR;
            PG8_LDA(At, 0, 1); PG8_STAGE(PG8_SA(0, 0), a2, voffA);
            PG8_BAR; PG8_WAIT_L(0); PG8_MMA(1, 0, At, B0); PG8_BAR; PG8_SCHED;
            PG8_STAGE(PG8_SB(0, 1), b2 + hstep, voffB);
            PG8_WAIT_V(6); PG8_BAR; PG8_MMA(1, 1, At, B1); PG8_BAR;
            PG8_LDB(B0, 1, 0); PG8_SCHED; PG8_LDA(At, 1, 0); PG8_STAGE(PG8_SA(0, 1), a2 + hstep, voffA);
            PG8_WAIT_L(8); PG8_BAR; PG8_WAIT_L(0); PG8_MMA(0, 0, At, B0); PG8_BAR; PG8_SCHED;
            PG8_LDB(B1, 1, 1); PG8_STAGE(PG8_SB(1, 0), b3, voffB);
            PG8_BAR; PG8_WAIT_L(0); PG8_MMA(0, 1, At, B1); PG8_BAR;
            PG8_LDA(At, 1, 1); PG8_STAGE(PG8_SA(1, 0), a3, voffA);
            PG8_BAR; PG8_WAIT_L(0); PG8_MMA(1, 0, At, B0); PG8_BAR; PG8_SCHED;
            PG8_STAGE(PG8_SB(1, 1), b3 + hstep, voffB);
            PG8_WAIT_V(6); PG8_BAR; PG8_MMA(1, 1, At, B1); PG8_BAR;
            }
        }
        if constexpr (ALIGN_EPI) { if (wr == 0) PG8_BAR; }
        if constexpr (!Epi::AFTER_DRAIN) { E(acc, cur, wr, wc, fr, fq); S.done(cur); }
        if (!has_next) break;
#pragma unroll
        for (int a = 0; a < 2; ++a)
#pragma unroll
            for (int b = 0; b < 2; ++b)
#pragma unroll
                for (int m = 0; m < 4; ++m)
#pragma unroll
                    for (int n = 0; n < 2; ++n) acc[a][b][m][n] = (f32x4){0.f, 0.f, 0.f, 0.f};
        cur = nxt; cA = nA; cB = nB; ++ui;
        if constexpr (ALIGN_EPI) { if (wr == 1) PG8_BAR; }
    }
    PG8_WAIT_V(0);
    if constexpr (!ALIGN_EPI) { if (wr == 0) PG8_BAR; }
    PG8_BAR;
    if constexpr (Epi::AFTER_DRAIN) { E.fused(acc, cur, wr, wc, fr, fq, lds, wid, lane); S.done(cur); }
#undef PG8_SA
#undef PG8_SB
#undef PG8_STAGE
#undef PG8_LDA
#undef PG8_LDB
#undef PG8_MMA
#undef PG8_WAIT_V
#undef PG8_WAIT_L
#undef PG8_BAR
#undef PG8_SCHED
}
}
namespace pg8 {
struct EpiProj {
    static constexpr bool PERM = true, AFTER_DRAIN = false;
    bf16_t* O; int ldc; int gelu_tiles;
    __device__ __forceinline__ void operator()(const f32x4 (&acc)[2][2][4][2], const Unit& u, int wr, int wc, int fr, int fq) const {
        const int row0 = u.pm * BM + wr * 64 + fr; const int col0 = u.pn * BM + wc * 32 + 8 * fq;
        const bool act = u.pn < gelu_tiles;
#pragma unroll
        for (int ai = 0; ai < 2; ++ai)
#pragma unroll
            for (int m = 0; m < 4; ++m) { bf16_t* rowp = O + (size_t)(row0 + ai * HALF + m * 16) * ldc + col0;
#pragma unroll
                for (int bj = 0; bj < 2; ++bj) { f32x4 v0 = acc[ai][bj][m][0], v1 = acc[ai][bj][m][1];
                    if (act) { f32x2 a = gelu_pk((f32x2){v0[0], v0[1]}), b = gelu_pk((f32x2){v0[2], v0[3]}), c = gelu_pk((f32x2){v1[0], v1[1]}), d = gelu_pk((f32x2){v1[2], v1[3]});
                        v0 = (f32x4){a.x, a.y, b.x, b.y}; v1 = (f32x4){c.x, c.y, d.x, d.y}; }
                    u32x4 w; w.x = cvt_pk_bf16(v0[0], v0[1]); w.y = cvt_pk_bf16(v0[2], v0[3]); w.z = cvt_pk_bf16(v1[0], v1[1]); w.w = cvt_pk_bf16(v1[2], v1[3]);
                    *(u32x4*)(rowp + bj * HALF) = w; } }
    }
};
struct EpiResid {
    static constexpr bool PERM = false, AFTER_DRAIN = false;
    const float* base; const float* gate; float* out; int ldc;
    __device__ __forceinline__ void operator()(const f32x4 (&acc)[2][2][4][2], const Unit& u, int wr, int wc, int fr, int fq) const {
        const int row0 = u.pm * BM + wr * 64 + fr, col0 = u.pn * BM + wc * 32 + 4 * fq;
        f32x4 gv[2][2];
#pragma unroll
        for (int bj = 0; bj < 2; ++bj)
#pragma unroll
            for (int n = 0; n < 2; ++n) gv[bj][n] = *(const f32x4*)(gate + col0 + bj * HALF + n * 16);
#pragma unroll
        for (int ai = 0; ai < 2; ++ai)
#pragma unroll
            for (int m = 0; m < 4; ++m) { const size_t off = (size_t)(row0 + ai * HALF + m * 16) * ldc + col0;
#pragma unroll
                for (int bj = 0; bj < 2; ++bj)
#pragma unroll
                    for (int n = 0; n < 2; ++n) { const f32x4 b = *(const f32x4*)(base + off + bj * HALF + n * 16); *(f32x4*)(out + off + bj * HALF + n * 16) = b + gv[bj][n] * acc[ai][bj][m][n]; } }
    }
};
struct EpiResid2 {
    static constexpr bool PERM = true, AFTER_DRAIN = false;
    const float* base; const float* gate; bf16_t* xb; float* ssq; int ldc;
    __device__ __forceinline__ void operator()(const f32x4 (&acc)[2][2][4][2], const Unit& u, int wr, int wc, int fr, int fq) const {
        const int row0 = u.pm * BM + wr * 64 + fr, col0 = u.pn * BM + wc * 32 + 8 * fq;
        f32x4 gv[2][2];
#pragma unroll
        for (int bj = 0; bj < 2; ++bj)
#pragma unroll
            for (int n = 0; n < 2; ++n) gv[bj][n] = *(const f32x4*)(gate + col0 + bj * HALF + 4 * n);
#pragma unroll
        for (int ai = 0; ai < 2; ++ai)
#pragma unroll
            for (int m = 0; m < 4; ++m) { const int row = row0 + ai * HALF + m * 16; const size_t off = (size_t)row * ldc + col0; float ss = 0.f;
#pragma unroll
                for (int bj = 0; bj < 2; ++bj) {
                    const f32x4 b0 = *(const f32x4*)(base + off + bj * HALF), b1 = *(const f32x4*)(base + off + bj * HALF + 4);
                    const f32x4 v0 = b0 + gv[bj][0] * acc[ai][bj][m][0], v1 = b1 + gv[bj][1] * acc[ai][bj][m][1];
                    ss += (v0[0] * v0[0] + v0[1] * v0[1]) + (v0[2] * v0[2] + v0[3] * v0[3]) + (v1[0] * v1[0] + v1[1] * v1[1]) + (v1[2] * v1[2] + v1[3] * v1[3]);
                    u32x4 w; w.x = cvt_pk_bf16(v0[0], v0[1]); w.y = cvt_pk_bf16(v0[2], v0[3]); w.z = cvt_pk_bf16(v1[0], v1[1]); w.w = cvt_pk_bf16(v1[2], v1[3]);
                    *(u32x4*)(xb + off + bj * HALF) = w; }
                ss += __shfl_xor(ss, 16); ss += __shfl_xor(ss, 32);
                if (fq == 0) ssq[(size_t)row * 32 + u.pn * 4 + wc] = ss; }
    }
};
struct EpiQ {
    static constexpr bool PERM = true, AFTER_DRAIN = false;
    bf16_t* O; int ldc; const float* bias; const PG8_LAS float* rstd;
    __device__ __forceinline__ void operator()(const f32x4 (&acc)[2][2][4][2], const Unit& u, int wr, int wc, int fr, int fq) const {
        const int lrow0 = wr * 64 + fr, col0 = u.pn * BM + wc * 32 + 8 * fq;
        f32x4 bv[2][2];
#pragma unroll
        for (int bj = 0; bj < 2; ++bj)
#pragma unroll
            for (int n = 0; n < 2; ++n) bv[bj][n] = *(const f32x4*)(bias + col0 + bj * HALF + 4 * n);
#pragma unroll
        for (int ai = 0; ai < 2; ++ai)
#pragma unroll
            for (int m = 0; m < 4; ++m) { const int lrow = lrow0 + ai * HALF + m * 16; const float rs = rstd[(u.pm & 1) * BM + lrow];
                bf16_t* rowp = O + (size_t)(u.pm * BM + lrow) * ldc + col0;
#pragma unroll
                for (int bj = 0; bj < 2; ++bj) { const f32x4 v0 = acc[ai][bj][m][0] * rs + bv[bj][0], v1 = acc[ai][bj][m][1] * rs + bv[bj][1];
                    u32x4 w; w.x = cvt_pk_bf16(v0[0], v0[1]); w.y = cvt_pk_bf16(v0[2], v0[3]); w.z = cvt_pk_bf16(v1[0], v1[1]); w.w = cvt_pk_bf16(v1[2], v1[3]);
                    *(u32x4*)(rowp + bj * HALF) = w; } }
    }
};
}
#ifndef PG8_SP2
#define PG8_SP2 true
#endif
#ifndef PG8_ALIGN
#define PG8_ALIGN true
#endif
constexpr int NWAVES = 8;
constexpr int M = 16384, D = 2048;
constexpr int IN_COLS = 6152, NWIN = 6144, NPROJ = 5120;
constexpr int C_UG = 0, C_VG = 1024, C_Q = 2048, C_K = 3072, C_OM = 4096;
constexpr int WROW_VM = 5120;
constexpr int NHEAD = 4, DH = 256, CH = 128, NCHUNK = M / CH;
constexpr int NEXP = 16384, PH = 8, TOPK = 16, NSEL = PH * TOPK;
constexpr float EPS = 1e-6f;
constexpr int MOD_SHM = 0, MOD_SCM = 2048, MOD_GM = 4096, MOD_SHF = 6144, MOD_SCF = 8192, MOD_GF = 10240, NMOD = 12288;
constexpr int ADA_KC = 16, ADA_KROWS = D / ADA_KC;

constexpr size_t MiB = 1u << 20;
constexpr size_t WS_CTL = 0, CTL_ZERO_BYTES = 1 * MiB;
constexpr size_t WS_MODP = 1 * MiB;
constexpr size_t WS_MODF = WS_MODP + (size_t)ADA_KC * NMOD * 4;
constexpr size_t WS_GATES = 2 * MiB;
constexpr size_t WS_SUMM = 2 * MiB + 512 * 1024;
constexpr size_t WS_MTAB = WS_SUMM + 8192;
constexpr size_t WS_NST = 3 * MiB;
constexpr size_t WS_WIN = 4 * MiB;
constexpr size_t WS_WOUT = 28 * MiB;
constexpr size_t WS_WQ = 36 * MiB;
constexpr size_t WS_IDX = 44 * MiB;
constexpr size_t WS_PG = 52 * MiB;
constexpr size_t WS_SSQP = 60 * MiB;
constexpr size_t WS_BQP = 62 * MiB, WS_BIASQ = 62 * MiB + 512 * 1024;
constexpr size_t WS_HA = 64 * MiB;
constexpr size_t WS_PROJ = 128 * MiB;
constexpr size_t WS_VT = 288 * MiB;
constexpr size_t WS_X1 = 192 * MiB;
constexpr size_t WS_STATE = 320 * MiB;
constexpr size_t WS_ED = 384 * MiB, WS_EU = 416 * MiB;
constexpr size_t WS_SD = 3 * MiB + 512 * 1024, WS_SU = WS_SD + 65536;
constexpr size_t WS_END = 512 * MiB;
constexpr int CW_TMO = 0, CW_CODE = 1, CW_BAR = 4096;

constexpr int RING_BYTES = 131072, LDSCTL_OFF = 163328, MISC_OFF = LDSCTL_OFF + 320, LDS_BYTES = 163840;

#define GAS __attribute__((address_space(1)))
#define LAS __attribute__((address_space(3)))
#define DI __device__ __forceinline__
typedef unsigned short bf16;
typedef unsigned v4u __attribute__((ext_vector_type(4)));
typedef unsigned v2u __attribute__((ext_vector_type(2)));
typedef float f32x4 __attribute__((ext_vector_type(4)));
typedef float f32x16 __attribute__((ext_vector_type(16)));
typedef short bf16x8 __attribute__((ext_vector_type(8)));
typedef GAS unsigned gu32;
#define RLX_AGENT __ATOMIC_RELAXED, __HIP_MEMORY_SCOPE_AGENT
#define LDS_WAIT() asm volatile("s_waitcnt lgkmcnt(0)" ::: "memory")
#define VM_WAIT() asm volatile("s_waitcnt vmcnt(0)" ::: "memory")
#define MFMA32(a, b, c) __builtin_amdgcn_mfma_f32_32x32x16_bf16((a), (b), (c), 0, 0, 0)
DI unsigned f2bf(float f) { unsigned u = __builtin_bit_cast(unsigned, f); return (u + 0x7fffu + ((u >> 16) & 1u)) >> 16; }
DI unsigned pk2(float lo, float hi) { return f2bf(lo) | (f2bf(hi) << 16); }
DI float bflo(unsigned w) { return __builtin_bit_cast(float, w << 16); }
DI float bfhi(unsigned w) { return __builtin_bit_cast(float, w & 0xffff0000u); }
DI float bf2f(unsigned short h) { return __builtin_bit_cast(float, (unsigned)h << 16); }
DI int crow(int reg, int h) { return (reg & 3) + 8 * (reg >> 2) + 4 * h; }
DI float wave_sum(float v) {
#pragma unroll
    for (int o = 1; o < 64; o <<= 1) v += __shfl_xor(v, o);
    return v;
}
DI float wave_max(float v) {
#pragma unroll
    for (int o = 1; o < 64; o <<= 1) v = fmaxf(v, __shfl_xor(v, o));
    return v;
}
DI float silu_f(float v) { return v / (1.0f + __expf(-v)); }
DI float sigmoid_f(float v) { return 1.0f / (1.0f + __expf(-v)); }
DI float gelu_f(float v) { return 0.5f * v * (1.0f + erff(v * 0.70710678118654752f)); }
typedef __bf16 bf16v2 __attribute__((ext_vector_type(2)));
#define DOT2(a, b, c) __builtin_amdgcn_fdot2_f32_bf16(__builtin_bit_cast(bf16v2, (unsigned)(a)), __builtin_bit_cast(bf16v2, (unsigned)(b)), (c), false)
DI f32x16 zero16() { f32x16 z; for (int i = 0; i < 16; ++i) z[i] = 0.f; return z; }
#define XB_TMO      128
#define XB_XCNT(j)  (256  + 64 * (j))
#define XB_XSUB(j)  (1280 + 64 * (j))
#define XB_XGEN(j)  (2304 + 64 * (j))
#define XB_TOP      3328
#define XB_TOPGEN   3392
#define XCD_BAR_WORDS 3456
#define XB_SPIN_CAP (1u << 18)

__device__ __forceinline__ unsigned xb_ld(unsigned* p)              { return __hip_atomic_load(p, __ATOMIC_RELAXED, __HIP_MEMORY_SCOPE_AGENT); }
__device__ __forceinline__ unsigned xb_add(unsigned* p, unsigned v) { return __hip_atomic_fetch_add(p, v, __ATOMIC_RELAXED, __HIP_MEMORY_SCOPE_AGENT); }
__device__ __forceinline__ unsigned xb_xcc_id() { return (unsigned)__builtin_amdgcn_s_getreg((3 << 11) | 20) & 0xFu; }
#define XB_SPIN(cond, bar) do { unsigned _sp = 0; while (cond) { __builtin_amdgcn_s_sleep(1); \
    if ((++_sp & 255u) == 0u) { if (xb_ld(&(bar)[XB_TMO])) break; if (_sp > XB_SPIN_CAP) { atomicAdd(&(bar)[XB_TMO], 1u); break; } } } } while (0)

struct XcdBarrier {
    unsigned* bar; unsigned x;
    volatile LAS unsigned* st;
};

__device__ __forceinline__ XcdBarrier xcd_barrier_post(unsigned* bar, volatile LAS unsigned* st) {
    XcdBarrier b; b.bar = bar; b.x = xb_xcc_id(); b.st = st;
    if (threadIdx.x == 0) (void)xb_add(&bar[XB_XCNT(b.x)], 1u);
    return b;
}
__device__ __forceinline__ void xcd_barrier_complete(unsigned* bar, unsigned x, unsigned& nloc, unsigned& nx) {
    const unsigned G = gridDim.x * gridDim.y * gridDim.z;
    unsigned sum, cnt, mine, sp = 0u;
    for (;;) {
        sum = 0u; cnt = 0u; mine = 0u;
#pragma unroll
        for (unsigned j = 0; j < 16; ++j) { const unsigned c = xb_ld(&bar[XB_XCNT(j)]); sum += c; cnt += (c > 0u) ? 1u : 0u; mine = (j == x) ? c : mine; }
        if (sum == G) break;
        __builtin_amdgcn_s_sleep(1);
        if ((++sp & 255u) == 0u) { if (xb_ld(&bar[XB_TMO])) break; if (sp > XB_SPIN_CAP) { atomicAdd(&bar[XB_TMO], 1u); break; } }
    }
    nloc = mine > 0u ? mine : 1u; nx = cnt > 0u ? cnt : 1u;
}

__device__ __forceinline__ void xcd_barrier(const XcdBarrier& b) {
    asm volatile("s_waitcnt vmcnt(0)" ::: "memory");
    __syncthreads();
    if (threadIdx.x == 0) {
        unsigned* bar = b.bar;
        __builtin_amdgcn_s_waitcnt(0);
        unsigned nloc = b.st[0], nx = b.st[1];
        if (nloc == 0u) { xcd_barrier_complete(bar, b.x, nloc, nx); b.st[0] = nloc; b.st[1] = nx; }
        const unsigned old = xb_add(&bar[XB_XSUB(b.x)], 1u);
        const unsigned gen = old / nloc;
        if (old + 1u == (gen + 1u) * nloc) {
            __builtin_amdgcn_fence(__ATOMIC_RELEASE, "agent");
            asm volatile("s_waitcnt vmcnt(0)" ::: "memory");
            const unsigned og = xb_add(&bar[XB_TOP], 1u);
            const unsigned tg = og / nx;
            if (og + 1u == (tg + 1u) * nx) xb_add(&bar[XB_TOPGEN], 1u);
            else XB_SPIN(xb_ld(&bar[XB_TOPGEN]) == tg, bar);
            __builtin_amdgcn_fence(__ATOMIC_ACQUIRE, "agent");
            xb_add(&bar[XB_XGEN(b.x)], 1u);
            asm volatile("s_waitcnt vmcnt(0)" ::: "memory");
        } else {
            XB_SPIN(xb_ld(&bar[XB_XGEN(b.x)]) == gen, bar);
            __builtin_amdgcn_fence(__ATOMIC_ACQUIRE, "agent");
            asm volatile("s_waitcnt vmcnt(0)" ::: "memory");
        }
    }
    __syncthreads();
}
struct Frame {
    LAS unsigned char* lds;
    volatile LAS unsigned* MISC;
    gu32* ctl;
    int tid, lane, wave, vcu, G;
    const float *x, *c, *ada_w, *ada_b, *norm_mix_g, *w_in, *b_gates, *conv_w, *conv_b, *gmlp_norm_g, *gmlp_w, *gmlp_b, *mlstm_norm_g, *w_out, *norm_ffn_g,
                *wq, *keys1, *keys2, *e_down, *e_up, *final_g;
    float* out;
    float *MODP, *MODF, *GATES, *SUMM, *MTAB, *NST, *PG;
    int* IDX;
    bf16 *WIN, *WOUT, *WQ, *HA, *PROJ, *QB, *STATE, *QC, *KC, *VT;
    unsigned char *ED, *EU; float *SD, *SU;
    float *SSQP, *BQP, *BIASQ; bf16* X1B;
};

DI void p0_transpose_item(const float* W, int K, int ldw, int nblk, bf16* WT, LAS float* scr, int item, int lane, bool vm_last = false) {
    const int kb = item / nblk, nb = item % nblk, k0 = 64 * kb, n0 = 32 * nb;
    const int d0 = !vm_last ? n0 : (n0 < 4096 ? n0 : (n0 < 5120 ? n0 + 1024 : n0 - 1024));
#pragma unroll 8
    for (int i = 0; i < 32; ++i) { const int kk = 2 * i + (lane >> 5); scr[kk * 33 + (lane & 31)] = W[(size_t)(k0 + kk) * ldw + n0 + (lane & 31)]; }
    LDS_WAIT(); asm volatile("" ::: "memory");
    const int c = lane & 7;
#pragma unroll
    for (int j = 0; j < 4; ++j) { const int n = (lane >> 3) + 8 * j; const LAS float* s = scr + (8 * c) * 33 + n;
        v4u o; o.x = pk2(s[0 * 33], s[1 * 33]); o.y = pk2(s[2 * 33], s[3 * 33]); o.z = pk2(s[4 * 33], s[5 * 33]); o.w = pk2(s[6 * 33], s[7 * 33]);
        *(GAS v4u*)(WT + (size_t)(d0 + n) * K + k0 + 8 * c) = o; }
    LDS_WAIT(); asm volatile("" ::: "memory");
}
DI void p0_ada_item(Frame& F, LAS float* scr, int item) {
    const int cc = item % (NMOD / 256), kc = item / (NMOD / 256), k0 = kc * ADA_KROWS, col = cc * 256 + F.lane * 4;
#pragma unroll
    for (int j = 0; j < ADA_KROWS / 64; ++j) scr[F.lane + 64 * j] = silu_f(F.c[k0 + F.lane + 64 * j]);
    LDS_WAIT(); asm volatile("" ::: "memory");
    f32x4 acc = {0.f, 0.f, 0.f, 0.f};
    const float* wp = F.ada_w + (size_t)k0 * NMOD + col;
#pragma unroll 8
    for (int kk = 0; kk < ADA_KROWS; ++kk) { const float s = scr[kk]; const f32x4 w = *(const GAS f32x4*)(wp + (size_t)kk * NMOD); acc += w * s; }
    *(GAS f32x4*)(F.MODP + (size_t)kc * NMOD + col) = acc;
    LDS_WAIT(); asm volatile("" ::: "memory");
}
DI void p0a_phase(Frame& F) {
    LAS float* scr = (LAS float*)(F.lds + F.wave * 16384);
    const int gw = F.wave * F.G + F.vcu, NGW = F.G * NWAVES;
    constexpr int I_ADA = (NMOD / 256) * ADA_KC;
    constexpr int I_WIN = (D / 64) * (NWIN / 32), I_WO = (D / 64) * (D / 32);
    constexpr int NITEMS = I_ADA + I_WIN + I_WO;
    for (int it = gw; it < NITEMS; it += NGW) {
        int r = it;
        if (r < I_ADA) { p0_ada_item(F, scr, r); continue; } r -= I_ADA;
        if (r < I_WIN) { p0_transpose_item(F.w_in, D, IN_COLS, NWIN / 32, F.WIN, scr, r, F.lane, true); continue; } r -= I_WIN;
        p0_transpose_item(F.w_out, D, D, D / 32, F.WOUT, scr, r, F.lane);
    }
#pragma unroll 1
    for (int row = gw; row < 2 * NEXP; row += NGW) {
        const int tb = row >= NEXP, e = row - tb * NEXP;
        const GAS f32x4* src = (const GAS f32x4*)((tb ? F.e_up : F.e_down) + (size_t)e * D) + F.lane;
        f32x4 v[8]; float am = 0.f;
#pragma unroll
        for (int j = 0; j < 8; ++j) { v[j] = src[64 * j]; am = fmaxf(am, fmaxf(fmaxf(fabsf(v[j].x), fabsf(v[j].y)), fmaxf(fabsf(v[j].z), fabsf(v[j].w)))); }
        am = fmaxf(wave_max(am), 1e-30f);
        const float sc = am * (1.0f / 127.0f), inv = 127.0f / am;
        GAS unsigned* dst = (GAS unsigned*)((tb ? F.EU : F.ED) + (size_t)e * D) + F.lane;
        const int off = tb ? 128 : 0;
#pragma unroll
        for (int j = 0; j < 8; ++j) {
            const int q0 = (int)__builtin_rintf(v[j].x * inv) + off, q1 = (int)__builtin_rintf(v[j].y * inv) + off, q2 = (int)__builtin_rintf(v[j].z * inv) + off, q3 = (int)__builtin_rintf(v[j].w * inv) + off;
            dst[64 * j] = (unsigned)(q0 & 255) | ((unsigned)(q1 & 255) << 8) | ((unsigned)(q2 & 255) << 16) | ((unsigned)(q3 & 255) << 24);
        }
        if (F.lane == 0) (tb ? F.SU : F.SD)[e] = sc;
    }
}
DI float mod_final(Frame& F, int col) { float s = F.ada_b[col];
#pragma unroll
    for (int k = 0; k < ADA_KC; ++k) s += F.MODP[(size_t)k * NMOD + col];
    return s; }
DI void norm_tables(Frame& F, const float* g, int col_scale, int col_shift) {
    LAS float* A1 = (LAS float*)(F.lds); LAS float* B1 = (LAS float*)(F.lds + 8192);
#pragma unroll
    for (int i = 0; i < 4; ++i) { const int c = F.tid + 512 * i; A1[c] = g[c] * (1.0f + F.MODF[col_scale + c]); B1[c] = F.MODF[col_shift + c]; }
}
DI void p0_wq_item(Frame& F, LAS float* scr, int item) {
    const int lane = F.lane, nblk = D / 32, kb = item / nblk, nb = item % nblk, k0 = 64 * kb, n0 = 32 * nb;
    LAS float* gsl = scr + 64 * 33; LAS float* shl = gsl + 64;
    gsl[lane] = F.norm_ffn_g[k0 + lane] * (1.0f + mod_final(F, MOD_SCF + k0 + lane)); shl[lane] = mod_final(F, MOD_SHF + k0 + lane);
    LDS_WAIT(); asm volatile("" ::: "memory");
    float bp = 0.f;
#pragma unroll 8
    for (int i = 0; i < 32; ++i) { const int kk = 2 * i + (lane >> 5); const float w = F.wq[(size_t)(k0 + kk) * D + n0 + (lane & 31)]; scr[kk * 33 + (lane & 31)] = w * gsl[kk]; bp += w * shl[kk]; }
    bp += __shfl_xor(bp, 32);
    if (lane < 32) F.BQP[(size_t)kb * D + n0 + lane] = bp;
    LDS_WAIT(); asm volatile("" ::: "memory");
    const int c = lane & 7;
#pragma unroll
    for (int j = 0; j < 4; ++j) { const int n = (lane >> 3) + 8 * j; const LAS float* sp = scr + (8 * c) * 33 + n;
        v4u o; o.x = pk2(sp[0 * 33], sp[1 * 33]); o.y = pk2(sp[2 * 33], sp[3 * 33]); o.z = pk2(sp[4 * 33], sp[5 * 33]); o.w = pk2(sp[6 * 33], sp[7 * 33]);
        *(GAS v4u*)(F.WQ + (size_t)(n0 + n) * D + k0 + 8 * c) = o; }
    LDS_WAIT(); asm volatile("" ::: "memory");
}
DI void p0b_phase(Frame& F) {
    LAS float* A1 = (LAS float*)(F.lds); LAS float* B1 = (LAS float*)(F.lds + 8192); LAS float* WG = (LAS float*)(F.lds + 16384);
#pragma unroll
    for (int i = 0; i < 4; ++i) { const int c = F.tid + 512 * i; A1[c] = F.norm_mix_g[c] * (1.0f + mod_final(F, MOD_SCM + c)); B1[c] = mod_final(F, MOD_SHM + c); }
    { const int per = (NMOD + F.G - 1) / F.G; const int c = (int)blockIdx.x * per + F.tid; if (F.tid < per && c < NMOD) F.MODF[c] = mod_final(F, c); }
#pragma unroll
    for (int i = 0; i < 4; ++i) { const int k = F.tid + 512 * i; const f32x4 a = *(const GAS f32x4*)(F.w_in + (size_t)k * IN_COLS + NWIN), b = *(const GAS f32x4*)(F.w_in + (size_t)k * IN_COLS + NWIN + 4);
        WG[0 * 2048 + k] = a.x; WG[1 * 2048 + k] = a.y; WG[2 * 2048 + k] = a.z; WG[3 * 2048 + k] = a.w; WG[4 * 2048 + k] = b.x; WG[5 * 2048 + k] = b.y; WG[6 * 2048 + k] = b.z; WG[7 * 2048 + k] = b.w; }
    __syncthreads();
    const int gw = F.vcu * NWAVES + F.wave, NGW = F.G * NWAVES;
    f32x4 vn[8];
    { const GAS f32x4* xr = (const GAS f32x4*)(F.x + (size_t)gw * D) + F.lane;
#pragma unroll
      for (int j = 0; j < 8; ++j) vn[j] = xr[64 * j]; }
#pragma unroll 1
    for (int row = gw; row < M; row += NGW) {
        f32x4 v[8]; float ss = 0.f;
#pragma unroll
        for (int j = 0; j < 8; ++j) { v[j] = vn[j]; ss += (v[j].x * v[j].x + v[j].y * v[j].y) + (v[j].z * v[j].z + v[j].w * v[j].w); }
        if (row + NGW < M) { const GAS f32x4* xr = (const GAS f32x4*)(F.x + (size_t)(row + NGW) * D) + F.lane;
#pragma unroll
            for (int j = 0; j < 8; ++j) vn[j] = xr[64 * j]; }
        const float rstd = 1.0f / sqrtf(wave_sum(ss) * (1.0f / D) + EPS);
        float gd[8];
#pragma unroll
        for (int g = 0; g < 8; ++g) gd[g] = 0.f;
        GAS v2u* o8 = (GAS v2u*)(F.HA + (size_t)row * D) + F.lane;
#pragma unroll
        for (int j = 0; j < 8; ++j) {
            const f32x4 a = *(const LAS f32x4*)(A1 + 256 * j + 4 * F.lane), b = *(const LAS f32x4*)(B1 + 256 * j + 4 * F.lane);
            const f32x4 h = v[j] * rstd * a + b;
            v2u o; o.x = pk2(h.x, h.y); o.y = pk2(h.z, h.w); o8[64 * j] = o;
#pragma unroll
            for (int g = 0; g < 8; ++g) { const f32x4 w = *(const LAS f32x4*)(WG + g * 2048 + 256 * j + 4 * F.lane); gd[g] += (h.x * w.x + h.y * w.y) + (h.z * w.z + h.w * w.w); }
            asm volatile("" ::: "memory");
        }
#pragma unroll
        for (int g = 0; g < 8; ++g) gd[g] = wave_sum(gd[g]);
        if (F.lane == 0) {
#pragma unroll
            for (int g = 0; g < 8; ++g) { float p = gd[g] + F.b_gates[g];
                if (g >= 4) { p = fminf(p, 0.f) - log1pf(__expf(-fabsf(p))); }
                F.GATES[(size_t)row * 8 + g] = p; }
        }
    }
    __syncthreads();
    {
        LAS float* scr = (LAS float*)(F.lds + F.wave * 8960);
        for (int it = F.wave * F.G + F.vcu; it < (D / 64) * (D / 32); it += NGW) p0_wq_item(F, scr, it);
    }
}
constexpr int IMG_PITCH = 576, M1_WL = 73728, M1_RED = 74240, M1_OB = 90624;
typedef short s16x4 __attribute__((ext_vector_type(4)));
DI bf16x8 tr_frag(const LAS unsigned char* p, int off_lo, int off_hi) {
    const s16x4 lo = __builtin_amdgcn_ds_read_tr16_b64_v4i16((LAS s16x4*)(p + off_lo));
    const s16x4 hi = __builtin_amdgcn_ds_read_tr16_b64_v4i16((LAS s16x4*)(p + off_hi));
    return __builtin_shufflevector(lo, hi, 0, 1, 2, 3, 4, 5, 6, 7);
}
DI float bfel(const v4u& w, int e) { const unsigned d = w[e >> 1]; return (e & 1) ? bfhi(d) : bflo(d); }
DI void m1_item(Frame& F, int hh, int kc) {
    LAS unsigned char* IMG = F.lds; LAS float* WL = (LAS float*)(F.lds + M1_WL); LAS float* RED = (LAS float*)(F.lds + M1_RED);
    const int t0 = kc * CH, lane = F.lane, tid = F.tid;
    if (F.wave == 0) {
        const float* gp = F.GATES + (size_t)(t0 + 2 * lane) * 8;
        const float i0 = gp[hh], lf0 = gp[4 + hh], i1 = gp[8 + hh], lf1 = gp[12 + hh];
        const float p = lf0 + lf1; float inc = p;
#pragma unroll
        for (int o = 1; o < 64; o <<= 1) { const float t = __shfl_up(inc, o); if (lane >= o) inc += t; }
        const float A = __shfl(inc, 63), ex = inc - p, b0 = ex + lf0, b1 = ex + p;
        const float lw0 = A - b0 + i0, lw1 = A - b1 + i1;
        const float B = wave_max(fmaxf(lw0, lw1));
        WL[2 * lane] = __expf(lw0 - B); WL[2 * lane + 1] = __expf(lw1 - B);
        if (lane == 0) { F.SUMM[(hh * NCHUNK + kc) * 2] = A; F.SUMM[(hh * NCHUNK + kc) * 2 + 1] = B; }
    }
    __syncthreads();
    const int dg = tid & 31, sg = tid >> 5;
#pragma unroll 1
    for (int which = 0; which < 2; ++which) {
        const int chb = (which == 0 ? 1024 : 0) + hh * DH + dg * 8;
        const int colb = (which == 0 ? C_K : C_Q) + hh * DH + dg * 8;
        v4u raw[11];
#pragma unroll
        for (int rr = 0; rr < 11; ++rr) { const int tt = t0 + sg * 8 - 3 + rr; raw[rr] = (v4u){0u, 0u, 0u, 0u}; if (tt >= 0) raw[rr] = *(const GAS v4u*)(F.PROJ + (size_t)tt * NPROJ + colb); }
        float wl[8];
#pragma unroll
        for (int i = 0; i < 8; ++i) wl[i] = (which == 0) ? WL[sg * 8 + i] : 0.0625f;
        v4u o1[8], o2[8];
#pragma unroll
        for (int dw = 0; dw < 4; ++dw) {
            typedef float f32x2 __attribute__((ext_vector_type(2)));
            f32x2 cw[4];
#pragma unroll
            for (int j = 0; j < 4; ++j) cw[j] = *(const GAS f32x2*)(F.conv_w + j * 2048 + chb + 2 * dw);
            const f32x2 cb = *(const GAS f32x2*)(F.conv_b + chb + 2 * dw);
            float xl[11], xh[11];
#pragma unroll
            for (int rr = 0; rr < 11; ++rr) { xl[rr] = bflo(raw[rr][dw]); xh[rr] = bfhi(raw[rr][dw]); }
            float d0 = 0.f, d1 = 0.f;
#pragma unroll
            for (int i = 0; i < 8; ++i) {
                float a0 = cb.x, a1 = cb.y;
#pragma unroll
                for (int j = 0; j < 4; ++j) { a0 += cw[j].x * xl[i + j]; a1 += cw[j].y * xh[i + j]; }
                a0 = silu_f(a0); a1 = silu_f(a1);
                if (which == 0) { o1[i][dw] = pk2(a0, a1); a0 *= wl[i]; a1 *= wl[i]; d0 += a0; d1 += a1; o2[i][dw] = pk2(a0, a1); }
                else { o1[i][dw] = pk2(a0 * wl[i], a1 * wl[i]); }
            }
            if (which == 0) { RED[sg * 256 + dg * 8 + 2 * dw] = d0; RED[sg * 256 + dg * 8 + 2 * dw + 1] = d1; }
            asm volatile("" ::: "memory");
        }
#pragma unroll
        for (int i = 0; i < 8; ++i) { const int s = sg * 8 + i, t = t0 + s;
            if (which == 0) { *(GAS v4u*)(F.KC + (size_t)t * 1024 + hh * DH + dg * 8) = o1[i]; *(LAS v4u*)(IMG + s * IMG_PITCH + dg * 16) = o2[i]; }
            else { *(GAS v4u*)(F.QC + (size_t)t * 1024 + hh * DH + dg * 8) = o1[i]; } }
    }
    __syncthreads();
    if (tid < 256) { float s = 0.f;
#pragma unroll
        for (int i = 0; i < 16; ++i) s += RED[i * 256 + tid];
        F.NST[(size_t)(hh * NCHUNK + kc) * DH + tid] = s; }
    const int r = lane & 31, h = lane >> 5, e0 = F.wave * 32;
    bf16x8 bf[8];
#pragma unroll
    for (int ks = 0; ks < 8; ++ks) {
        bf[ks] = *(const GAS bf16x8*)(F.VT + (size_t)(hh * DH + e0 + r) * M + t0 + ks * 16 + 8 * h);
    }
    const LAS unsigned char* trb = IMG + (8 * h + ((lane & 15) >> 2)) * IMG_PITCH + (16 * ((lane >> 4) & 1) + 4 * (lane & 3)) * 2;
    LAS unsigned char* OB = F.lds + M1_OB + F.wave * (32 * 144);
#pragma unroll 1
    for (int dp = 0; dp < 4; ++dp) {
#pragma unroll
        for (int d2 = 0; d2 < 2; ++d2) {
            const int dt = 2 * dp + d2;
            f32x16 acc = zero16();
#pragma unroll
            for (int ks = 0; ks < 8; ++ks) { const bf16x8 af = tr_frag(trb + dt * 64, ks * 16 * IMG_PITCH, ks * 16 * IMG_PITCH + 4 * IMG_PITCH); acc = MFMA32(af, bf[ks], acc); }
#pragma unroll
            for (int g = 0; g < 4; ++g) { v2u o; o.x = pk2(acc[4 * g], acc[4 * g + 1]); o.y = pk2(acc[4 * g + 2], acc[4 * g + 3]);
                *(LAS v2u*)(OB + r * 144 + (d2 * 32 + 8 * g + 4 * h) * 2) = o; }
        }
        LDS_WAIT(); asm volatile("" ::: "memory");
#pragma unroll
        for (int i = 0; i < 4; ++i) { const int q = lane + 64 * i, row = q >> 3, c16 = q & 7;
            *(GAS v4u*)(F.STATE + (size_t)(hh * NCHUNK + kc) * (DH * DH) + (size_t)(e0 + row) * DH + dp * 64 + c16 * 8) = *(const LAS v4u*)(OB + row * 144 + c16 * 16); }
        LDS_WAIT(); asm volatile("" ::: "memory");
    }
    __syncthreads();
}
constexpr int G_WI = 0, G_VI = 34816, G_UI = 75776, G_WP = 272, G_VP = 320, G_UP = 272;
DI void gmlp_block(Frame& F, int g, int n0, int nch) {
    LAS unsigned char* WI = F.lds + G_WI; LAS unsigned char* VI = F.lds + G_VI; LAS unsigned char* UI = F.lds + G_UI;
    const int c0 = g * 128, lane = F.lane, tid = F.tid;
    {
#pragma unroll
        for (int i = 0; i < 8; ++i) { const int p = tid + 512 * i, t = p >> 5, s4 = (p & 31) * 4;
            const f32x4 w = *(const GAS f32x4*)(F.gmlp_w + (size_t)(g * 128 + t) * 128 + s4);
            v2u o; o.x = pk2(s4 <= t ? w.x : 0.f, s4 + 1 <= t ? w.y : 0.f); o.y = pk2(s4 + 2 <= t ? w.z : 0.f, s4 + 3 <= t ? w.w : 0.f);
            *(LAS v2u*)(WI + t * G_WP + s4 * 2) = o; }
    }
    v4u tv[4], tu[4];
#define G_LOAD(N) do { _Pragma("unroll") for (int i = 0; i < 4; ++i) { const int p = tid + 512 * i; const bf16* rowp = F.PROJ + (size_t)((N) * CH + (p >> 4)) * NPROJ + c0 + (p & 15) * 8; \
        tv[i] = *(const GAS v4u*)(rowp + C_VG); tu[i] = *(const GAS v4u*)(rowp + C_UG); } } while (0)
    G_LOAD(n0);
    const int r = lane & 31, h = lane >> 5, ct = F.wave & 3, tp = F.wave >> 2;
    float ng[16];
#pragma unroll
    for (int reg = 0; reg < 16; ++reg) ng[reg] = F.gmlp_norm_g[g * 128 + ct * 32 + crow(reg, h)];
    const LAS unsigned char* trb = VI + (8 * h + ((lane & 15) >> 2)) * G_VP + (ct * 32 + 16 * ((lane >> 4) & 1) + 4 * (lane & 3)) * 2;
#pragma unroll 1
    for (int ci = 0; ci < nch; ++ci) {
        const int n = n0 + ci, t0 = n * CH;
#pragma unroll
        for (int i = 0; i < 4; ++i) { const int p = tid + 512 * i, row = p >> 4, c16 = p & 15; const v4u w = tv[i];
            float a[8] = {bflo(w.x), bfhi(w.x), bflo(w.y), bfhi(w.y), bflo(w.z), bfhi(w.z), bflo(w.w), bfhi(w.w)};
            float ss = (a[0] * a[0] + a[1] * a[1]) + (a[2] * a[2] + a[3] * a[3]) + (a[4] * a[4] + a[5] * a[5]) + (a[6] * a[6] + a[7] * a[7]);
            ss += __shfl_xor(ss, 1); ss += __shfl_xor(ss, 2); ss += __shfl_xor(ss, 4); ss += __shfl_xor(ss, 8);
            const float rs = 1.0f / sqrtf(ss * (1.0f / 128.0f) + EPS);
            v4u o; o.x = pk2(a[0] * rs, a[1] * rs); o.y = pk2(a[2] * rs, a[3] * rs); o.z = pk2(a[4] * rs, a[5] * rs); o.w = pk2(a[6] * rs, a[7] * rs);
            *(LAS v4u*)(VI + row * G_VP + c16 * 16) = o; *(LAS v4u*)(UI + row * G_UP + c16 * 16) = tu[i]; }
        __syncthreads();
        if (ci + 1 < nch) G_LOAD(n + 1);
#pragma unroll 1
        for (int ti = 0; ti < 2; ++ti) {
            const int tt = (ti == 0) ? tp : 3 - tp;
            const int t = tt * 32 + r;
            const LAS unsigned char* wrow = WI + t * G_WP + 16 * h;
            f32x16 acc = zero16();
#pragma unroll
            for (int ks = 0; ks < 8; ++ks) if (ks <= 2 * tt + 1) {
                const bf16x8 af = tr_frag(trb, ks * 16 * G_VP, ks * 16 * G_VP + 4 * G_VP);
                const bf16x8 bw = *(const LAS bf16x8*)(wrow + 32 * ks);
                acc = MFMA32(af, bw, acc);
            }
            const float bsp = F.gmlp_b[g * 128 + t];
            LAS unsigned char* urow = UI + t * G_UP + (ct * 32 + 4 * h) * 2;
#pragma unroll
            for (int gq = 0; gq < 4; ++gq) { LAS v2u* up = (LAS v2u*)(urow + 16 * gq);
                const v2u uw = *up;
                const float y0 = bflo(uw.x) * (ng[4 * gq] * acc[4 * gq] + bsp), y1 = bfhi(uw.x) * (ng[4 * gq + 1] * acc[4 * gq + 1] + bsp);
                const float y2 = bflo(uw.y) * (ng[4 * gq + 2] * acc[4 * gq + 2] + bsp), y3 = bfhi(uw.y) * (ng[4 * gq + 3] * acc[4 * gq + 3] + bsp);
                v2u o; o.x = pk2(y0, y1); o.y = pk2(y2, y3); *up = o; }
        }
        __syncthreads();
#pragma unroll
        for (int i = 0; i < 4; ++i) { const int p = tid + 512 * i, row = p >> 4, c16 = p & 15;
            *(GAS v4u*)(F.HA + (size_t)(t0 + row) * D + c0 + c16 * 8) = *(const LAS v4u*)(UI + row * G_UP + c16 * 16); }
        __syncthreads();
    }
#undef G_LOAD
}
DI void p2_phase(Frame& F) {
    constexpr int N_M1 = NHEAD * NCHUNK;
#pragma unroll 1
    for (int it = (int)blockIdx.x; it < N_M1; it += F.G) m1_item(F, it / NCHUNK, it % NCHUNK);
    { const int per = (8 * (M / CH) + F.G - 1) / F.G;
      const int first = (int)blockIdx.x * per;
      if (first < 8 * (M / CH)) { const int g = first / (M / CH), n0 = first % (M / CH); int nch = per; if (n0 + nch > M / CH) nch = M / CH - n0; gmlp_block(F, g, n0, nch); } }
}
DI void p3_phase(Frame& F) {
    LAS float* TAB = (LAS float*)F.lds;
    const int lane = F.lane;
    if (F.wave < NHEAD) {
        const int hh = F.wave; const float* sp = F.SUMM + (size_t)(hh * NCHUNK + 2 * lane) * 2;
        const float A0 = sp[0], B0 = sp[1], A1 = sp[2], B1 = sp[3];
        float ca = A0 + A1, cb = fmaxf(B0 + A1, B1);
        const float pa = ca, pb = cb;
#pragma unroll
        for (int o = 1; o < 64; o <<= 1) { const float ta = __shfl_up(ca, o), tb = __shfl_up(cb, o); if (lane >= o) { cb = fmaxf(tb + ca, cb); ca = ta + ca; } }
        (void)pa; (void)pb;
        float ea = __shfl_up(ca, 1), eb = __shfl_up(cb, 1);
        float m0 = (lane == 0) ? 0.f : fmaxf(ea, eb);
        const float m1 = fmaxf(m0 + A0, B0), m2 = fmaxf(m1 + A1, B1);
        TAB[(hh * NCHUNK + 2 * lane) * 2] = __expf(A0 + m0 - m1); TAB[(hh * NCHUNK + 2 * lane) * 2 + 1] = __expf(B0 - m1);
        TAB[(hh * NCHUNK + 2 * lane + 1) * 2] = __expf(A1 + m1 - m2); TAB[(hh * NCHUNK + 2 * lane + 1) * 2 + 1] = __expf(B1 - m2);
        if (blockIdx.x == 0) { F.MTAB[hh * NCHUNK + 2 * lane] = m0; F.MTAB[hh * NCHUNK + 2 * lane + 1] = m1; }
    }
    __syncthreads();
    const int NT = F.G * NWAVES * 64, gt = (int)blockIdx.x * (NWAVES * 64) + F.tid;
    if (gt < D) { float b = 0.f;
#pragma unroll 8
        for (int k = 0; k < D / 64; ++k) b += F.BQP[(size_t)k * D + gt];
        F.BIASQ[gt] = b; }
    for (int p = gt; p < NHEAD * (DH * DH / 2); p += NT) {
        const int hh = p / (DH * DH / 2), q = p % (DH * DH / 2);
        GAS unsigned* sp = (GAS unsigned*)(F.STATE + (size_t)hh * NCHUNK * (DH * DH)) + q;
        float s0 = 0.f, s1 = 0.f;
#pragma unroll 1
        for (int k0 = 0; k0 < NCHUNK; k0 += 16) {
            unsigned ld[16];
#pragma unroll
            for (int k = 0; k < 16; ++k) ld[k] = sp[(size_t)(k0 + k) * (DH * DH / 2)];
#pragma unroll
            for (int k = 0; k < 16; ++k) {
                sp[(size_t)(k0 + k) * (DH * DH / 2)] = pk2(s0, s1);
                const float dec = TAB[(hh * NCHUNK + k0 + k) * 2], wb = TAB[(hh * NCHUNK + k0 + k) * 2 + 1];
                s0 = dec * s0 + wb * bflo(ld[k]); s1 = dec * s1 + wb * bfhi(ld[k]);
            }
        }
    }
    for (int p = gt; p < NHEAD * DH; p += NT) {
        const int hh = p / DH, d = p % DH; float* np = F.NST + (size_t)hh * NCHUNK * DH + d; float s = 0.f;
#pragma unroll 8
        for (int k = 0; k < NCHUNK; ++k) { const float ld = np[(size_t)k * DH]; np[(size_t)k * DH] = s; s = TAB[(hh * NCHUNK + k) * 2] * s + TAB[(hh * NCHUNK + k) * 2 + 1] * ld; }
    }
}
constexpr int M3_QI = 8192, M3_R2 = 75776, M3_QP = 528, M3_CP = 272, M3_VP = 264;
static_assert(M3_R2 + 256 * M3_CP <= LDSCTL_OFF, "P4 LDS map");
DI void m3_item(Frame& F, int hh, int kc) {
    LAS float* GS = (LAS float*)F.lds; LAS float* MX = GS + 128; LAS float* BT = GS + 256; LAS float* NK = GS + 384; LAS float* XCH = GS + 640;
    LAS unsigned char* QI = F.lds + M3_QI; LAS unsigned char* R2 = F.lds + M3_R2;
    int tid = F.tid; asm volatile("" : "+v"(tid));
    const int t0 = kc * CH, lane = F.lane, item = hh * NCHUNK + kc;
    const float mk = F.MTAB[item];
    const bf16* cbase = F.STATE + (size_t)item * (DH * DH);
    const bf16* kbase = F.KC + (size_t)t0 * 1024 + hh * DH;
    const bf16* qbase = F.QC + (size_t)t0 * 1024 + hh * DH;
    const bf16* vbase = F.VT + (size_t)(hh * DH) * M + t0;
    {
        v4u tk[8], tq[8];
#pragma unroll
        for (int i = 0; i < 8; ++i) { const int p = tid + 512 * i; tk[i] = *(const GAS v4u*)(kbase + (size_t)(p >> 5) * 1024 + (p & 31) * 8); tq[i] = *(const GAS v4u*)(qbase + (size_t)(p >> 5) * 1024 + (p & 31) * 8); }
        if (F.wave == 0) {
            const float* gp = F.GATES + (size_t)(t0 + 2 * lane) * 8;
            const float i0 = gp[hh], lf0 = gp[4 + hh], i1 = gp[8 + hh], lf1 = gp[12 + hh];
            const float p = lf0 + lf1; float inc = p;
#pragma unroll
            for (int o = 1; o < 64; o <<= 1) { const float t = __shfl_up(inc, o); if (lane >= o) inc += t; }
            const float ex = inc - p, b0 = ex + lf0, b1 = ex + p;
            const float g0 = i0 - b0, g1 = i1 - b1;
            float cm = fmaxf(g0, g1);
#pragma unroll
            for (int o = 1; o < 64; o <<= 1) { const float t = __shfl_up(cm, o); if (lane >= o) cm = fmaxf(cm, t); }
            float pm = __shfl_up(cm, 1); if (lane == 0) pm = -INFINITY;
            const float M0 = fmaxf(mk, fmaxf(pm, g0)), M1 = fmaxf(M0, g1);
            GS[2 * lane] = g0; GS[2 * lane + 1] = g1; MX[2 * lane] = M0; MX[2 * lane + 1] = M1; BT[2 * lane] = b0; BT[2 * lane + 1] = b1;
        }
        if (tid < 256) NK[tid] = F.NST[(size_t)item * DH + tid];
#pragma unroll
        for (int i = 0; i < 8; ++i) { const int p = tid + 512 * i; *(LAS v4u*)(R2 + (p >> 5) * M3_QP + (p & 31) * 16) = tk[i]; *(LAS v4u*)(QI + (p >> 5) * M3_QP + (p & 31) * 16) = tq[i]; }
    }
    __syncthreads();
    const int r = lane & 31, h = lane >> 5, tt = F.wave & 3, eh = F.wave >> 2;
    const int tl = tt * 32 + r, t = t0 + tl;
    const float Mt = MX[tl], winter = __expf(mk - Mt);
    const LAS unsigned char* qrow = QI + tl * M3_QP + 16 * h;
    const LAS float* GSh = GS + 4 * h; int tlo = tl - 4 * h; asm volatile("" : "+v"(tlo));
    bf16x8 xs[4][2]; float den = 0.f;
#pragma unroll
    for (int st = 0; st < 4; ++st) {
        if (st <= tt) {
            f32x16 accS = zero16();
            const LAS unsigned char* krow = R2 + (st * 32 + r) * M3_QP + 16 * h;
#pragma unroll 4
            for (int ks = 0; ks < 16; ++ks) { const bf16x8 kf = *(const LAS bf16x8*)(krow + 32 * ks); const bf16x8 qf = *(const LAS bf16x8*)(qrow + 32 * ks); accS = MFMA32(kf, qf, accS); }
            float xv[16];
#pragma unroll
            for (int reg = 0; reg < 16; ++reg) { const int sc = st * 32 + (reg & 3) + 8 * (reg >> 2); float v = accS[reg] * __expf(GSh[sc] - Mt); if (sc > tlo) v = 0.f; xv[reg] = v; den += v; }
#pragma unroll
            for (int k2 = 0; k2 < 2; ++k2) { v4u xw; xw.x = pk2(xv[8 * k2], xv[8 * k2 + 1]); xw.y = pk2(xv[8 * k2 + 2], xv[8 * k2 + 3]); xw.z = pk2(xv[8 * k2 + 4], xv[8 * k2 + 5]); xw.w = pk2(xv[8 * k2 + 6], xv[8 * k2 + 7]);
                xs[st][k2] = __builtin_bit_cast(bf16x8, xw); }
        } else { xs[st][0] = (bf16x8){0, 0, 0, 0, 0, 0, 0, 0}; xs[st][1] = xs[st][0]; }
        asm volatile("" ::: "memory");
    }
    f32x16 accH[4];
#pragma unroll
    for (int i = 0; i < 4; ++i) accH[i] = zero16();
    float qn = 0.f;
#pragma unroll 1
    for (int hf = 0; hf < 2; ++hf) {
        v4u tc[8];
#pragma unroll
        for (int i = 0; i < 8; ++i) { const int p = tid + 512 * i; tc[i] = *(const GAS v4u*)(cbase + (size_t)(p >> 4) * DH + hf * 128 + (p & 15) * 8); }
        __syncthreads();
#pragma unroll
        for (int i = 0; i < 8; ++i) { const int p = tid + 512 * i; *(LAS v4u*)(R2 + (p >> 4) * M3_CP + (p & 15) * 16) = tc[i]; }
        __syncthreads();
        const LAS unsigned char* crow0 = R2 + (eh * 128 + r) * M3_CP + 16 * h;
#pragma unroll 2
        for (int ks = 0; ks < 8; ++ks) {
            const int kg = hf * 8 + ks;
            const v4u qw = *(const LAS v4u*)(qrow + 32 * kg);
            float qv[8] = {bflo(qw.x), bfhi(qw.x), bflo(qw.y), bfhi(qw.y), bflo(qw.z), bfhi(qw.z), bflo(qw.w), bfhi(qw.w)};
            const f32x4 na = *(const LAS f32x4*)(NK + kg * 16 + 8 * h), nb = *(const LAS f32x4*)(NK + kg * 16 + 8 * h + 4);
            qn += (qv[0] * na.x + qv[1] * na.y) + (qv[2] * na.z + qv[3] * na.w) + (qv[4] * nb.x + qv[5] * nb.y) + (qv[6] * nb.z + qv[7] * nb.w);
            v4u q2; q2.x = pk2(qv[0] * winter, qv[1] * winter); q2.y = pk2(qv[2] * winter, qv[3] * winter); q2.z = pk2(qv[4] * winter, qv[5] * winter); q2.w = pk2(qv[6] * winter, qv[7] * winter);
            const bf16x8 q2f = __builtin_bit_cast(bf16x8, q2);
#pragma unroll
            for (int et = 0; et < 4; ++et) { const bf16x8 cf = *(const LAS bf16x8*)(crow0 + et * 32 * M3_CP + 32 * ks); accH[et] = MFMA32(cf, q2f, accH[et]); }
        }
    }
    qn += __shfl_xor(qn, 32);
    {
        v4u tv[8];
#pragma unroll
        for (int i = 0; i < 8; ++i) { const int p = tid + 512 * i; tv[i] = *(const GAS v4u*)(vbase + (size_t)(p >> 4) * M + (p & 15) * 8); }
        __syncthreads();
#pragma unroll
        for (int i = 0; i < 8; ++i) { const int p = tid + 512 * i; LAS unsigned char* d = R2 + (p >> 4) * M3_VP + (p & 15) * 16;
            *(LAS v2u*)d = (v2u){tv[i].x, tv[i].y}; *(LAS v2u*)(d + 8) = (v2u){tv[i].z, tv[i].w}; }
    }
    __syncthreads();
    const LAS unsigned char* vrow0 = R2 + (eh * 128 + r) * M3_VP + 8 * h;
#pragma unroll
    for (int st = 0; st < 4; ++st) if (st <= tt) {
#pragma unroll
        for (int k2 = 0; k2 < 2; ++k2)
#pragma unroll
            for (int et = 0; et < 4; ++et) {
                const LAS unsigned char* vp = vrow0 + et * 32 * M3_VP + (st * 32 + 16 * k2) * 2;
                const v2u lo = *(const LAS v2u*)vp, hi = *(const LAS v2u*)(vp + 16);
                v4u vw; vw.x = lo.x; vw.y = lo.y; vw.z = hi.x; vw.w = hi.y;
                accH[et] = MFMA32(__builtin_bit_cast(bf16x8, vw), xs[st][k2], accH[et]);
                asm volatile("" ::: "memory");
            }
    }
    v4u to[8];
    { const bf16* obase = F.PROJ + (size_t)t0 * NPROJ + C_OM + hh * DH;
#pragma unroll
      for (int i = 0; i < 8; ++i) { const int p = tid + 512 * i; to[i] = *(const GAS v4u*)(obase + (size_t)(p >> 5) * NPROJ + (p & 31) * 8); } }
    den += __shfl_xor(den, 32);
    den += winter * qn;
    const float dnm = fmaxf(fabsf(den), __expf(-(BT[tl] + Mt))), inv = 1.0f / dnm;
    float ss = 0.f;
#pragma unroll
    for (int et = 0; et < 4; ++et)
#pragma unroll
        for (int reg = 0; reg < 16; ++reg) { accH[et][reg] *= inv; ss += accH[et][reg] * accH[et][reg]; }
    ss += __shfl_xor(ss, 32);
    if (h == 0) XCH[eh * 128 + tl] = ss;
#pragma unroll
    for (int i = 0; i < 8; ++i) { const int p = tid + 512 * i; *(LAS v4u*)(QI + (p >> 5) * M3_QP + (p & 31) * 16) = to[i]; }
    __syncthreads();
    const float rstd = 1.0f / sqrtf((XCH[tl] + XCH[128 + tl]) * (1.0f / DH) + EPS);
    LAS unsigned char* orow = QI + tl * M3_QP + (eh * 128 + 4 * h) * 2;
    const float* ngp = F.mlstm_norm_g + hh * DH + eh * 128;
#pragma unroll
    for (int et = 0; et < 4; ++et)
#pragma unroll
        for (int gq = 0; gq < 4; ++gq) { const int el = et * 32 + 8 * gq + 4 * h; LAS v2u* op = (LAS v2u*)(orow + (et * 32 + 8 * gq) * 2);
            const v2u ow = *op; const f32x4 gn = *(const GAS f32x4*)(ngp + el);
            const float y0 = accH[et][4 * gq] * rstd * gn.x * sigmoid_f(bflo(ow.x)), y1 = accH[et][4 * gq + 1] * rstd * gn.y * sigmoid_f(bfhi(ow.x));
            const float y2 = accH[et][4 * gq + 2] * rstd * gn.z * sigmoid_f(bflo(ow.y)), y3 = accH[et][4 * gq + 3] * rstd * gn.w * sigmoid_f(bfhi(ow.y));
            v2u o; o.x = pk2(y0, y1); o.y = pk2(y2, y3); *op = o; }
    __syncthreads();
#pragma unroll
    for (int i = 0; i < 8; ++i) { const int p = tid + 512 * i, row = p >> 5, c16 = p & 31;
        *(GAS v4u*)(F.HA + (size_t)(t0 + row) * D + 1024 + hh * DH + c16 * 8) = *(const LAS v4u*)(QI + row * M3_QP + c16 * 16); }
    __syncthreads();
}
DI void p4_phase(Frame& F) {
    for (int it = (int)blockIdx.x; it < NHEAD * NCHUNK; it += F.G) m3_item(F, it / NCHUNK, it % NCHUNK);
}
constexpr int KPITCH = 272, P8_TBL = 69632;
DI void topk_insert(float (&L)[16], float x) {
#pragma unroll
    for (int i = 15; i >= 1; --i) L[i] = __builtin_amdgcn_fmed3f(x, L[i - 1], L[i]);
    L[0] = fmaxf(L[0], x);
}
DI void p8_phase(Frame& F) {
    LAS unsigned char* KIMG = F.lds; LAS unsigned char* TBL = F.lds + P8_TBL + F.wave * 1024;
    const int lane = F.lane, tid = F.tid, r = lane & 31, h = lane >> 5;
#pragma unroll 4
    for (int i = 0; i < 16; ++i) { const int idx = tid * 4 + 2048 * i, side = idx >> 14, rem = idx & 16383, row = rem >> 7, col = rem & 127;
        const f32x4 a = *(const GAS f32x4*)((side ? F.keys2 : F.keys1) + rem);
        v2u o; o.x = pk2(a.x, a.y); o.y = pk2(a.z, a.w); *(LAS v2u*)(KIMG + (side * 128 + row) * KPITCH + col * 2) = o; }
    __syncthreads();
    for (int it = (int)blockIdx.x; it < (M / 256) * PH; it += F.G) {
        const int tile = it / PH, hd = it % PH;
        const int t = tile * 256 + F.wave * 32 + r;
        float L1[16], L2[16];
#pragma unroll 1
        for (int side = 0; side < 2; ++side) {
            f32x16 acc[4];
#pragma unroll
            for (int kt = 0; kt < 4; ++kt) acc[kt] = zero16();
            const bf16* qp = F.QB + (size_t)t * D + hd * 256 + side * 128 + 8 * h;
#pragma unroll
            for (int ks = 0; ks < 8; ++ks) {
                const bf16x8 qf = *(const GAS bf16x8*)(qp + ks * 16);
#pragma unroll
                for (int kt = 0; kt < 4; ++kt) { const bf16x8 kf = *(const LAS bf16x8*)(KIMG + (side * 128 + kt * 32 + r) * KPITCH + (ks * 16 + 8 * h) * 2); acc[kt] = MFMA32(kf, qf, acc[kt]); }
            }
            float L[16];
#pragma unroll
            for (int i = 0; i < 16; ++i) L[i] = -3.0e38f;
#pragma unroll
            for (int kt = 0; kt < 4; ++kt)
#pragma unroll
                for (int reg = 0; reg < 16; ++reg) { const unsigned key = (unsigned)(kt * 32 + crow(reg, h)); const float sv = acc[kt][reg];
                    topk_insert(L, __uint_as_float((__float_as_uint(sv) & ~127u) | key)); }
            float P[16];
#pragma unroll
            for (int i = 0; i < 16; ++i) P[i] = __shfl_xor(L[i], 32);
#pragma unroll
            for (int i = 0; i < 16; ++i) topk_insert(L, P[i]);
            if (side == 0) {
#pragma unroll
                for (int i = 0; i < 16; ++i) L1[i] = L[i];
            } else {
#pragma unroll
                for (int i = 0; i < 16; ++i) L2[i] = L[i];
            }
        }
        if (h == 0) {
#pragma unroll
            for (int w = 0; w < 4; ++w) {
                const unsigned a = (__builtin_bit_cast(unsigned, L1[4 * w]) & 127u) | ((__builtin_bit_cast(unsigned, L1[4 * w + 1]) & 127u) << 8) | ((__builtin_bit_cast(unsigned, L1[4 * w + 2]) & 127u) << 16) | ((__builtin_bit_cast(unsigned, L1[4 * w + 3]) & 127u) << 24);
                const unsigned b = (__builtin_bit_cast(unsigned, L2[4 * w]) & 127u) | ((__builtin_bit_cast(unsigned, L2[4 * w + 1]) & 127u) << 8) | ((__builtin_bit_cast(unsigned, L2[4 * w + 2]) & 127u) << 16) | ((__builtin_bit_cast(unsigned, L2[4 * w + 3]) & 127u) << 24);
                *(LAS unsigned*)(TBL + r * 32 + 4 * w) = a; *(LAS unsigned*)(TBL + r * 32 + 16 + 4 * w) = b;
            }
        }
        float T[16];
#pragma unroll
        for (int i = 0; i < 16; ++i) T[i] = -3.0e38f;
#pragma unroll
        for (int i = 0; i < 16; ++i) {
            const float v1 = __builtin_bit_cast(float, __builtin_bit_cast(unsigned, L1[i]) & ~127u);
#pragma unroll
            for (int j = 0; j < 16; ++j) if ((i + 1) * (j + 1) <= 16) {
                const float v2 = __builtin_bit_cast(float, __builtin_bit_cast(unsigned, L2[j]) & ~127u);
                topk_insert(T, __builtin_bit_cast(float, (__builtin_bit_cast(unsigned, v1 + v2) & ~255u) | (unsigned)(i * 16 + j)));
            }
        }
        LDS_WAIT(); asm volatile("" ::: "memory");
        float ev[16], esum = 0.f;
        const float mx = __builtin_bit_cast(float, __builtin_bit_cast(unsigned, T[0]) & ~255u);
#pragma unroll
        for (int i = 0; i < 16; ++i) { ev[i] = __expf(__builtin_bit_cast(float, __builtin_bit_cast(unsigned, T[i]) & ~255u) - mx); esum += ev[i]; }
        const float einv = 1.0f / esum;
        int eid[8]; float gt[8];
#pragma unroll
        for (int i = 0; i < 8; ++i) { const float tv = h ? T[8 + i] : T[i]; const float e = h ? ev[8 + i] : ev[i];
            const unsigned p = __builtin_bit_cast(unsigned, tv) & 255u;
            const unsigned i1 = *(const LAS unsigned char*)(TBL + r * 32 + (p >> 4)), i2 = *(const LAS unsigned char*)(TBL + r * 32 + 16 + (p & 15u));
            eid[i] = (int)(i1 * 128u + i2); gt[i] = e * einv; }
        int* ip = F.IDX + (size_t)t * NSEL + hd * 16 + 8 * h; float* gp = F.PG + (size_t)t * NSEL + hd * 16 + 8 * h;
        *(GAS v4u*)ip = (v4u){(unsigned)eid[0], (unsigned)eid[1], (unsigned)eid[2], (unsigned)eid[3]}; *(GAS v4u*)(ip + 4) = (v4u){(unsigned)eid[4], (unsigned)eid[5], (unsigned)eid[6], (unsigned)eid[7]};
        *(GAS f32x4*)gp = (f32x4){gt[0], gt[1], gt[2], gt[3]}; *(GAS f32x4*)(gp + 4) = (f32x4){gt[4], gt[5], gt[6], gt[7]};
        LDS_WAIT(); asm volatile("" ::: "memory");
    }
}
constexpr int P9_IDX = 131072, P9_SH = 147456, P9_CORR = 147712, P9_GF = 32768, P9_FG = 40960, P9_SSQ = 49152, P9_CQ = 65536, P9_CT = 81920, P9_CSQ = 82176, NSLICE = 16, SLICE_B = 128;
#ifndef NSLICE_A
#define NSLICE_A NSLICE
#endif
#ifndef NSLICE_C
#define NSLICE_C NSLICE
#endif
template <int N, int MASK> DI void red_step_i(int (&v)[8], int lane) {
#pragma unroll
    for (int i = 0; i < N / 2; ++i) { const bool up = (lane & MASK) != 0; const int keep = up ? v[i + N / 2] : v[i], send = up ? v[i] : v[i + N / 2]; v[i] = keep + __shfl_xor(send, MASK); }
}
template <int N, int MASK> DI void red_step_f(float (&v)[16], int lane) {
#pragma unroll
    for (int i = 0; i < N / 2; ++i) { const bool up = (lane & MASK) != 0; const float keep = up ? v[i + N / 2] : v[i], send = up ? v[i] : v[i + N / 2]; v[i] = keep + __shfl_xor(send, MASK); }
}
typedef _Float16 h2v __attribute__((ext_vector_type(2)));
DI void acc4(float& o0, float& o1, float& o2, float& o3, unsigned u, float c) {
    const h2v p = __builtin_bit_cast(h2v, __builtin_amdgcn_perm(u, 0x64646464u, 0x01050004u));
    const h2v q = __builtin_bit_cast(h2v, __builtin_amdgcn_perm(u, 0x64646464u, 0x01070006u));
    o0 = __builtin_fmaf((float)p.x, c, o0); o1 = __builtin_fmaf((float)p.y, c, o1); o2 = __builtin_fmaf((float)q.x, c, o2); o3 = __builtin_fmaf((float)q.y, c, o3);
}
template <int N> DI void red32_f(float (&v)[16]) {
#pragma unroll
    for (int i = 0; i < N / 2; ++i) { const auto rr = __builtin_amdgcn_permlane32_swap(__float_as_uint(v[i]), __float_as_uint(v[i + N / 2]), false, false); v[i] = __uint_as_float(rr[0]) + __uint_as_float(rr[1]); }
}
template <int N> DI void red16_f(float (&v)[16]) {
#pragma unroll
    for (int i = 0; i < N / 2; ++i) { const auto rr = __builtin_amdgcn_permlane16_swap(__float_as_uint(v[i]), __float_as_uint(v[i + N / 2]), false, false); v[i] = __uint_as_float(rr[0]) + __uint_as_float(rr[1]); }
}
template <int N> DI void red8_f(float (&v)[16], int lane) {
#pragma unroll
    for (int i = 0; i < N / 2; ++i) { const bool up = (lane & 8) != 0; const float keep = up ? v[i + N / 2] : v[i], send = up ? v[i] : v[i + N / 2];
        v[i] = keep + __builtin_bit_cast(float, __builtin_amdgcn_mov_dpp(__builtin_bit_cast(int, send), 0x128, 0xf, 0xf, true)); }
}
template <int N> DI void redi32(int (&v)[16]) {
#pragma unroll
    for (int i = 0; i < N / 2; ++i) { const auto rr = __builtin_amdgcn_permlane32_swap((unsigned)v[i], (unsigned)v[i + N / 2], false, false); v[i] = (int)(rr[0] + rr[1]); }
}
template <int N> DI void redi16(int (&v)[16]) {
#pragma unroll
    for (int i = 0; i < N / 2; ++i) { const auto rr = __builtin_amdgcn_permlane16_swap((unsigned)v[i], (unsigned)v[i + N / 2], false, false); v[i] = (int)(rr[0] + rr[1]); }
}
template <int N> DI void redi8(int (&v)[16], int lane) {
#pragma unroll
    for (int i = 0; i < N / 2; ++i) { const bool up = (lane & 8) != 0; const int keep = up ? v[i + N / 2] : v[i], send = up ? v[i] : v[i + N / 2]; v[i] = keep + __builtin_amdgcn_mov_dpp(send, 0x128, 0xf, 0xf, true); }
}
DI void p9v2_phase(Frame& F) {
    LAS unsigned char* HQ = F.lds; LAS float* A2 = (LAS float*)(F.lds + P9_IDX); LAS float* B2 = (LAS float*)(F.lds + P9_IDX + 8192);
    LAS unsigned short* IDX16 = (LAS unsigned short*)(F.lds + P9_IDX); LAS float* SH = (LAS float*)(F.lds + P9_SH); LAS float* CORR = (LAS float*)(F.lds + P9_CORR);
    LAS float* GF = (LAS float*)(F.lds + P9_GF); LAS float* FG = (LAS float*)(F.lds + P9_FG);
    const int lane = F.lane, tid = F.tid, c8 = lane & 7, g = lane >> 3;
#pragma unroll 1
    for (int tb = (int)blockIdx.x * 64; tb < M; tb += F.G * 64) {
#pragma unroll
        for (int i = 0; i < 4; ++i) { const int c = tid + 512 * i; A2[c] = F.norm_ffn_g[c] * (1.0f + F.MODF[MOD_SCF + c]); B2[c] = F.MODF[MOD_SHF + c]; }
        __syncthreads();
#pragma unroll 1
        for (int j = 0; j < 8; ++j) {
            const int tl = F.wave * 8 + j, t = tb + tl;
            float hv[32]; float ss = 0.f;
            const bf16* xr = F.X1B + (size_t)t * D + 16 * lane;
#pragma unroll
            for (int jj = 0; jj < 2; ++jj)
#pragma unroll
                for (int q = 0; q < 2; ++q) { const v4u a = *(const GAS v4u*)(xr + 1024 * jj + 8 * q); const int o = 16 * jj + 8 * q;
                    hv[o] = bflo(a.x); hv[o + 1] = bfhi(a.x); hv[o + 2] = bflo(a.y); hv[o + 3] = bfhi(a.y); hv[o + 4] = bflo(a.z); hv[o + 5] = bfhi(a.z); hv[o + 6] = bflo(a.w); hv[o + 7] = bfhi(a.w); }
#pragma unroll
            for (int i = 0; i < 32; ++i) ss += hv[i] * hv[i];
            const float rstd = 1.0f / sqrtf(wave_sum(ss) * (1.0f / D) + EPS);
            float am = 0.f;
#pragma unroll
            for (int jj = 0; jj < 2; ++jj)
#pragma unroll
                for (int q = 0; q < 4; ++q) { const f32x4 a = *(const LAS f32x4*)(A2 + 1024 * jj + 16 * lane + 4 * q), b = *(const LAS f32x4*)(B2 + 1024 * jj + 16 * lane + 4 * q);
                    const int o = 16 * jj + 4 * q;
                    hv[o] = hv[o] * rstd * a.x + b.x; hv[o + 1] = hv[o + 1] * rstd * a.y + b.y; hv[o + 2] = hv[o + 2] * rstd * a.z + b.z; hv[o + 3] = hv[o + 3] * rstd * a.w + b.w;
                    am = fmaxf(am, fmaxf(fmaxf(fabsf(hv[o]), fabsf(hv[o + 1])), fmaxf(fabsf(hv[o + 2]), fabsf(hv[o + 3])))); }
            am = fmaxf(wave_max(am), 1e-30f); const float inv = 127.0f / am;
            if (lane == 0) SH[tl] = am * (1.0f / 127.0f);
#pragma unroll
            for (int jj = 0; jj < 2; ++jj) { v4u o;
#pragma unroll
                for (int q = 0; q < 4; ++q) { const int b = 16 * jj + 4 * q;
                    const int q0 = (int)__builtin_rintf(hv[b] * inv), q1 = (int)__builtin_rintf(hv[b + 1] * inv), q2 = (int)__builtin_rintf(hv[b + 2] * inv), q3 = (int)__builtin_rintf(hv[b + 3] * inv);
                    o[q] = (unsigned)(q0 & 255) | ((unsigned)(q1 & 255) << 8) | ((unsigned)(q2 & 255) << 16) | ((unsigned)(q3 & 255) << 24); }
                *(LAS v4u*)(HQ + tl * 2048 + 1024 * jj + 16 * lane) = o; }
        }
        __syncthreads();
#pragma unroll
        for (int i = 0; i < 16; ++i) { const int q = tid + 512 * i, k = q & 127; IDX16[(q & ~127) + (k & 64) + 8 * (k & 7) + ((k >> 3) & 7)] = (unsigned short)F.IDX[(size_t)tb * NSEL + q]; }
        __syncthreads();
        int P[8][2];
#pragma unroll
        for (int j = 0; j < 8; ++j) { P[j][0] = 0; P[j][1] = 0; }
#pragma unroll 1
        for (int s = 0; s < NSLICE_A; ++s) {
            const unsigned char* eb = F.ED + s * SLICE_B;
            const unsigned lo = (unsigned)(c8 * 16);
            v4u wA[8], wB[8];
#define P9A_LOAD(W, J, H) do { _Pragma("unroll") for (int i = 0; i < 8; ++i) { const unsigned e = IDX16[(F.wave * 8 + (J)) * 128 + 64 * (H) + 8 * g + i]; W[i] = *(const GAS v4u*)(eb + (e * 2048u + lo)); } } while (0)
#define P9A_COMP(W, J, H) do { const v4u hq = *(const LAS v4u*)(HQ + (F.wave * 8 + (J)) * 2048 + s * SLICE_B + c8 * 16); int a[8]; \
                _Pragma("unroll") for (int i = 0; i < 8; ++i) { int d = 0; const v4u ww = W[i]; \
                    d = __builtin_amdgcn_sdot4((int)hq.x, (int)ww.x, d, false); d = __builtin_amdgcn_sdot4((int)hq.y, (int)ww.y, d, false); d = __builtin_amdgcn_sdot4((int)hq.z, (int)ww.z, d, false); d = __builtin_amdgcn_sdot4((int)hq.w, (int)ww.w, d, false); a[i] = d; } \
                red_step_i<8, 4>(a, lane); red_step_i<4, 2>(a, lane); red_step_i<2, 1>(a, lane); P[J][H] += a[0]; asm volatile("" ::: "memory"); } while (0)
            P9A_LOAD(wA, 0, 0);
#pragma unroll
            for (int j = 0; j < 8; ++j) {
                P9A_LOAD(wB, j, 1);
                P9A_COMP(wA, j, 0);
                if (j < 7) P9A_LOAD(wA, j + 1, 0);
                P9A_COMP(wB, j, 1);
            }
#undef P9A_LOAD
#undef P9A_COMP
        }
        __syncthreads();
        LAS int* PI = (LAS int*)F.lds;
#pragma unroll
        for (int j = 0; j < 8; ++j) { const int tl = F.wave * 8 + j; PI[tl * 128 + 8 * c8 + g] = P[j][0]; PI[tl * 128 + 64 + 8 * c8 + g] = P[j][1]; }
#pragma unroll
        for (int i = 0; i < 4; ++i) { const int c = tid + 512 * i; GF[c] = F.MODF[MOD_GF + c]; FG[c] = F.final_g[c]; }
        LAS float* SSQL = (LAS float*)(F.lds + P9_SSQ); LAS short* CQ = (LAS short*)(F.lds + P9_CQ); LAS float* CT = (LAS float*)(F.lds + P9_CT); LAS int* CSQ = (LAS int*)(F.lds + P9_CSQ);
#pragma unroll 1
        for (int j = 0; j < 8; ++j) { const int tl = F.wave * 8 + j, t = tb + tl; const float sh = SH[tl]; float cf[2]; float am = 0.f;
#pragma unroll
            for (int h = 0; h < 2; ++h) { const int k = 64 * h + lane; const unsigned e = IDX16[tl * 128 + 64 * h + 8 * (lane & 7) + (lane >> 3)];
                const float act = (float)PI[tl * 128 + k] * (sh * F.SD[e]); cf[h] = F.PG[(size_t)t * NSEL + k] * gelu_f(act) * F.SU[e]; am = fmaxf(am, fabsf(cf[h])); }
            am = fmaxf(wave_max(am), 1e-30f); const float inv = 32767.0f / am; int qs = 0;
#pragma unroll
            for (int h = 0; h < 2; ++h) { const int q = (int)__builtin_rintf(cf[h] * inv); qs += q; CQ[tl * 128 + 64 * h + 8 * (lane & 7) + (lane >> 3)] = (short)q; }
#pragma unroll
            for (int o = 1; o < 64; o <<= 1) qs += __shfl_xor(qs, o);
            if (lane == 0) { CT[tl] = am * (1.0f / 32767.0f); CSQ[tl] = 128 * qs; }
            SSQL[tl * 64 + lane] = 0.f; }
        __syncthreads();
        const int cb = c8 * 16 + ((lane >> 5) & 1) * 8 + ((lane >> 4) & 1) * 4 + ((lane >> 3) & 1) * 2;
        typedef short s16x2 __attribute__((ext_vector_type(2)));
#pragma unroll 1
        for (int s = 0; s < NSLICE_C; ++s) {
            const unsigned char* eb = F.EU + s * SLICE_B;
            const unsigned lo = (unsigned)(c8 * 16);
            v4u wA[8], wB[8]; unsigned cA[4], cB[4];
#define P9C_LOAD(W, C, TL, H) do { const LAS unsigned* ip = (const LAS unsigned*)(IDX16 + (TL) * 128 + 64 * (H) + 8 * g); const LAS unsigned* cp = (const LAS unsigned*)(CQ + (TL) * 128 + 64 * (H) + 8 * g); \
                _Pragma("unroll") for (int i2 = 0; i2 < 4; ++i2) { const unsigned ee = ip[i2]; C[i2] = cp[i2]; \
                    W[2 * i2] = *(const GAS v4u*)(eb + ((ee & 0xffffu) * 2048u + lo)); W[2 * i2 + 1] = *(const GAS v4u*)(eb + ((ee >> 16) * 2048u + lo)); } } while (0)
#define P9C_D4(O, UA, UB, CC) do { O[0] = __builtin_amdgcn_sdot2(__builtin_bit_cast(s16x2, __builtin_amdgcn_perm(UB, UA, 0x0c040c00u)), __builtin_bit_cast(s16x2, CC), O[0], false); \
                O[1] = __builtin_amdgcn_sdot2(__builtin_bit_cast(s16x2, __builtin_amdgcn_perm(UB, UA, 0x0c050c01u)), __builtin_bit_cast(s16x2, CC), O[1], false); \
                O[2] = __builtin_amdgcn_sdot2(__builtin_bit_cast(s16x2, __builtin_amdgcn_perm(UB, UA, 0x0c060c02u)), __builtin_bit_cast(s16x2, CC), O[2], false); \
                O[3] = __builtin_amdgcn_sdot2(__builtin_bit_cast(s16x2, __builtin_amdgcn_perm(UB, UA, 0x0c070c03u)), __builtin_bit_cast(s16x2, CC), O[3], false); } while (0)
#define P9C_ACC(W, C) do { _Pragma("unroll") for (int i2 = 0; i2 < 4; ++i2) { const v4u ua = W[2 * i2], ub = W[2 * i2 + 1]; const unsigned cc = C[i2]; \
                P9C_D4((o + 0), ua.x, ub.x, cc); P9C_D4((o + 4), ua.y, ub.y, cc); P9C_D4((o + 8), ua.z, ub.z, cc); P9C_D4((o + 12), ua.w, ub.w, cc); } asm volatile("" ::: "memory"); } while (0)
            P9C_LOAD(wA, cA, F.wave * 8, 0);
#pragma unroll 1
            for (int j = 0; j < 8; ++j) {
                const int tl = F.wave * 8 + j, t = tb + tl;
                int o[16];
#pragma unroll
                for (int b = 0; b < 16; ++b) o[b] = 0;
                P9C_LOAD(wB, cB, tl, 1);
                P9C_ACC(wA, cA);
                if (j < 7) P9C_LOAD(wA, cA, tl + 1, 0);
                P9C_ACC(wB, cB);
                redi32<16>(o); redi16<8>(o); redi8<4>(o, lane);
                const int col = s * SLICE_B + cb; const int csq = CSQ[tl]; const float ct = CT[tl];
                GAS unsigned* xp = (GAS unsigned*)(F.X1B + (size_t)t * D + col);
                const unsigned xw = *xp;
                const float y0 = bflo(xw) + GF[col] * ((float)(o[0] - csq) * ct), y1 = bfhi(xw) + GF[col + 1] * ((float)(o[1] - csq) * ct);
                const unsigned yw = pk2(y0, y1); const float r0 = bflo(yw), r1 = bfhi(yw);
                SSQL[tl * 64 + lane] += r0 * r0 + r1 * r1;
                *xp = yw;
            }
#undef P9C_LOAD
#undef P9C_ACC
#undef P9C_D4
        }
#pragma unroll 1
        for (int j = 0; j < 8; ++j) {
            const int tl = F.wave * 8 + j, t = tb + tl;
            const float rstd2 = 1.0f / sqrtf(wave_sum(SSQL[tl * 64 + lane]) * (1.0f / D) + EPS);
            const GAS v2u* xrow = (const GAS v2u*)(F.X1B + (size_t)t * D) + lane; GAS f32x4* orow = (GAS f32x4*)(F.out + (size_t)t * D) + lane;
#pragma unroll
            for (int q = 0; q < 8; ++q) { const v2u w = xrow[64 * q]; const f32x4 f = *(const LAS f32x4*)(FG + 256 * q + 4 * lane);
                orow[64 * q] = (f32x4){bflo(w.x) * rstd2 * f.x, bfhi(w.x) * rstd2 * f.y, bflo(w.y) * rstd2 * f.z, bfhi(w.y) * rstd2 * f.w}; }
        }
        __syncthreads();
    }
}
struct Args { const float* in[21]; float* out; unsigned char* ws; int ph_lo, ph_hi, li, pad; };
constexpr int N_PHASES = 10;
__global__ void __launch_bounds__(NWAVES * 64, 2) mk_fwd(Args args) {
    extern __shared__ __attribute__((aligned(16))) unsigned char lds[];
    Frame F;
    F.lds = (LAS unsigned char*)lds;
    F.MISC = (volatile LAS unsigned*)(F.lds + MISC_OFF);
    F.tid = threadIdx.x; F.lane = F.tid & 63; F.wave = __builtin_amdgcn_readfirstlane(F.tid >> 6);
    F.G = gridDim.x; { const int bx = blockIdx.x; F.vcu = (F.G % 8 == 0) ? (bx % 8) * (F.G / 8) + bx / 8 : bx; }
    unsigned char* ws = args.ws;
    F.ctl = (gu32*)(ws + WS_CTL);
    F.x = args.in[0]; F.c = args.in[1]; F.ada_w = args.in[2]; F.ada_b = args.in[3]; F.norm_mix_g = args.in[4]; F.w_in = args.in[5]; F.b_gates = args.in[6];
    F.conv_w = args.in[7]; F.conv_b = args.in[8]; F.gmlp_norm_g = args.in[9]; F.gmlp_w = args.in[10]; F.gmlp_b = args.in[11]; F.mlstm_norm_g = args.in[12];
    F.w_out = args.in[13]; F.norm_ffn_g = args.in[14]; F.wq = args.in[15]; F.keys1 = args.in[16]; F.keys2 = args.in[17]; F.e_down = args.in[18]; F.e_up = args.in[19]; F.final_g = args.in[20];
    F.out = args.out;
    F.MODP = (float*)(ws + WS_MODP); F.MODF = (float*)(ws + WS_MODF); F.GATES = (float*)(ws + WS_GATES); F.SUMM = (float*)(ws + WS_SUMM); F.MTAB = (float*)(ws + WS_MTAB);
    F.NST = (float*)(ws + WS_NST); F.PG = (float*)(ws + WS_PG); F.IDX = (int*)(ws + WS_IDX);
    F.WIN = (bf16*)(ws + WS_WIN); F.WOUT = (bf16*)(ws + WS_WOUT); F.WQ = (bf16*)(ws + WS_WQ); F.HA = (bf16*)(ws + WS_HA); F.PROJ = (bf16*)(ws + WS_PROJ); F.QB = (bf16*)(ws + WS_PROJ);
    F.STATE = (bf16*)(ws + WS_STATE); F.VT = (bf16*)(ws + WS_VT); F.ED = ws + WS_ED; F.EU = ws + WS_EU; F.SD = (float*)(ws + WS_SD); F.SU = (float*)(ws + WS_SU);
    F.SSQP = (float*)(ws + WS_SSQP); F.BQP = (float*)(ws + WS_BQP); F.BIASQ = (float*)(ws + WS_BIASQ); F.X1B = (bf16*)(ws + WS_STATE);
    F.QC = (bf16*)args.out; F.KC = (bf16*)args.out + (size_t)M * 1024;
    for (int u = F.tid; u < (LDS_BYTES - LDSCTL_OFF) / 4; u += NWAVES * 64) ((LAS unsigned*)(F.lds + LDSCTL_OFF))[u] = 0u;
    __syncthreads();
    const int lo = args.ph_lo, hi = args.ph_hi;
    const bool multi = (hi - lo) > 1;
    XcdBarrier bar; bar.bar = (unsigned*)(F.ctl + CW_BAR) + args.li * XCD_BAR_WORDS; bar.x = 0; bar.st = nullptr;
    if (multi) bar = xcd_barrier_post((unsigned*)(F.ctl + CW_BAR) + args.li * XCD_BAR_WORDS, F.MISC + 8);
#ifndef PH_MASK
#define PH_MASK 0x7ff
#endif
#define IN(k) (((PH_MASK >> (k)) & 1) && lo <= (k) && (k) < hi)
#define SEAM(k) do { if (IN(k) && IN((k) + 1)) xcd_barrier(bar); } while (0)
    if (IN(0)) { p0a_phase(F); } SEAM(0);
    if (IN(1)) { p0b_phase(F); } SEAM(1);
    if (IN(2)) {
        { pg8::Gemm g{F.HA, F.WIN, M, NPROJ, D}; pg8::StaticOrder S; S.init(M, NPROJ, F.G, (int)blockIdx.x);
          pg8::EpiProj E{F.PROJ, NPROJ, 2048 / 256};
          pg8::gemm_phase<pg8::EpiProj, pg8::StaticOrder, PG8_ALIGN, PG8_SP2>(F.lds, g, S, E); }
        {
          pg8::Gemm g{F.WIN + (size_t)WROW_VM * D, F.HA, 1024, M, D}; pg8::StaticOrder S; S.init(1024, M, F.G, (int)blockIdx.x);
          pg8::EpiBf16<0> E{F.VT, M, nullptr, 0, 0, 1.f};
          pg8::gemm_phase<pg8::EpiBf16<0>, pg8::StaticOrder, PG8_ALIGN, PG8_SP2>(F.lds, g, S, E); }
    } SEAM(2);
    if (IN(3)) { p2_phase(F); } SEAM(3);
    if (IN(4)) { p3_phase(F); } SEAM(4);
    if (IN(5)) { p4_phase(F); } SEAM(5);
    if (IN(6)) {
        pg8::Gemm g{F.HA, F.WOUT, M, D, D}; pg8::StaticOrder S; S.init(M, D, F.G, (int)blockIdx.x);
        pg8::EpiResid2 E{F.x, F.MODF + MOD_GM, F.X1B, F.SSQP, D};
        pg8::gemm_phase<pg8::EpiResid2, pg8::StaticOrder, PG8_ALIGN, PG8_SP2>(F.lds, g, S, E);
    } SEAM(6);
    if (IN(7)) {
        pg8::Gemm g{F.X1B, F.WQ, M, D, D}; pg8::StaticOrder S; S.init(M, D, F.G, (int)blockIdx.x);
        LAS float* RSTDL = (LAS float*)(F.lds + RING_BYTES);
        { pg8::Unit u; for (int i = 0; S.next(i, u); ++i) { if (F.tid < 256) { const float* sp = F.SSQP + (size_t)(u.pm * 256 + F.tid) * 32; float ss = 0.f;
#pragma unroll
                    for (int q = 0; q < 8; ++q) { const f32x4 v = *(const GAS f32x4*)(sp + 4 * q); ss += (v.x + v.y) + (v.z + v.w); }
                    RSTDL[(u.pm & 1) * 256 + F.tid] = 1.0f / sqrtf(ss * (1.0f / D) + EPS); } } }
        __syncthreads();
        pg8::EpiQ E{F.QB, D, F.BIASQ, RSTDL};
        pg8::gemm_phase<pg8::EpiQ, pg8::StaticOrder, PG8_ALIGN, PG8_SP2>(F.lds, g, S, E);
    } SEAM(7);
#ifndef P8_ALT
#define P8_ALT 0
#endif
    if (IN(8)) { p8_phase(F); } SEAM(8);
#ifndef P9_V2
#define P9_V2 1
#endif
    if (IN(9)) { p9v2_phase(F); }
#undef IN
#undef SEAM
}

#ifndef MK_N_LAUNCHES
#define MK_N_LAUNCHES 1
#endif
extern "C" void kernel_launch(void* const* d_in, const int* in_sizes, int n_in, void* d_out, int out_size, void* d_ws, size_t ws_size, hipStream_t stream) {
    static int grid = 0;
    if (grid == 0) {
        if (n_in != 21 || in_sizes[0] != M * D || out_size != M * D || ws_size < WS_END) { fprintf(stderr, "kernel_launch: unexpected shapes (n_in %d, in0 %d, out %d, ws %zu); nothing launched\n", n_in, n_in > 0 ? in_sizes[0] : -1, out_size, ws_size); grid = -1; return; }
        int dev = 0, cus = 0, per_cu = 0;
        if (hipGetDevice(&dev) != hipSuccess || hipDeviceGetAttribute(&cus, hipDeviceAttributeMultiprocessorCount, dev) != hipSuccess) { grid = -1; return; }
        if (hipFuncSetAttribute((const void*)mk_fwd, hipFuncAttributeMaxDynamicSharedMemorySize, LDS_BYTES) != hipSuccess) { fprintf(stderr, "kernel_launch: hipFuncSetAttribute failed\n"); grid = -1; return; }
        if (hipOccupancyMaxActiveBlocksPerMultiprocessor(&per_cu, (const void*)mk_fwd, NWAVES * 64, LDS_BYTES) != hipSuccess || per_cu < 1) { fprintf(stderr, "kernel_launch: occupancy query says %d blocks per CU\n", per_cu); }
        (void)hipGetLastError();
        grid = cus;
    }
    if (grid < 0) return;
    (void)hipMemsetAsync((char*)d_ws + WS_CTL, 0, CTL_ZERO_BYTES, stream);
    Args a{};
    for (int i = 0; i < 21; ++i) a.in[i] = (const float*)d_in[i];
    a.out = (float*)d_out; a.ws = (unsigned char*)d_ws;
    if (MK_N_LAUNCHES == 1) { a.ph_lo = 0; a.ph_hi = N_PHASES; a.li = 0; hipLaunchKernelGGL(mk_fwd, dim3(grid), dim3(NWAVES * 64), LDS_BYTES, stream, a); }
    else for (int li = 0; li < N_PHASES; ++li) { a.ph_lo = li; a.ph_hi = li + 1; a.li = 0; hipLaunchKernelGGL(mk_fwd, dim3(grid), dim3(NWAVES * 64), LDS_BYTES, stream, a); }
}
```

```cpp
#include <hip/hip_runtime.h>
#include <cstdio>
#include <cstdint>
namespace pg8 {
#define PG8_LAS __attribute__((address_space(3)))
typedef unsigned short bf16_t;
typedef short bf16x8 __attribute__((ext_vector_type(8)));
typedef float f32x4 __attribute__((ext_vector_type(4)));
typedef unsigned u32x4 __attribute__((ext_vector_type(4)));
constexpr int BM = 256, BK = 64, HALF = 128, HTB = HALF * BK * 2  , STAGE_BYTES = 8 * HTB, NXCD = 8, WGM = 8;

__host__ __device__ __forceinline__ int lds_byte(int r, int c) { const int st = (r >> 4) * 2 + (c >> 5), rr = r & 15, cc = c & 31, ob = rr * 64 + cc * 2; return st * 1024 + (ob ^ (((ob >> 9) & 1) << 5)); }
__host__ __device__ __forceinline__ void stage_rc(int b, int& R, int& C) { const int st = b / 1024, sb = b % 1024, swz = sb ^ (((sb >> 9) & 1) << 5); R = (st >> 1) * 16 + swz / 64; C = (st & 1) * 32 + (swz % 64) / 2; }
__host__ __device__ __forceinline__ int perm32(int rho) { const int n = rho >> 4, i = rho & 15; return 8 * (i >> 2) + 4 * n + (i & 3); }

struct Unit { int pm, pn; };
struct Gemm { const bf16_t* A; const bf16_t* Bt; int M, N, K; };

struct StaticOrder {
    int nM, nN, nwg, G, c;
    __host__ __device__ void init(int M, int N, int G_, int c_) { nM = M / BM; nN = N / BM; nwg = nM * nN; G = G_; c = c_; }
    __host__ __device__ bool next(int i, Unit& u) const {
        const long L = (long)i * G + c; if (L >= nwg) return false;
        int wgid = (int)L; { const int q = nwg / NXCD, r = nwg % NXCD, xcd = wgid % NXCD, off = wgid / NXCD; wgid = (xcd < r ? xcd * (q + 1) : r * (q + 1) + (xcd - r) * q) + off; }
        const int nig = WGM * nN, gid = wgid / nig, fm = gid * WGM, gsz = (nM - fm) < WGM ? (nM - fm) : WGM;
        u.pm = fm + ((wgid % nig) % gsz); u.pn = (wgid % nig) / gsz; return true;
    }
    __device__ __forceinline__ void a_ready(const Unit&) const {}
    __device__ __forceinline__ void done(const Unit&) const {}
};

__device__ __forceinline__ unsigned cvt_pk_bf16(float lo, float hi) { unsigned r; asm volatile("v_cvt_pk_bf16_f32 %0, %1, %2" : "=v"(r) : "v"(lo), "v"(hi)); return r; }
typedef float f32x2 __attribute__((ext_vector_type(2)));
__device__ __forceinline__ f32x2 gelu_pk(f32x2 v) {
    const f32x2 av = __builtin_elementwise_abs(v), d = av * 0.2316418882f + 1.0f;
    f32x2 t; t.x = __builtin_amdgcn_rcpf(d.x); t.y = __builtin_amdgcn_rcpf(d.y);
    f32x2 q = t * 0.5307027145f + (-0.7265760135f); q = q * t + 0.7107068705f; q = q * t + (-0.142248368f); q = q * t + 0.127414796f; q = q * t;
    const f32x2 s = (v * v) * (-0.72134752044f);
    f32x2 e; e.x = __builtin_amdgcn_exp2f(s.x); e.y = __builtin_amdgcn_exp2f(s.y);
    const f32x2 m = v * (q * e), r = v - m;
    f32x2 o; o.x = v.x < 0.f ? m.x : r.x; o.y = v.y < 0.f ? m.y : r.y; return o;
}

template <int ACT  > struct EpiBf16 {
    static constexpr bool PERM = true, AFTER_DRAIN = false; static_assert(ACT == 0 || ACT == 1, "EpiBf16: ACT is 0 (none) or 1 (gelu_pk)");
    bf16_t* O; int ldc; const float* bias; int split_cols; size_t split_stride; float scale0;
    __device__ __forceinline__ void operator()(const f32x4 (&acc)[2][2][4][2], const Unit& u, int wr, int wc, int fr, int fq) const {
        const int row0 = u.pm * BM + wr * 64 + fr; int colt = u.pn * BM; bf16_t* base = O;
        float sc = 1.f; if (split_cols) { const int t = colt / split_cols; base += (size_t)t * split_stride; colt -= t * split_cols; if (t == 0) sc = scale0; }
        const int col0 = colt + wc * 32 + 8 * fq, bcol0 = u.pn * BM + wc * 32 + 8 * fq;
        f32x4 bv[2][2];
#pragma unroll
        for (int bj = 0; bj < 2; ++bj)
#pragma unroll
            for (int n = 0; n < 2; ++n) bv[bj][n] = bias ? *(const f32x4*)(bias + bcol0 + bj * HALF + 4 * n) : (f32x4){0.f, 0.f, 0.f, 0.f};
#pragma unroll
        for (int ai = 0; ai < 2; ++ai)
#pragma unroll
            for (int m = 0; m < 4; ++m) { bf16_t* rowp = base + (size_t)(row0 + ai * HALF + m * 16) * ldc + col0;
#pragma unroll
                for (int bj = 0; bj < 2; ++bj) { f32x4 v0 = acc[ai][bj][m][0] + bv[bj][0], v1 = acc[ai][bj][m][1] + bv[bj][1];
                    if (ACT == 1) { f32x2 a = gelu_pk((f32x2){v0[0], v0[1]}), b = gelu_pk((f32x2){v0[2], v0[3]}), c = gelu_pk((f32x2){v1[0], v1[1]}), d = gelu_pk((f32x2){v1[2], v1[3]});
                        v0 = (f32x4){a.x, a.y, b.x, b.y}; v1 = (f32x4){c.x, c.y, d.x, d.y}; }
                    v0 = v0 * sc; v1 = v1 * sc; u32x4 w; w.x = cvt_pk_bf16(v0[0], v0[1]); w.y = cvt_pk_bf16(v0[2], v0[3]); w.z = cvt_pk_bf16(v1[0], v1[1]); w.w = cvt_pk_bf16(v1[2], v1[3]);
                    *(u32x4*)(rowp + bj * HALF) = w; } }
    }
};

typedef int i32x4 __attribute__((ext_vector_type(4)));
template <bool I8> __device__ __forceinline__ f32x4 mma16(bf16x8 a, bf16x8 b, f32x4 c) {
    if constexpr (I8) return __builtin_bit_cast(f32x4, __builtin_amdgcn_mfma_i32_16x16x64_i8(__builtin_bit_cast(i32x4, a), __builtin_bit_cast(i32x4, b), __builtin_bit_cast(i32x4, c), 0, 0, 0));
    else return __builtin_amdgcn_mfma_f32_16x16x32_bf16(a, b, c, 0, 0, 0);
}
template <class Epi, class Sched, bool ALIGN_EPI = false, bool SP2 = false, bool I8 = false>
__device__ __forceinline__ void gemm_phase(PG8_LAS unsigned char* lds, const Gemm g, const Sched& S, const Epi& E) {
    const int tid = threadIdx.x, wid = __builtin_amdgcn_readfirstlane(tid >> 6), lane = tid & 63, wr = wid >> 2, wc = wid & 3, fr = lane & 15, fq = lane >> 4;
    const int K = g.K, nt = K / BK;
    unsigned voffA[2], voffB[2];
#pragma unroll
    for (int i = 0; i < 2; ++i) { int R, C; stage_rc(tid * 16 + i * 8192, R, C); const int Rb = Epi::PERM ? ((R & ~31) + perm32(R & 31)) : R;
        voffA[i] = (unsigned)(R * K + C) * 2u; voffB[i] = (unsigned)(Rb * K + C) * 2u; }
    const size_t kstep = (size_t)(BK * 2);
    const size_t hstep = (size_t)HALF * K * 2;
    const size_t tstep = 2 * hstep;
    const unsigned ldsw = (unsigned)wid * 1024u;
    const int aoff = lds_byte(wr * 64 + fr, fq * 8), boff = lds_byte(wc * 32 + fr, fq * 8);
#define PG8_SA(b, h) (((b) * 2 + (h)) * HTB)
#define PG8_SB(b, h) ((4 + (b) * 2 + (h)) * HTB)
#define PG8_STAGE(bufoff, gbase, voff) do { _Pragma("unroll") for (int _i = 0; _i < 2; ++_i) \
        __builtin_amdgcn_global_load_lds((const unsigned*)((const char*)(gbase) + (voff)[_i]), (PG8_LAS unsigned*)(lds + (bufoff) + ldsw + _i * 8192), 16, 0, 0); } while (0)
#define PG8_LDA(dst, b, h) do { _Pragma("unroll") for (int m = 0; m < 4; ++m) _Pragma("unroll") for (int k = 0; k < 2; ++k) dst[m][k] = *(const PG8_LAS bf16x8*)(lds + PG8_SA(b, h) + aoff + m * 2048 + k * 1024); } while (0)
#define PG8_LDB(dst, b, h) do { _Pragma("unroll") for (int n = 0; n < 2; ++n) _Pragma("unroll") for (int k = 0; k < 2; ++k) dst[n][k] = *(const PG8_LAS bf16x8*)(lds + PG8_SB(b, h) + boff + n * 2048 + k * 1024); } while (0)
#define PG8_MMA(ai, bj, At, Bt) do { __builtin_amdgcn_s_setprio(1); _Pragma("unroll") for (int m = 0; m < 4; ++m) _Pragma("unroll") for (int n = 0; n < 2; ++n) _Pragma("unroll") for (int k = 0; k < 2; ++k) \
        acc[ai][bj][m][n] = mma16<I8>(Bt[n][k], At[m][k], acc[ai][bj][m][n]); __builtin_amdgcn_s_setprio(0); } while (0)
#define PG8_WAIT_V(n) asm volatile("s_waitcnt vmcnt(" #n ")" ::: "memory")
#define PG8_WAIT_L(n) asm volatile("s_waitcnt lgkmcnt(" #n ")" ::: "memory")
#define PG8_BAR __builtin_amdgcn_s_barrier()
#define PG8_SCHED __builtin_amdgcn_sched_barrier(0)
    Unit cur, nxt; int ui = 0;
    if (!S.next(0, cur)) return;
    f32x4 acc[2][2][4][2];
#pragma unroll
    for (int a = 0; a < 2; ++a)
#pragma unroll
        for (int b = 0; b < 2; ++b)
#pragma unroll
            for (int m = 0; m < 4; ++m)
#pragma unroll
                for (int n = 0; n < 2; ++n) acc[a][b][m][n] = (f32x4){0.f, 0.f, 0.f, 0.f};
    bf16x8 At[4][2], B0[2][2], B1[2][2];
    const char* cA = (const char*)g.A + (size_t)cur.pm * tstep; const char* cB = (const char*)g.Bt + (size_t)cur.pn * tstep;
    S.a_ready(cur);
    if constexpr (SP2) {
        PG8_STAGE(PG8_SB(0, 0), cB, voffB); PG8_STAGE(PG8_SB(0, 1), cB + hstep, voffB); PG8_STAGE(PG8_SA(0, 0), cA, voffA); PG8_STAGE(PG8_SA(0, 1), cA + hstep, voffA);
        if (wr == 1) PG8_BAR;
        PG8_WAIT_V(2); PG8_BAR;
        PG8_STAGE(PG8_SB(1, 0), cB + kstep, voffB); PG8_STAGE(PG8_SA(1, 0), cA + kstep, voffA); PG8_STAGE(PG8_SB(1, 1), cB + hstep + kstep, voffB);
        PG8_WAIT_V(6); PG8_BAR;
    } else {
        PG8_STAGE(PG8_SB(0, 0), cB, voffB); PG8_STAGE(PG8_SA(0, 0), cA, voffA); PG8_STAGE(PG8_SB(0, 1), cB + hstep, voffB); PG8_STAGE(PG8_SA(0, 1), cA + hstep, voffA);
        if (wr == 1) PG8_BAR;
        PG8_WAIT_V(4); PG8_BAR;
        PG8_STAGE(PG8_SB(1, 0), cB + kstep, voffB); PG8_STAGE(PG8_SA(1, 0), cA + kstep, voffA); PG8_STAGE(PG8_SB(1, 1), cB + hstep + kstep, voffB);
        PG8_WAIT_V(6); PG8_BAR;
    }
    for (;;) {
        const bool has_next = S.next(ui + 1, nxt);
        const char* nA = has_next ? (const char*)g.A + (size_t)nxt.pm * tstep : cA; const char* nB = has_next ? (const char*)g.Bt + (size_t)nxt.pn * tstep : cB;
        for (int t = 0; t < nt; t += 2) {
            const bool last = (t == nt - 2);
            const char* a1 = cA + (size_t)(t + 1) * kstep;
            const char* a2 = last ? nA : cA + (size_t)(t + 2) * kstep; const char* b2 = last ? nB : cB + (size_t)(t + 2) * kstep;
            const char* a3 = a2 + kstep; const char* b3 = b2 + kstep;
            if (last && has_next) S.a_ready(nxt);
            if constexpr (SP2) {
            PG8_LDB(B0, 0, 0); PG8_LDB(B1, 0, 1); PG8_SCHED; PG8_LDA(At, 0, 0); PG8_STAGE(PG8_SA(1, 1), a1 + hstep, voffA);
            PG8_WAIT_V(8); PG8_WAIT_L(0); PG8_BAR; PG8_MMA(0, 0, At, B0); PG8_MMA(0, 1, At, B1); PG8_BAR; PG8_SCHED;
            PG8_LDA(At, 0, 1); PG8_STAGE(PG8_SB(0, 0), b2, voffB); PG8_STAGE(PG8_SB(0, 1), b2 + hstep, voffB); PG8_STAGE(PG8_SA(0, 0), a2, voffA);
            PG8_WAIT_V(8); PG8_WAIT_L(0); PG8_BAR; PG8_MMA(1, 0, At, B0); PG8_MMA(1, 1, At, B1); PG8_BAR; PG8_SCHED;
            PG8_LDB(B0, 1, 0); PG8_LDB(B1, 1, 1); PG8_SCHED; PG8_LDA(At, 1, 0); PG8_STAGE(PG8_SA(0, 1), a2 + hstep, voffA);
            PG8_WAIT_V(8); PG8_WAIT_L(0); PG8_BAR; PG8_MMA(0, 0, At, B0); PG8_MMA(0, 1, At, B1); PG8_BAR; PG8_SCHED;
            PG8_LDA(At, 1, 1); PG8_STAGE(PG8_SB(1, 0), b3, voffB); PG8_STAGE(PG8_SB(1, 1), b3 + hstep, voffB); PG8_STAGE(PG8_SA(1, 0), a3, voffA);
            PG8_WAIT_V(8); PG8_WAIT_L(0); PG8_BAR; PG8_MMA(1, 0, At, B0); PG8_MMA(1, 1, At, B1); PG8_BAR; PG8_SCHED;
            } else {
            PG8_LDB(B0, 0, 0); PG8_SCHED; PG8_LDA(At, 0, 0); PG8_STAGE(PG8_SA(1, 1), a1 + hstep, voffA);
            PG8_WAIT_L(8); PG8_BAR; PG8_WAIT_L(0); PG8_MMA(0, 0, At, B0); PG8_BAR; PG8_SCHED;
            PG8_LDB(B1, 0, 1); PG8_STAGE(PG8_SB(0, 0), b2, voffB);
            PG8_BAR; PG8_WAIT_L(0); PG8_MMA(0, 1, At, B1); PG8_BAR;
            PG8_LDA(At, 0, 1); PG8_STAGE(PG8_SA(0, 0), a2, voffA);
            PG8_BAR; PG8_WAIT_L(0); PG8_MMA(1, 0, At, B0); PG8_BAR; PG8_SCHED;
            PG8_STAGE(PG8_SB(0, 1), b2 + hstep, voffB);
            PG8_WAIT_V(6); PG8_BAR; PG8_MMA(1, 1, At, B1); PG8_BAR;
            PG8_LDB(B0, 1, 0); PG8_SCHED; PG8_LDA(At, 1, 0); PG8_STAGE(PG8_SA(0, 1), a2 + hstep, voffA);
            PG8_WAIT_L(8); PG8_BAR; PG8_WAIT_L(0); PG8_MMA(0, 0, At, B0); PG8_BAR; PG8_SCHED;
            PG8_LDB(B1, 1, 1); PG8_STAGE(PG8_SB(1, 0), b3, voffB);
            PG8_BAR; PG8_WAIT_L(0); PG8_MMA(0, 1, At, B1); PG8_BAR;
            PG8_LDA(At, 1, 1); PG8_STAGE(PG8_SA(1, 0), a3, voffA);
            PG8_BAR; PG8_WAIT_L(0); PG8_MMA(1, 0, At, B0); PG8_BAR; PG8_SCHED;
            PG8_STAGE(PG8_SB(1, 1), b3 + hstep, voffB);
            PG8_WAIT_V(6); PG8_BAR; PG8_MMA(1, 1, At, B1); PG8_BAR;
            }
        }
        if constexpr (ALIGN_EPI) { if (wr == 0) PG8_BAR; }
        if constexpr (!Epi::AFTER_DRAIN) { E(acc, cur, wr, wc, fr, fq); S.done(cur); }
        if (!has_next) break;
#pragma unroll
        for (int a = 0; a < 2; ++a)
#pragma unroll
            for (int b = 0; b < 2; ++b)
#pragma unroll
                for (int m = 0; m < 4; ++m)
#pragma unroll
                    for (int n = 0; n < 2; ++n) acc[a][b][m][n] = (f32x4){0.f, 0.f, 0.f, 0.f};
        cur = nxt; cA = nA; cB = nB; ++ui;
        if constexpr (ALIGN_EPI) { if (wr == 1) PG8_BAR; }
    }
    PG8_WAIT_V(0);
    if constexpr (!ALIGN_EPI) { if (wr == 0) PG8_BAR; }
    PG8_BAR;
    if constexpr (Epi::AFTER_DRAIN) { E.fused(acc, cur, wr, wc, fr, fq, lds, wid, lane); S.done(cur); }
#undef PG8_SA
#undef PG8_SB
#undef PG8_STAGE
#undef PG8_LDA
#undef PG8_LDB
#undef PG8_MMA
#undef PG8_WAIT_V
#undef PG8_WAIT_L
#undef PG8_BAR
#undef PG8_SCHED
}
}
namespace pg8 {
struct EpiProj {
    static constexpr bool PERM = true, AFTER_DRAIN = false;
    bf16_t* O; int ldc; int gelu_tiles;
    __device__ __forceinline__ void operator()(const f32x4 (&acc)[2][2][4][2], const Unit& u, int wr, int wc, int fr, int fq) const {
        const int row0 = u.pm * BM + wr * 64 + fr; const int col0 = u.pn * BM + wc * 32 + 8 * fq;
        const bool act = u.pn < gelu_tiles;
#pragma unroll
        for (int ai = 0; ai < 2; ++ai)
#pragma unroll
            for (int m = 0; m < 4; ++m) { bf16_t* rowp = O + (size_t)(row0 + ai * HALF + m * 16) * ldc + col0;
#pragma unroll
                for (int bj = 0; bj < 2; ++bj) { f32x4 v0 = acc[ai][bj][m][0], v1 = acc[ai][bj][m][1];
                    if (act) { f32x2 a = gelu_pk((f32x2){v0[0], v0[1]}), b = gelu_pk((f32x2){v0[2], v0[3]}), c = gelu_pk((f32x2){v1[0], v1[1]}), d = gelu_pk((f32x2){v1[2], v1[3]});
                        v0 = (f32x4){a.x, a.y, b.x, b.y}; v1 = (f32x4){c.x, c.y, d.x, d.y}; }
                    u32x4 w; w.x = cvt_pk_bf16(v0[0], v0[1]); w.y = cvt_pk_bf16(v0[2], v0[3]); w.z = cvt_pk_bf16(v1[0], v1[1]); w.w = cvt_pk_bf16(v1[2], v1[3]);
                    *(u32x4*)(rowp + bj * HALF) = w; } }
    }
};
struct EpiResid {
    static constexpr bool PERM = false, AFTER_DRAIN = false;
    const float* base; const float* gate; float* out; int ldc;
    __device__ __forceinline__ void operator()(const f32x4 (&acc)[2][2][4][2], const Unit& u, int wr, int wc, int fr, int fq) const {
        const int row0 = u.pm * BM + wr * 64 + fr, col0 = u.pn * BM + wc * 32 + 4 * fq;
        f32x4 gv[2][2];
#pragma unroll
        for (int bj = 0; bj < 2; ++bj)
#pragma unroll
            for (int n = 0; n < 2; ++n) gv[bj][n] = *(const f32x4*)(gate + col0 + bj * HALF + n * 16);
#pragma unroll
        for (int ai = 0; ai < 2; ++ai)
#pragma unroll
            for (int m = 0; m < 4; ++m) { const size_t off = (size_t)(row0 + ai * HALF + m * 16) * ldc + col0;
#pragma unroll
                for (int bj = 0; bj < 2; ++bj)
#pragma unroll
                    for (int n = 0; n < 2; ++n) { const f32x4 b = *(const f32x4*)(base + off + bj * HALF + n * 16); *(f32x4*)(out + off + bj * HALF + n * 16) = b + gv[bj][n] * acc[ai][bj][m][n]; } }
    }
};
struct EpiQ8 {
    static constexpr bool PERM = true, AFTER_DRAIN = false;
    bf16_t* O; int ldc; int gelu_tiles; const float* rs; const float* cs;
    __device__ __forceinline__ void operator()(const f32x4 (&acc)[2][2][4][2], const Unit& u, int wr, int wc, int fr, int fq) const {
        const int row0 = u.pm * BM + wr * 64 + fr; const int col0 = u.pn * BM + wc * 32 + 8 * fq;
        const bool act = u.pn < gelu_tiles;
        f32x4 cv[2][2];
#pragma unroll
        for (int bj = 0; bj < 2; ++bj)
#pragma unroll
            for (int n = 0; n < 2; ++n) cv[bj][n] = *(const f32x4*)(cs + col0 + bj * HALF + 4 * n);
#pragma unroll
        for (int ai = 0; ai < 2; ++ai)
#pragma unroll
            for (int m = 0; m < 4; ++m) { const int row = row0 + ai * HALF + m * 16; const float rsc = rs[row]; bf16_t* rowp = O + (size_t)row * ldc + col0;
#pragma unroll
                for (int bj = 0; bj < 2; ++bj) { const i32x4 a0 = __builtin_bit_cast(i32x4, acc[ai][bj][m][0]), a1 = __builtin_bit_cast(i32x4, acc[ai][bj][m][1]);
                    f32x4 v0 = (f32x4){(float)a0[0], (float)a0[1], (float)a0[2], (float)a0[3]} * rsc * cv[bj][0], v1 = (f32x4){(float)a1[0], (float)a1[1], (float)a1[2], (float)a1[3]} * rsc * cv[bj][1];
                    if (act) { f32x2 a = gelu_pk((f32x2){v0[0], v0[1]}), b = gelu_pk((f32x2){v0[2], v0[3]}), c = gelu_pk((f32x2){v1[0], v1[1]}), d = gelu_pk((f32x2){v1[2], v1[3]});
                        v0 = (f32x4){a.x, a.y, b.x, b.y}; v1 = (f32x4){c.x, c.y, d.x, d.y}; }
                    u32x4 w; w.x = cvt_pk_bf16(v0[0], v0[1]); w.y = cvt_pk_bf16(v0[2], v0[3]); w.z = cvt_pk_bf16(v1[0], v1[1]); w.w = cvt_pk_bf16(v1[2], v1[3]);
                    *(u32x4*)(rowp + bj * HALF) = w; } }
    }
};
struct EpiResid2 {
    static constexpr bool PERM = true, AFTER_DRAIN = false;
    const float* base; const float* gate; bf16_t* xb; float* ssq; int ldc;
    __device__ __forceinline__ void operator()(const f32x4 (&acc)[2][2][4][2], const Unit& u, int wr, int wc, int fr, int fq) const {
        const int row0 = u.pm * BM + wr * 64 + fr, col0 = u.pn * BM + wc * 32 + 8 * fq;
        f32x4 gv[2][2];
#pragma unroll
        for (int bj = 0; bj < 2; ++bj)
#pragma unroll
            for (int n = 0; n < 2; ++n) gv[bj][n] = *(const f32x4*)(gate + col0 + bj * HALF + 4 * n);
#pragma unroll
        for (int ai = 0; ai < 2; ++ai)
#pragma unroll
            for (int m = 0; m < 4; ++m) { const int row = row0 + ai * HALF + m * 16; const size_t off = (size_t)row * ldc + col0; float ss = 0.f;
#pragma unroll
                for (int bj = 0; bj < 2; ++bj) {
                    const f32x4 b0 = *(const f32x4*)(base + off + bj * HALF), b1 = *(const f32x4*)(base + off + bj * HALF + 4);
                    const f32x4 v0 = b0 + gv[bj][0] * acc[ai][bj][m][0], v1 = b1 + gv[bj][1] * acc[ai][bj][m][1];
                    ss += (v0[0] * v0[0] + v0[1] * v0[1]) + (v0[2] * v0[2] + v0[3] * v0[3]) + (v1[0] * v1[0] + v1[1] * v1[1]) + (v1[2] * v1[2] + v1[3] * v1[3]);
                    u32x4 w; w.x = cvt_pk_bf16(v0[0], v0[1]); w.y = cvt_pk_bf16(v0[2], v0[3]); w.z = cvt_pk_bf16(v1[0], v1[1]); w.w = cvt_pk_bf16(v1[2], v1[3]);
                    *(u32x4*)(xb + off + bj * HALF) = w; }
                ss += __shfl_xor(ss, 16); ss += __shfl_xor(ss, 32);
                if (fq == 0) ssq[(size_t)row * 32 + u.pn * 4 + wc] = ss; }
    }
};
struct EpiQ {
    static constexpr bool PERM = true, AFTER_DRAIN = false;
    bf16_t* O; int ldc; const float* bias; const PG8_LAS float* rstd;
    __device__ __forceinline__ void operator()(const f32x4 (&acc)[2][2][4][2], const Unit& u, int wr, int wc, int fr, int fq) const {
        const int lrow0 = wr * 64 + fr, col0 = u.pn * BM + wc * 32 + 8 * fq;
        f32x4 bv[2][2];
#pragma unroll
        for (int bj = 0; bj < 2; ++bj)
#pragma unroll
            for (int n = 0; n < 2; ++n) bv[bj][n] = *(const f32x4*)(bias + col0 + bj * HALF + 4 * n);
#pragma unroll
        for (int ai = 0; ai < 2; ++ai)
#pragma unroll
            for (int m = 0; m < 4; ++m) { const int lrow = lrow0 + ai * HALF + m * 16; const float rs = rstd[(u.pm & 1) * BM + lrow];
                bf16_t* rowp = O + (size_t)(u.pm * BM + lrow) * ldc + col0;
#pragma unroll
                for (int bj = 0; bj < 2; ++bj) { const f32x4 v0 = acc[ai][bj][m][0] * rs + bv[bj][0], v1 = acc[ai][bj][m][1] * rs + bv[bj][1];
                    u32x4 w; w.x = cvt_pk_bf16(v0[0], v0[1]); w.y = cvt_pk_bf16(v0[2], v0[3]); w.z = cvt_pk_bf16(v1[0], v1[1]); w.w = cvt_pk_bf16(v1[2], v1[3]);
                    *(u32x4*)(rowp + bj * HALF) = w; } }
    }
};
}
#ifndef PG8_SP2
#define PG8_SP2 true
#endif
#ifndef PG8_ALIGN
#define PG8_ALIGN true
#endif
constexpr int NWAVES = 8;
constexpr int M = 16384, D = 2048;
constexpr int IN_COLS = 6152, NWIN = 6144, NPROJ = 5120;
constexpr int C_UG = 0, C_VG = 1024, C_Q = 2048, C_K = 3072, C_OM = 4096;
constexpr int WROW_VM = 5120;
constexpr int NHEAD = 4, DH = 256, CH = 128, NCHUNK = M / CH;
constexpr int NEXP = 16384, PH = 8, TOPK = 16, NSEL = PH * TOPK;
constexpr float EPS = 1e-6f;
constexpr int MOD_SHM = 0, MOD_SCM = 2048, MOD_GM = 4096, MOD_SHF = 6144, MOD_SCF = 8192, MOD_GF = 10240, NMOD = 12288;
constexpr int ADA_KC = 16, ADA_KROWS = D / ADA_KC;

constexpr size_t MiB = 1u << 20;
constexpr size_t WS_CTL = 0, CTL_ZERO_BYTES = 1 * MiB;
constexpr size_t WS_MODP = 1 * MiB;
constexpr size_t WS_MODF = WS_MODP + (size_t)ADA_KC * NMOD * 4;
constexpr size_t WS_GATES = 2 * MiB;
constexpr size_t WS_SUMM = 2 * MiB + 512 * 1024;
constexpr size_t WS_MTAB = WS_SUMM + 8192;
constexpr size_t WS_NST = 3 * MiB;
constexpr size_t WS_WIN = 4 * MiB;
constexpr size_t WS_WOUT = 28 * MiB;
constexpr size_t WS_WQ = 36 * MiB;
constexpr size_t WS_IDX = 44 * MiB;
constexpr size_t WS_PG = 52 * MiB;
constexpr size_t WS_SSQP = 60 * MiB;
constexpr size_t WS_BQP = 62 * MiB, WS_BIASQ = 62 * MiB + 512 * 1024;
constexpr size_t WS_SW = 62 * MiB + 768 * 1024;
constexpr size_t WS_CMAXP = 63 * MiB;
constexpr size_t WS_SA = 3 * MiB + 512 * 1024 + 131072;
constexpr size_t WS_HA = 64 * MiB;
constexpr size_t WS_PROJ = 128 * MiB;
constexpr size_t WS_VT = 288 * MiB;
constexpr size_t WS_X1 = 192 * MiB;
constexpr size_t WS_STATE = 320 * MiB;
constexpr size_t WS_ED = 384 * MiB, WS_EU = 416 * MiB;
constexpr size_t WS_SD = 3 * MiB + 512 * 1024, WS_SU = WS_SD + 65536;
constexpr size_t WS_END = 512 * MiB;
constexpr int CW_TMO = 0, CW_CODE = 1, CW_BAR = 4096;

constexpr int RING_BYTES = 131072, LDSCTL_OFF = 163328, MISC_OFF = LDSCTL_OFF + 320, LDS_BYTES = 163840;

#define GAS __attribute__((address_space(1)))
#define LAS __attribute__((address_space(3)))
#define DI __device__ __forceinline__
typedef unsigned short bf16;
typedef unsigned v4u __attribute__((ext_vector_type(4)));
typedef unsigned v2u __attribute__((ext_vector_type(2)));
typedef float f32x4 __attribute__((ext_vector_type(4)));
typedef float f32x16 __attribute__((ext_vector_type(16)));
typedef short bf16x8 __attribute__((ext_vector_type(8)));
typedef GAS unsigned gu32;
#define RLX_AGENT __ATOMIC_RELAXED, __HIP_MEMORY_SCOPE_AGENT
#define LDS_WAIT() asm volatile("s_waitcnt lgkmcnt(0)" ::: "memory")
#define VM_WAIT() asm volatile("s_waitcnt vmcnt(0)" ::: "memory")
#define MFMA32(a, b, c) __builtin_amdgcn_mfma_f32_32x32x16_bf16((a), (b), (c), 0, 0, 0)
DI unsigned f2bf(float f) { unsigned u = __builtin_bit_cast(unsigned, f); return (u + 0x7fffu + ((u >> 16) & 1u)) >> 16; }
DI unsigned pk2(float lo, float hi) { return f2bf(lo) | (f2bf(hi) << 16); }
DI float bflo(unsigned w) { return __builtin_bit_cast(float, w << 16); }
DI float bfhi(unsigned w) { return __builtin_bit_cast(float, w & 0xffff0000u); }
DI float bf2f(unsigned short h) { return __builtin_bit_cast(float, (unsigned)h << 16); }
DI int crow(int reg, int h) { return (reg & 3) + 8 * (reg >> 2) + 4 * h; }
DI float wave_sum(float v) {
#pragma unroll
    for (int o = 1; o < 64; o <<= 1) v += __shfl_xor(v, o);
    return v;
}
DI float wave_max(float v) {
#pragma unroll
    for (int o = 1; o < 64; o <<= 1) v = fmaxf(v, __shfl_xor(v, o));
    return v;
}
DI float silu_f(float v) { return v / (1.0f + __expf(-v)); }
DI float sigmoid_f(float v) { return 1.0f / (1.0f + __expf(-v)); }
DI float gelu_f(float v) { return 0.5f * v * (1.0f + erff(v * 0.70710678118654752f)); }
typedef __bf16 bf16v2 __attribute__((ext_vector_type(2)));
#define DOT2(a, b, c) __builtin_amdgcn_fdot2_f32_bf16(__builtin_bit_cast(bf16v2, (unsigned)(a)), __builtin_bit_cast(bf16v2, (unsigned)(b)), (c), false)
DI f32x16 zero16() { f32x16 z; for (int i = 0; i < 16; ++i) z[i] = 0.f; return z; }
#define XB_TMO      128
#define XB_XCNT(j)  (256  + 64 * (j))
#define XB_XSUB(j)  (1280 + 64 * (j))
#define XB_XGEN(j)  (2304 + 64 * (j))
#define XB_TOP      3328
#define XB_TOPGEN   3392
#define XCD_BAR_WORDS 3456
#define XB_SPIN_CAP (1u << 18)

__device__ __forceinline__ unsigned xb_ld(unsigned* p)              { return __hip_atomic_load(p, __ATOMIC_RELAXED, __HIP_MEMORY_SCOPE_AGENT); }
__device__ __forceinline__ unsigned xb_add(unsigned* p, unsigned v) { return __hip_atomic_fetch_add(p, v, __ATOMIC_RELAXED, __HIP_MEMORY_SCOPE_AGENT); }
__device__ __forceinline__ unsigned xb_xcc_id() { return (unsigned)__builtin_amdgcn_s_getreg((3 << 11) | 20) & 0xFu; }
#define XB_SPIN(cond, bar) do { unsigned _sp = 0; while (cond) { __builtin_amdgcn_s_sleep(1); \
    if ((++_sp & 255u) == 0u) { if (xb_ld(&(bar)[XB_TMO])) break; if (_sp > XB_SPIN_CAP) { atomicAdd(&(bar)[XB_TMO], 1u); break; } } } } while (0)

struct XcdBarrier {
    unsigned* bar; unsigned x;
    volatile LAS unsigned* st;
};

__device__ __forceinline__ XcdBarrier xcd_barrier_post(unsigned* bar, volatile LAS unsigned* st) {
    XcdBarrier b; b.bar = bar; b.x = xb_xcc_id(); b.st = st;
    if (threadIdx.x == 0) (void)xb_add(&bar[XB_XCNT(b.x)], 1u);
    return b;
}
__device__ __forceinline__ void xcd_barrier_complete(unsigned* bar, unsigned x, unsigned& nloc, unsigned& nx) {
    const unsigned G = gridDim.x * gridDim.y * gridDim.z;
    unsigned sum, cnt, mine, sp = 0u;
    for (;;) {
        sum = 0u; cnt = 0u; mine = 0u;
#pragma unroll
        for (unsigned j = 0; j < 16; ++j) { const unsigned c = xb_ld(&bar[XB_XCNT(j)]); sum += c; cnt += (c > 0u) ? 1u : 0u; mine = (j == x) ? c : mine; }
        if (sum == G) break;
        __builtin_amdgcn_s_sleep(1);
        if ((++sp & 255u) == 0u) { if (xb_ld(&bar[XB_TMO])) break; if (sp > XB_SPIN_CAP) { atomicAdd(&bar[XB_TMO], 1u); break; } }
    }
    nloc = mine > 0u ? mine : 1u; nx = cnt > 0u ? cnt : 1u;
}

__device__ __forceinline__ void xcd_barrier(const XcdBarrier& b) {
    asm volatile("s_waitcnt vmcnt(0)" ::: "memory");
    __syncthreads();
    if (threadIdx.x == 0) {
        unsigned* bar = b.bar;
        __builtin_amdgcn_s_waitcnt(0);
        unsigned nloc = b.st[0], nx = b.st[1];
        if (nloc == 0u) { xcd_barrier_complete(bar, b.x, nloc, nx); b.st[0] = nloc; b.st[1] = nx; }
        const unsigned old = xb_add(&bar[XB_XSUB(b.x)], 1u);
        const unsigned gen = old / nloc;
        if (old + 1u == (gen + 1u) * nloc) {
            __builtin_amdgcn_fence(__ATOMIC_RELEASE, "agent");
            asm volatile("s_waitcnt vmcnt(0)" ::: "memory");
            const unsigned og = xb_add(&bar[XB_TOP], 1u);
            const unsigned tg = og / nx;
            if (og + 1u == (tg + 1u) * nx) xb_add(&bar[XB_TOPGEN], 1u);
            else XB_SPIN(xb_ld(&bar[XB_TOPGEN]) == tg, bar);
            __builtin_amdgcn_fence(__ATOMIC_ACQUIRE, "agent");
            xb_add(&bar[XB_XGEN(b.x)], 1u);
            asm volatile("s_waitcnt vmcnt(0)" ::: "memory");
        } else {
            XB_SPIN(xb_ld(&bar[XB_XGEN(b.x)]) == gen, bar);
            __builtin_amdgcn_fence(__ATOMIC_ACQUIRE, "agent");
            asm volatile("s_waitcnt vmcnt(0)" ::: "memory");
        }
    }
    __syncthreads();
}
struct Frame {
    LAS unsigned char* lds;
    volatile LAS unsigned* MISC;
    gu32* ctl;
    int tid, lane, wave, vcu, G;
    const float *x, *c, *ada_w, *ada_b, *norm_mix_g, *w_in, *b_gates, *conv_w, *conv_b, *gmlp_norm_g, *gmlp_w, *gmlp_b, *mlstm_norm_g, *w_out, *norm_ffn_g,
                *wq, *keys1, *keys2, *e_down, *e_up, *final_g;
    float* out;
    float *MODP, *MODF, *GATES, *SUMM, *MTAB, *NST, *PG;
    int* IDX;
    bf16 *WIN, *WOUT, *WQ, *HA, *PROJ, *QB, *STATE, *QC, *KC, *VT;
    unsigned char *ED, *EU, *H1Q; float *SD, *SU;
    float *SSQP, *BQP, *BIASQ, *SW, *CMAXP, *SA; bf16* X1B;
};

DI void p0_transpose_item(const float* W, int K, int ldw, int nblk, bf16* WT, LAS float* scr, int item, int lane, bool vm_last = false) {
    const int kb = item / nblk, nb = item % nblk, k0 = 64 * kb, n0 = 32 * nb;
    const int d0 = !vm_last ? n0 : (n0 < 4096 ? n0 : (n0 < 5120 ? n0 + 1024 : n0 - 1024));
#pragma unroll 8
    for (int i = 0; i < 32; ++i) { const int kk = 2 * i + (lane >> 5); scr[kk * 33 + (lane & 31)] = W[(size_t)(k0 + kk) * ldw + n0 + (lane & 31)]; }
    LDS_WAIT(); asm volatile("" ::: "memory");
    const int c = lane & 7;
#pragma unroll
    for (int j = 0; j < 4; ++j) { const int n = (lane >> 3) + 8 * j; const LAS float* s = scr + (8 * c) * 33 + n;
        v4u o; o.x = pk2(s[0 * 33], s[1 * 33]); o.y = pk2(s[2 * 33], s[3 * 33]); o.z = pk2(s[4 * 33], s[5 * 33]); o.w = pk2(s[6 * 33], s[7 * 33]);
        *(GAS v4u*)(WT + (size_t)(d0 + n) * K + k0 + 8 * c) = o; }
    LDS_WAIT(); asm volatile("" ::: "memory");
}
DI void p0_colmax_item(Frame& F, int item) {
    const int lane = F.lane, nblk = NWIN / 32, kb = item / nblk, nb = item % nblk, k0 = 64 * kb, n0 = 32 * nb;
    float m = 0.f;
#pragma unroll 8
    for (int i = 0; i < 32; ++i) { const int kk = 2 * i + (lane >> 5); m = fmaxf(m, fabsf(F.w_in[(size_t)(k0 + kk) * IN_COLS + n0 + (lane & 31)])); }
    m = fmaxf(m, __shfl_xor(m, 32));
    if (lane < 32) F.CMAXP[(size_t)kb * NWIN + n0 + lane] = m;
}
DI void p0_ada_item(Frame& F, LAS float* scr, int item) {
    const int cc = item % (NMOD / 256), kc = item / (NMOD / 256), k0 = kc * ADA_KROWS, col = cc * 256 + F.lane * 4;
#pragma unroll
    for (int j = 0; j < ADA_KROWS / 64; ++j) scr[F.lane + 64 * j] = silu_f(F.c[k0 + F.lane + 64 * j]);
    LDS_WAIT(); asm volatile("" ::: "memory");
    f32x4 acc = {0.f, 0.f, 0.f, 0.f};
    const float* wp = F.ada_w + (size_t)k0 * NMOD + col;
#pragma unroll 8
    for (int kk = 0; kk < ADA_KROWS; ++kk) { const float s = scr[kk]; const f32x4 w = *(const GAS f32x4*)(wp + (size_t)kk * NMOD); acc += w * s; }
    *(GAS f32x4*)(F.MODP + (size_t)kc * NMOD + col) = acc;
    LDS_WAIT(); asm volatile("" ::: "memory");
}
DI void p0a_phase(Frame& F) {
    LAS float* scr = (LAS float*)(F.lds + F.wave * 16384);
    const int gw = F.wave * F.G + F.vcu, NGW = F.G * NWAVES;
    constexpr int I_ADA = (NMOD / 256) * ADA_KC;
    constexpr int I_WIN = (D / 64) * (NWIN / 32), I_WO = (D / 64) * (D / 32);
    constexpr int NITEMS = I_ADA + I_WIN + I_WO;
    for (int it = gw; it < NITEMS; it += NGW) {
        int r = it;
        if (r < I_ADA) { p0_ada_item(F, scr, r); continue; } r -= I_ADA;
        if (r < I_WIN) { p0_colmax_item(F, r); continue; } r -= I_WIN;
        p0_transpose_item(F.w_out, D, D, D / 32, F.WOUT, scr, r, F.lane);
    }
#pragma unroll 1
    for (int row = gw; row < 2 * NEXP; row += NGW) {
        const int tb = row >= NEXP, e = row - tb * NEXP;
        const GAS f32x4* src = (const GAS f32x4*)((tb ? F.e_up : F.e_down) + (size_t)e * D) + F.lane;
        f32x4 v[8]; float am = 0.f;
#pragma unroll
        for (int j = 0; j < 8; ++j) { v[j] = src[64 * j]; am = fmaxf(am, fmaxf(fmaxf(fabsf(v[j].x), fabsf(v[j].y)), fmaxf(fabsf(v[j].z), fabsf(v[j].w)))); }
        am = fmaxf(wave_max(am), 1e-30f);
        const float sc = am * (1.0f / 127.0f), inv = 127.0f / am;
        GAS unsigned* dst = (GAS unsigned*)((tb ? F.EU : F.ED) + (size_t)e * D) + F.lane;
        const int off = tb ? 128 : 0;
#pragma unroll
        for (int j = 0; j < 8; ++j) {
            const int q0 = (int)__builtin_rintf(v[j].x * inv) + off, q1 = (int)__builtin_rintf(v[j].y * inv) + off, q2 = (int)__builtin_rintf(v[j].z * inv) + off, q3 = (int)__builtin_rintf(v[j].w * inv) + off;
            dst[64 * j] = (unsigned)(q0 & 255) | ((unsigned)(q1 & 255) << 8) | ((unsigned)(q2 & 255) << 16) | ((unsigned)(q3 & 255) << 24);
        }
        if (F.lane == 0) (tb ? F.SU : F.SD)[e] = sc;
    }
}
DI float mod_final(Frame& F, int col) { float s = F.ada_b[col];
#pragma unroll
    for (int k = 0; k < ADA_KC; ++k) s += F.MODP[(size_t)k * NMOD + col];
    return s; }
DI void norm_tables(Frame& F, const float* g, int col_scale, int col_shift) {
    LAS float* A1 = (LAS float*)(F.lds); LAS float* B1 = (LAS float*)(F.lds + 8192);
#pragma unroll
    for (int i = 0; i < 4; ++i) { const int c = F.tid + 512 * i; A1[c] = g[c] * (1.0f + F.MODF[col_scale + c]); B1[c] = F.MODF[col_shift + c]; }
}
DI void p0_wq_item(Frame& F, LAS float* scr, int item) {
    const int lane = F.lane, nblk = D / 32, kb = item / nblk, nb = item % nblk, k0 = 64 * kb, n0 = 32 * nb;
    LAS float* gsl = scr + 64 * 33; LAS float* shl = gsl + 64;
    gsl[lane] = F.norm_ffn_g[k0 + lane] * (1.0f + mod_final(F, MOD_SCF + k0 + lane)); shl[lane] = mod_final(F, MOD_SHF + k0 + lane);
    LDS_WAIT(); asm volatile("" ::: "memory");
    float bp = 0.f;
#pragma unroll 8
    for (int i = 0; i < 32; ++i) { const int kk = 2 * i + (lane >> 5); const float w = F.wq[(size_t)(k0 + kk) * D + n0 + (lane & 31)]; scr[kk * 33 + (lane & 31)] = w * gsl[kk]; bp += w * shl[kk]; }
    bp += __shfl_xor(bp, 32);
    if (lane < 32) F.BQP[(size_t)kb * D + n0 + lane] = bp;
    LDS_WAIT(); asm volatile("" ::: "memory");
    const int c = lane & 7;
#pragma unroll
    for (int j = 0; j < 4; ++j) { const int n = (lane >> 3) + 8 * j; const LAS float* sp = scr + (8 * c) * 33 + n;
        v4u o; o.x = pk2(sp[0 * 33], sp[1 * 33]); o.y = pk2(sp[2 * 33], sp[3 * 33]); o.z = pk2(sp[4 * 33], sp[5 * 33]); o.w = pk2(sp[6 * 33], sp[7 * 33]);
        *(GAS v4u*)(F.WQ + (size_t)(n0 + n) * D + k0 + 8 * c) = o; }
    LDS_WAIT(); asm volatile("" ::: "memory");
}
DI void p0_winq_item(Frame& F, LAS float* scr, int item) {
    const int lane = F.lane, nblk = NWIN / 32, kb = item / nblk, nb = item % nblk, k0 = 64 * kb, n0 = 32 * nb;
    const int d0 = n0 < 4096 ? n0 : (n0 < 5120 ? n0 + 1024 : n0 - 1024);
    LAS float* inv = scr + 64 * 33;
    if (lane < 32) { float m = 0.f;
#pragma unroll 8
        for (int q = 0; q < D / 64; ++q) m = fmaxf(m, F.CMAXP[(size_t)q * NWIN + n0 + lane]);
        m = fmaxf(m, 1e-30f); inv[lane] = 127.0f / m; if (kb == 0) F.SW[d0 + lane] = m * (1.0f / 127.0f); }
#pragma unroll 8
    for (int i = 0; i < 32; ++i) { const int kk = 2 * i + (lane >> 5); scr[kk * 33 + (lane & 31)] = F.w_in[(size_t)(k0 + kk) * IN_COLS + n0 + (lane & 31)]; }
    LDS_WAIT(); asm volatile("" ::: "memory");
    unsigned char* WQ = (unsigned char*)F.WIN;
#pragma unroll
    for (int i = 0; i < 2; ++i) { const int q = lane + 64 * i, n = q >> 2, c = q & 3; const float iv = inv[n]; const LAS float* sp = scr + (16 * c) * 33 + n; v4u o;
#pragma unroll
        for (int w = 0; w < 4; ++w) { const int q0 = (int)__builtin_rintf(sp[(4 * w) * 33] * iv), q1 = (int)__builtin_rintf(sp[(4 * w + 1) * 33] * iv), q2 = (int)__builtin_rintf(sp[(4 * w + 2) * 33] * iv), q3 = (int)__builtin_rintf(sp[(4 * w + 3) * 33] * iv);
            o[w] = (unsigned)(q0 & 255) | ((unsigned)(q1 & 255) << 8) | ((unsigned)(q2 & 255) << 16) | ((unsigned)(q3 & 255) << 24); }
        *(GAS v4u*)(WQ + (size_t)(d0 + n) * D + k0 + 16 * c) = o; }
    LDS_WAIT(); asm volatile("" ::: "memory");
}
DI void p0b_phase(Frame& F) {
    LAS float* A1 = (LAS float*)(F.lds); LAS float* B1 = (LAS float*)(F.lds + 8192); LAS float* WG = (LAS float*)(F.lds + 16384);
#pragma unroll
    for (int i = 0; i < 4; ++i) { const int c = F.tid + 512 * i; A1[c] = F.norm_mix_g[c] * (1.0f + mod_final(F, MOD_SCM + c)); B1[c] = mod_final(F, MOD_SHM + c); }
    { const int per = (NMOD + F.G - 1) / F.G; const int c = (int)blockIdx.x * per + F.tid; if (F.tid < per && c < NMOD) F.MODF[c] = mod_final(F, c); }
#pragma unroll
    for (int i = 0; i < 4; ++i) { const int k = F.tid + 512 * i; const f32x4 a = *(const GAS f32x4*)(F.w_in + (size_t)k * IN_COLS + NWIN), b = *(const GAS f32x4*)(F.w_in + (size_t)k * IN_COLS + NWIN + 4);
        WG[0 * 2048 + k] = a.x; WG[1 * 2048 + k] = a.y; WG[2 * 2048 + k] = a.z; WG[3 * 2048 + k] = a.w; WG[4 * 2048 + k] = b.x; WG[5 * 2048 + k] = b.y; WG[6 * 2048 + k] = b.z; WG[7 * 2048 + k] = b.w; }
    __syncthreads();
    const int gw = F.vcu * NWAVES + F.wave, NGW = F.G * NWAVES;
    f32x4 vn[8];
    { const GAS f32x4* xr = (const GAS f32x4*)(F.x + (size_t)gw * D) + F.lane;
#pragma unroll
      for (int j = 0; j < 8; ++j) vn[j] = xr[64 * j]; }
#pragma unroll 1
    for (int row = gw; row < M; row += NGW) {
        f32x4 v[8]; float ss = 0.f;
#pragma unroll
        for (int j = 0; j < 8; ++j) { v[j] = vn[j]; ss += (v[j].x * v[j].x + v[j].y * v[j].y) + (v[j].z * v[j].z + v[j].w * v[j].w); }
        if (row + NGW < M) { const GAS f32x4* xr = (const GAS f32x4*)(F.x + (size_t)(row + NGW) * D) + F.lane;
#pragma unroll
            for (int j = 0; j < 8; ++j) vn[j] = xr[64 * j]; }
        const float rstd = 1.0f / sqrtf(wave_sum(ss) * (1.0f / D) + EPS);
        float gd[8];
#pragma unroll
        for (int g = 0; g < 8; ++g) gd[g] = 0.f;
        GAS v2u* o8 = (GAS v2u*)(F.HA + (size_t)row * D) + F.lane;
#pragma unroll
        for (int j = 0; j < 8; ++j) {
            const f32x4 a = *(const LAS f32x4*)(A1 + 256 * j + 4 * F.lane), b = *(const LAS f32x4*)(B1 + 256 * j + 4 * F.lane);
            const f32x4 h = v[j] * rstd * a + b;
            v2u o; o.x = pk2(h.x, h.y); o.y = pk2(h.z, h.w); o8[64 * j] = o;
#pragma unroll
            for (int g = 0; g < 8; ++g) { const f32x4 w = *(const LAS f32x4*)(WG + g * 2048 + 256 * j + 4 * F.lane); gd[g] += (h.x * w.x + h.y * w.y) + (h.z * w.z + h.w * w.w); }
            asm volatile("" ::: "memory");
        }
#pragma unroll
        for (int g = 0; g < 8; ++g) gd[g] = wave_sum(gd[g]);
        if (F.lane == 0) {
#pragma unroll
            for (int g = 0; g < 8; ++g) { float p = gd[g] + F.b_gates[g];
                if (g >= 4) { p = fminf(p, 0.f) - log1pf(__expf(-fabsf(p))); }
                F.GATES[(size_t)row * 8 + g] = p; }
        }
    }
#pragma unroll 1
    for (int row = gw; row < M; row += NGW) {
        const GAS v4u* hr = (const GAS v4u*)(F.HA + (size_t)row * D) + F.lane;
        v4u w[4]; float am = 0.f;
#pragma unroll
        for (int i = 0; i < 4; ++i) { w[i] = hr[64 * i];
            am = fmaxf(am, fmaxf(fmaxf(fmaxf(fabsf(bflo(w[i].x)), fabsf(bfhi(w[i].x))), fmaxf(fabsf(bflo(w[i].y)), fabsf(bfhi(w[i].y)))), fmaxf(fmaxf(fabsf(bflo(w[i].z)), fabsf(bfhi(w[i].z))), fmaxf(fabsf(bflo(w[i].w)), fabsf(bfhi(w[i].w)))))); }
        am = fmaxf(wave_max(am), 1e-30f); const float qinv = 127.0f / am;
        GAS v2u* qr = (GAS v2u*)(F.H1Q + (size_t)row * D) + F.lane;
#pragma unroll
        for (int i = 0; i < 4; ++i) {
            const int q0 = (int)__builtin_rintf(bflo(w[i].x) * qinv), q1 = (int)__builtin_rintf(bfhi(w[i].x) * qinv), q2 = (int)__builtin_rintf(bflo(w[i].y) * qinv), q3 = (int)__builtin_rintf(bfhi(w[i].y) * qinv);
            const int q4 = (int)__builtin_rintf(bflo(w[i].z) * qinv), q5 = (int)__builtin_rintf(bfhi(w[i].z) * qinv), q6 = (int)__builtin_rintf(bflo(w[i].w) * qinv), q7 = (int)__builtin_rintf(bfhi(w[i].w) * qinv);
            v2u o; o.x = (unsigned)(q0 & 255) | ((unsigned)(q1 & 255) << 8) | ((unsigned)(q2 & 255) << 16) | ((unsigned)(q3 & 255) << 24);
            o.y = (unsigned)(q4 & 255) | ((unsigned)(q5 & 255) << 8) | ((unsigned)(q6 & 255) << 16) | ((unsigned)(q7 & 255) << 24);
            qr[64 * i] = o; }
        if (F.lane == 0) F.SA[row] = am * (1.0f / 127.0f);
    }
    __syncthreads();
    {
        LAS float* scr = (LAS float*)(F.lds + F.wave * 8960);
        for (int it = F.wave * F.G + F.vcu; it < (D / 64) * (D / 32); it += NGW) p0_wq_item(F, scr, it);
        for (int it = F.wave * F.G + F.vcu; it < (D / 64) * (NWIN / 32); it += NGW) p0_winq_item(F, scr, it);
    }
}
constexpr int IMG_PITCH = 576, M1_WL = 73728, M1_RED = 74240, M1_OB = 90624;
typedef short s16x4 __attribute__((ext_vector_type(4)));
DI bf16x8 tr_frag(const LAS unsigned char* p, int off_lo, int off_hi) {
    const s16x4 lo = __builtin_amdgcn_ds_read_tr16_b64_v4i16((LAS s16x4*)(p + off_lo));
    const s16x4 hi = __builtin_amdgcn_ds_read_tr16_b64_v4i16((LAS s16x4*)(p + off_hi));
    return __builtin_shufflevector(lo, hi, 0, 1, 2, 3, 4, 5, 6, 7);
}
DI float bfel(const v4u& w, int e) { const unsigned d = w[e >> 1]; return (e & 1) ? bfhi(d) : bflo(d); }
DI void m1_item(Frame& F, int hh, int kc) {
    LAS unsigned char* IMG = F.lds; LAS float* WL = (LAS float*)(F.lds + M1_WL); LAS float* RED = (LAS float*)(F.lds + M1_RED);
    const int t0 = kc * CH, lane = F.lane, tid = F.tid;
    if (F.wave == 0) {
        const float* gp = F.GATES + (size_t)(t0 + 2 * lane) * 8;
        const float i0 = gp[hh], lf0 = gp[4 + hh], i1 = gp[8 + hh], lf1 = gp[12 + hh];
        const float p = lf0 + lf1; float inc = p;
#pragma unroll
        for (int o = 1; o < 64; o <<= 1) { const float t = __shfl_up(inc, o); if (lane >= o) inc += t; }
        const float A = __shfl(inc, 63), ex = inc - p, b0 = ex + lf0, b1 = ex + p;
        const float lw0 = A - b0 + i0, lw1 = A - b1 + i1;
        const float B = wave_max(fmaxf(lw0, lw1));
        WL[2 * lane] = __expf(lw0 - B); WL[2 * lane + 1] = __expf(lw1 - B);
        if (lane == 0) { F.SUMM[(hh * NCHUNK + kc) * 2] = A; F.SUMM[(hh * NCHUNK + kc) * 2 + 1] = B; }
    }
    __syncthreads();
    const int dg = tid & 31, sg = tid >> 5;
#pragma unroll 1
    for (int which = 0; which < 2; ++which) {
        const int chb = (which == 0 ? 1024 : 0) + hh * DH + dg * 8;
        const int colb = (which == 0 ? C_K : C_Q) + hh * DH + dg * 8;
        v4u raw[11];
#pragma unroll
        for (int rr = 0; rr < 11; ++rr) { const int tt = t0 + sg * 8 - 3 + rr; raw[rr] = (v4u){0u, 0u, 0u, 0u}; if (tt >= 0) raw[rr] = *(const GAS v4u*)(F.PROJ + (size_t)tt * NPROJ + colb); }
        float wl[8];
#pragma unroll
        for (int i = 0; i < 8; ++i) wl[i] = (which == 0) ? WL[sg * 8 + i] : 0.0625f;
        v4u o1[8], o2[8];
#pragma unroll
        for (int dw = 0; dw < 4; ++dw) {
            typedef float f32x2 __attribute__((ext_vector_type(2)));
            f32x2 cw[4];
#pragma unroll
            for (int j = 0; j < 4; ++j) cw[j] = *(const GAS f32x2*)(F.conv_w + j * 2048 + chb + 2 * dw);
            const f32x2 cb = *(const GAS f32x2*)(F.conv_b + chb + 2 * dw);
            float xl[11], xh[11];
#pragma unroll
            for (int rr = 0; rr < 11; ++rr) { xl[rr] = bflo(raw[rr][dw]); xh[rr] = bfhi(raw[rr][dw]); }
            float d0 = 0.f, d1 = 0.f;
#pragma unroll
            for (int i = 0; i < 8; ++i) {
                float a0 = cb.x, a1 = cb.y;
#pragma unroll
                for (int j = 0; j < 4; ++j) { a0 += cw[j].x * xl[i + j]; a1 += cw[j].y * xh[i + j]; }
                a0 = silu_f(a0); a1 = silu_f(a1);
                if (which == 0) { o1[i][dw] = pk2(a0, a1); a0 *= wl[i]; a1 *= wl[i]; d0 += a0; d1 += a1; o2[i][dw] = pk2(a0, a1); }
                else { o1[i][dw] = pk2(a0 * wl[i], a1 * wl[i]); }
            }
            if (which == 0) { RED[sg * 256 + dg * 8 + 2 * dw] = d0; RED[sg * 256 + dg * 8 + 2 * dw + 1] = d1; }
            asm volatile("" ::: "memory");
        }
#pragma unroll
        for (int i = 0; i < 8; ++i) { const int s = sg * 8 + i, t = t0 + s;
            if (which == 0) { *(GAS v4u*)(F.KC + (size_t)t * 1024 + hh * DH + dg * 8) = o1[i]; *(LAS v4u*)(IMG + s * IMG_PITCH + dg * 16) = o2[i]; }
            else { *(GAS v4u*)(F.QC + (size_t)t * 1024 + hh * DH + dg * 8) = o1[i]; } }
    }
    __syncthreads();
    if (tid < 256) { float s = 0.f;
#pragma unroll
        for (int i = 0; i < 16; ++i) s += RED[i * 256 + tid];
        F.NST[(size_t)(hh * NCHUNK + kc) * DH + tid] = s; }
    const int r = lane & 31, h = lane >> 5, e0 = F.wave * 32;
    bf16x8 bf[8];
#pragma unroll
    for (int ks = 0; ks < 8; ++ks) {
        bf[ks] = *(const GAS bf16x8*)(F.VT + (size_t)(hh * DH + e0 + r) * M + t0 + ks * 16 + 8 * h);
    }
    const LAS unsigned char* trb = IMG + (8 * h + ((lane & 15) >> 2)) * IMG_PITCH + (16 * ((lane >> 4) & 1) + 4 * (lane & 3)) * 2;
    LAS unsigned char* OB = F.lds + M1_OB + F.wave * (32 * 144);
#pragma unroll 1
    for (int dp = 0; dp < 4; ++dp) {
#pragma unroll
        for (int d2 = 0; d2 < 2; ++d2) {
            const int dt = 2 * dp + d2;
            f32x16 acc = zero16();
#pragma unroll
            for (int ks = 0; ks < 8; ++ks) { const bf16x8 af = tr_frag(trb + dt * 64, ks * 16 * IMG_PITCH, ks * 16 * IMG_PITCH + 4 * IMG_PITCH); acc = MFMA32(af, bf[ks], acc); }
#pragma unroll
            for (int g = 0; g < 4; ++g) { v2u o; o.x = pk2(acc[4 * g], acc[4 * g + 1]); o.y = pk2(acc[4 * g + 2], acc[4 * g + 3]);
                *(LAS v2u*)(OB + r * 144 + (d2 * 32 + 8 * g + 4 * h) * 2) = o; }
        }
        LDS_WAIT(); asm volatile("" ::: "memory");
#pragma unroll
        for (int i = 0; i < 4; ++i) { const int q = lane + 64 * i, row = q >> 3, c16 = q & 7;
            *(GAS v4u*)(F.STATE + (size_t)(hh * NCHUNK + kc) * (DH * DH) + (size_t)(e0 + row) * DH + dp * 64 + c16 * 8) = *(const LAS v4u*)(OB + row * 144 + c16 * 16); }
        LDS_WAIT(); asm volatile("" ::: "memory");
    }
    __syncthreads();
}
constexpr int G_WI = 0, G_VI = 34816, G_UI = 75776, G_WP = 272, G_VP = 320, G_UP = 272;
DI void gmlp_block(Frame& F, int g, int n0, int nch) {
    LAS unsigned char* WI = F.lds + G_WI; LAS unsigned char* VI = F.lds + G_VI; LAS unsigned char* UI = F.lds + G_UI;
    const int c0 = g * 128, lane = F.lane, tid = F.tid;
    {
#pragma unroll
        for (int i = 0; i < 8; ++i) { const int p = tid + 512 * i, t = p >> 5, s4 = (p & 31) * 4;
            const f32x4 w = *(const GAS f32x4*)(F.gmlp_w + (size_t)(g * 128 + t) * 128 + s4);
            v2u o; o.x = pk2(s4 <= t ? w.x : 0.f, s4 + 1 <= t ? w.y : 0.f); o.y = pk2(s4 + 2 <= t ? w.z : 0.f, s4 + 3 <= t ? w.w : 0.f);
            *(LAS v2u*)(WI + t * G_WP + s4 * 2) = o; }
    }
    v4u tv[4], tu[4];
#define G_LOAD(N) do { _Pragma("unroll") for (int i = 0; i < 4; ++i) { const int p = tid + 512 * i; const bf16* rowp = F.PROJ + (size_t)((N) * CH + (p >> 4)) * NPROJ + c0 + (p & 15) * 8; \
        tv[i] = *(const GAS v4u*)(rowp + C_VG); tu[i] = *(const GAS v4u*)(rowp + C_UG); } } while (0)
    G_LOAD(n0);
    const int r = lane & 31, h = lane >> 5, ct = F.wave & 3, tp = F.wave >> 2;
    float ng[16];
#pragma unroll
    for (int reg = 0; reg < 16; ++reg) ng[reg] = F.gmlp_norm_g[g * 128 + ct * 32 + crow(reg, h)];
    const LAS unsigned char* trb = VI + (8 * h + ((lane & 15) >> 2)) * G_VP + (ct * 32 + 16 * ((lane >> 4) & 1) + 4 * (lane & 3)) * 2;
#pragma unroll 1
    for (int ci = 0; ci < nch; ++ci) {
        const int n = n0 + ci, t0 = n * CH;
#pragma unroll
        for (int i = 0; i < 4; ++i) { const int p = tid + 512 * i, row = p >> 4, c16 = p & 15; const v4u w = tv[i];
            float a[8] = {bflo(w.x), bfhi(w.x), bflo(w.y), bfhi(w.y), bflo(w.z), bfhi(w.z), bflo(w.w), bfhi(w.w)};
            float ss = (a[0] * a[0] + a[1] * a[1]) + (a[2] * a[2] + a[3] * a[3]) + (a[4] * a[4] + a[5] * a[5]) + (a[6] * a[6] + a[7] * a[7]);
            ss += __shfl_xor(ss, 1); ss += __shfl_xor(ss, 2); ss += __shfl_xor(ss, 4); ss += __shfl_xor(ss, 8);
            const float rs = 1.0f / sqrtf(ss * (1.0f / 128.0f) + EPS);
            v4u o; o.x = pk2(a[0] * rs, a[1] * rs); o.y = pk2(a[2] * rs, a[3] * rs); o.z = pk2(a[4] * rs, a[5] * rs); o.w = pk2(a[6] * rs, a[7] * rs);
            *(LAS v4u*)(VI + row * G_VP + c16 * 16) = o; *(LAS v4u*)(UI + row * G_UP + c16 * 16) = tu[i]; }
        __syncthreads();
        if (ci + 1 < nch) G_LOAD(n + 1);
#pragma unroll 1
        for (int ti = 0; ti < 2; ++ti) {
            const int tt = (ti == 0) ? tp : 3 - tp;
            const int t = tt * 32 + r;
            const LAS unsigned char* wrow = WI + t * G_WP + 16 * h;
            f32x16 acc = zero16();
#pragma unroll
            for (int ks = 0; ks < 8; ++ks) if (ks <= 2 * tt + 1) {
                const bf16x8 af = tr_frag(trb, ks * 16 * G_VP, ks * 16 * G_VP + 4 * G_VP);
                const bf16x8 bw = *(const LAS bf16x8*)(wrow + 32 * ks);
                acc = MFMA32(af, bw, acc);
            }
            const float bsp = F.gmlp_b[g * 128 + t];
            LAS unsigned char* urow = UI + t * G_UP + (ct * 32 + 4 * h) * 2;
#pragma unroll
            for (int gq = 0; gq < 4; ++gq) { LAS v2u* up = (LAS v2u*)(urow + 16 * gq);
                const v2u uw = *up;
                const float y0 = bflo(uw.x) * (ng[4 * gq] * acc[4 * gq] + bsp), y1 = bfhi(uw.x) * (ng[4 * gq + 1] * acc[4 * gq + 1] + bsp);
                const float y2 = bflo(uw.y) * (ng[4 * gq + 2] * acc[4 * gq + 2] + bsp), y3 = bfhi(uw.y) * (ng[4 * gq + 3] * acc[4 * gq + 3] + bsp);
                v2u o; o.x = pk2(y0, y1); o.y = pk2(y2, y3); *up = o; }
        }
        __syncthreads();
#pragma unroll
        for (int i = 0; i < 4; ++i) { const int p = tid + 512 * i, row = p >> 4, c16 = p & 15;
            *(GAS v4u*)(F.HA + (size_t)(t0 + row) * D + c0 + c16 * 8) = *(const LAS v4u*)(UI + row * G_UP + c16 * 16); }
        __syncthreads();
    }
#undef G_LOAD
}
DI void p2_phase(Frame& F) {
    constexpr int N_M1 = NHEAD * NCHUNK;
#pragma unroll 1
    for (int it = (int)blockIdx.x; it < N_M1; it += F.G) m1_item(F, it / NCHUNK, it % NCHUNK);
    { const int per = (8 * (M / CH) + F.G - 1) / F.G;
      const int first = (int)blockIdx.x * per;
      if (first < 8 * (M / CH)) { const int g = first / (M / CH), n0 = first % (M / CH); int nch = per; if (n0 + nch > M / CH) nch = M / CH - n0; gmlp_block(F, g, n0, nch); } }
}
DI void p3_phase(Frame& F) {
    LAS float* TAB = (LAS float*)F.lds;
    const int lane = F.lane;
    if (F.wave < NHEAD) {
        const int hh = F.wave; const float* sp = F.SUMM + (size_t)(hh * NCHUNK + 2 * lane) * 2;
        const float A0 = sp[0], B0 = sp[1], A1 = sp[2], B1 = sp[3];
        float ca = A0 + A1, cb = fmaxf(B0 + A1, B1);
        const float pa = ca, pb = cb;
#pragma unroll
        for (int o = 1; o < 64; o <<= 1) { const float ta = __shfl_up(ca, o), tb = __shfl_up(cb, o); if (lane >= o) { cb = fmaxf(tb + ca, cb); ca = ta + ca; } }
        (void)pa; (void)pb;
        float ea = __shfl_up(ca, 1), eb = __shfl_up(cb, 1);
        float m0 = (lane == 0) ? 0.f : fmaxf(ea, eb);
        const float m1 = fmaxf(m0 + A0, B0), m2 = fmaxf(m1 + A1, B1);
        TAB[(hh * NCHUNK + 2 * lane) * 2] = __expf(A0 + m0 - m1); TAB[(hh * NCHUNK + 2 * lane) * 2 + 1] = __expf(B0 - m1);
        TAB[(hh * NCHUNK + 2 * lane + 1) * 2] = __expf(A1 + m1 - m2); TAB[(hh * NCHUNK + 2 * lane + 1) * 2 + 1] = __expf(B1 - m2);
        if (blockIdx.x == 0) { F.MTAB[hh * NCHUNK + 2 * lane] = m0; F.MTAB[hh * NCHUNK + 2 * lane + 1] = m1; }
    }
    __syncthreads();
    const int NT = F.G * NWAVES * 64, gt = (int)blockIdx.x * (NWAVES * 64) + F.tid;
    if (gt < D) { float b = 0.f;
#pragma unroll 8
        for (int k = 0; k < D / 64; ++k) b += F.BQP[(size_t)k * D + gt];
        F.BIASQ[gt] = b; }
    for (int p = gt; p < NHEAD * (DH * DH / 2); p += NT) {
        const int hh = p / (DH * DH / 2), q = p % (DH * DH / 2);
        GAS unsigned* sp = (GAS unsigned*)(F.STATE + (size_t)hh * NCHUNK * (DH * DH)) + q;
        float s0 = 0.f, s1 = 0.f;
#pragma unroll 1
        for (int k0 = 0; k0 < NCHUNK; k0 += 16) {
            unsigned ld[16];
#pragma unroll
            for (int k = 0; k < 16; ++k) ld[k] = sp[(size_t)(k0 + k) * (DH * DH / 2)];
#pragma unroll
            for (int k = 0; k < 16; ++k) {
                sp[(size_t)(k0 + k) * (DH * DH / 2)] = pk2(s0, s1);
                const float dec = TAB[(hh * NCHUNK + k0 + k) * 2], wb = TAB[(hh * NCHUNK + k0 + k) * 2 + 1];
                s0 = dec * s0 + wb * bflo(ld[k]); s1 = dec * s1 + wb * bfhi(ld[k]);
            }
        }
    }
    for (int p = gt; p < NHEAD * DH; p += NT) {
        const int hh = p / DH, d = p % DH; float* np = F.NST + (size_t)hh * NCHUNK * DH + d; float s = 0.f;
#pragma unroll 8
        for (int k = 0; k < NCHUNK; ++k) { const float ld = np[(size_t)k * DH]; np[(size_t)k * DH] = s; s = TAB[(hh * NCHUNK + k) * 2] * s + TAB[(hh * NCHUNK + k) * 2 + 1] * ld; }
    }
}
constexpr int M3_QI = 8192, M3_R2 = 75776, M3_QP = 528, M3_CP = 272, M3_VP = 264;
static_assert(M3_R2 + 256 * M3_CP <= LDSCTL_OFF, "P4 LDS map");
DI void m3_item(Frame& F, int hh, int kc) {
    LAS float* GS = (LAS float*)F.lds; LAS float* MX = GS + 128; LAS float* BT = GS + 256; LAS float* NK = GS + 384; LAS float* XCH = GS + 640;
    LAS unsigned char* QI = F.lds + M3_QI; LAS unsigned char* R2 = F.lds + M3_R2;
    int tid = F.tid; asm volatile("" : "+v"(tid));
    const int t0 = kc * CH, lane = F.lane, item = hh * NCHUNK + kc;
    const float mk = F.MTAB[item];
    const bf16* cbase = F.STATE + (size_t)item * (DH * DH);
    const bf16* kbase = F.KC + (size_t)t0 * 1024 + hh * DH;
    const bf16* qbase = F.QC + (size_t)t0 * 1024 + hh * DH;
    const bf16* vbase = F.VT + (size_t)(hh * DH) * M + t0;
    {
        v4u tk[8], tq[8];
#pragma unroll
        for (int i = 0; i < 8; ++i) { const int p = tid + 512 * i; tk[i] = *(const GAS v4u*)(kbase + (size_t)(p >> 5) * 1024 + (p & 31) * 8); tq[i] = *(const GAS v4u*)(qbase + (size_t)(p >> 5) * 1024 + (p & 31) * 8); }
        if (F.wave == 0) {
            const float* gp = F.GATES + (size_t)(t0 + 2 * lane) * 8;
            const float i0 = gp[hh], lf0 = gp[4 + hh], i1 = gp[8 + hh], lf1 = gp[12 + hh];
            const float p = lf0 + lf1; float inc = p;
#pragma unroll
            for (int o = 1; o < 64; o <<= 1) { const float t = __shfl_up(inc, o); if (lane >= o) inc += t; }
            const float ex = inc - p, b0 = ex + lf0, b1 = ex + p;
            const float g0 = i0 - b0, g1 = i1 - b1;
            float cm = fmaxf(g0, g1);
#pragma unroll
            for (int o = 1; o < 64; o <<= 1) { const float t = __shfl_up(cm, o); if (lane >= o) cm = fmaxf(cm, t); }
            float pm = __shfl_up(cm, 1); if (lane == 0) pm = -INFINITY;
            const float M0 = fmaxf(mk, fmaxf(pm, g0)), M1 = fmaxf(M0, g1);
            GS[2 * lane] = g0; GS[2 * lane + 1] = g1; MX[2 * lane] = M0; MX[2 * lane + 1] = M1; BT[2 * lane] = b0; BT[2 * lane + 1] = b1;
        }
        if (tid < 256) NK[tid] = F.NST[(size_t)item * DH + tid];
#pragma unroll
        for (int i = 0; i < 8; ++i) { const int p = tid + 512 * i; *(LAS v4u*)(R2 + (p >> 5) * M3_QP + (p & 31) * 16) = tk[i]; *(LAS v4u*)(QI + (p >> 5) * M3_QP + (p & 31) * 16) = tq[i]; }
    }
    __syncthreads();
    const int r = lane & 31, h = lane >> 5, tt = F.wave & 3, eh = F.wave >> 2;
    const int tl = tt * 32 + r, t = t0 + tl;
    const float Mt = MX[tl], winter = __expf(mk - Mt);
    const LAS unsigned char* qrow = QI + tl * M3_QP + 16 * h;
    const LAS float* GSh = GS + 4 * h; int tlo = tl - 4 * h; asm volatile("" : "+v"(tlo));
    bf16x8 xs[4][2]; float den = 0.f;
#pragma unroll
    for (int st = 0; st < 4; ++st) {
        if (st <= tt) {
            f32x16 accS = zero16();
            const LAS unsigned char* krow = R2 + (st * 32 + r) * M3_QP + 16 * h;
#pragma unroll 4
            for (int ks = 0; ks < 16; ++ks) { const bf16x8 kf = *(const LAS bf16x8*)(krow + 32 * ks); const bf16x8 qf = *(const LAS bf16x8*)(qrow + 32 * ks); accS = MFMA32(kf, qf, accS); }
            float xv[16];
#pragma unroll
            for (int reg = 0; reg < 16; ++reg) { const int sc = st * 32 + (reg & 3) + 8 * (reg >> 2); float v = accS[reg] * __expf(GSh[sc] - Mt); if (sc > tlo) v = 0.f; xv[reg] = v; den += v; }
#pragma unroll
            for (int k2 = 0; k2 < 2; ++k2) { v4u xw; xw.x = pk2(xv[8 * k2], xv[8 * k2 + 1]); xw.y = pk2(xv[8 * k2 + 2], xv[8 * k2 + 3]); xw.z = pk2(xv[8 * k2 + 4], xv[8 * k2 + 5]); xw.w = pk2(xv[8 * k2 + 6], xv[8 * k2 + 7]);
                xs[st][k2] = __builtin_bit_cast(bf16x8, xw); }
        } else { xs[st][0] = (bf16x8){0, 0, 0, 0, 0, 0, 0, 0}; xs[st][1] = xs[st][0]; }
        asm volatile("" ::: "memory");
    }
    f32x16 accH[4];
#pragma unroll
    for (int i = 0; i < 4; ++i) accH[i] = zero16();
    float qn = 0.f;
#pragma unroll 1
    for (int hf = 0; hf < 2; ++hf) {
        v4u tc[8];
#pragma unroll
        for (int i = 0; i < 8; ++i) { const int p = tid + 512 * i; tc[i] = *(const GAS v4u*)(cbase + (size_t)(p >> 4) * DH + hf * 128 + (p & 15) * 8); }
        __syncthreads();
#pragma unroll
        for (int i = 0; i < 8; ++i) { const int p = tid + 512 * i; *(LAS v4u*)(R2 + (p >> 4) * M3_CP + (p & 15) * 16) = tc[i]; }
        __syncthreads();
        const LAS unsigned char* crow0 = R2 + (eh * 128 + r) * M3_CP + 16 * h;
#pragma unroll 2
        for (int ks = 0; ks < 8; ++ks) {
            const int kg = hf * 8 + ks;
            const v4u qw = *(const LAS v4u*)(qrow + 32 * kg);
            float qv[8] = {bflo(qw.x), bfhi(qw.x), bflo(qw.y), bfhi(qw.y), bflo(qw.z), bfhi(qw.z), bflo(qw.w), bfhi(qw.w)};
            const f32x4 na = *(const LAS f32x4*)(NK + kg * 16 + 8 * h), nb = *(const LAS f32x4*)(NK + kg * 16 + 8 * h + 4);
            qn += (qv[0] * na.x + qv[1] * na.y) + (qv[2] * na.z + qv[3] * na.w) + (qv[4] * nb.x + qv[5] * nb.y) + (qv[6] * nb.z + qv[7] * nb.w);
            v4u q2; q2.x = pk2(qv[0] * winter, qv[1] * winter); q2.y = pk2(qv[2] * winter, qv[3] * winter); q2.z = pk2(qv[4] * winter, qv[5] * winter); q2.w = pk2(qv[6] * winter, qv[7] * winter);
            const bf16x8 q2f = __builtin_bit_cast(bf16x8, q2);
#pragma unroll
            for (int et = 0; et < 4; ++et) { const bf16x8 cf = *(const LAS bf16x8*)(crow0 + et * 32 * M3_CP + 32 * ks); accH[et] = MFMA32(cf, q2f, accH[et]); }
        }
    }
    qn += __shfl_xor(qn, 32);
    {
        v4u tv[8];
#pragma unroll
        for (int i = 0; i < 8; ++i) { const int p = tid + 512 * i; tv[i] = *(const GAS v4u*)(vbase + (size_t)(p >> 4) * M + (p & 15) * 8); }
        __syncthreads();
#pragma unroll
        for (int i = 0; i < 8; ++i) { const int p = tid + 512 * i; LAS unsigned char* d = R2 + (p >> 4) * M3_VP + (p & 15) * 16;
            *(LAS v2u*)d = (v2u){tv[i].x, tv[i].y}; *(LAS v2u*)(d + 8) = (v2u){tv[i].z, tv[i].w}; }
    }
    __syncthreads();
    const LAS unsigned char* vrow0 = R2 + (eh * 128 + r) * M3_VP + 8 * h;
#pragma unroll
    for (int st = 0; st < 4; ++st) if (st <= tt) {
#pragma unroll
        for (int k2 = 0; k2 < 2; ++k2)
#pragma unroll
            for (int et = 0; et < 4; ++et) {
                const LAS unsigned char* vp = vrow0 + et * 32 * M3_VP + (st * 32 + 16 * k2) * 2;
                const v2u lo = *(const LAS v2u*)vp, hi = *(const LAS v2u*)(vp + 16);
                v4u vw; vw.x = lo.x; vw.y = lo.y; vw.z = hi.x; vw.w = hi.y;
                accH[et] = MFMA32(__builtin_bit_cast(bf16x8, vw), xs[st][k2], accH[et]);
                asm volatile("" ::: "memory");
            }
    }
    v4u to[8];
    { const bf16* obase = F.PROJ + (size_t)t0 * NPROJ + C_OM + hh * DH;
#pragma unroll
      for (int i = 0; i < 8; ++i) { const int p = tid + 512 * i; to[i] = *(const GAS v4u*)(obase + (size_t)(p >> 5) * NPROJ + (p & 31) * 8); } }
    den += __shfl_xor(den, 32);
    den += winter * qn;
    const float dnm = fmaxf(fabsf(den), __expf(-(BT[tl] + Mt))), inv = 1.0f / dnm;
    float ss = 0.f;
#pragma unroll
    for (int et = 0; et < 4; ++et)
#pragma unroll
        for (int reg = 0; reg < 16; ++reg) { accH[et][reg] *= inv; ss += accH[et][reg] * accH[et][reg]; }
    ss += __shfl_xor(ss, 32);
    if (h == 0) XCH[eh * 128 + tl] = ss;
#pragma unroll
    for (int i = 0; i < 8; ++i) { const int p = tid + 512 * i; *(LAS v4u*)(QI + (p >> 5) * M3_QP + (p & 31) * 16) = to[i]; }
    __syncthreads();
    const float rstd = 1.0f / sqrtf((XCH[tl] + XCH[128 + tl]) * (1.0f / DH) + EPS);
    LAS unsigned char* orow = QI + tl * M3_QP + (eh * 128 + 4 * h) * 2;
    const float* ngp = F.mlstm_norm_g + hh * DH + eh * 128;
#pragma unroll
    for (int et = 0; et < 4; ++et)
#pragma unroll
        for (int gq = 0; gq < 4; ++gq) { const int el = et * 32 + 8 * gq + 4 * h; LAS v2u* op = (LAS v2u*)(orow + (et * 32 + 8 * gq) * 2);
            const v2u ow = *op; const f32x4 gn = *(const GAS f32x4*)(ngp + el);
            const float y0 = accH[et][4 * gq] * rstd * gn.x * sigmoid_f(bflo(ow.x)), y1 = accH[et][4 * gq + 1] * rstd * gn.y * sigmoid_f(bfhi(ow.x));
            const float y2 = accH[et][4 * gq + 2] * rstd * gn.z * sigmoid_f(bflo(ow.y)), y3 = accH[et][4 * gq + 3] * rstd * gn.w * sigmoid_f(bfhi(ow.y));
            v2u o; o.x = pk2(y0, y1); o.y = pk2(y2, y3); *op = o; }
    __syncthreads();
#pragma unroll
    for (int i = 0; i < 8; ++i) { const int p = tid + 512 * i, row = p >> 5, c16 = p & 31;
        *(GAS v4u*)(F.HA + (size_t)(t0 + row) * D + 1024 + hh * DH + c16 * 8) = *(const LAS v4u*)(QI + row * M3_QP + c16 * 16); }
    __syncthreads();
}
DI void p4_phase(Frame& F) {
    for (int it = (int)blockIdx.x; it < NHEAD * NCHUNK; it += F.G) m3_item(F, it / NCHUNK, it % NCHUNK);
}
constexpr int KPITCH = 272, P8_TBL = 69632;
DI void topk_insert(float (&L)[16], float x) {
#pragma unroll
    for (int i = 15; i >= 1; --i) L[i] = __builtin_amdgcn_fmed3f(x, L[i - 1], L[i]);
    L[0] = fmaxf(L[0], x);
}
DI void p8_phase(Frame& F) {
    LAS unsigned char* KIMG = F.lds; LAS unsigned char* TBL = F.lds + P8_TBL + F.wave * 1024;
    const int lane = F.lane, tid = F.tid, r = lane & 31, h = lane >> 5;
#pragma unroll 4
    for (int i = 0; i < 16; ++i) { const int idx = tid * 4 + 2048 * i, side = idx >> 14, rem = idx & 16383, row = rem >> 7, col = rem & 127;
        const f32x4 a = *(const GAS f32x4*)((side ? F.keys2 : F.keys1) + rem);
        v2u o; o.x = pk2(a.x, a.y); o.y = pk2(a.z, a.w); *(LAS v2u*)(KIMG + (side * 128 + row) * KPITCH + col * 2) = o; }
    __syncthreads();
    for (int it = (int)blockIdx.x; it < (M / 256) * PH; it += F.G) {
        const int tile = it / PH, hd = it % PH;
        const int t = tile * 256 + F.wave * 32 + r;
        float L1[16], L2[16];
#pragma unroll 1
        for (int side = 0; side < 2; ++side) {
            f32x16 acc[4];
#pragma unroll
            for (int kt = 0; kt < 4; ++kt) acc[kt] = zero16();
            const bf16* qp = F.QB + (size_t)t * D + hd * 256 + side * 128 + 8 * h;
#pragma unroll
            for (int ks = 0; ks < 8; ++ks) {
                const bf16x8 qf = *(const GAS bf16x8*)(qp + ks * 16);
#pragma unroll
                for (int kt = 0; kt < 4; ++kt) { const bf16x8 kf = *(const LAS bf16x8*)(KIMG + (side * 128 + kt * 32 + r) * KPITCH + (ks * 16 + 8 * h) * 2); acc[kt] = MFMA32(kf, qf, acc[kt]); }
            }
            float L[16];
#pragma unroll
            for (int i = 0; i < 16; ++i) L[i] = -3.0e38f;
#pragma unroll
            for (int kt = 0; kt < 4; ++kt)
#pragma unroll
                for (int reg = 0; reg < 16; ++reg) { const unsigned key = (unsigned)(kt * 32 + crow(reg, h)); const float sv = acc[kt][reg];
                    topk_insert(L, __uint_as_float((__float_as_uint(sv) & ~127u) | key)); }
            float P[16];
#pragma unroll
            for (int i = 0; i < 16; ++i) P[i] = __shfl_xor(L[i], 32);
#pragma unroll
            for (int i = 0; i < 16; ++i) topk_insert(L, P[i]);
            if (side == 0) {
#pragma unroll
                for (int i = 0; i < 16; ++i) L1[i] = L[i];
            } else {
#pragma unroll
                for (int i = 0; i < 16; ++i) L2[i] = L[i];
            }
        }
        if (h == 0) {
#pragma unroll
            for (int w = 0; w < 4; ++w) {
                const unsigned a = (__builtin_bit_cast(unsigned, L1[4 * w]) & 127u) | ((__builtin_bit_cast(unsigned, L1[4 * w + 1]) & 127u) << 8) | ((__builtin_bit_cast(unsigned, L1[4 * w + 2]) & 127u) << 16) | ((__builtin_bit_cast(unsigned, L1[4 * w + 3]) & 127u) << 24);
                const unsigned b = (__builtin_bit_cast(unsigned, L2[4 * w]) & 127u) | ((__builtin_bit_cast(unsigned, L2[4 * w + 1]) & 127u) << 8) | ((__builtin_bit_cast(unsigned, L2[4 * w + 2]) & 127u) << 16) | ((__builtin_bit_cast(unsigned, L2[4 * w + 3]) & 127u) << 24);
                *(LAS unsigned*)(TBL + r * 32 + 4 * w) = a; *(LAS unsigned*)(TBL + r * 32 + 16 + 4 * w) = b;
            }
        }
        float T[16];
#pragma unroll
        for (int i = 0; i < 16; ++i) T[i] = -3.0e38f;
#pragma unroll
        for (int i = 0; i < 16; ++i) {
            const float v1 = __builtin_bit_cast(float, __builtin_bit_cast(unsigned, L1[i]) & ~127u);
#pragma unroll
            for (int j = 0; j < 16; ++j) if ((i + 1) * (j + 1) <= 16) {
                const float v2 = __builtin_bit_cast(float, __builtin_bit_cast(unsigned, L2[j]) & ~127u);
                topk_insert(T, __builtin_bit_cast(float, (__builtin_bit_cast(unsigned, v1 + v2) & ~255u) | (unsigned)(i * 16 + j)));
            }
        }
        LDS_WAIT(); asm volatile("" ::: "memory");
        float ev[16], esum = 0.f;
        const float mx = __builtin_bit_cast(float, __builtin_bit_cast(unsigned, T[0]) & ~255u);
#pragma unroll
        for (int i = 0; i < 16; ++i) { ev[i] = __expf(__builtin_bit_cast(float, __builtin_bit_cast(unsigned, T[i]) & ~255u) - mx); esum += ev[i]; }
        const float einv = 1.0f / esum;
        int eid[8]; float gt[8];
#pragma unroll
        for (int i = 0; i < 8; ++i) { const float tv = h ? T[8 + i] : T[i]; const float e = h ? ev[8 + i] : ev[i];
            const unsigned p = __builtin_bit_cast(unsigned, tv) & 255u;
            const unsigned i1 = *(const LAS unsigned char*)(TBL + r * 32 + (p >> 4)), i2 = *(const LAS unsigned char*)(TBL + r * 32 + 16 + (p & 15u));
            eid[i] = (int)(i1 * 128u + i2); gt[i] = e * einv; }
        int* ip = F.IDX + (size_t)t * NSEL + hd * 16 + 8 * h; float* gp = F.PG + (size_t)t * NSEL + hd * 16 + 8 * h;
        *(GAS v4u*)ip = (v4u){(unsigned)eid[0], (unsigned)eid[1], (unsigned)eid[2], (unsigned)eid[3]}; *(GAS v4u*)(ip + 4) = (v4u){(unsigned)eid[4], (unsigned)eid[5], (unsigned)eid[6], (unsigned)eid[7]};
        *(GAS f32x4*)gp = (f32x4){gt[0], gt[1], gt[2], gt[3]}; *(GAS f32x4*)(gp + 4) = (f32x4){gt[4], gt[5], gt[6], gt[7]};
        LDS_WAIT(); asm volatile("" ::: "memory");
    }
}
constexpr int P9_IDX = 131072, P9_SH = 147456, P9_CORR = 147712, P9_GF = 32768, P9_FG = 40960, P9_SSQ = 49152, P9_CQ = 65536, P9_CT = 81920, P9_CSQ = 82176, NSLICE = 16, SLICE_B = 128;
#ifndef NSLICE_A
#define NSLICE_A NSLICE
#endif
#ifndef NSLICE_C
#define NSLICE_C NSLICE
#endif
template <int N, int MASK> DI void red_step_i(int (&v)[8], int lane) {
#pragma unroll
    for (int i = 0; i < N / 2; ++i) { const bool up = (lane & MASK) != 0; const int keep = up ? v[i + N / 2] : v[i], send = up ? v[i] : v[i + N / 2]; v[i] = keep + __shfl_xor(send, MASK); }
}
template <int N, int MASK> DI void red_step_f(float (&v)[16], int lane) {
#pragma unroll
    for (int i = 0; i < N / 2; ++i) { const bool up = (lane & MASK) != 0; const float keep = up ? v[i + N / 2] : v[i], send = up ? v[i] : v[i + N / 2]; v[i] = keep + __shfl_xor(send, MASK); }
}
typedef _Float16 h2v __attribute__((ext_vector_type(2)));
DI void acc4(float& o0, float& o1, float& o2, float& o3, unsigned u, float c) {
    const h2v p = __builtin_bit_cast(h2v, __builtin_amdgcn_perm(u, 0x64646464u, 0x01050004u));
    const h2v q = __builtin_bit_cast(h2v, __builtin_amdgcn_perm(u, 0x64646464u, 0x01070006u));
    o0 = __builtin_fmaf((float)p.x, c, o0); o1 = __builtin_fmaf((float)p.y, c, o1); o2 = __builtin_fmaf((float)q.x, c, o2); o3 = __builtin_fmaf((float)q.y, c, o3);
}
template <int N> DI void red32_f(float (&v)[16]) {
#pragma unroll
    for (int i = 0; i < N / 2; ++i) { const auto rr = __builtin_amdgcn_permlane32_swap(__float_as_uint(v[i]), __float_as_uint(v[i + N / 2]), false, false); v[i] = __uint_as_float(rr[0]) + __uint_as_float(rr[1]); }
}
template <int N> DI void red16_f(float (&v)[16]) {
#pragma unroll
    for (int i = 0; i < N / 2; ++i) { const auto rr = __builtin_amdgcn_permlane16_swap(__float_as_uint(v[i]), __float_as_uint(v[i + N / 2]), false, false); v[i] = __uint_as_float(rr[0]) + __uint_as_float(rr[1]); }
}
template <int N> DI void red8_f(float (&v)[16], int lane) {
#pragma unroll
    for (int i = 0; i < N / 2; ++i) { const bool up = (lane & 8) != 0; const float keep = up ? v[i + N / 2] : v[i], send = up ? v[i] : v[i + N / 2];
        v[i] = keep + __builtin_bit_cast(float, __builtin_amdgcn_mov_dpp(__builtin_bit_cast(int, send), 0x128, 0xf, 0xf, true)); }
}
template <int N> DI void redi32(int (&v)[16]) {
#pragma unroll
    for (int i = 0; i < N / 2; ++i) { const auto rr = __builtin_amdgcn_permlane32_swap((unsigned)v[i], (unsigned)v[i + N / 2], false, false); v[i] = (int)(rr[0] + rr[1]); }
}
template <int N> DI void redi16(int (&v)[16]) {
#pragma unroll
    for (int i = 0; i < N / 2; ++i) { const auto rr = __builtin_amdgcn_permlane16_swap((unsigned)v[i], (unsigned)v[i + N / 2], false, false); v[i] = (int)(rr[0] + rr[1]); }
}
template <int N> DI void redi8(int (&v)[16], int lane) {
#pragma unroll
    for (int i = 0; i < N / 2; ++i) { const bool up = (lane & 8) != 0; const int keep = up ? v[i + N / 2] : v[i], send = up ? v[i] : v[i + N / 2]; v[i] = keep + __builtin_amdgcn_mov_dpp(send, 0x128, 0xf, 0xf, true); }
}
DI void p9v2_phase(Frame& F) {
    LAS unsigned char* HQ = F.lds; LAS float* A2 = (LAS float*)(F.lds + P9_IDX); LAS float* B2 = (LAS float*)(F.lds + P9_IDX + 8192);
    LAS unsigned short* IDX16 = (LAS unsigned short*)(F.lds + P9_IDX); LAS float* SH = (LAS float*)(F.lds + P9_SH); LAS float* CORR = (LAS float*)(F.lds + P9_CORR);
    LAS float* GF = (LAS float*)(F.lds + P9_GF); LAS float* FG = (LAS float*)(F.lds + P9_FG);
    const int lane = F.lane, tid = F.tid, c8 = lane & 7, g = lane >> 3;
#pragma unroll 1
    for (int tb = (int)blockIdx.x * 64; tb < M; tb += F.G * 64) {
#pragma unroll
        for (int i = 0; i < 4; ++i) { const int c = tid + 512 * i; A2[c] = F.norm_ffn_g[c] * (1.0f + F.MODF[MOD_SCF + c]); B2[c] = F.MODF[MOD_SHF + c]; }
        __syncthreads();
#pragma unroll 1
        for (int j = 0; j < 8; ++j) {
            const int tl = F.wave * 8 + j, t = tb + tl;
            float hv[32]; float ss = 0.f;
            const bf16* xr = F.X1B + (size_t)t * D + 16 * lane;
#pragma unroll
            for (int jj = 0; jj < 2; ++jj)
#pragma unroll
                for (int q = 0; q < 2; ++q) { const v4u a = *(const GAS v4u*)(xr + 1024 * jj + 8 * q); const int o = 16 * jj + 8 * q;
                    hv[o] = bflo(a.x); hv[o + 1] = bfhi(a.x); hv[o + 2] = bflo(a.y); hv[o + 3] = bfhi(a.y); hv[o + 4] = bflo(a.z); hv[o + 5] = bfhi(a.z); hv[o + 6] = bflo(a.w); hv[o + 7] = bfhi(a.w); }
#pragma unroll
            for (int i = 0; i < 32; ++i) ss += hv[i] * hv[i];
            const float rstd = 1.0f / sqrtf(wave_sum(ss) * (1.0f / D) + EPS);
            float am = 0.f;
#pragma unroll
            for (int jj = 0; jj < 2; ++jj)
#pragma unroll
                for (int q = 0; q < 4; ++q) { const f32x4 a = *(const LAS f32x4*)(A2 + 1024 * jj + 16 * lane + 4 * q), b = *(const LAS f32x4*)(B2 + 1024 * jj + 16 * lane + 4 * q);
                    const int o = 16 * jj + 4 * q;
                    hv[o] = hv[o] * rstd * a.x + b.x; hv[o + 1] = hv[o + 1] * rstd * a.y + b.y; hv[o + 2] = hv[o + 2] * rstd * a.z + b.z; hv[o + 3] = hv[o + 3] * rstd * a.w + b.w;
                    am = fmaxf(am, fmaxf(fmaxf(fabsf(hv[o]), fabsf(hv[o + 1])), fmaxf(fabsf(hv[o + 2]), fabsf(hv[o + 3])))); }
            am = fmaxf(wave_max(am), 1e-30f); const float inv = 127.0f / am;
            if (lane == 0) SH[tl] = am * (1.0f / 127.0f);
#pragma unroll
            for (int jj = 0; jj < 2; ++jj) { v4u o;
#pragma unroll
                for (int q = 0; q < 4; ++q) { const int b = 16 * jj + 4 * q;
                    const int q0 = (int)__builtin_rintf(hv[b] * inv), q1 = (int)__builtin_rintf(hv[b + 1] * inv), q2 = (int)__builtin_rintf(hv[b + 2] * inv), q3 = (int)__builtin_rintf(hv[b + 3] * inv);
                    o[q] = (unsigned)(q0 & 255) | ((unsigned)(q1 & 255) << 8) | ((unsigned)(q2 & 255) << 16) | ((unsigned)(q3 & 255) << 24); }
                *(LAS v4u*)(HQ + tl * 2048 + 1024 * jj + 16 * lane) = o; }
        }
        __syncthreads();
#pragma unroll
        for (int i = 0; i < 16; ++i) { const int q = tid + 512 * i, k = q & 127; IDX16[(q & ~127) + (k & 64) + 8 * (k & 7) + ((k >> 3) & 7)] = (unsigned short)F.IDX[(size_t)tb * NSEL + q]; }
        __syncthreads();
        int P[8][2];
#pragma unroll
        for (int j = 0; j < 8; ++j) { P[j][0] = 0; P[j][1] = 0; }
#pragma unroll 1
        for (int s = 0; s < NSLICE_A; ++s) {
            if (((s ^ (F.wave >> 2)) & 1) != 0) __builtin_amdgcn_s_setprio(1); else __builtin_amdgcn_s_setprio(0);
            const unsigned char* eb = F.ED + s * SLICE_B;
            const unsigned lo = (unsigned)(c8 * 16);
            v4u wA[8], wB[8];
#define P9A_LOAD(W, J, H) do { _Pragma("unroll") for (int i = 0; i < 8; ++i) { const unsigned e = IDX16[(F.wave * 8 + (J)) * 128 + 64 * (H) + 8 * g + i]; W[i] = *(const GAS v4u*)(eb + (e * 2048u + lo)); } } while (0)
#define P9A_COMP(W, J, H) do { const v4u hq = *(const LAS v4u*)(HQ + (F.wave * 8 + (J)) * 2048 + s * SLICE_B + c8 * 16); int a[8]; \
                _Pragma("unroll") for (int i = 0; i < 8; ++i) { int d = 0; const v4u ww = W[i]; \
                    d = __builtin_amdgcn_sdot4((int)hq.x, (int)ww.x, d, false); d = __builtin_amdgcn_sdot4((int)hq.y, (int)ww.y, d, false); d = __builtin_amdgcn_sdot4((int)hq.z, (int)ww.z, d, false); d = __builtin_amdgcn_sdot4((int)hq.w, (int)ww.w, d, false); a[i] = d; } \
                red_step_i<8, 4>(a, lane); red_step_i<4, 2>(a, lane); red_step_i<2, 1>(a, lane); P[J][H] += a[0]; asm volatile("" ::: "memory"); } while (0)
            P9A_LOAD(wA, 0, 0);
#pragma unroll
            for (int j = 0; j < 8; ++j) {
                P9A_LOAD(wB, j, 1);
                P9A_COMP(wA, j, 0);
                if (j < 7) P9A_LOAD(wA, j + 1, 0);
                P9A_COMP(wB, j, 1);
            }
#undef P9A_LOAD
#undef P9A_COMP
        }
        __builtin_amdgcn_s_setprio(0);
        __syncthreads();
        LAS int* PI = (LAS int*)F.lds;
#pragma unroll
        for (int j = 0; j < 8; ++j) { const int tl = F.wave * 8 + j; PI[tl * 128 + 8 * c8 + g] = P[j][0]; PI[tl * 128 + 64 + 8 * c8 + g] = P[j][1]; }
#pragma unroll
        for (int i = 0; i < 4; ++i) { const int c = tid + 512 * i; GF[c] = F.MODF[MOD_GF + c]; FG[c] = F.final_g[c]; }
        LAS float* SSQL = (LAS float*)(F.lds + P9_SSQ); LAS short* CQ = (LAS short*)(F.lds + P9_CQ); LAS float* CT = (LAS float*)(F.lds + P9_CT); LAS int* CSQ = (LAS int*)(F.lds + P9_CSQ);
#pragma unroll 1
        for (int j = 0; j < 8; ++j) { const int tl = F.wave * 8 + j, t = tb + tl; const float sh = SH[tl]; float cf[2]; float am = 0.f;
#pragma unroll
            for (int h = 0; h < 2; ++h) { const int k = 64 * h + lane; const unsigned e = IDX16[tl * 128 + 64 * h + 8 * (lane & 7) + (lane >> 3)];
                const float act = (float)PI[tl * 128 + k] * (sh * F.SD[e]); cf[h] = F.PG[(size_t)t * NSEL + k] * gelu_f(act) * F.SU[e]; am = fmaxf(am, fabsf(cf[h])); }
            am = fmaxf(wave_max(am), 1e-30f); const float inv = 32767.0f / am; int qs = 0;
#pragma unroll
            for (int h = 0; h < 2; ++h) { const int q = (int)__builtin_rintf(cf[h] * inv); qs += q; CQ[tl * 128 + 64 * h + 8 * (lane & 7) + (lane >> 3)] = (short)q; }
#pragma unroll
            for (int o = 1; o < 64; o <<= 1) qs += __shfl_xor(qs, o);
            if (lane == 0) { CT[tl] = am * (1.0f / 32767.0f); CSQ[tl] = 128 * qs; }
            SSQL[tl * 64 + lane] = 0.f; }
        __syncthreads();
        const int cb = c8 * 16 + ((lane >> 5) & 1) * 8 + ((lane >> 4) & 1) * 4 + ((lane >> 3) & 1) * 2;
        typedef short s16x2 __attribute__((ext_vector_type(2)));
#pragma unroll 1
        for (int s = 0; s < NSLICE_C; ++s) {
            if (((s ^ (F.wave >> 2)) & 1) != 0) __builtin_amdgcn_s_setprio(1); else __builtin_amdgcn_s_setprio(0);
            const unsigned char* eb = F.EU + s * SLICE_B;
            const unsigned lo = (unsigned)(c8 * 16);
            v4u wA[8], wB[8]; unsigned cA[4], cB[4];
#define P9C_LOAD(W, C, TL, H) do { const LAS unsigned* ip = (const LAS unsigned*)(IDX16 + (TL) * 128 + 64 * (H) + 8 * g); const LAS unsigned* cp = (const LAS unsigned*)(CQ + (TL) * 128 + 64 * (H) + 8 * g); \
                _Pragma("unroll") for (int i2 = 0; i2 < 4; ++i2) { const unsigned ee = ip[i2]; C[i2] = cp[i2]; \
                    W[2 * i2] = *(const GAS v4u*)(eb + ((ee & 0xffffu) * 2048u + lo)); W[2 * i2 + 1] = *(const GAS v4u*)(eb + ((ee >> 16) * 2048u + lo)); } } while (0)
#define P9C_D4(O, UA, UB, CC) do { O[0] = __builtin_amdgcn_sdot2(__builtin_bit_cast(s16x2, __builtin_amdgcn_perm(UB, UA, 0x0c040c00u)), __builtin_bit_cast(s16x2, CC), O[0], false); \
                O[1] = __builtin_amdgcn_sdot2(__builtin_bit_cast(s16x2, __builtin_amdgcn_perm(UB, UA, 0x0c050c01u)), __builtin_bit_cast(s16x2, CC), O[1], false); \
                O[2] = __builtin_amdgcn_sdot2(__builtin_bit_cast(s16x2, __builtin_amdgcn_perm(UB, UA, 0x0c060c02u)), __builtin_bit_cast(s16x2, CC), O[2], false); \
                O[3] = __builtin_amdgcn_sdot2(__builtin_bit_cast(s16x2, __builtin_amdgcn_perm(UB, UA, 0x0c070c03u)), __builtin_bit_cast(s16x2, CC), O[3], false); } while (0)
#define P9C_ACC(W, C) do { _Pragma("unroll") for (int i2 = 0; i2 < 4; ++i2) { const v4u ua = W[2 * i2], ub = W[2 * i2 + 1]; const unsigned cc = C[i2]; \
                P9C_D4((o + 0), ua.x, ub.x, cc); P9C_D4((o + 4), ua.y, ub.y, cc); P9C_D4((o + 8), ua.z, ub.z, cc); P9C_D4((o + 12), ua.w, ub.w, cc); } asm volatile("" ::: "memory"); } while (0)
            P9C_LOAD(wA, cA, F.wave * 8, 0);
#pragma unroll 1
            for (int j = 0; j < 8; ++j) {
                const int tl = F.wave * 8 + j, t = tb + tl;
                int o[16];
#pragma unroll
                for (int b = 0; b < 16; ++b) o[b] = 0;
                P9C_LOAD(wB, cB, tl, 1);
                P9C_ACC(wA, cA);
                if (j < 7) P9C_LOAD(wA, cA, tl + 1, 0);
                P9C_ACC(wB, cB);
                redi32<16>(o); redi16<8>(o); redi8<4>(o, lane);
                const int col = s * SLICE_B + cb; const int csq = CSQ[tl]; const float ct = CT[tl];
                GAS unsigned* xp = (GAS unsigned*)(F.X1B + (size_t)t * D + col);
                const unsigned xw = *xp;
                const float y0 = bflo(xw) + GF[col] * ((float)(o[0] - csq) * ct), y1 = bfhi(xw) + GF[col + 1] * ((float)(o[1] - csq) * ct);
                const unsigned yw = pk2(y0, y1); const float r0 = bflo(yw), r1 = bfhi(yw);
                SSQL[tl * 64 + lane] += r0 * r0 + r1 * r1;
                *xp = yw;
            }
#undef P9C_LOAD
#undef P9C_ACC
#undef P9C_D4
        }
        __builtin_amdgcn_s_setprio(0);
#pragma unroll 1
        for (int j = 0; j < 8; ++j) {
            const int tl = F.wave * 8 + j, t = tb + tl;
            const float rstd2 = 1.0f / sqrtf(wave_sum(SSQL[tl * 64 + lane]) * (1.0f / D) + EPS);
            const GAS v2u* xrow = (const GAS v2u*)(F.X1B + (size_t)t * D) + lane; GAS f32x4* orow = (GAS f32x4*)(F.out + (size_t)t * D) + lane;
#pragma unroll
            for (int q = 0; q < 8; ++q) { const v2u w = xrow[64 * q]; const f32x4 f = *(const LAS f32x4*)(FG + 256 * q + 4 * lane);
                orow[64 * q] = (f32x4){bflo(w.x) * rstd2 * f.x, bfhi(w.x) * rstd2 * f.y, bflo(w.y) * rstd2 * f.z, bfhi(w.y) * rstd2 * f.w}; }
        }
        __syncthreads();
    }
}
struct Args { const float* in[21]; float* out; unsigned char* ws; int ph_lo, ph_hi, li, pad; };
constexpr int N_PHASES = 10;
__global__ void __launch_bounds__(NWAVES * 64, 2) mk_fwd(Args args) {
    extern __shared__ __attribute__((aligned(16))) unsigned char lds[];
    Frame F;
    F.lds = (LAS unsigned char*)lds;
    F.MISC = (volatile LAS unsigned*)(F.lds + MISC_OFF);
    F.tid = threadIdx.x; F.lane = F.tid & 63; F.wave = __builtin_amdgcn_readfirstlane(F.tid >> 6);
    F.G = gridDim.x; { const int bx = blockIdx.x; F.vcu = (F.G % 8 == 0) ? (bx % 8) * (F.G / 8) + bx / 8 : bx; }
    unsigned char* ws = args.ws;
    F.ctl = (gu32*)(ws + WS_CTL);
    F.x = args.in[0]; F.c = args.in[1]; F.ada_w = args.in[2]; F.ada_b = args.in[3]; F.norm_mix_g = args.in[4]; F.w_in = args.in[5]; F.b_gates = args.in[6];
    F.conv_w = args.in[7]; F.conv_b = args.in[8]; F.gmlp_norm_g = args.in[9]; F.gmlp_w = args.in[10]; F.gmlp_b = args.in[11]; F.mlstm_norm_g = args.in[12];
    F.w_out = args.in[13]; F.norm_ffn_g = args.in[14]; F.wq = args.in[15]; F.keys1 = args.in[16]; F.keys2 = args.in[17]; F.e_down = args.in[18]; F.e_up = args.in[19]; F.final_g = args.in[20];
    F.out = args.out;
    F.MODP = (float*)(ws + WS_MODP); F.MODF = (float*)(ws + WS_MODF); F.GATES = (float*)(ws + WS_GATES); F.SUMM = (float*)(ws + WS_SUMM); F.MTAB = (float*)(ws + WS_MTAB);
    F.NST = (float*)(ws + WS_NST); F.PG = (float*)(ws + WS_PG); F.IDX = (int*)(ws + WS_IDX);
    F.WIN = (bf16*)(ws + WS_WIN); F.WOUT = (bf16*)(ws + WS_WOUT); F.WQ = (bf16*)(ws + WS_WQ); F.HA = (bf16*)(ws + WS_HA); F.PROJ = (bf16*)(ws + WS_PROJ); F.QB = (bf16*)(ws + WS_PROJ);
    F.STATE = (bf16*)(ws + WS_STATE); F.VT = (bf16*)(ws + WS_VT); F.ED = ws + WS_ED; F.EU = ws + WS_EU; F.SD = (float*)(ws + WS_SD); F.SU = (float*)(ws + WS_SU);
    F.H1Q = ws + WS_STATE;
    F.SW = (float*)(ws + WS_SW); F.CMAXP = (float*)(ws + WS_CMAXP); F.SA = (float*)(ws + WS_SA);
    F.SSQP = (float*)(ws + WS_SSQP); F.BQP = (float*)(ws + WS_BQP); F.BIASQ = (float*)(ws + WS_BIASQ); F.X1B = (bf16*)(ws + WS_STATE);
    F.QC = (bf16*)args.out; F.KC = (bf16*)args.out + (size_t)M * 1024;
    for (int u = F.tid; u < (LDS_BYTES - LDSCTL_OFF) / 4; u += NWAVES * 64) ((LAS unsigned*)(F.lds + LDSCTL_OFF))[u] = 0u;
    __syncthreads();
    const int lo = args.ph_lo, hi = args.ph_hi;
    const bool multi = (hi - lo) > 1;
    XcdBarrier bar; bar.bar = (unsigned*)(F.ctl + CW_BAR) + args.li * XCD_BAR_WORDS; bar.x = 0; bar.st = nullptr;
    if (multi) bar = xcd_barrier_post((unsigned*)(F.ctl + CW_BAR) + args.li * XCD_BAR_WORDS, F.MISC + 8);
#ifndef PH_MASK
#define PH_MASK 0x7ff
#endif
#define IN(k) (((PH_MASK >> (k)) & 1) && lo <= (k) && (k) < hi)
#define SEAM(k) do { if (IN(k) && IN((k) + 1)) xcd_barrier(bar); } while (0)
    if (IN(0)) { p0a_phase(F); } SEAM(0);
    if (IN(1)) { p0b_phase(F); } SEAM(1);
    if (IN(2)) {
        { pg8::Gemm g{(const pg8::bf16_t*)F.H1Q, F.WIN, M, NPROJ, D / 2}; pg8::StaticOrder S; S.init(M, NPROJ, F.G, (int)blockIdx.x);
          pg8::EpiQ8 E{F.PROJ, NPROJ, 2048 / 256, F.SA, F.SW};
          pg8::gemm_phase<pg8::EpiQ8, pg8::StaticOrder, PG8_ALIGN, PG8_SP2, true>(F.lds, g, S, E); }
        {
          pg8::Gemm g{(const pg8::bf16_t*)((const unsigned char*)F.WIN + (size_t)WROW_VM * D), (const pg8::bf16_t*)F.H1Q, 1024, M, D / 2}; pg8::StaticOrder S; S.init(1024, M, F.G, (int)blockIdx.x);
          pg8::EpiQ8 E{F.VT, M, 0, F.SW + WROW_VM, F.SA};
          pg8::gemm_phase<pg8::EpiQ8, pg8::StaticOrder, PG8_ALIGN, PG8_SP2, true>(F.lds, g, S, E); }
    } SEAM(2);
    if (IN(3)) { p2_phase(F); } SEAM(3);
    if (IN(4)) { p3_phase(F); } SEAM(4);
    if (IN(5)) { p4_phase(F); } SEAM(5);
    if (IN(6)) {
        pg8::Gemm g{F.HA, F.WOUT, M, D, D}; pg8::StaticOrder S; S.init(M, D, F.G, (int)blockIdx.x);
        pg8::EpiResid2 E{F.x, F.MODF + MOD_GM, F.X1B, F.SSQP, D};
        pg8::gemm_phase<pg8::EpiResid2, pg8::StaticOrder, PG8_ALIGN, PG8_SP2>(F.lds, g, S, E);
    } SEAM(6);
    if (IN(7)) {
        pg8::Gemm g{F.X1B, F.WQ, M, D, D}; pg8::StaticOrder S; S.init(M, D, F.G, (int)blockIdx.x);
        LAS float* RSTDL = (LAS float*)(F.lds + RING_BYTES);
        { pg8::Unit u; for (int i = 0; S.next(i, u); ++i) { if (F.tid < 256) { const float* sp = F.SSQP + (size_t)(u.pm * 256 + F.tid) * 32; float ss = 0.f;
#pragma unroll
                    for (int q = 0; q < 8; ++q) { const f32x4 v = *(const GAS f32x4*)(sp + 4 * q); ss += (v.x + v.y) + (v.z + v.w); }
                    RSTDL[(u.pm & 1) * 256 + F.tid] = 1.0f / sqrtf(ss * (1.0f / D) + EPS); } } }
        __syncthreads();
        pg8::EpiQ E{F.QB, D, F.BIASQ, RSTDL};
        pg8::gemm_phase<pg8::EpiQ, pg8::StaticOrder, PG8_ALIGN, PG8_SP2>(F.lds, g, S, E);
    } SEAM(7);
#ifndef P8_ALT
#define P8_ALT 0
#endif
    if (IN(8)) { p8_phase(F); } SEAM(8);
#ifndef P9_V2
#define P9_V2 1
#endif
    if (IN(9)) { p9v2_phase(F); }
#undef IN
#undef SEAM
}

#ifndef MK_N_LAUNCHES
#define MK_N_LAUNCHES 1
#endif
extern "C" void kernel_launch(void* const* d_in, const int* in_sizes, int n_in, void* d_out, int out_size, void* d_ws, size_t ws_size, hipStream_t stream) {
    static int grid = 0;
    if (grid == 0) {
        if (n_in != 21 || in_sizes[0] != M * D || out_size != M * D || ws_size < WS_END) { fprintf(stderr, "kernel_launch: unexpected shapes (n_in %d, in0 %d, out %d, ws %zu); nothing launched\n", n_in, n_in > 0 ? in_sizes[0] : -1, out_size, ws_size); grid = -1; return; }
        int dev = 0, cus = 0, per_cu = 0;
        if (hipGetDevice(&dev) != hipSuccess || hipDeviceGetAttribute(&cus, hipDeviceAttributeMultiprocessorCount, dev) != hipSuccess) { grid = -1; return; }
        if (hipFuncSetAttribute((const void*)mk_fwd, hipFuncAttributeMaxDynamicSharedMemorySize, LDS_BYTES) != hipSuccess) { fprintf(stderr, "kernel_launch: hipFuncSetAttribute failed\n"); grid = -1; return; }
        if (hipOccupancyMaxActiveBlocksPerMultiprocessor(&per_cu, (const void*)mk_fwd, NWAVES * 64, LDS_BYTES) != hipSuccess || per_cu < 1) { fprintf(stderr, "kernel_launch: occupancy query says %d blocks per CU\n", per_cu); }
        (void)hipGetLastError();
        grid = cus;
    }
    if (grid < 0) return;
    (void)hipMemsetAsync((char*)d_ws + WS_CTL, 0, CTL_ZERO_BYTES, stream);
    Args a{};
    for (int i = 0; i < 21; ++i) a.in[i] = (const float*)d_in[i];
    a.out = (float*)d_out; a.ws = (unsigned char*)d_ws;
    if (MK_N_LAUNCHES == 1) { a.ph_lo = 0; a.ph_hi = N_PHASES; a.li = 0; hipLaunchKernelGGL(mk_fwd, dim3(grid), dim3(NWAVES * 64), LDS_BYTES, stream, a); }
    else for (int li = 0; li < N_PHASES; ++li) { a.ph_lo = li; a.ph_hi = li + 1; a.li = 0; hipLaunchKernelGGL(mk_fwd, dim3(grid), dim3(NWAVES * 64), LDS_BYTES, stream, a); }
}
```

```cpp
#include <hip/hip_runtime.h>
#include <cstdio>
#include <cstdint>
namespace pg8 {
#define PG8_LAS __attribute__((address_space(3)))
typedef unsigned short bf16_t;
typedef short bf16x8 __attribute__((ext_vector_type(8)));
typedef float f32x4 __attribute__((ext_vector_type(4)));
typedef unsigned u32x4 __attribute__((ext_vector_type(4)));
constexpr int BM = 256, BK = 64, HALF = 128, HTB = HALF * BK * 2  , STAGE_BYTES = 8 * HTB, NXCD = 8, WGM = 8;

__host__ __device__ __forceinline__ int lds_byte(int r, int c) { const int st = (r >> 4) * 2 + (c >> 5), rr = r & 15, cc = c & 31, ob = rr * 64 + cc * 2; return st * 1024 + (ob ^ (((ob >> 9) & 1) << 5)); }
__host__ __device__ __forceinline__ void stage_rc(int b, int& R, int& C) { const int st = b / 1024, sb = b % 1024, swz = sb ^ (((sb >> 9) & 1) << 5); R = (st >> 1) * 16 + swz / 64; C = (st & 1) * 32 + (swz % 64) / 2; }
__host__ __device__ __forceinline__ int perm32(int rho) { const int n = rho >> 4, i = rho & 15; return 8 * (i >> 2) + 4 * n + (i & 3); }

struct Unit { int pm, pn; };
struct Gemm { const bf16_t* A; const bf16_t* Bt; int M, N, K; };

struct StaticOrder {
    int nM, nN, nwg, G, c;
    __host__ __device__ void init(int M, int N, int G_, int c_) { nM = M / BM; nN = N / BM; nwg = nM * nN; G = G_; c = c_; }
    __host__ __device__ bool next(int i, Unit& u) const {
        const long L = (long)i * G + c; if (L >= nwg) return false;
        int wgid = (int)L; { const int q = nwg / NXCD, r = nwg % NXCD, xcd = wgid % NXCD, off = wgid / NXCD; wgid = (xcd < r ? xcd * (q + 1) : r * (q + 1) + (xcd - r) * q) + off; }
        const int nig = WGM * nN, gid = wgid / nig, fm = gid * WGM, gsz = (nM - fm) < WGM ? (nM - fm) : WGM;
        u.pm = fm + ((wgid % nig) % gsz); u.pn = (wgid % nig) / gsz; return true;
    }
    __device__ __forceinline__ void a_ready(const Unit&) const {}
    __device__ __forceinline__ void done(const Unit&) const {}
};

__device__ __forceinline__ unsigned cvt_pk_bf16(float lo, float hi) { unsigned r; asm volatile("v_cvt_pk_bf16_f32 %0, %1, %2" : "=v"(r) : "v"(lo), "v"(hi)); return r; }
typedef float f32x2 __attribute__((ext_vector_type(2)));
__device__ __forceinline__ f32x2 gelu_pk(f32x2 v) {
    const f32x2 av = __builtin_elementwise_abs(v), d = av * 0.2316418882f + 1.0f;
    f32x2 t; t.x = __builtin_amdgcn_rcpf(d.x); t.y = __builtin_amdgcn_rcpf(d.y);
    f32x2 q = t * 0.5307027145f + (-0.7265760135f); q = q * t + 0.7107068705f; q = q * t + (-0.142248368f); q = q * t + 0.127414796f; q = q * t;
    const f32x2 s = (v * v) * (-0.72134752044f);
    f32x2 e; e.x = __builtin_amdgcn_exp2f(s.x); e.y = __builtin_amdgcn_exp2f(s.y);
    const f32x2 m = v * (q * e), r = v - m;
    f32x2 o; o.x = v.x < 0.f ? m.x : r.x; o.y = v.y < 0.f ? m.y : r.y; return o;
}

template <int ACT  > struct EpiBf16 {
    static constexpr bool PERM = true, AFTER_DRAIN = false; static_assert(ACT == 0 || ACT == 1, "EpiBf16: ACT is 0 (none) or 1 (gelu_pk)");
    bf16_t* O; int ldc; const float* bias; int split_cols; size_t split_stride; float scale0;
    __device__ __forceinline__ void operator()(const f32x4 (&acc)[2][2][4][2], const Unit& u, int wr, int wc, int fr, int fq) const {
        const int row0 = u.pm * BM + wr * 64 + fr; int colt = u.pn * BM; bf16_t* base = O;
        float sc = 1.f; if (split_cols) { const int t = colt / split_cols; base += (size_t)t * split_stride; colt -= t * split_cols; if (t == 0) sc = scale0; }
        const int col0 = colt + wc * 32 + 8 * fq, bcol0 = u.pn * BM + wc * 32 + 8 * fq;
        f32x4 bv[2][2];
#pragma unroll
        for (int bj = 0; bj < 2; ++bj)
#pragma unroll
            for (int n = 0; n < 2; ++n) bv[bj][n] = bias ? *(const f32x4*)(bias + bcol0 + bj * HALF + 4 * n) : (f32x4){0.f, 0.f, 0.f, 0.f};
#pragma unroll
        for (int ai = 0; ai < 2; ++ai)
#pragma unroll
            for (int m = 0; m < 4; ++m) { bf16_t* rowp = base + (size_t)(row0 + ai * HALF + m * 16) * ldc + col0;
#pragma unroll
                for (int bj = 0; bj < 2; ++bj) { f32x4 v0 = acc[ai][bj][m][0] + bv[bj][0], v1 = acc[ai][bj][m][1] + bv[bj][1];
                    if (ACT == 1) { f32x2 a = gelu_pk((f32x2){v0[0], v0[1]}), b = gelu_pk((f32x2){v0[2], v0[3]}), c = gelu_pk((f32x2){v1[0], v1[1]}), d = gelu_pk((f32x2){v1[2], v1[3]});
                        v0 = (f32x4){a.x, a.y, b.x, b.y}; v1 = (f32x4){c.x, c.y, d.x, d.y}; }
                    v0 = v0 * sc; v1 = v1 * sc; u32x4 w; w.x = cvt_pk_bf16(v0[0], v0[1]); w.y = cvt_pk_bf16(v0[2], v0[3]); w.z = cvt_pk_bf16(v1[0], v1[1]); w.w = cvt_pk_bf16(v1[2], v1[3]);
                    *(u32x4*)(rowp + bj * HALF) = w; } }
    }
};

typedef int i32x4 __attribute__((ext_vector_type(4)));
template <bool I8> __device__ __forceinline__ f32x4 mma16(bf16x8 a, bf16x8 b, f32x4 c) {
    if constexpr (I8) return __builtin_bit_cast(f32x4, __builtin_amdgcn_mfma_i32_16x16x64_i8(__builtin_bit_cast(i32x4, a), __builtin_bit_cast(i32x4, b), __builtin_bit_cast(i32x4, c), 0, 0, 0));
    else return __builtin_amdgcn_mfma_f32_16x16x32_bf16(a, b, c, 0, 0, 0);
}
template <class Epi, class Sched, bool ALIGN_EPI = false, bool SP2 = false, bool I8 = false>
__device__ __forceinline__ void gemm_phase(PG8_LAS unsigned char* lds, const Gemm g, const Sched& S, const Epi& E) {
    const int tid = threadIdx.x, wid = __builtin_amdgcn_readfirstlane(tid >> 6), lane = tid & 63, wr = wid >> 2, wc = wid & 3, fr = lane & 15, fq = lane >> 4;
    const int K = g.K, nt = K / BK;
    unsigned voffA[2], voffB[2];
#pragma unroll
    for (int i = 0; i < 2; ++i) { int R, C; stage_rc(tid * 16 + i * 8192, R, C); const int Rb = Epi::PERM ? ((R & ~31) + perm32(R & 31)) : R;
        voffA[i] = (unsigned)(R * K + C) * 2u; voffB[i] = (unsigned)(Rb * K + C) * 2u; }
    const size_t kstep = (size_t)(BK * 2);
    const size_t hstep = (size_t)HALF * K * 2;
    const size_t tstep = 2 * hstep;
    const unsigned ldsw = (unsigned)wid * 1024u;
    const int aoff = lds_byte(wr * 64 + fr, fq * 8), boff = lds_byte(wc * 32 + fr, fq * 8);
#define PG8_SA(b, h) (((b) * 2 + (h)) * HTB)
#define PG8_SB(b, h) ((4 + (b) * 2 + (h)) * HTB)
#define PG8_STAGE(bufoff, gbase, voff) do { _Pragma("unroll") for (int _i = 0; _i < 2; ++_i) \
        __builtin_amdgcn_global_load_lds((const unsigned*)((const char*)(gbase) + (voff)[_i]), (PG8_LAS unsigned*)(lds + (bufoff) + ldsw + _i * 8192), 16, 0, 0); } while (0)
#define PG8_LDA(dst, b, h) do { _Pragma("unroll") for (int m = 0; m < 4; ++m) _Pragma("unroll") for (int k = 0; k < 2; ++k) dst[m][k] = *(const PG8_LAS bf16x8*)(lds + PG8_SA(b, h) + aoff + m * 2048 + k * 1024); } while (0)
#define PG8_LDB(dst, b, h) do { _Pragma("unroll") for (int n = 0; n < 2; ++n) _Pragma("unroll") for (int k = 0; k < 2; ++k) dst[n][k] = *(const PG8_LAS bf16x8*)(lds + PG8_SB(b, h) + boff + n * 2048 + k * 1024); } while (0)
#define PG8_MMA(ai, bj, At, Bt) do { __builtin_amdgcn_s_setprio(1); _Pragma("unroll") for (int m = 0; m < 4; ++m) _Pragma("unroll") for (int n = 0; n < 2; ++n) _Pragma("unroll") for (int k = 0; k < 2; ++k) \
        acc[ai][bj][m][n] = mma16<I8>(Bt[n][k], At[m][k], acc[ai][bj][m][n]); __builtin_amdgcn_s_setprio(0); } while (0)
#define PG8_WAIT_V(n) asm volatile("s_waitcnt vmcnt(" #n ")" ::: "memory")
#define PG8_WAIT_L(n) asm volatile("s_waitcnt lgkmcnt(" #n ")" ::: "memory")
#define PG8_BAR __builtin_amdgcn_s_barrier()
#define PG8_SCHED __builtin_amdgcn_sched_barrier(0)
    Unit cur, nxt; int ui = 0;
    if (!S.next(0, cur)) return;
    f32x4 acc[2][2][4][2];
#pragma unroll
    for (int a = 0; a < 2; ++a)
#pragma unroll
        for (int b = 0; b < 2; ++b)
#pragma unroll
            for (int m = 0; m < 4; ++m)
#pragma unroll
                for (int n = 0; n < 2; ++n) acc[a][b][m][n] = (f32x4){0.f, 0.f, 0.f, 0.f};
    bf16x8 At[4][2], B0[2][2], B1[2][2];
    const char* cA = (const char*)g.A + (size_t)cur.pm * tstep; const char* cB = (const char*)g.Bt + (size_t)cur.pn * tstep;
    S.a_ready(cur);
    if constexpr (SP2) {
        PG8_STAGE(PG8_SB(0, 0), cB, voffB); PG8_STAGE(PG8_SB(0, 1), cB + hstep, voffB); PG8_STAGE(PG8_SA(0, 0), cA, voffA); PG8_STAGE(PG8_SA(0, 1), cA + hstep, voffA);
        if (wr == 1) PG8_BAR;
        PG8_WAIT_V(2); PG8_BAR;
        PG8_STAGE(PG8_SB(1, 0), cB + kstep, voffB); PG8_STAGE(PG8_SA(1, 0), cA + kstep, voffA); PG8_STAGE(PG8_SB(1, 1), cB + hstep + kstep, voffB);
        PG8_WAIT_V(6); PG8_BAR;
    } else {
        PG8_STAGE(PG8_SB(0, 0), cB, voffB); PG8_STAGE(PG8_SA(0, 0), cA, voffA); PG8_STAGE(PG8_SB(0, 1), cB + hstep, voffB); PG8_STAGE(PG8_SA(0, 1), cA + hstep, voffA);
        if (wr == 1) PG8_BAR;
        PG8_WAIT_V(4); PG8_BAR;
        PG8_STAGE(PG8_SB(1, 0), cB + kstep, voffB); PG8_STAGE(PG8_SA(1, 0), cA + kstep, voffA); PG8_STAGE(PG8_SB(1, 1), cB + hstep + kstep, voffB);
        PG8_WAIT_V(6); PG8_BAR;
    }
    for (;;) {
        const bool has_next = S.next(ui + 1, nxt);
        const char* nA = has_next ? (const char*)g.A + (size_t)nxt.pm * tstep : cA; const char* nB = has_next ? (const char*)g.Bt + (size_t)nxt.pn * tstep : cB;
        for (int t = 0; t < nt; t += 2) {
            const bool last = (t == nt - 2);
            const char* a1 = cA + (size_t)(t + 1) * kstep;
            const char* a2 = last ? nA : cA + (size_t)(t + 2) * kstep; const char* b2 = last ? nB : cB + (size_t)(t + 2) * kstep;
            const char* a3 = a2 + kstep; const char* b3 = b2 + kstep;
            if (last && has_next) S.a_ready(nxt);
            if constexpr (SP2) {
            PG8_LDB(B0, 0, 0); PG8_LDB(B1, 0, 1); PG8_SCHED; PG8_LDA(At, 0, 0); PG8_STAGE(PG8_SA(1, 1), a1 + hstep, voffA);
            PG8_WAIT_V(8); PG8_WAIT_L(0); PG8_BAR; PG8_MMA(0, 0, At, B0); PG8_MMA(0, 1, At, B1); PG8_BAR; PG8_SCHED;
            PG8_LDA(At, 0, 1); PG8_STAGE(PG8_SB(0, 0), b2, voffB); PG8_STAGE(PG8_SB(0, 1), b2 + hstep, voffB); PG8_STAGE(PG8_SA(0, 0), a2, voffA);
            PG8_WAIT_V(8); PG8_WAIT_L(0); PG8_BAR; PG8_MMA(1, 0, At, B0); PG8_MMA(1, 1, At, B1); PG8_BAR; PG8_SCHED;
            PG8_LDB(B0, 1, 0); PG8_LDB(B1, 1, 1); PG8_SCHED; PG8_LDA(At, 1, 0); PG8_STAGE(PG8_SA(0, 1), a2 + hstep, voffA);
            PG8_WAIT_V(8); PG8_WAIT_L(0); PG8_BAR; PG8_MMA(0, 0, At, B0); PG8_MMA(0, 1, At, B1); PG8_BAR; PG8_SCHED;
            PG8_LDA(At, 1, 1); PG8_STAGE(PG8_SB(1, 0), b3, voffB); PG8_STAGE(PG8_SB(1, 1), b3 + hstep, voffB); PG8_STAGE(PG8_SA(1, 0), a3, voffA);
            PG8_WAIT_V(8); PG8_WAIT_L(0); PG8_BAR; PG8_MMA(1, 0, At, B0); PG8_MMA(1, 1, At, B1); PG8_BAR; PG8_SCHED;
            } else {
            PG8_LDB(B0, 0, 0); PG8_SCHED; PG8_LDA(At, 0, 0); PG8_STAGE(PG8_SA(1, 1), a1 + hstep, voffA);
            PG8_WAIT_L(8); PG8_BAR; PG8_WAIT_L(0); PG8_MMA(0, 0, At, B0); PG8_BAR; PG8_SCHED;
            PG8_LDB(B1, 0, 1); PG8_STAGE(PG8_SB(0, 0), b2, voffB);
            PG8_BAR; PG8_WAIT_L(0); PG8_MMA(0, 1, At, B1); PG8_BAR;
            PG8_LDA(At, 0, 1); PG8_STAGE(PG8_SA(0, 0), a2, voffA);
            PG8_BAR; PG8_WAIT_L(0); PG8_MMA(1, 0, At, B0); PG8_BAR; PG8_SCHED;
            PG8_STAGE(PG8_SB(0, 1), b2 + hstep, voffB);
            PG8_WAIT_V(6); PG8_BAR; PG8_MMA(1, 1, At, B1); PG8_BAR;
            PG8_LDB(B0, 1, 0); PG8_SCHED; PG8_LDA(At, 1, 0); PG8_STAGE(PG8_SA(0, 1), a2 + hstep, voffA);
            PG8_WAIT_L(8); PG8_BAR; PG8_WAIT_L(0); PG8_MMA(0, 0, At, B0); PG8_BAR; PG8_SCHED;
            PG8_LDB(B1, 1, 1); PG8_STAGE(PG8_SB(1, 0), b3, voffB);
            PG8_BAR; PG8_WAIT_L(0); PG8_MMA(0, 1, At, B1); PG8_BAR;
            PG8_LDA(At, 1, 1); PG8_STAGE(PG8_SA(1, 0), a3, voffA);
            PG8_BAR; PG8_WAIT_L(0); PG8_MMA(1, 0, At, B0); PG8_BAR; PG8_SCHED;
            PG8_STAGE(PG8_SB(1, 1), b3 + hstep, voffB);
            PG8_WAIT_V(6); PG8_BAR; PG8_MMA(1, 1, At, B1); PG8_BAR;
            }
        }
        if constexpr (ALIGN_EPI) { if (wr == 0) PG8_BAR; }
        if constexpr (!Epi::AFTER_DRAIN) { E(acc, cur, wr, wc, fr, fq); S.done(cur); }
        if (!has_next) break;
#pragma unroll
        for (int a = 0; a < 2; ++a)
#pragma unroll
            for (int b = 0; b < 2; ++b)
#pragma unroll
                for (int m = 0; m < 4; ++m)
#pragma unroll
                    for (int n = 0; n < 2; ++n) acc[a][b][m][n] = (f32x4){0.f, 0.f, 0.f, 0.f};
        cur = nxt; cA = nA; cB = nB; ++ui;
        if constexpr (ALIGN_EPI) { if (wr == 1) PG8_BAR; }
    }
    PG8_WAIT_V(0);
    if constexpr (!ALIGN_EPI) { if (wr == 0) PG8_BAR; }
    PG8_BAR;
    if constexpr (Epi::AFTER_DRAIN) { E.fused(acc, cur, wr, wc, fr, fq, lds, wid, lane); S.done(cur); }
#undef PG8_SA
#undef PG8_SB
#undef PG8_STAGE
#undef PG8_LDA
#undef PG8_LDB
#undef PG8_MMA
#undef PG8_WAIT_V
#undef PG8_WAIT_L
#undef PG8_BAR
#undef PG8_SCHED
}
}
namespace pg8 {
struct EpiProj {
    static constexpr bool PERM = true, AFTER_DRAIN = false;
    bf16_t* O; int ldc; int gelu_tiles;
    __device__ __forceinline__ void operator()(const f32x4 (&acc)[2][2][4][2], const Unit& u, int wr, int wc, int fr, int fq) const {
        const int row0 = u.pm * BM + wr * 64 + fr; const int col0 = u.pn * BM + wc * 32 + 8 * fq;
        const bool act = u.pn < gelu_tiles;
#pragma unroll
        for (int ai = 0; ai < 2; ++ai)
#pragma unroll
            for (int m = 0; m < 4; ++m) { bf16_t* rowp = O + (size_t)(row0 + ai * HALF + m * 16) * ldc + col0;
#pragma unroll
                for (int bj = 0; bj < 2; ++bj) { f32x4 v0 = acc[ai][bj][m][0], v1 = acc[ai][bj][m][1];
                    if (act) { f32x2 a = gelu_pk((f32x2){v0[0], v0[1]}), b = gelu_pk((f32x2){v0[2], v0[3]}), c = gelu_pk((f32x2){v1[0], v1[1]}), d = gelu_pk((f32x2){v1[2], v1[3]});
                        v0 = (f32x4){a.x, a.y, b.x, b.y}; v1 = (f32x4){c.x, c.y, d.x, d.y}; }
                    u32x4 w; w.x = cvt_pk_bf16(v0[0], v0[1]); w.y = cvt_pk_bf16(v0[2], v0[3]); w.z = cvt_pk_bf16(v1[0], v1[1]); w.w = cvt_pk_bf16(v1[2], v1[3]);
                    *(u32x4*)(rowp + bj * HALF) = w; } }
    }
};
struct EpiResid {
    static constexpr bool PERM = false, AFTER_DRAIN = false;
    const float* base; const float* gate; float* out; int ldc;
    __device__ __forceinline__ void operator()(const f32x4 (&acc)[2][2][4][2], const Unit& u, int wr, int wc, int fr, int fq) const {
        const int row0 = u.pm * BM + wr * 64 + fr, col0 = u.pn * BM + wc * 32 + 4 * fq;
        f32x4 gv[2][2];
#pragma unroll
        for (int bj = 0; bj < 2; ++bj)
#pragma unroll
            for (int n = 0; n < 2; ++n) gv[bj][n] = *(const f32x4*)(gate + col0 + bj * HALF + n * 16);
#pragma unroll
        for (int ai = 0; ai < 2; ++ai)
#pragma unroll
            for (int m = 0; m < 4; ++m) { const size_t off = (size_t)(row0 + ai * HALF + m * 16) * ldc + col0;
#pragma unroll
                for (int bj = 0; bj < 2; ++bj)
#pragma unroll
                    for (int n = 0; n < 2; ++n) { const f32x4 b = *(const f32x4*)(base + off + bj * HALF + n * 16); *(f32x4*)(out + off + bj * HALF + n * 16) = b + gv[bj][n] * acc[ai][bj][m][n]; } }
    }
};
struct EpiQ8 {
    static constexpr bool PERM = true, AFTER_DRAIN = false;
    bf16_t* O; int ldc; int gelu_tiles; const float* rs; const float* cs;
    __device__ __forceinline__ void operator()(const f32x4 (&acc)[2][2][4][2], const Unit& u, int wr, int wc, int fr, int fq) const {
        const int row0 = u.pm * BM + wr * 64 + fr; const int col0 = u.pn * BM + wc * 32 + 8 * fq;
        const bool act = u.pn < gelu_tiles;
        f32x4 cv[2][2];
#pragma unroll
        for (int bj = 0; bj < 2; ++bj)
#pragma unroll
            for (int n = 0; n < 2; ++n) cv[bj][n] = *(const f32x4*)(cs + col0 + bj * HALF + 4 * n);
#pragma unroll
        for (int ai = 0; ai < 2; ++ai)
#pragma unroll
            for (int m = 0; m < 4; ++m) { const int row = row0 + ai * HALF + m * 16; const float rsc = rs[row]; bf16_t* rowp = O + (size_t)row * ldc + col0;
#pragma unroll
                for (int bj = 0; bj < 2; ++bj) { const i32x4 a0 = __builtin_bit_cast(i32x4, acc[ai][bj][m][0]), a1 = __builtin_bit_cast(i32x4, acc[ai][bj][m][1]);
                    f32x4 v0 = (f32x4){(float)a0[0], (float)a0[1], (float)a0[2], (float)a0[3]} * rsc * cv[bj][0], v1 = (f32x4){(float)a1[0], (float)a1[1], (float)a1[2], (float)a1[3]} * rsc * cv[bj][1];
                    if (act) { f32x2 a = gelu_pk((f32x2){v0[0], v0[1]}), b = gelu_pk((f32x2){v0[2], v0[3]}), c = gelu_pk((f32x2){v1[0], v1[1]}), d = gelu_pk((f32x2){v1[2], v1[3]});
                        v0 = (f32x4){a.x, a.y, b.x, b.y}; v1 = (f32x4){c.x, c.y, d.x, d.y}; }
                    u32x4 w; w.x = cvt_pk_bf16(v0[0], v0[1]); w.y = cvt_pk_bf16(v0[2], v0[3]); w.z = cvt_pk_bf16(v1[0], v1[1]); w.w = cvt_pk_bf16(v1[2], v1[3]);
                    *(u32x4*)(rowp + bj * HALF) = w; } }
    }
};
struct EpiResid2 {
    static constexpr bool PERM = true, AFTER_DRAIN = false;
    const float* base; const float* gate; bf16_t* xb; float* ssq; int ldc;
    __device__ __forceinline__ void operator()(const f32x4 (&acc)[2][2][4][2], const Unit& u, int wr, int wc, int fr, int fq) const {
        const int row0 = u.pm * BM + wr * 64 + fr, col0 = u.pn * BM + wc * 32 + 8 * fq;
        f32x4 gv[2][2];
#pragma unroll
        for (int bj = 0; bj < 2; ++bj)
#pragma unroll
            for (int n = 0; n < 2; ++n) gv[bj][n] = *(const f32x4*)(gate + col0 + bj * HALF + 4 * n);
#pragma unroll
        for (int ai = 0; ai < 2; ++ai)
#pragma unroll
            for (int m = 0; m < 4; ++m) { const int row = row0 + ai * HALF + m * 16; const size_t off = (size_t)row * ldc + col0; float ss = 0.f;
#pragma unroll
                for (int bj = 0; bj < 2; ++bj) {
                    const f32x4 b0 = *(const f32x4*)(base + off + bj * HALF), b1 = *(const f32x4*)(base + off + bj * HALF + 4);
                    const f32x4 v0 = b0 + gv[bj][0] * acc[ai][bj][m][0], v1 = b1 + gv[bj][1] * acc[ai][bj][m][1];
                    ss += (v0[0] * v0[0] + v0[1] * v0[1]) + (v0[2] * v0[2] + v0[3] * v0[3]) + (v1[0] * v1[0] + v1[1] * v1[1]) + (v1[2] * v1[2] + v1[3] * v1[3]);
                    u32x4 w; w.x = cvt_pk_bf16(v0[0], v0[1]); w.y = cvt_pk_bf16(v0[2], v0[3]); w.z = cvt_pk_bf16(v1[0], v1[1]); w.w = cvt_pk_bf16(v1[2], v1[3]);
                    *(u32x4*)(xb + off + bj * HALF) = w; }
                ss += __shfl_xor(ss, 16); ss += __shfl_xor(ss, 32);
                if (fq == 0) ssq[(size_t)row * 32 + u.pn * 4 + wc] = ss; }
    }
};
struct EpiQ {
    static constexpr bool PERM = true, AFTER_DRAIN = false;
    bf16_t* O; int ldc; const float* bias; const PG8_LAS float* rstd;
    __device__ __forceinline__ void operator()(const f32x4 (&acc)[2][2][4][2], const Unit& u, int wr, int wc, int fr, int fq) const {
        const int lrow0 = wr * 64 + fr, col0 = u.pn * BM + wc * 32 + 8 * fq;
        f32x4 bv[2][2];
#pragma unroll
        for (int bj = 0; bj < 2; ++bj)
#pragma unroll
            for (int n = 0; n < 2; ++n) bv[bj][n] = *(const f32x4*)(bias + col0 + bj * HALF + 4 * n);
#pragma unroll
        for (int ai = 0; ai < 2; ++ai)
#pragma unroll
            for (int m = 0; m < 4; ++m) { const int lrow = lrow0 + ai * HALF + m * 16; const float rs = rstd[(u.pm & 1) * BM + lrow];
                bf16_t* rowp = O + (size_t)(u.pm * BM + lrow) * ldc + col0;
#pragma unroll
                for (int bj = 0; bj < 2; ++bj) { const f32x4 v0 = acc[ai][bj][m][0] * rs + bv[bj][0], v1 = acc[ai][bj][m][1] * rs + bv[bj][1];
                    u32x4 w; w.x = cvt_pk_bf16(v0[0], v0[1]); w.y = cvt_pk_bf16(v0[2], v0[3]); w.z = cvt_pk_bf16(v1[0], v1[1]); w.w = cvt_pk_bf16(v1[2], v1[3]);
                    *(u32x4*)(rowp + bj * HALF) = w; } }
    }
};
}
#ifndef PG8_SP2
#define PG8_SP2 true
#endif
#ifndef PG8_ALIGN
#define PG8_ALIGN true
#endif
constexpr int NWAVES = 8;
constexpr int M = 16384, D = 2048;
constexpr int IN_COLS = 6152, NWIN = 6144, NPROJ = 5120;
constexpr int C_UG = 0, C_VG = 1024, C_Q = 2048, C_K = 3072, C_OM = 4096;
constexpr int WROW_VM = 5120;
constexpr int NHEAD = 4, DH = 256, CH = 128, NCHUNK = M / CH;
constexpr int NEXP = 16384, PH = 8, TOPK = 16, NSEL = PH * TOPK;
constexpr float EPS = 1e-6f;
constexpr int MOD_SHM = 0, MOD_SCM = 2048, MOD_GM = 4096, MOD_SHF = 6144, MOD_SCF = 8192, MOD_GF = 10240, NMOD = 12288;
constexpr int ADA_KC = 16, ADA_KROWS = D / ADA_KC;

constexpr size_t MiB = 1u << 20;
constexpr size_t WS_CTL = 0, CTL_ZERO_BYTES = 1 * MiB;
constexpr size_t WS_MODP = 1 * MiB;
constexpr size_t WS_MODF = WS_MODP + (size_t)ADA_KC * NMOD * 4;
constexpr size_t WS_GATES = 2 * MiB;
constexpr size_t WS_SUMM = 2 * MiB + 512 * 1024;
constexpr size_t WS_MTAB = WS_SUMM + 8192;
constexpr size_t WS_NST = 3 * MiB;
constexpr size_t WS_WIN = 4 * MiB;
constexpr size_t WS_WOUT = 28 * MiB;
constexpr size_t WS_WQ = 36 * MiB;
constexpr size_t WS_IDX = 44 * MiB;
constexpr size_t WS_PG = 52 * MiB;
constexpr size_t WS_SSQP = 60 * MiB;
constexpr size_t WS_BQP = 62 * MiB, WS_BIASQ = 62 * MiB + 512 * 1024;
constexpr size_t WS_SW = 62 * MiB + 768 * 1024;
constexpr size_t WS_CMAXP = 63 * MiB;
constexpr size_t WS_SA = 3 * MiB + 512 * 1024 + 131072;
constexpr size_t WS_HA = 64 * MiB;
constexpr size_t WS_PROJ = 128 * MiB;
constexpr size_t WS_VT = 288 * MiB;
constexpr size_t WS_X1 = 192 * MiB;
constexpr size_t WS_STATE = 320 * MiB;
constexpr size_t WS_ED = 384 * MiB, WS_EU = 416 * MiB;
constexpr size_t WS_SD = 3 * MiB + 512 * 1024, WS_SU = WS_SD + 65536;
constexpr size_t WS_END = 512 * MiB;
constexpr int CW_TMO = 0, CW_CODE = 1, CW_BAR = 4096;

constexpr int RING_BYTES = 131072, LDSCTL_OFF = 163328, MISC_OFF = LDSCTL_OFF + 320, LDS_BYTES = 163840;

#define GAS __attribute__((address_space(1)))
#define LAS __attribute__((address_space(3)))
#define DI __device__ __forceinline__
typedef unsigned short bf16;
typedef unsigned v4u __attribute__((ext_vector_type(4)));
typedef unsigned v2u __attribute__((ext_vector_type(2)));
typedef float f32x4 __attribute__((ext_vector_type(4)));
typedef float f32x16 __attribute__((ext_vector_type(16)));
typedef short bf16x8 __attribute__((ext_vector_type(8)));
typedef GAS unsigned gu32;
#define RLX_AGENT __ATOMIC_RELAXED, __HIP_MEMORY_SCOPE_AGENT
#define LDS_WAIT() asm volatile("s_waitcnt lgkmcnt(0)" ::: "memory")
#define VM_WAIT() asm volatile("s_waitcnt vmcnt(0)" ::: "memory")
#define MFMA32(a, b, c) __builtin_amdgcn_mfma_f32_32x32x16_bf16((a), (b), (c), 0, 0, 0)
DI unsigned f2bf(float f) { unsigned u = __builtin_bit_cast(unsigned, f); return (u + 0x7fffu + ((u >> 16) & 1u)) >> 16; }
DI unsigned pk2(float lo, float hi) { return f2bf(lo) | (f2bf(hi) << 16); }
DI float bflo(unsigned w) { return __builtin_bit_cast(float, w << 16); }
DI float bfhi(unsigned w) { return __builtin_bit_cast(float, w & 0xffff0000u); }
DI float bf2f(unsigned short h) { return __builtin_bit_cast(float, (unsigned)h << 16); }
DI int crow(int reg, int h) { return (reg & 3) + 8 * (reg >> 2) + 4 * h; }
DI float wave_sum(float v) {
#pragma unroll
    for (int o = 1; o < 64; o <<= 1) v += __shfl_xor(v, o);
    return v;
}
DI float wave_max(float v) {
#pragma unroll
    for (int o = 1; o < 64; o <<= 1) v = fmaxf(v, __shfl_xor(v, o));
    return v;
}
DI float silu_f(float v) { return v / (1.0f + __expf(-v)); }
DI float sigmoid_f(float v) { return 1.0f / (1.0f + __expf(-v)); }
DI float gelu_f(float v) { return 0.5f * v * (1.0f + erff(v * 0.70710678118654752f)); }
typedef __bf16 bf16v2 __attribute__((ext_vector_type(2)));
#define DOT2(a, b, c) __builtin_amdgcn_fdot2_f32_bf16(__builtin_bit_cast(bf16v2, (unsigned)(a)), __builtin_bit_cast(bf16v2, (unsigned)(b)), (c), false)
DI f32x16 zero16() { f32x16 z; for (int i = 0; i < 16; ++i) z[i] = 0.f; return z; }
#define XB_TMO      128
#define XB_XCNT(j)  (256  + 64 * (j))
#define XB_XSUB(j)  (1280 + 64 * (j))
#define XB_XGEN(j)  (2304 + 64 * (j))
#define XB_TOP      3328
#define XB_TOPGEN   3392
#define XCD_BAR_WORDS 3456
#define XB_SPIN_CAP (1u << 18)

__device__ __forceinline__ unsigned xb_ld(unsigned* p)              { return __hip_atomic_load(p, __ATOMIC_RELAXED, __HIP_MEMORY_SCOPE_AGENT); }
__device__ __forceinline__ unsigned xb_add(unsigned* p, unsigned v) { return __hip_atomic_fetch_add(p, v, __ATOMIC_RELAXED, __HIP_MEMORY_SCOPE_AGENT); }
__device__ __forceinline__ unsigned xb_xcc_id() { return (unsigned)__builtin_amdgcn_s_getreg((3 << 11) | 20) & 0xFu; }
#define XB_SPIN(cond, bar) do { unsigned _sp = 0; while (cond) { __builtin_amdgcn_s_sleep(1); \
    if ((++_sp & 255u) == 0u) { if (xb_ld(&(bar)[XB_TMO])) break; if (_sp > XB_SPIN_CAP) { atomicAdd(&(bar)[XB_TMO], 1u); break; } } } } while (0)

struct XcdBarrier {
    unsigned* bar; unsigned x;
    volatile LAS unsigned* st;
};

__device__ __forceinline__ XcdBarrier xcd_barrier_post(unsigned* bar, volatile LAS unsigned* st) {
    XcdBarrier b; b.bar = bar; b.x = xb_xcc_id(); b.st = st;
    if (threadIdx.x == 0) (void)xb_add(&bar[XB_XCNT(b.x)], 1u);
    return b;
}
__device__ __forceinline__ void xcd_barrier_complete(unsigned* bar, unsigned x, unsigned& nloc, unsigned& nx) {
    const unsigned G = gridDim.x * gridDim.y * gridDim.z;
    unsigned sum, cnt, mine, sp = 0u;
    for (;;) {
        sum = 0u; cnt = 0u; mine = 0u;
#pragma unroll
        for (unsigned j = 0; j < 16; ++j) { const unsigned c = xb_ld(&bar[XB_XCNT(j)]); sum += c; cnt += (c > 0u) ? 1u : 0u; mine = (j == x) ? c : mine; }
        if (sum == G) break;
        __builtin_amdgcn_s_sleep(1);
        if ((++sp & 255u) == 0u) { if (xb_ld(&bar[XB_TMO])) break; if (sp > XB_SPIN_CAP) { atomicAdd(&bar[XB_TMO], 1u); break; } }
    }
    nloc = mine > 0u ? mine : 1u; nx = cnt > 0u ? cnt : 1u;
}

__device__ __forceinline__ void xcd_barrier(const XcdBarrier& b) {
    asm volatile("s_waitcnt vmcnt(0)" ::: "memory");
    __syncthreads();
    if (threadIdx.x == 0) {
        unsigned* bar = b.bar;
        __builtin_amdgcn_s_waitcnt(0);
        unsigned nloc = b.st[0], nx = b.st[1];
        if (nloc == 0u) { xcd_barrier_complete(bar, b.x, nloc, nx); b.st[0] = nloc; b.st[1] = nx; }
        const unsigned old = xb_add(&bar[XB_XSUB(b.x)], 1u);
        const unsigned gen = old / nloc;
        if (old + 1u == (gen + 1u) * nloc) {
            __builtin_amdgcn_fence(__ATOMIC_RELEASE, "agent");
            asm volatile("s_waitcnt vmcnt(0)" ::: "memory");
            const unsigned og = xb_add(&bar[XB_TOP], 1u);
            const unsigned tg = og / nx;
            if (og + 1u == (tg + 1u) * nx) xb_add(&bar[XB_TOPGEN], 1u);
            else XB_SPIN(xb_ld(&bar[XB_TOPGEN]) == tg, bar);
            __builtin_amdgcn_fence(__ATOMIC_ACQUIRE, "agent");
            xb_add(&bar[XB_XGEN(b.x)], 1u);
            asm volatile("s_waitcnt vmcnt(0)" ::: "memory");
        } else {
            XB_SPIN(xb_ld(&bar[XB_XGEN(b.x)]) == gen, bar);
            __builtin_amdgcn_fence(__ATOMIC_ACQUIRE, "agent");
            asm volatile("s_waitcnt vmcnt(0)" ::: "memory");
        }
    }
    __syncthreads();
}
struct Frame {
    LAS unsigned char* lds;
    volatile LAS unsigned* MISC;
    gu32* ctl;
    int tid, lane, wave, vcu, G;
    const float *x, *c, *ada_w, *ada_b, *norm_mix_g, *w_in, *b_gates, *conv_w, *conv_b, *gmlp_norm_g, *gmlp_w, *gmlp_b, *mlstm_norm_g, *w_out, *norm_ffn_g,
                *wq, *keys1, *keys2, *e_down, *e_up, *final_g;
    float* out;
    float *MODP, *MODF, *GATES, *SUMM, *MTAB, *NST, *PG;
    int* IDX;
    bf16 *WIN, *WOUT, *WQ, *HA, *PROJ, *QB, *STATE, *QC, *KC, *VT;
    unsigned char *ED, *EU, *H1Q; float *SD, *SU;
    float *SSQP, *BQP, *BIASQ, *SW, *CMAXP, *SA; bf16* X1B;
};

DI void p0_transpose_item(const float* W, int K, int ldw, int nblk, bf16* WT, LAS float* scr, int item, int lane, bool vm_last = false) {
    const int kb = item / nblk, nb = item % nblk, k0 = 64 * kb, n0 = 32 * nb;
    const int d0 = !vm_last ? n0 : (n0 < 4096 ? n0 : (n0 < 5120 ? n0 + 1024 : n0 - 1024));
#pragma unroll 8
    for (int i = 0; i < 32; ++i) { const int kk = 2 * i + (lane >> 5); scr[kk * 33 + (lane & 31)] = W[(size_t)(k0 + kk) * ldw + n0 + (lane & 31)]; }
    LDS_WAIT(); asm volatile("" ::: "memory");
    const int c = lane & 7;
#pragma unroll
    for (int j = 0; j < 4; ++j) { const int n = (lane >> 3) + 8 * j; const LAS float* s = scr + (8 * c) * 33 + n;
        v4u o; o.x = pk2(s[0 * 33], s[1 * 33]); o.y = pk2(s[2 * 33], s[3 * 33]); o.z = pk2(s[4 * 33], s[5 * 33]); o.w = pk2(s[6 * 33], s[7 * 33]);
        *(GAS v4u*)(WT + (size_t)(d0 + n) * K + k0 + 8 * c) = o; }
    LDS_WAIT(); asm volatile("" ::: "memory");
}
DI void p0_colmax_item(Frame& F, int item) {
    const int lane = F.lane, nblk = NWIN / 32, kb = item / nblk, nb = item % nblk, k0 = 64 * kb, n0 = 32 * nb;
    float m = 0.f;
#pragma unroll 8
    for (int i = 0; i < 32; ++i) { const int kk = 2 * i + (lane >> 5); m = fmaxf(m, fabsf(F.w_in[(size_t)(k0 + kk) * IN_COLS + n0 + (lane & 31)])); }
    m = fmaxf(m, __shfl_xor(m, 32));
    if (lane < 32) F.CMAXP[(size_t)kb * NWIN + n0 + lane] = m;
}
DI void p0_ada_item(Frame& F, LAS float* scr, int item) {
    const int cc = item % (NMOD / 256), kc = item / (NMOD / 256), k0 = kc * ADA_KROWS, col = cc * 256 + F.lane * 4;
#pragma unroll
    for (int j = 0; j < ADA_KROWS / 64; ++j) scr[F.lane + 64 * j] = silu_f(F.c[k0 + F.lane + 64 * j]);
    LDS_WAIT(); asm volatile("" ::: "memory");
    f32x4 acc = {0.f, 0.f, 0.f, 0.f};
    const float* wp = F.ada_w + (size_t)k0 * NMOD + col;
#pragma unroll 8
    for (int kk = 0; kk < ADA_KROWS; ++kk) { const float s = scr[kk]; const f32x4 w = *(const GAS f32x4*)(wp + (size_t)kk * NMOD); acc += w * s; }
    *(GAS f32x4*)(F.MODP + (size_t)kc * NMOD + col) = acc;
    LDS_WAIT(); asm volatile("" ::: "memory");
}
DI void p0a_phase(Frame& F) {
    LAS float* scr = (LAS float*)(F.lds + F.wave * 16384);
    const int gw = F.wave * F.G + F.vcu, NGW = F.G * NWAVES;
    constexpr int I_ADA = (NMOD / 256) * ADA_KC;
    constexpr int I_WIN = (D / 64) * (NWIN / 32), I_WO = (D / 64) * (D / 32);
    constexpr int NITEMS = I_ADA + I_WIN + I_WO;
    for (int it = gw; it < NITEMS; it += NGW) {
        int r = it;
        if (r < I_ADA) { p0_ada_item(F, scr, r); continue; } r -= I_ADA;
        if (r < I_WIN) { p0_colmax_item(F, r); continue; } r -= I_WIN;
        p0_transpose_item(F.w_out, D, D, D / 32, F.WOUT, scr, r, F.lane);
    }
#pragma unroll 1
    for (int row = gw; row < 2 * NEXP; row += NGW) {
        const int tb = row >= NEXP, e = row - tb * NEXP;
        const GAS f32x4* src = (const GAS f32x4*)((tb ? F.e_up : F.e_down) + (size_t)e * D) + F.lane;
        f32x4 v[8]; float am = 0.f;
#pragma unroll
        for (int j = 0; j < 8; ++j) { v[j] = src[64 * j]; am = fmaxf(am, fmaxf(fmaxf(fabsf(v[j].x), fabsf(v[j].y)), fmaxf(fabsf(v[j].z), fabsf(v[j].w)))); }
        am = fmaxf(wave_max(am), 1e-30f);
        const float sc = am * (1.0f / 127.0f), inv = 127.0f / am;
        GAS unsigned* dst = (GAS unsigned*)((tb ? F.EU : F.ED) + (size_t)e * D) + F.lane;
        const int off = tb ? 128 : 0;
#pragma unroll
        for (int j = 0; j < 8; ++j) {
            const int q0 = (int)__builtin_rintf(v[j].x * inv) + off, q1 = (int)__builtin_rintf(v[j].y * inv) + off, q2 = (int)__builtin_rintf(v[j].z * inv) + off, q3 = (int)__builtin_rintf(v[j].w * inv) + off;
            dst[64 * j] = (unsigned)(q0 & 255) | ((unsigned)(q1 & 255) << 8) | ((unsigned)(q2 & 255) << 16) | ((unsigned)(q3 & 255) << 24);
        }
        if (F.lane == 0) (tb ? F.SU : F.SD)[e] = sc;
    }
}
DI float mod_final(Frame& F, int col) { float s = F.ada_b[col];
#pragma unroll
    for (int k = 0; k < ADA_KC; ++k) s += F.MODP[(size_t)k * NMOD + col];
    return s; }
DI void norm_tables(Frame& F, const float* g, int col_scale, int col_shift) {
    LAS float* A1 = (LAS float*)(F.lds); LAS float* B1 = (LAS float*)(F.lds + 8192);
#pragma unroll
    for (int i = 0; i < 4; ++i) { const int c = F.tid + 512 * i; A1[c] = g[c] * (1.0f + F.MODF[col_scale + c]); B1[c] = F.MODF[col_shift + c]; }
}
DI void p0_wq_item(Frame& F, LAS float* scr, int item) {
    const int lane = F.lane, nblk = D / 32, kb = item / nblk, nb = item % nblk, k0 = 64 * kb, n0 = 32 * nb;
    LAS float* gsl = scr + 64 * 33; LAS float* shl = gsl + 64;
    gsl[lane] = F.norm_ffn_g[k0 + lane] * (1.0f + mod_final(F, MOD_SCF + k0 + lane)); shl[lane] = mod_final(F, MOD_SHF + k0 + lane);
    LDS_WAIT(); asm volatile("" ::: "memory");
    float bp = 0.f;
#pragma unroll 8
    for (int i = 0; i < 32; ++i) { const int kk = 2 * i + (lane >> 5); const float w = F.wq[(size_t)(k0 + kk) * D + n0 + (lane & 31)]; scr[kk * 33 + (lane & 31)] = w * gsl[kk]; bp += w * shl[kk]; }
    bp += __shfl_xor(bp, 32);
    if (lane < 32) F.BQP[(size_t)kb * D + n0 + lane] = bp;
    LDS_WAIT(); asm volatile("" ::: "memory");
    const int c = lane & 7;
#pragma unroll
    for (int j = 0; j < 4; ++j) { const int n = (lane >> 3) + 8 * j; const LAS float* sp = scr + (8 * c) * 33 + n;
        v4u o; o.x = pk2(sp[0 * 33], sp[1 * 33]); o.y = pk2(sp[2 * 33], sp[3 * 33]); o.z = pk2(sp[4 * 33], sp[5 * 33]); o.w = pk2(sp[6 * 33], sp[7 * 33]);
        *(GAS v4u*)(F.WQ + (size_t)(n0 + n) * D + k0 + 8 * c) = o; }
    LDS_WAIT(); asm volatile("" ::: "memory");
}
DI void p0_winq_item(Frame& F, LAS float* scr, int item) {
    const int lane = F.lane, nblk = NWIN / 32, kb = item / nblk, nb = item % nblk, k0 = 64 * kb, n0 = 32 * nb;
    const int d0 = n0 < 4096 ? n0 : (n0 < 5120 ? n0 + 1024 : n0 - 1024);
    LAS float* inv = scr + 64 * 33;
    if (lane < 32) { float m = 0.f;
#pragma unroll 8
        for (int q = 0; q < D / 64; ++q) m = fmaxf(m, F.CMAXP[(size_t)q * NWIN + n0 + lane]);
        m = fmaxf(m, 1e-30f); inv[lane] = 127.0f / m; if (kb == 0) F.SW[d0 + lane] = m * (1.0f / 127.0f); }
#pragma unroll 8
    for (int i = 0; i < 32; ++i) { const int kk = 2 * i + (lane >> 5); scr[kk * 33 + (lane & 31)] = F.w_in[(size_t)(k0 + kk) * IN_COLS + n0 + (lane & 31)]; }
    LDS_WAIT(); asm volatile("" ::: "memory");
    unsigned char* WQ = (unsigned char*)F.WIN;
#pragma unroll
    for (int i = 0; i < 2; ++i) { const int q = lane + 64 * i, n = q >> 2, c = q & 3; const float iv = inv[n]; const LAS float* sp = scr + (16 * c) * 33 + n; v4u o;
#pragma unroll
        for (int w = 0; w < 4; ++w) { const int q0 = (int)__builtin_rintf(sp[(4 * w) * 33] * iv), q1 = (int)__builtin_rintf(sp[(4 * w + 1) * 33] * iv), q2 = (int)__builtin_rintf(sp[(4 * w + 2) * 33] * iv), q3 = (int)__builtin_rintf(sp[(4 * w + 3) * 33] * iv);
            o[w] = (unsigned)(q0 & 255) | ((unsigned)(q1 & 255) << 8) | ((unsigned)(q2 & 255) << 16) | ((unsigned)(q3 & 255) << 24); }
        *(GAS v4u*)(WQ + (size_t)(d0 + n) * D + k0 + 16 * c) = o; }
    LDS_WAIT(); asm volatile("" ::: "memory");
}
DI void p0b_phase(Frame& F) {
    LAS float* A1 = (LAS float*)(F.lds); LAS float* B1 = (LAS float*)(F.lds + 8192); LAS float* WG = (LAS float*)(F.lds + 16384);
#pragma unroll
    for (int i = 0; i < 4; ++i) { const int c = F.tid + 512 * i; A1[c] = F.norm_mix_g[c] * (1.0f + mod_final(F, MOD_SCM + c)); B1[c] = mod_final(F, MOD_SHM + c); }
    { const int per = (NMOD + F.G - 1) / F.G; const int c = (int)blockIdx.x * per + F.tid; if (F.tid < per && c < NMOD) F.MODF[c] = mod_final(F, c); }
#pragma unroll
    for (int i = 0; i < 4; ++i) { const int k = F.tid + 512 * i; const f32x4 a = *(const GAS f32x4*)(F.w_in + (size_t)k * IN_COLS + NWIN), b = *(const GAS f32x4*)(F.w_in + (size_t)k * IN_COLS + NWIN + 4);
        WG[0 * 2048 + k] = a.x; WG[1 * 2048 + k] = a.y; WG[2 * 2048 + k] = a.z; WG[3 * 2048 + k] = a.w; WG[4 * 2048 + k] = b.x; WG[5 * 2048 + k] = b.y; WG[6 * 2048 + k] = b.z; WG[7 * 2048 + k] = b.w; }
    __syncthreads();
    const int gw = F.vcu * NWAVES + F.wave, NGW = F.G * NWAVES;
    f32x4 vn[8];
    { const GAS f32x4* xr = (const GAS f32x4*)(F.x + (size_t)gw * D) + F.lane;
#pragma unroll
      for (int j = 0; j < 8; ++j) vn[j] = xr[64 * j]; }
#pragma unroll 1
    for (int row = gw; row < M; row += NGW) {
        f32x4 v[8]; float ss = 0.f;
#pragma unroll
        for (int j = 0; j < 8; ++j) { v[j] = vn[j]; ss += (v[j].x * v[j].x + v[j].y * v[j].y) + (v[j].z * v[j].z + v[j].w * v[j].w); }
        if (row + NGW < M) { const GAS f32x4* xr = (const GAS f32x4*)(F.x + (size_t)(row + NGW) * D) + F.lane;
#pragma unroll
            for (int j = 0; j < 8; ++j) vn[j] = xr[64 * j]; }
        const float rstd = 1.0f / sqrtf(wave_sum(ss) * (1.0f / D) + EPS);
        float gd[8];
#pragma unroll
        for (int g = 0; g < 8; ++g) gd[g] = 0.f;
        LAS v2u* o8 = (LAS v2u*)(F.lds + 81920 + F.wave * 4096) + F.lane; float am = 0.f;
#pragma unroll
        for (int j = 0; j < 8; ++j) {
            const f32x4 a = *(const LAS f32x4*)(A1 + 256 * j + 4 * F.lane), b = *(const LAS f32x4*)(B1 + 256 * j + 4 * F.lane);
            const f32x4 h = v[j] * rstd * a + b;
            v2u o; o.x = pk2(h.x, h.y); o.y = pk2(h.z, h.w); o8[64 * j] = o; am = fmaxf(am, fmaxf(fmaxf(fabsf(h.x), fabsf(h.y)), fmaxf(fabsf(h.z), fabsf(h.w))));
#pragma unroll
            for (int g = 0; g < 8; ++g) { const f32x4 w = *(const LAS f32x4*)(WG + g * 2048 + 256 * j + 4 * F.lane); gd[g] += (h.x * w.x + h.y * w.y) + (h.z * w.z + h.w * w.w); }
            asm volatile("" ::: "memory");
        }
#pragma unroll
        for (int g = 0; g < 8; ++g) gd[g] = wave_sum(gd[g]);
        if (F.lane == 0) {
#pragma unroll
            for (int g = 0; g < 8; ++g) { float p = gd[g] + F.b_gates[g];
                if (g >= 4) { p = fminf(p, 0.f) - log1pf(__expf(-fabsf(p))); }
                F.GATES[(size_t)row * 8 + g] = p; }
        }
            {
            am = fmaxf(wave_max(am), 1e-30f); const float qinv = 127.0f / am;
            LDS_WAIT(); asm volatile("" ::: "memory");
            GAS unsigned* qr = (GAS unsigned*)(F.H1Q + (size_t)row * D) + F.lane;
#pragma unroll
            for (int j = 0; j < 8; ++j) { const v2u w = o8[64 * j];
                const int q0 = (int)__builtin_rintf(bflo(w.x) * qinv), q1 = (int)__builtin_rintf(bfhi(w.x) * qinv), q2 = (int)__builtin_rintf(bflo(w.y) * qinv), q3 = (int)__builtin_rintf(bfhi(w.y) * qinv);
                qr[64 * j] = (unsigned)(q0 & 255) | ((unsigned)(q1 & 255) << 8) | ((unsigned)(q2 & 255) << 16) | ((unsigned)(q3 & 255) << 24); }
            if (F.lane == 0) F.SA[row] = am * (1.0f / 127.0f);
            LDS_WAIT(); asm volatile("" ::: "memory");
        }
    }
    __syncthreads();
    {
        LAS float* scr = (LAS float*)(F.lds + F.wave * 8960);
        for (int it = F.wave * F.G + F.vcu; it < (D / 64) * (D / 32); it += NGW) p0_wq_item(F, scr, it);
        for (int it = F.wave * F.G + F.vcu; it < (D / 64) * (NWIN / 32); it += NGW) p0_winq_item(F, scr, it);
    }
}
constexpr int IMG_PITCH = 576, M1_WL = 73728, M1_RED = 74240, M1_OB = 90624;
typedef short s16x4 __attribute__((ext_vector_type(4)));
DI bf16x8 tr_frag(const LAS unsigned char* p, int off_lo, int off_hi) {
    const s16x4 lo = __builtin_amdgcn_ds_read_tr16_b64_v4i16((LAS s16x4*)(p + off_lo));
    const s16x4 hi = __builtin_amdgcn_ds_read_tr16_b64_v4i16((LAS s16x4*)(p + off_hi));
    return __builtin_shufflevector(lo, hi, 0, 1, 2, 3, 4, 5, 6, 7);
}
DI float bfel(const v4u& w, int e) { const unsigned d = w[e >> 1]; return (e & 1) ? bfhi(d) : bflo(d); }
DI void m1_item(Frame& F, int hh, int kc) {
    LAS unsigned char* IMG = F.lds; LAS float* WL = (LAS float*)(F.lds + M1_WL); LAS float* RED = (LAS float*)(F.lds + M1_RED);
    const int t0 = kc * CH, lane = F.lane, tid = F.tid;
    if (F.wave == 0) {
        const float* gp = F.GATES + (size_t)(t0 + 2 * lane) * 8;
        const float i0 = gp[hh], lf0 = gp[4 + hh], i1 = gp[8 + hh], lf1 = gp[12 + hh];
        const float p = lf0 + lf1; float inc = p;
#pragma unroll
        for (int o = 1; o < 64; o <<= 1) { const float t = __shfl_up(inc, o); if (lane >= o) inc += t; }
        const float A = __shfl(inc, 63), ex = inc - p, b0 = ex + lf0, b1 = ex + p;
        const float lw0 = A - b0 + i0, lw1 = A - b1 + i1;
        const float B = wave_max(fmaxf(lw0, lw1));
        WL[2 * lane] = __expf(lw0 - B); WL[2 * lane + 1] = __expf(lw1 - B);
        if (lane == 0) { F.SUMM[(hh * NCHUNK + kc) * 2] = A; F.SUMM[(hh * NCHUNK + kc) * 2 + 1] = B; }
    }
    __syncthreads();
    const int dg = tid & 31, sg = tid >> 5;
#pragma unroll 1
    for (int which = 0; which < 2; ++which) {
        const int chb = (which == 0 ? 1024 : 0) + hh * DH + dg * 8;
        const int colb = (which == 0 ? C_K : C_Q) + hh * DH + dg * 8;
        v4u raw[11];
#pragma unroll
        for (int rr = 0; rr < 11; ++rr) { const int tt = t0 + sg * 8 - 3 + rr; raw[rr] = (v4u){0u, 0u, 0u, 0u}; if (tt >= 0) raw[rr] = *(const GAS v4u*)(F.PROJ + (size_t)tt * NPROJ + colb); }
        float wl[8];
#pragma unroll
        for (int i = 0; i < 8; ++i) wl[i] = (which == 0) ? WL[sg * 8 + i] : 0.0625f;
        v4u o1[8], o2[8];
#pragma unroll
        for (int dw = 0; dw < 4; ++dw) {
            typedef float f32x2 __attribute__((ext_vector_type(2)));
            f32x2 cw[4];
#pragma unroll
            for (int j = 0; j < 4; ++j) cw[j] = *(const GAS f32x2*)(F.conv_w + j * 2048 + chb + 2 * dw);
            const f32x2 cb = *(const GAS f32x2*)(F.conv_b + chb + 2 * dw);
            float xl[11], xh[11];
#pragma unroll
            for (int rr = 0; rr < 11; ++rr) { xl[rr] = bflo(raw[rr][dw]); xh[rr] = bfhi(raw[rr][dw]); }
            float d0 = 0.f, d1 = 0.f;
#pragma unroll
            for (int i = 0; i < 8; ++i) {
                float a0 = cb.x, a1 = cb.y;
#pragma unroll
                for (int j = 0; j < 4; ++j) { a0 += cw[j].x * xl[i + j]; a1 += cw[j].y * xh[i + j]; }
                a0 = silu_f(a0); a1 = silu_f(a1);
                if (which == 0) { o1[i][dw] = pk2(a0, a1); a0 *= wl[i]; a1 *= wl[i]; d0 += a0; d1 += a1; o2[i][dw] = pk2(a0, a1); }
                else { o1[i][dw] = pk2(a0 * wl[i], a1 * wl[i]); }
            }
            if (which == 0) { RED[sg * 256 + dg * 8 + 2 * dw] = d0; RED[sg * 256 + dg * 8 + 2 * dw + 1] = d1; }
            asm volatile("" ::: "memory");
        }
#pragma unroll
        for (int i = 0; i < 8; ++i) { const int s = sg * 8 + i, t = t0 + s;
            if (which == 0) { *(GAS v4u*)(F.KC + (size_t)t * 1024 + hh * DH + dg * 8) = o1[i]; *(LAS v4u*)(IMG + s * IMG_PITCH + dg * 16) = o2[i]; }
            else { *(GAS v4u*)(F.QC + (size_t)t * 1024 + hh * DH + dg * 8) = o1[i]; } }
    }
    __syncthreads();
    if (tid < 256) { float s = 0.f;
#pragma unroll
        for (int i = 0; i < 16; ++i) s += RED[i * 256 + tid];
        F.NST[(size_t)(hh * NCHUNK + kc) * DH + tid] = s; }
    const int r = lane & 31, h = lane >> 5, e0 = F.wave * 32;
    bf16x8 bf[8];
#pragma unroll
    for (int ks = 0; ks < 8; ++ks) {
        bf[ks] = *(const GAS bf16x8*)(F.VT + (size_t)(hh * DH + e0 + r) * M + t0 + ks * 16 + 8 * h);
    }
    const LAS unsigned char* trb = IMG + (8 * h + ((lane & 15) >> 2)) * IMG_PITCH + (16 * ((lane >> 4) & 1) + 4 * (lane & 3)) * 2;
    LAS unsigned char* OB = F.lds + M1_OB + F.wave * (32 * 144);
#pragma unroll 1
    for (int dp = 0; dp < 4; ++dp) {
#pragma unroll
        for (int d2 = 0; d2 < 2; ++d2) {
            const int dt = 2 * dp + d2;
            f32x16 acc = zero16();
#pragma unroll
            for (int ks = 0; ks < 8; ++ks) { const bf16x8 af = tr_frag(trb + dt * 64, ks * 16 * IMG_PITCH, ks * 16 * IMG_PITCH + 4 * IMG_PITCH); acc = MFMA32(af, bf[ks], acc); }
#pragma unroll
            for (int g = 0; g < 4; ++g) { v2u o; o.x = pk2(acc[4 * g], acc[4 * g + 1]); o.y = pk2(acc[4 * g + 2], acc[4 * g + 3]);
                *(LAS v2u*)(OB + r * 144 + (d2 * 32 + 8 * g + 4 * h) * 2) = o; }
        }
        LDS_WAIT(); asm volatile("" ::: "memory");
#pragma unroll
        for (int i = 0; i < 4; ++i) { const int q = lane + 64 * i, row = q >> 3, c16 = q & 7;
            *(GAS v4u*)(F.STATE + (size_t)(hh * NCHUNK + kc) * (DH * DH) + (size_t)(e0 + row) * DH + dp * 64 + c16 * 8) = *(const LAS v4u*)(OB + row * 144 + c16 * 16); }
        LDS_WAIT(); asm volatile("" ::: "memory");
    }
    __syncthreads();
}
constexpr int G_WI = 0, G_VI = 34816, G_UI = 75776, G_WP = 272, G_VP = 320, G_UP = 272;
DI void gmlp_block(Frame& F, int g, int n0, int nch) {
    LAS unsigned char* WI = F.lds + G_WI; LAS unsigned char* VI = F.lds + G_VI; LAS unsigned char* UI = F.lds + G_UI;
    const int c0 = g * 128, lane = F.lane, tid = F.tid;
    {
#pragma unroll
        for (int i = 0; i < 8; ++i) { const int p = tid + 512 * i, t = p >> 5, s4 = (p & 31) * 4;
            const f32x4 w = *(const GAS f32x4*)(F.gmlp_w + (size_t)(g * 128 + t) * 128 + s4);
            v2u o; o.x = pk2(s4 <= t ? w.x : 0.f, s4 + 1 <= t ? w.y : 0.f); o.y = pk2(s4 + 2 <= t ? w.z : 0.f, s4 + 3 <= t ? w.w : 0.f);
            *(LAS v2u*)(WI + t * G_WP + s4 * 2) = o; }
    }
    v4u tv[4], tu[4];
#define G_LOAD(N) do { _Pragma("unroll") for (int i = 0; i < 4; ++i) { const int p = tid + 512 * i; const bf16* rowp = F.PROJ + (size_t)((N) * CH + (p >> 4)) * NPROJ + c0 + (p & 15) * 8; \
        tv[i] = *(const GAS v4u*)(rowp + C_VG); tu[i] = *(const GAS v4u*)(rowp + C_UG); } } while (0)
    G_LOAD(n0);
    const int r = lane & 31, h = lane >> 5, ct = F.wave & 3, tp = F.wave >> 2;
    float ng[16];
#pragma unroll
    for (int reg = 0; reg < 16; ++reg) ng[reg] = F.gmlp_norm_g[g * 128 + ct * 32 + crow(reg, h)];
    const LAS unsigned char* trb = VI + (8 * h + ((lane & 15) >> 2)) * G_VP + (ct * 32 + 16 * ((lane >> 4) & 1) + 4 * (lane & 3)) * 2;
#pragma unroll 1
    for (int ci = 0; ci < nch; ++ci) {
        const int n = n0 + ci, t0 = n * CH;
#pragma unroll
        for (int i = 0; i < 4; ++i) { const int p = tid + 512 * i, row = p >> 4, c16 = p & 15; const v4u w = tv[i];
            float a[8] = {bflo(w.x), bfhi(w.x), bflo(w.y), bfhi(w.y), bflo(w.z), bfhi(w.z), bflo(w.w), bfhi(w.w)};
            float ss = (a[0] * a[0] + a[1] * a[1]) + (a[2] * a[2] + a[3] * a[3]) + (a[4] * a[4] + a[5] * a[5]) + (a[6] * a[6] + a[7] * a[7]);
            ss += __shfl_xor(ss, 1); ss += __shfl_xor(ss, 2); ss += __shfl_xor(ss, 4); ss += __shfl_xor(ss, 8);
            const float rs = 1.0f / sqrtf(ss * (1.0f / 128.0f) + EPS);
            v4u o; o.x = pk2(a[0] * rs, a[1] * rs); o.y = pk2(a[2] * rs, a[3] * rs); o.z = pk2(a[4] * rs, a[5] * rs); o.w = pk2(a[6] * rs, a[7] * rs);
            *(LAS v4u*)(VI + row * G_VP + c16 * 16) = o; *(LAS v4u*)(UI + row * G_UP + c16 * 16) = tu[i]; }
        __syncthreads();
        if (ci + 1 < nch) G_LOAD(n + 1);
#pragma unroll 1
        for (int ti = 0; ti < 2; ++ti) {
            const int tt = (ti == 0) ? tp : 3 - tp;
            const int t = tt * 32 + r;
            const LAS unsigned char* wrow = WI + t * G_WP + 16 * h;
            f32x16 acc = zero16();
#pragma unroll
            for (int ks = 0; ks < 8; ++ks) if (ks <= 2 * tt + 1) {
                const bf16x8 af = tr_frag(trb, ks * 16 * G_VP, ks * 16 * G_VP + 4 * G_VP);
                const bf16x8 bw = *(const LAS bf16x8*)(wrow + 32 * ks);
                acc = MFMA32(af, bw, acc);
            }
            const float bsp = F.gmlp_b[g * 128 + t];
            LAS unsigned char* urow = UI + t * G_UP + (ct * 32 + 4 * h) * 2;
#pragma unroll
            for (int gq = 0; gq < 4; ++gq) { LAS v2u* up = (LAS v2u*)(urow + 16 * gq);
                const v2u uw = *up;
                const float y0 = bflo(uw.x) * (ng[4 * gq] * acc[4 * gq] + bsp), y1 = bfhi(uw.x) * (ng[4 * gq + 1] * acc[4 * gq + 1] + bsp);
                const float y2 = bflo(uw.y) * (ng[4 * gq + 2] * acc[4 * gq + 2] + bsp), y3 = bfhi(uw.y) * (ng[4 * gq + 3] * acc[4 * gq + 3] + bsp);
                v2u o; o.x = pk2(y0, y1); o.y = pk2(y2, y3); *up = o; }
        }
        __syncthreads();
#pragma unroll
        for (int i = 0; i < 4; ++i) { const int p = tid + 512 * i, row = p >> 4, c16 = p & 15;
            *(GAS v4u*)(F.HA + (size_t)(t0 + row) * D + c0 + c16 * 8) = *(const LAS v4u*)(UI + row * G_UP + c16 * 16); }
        __syncthreads();
    }
#undef G_LOAD
}
DI void p2_phase(Frame& F) {
    constexpr int N_M1 = NHEAD * NCHUNK;
#pragma unroll 1
    for (int it = (int)blockIdx.x; it < N_M1; it += F.G) m1_item(F, it / NCHUNK, it % NCHUNK);
    { const int per = (8 * (M / CH) + F.G - 1) / F.G;
      const int first = (int)blockIdx.x * per;
      if (first < 8 * (M / CH)) { const int g = first / (M / CH), n0 = first % (M / CH); int nch = per; if (n0 + nch > M / CH) nch = M / CH - n0; gmlp_block(F, g, n0, nch); } }
}
DI void p3_phase(Frame& F) {
    LAS float* TAB = (LAS float*)F.lds;
    const int lane = F.lane;
    if (F.wave < NHEAD) {
        const int hh = F.wave; const float* sp = F.SUMM + (size_t)(hh * NCHUNK + 2 * lane) * 2;
        const float A0 = sp[0], B0 = sp[1], A1 = sp[2], B1 = sp[3];
        float ca = A0 + A1, cb = fmaxf(B0 + A1, B1);
        const float pa = ca, pb = cb;
#pragma unroll
        for (int o = 1; o < 64; o <<= 1) { const float ta = __shfl_up(ca, o), tb = __shfl_up(cb, o); if (lane >= o) { cb = fmaxf(tb + ca, cb); ca = ta + ca; } }
        (void)pa; (void)pb;
        float ea = __shfl_up(ca, 1), eb = __shfl_up(cb, 1);
        float m0 = (lane == 0) ? 0.f : fmaxf(ea, eb);
        const float m1 = fmaxf(m0 + A0, B0), m2 = fmaxf(m1 + A1, B1);
        TAB[(hh * NCHUNK + 2 * lane) * 2] = __expf(A0 + m0 - m1); TAB[(hh * NCHUNK + 2 * lane) * 2 + 1] = __expf(B0 - m1);
        TAB[(hh * NCHUNK + 2 * lane + 1) * 2] = __expf(A1 + m1 - m2); TAB[(hh * NCHUNK + 2 * lane + 1) * 2 + 1] = __expf(B1 - m2);
        if (blockIdx.x == 0) { F.MTAB[hh * NCHUNK + 2 * lane] = m0; F.MTAB[hh * NCHUNK + 2 * lane + 1] = m1; }
    }
    __syncthreads();
    const int NT = F.G * NWAVES * 64, gt = (int)blockIdx.x * (NWAVES * 64) + F.tid;
    if (gt < D) { float b = 0.f;
#pragma unroll 8
        for (int k = 0; k < D / 64; ++k) b += F.BQP[(size_t)k * D + gt];
        F.BIASQ[gt] = b; }
    for (int p = gt; p < NHEAD * (DH * DH / 2); p += NT) {
        const int hh = p / (DH * DH / 2), q = p % (DH * DH / 2);
        GAS unsigned* sp = (GAS unsigned*)(F.STATE + (size_t)hh * NCHUNK * (DH * DH)) + q;
        float s0 = 0.f, s1 = 0.f;
#pragma unroll 1
        for (int k0 = 0; k0 < NCHUNK; k0 += 16) {
            unsigned ld[16];
#pragma unroll
            for (int k = 0; k < 16; ++k) ld[k] = sp[(size_t)(k0 + k) * (DH * DH / 2)];
#pragma unroll
            for (int k = 0; k < 16; ++k) {
                sp[(size_t)(k0 + k) * (DH * DH / 2)] = pk2(s0, s1);
                const float dec = TAB[(hh * NCHUNK + k0 + k) * 2], wb = TAB[(hh * NCHUNK + k0 + k) * 2 + 1];
                s0 = dec * s0 + wb * bflo(ld[k]); s1 = dec * s1 + wb * bfhi(ld[k]);
            }
        }
    }
    for (int p = gt; p < NHEAD * DH; p += NT) {
        const int hh = p / DH, d = p % DH; float* np = F.NST + (size_t)hh * NCHUNK * DH + d; float s = 0.f;
#pragma unroll 8
        for (int k = 0; k < NCHUNK; ++k) { const float ld = np[(size_t)k * DH]; np[(size_t)k * DH] = s; s = TAB[(hh * NCHUNK + k) * 2] * s + TAB[(hh * NCHUNK + k) * 2 + 1] * ld; }
    }
}
constexpr int M3_QI = 8192, M3_R2 = 75776, M3_QP = 528, M3_CP = 272, M3_VP = 264;
static_assert(M3_R2 + 256 * M3_CP <= LDSCTL_OFF, "P4 LDS map");
DI void m3_item(Frame& F, int hh, int kc) {
    LAS float* GS = (LAS float*)F.lds; LAS float* MX = GS + 128; LAS float* BT = GS + 256; LAS float* NK = GS + 384; LAS float* XCH = GS + 640;
    LAS unsigned char* QI = F.lds + M3_QI; LAS unsigned char* R2 = F.lds + M3_R2;
    int tid = F.tid; asm volatile("" : "+v"(tid));
    const int t0 = kc * CH, lane = F.lane, item = hh * NCHUNK + kc;
    const float mk = F.MTAB[item];
    const bf16* cbase = F.STATE + (size_t)item * (DH * DH);
    const bf16* kbase = F.KC + (size_t)t0 * 1024 + hh * DH;
    const bf16* qbase = F.QC + (size_t)t0 * 1024 + hh * DH;
    const bf16* vbase = F.VT + (size_t)(hh * DH) * M + t0;
    {
        v4u tk[8], tq[8];
#pragma unroll
        for (int i = 0; i < 8; ++i) { const int p = tid + 512 * i; tk[i] = *(const GAS v4u*)(kbase + (size_t)(p >> 5) * 1024 + (p & 31) * 8); tq[i] = *(const GAS v4u*)(qbase + (size_t)(p >> 5) * 1024 + (p & 31) * 8); }
        if (F.wave == 0) {
            const float* gp = F.GATES + (size_t)(t0 + 2 * lane) * 8;
            const float i0 = gp[hh], lf0 = gp[4 + hh], i1 = gp[8 + hh], lf1 = gp[12 + hh];
            const float p = lf0 + lf1; float inc = p;
#pragma unroll
            for (int o = 1; o < 64; o <<= 1) { const float t = __shfl_up(inc, o); if (lane >= o) inc += t; }
            const float ex = inc - p, b0 = ex + lf0, b1 = ex + p;
            const float g0 = i0 - b0, g1 = i1 - b1;
            float cm = fmaxf(g0, g1);
#pragma unroll
            for (int o = 1; o < 64; o <<= 1) { const float t = __shfl_up(cm, o); if (lane >= o) cm = fmaxf(cm, t); }
            float pm = __shfl_up(cm, 1); if (lane == 0) pm = -INFINITY;
            const float M0 = fmaxf(mk, fmaxf(pm, g0)), M1 = fmaxf(M0, g1);
            GS[2 * lane] = g0; GS[2 * lane + 1] = g1; MX[2 * lane] = M0; MX[2 * lane + 1] = M1; BT[2 * lane] = b0; BT[2 * lane + 1] = b1;
        }
        if (tid < 256) NK[tid] = F.NST[(size_t)item * DH + tid];
#pragma unroll
        for (int i = 0; i < 8; ++i) { const int p = tid + 512 * i; *(LAS v4u*)(R2 + (p >> 5) * M3_QP + (p & 31) * 16) = tk[i]; *(LAS v4u*)(QI + (p >> 5) * M3_QP + (p & 31) * 16) = tq[i]; }
    }
    __syncthreads();
    const int r = lane & 31, h = lane >> 5, tt = F.wave & 3, eh = F.wave >> 2;
    const int tl = tt * 32 + r, t = t0 + tl;
    const float Mt = MX[tl], winter = __expf(mk - Mt);
    const LAS unsigned char* qrow = QI + tl * M3_QP + 16 * h;
    const LAS float* GSh = GS + 4 * h; int tlo = tl - 4 * h; asm volatile("" : "+v"(tlo));
    bf16x8 xs[4][2]; float den = 0.f;
#pragma unroll
    for (int st = 0; st < 4; ++st) {
        if (st <= tt) {
            f32x16 accS = zero16();
            const LAS unsigned char* krow = R2 + (st * 32 + r) * M3_QP + 16 * h;
#pragma unroll 4
            for (int ks = 0; ks < 16; ++ks) { const bf16x8 kf = *(const LAS bf16x8*)(krow + 32 * ks); const bf16x8 qf = *(const LAS bf16x8*)(qrow + 32 * ks); accS = MFMA32(kf, qf, accS); }
            float xv[16];
#pragma unroll
            for (int reg = 0; reg < 16; ++reg) { const int sc = st * 32 + (reg & 3) + 8 * (reg >> 2); float v = accS[reg] * __expf(GSh[sc] - Mt); if (sc > tlo) v = 0.f; xv[reg] = v; den += v; }
#pragma unroll
            for (int k2 = 0; k2 < 2; ++k2) { v4u xw; xw.x = pk2(xv[8 * k2], xv[8 * k2 + 1]); xw.y = pk2(xv[8 * k2 + 2], xv[8 * k2 + 3]); xw.z = pk2(xv[8 * k2 + 4], xv[8 * k2 + 5]); xw.w = pk2(xv[8 * k2 + 6], xv[8 * k2 + 7]);
                xs[st][k2] = __builtin_bit_cast(bf16x8, xw); }
        } else { xs[st][0] = (bf16x8){0, 0, 0, 0, 0, 0, 0, 0}; xs[st][1] = xs[st][0]; }
        asm volatile("" ::: "memory");
    }
    f32x16 accH[4];
#pragma unroll
    for (int i = 0; i < 4; ++i) accH[i] = zero16();
    float qn = 0.f;
#pragma unroll 1
    for (int hf = 0; hf < 2; ++hf) {
        v4u tc[8];
#pragma unroll
        for (int i = 0; i < 8; ++i) { const int p = tid + 512 * i; tc[i] = *(const GAS v4u*)(cbase + (size_t)(p >> 4) * DH + hf * 128 + (p & 15) * 8); }
        __syncthreads();
#pragma unroll
        for (int i = 0; i < 8; ++i) { const int p = tid + 512 * i; *(LAS v4u*)(R2 + (p >> 4) * M3_CP + (p & 15) * 16) = tc[i]; }
        __syncthreads();
        const LAS unsigned char* crow0 = R2 + (eh * 128 + r) * M3_CP + 16 * h;
#pragma unroll 2
        for (int ks = 0; ks < 8; ++ks) {
            const int kg = hf * 8 + ks;
            const v4u qw = *(const LAS v4u*)(qrow + 32 * kg);
            float qv[8] = {bflo(qw.x), bfhi(qw.x), bflo(qw.y), bfhi(qw.y), bflo(qw.z), bfhi(qw.z), bflo(qw.w), bfhi(qw.w)};
            const f32x4 na = *(const LAS f32x4*)(NK + kg * 16 + 8 * h), nb = *(const LAS f32x4*)(NK + kg * 16 + 8 * h + 4);
            qn += (qv[0] * na.x + qv[1] * na.y) + (qv[2] * na.z + qv[3] * na.w) + (qv[4] * nb.x + qv[5] * nb.y) + (qv[6] * nb.z + qv[7] * nb.w);
            v4u q2; q2.x = pk2(qv[0] * winter, qv[1] * winter); q2.y = pk2(qv[2] * winter, qv[3] * winter); q2.z = pk2(qv[4] * winter, qv[5] * winter); q2.w = pk2(qv[6] * winter, qv[7] * winter);
            const bf16x8 q2f = __builtin_bit_cast(bf16x8, q2);
#pragma unroll
            for (int et = 0; et < 4; ++et) { const bf16x8 cf = *(const LAS bf16x8*)(crow0 + et * 32 * M3_CP + 32 * ks); accH[et] = MFMA32(cf, q2f, accH[et]); }
        }
    }
    qn += __shfl_xor(qn, 32);
    {
        v4u tv[8];
#pragma unroll
        for (int i = 0; i < 8; ++i) { const int p = tid + 512 * i; tv[i] = *(const GAS v4u*)(vbase + (size_t)(p >> 4) * M + (p & 15) * 8); }
        __syncthreads();
#pragma unroll
        for (int i = 0; i < 8; ++i) { const int p = tid + 512 * i; LAS unsigned char* d = R2 + (p >> 4) * M3_VP + (p & 15) * 16;
            *(LAS v2u*)d = (v2u){tv[i].x, tv[i].y}; *(LAS v2u*)(d + 8) = (v2u){tv[i].z, tv[i].w}; }
    }
    __syncthreads();
    const LAS unsigned char* vrow0 = R2 + (eh * 128 + r) * M3_VP + 8 * h;
#pragma unroll
    for (int st = 0; st < 4; ++st) if (st <= tt) {
#pragma unroll
        for (int k2 = 0; k2 < 2; ++k2)
#pragma unroll
            for (int et = 0; et < 4; ++et) {
                const LAS unsigned char* vp = vrow0 + et * 32 * M3_VP + (st * 32 + 16 * k2) * 2;
                const v2u lo = *(const LAS v2u*)vp, hi = *(const LAS v2u*)(vp + 16);
                v4u vw; vw.x = lo.x; vw.y = lo.y; vw.z = hi.x; vw.w = hi.y;
                accH[et] = MFMA32(__builtin_bit_cast(bf16x8, vw), xs[st][k2], accH[et]);
                asm volatile("" ::: "memory");
            }
    }
    v4u to[8];
    { const bf16* obase = F.PROJ + (size_t)t0 * NPROJ + C_OM + hh * DH;
#pragma unroll
      for (int i = 0; i < 8; ++i) { const int p = tid + 512 * i; to[i] = *(const GAS v4u*)(obase + (size_t)(p >> 5) * NPROJ + (p & 31) * 8); } }
    den += __shfl_xor(den, 32);
    den += winter * qn;
    const float dnm = fmaxf(fabsf(den), __expf(-(BT[tl] + Mt))), inv = 1.0f / dnm;
    float ss = 0.f;
#pragma unroll
    for (int et = 0; et < 4; ++et)
#pragma unroll
        for (int reg = 0; reg < 16; ++reg) { accH[et][reg] *= inv; ss += accH[et][reg] * accH[et][reg]; }
    ss += __shfl_xor(ss, 32);
    if (h == 0) XCH[eh * 128 + tl] = ss;
#pragma unroll
    for (int i = 0; i < 8; ++i) { const int p = tid + 512 * i; *(LAS v4u*)(QI + (p >> 5) * M3_QP + (p & 31) * 16) = to[i]; }
    __syncthreads();
    const float rstd = 1.0f / sqrtf((XCH[tl] + XCH[128 + tl]) * (1.0f / DH) + EPS);
    LAS unsigned char* orow = QI + tl * M3_QP + (eh * 128 + 4 * h) * 2;
    const float* ngp = F.mlstm_norm_g + hh * DH + eh * 128;
#pragma unroll
    for (int et = 0; et < 4; ++et)
#pragma unroll
        for (int gq = 0; gq < 4; ++gq) { const int el = et * 32 + 8 * gq + 4 * h; LAS v2u* op = (LAS v2u*)(orow + (et * 32 + 8 * gq) * 2);
            const v2u ow = *op; const f32x4 gn = *(const GAS f32x4*)(ngp + el);
            const float y0 = accH[et][4 * gq] * rstd * gn.x * sigmoid_f(bflo(ow.x)), y1 = accH[et][4 * gq + 1] * rstd * gn.y * sigmoid_f(bfhi(ow.x));
            const float y2 = accH[et][4 * gq + 2] * rstd * gn.z * sigmoid_f(bflo(ow.y)), y3 = accH[et][4 * gq + 3] * rstd * gn.w * sigmoid_f(bfhi(ow.y));
            v2u o; o.x = pk2(y0, y1); o.y = pk2(y2, y3); *op = o; }
    __syncthreads();
#pragma unroll
    for (int i = 0; i < 8; ++i) { const int p = tid + 512 * i, row = p >> 5, c16 = p & 31;
        *(GAS v4u*)(F.HA + (size_t)(t0 + row) * D + 1024 + hh * DH + c16 * 8) = *(const LAS v4u*)(QI + row * M3_QP + c16 * 16); }
    __syncthreads();
}
DI void p4_phase(Frame& F) {
    for (int it = (int)blockIdx.x; it < NHEAD * NCHUNK; it += F.G) m3_item(F, it / NCHUNK, it % NCHUNK);
}
constexpr int KPITCH = 272, P8_TBL = 69632;
DI void topk_insert(float (&L)[16], float x) {
#pragma unroll
    for (int i = 15; i >= 1; --i) L[i] = __builtin_amdgcn_fmed3f(x, L[i - 1], L[i]);
    L[0] = fmaxf(L[0], x);
}
DI void p8_phase(Frame& F) {
    LAS unsigned char* KIMG = F.lds; LAS unsigned char* TBL = F.lds + P8_TBL + F.wave * 1024;
    const int lane = F.lane, tid = F.tid, r = lane & 31, h = lane >> 5;
#pragma unroll 4
    for (int i = 0; i < 16; ++i) { const int idx = tid * 4 + 2048 * i, side = idx >> 14, rem = idx & 16383, row = rem >> 7, col = rem & 127;
        const f32x4 a = *(const GAS f32x4*)((side ? F.keys2 : F.keys1) + rem);
        v2u o; o.x = pk2(a.x, a.y); o.y = pk2(a.z, a.w); *(LAS v2u*)(KIMG + (side * 128 + row) * KPITCH + col * 2) = o; }
    __syncthreads();
    for (int it = (int)blockIdx.x; it < (M / 256) * PH; it += F.G) {
        const int tile = it / PH, hd = it % PH;
        const int t = tile * 256 + F.wave * 32 + r;
        float L1[16], L2[16];
#pragma unroll 1
        for (int side = 0; side < 2; ++side) {
            f32x16 acc[4];
#pragma unroll
            for (int kt = 0; kt < 4; ++kt) acc[kt] = zero16();
            const bf16* qp = F.QB + (size_t)t * D + hd * 256 + side * 128 + 8 * h;
#pragma unroll
            for (int ks = 0; ks < 8; ++ks) {
                const bf16x8 qf = *(const GAS bf16x8*)(qp + ks * 16);
#pragma unroll
                for (int kt = 0; kt < 4; ++kt) { const bf16x8 kf = *(const LAS bf16x8*)(KIMG + (side * 128 + kt * 32 + r) * KPITCH + (ks * 16 + 8 * h) * 2); acc[kt] = MFMA32(kf, qf, acc[kt]); }
            }
            float L[16];
#pragma unroll
            for (int i = 0; i < 16; ++i) L[i] = -3.0e38f;
#pragma unroll
            for (int kt = 0; kt < 4; ++kt)
#pragma unroll
                for (int reg = 0; reg < 16; ++reg) { const unsigned key = (unsigned)(kt * 32 + crow(reg, h)); const float sv = acc[kt][reg];
                    topk_insert(L, __uint_as_float((__float_as_uint(sv) & ~127u) | key)); }
            float P[16];
#pragma unroll
            for (int i = 0; i < 16; ++i) P[i] = __shfl_xor(L[i], 32);
#pragma unroll
            for (int i = 0; i < 16; ++i) topk_insert(L, P[i]);
            if (side == 0) {
#pragma unroll
                for (int i = 0; i < 16; ++i) L1[i] = L[i];
            } else {
#pragma unroll
                for (int i = 0; i < 16; ++i) L2[i] = L[i];
            }
        }
        if (h == 0) {
#pragma unroll
            for (int w = 0; w < 4; ++w) {
                const unsigned a = (__builtin_bit_cast(unsigned, L1[4 * w]) & 127u) | ((__builtin_bit_cast(unsigned, L1[4 * w + 1]) & 127u) << 8) | ((__builtin_bit_cast(unsigned, L1[4 * w + 2]) & 127u) << 16) | ((__builtin_bit_cast(unsigned, L1[4 * w + 3]) & 127u) << 24);
                const unsigned b = (__builtin_bit_cast(unsigned, L2[4 * w]) & 127u) | ((__builtin_bit_cast(unsigned, L2[4 * w + 1]) & 127u) << 8) | ((__builtin_bit_cast(unsigned, L2[4 * w + 2]) & 127u) << 16) | ((__builtin_bit_cast(unsigned, L2[4 * w + 3]) & 127u) << 24);
                *(LAS unsigned*)(TBL + r * 32 + 4 * w) = a; *(LAS unsigned*)(TBL + r * 32 + 16 + 4 * w) = b;
            }
        }
        float T[16];
#pragma unroll
        for (int i = 0; i < 16; ++i) T[i] = -3.0e38f;
#pragma unroll
        for (int i = 0; i < 16; ++i) {
            const float v1 = __builtin_bit_cast(float, __builtin_bit_cast(unsigned, L1[i]) & ~127u);
#pragma unroll
            for (int j = 0; j < 16; ++j) if ((i + 1) * (j + 1) <= 16) {
                const float v2 = __builtin_bit_cast(float, __builtin_bit_cast(unsigned, L2[j]) & ~127u);
                topk_insert(T, __builtin_bit_cast(float, (__builtin_bit_cast(unsigned, v1 + v2) & ~255u) | (unsigned)(i * 16 + j)));
            }
        }
        LDS_WAIT(); asm volatile("" ::: "memory");
        float ev[16], esum = 0.f;
        const float mx = __builtin_bit_cast(float, __builtin_bit_cast(unsigned, T[0]) & ~255u);
#pragma unroll
        for (int i = 0; i < 16; ++i) { ev[i] = __expf(__builtin_bit_cast(float, __builtin_bit_cast(unsigned, T[i]) & ~255u) - mx); esum += ev[i]; }
        const float einv = 1.0f / esum;
        int eid[8]; float gt[8];
#pragma unroll
        for (int i = 0; i < 8; ++i) { const float tv = h ? T[8 + i] : T[i]; const float e = h ? ev[8 + i] : ev[i];
            const unsigned p = __builtin_bit_cast(unsigned, tv) & 255u;
            const unsigned i1 = *(const LAS unsigned char*)(TBL + r * 32 + (p >> 4)), i2 = *(const LAS unsigned char*)(TBL + r * 32 + 16 + (p & 15u));
            eid[i] = (int)(i1 * 128u + i2); gt[i] = e * einv; }
        int* ip = F.IDX + (size_t)t * NSEL + hd * 16 + 8 * h; float* gp = F.PG + (size_t)t * NSEL + hd * 16 + 8 * h;
        *(GAS v4u*)ip = (v4u){(unsigned)eid[0], (unsigned)eid[1], (unsigned)eid[2], (unsigned)eid[3]}; *(GAS v4u*)(ip + 4) = (v4u){(unsigned)eid[4], (unsigned)eid[5], (unsigned)eid[6], (unsigned)eid[7]};
        *(GAS f32x4*)gp = (f32x4){gt[0], gt[1], gt[2], gt[3]}; *(GAS f32x4*)(gp + 4) = (f32x4){gt[4], gt[5], gt[6], gt[7]};
        LDS_WAIT(); asm volatile("" ::: "memory");
    }
}
constexpr int P9_IDX = 131072, P9_SH = 147456, P9_CORR = 147712, P9_GF = 32768, P9_FG = 40960, P9_SSQ = 49152, P9_CQ = 65536, P9_CT = 81920, P9_CSQ = 82176, NSLICE = 16, SLICE_B = 128;
#ifndef NSLICE_A
#define NSLICE_A NSLICE
#endif
#ifndef NSLICE_C
#define NSLICE_C NSLICE
#endif
template <int N, int MASK> DI void red_step_i(int (&v)[8], int lane) {
#pragma unroll
    for (int i = 0; i < N / 2; ++i) { const bool up = (lane & MASK) != 0; const int keep = up ? v[i + N / 2] : v[i], send = up ? v[i] : v[i + N / 2]; v[i] = keep + __shfl_xor(send, MASK); }
}
template <int N, int MASK> DI void red_step_f(float (&v)[16], int lane) {
#pragma unroll
    for (int i = 0; i < N / 2; ++i) { const bool up = (lane & MASK) != 0; const float keep = up ? v[i + N / 2] : v[i], send = up ? v[i] : v[i + N / 2]; v[i] = keep + __shfl_xor(send, MASK); }
}
typedef _Float16 h2v __attribute__((ext_vector_type(2)));
DI void acc4(float& o0, float& o1, float& o2, float& o3, unsigned u, float c) {
    const h2v p = __builtin_bit_cast(h2v, __builtin_amdgcn_perm(u, 0x64646464u, 0x01050004u));
    const h2v q = __builtin_bit_cast(h2v, __builtin_amdgcn_perm(u, 0x64646464u, 0x01070006u));
    o0 = __builtin_fmaf((float)p.x, c, o0); o1 = __builtin_fmaf((float)p.y, c, o1); o2 = __builtin_fmaf((float)q.x, c, o2); o3 = __builtin_fmaf((float)q.y, c, o3);
}
template <int N> DI void red32_f(float (&v)[16]) {
#pragma unroll
    for (int i = 0; i < N / 2; ++i) { const auto rr = __builtin_amdgcn_permlane32_swap(__float_as_uint(v[i]), __float_as_uint(v[i + N / 2]), false, false); v[i] = __uint_as_float(rr[0]) + __uint_as_float(rr[1]); }
}
template <int N> DI void red16_f(float (&v)[16]) {
#pragma unroll
    for (int i = 0; i < N / 2; ++i) { const auto rr = __builtin_amdgcn_permlane16_swap(__float_as_uint(v[i]), __float_as_uint(v[i + N / 2]), false, false); v[i] = __uint_as_float(rr[0]) + __uint_as_float(rr[1]); }
}
template <int N> DI void red8_f(float (&v)[16], int lane) {
#pragma unroll
    for (int i = 0; i < N / 2; ++i) { const bool up = (lane & 8) != 0; const float keep = up ? v[i + N / 2] : v[i], send = up ? v[i] : v[i + N / 2];
        v[i] = keep + __builtin_bit_cast(float, __builtin_amdgcn_mov_dpp(__builtin_bit_cast(int, send), 0x128, 0xf, 0xf, true)); }
}
template <int N> DI void redi32(int (&v)[16]) {
#pragma unroll
    for (int i = 0; i < N / 2; ++i) { const auto rr = __builtin_amdgcn_permlane32_swap((unsigned)v[i], (unsigned)v[i + N / 2], false, false); v[i] = (int)(rr[0] + rr[1]); }
}
template <int N> DI void redi16(int (&v)[16]) {
#pragma unroll
    for (int i = 0; i < N / 2; ++i) { const auto rr = __builtin_amdgcn_permlane16_swap((unsigned)v[i], (unsigned)v[i + N / 2], false, false); v[i] = (int)(rr[0] + rr[1]); }
}
template <int N> DI void redi8(int (&v)[16], int lane) {
#pragma unroll
    for (int i = 0; i < N / 2; ++i) { const bool up = (lane & 8) != 0; const int keep = up ? v[i + N / 2] : v[i], send = up ? v[i] : v[i + N / 2]; v[i] = keep + __builtin_amdgcn_mov_dpp(send, 0x128, 0xf, 0xf, true); }
}
DI void p9v2_phase(Frame& F) {
    LAS unsigned char* HQ = F.lds; LAS float* A2 = (LAS float*)(F.lds + P9_IDX); LAS float* B2 = (LAS float*)(F.lds + P9_IDX + 8192);
    LAS unsigned short* IDX16 = (LAS unsigned short*)(F.lds + P9_IDX); LAS float* SH = (LAS float*)(F.lds + P9_SH); LAS float* CORR = (LAS float*)(F.lds + P9_CORR);
    LAS float* GF = (LAS float*)(F.lds + P9_GF); LAS float* FG = (LAS float*)(F.lds + P9_FG);
    const int lane = F.lane, tid = F.tid, c8 = lane & 7, g = lane >> 3;
#pragma unroll 1
    for (int tb = (int)blockIdx.x * 64; tb < M; tb += F.G * 64) {
#pragma unroll
        for (int i = 0; i < 4; ++i) { const int c = tid + 512 * i; A2[c] = F.norm_ffn_g[c] * (1.0f + F.MODF[MOD_SCF + c]); B2[c] = F.MODF[MOD_SHF + c]; }
        __syncthreads();
#pragma unroll 1
        for (int j = 0; j < 8; ++j) {
            const int tl = F.wave * 8 + j, t = tb + tl;
            float hv[32]; float ss = 0.f;
            const bf16* xr = F.X1B + (size_t)t * D + 16 * lane;
#pragma unroll
            for (int jj = 0; jj < 2; ++jj)
#pragma unroll
                for (int q = 0; q < 2; ++q) { const v4u a = *(const GAS v4u*)(xr + 1024 * jj + 8 * q); const int o = 16 * jj + 8 * q;
                    hv[o] = bflo(a.x); hv[o + 1] = bfhi(a.x); hv[o + 2] = bflo(a.y); hv[o + 3] = bfhi(a.y); hv[o + 4] = bflo(a.z); hv[o + 5] = bfhi(a.z); hv[o + 6] = bflo(a.w); hv[o + 7] = bfhi(a.w); }
#pragma unroll
            for (int i = 0; i < 32; ++i) ss += hv[i] * hv[i];
            const float rstd = 1.0f / sqrtf(wave_sum(ss) * (1.0f / D) + EPS);
            float am = 0.f;
#pragma unroll
            for (int jj = 0; jj < 2; ++jj)
#pragma unroll
                for (int q = 0; q < 4; ++q) { const f32x4 a = *(const LAS f32x4*)(A2 + 1024 * jj + 16 * lane + 4 * q), b = *(const LAS f32x4*)(B2 + 1024 * jj + 16 * lane + 4 * q);
                    const int o = 16 * jj + 4 * q;
                    hv[o] = hv[o] * rstd * a.x + b.x; hv[o + 1] = hv[o + 1] * rstd * a.y + b.y; hv[o + 2] = hv[o + 2] * rstd * a.z + b.z; hv[o + 3] = hv[o + 3] * rstd * a.w + b.w;
                    am = fmaxf(am, fmaxf(fmaxf(fabsf(hv[o]), fabsf(hv[o + 1])), fmaxf(fabsf(hv[o + 2]), fabsf(hv[o + 3])))); }
            am = fmaxf(wave_max(am), 1e-30f); const float inv = 127.0f / am;
            if (lane == 0) SH[tl] = am * (1.0f / 127.0f);
#pragma unroll
            for (int jj = 0; jj < 2; ++jj) { v4u o;
#pragma unroll
                for (int q = 0; q < 4; ++q) { const int b = 16 * jj + 4 * q;
                    const int q0 = (int)__builtin_rintf(hv[b] * inv), q1 = (int)__builtin_rintf(hv[b + 1] * inv), q2 = (int)__builtin_rintf(hv[b + 2] * inv), q3 = (int)__builtin_rintf(hv[b + 3] * inv);
                    o[q] = (unsigned)(q0 & 255) | ((unsigned)(q1 & 255) << 8) | ((unsigned)(q2 & 255) << 16) | ((unsigned)(q3 & 255) << 24); }
                *(LAS v4u*)(HQ + tl * 2048 + 1024 * jj + 16 * lane) = o; }
        }
        __syncthreads();
#pragma unroll
        for (int i = 0; i < 16; ++i) { const int q = tid + 512 * i, k = q & 127; IDX16[(q & ~127) + (k & 64) + 8 * (k & 7) + ((k >> 3) & 7)] = (unsigned short)F.IDX[(size_t)tb * NSEL + q]; }
        __syncthreads();
        int P[8][2];
#pragma unroll
        for (int j = 0; j < 8; ++j) { P[j][0] = 0; P[j][1] = 0; }
#pragma unroll 1
        for (int s = 0; s < NSLICE_A; ++s) {
            if (((s ^ (F.wave >> 2)) & 1) != 0) __builtin_amdgcn_s_setprio(1); else __builtin_amdgcn_s_setprio(0);
            const unsigned char* eb = F.ED + s * SLICE_B;
            const unsigned lo = (unsigned)(c8 * 16);
            v4u wA[8], wB[8];
#define P9A_LOAD(W, J, H) do { _Pragma("unroll") for (int i = 0; i < 8; ++i) { const unsigned e = IDX16[(F.wave * 8 + (J)) * 128 + 64 * (H) + 8 * g + i]; W[i] = *(const GAS v4u*)(eb + (e * 2048u + lo)); } } while (0)
#define P9A_COMP(W, J, H) do { const v4u hq = *(const LAS v4u*)(HQ + (F.wave * 8 + (J)) * 2048 + s * SLICE_B + c8 * 16); int a[8]; \
                _Pragma("unroll") for (int i = 0; i < 8; ++i) { int d = 0; const v4u ww = W[i]; \
                    d = __builtin_amdgcn_sdot4((int)hq.x, (int)ww.x, d, false); d = __builtin_amdgcn_sdot4((int)hq.y, (int)ww.y, d, false); d = __builtin_amdgcn_sdot4((int)hq.z, (int)ww.z, d, false); d = __builtin_amdgcn_sdot4((int)hq.w, (int)ww.w, d, false); a[i] = d; } \
                red_step_i<8, 4>(a, lane); red_step_i<4, 2>(a, lane); red_step_i<2, 1>(a, lane); P[J][H] += a[0]; asm volatile("" ::: "memory"); } while (0)
            P9A_LOAD(wA, 0, 0);
#pragma unroll
            for (int j = 0; j < 8; ++j) {
                P9A_LOAD(wB, j, 1);
                P9A_COMP(wA, j, 0);
                if (j < 7) P9A_LOAD(wA, j + 1, 0);
                P9A_COMP(wB, j, 1);
            }
#undef P9A_LOAD
#undef P9A_COMP
        }
        __builtin_amdgcn_s_setprio(0);
        __syncthreads();
        LAS int* PI = (LAS int*)F.lds;
#pragma unroll
        for (int j = 0; j < 8; ++j) { const int tl = F.wave * 8 + j; PI[tl * 128 + 8 * c8 + g] = P[j][0]; PI[tl * 128 + 64 + 8 * c8 + g] = P[j][1]; }
#pragma unroll
        for (int i = 0; i < 4; ++i) { const int c = tid + 512 * i; GF[c] = F.MODF[MOD_GF + c]; FG[c] = F.final_g[c]; }
        LAS float* SSQL = (LAS float*)(F.lds + P9_SSQ); LAS short* CQ = (LAS short*)(F.lds + P9_CQ); LAS float* CT = (LAS float*)(F.lds + P9_CT); LAS int* CSQ = (LAS int*)(F.lds + P9_CSQ);
#pragma unroll 1
        for (int j = 0; j < 8; ++j) { const int tl = F.wave * 8 + j, t = tb + tl; const float sh = SH[tl]; float cf[2]; float am = 0.f;
#pragma unroll
            for (int h = 0; h < 2; ++h) { const int k = 64 * h + lane; const unsigned e = IDX16[tl * 128 + 64 * h + 8 * (lane & 7) + (lane >> 3)];
                const float act = (float)PI[tl * 128 + k] * (sh * F.SD[e]); cf[h] = F.PG[(size_t)t * NSEL + k] * gelu_f(act) * F.SU[e]; am = fmaxf(am, fabsf(cf[h])); }
            am = fmaxf(wave_max(am), 1e-30f); const float inv = 32767.0f / am; int qs = 0;
#pragma unroll
            for (int h = 0; h < 2; ++h) { const int q = (int)__builtin_rintf(cf[h] * inv); qs += q; CQ[tl * 128 + 64 * h + 8 * (lane & 7) + (lane >> 3)] = (short)q; }
#pragma unroll
            for (int o = 1; o < 64; o <<= 1) qs += __shfl_xor(qs, o);
            if (lane == 0) { CT[tl] = am * (1.0f / 32767.0f); CSQ[tl] = 128 * qs; }
            SSQL[tl * 64 + lane] = 0.f; }
        __syncthreads();
        const int cb = c8 * 16 + ((lane >> 5) & 1) * 8 + ((lane >> 4) & 1) * 4 + ((lane >> 3) & 1) * 2;
        typedef short s16x2 __attribute__((ext_vector_type(2)));
#pragma unroll 1
        for (int s = 0; s < NSLICE_C; ++s) {
            if (((s ^ (F.wave >> 2)) & 1) != 0) __builtin_amdgcn_s_setprio(1); else __builtin_amdgcn_s_setprio(0);
            const unsigned char* eb = F.EU + s * SLICE_B;
            const unsigned lo = (unsigned)(c8 * 16);
            v4u wA[8], wB[8]; unsigned cA[4], cB[4];
#define P9C_LOAD(W, C, TL, H) do { const LAS unsigned* ip = (const LAS unsigned*)(IDX16 + (TL) * 128 + 64 * (H) + 8 * g); const LAS unsigned* cp = (const LAS unsigned*)(CQ + (TL) * 128 + 64 * (H) + 8 * g); \
                _Pragma("unroll") for (int i2 = 0; i2 < 4; ++i2) { const unsigned ee = ip[i2]; C[i2] = cp[i2]; \
                    W[2 * i2] = *(const GAS v4u*)(eb + ((ee & 0xffffu) * 2048u + lo)); W[2 * i2 + 1] = *(const GAS v4u*)(eb + ((ee >> 16) * 2048u + lo)); } } while (0)
#define P9C_D4(O, UA, UB, CC) do { O[0] = __builtin_amdgcn_sdot2(__builtin_bit_cast(s16x2, __builtin_amdgcn_perm(UB, UA, 0x0c040c00u)), __builtin_bit_cast(s16x2, CC), O[0], false); \
                O[1] = __builtin_amdgcn_sdot2(__builtin_bit_cast(s16x2, __builtin_amdgcn_perm(UB, UA, 0x0c050c01u)), __builtin_bit_cast(s16x2, CC), O[1], false); \
                O[2] = __builtin_amdgcn_sdot2(__builtin_bit_cast(s16x2, __builtin_amdgcn_perm(UB, UA, 0x0c060c02u)), __builtin_bit_cast(s16x2, CC), O[2], false); \
                O[3] = __builtin_amdgcn_sdot2(__builtin_bit_cast(s16x2, __builtin_amdgcn_perm(UB, UA, 0x0c070c03u)), __builtin_bit_cast(s16x2, CC), O[3], false); } while (0)
#define P9C_ACC(W, C) do { _Pragma("unroll") for (int i2 = 0; i2 < 4; ++i2) { const v4u ua = W[2 * i2], ub = W[2 * i2 + 1]; const unsigned cc = C[i2]; \
                P9C_D4((o + 0), ua.x, ub.x, cc); P9C_D4((o + 4), ua.y, ub.y, cc); P9C_D4((o + 8), ua.z, ub.z, cc); P9C_D4((o + 12), ua.w, ub.w, cc); } asm volatile("" ::: "memory"); } while (0)
            P9C_LOAD(wA, cA, F.wave * 8, 0);
#pragma unroll 1
            for (int j = 0; j < 8; ++j) {
                const int tl = F.wave * 8 + j, t = tb + tl;
                int o[16];
#pragma unroll
                for (int b = 0; b < 16; ++b) o[b] = 0;
                P9C_LOAD(wB, cB, tl, 1);
                P9C_ACC(wA, cA);
                if (j < 7) P9C_LOAD(wA, cA, tl + 1, 0);
                P9C_ACC(wB, cB);
                redi32<16>(o); redi16<8>(o); redi8<4>(o, lane);
                const int col = s * SLICE_B + cb; const int csq = CSQ[tl]; const float ct = CT[tl];
                GAS unsigned* xp = (GAS unsigned*)(F.X1B + (size_t)t * D + col);
                const unsigned xw = *xp;
                const float y0 = bflo(xw) + GF[col] * ((float)(o[0] - csq) * ct), y1 = bfhi(xw) + GF[col + 1] * ((float)(o[1] - csq) * ct);
                const unsigned yw = pk2(y0, y1); const float r0 = bflo(yw), r1 = bfhi(yw);
                SSQL[tl * 64 + lane] += r0 * r0 + r1 * r1;
                *xp = yw;
            }
#undef P9C_LOAD
#undef P9C_ACC
#undef P9C_D4
        }
        __builtin_amdgcn_s_setprio(0);
#pragma unroll 1
        for (int j = 0; j < 8; ++j) {
            const int tl = F.wave * 8 + j, t = tb + tl;
            const float rstd2 = 1.0f / sqrtf(wave_sum(SSQL[tl * 64 + lane]) * (1.0f / D) + EPS);
            const GAS v2u* xrow = (const GAS v2u*)(F.X1B + (size_t)t * D) + lane; GAS f32x4* orow = (GAS f32x4*)(F.out + (size_t)t * D) + lane;
#pragma unroll
            for (int q = 0; q < 8; ++q) { const v2u w = xrow[64 * q]; const f32x4 f = *(const LAS f32x4*)(FG + 256 * q + 4 * lane);
                orow[64 * q] = (f32x4){bflo(w.x) * rstd2 * f.x, bfhi(w.x) * rstd2 * f.y, bflo(w.y) * rstd2 * f.z, bfhi(w.y) * rstd2 * f.w}; }
        }
        __syncthreads();
    }
}
struct Args { const float* in[21]; float* out; unsigned char* ws; int ph_lo, ph_hi, li, pad; };
constexpr int N_PHASES = 10;
__global__ void __launch_bounds__(NWAVES * 64, 2) mk_fwd(Args args) {
    extern __shared__ __attribute__((aligned(16))) unsigned char lds[];
    Frame F;
    F.lds = (LAS unsigned char*)lds;
    F.MISC = (volatile LAS unsigned*)(F.lds + MISC_OFF);
    F.tid = threadIdx.x; F.lane = F.tid & 63; F.wave = __builtin_amdgcn_readfirstlane(F.tid >> 6);
    F.G = gridDim.x; { const int bx = blockIdx.x; F.vcu = (F.G % 8 == 0) ? (bx % 8) * (F.G / 8) + bx / 8 : bx; }
    unsigned char* ws = args.ws;
    F.ctl = (gu32*)(ws + WS_CTL);
    F.x = args.in[0]; F.c = args.in[1]; F.ada_w = args.in[2]; F.ada_b = args.in[3]; F.norm_mix_g = args.in[4]; F.w_in = args.in[5]; F.b_gates = args.in[6];
    F.conv_w = args.in[7]; F.conv_b = args.in[8]; F.gmlp_norm_g = args.in[9]; F.gmlp_w = args.in[10]; F.gmlp_b = args.in[11]; F.mlstm_norm_g = args.in[12];
    F.w_out = args.in[13]; F.norm_ffn_g = args.in[14]; F.wq = args.in[15]; F.keys1 = args.in[16]; F.keys2 = args.in[17]; F.e_down = args.in[18]; F.e_up = args.in[19]; F.final_g = args.in[20];
    F.out = args.out;
    F.MODP = (float*)(ws + WS_MODP); F.MODF = (float*)(ws + WS_MODF); F.GATES = (float*)(ws + WS_GATES); F.SUMM = (float*)(ws + WS_SUMM); F.MTAB = (float*)(ws + WS_MTAB);
    F.NST = (float*)(ws + WS_NST); F.PG = (float*)(ws + WS_PG); F.IDX = (int*)(ws + WS_IDX);
    F.WIN = (bf16*)(ws + WS_WIN); F.WOUT = (bf16*)(ws + WS_WOUT); F.WQ = (bf16*)(ws + WS_WQ); F.HA = (bf16*)(ws + WS_HA); F.PROJ = (bf16*)(ws + WS_PROJ); F.QB = (bf16*)(ws + WS_PROJ);
    F.STATE = (bf16*)(ws + WS_STATE); F.VT = (bf16*)(ws + WS_VT); F.ED = ws + WS_ED; F.EU = ws + WS_EU; F.SD = (float*)(ws + WS_SD); F.SU = (float*)(ws + WS_SU);
    F.H1Q = ws + WS_STATE;
    F.SW = (float*)(ws + WS_SW); F.CMAXP = (float*)(ws + WS_CMAXP); F.SA = (float*)(ws + WS_SA);
    F.SSQP = (float*)(ws + WS_SSQP); F.BQP = (float*)(ws + WS_BQP); F.BIASQ = (float*)(ws + WS_BIASQ); F.X1B = (bf16*)(ws + WS_STATE);
    F.QC = (bf16*)args.out; F.KC = (bf16*)args.out + (size_t)M * 1024;
    for (int u = F.tid; u < (LDS_BYTES - LDSCTL_OFF) / 4; u += NWAVES * 64) ((LAS unsigned*)(F.lds + LDSCTL_OFF))[u] = 0u;
    __syncthreads();
    const int lo = args.ph_lo, hi = args.ph_hi;
    const bool multi = (hi - lo) > 1;
    XcdBarrier bar; bar.bar = (unsigned*)(F.ctl + CW_BAR) + args.li * XCD_BAR_WORDS; bar.x = 0; bar.st = nullptr;
    if (multi) bar = xcd_barrier_post((unsigned*)(F.ctl + CW_BAR) + args.li * XCD_BAR_WORDS, F.MISC + 8);
#ifndef PH_MASK
#define PH_MASK 0x7ff
#endif
#define IN(k) (((PH_MASK >> (k)) & 1) && lo <= (k) && (k) < hi)
#define SEAM(k) do { if (IN(k) && IN((k) + 1)) xcd_barrier(bar); } while (0)
    if (IN(0)) { p0a_phase(F); } SEAM(0);
    if (IN(1)) { p0b_phase(F); } SEAM(1);
    if (IN(2)) {
        { pg8::Gemm g{(const pg8::bf16_t*)F.H1Q, F.WIN, M, NPROJ, D / 2}; pg8::StaticOrder S; S.init(M, NPROJ, F.G, (int)blockIdx.x);
          pg8::EpiQ8 E{F.PROJ, NPROJ, 2048 / 256, F.SA, F.SW};
          pg8::gemm_phase<pg8::EpiQ8, pg8::StaticOrder, PG8_ALIGN, PG8_SP2, true>(F.lds, g, S, E); }
        {
          pg8::Gemm g{(const pg8::bf16_t*)((const unsigned char*)F.WIN + (size_t)WROW_VM * D), (const pg8::bf16_t*)F.H1Q, 1024, M, D / 2}; pg8::StaticOrder S; S.init(1024, M, F.G, (int)blockIdx.x);
          pg8::EpiQ8 E{F.VT, M, 0, F.SW + WROW_VM, F.SA};
          pg8::gemm_phase<pg8::EpiQ8, pg8::StaticOrder, PG8_ALIGN, PG8_SP2, true>(F.lds, g, S, E); }
    } SEAM(2);
    if (IN(3)) { p2_phase(F); } SEAM(3);
    if (IN(4)) { p3_phase(F); } SEAM(4);
    if (IN(5)) { p4_phase(F); } SEAM(5);
    if (IN(6)) {
        pg8::Gemm g{F.HA, F.WOUT, M, D, D}; pg8::StaticOrder S; S.init(M, D, F.G, (int)blockIdx.x);
        pg8::EpiResid2 E{F.x, F.MODF + MOD_GM, F.X1B, F.SSQP, D};
        pg8::gemm_phase<pg8::EpiResid2, pg8::StaticOrder, PG8_ALIGN, PG8_SP2>(F.lds, g, S, E);
    } SEAM(6);
    if (IN(7)) {
        pg8::Gemm g{F.X1B, F.WQ, M, D, D}; pg8::StaticOrder S; S.init(M, D, F.G, (int)blockIdx.x);
        LAS float* RSTDL = (LAS float*)(F.lds + RING_BYTES);
        { pg8::Unit u; for (int i = 0; S.next(i, u); ++i) { if (F.tid < 256) { const float* sp = F.SSQP + (size_t)(u.pm * 256 + F.tid) * 32; float ss = 0.f;
#pragma unroll
                    for (int q = 0; q < 8; ++q) { const f32x4 v = *(const GAS f32x4*)(sp + 4 * q); ss += (v.x + v.y) + (v.z + v.w); }
                    RSTDL[(u.pm & 1) * 256 + F.tid] = 1.0f / sqrtf(ss * (1.0f / D) + EPS); } } }
        __syncthreads();
        pg8::EpiQ E{F.QB, D, F.BIASQ, RSTDL};
        pg8::gemm_phase<pg8::EpiQ, pg8::StaticOrder, PG8_ALIGN, PG8_SP2>(F.lds, g, S, E);
    } SEAM(7);
#ifndef P8_ALT
#define P8_ALT 0
#endif
    if (IN(8)) { p8_phase(F); } SEAM(8);
#ifndef P9_V2
#define P9_V2 1
#endif
    if (IN(9)) { p9v2_phase(F); }
#undef IN
#undef SEAM
}

#ifndef MK_N_LAUNCHES
#define MK_N_LAUNCHES 1
#endif
extern "C" void kernel_launch(void* const* d_in, const int* in_sizes, int n_in, void* d_out, int out_size, void* d_ws, size_t ws_size, hipStream_t stream) {
    static int grid = 0;
    if (grid == 0) {
        if (n_in != 21 || in_sizes[0] != M * D || out_size != M * D || ws_size < WS_END) { fprintf(stderr, "kernel_launch: unexpected shapes (n_in %d, in0 %d, out %d, ws %zu); nothing launched\n", n_in, n_in > 0 ? in_sizes[0] : -1, out_size, ws_size); grid = -1; return; }
        int dev = 0, cus = 0, per_cu = 0;
        if (hipGetDevice(&dev) != hipSuccess || hipDeviceGetAttribute(&cus, hipDeviceAttributeMultiprocessorCount, dev) != hipSuccess) { grid = -1; return; }
        if (hipFuncSetAttribute((const void*)mk_fwd, hipFuncAttributeMaxDynamicSharedMemorySize, LDS_BYTES) != hipSuccess) { fprintf(stderr, "kernel_launch: hipFuncSetAttribute failed\n"); grid = -1; return; }
        if (hipOccupancyMaxActiveBlocksPerMultiprocessor(&per_cu, (const void*)mk_fwd, NWAVES * 64, LDS_BYTES) != hipSuccess || per_cu < 1) { fprintf(stderr, "kernel_launch: occupancy query says %d blocks per CU\n", per_cu); }
        (void)hipGetLastError();
        grid = cus;
    }
    if (grid < 0) return;
    (void)hipMemsetAsync((char*)d_ws + WS_CTL, 0, CTL_ZERO_BYTES, stream);
    Args a{};
    for (int i = 0; i < 21; ++i) a.in[i] = (const float*)d_in[i];
    a.out = (float*)d_out; a.ws = (unsigned char*)d_ws;
    if (MK_N_LAUNCHES == 1) { a.ph_lo = 0; a.ph_hi = N_PHASES; a.li = 0; hipLaunchKernelGGL(mk_fwd, dim3(grid), dim3(NWAVES * 64), LDS_BYTES, stream, a); }
    else for (int li = 0; li < N_PHASES; ++li) { a.ph_lo = li; a.ph_hi = li + 1; a.li = 0; hipLaunchKernelGGL(mk_fwd, dim3(grid), dim3(NWAVES * 64), LDS_BYTES, stream, a); }
}
```

```cpp
#include <hip/hip_runtime.h>
#include <cstdio>
#include <cstdint>
namespace pg8 {
#define PG8_LAS __attribute__((address_space(3)))
typedef unsigned short bf16_t;
typedef short bf16x8 __attribute__((ext_vector_type(8)));
typedef float f32x4 __attribute__((ext_vector_type(4)));
typedef unsigned u32x4 __attribute__((ext_vector_type(4)));
constexpr int BM = 256, BK = 64, HALF = 128, HTB = HALF * BK * 2  , STAGE_BYTES = 8 * HTB, NXCD = 8, WGM = 8;

__host__ __device__ __forceinline__ int lds_byte(int r, int c) { const int st = (r >> 4) * 2 + (c >> 5), rr = r & 15, cc = c & 31, ob = rr * 64 + cc * 2; return st * 1024 + (ob ^ (((ob >> 9) & 1) << 5)); }
__host__ __device__ __forceinline__ void stage_rc(int b, int& R, int& C) { const int st = b / 1024, sb = b % 1024, swz = sb ^ (((sb >> 9) & 1) << 5); R = (st >> 1) * 16 + swz / 64; C = (st & 1) * 32 + (swz % 64) / 2; }
__host__ __device__ __forceinline__ int perm32(int rho) { const int n = rho >> 4, i = rho & 15; return 8 * (i >> 2) + 4 * n + (i & 3); }

struct Unit { int pm, pn; };
struct Gemm { const bf16_t* A; const bf16_t* Bt; int M, N, K; };

struct StaticOrder {
    int nM, nN, nwg, G, c;
    __host__ __device__ void init(int M, int N, int G_, int c_) { nM = M / BM; nN = N / BM; nwg = nM * nN; G = G_; c = c_; }
    __host__ __device__ bool next(int i, Unit& u) const {
        const long L = (long)i * G + c; if (L >= nwg) return false;
        int wgid = (int)L; { const int q = nwg / NXCD, r = nwg % NXCD, xcd = wgid % NXCD, off = wgid / NXCD; wgid = (xcd < r ? xcd * (q + 1) : r * (q + 1) + (xcd - r) * q) + off; }
        const int nig = WGM * nN, gid = wgid / nig, fm = gid * WGM, gsz = (nM - fm) < WGM ? (nM - fm) : WGM;
        u.pm = fm + ((wgid % nig) % gsz); u.pn = (wgid % nig) / gsz; return true;
    }
    __device__ __forceinline__ void a_ready(const Unit&) const {}
    __device__ __forceinline__ void done(const Unit&) const {}
};

__device__ __forceinline__ unsigned cvt_pk_bf16(float lo, float hi) { unsigned r; asm volatile("v_cvt_pk_bf16_f32 %0, %1, %2" : "=v"(r) : "v"(lo), "v"(hi)); return r; }
typedef float f32x2 __attribute__((ext_vector_type(2)));
__device__ __forceinline__ f32x2 gelu_pk(f32x2 v) {
    const f32x2 av = __builtin_elementwise_abs(v), d = av * 0.2316418882f + 1.0f;
    f32x2 t; t.x = __builtin_amdgcn_rcpf(d.x); t.y = __builtin_amdgcn_rcpf(d.y);
    f32x2 q = t * 0.5307027145f + (-0.7265760135f); q = q * t + 0.7107068705f; q = q * t + (-0.142248368f); q = q * t + 0.127414796f; q = q * t;
    const f32x2 s = (v * v) * (-0.72134752044f);
    f32x2 e; e.x = __builtin_amdgcn_exp2f(s.x); e.y = __builtin_amdgcn_exp2f(s.y);
    const f32x2 m = v * (q * e), r = v - m;
    f32x2 o; o.x = v.x < 0.f ? m.x : r.x; o.y = v.y < 0.f ? m.y : r.y; return o;
}

template <int ACT  > struct EpiBf16 {
    static constexpr bool PERM = true, AFTER_DRAIN = false; static_assert(ACT == 0 || ACT == 1, "EpiBf16: ACT is 0 (none) or 1 (gelu_pk)");
    bf16_t* O; int ldc; const float* bias; int split_cols; size_t split_stride; float scale0;
    __device__ __forceinline__ void operator()(const f32x4 (&acc)[2][2][4][2], const Unit& u, int wr, int wc, int fr, int fq) const {
        const int row0 = u.pm * BM + wr * 64 + fr; int colt = u.pn * BM; bf16_t* base = O;
        float sc = 1.f; if (split_cols) { const int t = colt / split_cols; base += (size_t)t * split_stride; colt -= t * split_cols; if (t == 0) sc = scale0; }
        const int col0 = colt + wc * 32 + 8 * fq, bcol0 = u.pn * BM + wc * 32 + 8 * fq;
        f32x4 bv[2][2];
#pragma unroll
        for (int bj = 0; bj < 2; ++bj)
#pragma unroll
            for (int n = 0; n < 2; ++n) bv[bj][n] = bias ? *(const f32x4*)(bias + bcol0 + bj * HALF + 4 * n) : (f32x4){0.f, 0.f, 0.f, 0.f};
#pragma unroll
        for (int ai = 0; ai < 2; ++ai)
#pragma unroll
            for (int m = 0; m < 4; ++m) { bf16_t* rowp = base + (size_t)(row0 + ai * HALF + m * 16) * ldc + col0;
#pragma unroll
                for (int bj = 0; bj < 2; ++bj) { f32x4 v0 = acc[ai][bj][m][0] + bv[bj][0], v1 = acc[ai][bj][m][1] + bv[bj][1];
                    if (ACT == 1) { f32x2 a = gelu_pk((f32x2){v0[0], v0[1]}), b = gelu_pk((f32x2){v0[2], v0[3]}), c = gelu_pk((f32x2){v1[0], v1[1]}), d = gelu_pk((f32x2){v1[2], v1[3]});
                        v0 = (f32x4){a.x, a.y, b.x, b.y}; v1 = (f32x4){c.x, c.y, d.x, d.y}; }
                    v0 = v0 * sc; v1 = v1 * sc; u32x4 w; w.x = cvt_pk_bf16(v0[0], v0[1]); w.y = cvt_pk_bf16(v0[2], v0[3]); w.z = cvt_pk_bf16(v1[0], v1[1]); w.w = cvt_pk_bf16(v1[2], v1[3]);
                    *(u32x4*)(rowp + bj * HALF) = w; } }
    }
};

typedef int i32x4 __attribute__((ext_vector_type(4)));
template <bool I8> __device__ __forceinline__ f32x4 mma16(bf16x8 a, bf16x8 b, f32x4 c) {
    if constexpr (I8) return __builtin_bit_cast(f32x4, __builtin_amdgcn_mfma_i32_16x16x64_i8(__builtin_bit_cast(i32x4, a), __builtin_bit_cast(i32x4, b), __builtin_bit_cast(i32x4, c), 0, 0, 0));
    else return __builtin_amdgcn_mfma_f32_16x16x32_bf16(a, b, c, 0, 0, 0);
}
template <class Epi, class Sched, bool ALIGN_EPI = false, bool SP2 = false, bool I8 = false>
__device__ __forceinline__ void gemm_phase(PG8_LAS unsigned char* lds, const Gemm g, const Sched& S, const Epi& E) {
    const int tid = threadIdx.x, wid = __builtin_amdgcn_readfirstlane(tid >> 6), lane = tid & 63, wr = wid >> 2, wc = wid & 3, fr = lane & 15, fq = lane >> 4;
    const int K = g.K, nt = K / BK;
    unsigned voffA[2], voffB[2];
#pragma unroll
    for (int i = 0; i < 2; ++i) { int R, C; stage_rc(tid * 16 + i * 8192, R, C); const int Rb = Epi::PERM ? ((R & ~31) + perm32(R & 31)) : R;
        voffA[i] = (unsigned)(R * K + C) * 2u; voffB[i] = (unsigned)(Rb * K + C) * 2u; }
    const size_t kstep = (size_t)(BK * 2);
    const size_t hstep = (size_t)HALF * K * 2;
    const size_t tstep = 2 * hstep;
    const unsigned ldsw = (unsigned)wid * 1024u;
    const int aoff = lds_byte(wr * 64 + fr, fq * 8), boff = lds_byte(wc * 32 + fr, fq * 8);
#define PG8_SA(b, h) (((b) * 2 + (h)) * HTB)
#define PG8_SB(b, h) ((4 + (b) * 2 + (h)) * HTB)
#define PG8_STAGE(bufoff, gbase, voff) do { _Pragma("unroll") for (int _i = 0; _i < 2; ++_i) \
        __builtin_amdgcn_global_load_lds((const unsigned*)((const char*)(gbase) + (voff)[_i]), (PG8_LAS unsigned*)(lds + (bufoff) + ldsw + _i * 8192), 16, 0, 0); } while (0)
#define PG8_LDA(dst, b, h) do { _Pragma("unroll") for (int m = 0; m < 4; ++m) _Pragma("unroll") for (int k = 0; k < 2; ++k) dst[m][k] = *(const PG8_LAS bf16x8*)(lds + PG8_SA(b, h) + aoff + m * 2048 + k * 1024); } while (0)
#define PG8_LDB(dst, b, h) do { _Pragma("unroll") for (int n = 0; n < 2; ++n) _Pragma("unroll") for (int k = 0; k < 2; ++k) dst[n][k] = *(const PG8_LAS bf16x8*)(lds + PG8_SB(b, h) + boff + n * 2048 + k * 1024); } while (0)
#define PG8_MMA(ai, bj, At, Bt) do { __builtin_amdgcn_s_setprio(1); _Pragma("unroll") for (int m = 0; m < 4; ++m) _Pragma("unroll") for (int n = 0; n < 2; ++n) _Pragma("unroll") for (int k = 0; k < 2; ++k) \
        acc[ai][bj][m][n] = mma16<I8>(Bt[n][k], At[m][k], acc[ai][bj][m][n]); __builtin_amdgcn_s_setprio(0); } while (0)
#define PG8_WAIT_V(n) asm volatile("s_waitcnt vmcnt(" #n ")" ::: "memory")
#define PG8_WAIT_L(n) asm volatile("s_waitcnt lgkmcnt(" #n ")" ::: "memory")
#define PG8_BAR __builtin_amdgcn_s_barrier()
#define PG8_SCHED __builtin_amdgcn_sched_barrier(0)
    Unit cur, nxt; int ui = 0;
    if (!S.next(0, cur)) return;
    f32x4 acc[2][2][4][2];
#pragma unroll
    for (int a = 0; a < 2; ++a)
#pragma unroll
        for (int b = 0; b < 2; ++b)
#pragma unroll
            for (int m = 0; m < 4; ++m)
#pragma unroll
                for (int n = 0; n < 2; ++n) acc[a][b][m][n] = (f32x4){0.f, 0.f, 0.f, 0.f};
    bf16x8 At[4][2], B0[2][2], B1[2][2];
    const char* cA = (const char*)g.A + (size_t)cur.pm * tstep; const char* cB = (const char*)g.Bt + (size_t)cur.pn * tstep;
    S.a_ready(cur);
    if constexpr (SP2) {
        PG8_STAGE(PG8_SB(0, 0), cB, voffB); PG8_STAGE(PG8_SB(0, 1), cB + hstep, voffB); PG8_STAGE(PG8_SA(0, 0), cA, voffA); PG8_STAGE(PG8_SA(0, 1), cA + hstep, voffA);
        if (wr == 1) PG8_BAR;
        PG8_WAIT_V(2); PG8_BAR;
        PG8_STAGE(PG8_SB(1, 0), cB + kstep, voffB); PG8_STAGE(PG8_SA(1, 0), cA + kstep, voffA); PG8_STAGE(PG8_SB(1, 1), cB + hstep + kstep, voffB);
        PG8_WAIT_V(6); PG8_BAR;
    } else {
        PG8_STAGE(PG8_SB(0, 0), cB, voffB); PG8_STAGE(PG8_SA(0, 0), cA, voffA); PG8_STAGE(PG8_SB(0, 1), cB + hstep, voffB); PG8_STAGE(PG8_SA(0, 1), cA + hstep, voffA);
        if (wr == 1) PG8_BAR;
        PG8_WAIT_V(4); PG8_BAR;
        PG8_STAGE(PG8_SB(1, 0), cB + kstep, voffB); PG8_STAGE(PG8_SA(1, 0), cA + kstep, voffA); PG8_STAGE(PG8_SB(1, 1), cB + hstep + kstep, voffB);
        PG8_WAIT_V(6); PG8_BAR;
    }
    for (;;) {
        const bool has_next = S.next(ui + 1, nxt);
        const char* nA = has_next ? (const char*)g.A + (size_t)nxt.pm * tstep : cA; const char* nB = has_next ? (const char*)g.Bt + (size_t)nxt.pn * tstep : cB;
        for (int t = 0; t < nt; t += 2) {
            const bool last = (t == nt - 2);
            const char* a1 = cA + (size_t)(t + 1) * kstep;
            const char* a2 = last ? nA : cA + (size_t)(t + 2) * kstep; const char* b2 = last ? nB : cB + (size_t)(t + 2) * kstep;
            const char* a3 = a2 + kstep; const char* b3 = b2 + kstep;
            if (last && has_next) S.a_ready(nxt);
            if constexpr (SP2) {
            PG8_LDB(B0, 0, 0); PG8_LDB(B1, 0, 1); PG8_SCHED; PG8_LDA(At, 0, 0); PG8_STAGE(PG8_SA(1, 1), a1 + hstep, voffA);
            PG8_WAIT_V(8); PG8_WAIT_L(0); PG8_BAR; PG8_MMA(0, 0, At, B0); PG8_MMA(0, 1, At, B1); PG8_BAR; PG8_SCHED;
            PG8_LDA(At, 0, 1); PG8_STAGE(PG8_SB(0, 0), b2, voffB); PG8_STAGE(PG8_SB(0, 1), b2 + hstep, voffB); PG8_STAGE(PG8_SA(0, 0), a2, voffA);
            PG8_WAIT_V(8); PG8_WAIT_L(0); PG8_BAR; PG8_MMA(1, 0, At, B0); PG8_MMA(1, 1, At, B1); PG8_BAR; PG8_SCHED;
            PG8_LDB(B0, 1, 0); PG8_LDB(B1, 1, 1); PG8_SCHED; PG8_LDA(At, 1, 0); PG8_STAGE(PG8_SA(0, 1), a2 + hstep, voffA);
            PG8_WAIT_V(8); PG8_WAIT_L(0); PG8_BAR; PG8_MMA(0, 0, At, B0); PG8_MMA(0, 1, At, B1); PG8_BAR; PG8_SCHED;
            PG8_LDA(At, 1, 1); PG8_STAGE(PG8_SB(1, 0), b3, voffB); PG8_STAGE(PG8_SB(1, 1), b3 + hstep, voffB); PG8_STAGE(PG8_SA(1, 0), a3, voffA);
            PG8_WAIT_V(8); PG8_WAIT_L(0); PG8_BAR; PG8_MMA(1, 0, At, B0); PG8_MMA(1, 1, At, B1); PG8_BAR; PG8_SCHED;
            } else {
            PG8_LDB(B0, 0, 0); PG8_SCHED; PG8_LDA(At, 0, 0); PG8_STAGE(PG8_SA(1, 1), a1 + hstep, voffA);
            PG8_WAIT_L(8); PG8_BAR; PG8_WAIT_L(0); PG8_MMA(0, 0, At, B0); PG8_BAR; PG8_SCHED;
            PG8_LDB(B1, 0, 1); PG8_STAGE(PG8_SB(0, 0), b2, voffB);
            PG8_BAR; PG8_WAIT_L(0); PG8_MMA(0, 1, At, B1); PG8_BAR;
            PG8_LDA(At, 0, 1); PG8_STAGE(PG8_SA(0, 0), a2, voffA);
            PG8_BAR; PG8_WAIT_L(0); PG8_MMA(1, 0, At, B0); PG8_BAR; PG8_SCHED;
            PG8_STAGE(PG8_SB(0, 1), b2 + hstep, voffB);
            PG8_WAIT_V(6); PG8_BAR; PG8_MMA(1, 1, At, B1); PG8_BAR;
            PG8_LDB(B0, 1, 0); PG8_SCHED; PG8_LDA(At, 1, 0); PG8_STAGE(PG8_SA(0, 1), a2 + hstep, voffA);
            PG8_WAIT_L(8); PG8_BAR; PG8_WAIT_L(0); PG8_MMA(0, 0, At, B0); PG8_BAR; PG8_SCHED;
            PG8_LDB(B1, 1, 1); PG8_STAGE(PG8_SB(1, 0), b3, voffB);
            PG8_BAR; PG8_WAIT_L(0); PG8_MMA(0, 1, At, B1); PG8_BAR;
            PG8_LDA(At, 1, 1); PG8_STAGE(PG8_SA(1, 0), a3, voffA);
            PG8_BAR; PG8_WAIT_L(0); PG8_MMA(1, 0, At, B0); PG8_BAR; PG8_SCHED;
            PG8_STAGE(PG8_SB(1, 1), b3 + hstep, voffB);
            PG8_WAIT_V(6); PG8_BAR; PG8_MMA(1, 1, At, B1); PG8_BAR;
            }
        }
        if constexpr (ALIGN_EPI) { if (wr == 0) PG8_BAR; }
        if constexpr (!Epi::AFTER_DRAIN) { E(acc, cur, wr, wc, fr, fq); S.done(cur); }
        if (!has_next) break;
#pragma unroll
        for (int a = 0; a < 2; ++a)
#pragma unroll
            for (int b = 0; b < 2; ++b)
#pragma unroll
                for (int m = 0; m < 4; ++m)
#pragma unroll
                    for (int n = 0; n < 2; ++n) acc[a][b][m][n] = (f32x4){0.f, 0.f, 0.f, 0.f};
        cur = nxt; cA = nA; cB = nB; ++ui;
        if constexpr (ALIGN_EPI) { if (wr == 1) PG8_BAR; }
    }
    PG8_WAIT_V(0);
    if constexpr (!ALIGN_EPI) { if (wr == 0) PG8_BAR; }
    PG8_BAR;
    if constexpr (Epi::AFTER_DRAIN) { E.fused(acc, cur, wr, wc, fr, fq, lds, wid, lane); S.done(cur); }
#undef PG8_SA
#undef PG8_SB
#undef PG8_STAGE
#undef PG8_LDA
#undef PG8_LDB
#undef PG8_MMA
#undef PG8_WAIT_V
#undef PG8_WAIT_L
#undef PG8_BAR
#undef PG8_SCHED
}
}
namespace pg8 {
struct EpiProj {
    static constexpr bool PERM = true, AFTER_DRAIN = false;
    bf16_t* O; int ldc; int gelu_tiles;
    __device__ __forceinline__ void operator()(const f32x4 (&acc)[2][2][4][2], const Unit& u, int wr, int wc, int fr, int fq) const {
        const int row0 = u.pm * BM + wr * 64 + fr; const int col0 = u.pn * BM + wc * 32 + 8 * fq;
        const bool act = u.pn < gelu_tiles;
#pragma unroll
        for (int ai = 0; ai < 2; ++ai)
#pragma unroll
            for (int m = 0; m < 4; ++m) { bf16_t* rowp = O + (size_t)(row0 + ai * HALF + m * 16) * ldc + col0;
#pragma unroll
                for (int bj = 0; bj < 2; ++bj) { f32x4 v0 = acc[ai][bj][m][0], v1 = acc[ai][bj][m][1];
                    if (act) { f32x2 a = gelu_pk((f32x2){v0[0], v0[1]}), b = gelu_pk((f32x2){v0[2], v0[3]}), c = gelu_pk((f32x2){v1[0], v1[1]}), d = gelu_pk((f32x2){v1[2], v1[3]});
                        v0 = (f32x4){a.x, a.y, b.x, b.y}; v1 = (f32x4){c.x, c.y, d.x, d.y}; }
                    u32x4 w; w.x = cvt_pk_bf16(v0[0], v0[1]); w.y = cvt_pk_bf16(v0[2], v0[3]); w.z = cvt_pk_bf16(v1[0], v1[1]); w.w = cvt_pk_bf16(v1[2], v1[3]);
                    *(u32x4*)(rowp + bj * HALF) = w; } }
    }
};
struct EpiResid {
    static constexpr bool PERM = false, AFTER_DRAIN = false;
    const float* base; const float* gate; float* out; int ldc;
    __device__ __forceinline__ void operator()(const f32x4 (&acc)[2][2][4][2], const Unit& u, int wr, int wc, int fr, int fq) const {
        const int row0 = u.pm * BM + wr * 64 + fr, col0 = u.pn * BM + wc * 32 + 4 * fq;
        f32x4 gv[2][2];
#pragma unroll
        for (int bj = 0; bj < 2; ++bj)
#pragma unroll
            for (int n = 0; n < 2; ++n) gv[bj][n] = *(const f32x4*)(gate + col0 + bj * HALF + n * 16);
#pragma unroll
        for (int ai = 0; ai < 2; ++ai)
#pragma unroll
            for (int m = 0; m < 4; ++m) { const size_t off = (size_t)(row0 + ai * HALF + m * 16) * ldc + col0;
#pragma unroll
                for (int bj = 0; bj < 2; ++bj)
#pragma unroll
                    for (int n = 0; n < 2; ++n) { const f32x4 b = *(const f32x4*)(base + off + bj * HALF + n * 16); *(f32x4*)(out + off + bj * HALF + n * 16) = b + gv[bj][n] * acc[ai][bj][m][n]; } }
    }
};
struct EpiQ8 {
    static constexpr bool PERM = true, AFTER_DRAIN = false;
    bf16_t* O; int ldc; int gelu_tiles; const float* rs; const float* cs;
    __device__ __forceinline__ void operator()(const f32x4 (&acc)[2][2][4][2], const Unit& u, int wr, int wc, int fr, int fq) const {
        const int row0 = u.pm * BM + wr * 64 + fr; const int col0 = u.pn * BM + wc * 32 + 8 * fq;
        const bool act = u.pn < gelu_tiles;
        f32x4 cv[2][2];
#pragma unroll
        for (int bj = 0; bj < 2; ++bj)
#pragma unroll
            for (int n = 0; n < 2; ++n) cv[bj][n] = *(const f32x4*)(cs + col0 + bj * HALF + 4 * n);
#pragma unroll
        for (int ai = 0; ai < 2; ++ai)
#pragma unroll
            for (int m = 0; m < 4; ++m) { const int row = row0 + ai * HALF + m * 16; const float rsc = rs[row]; bf16_t* rowp = O + (size_t)row * ldc + col0;
#pragma unroll
                for (int bj = 0; bj < 2; ++bj) { const i32x4 a0 = __builtin_bit_cast(i32x4, acc[ai][bj][m][0]), a1 = __builtin_bit_cast(i32x4, acc[ai][bj][m][1]);
                    f32x4 v0 = (f32x4){(float)a0[0], (float)a0[1], (float)a0[2], (float)a0[3]} * rsc * cv[bj][0], v1 = (f32x4){(float)a1[0], (float)a1[1], (float)a1[2], (float)a1[3]} * rsc * cv[bj][1];
                    if (act) { f32x2 a = gelu_pk((f32x2){v0[0], v0[1]}), b = gelu_pk((f32x2){v0[2], v0[3]}), c = gelu_pk((f32x2){v1[0], v1[1]}), d = gelu_pk((f32x2){v1[2], v1[3]});
                        v0 = (f32x4){a.x, a.y, b.x, b.y}; v1 = (f32x4){c.x, c.y, d.x, d.y}; }
                    u32x4 w; w.x = cvt_pk_bf16(v0[0], v0[1]); w.y = cvt_pk_bf16(v0[2], v0[3]); w.z = cvt_pk_bf16(v1[0], v1[1]); w.w = cvt_pk_bf16(v1[2], v1[3]);
                    *(u32x4*)(rowp + bj * HALF) = w; } }
    }
};
struct EpiResid2 {
    static constexpr bool PERM = true, AFTER_DRAIN = false;
    const float* base; const float* gate; bf16_t* xb; float* ssq; int ldc;
    __device__ __forceinline__ void operator()(const f32x4 (&acc)[2][2][4][2], const Unit& u, int wr, int wc, int fr, int fq) const {
        const int row0 = u.pm * BM + wr * 64 + fr, col0 = u.pn * BM + wc * 32 + 8 * fq;
        f32x4 gv[2][2];
#pragma unroll
        for (int bj = 0; bj < 2; ++bj)
#pragma unroll
            for (int n = 0; n < 2; ++n) gv[bj][n] = *(const f32x4*)(gate + col0 + bj * HALF + 4 * n);
#pragma unroll
        for (int ai = 0; ai < 2; ++ai)
#pragma unroll
            for (int m = 0; m < 4; ++m) { const int row = row0 + ai * HALF + m * 16; const size_t off = (size_t)row * ldc + col0; float ss = 0.f;
#pragma unroll
                for (int bj = 0; bj < 2; ++bj) {
                    const f32x4 b0 = *(const f32x4*)(base + off + bj * HALF), b1 = *(const f32x4*)(base + off + bj * HALF + 4);
                    const f32x4 v0 = b0 + gv[bj][0] * acc[ai][bj][m][0], v1 = b1 + gv[bj][1] * acc[ai][bj][m][1];
                    ss += (v0[0] * v0[0] + v0[1] * v0[1]) + (v0[2] * v0[2] + v0[3] * v0[3]) + (v1[0] * v1[0] + v1[1] * v1[1]) + (v1[2] * v1[2] + v1[3] * v1[3]);
                    u32x4 w; w.x = cvt_pk_bf16(v0[0], v0[1]); w.y = cvt_pk_bf16(v0[2], v0[3]); w.z = cvt_pk_bf16(v1[0], v1[1]); w.w = cvt_pk_bf16(v1[2], v1[3]);
                    *(u32x4*)(xb + off + bj * HALF) = w; }
                ss += __shfl_xor(ss, 16); ss += __shfl_xor(ss, 32);
                if (fq == 0) ssq[(size_t)row * 32 + u.pn * 4 + wc] = ss; }
    }
};
struct EpiQ {
    static constexpr bool PERM = true, AFTER_DRAIN = false;
    bf16_t* O; int ldc; const float* bias; const PG8_LAS float* rstd;
    __device__ __forceinline__ void operator()(const f32x4 (&acc)[2][2][4][2], const Unit& u, int wr, int wc, int fr, int fq) const {
        const int lrow0 = wr * 64 + fr, col0 = u.pn * BM + wc * 32 + 8 * fq;
        f32x4 bv[2][2];
#pragma unroll
        for (int bj = 0; bj < 2; ++bj)
#pragma unroll
            for (int n = 0; n < 2; ++n) bv[bj][n] = *(const f32x4*)(bias + col0 + bj * HALF + 4 * n);
#pragma unroll
        for (int ai = 0; ai < 2; ++ai)
#pragma unroll
            for (int m = 0; m < 4; ++m) { const int lrow = lrow0 + ai * HALF + m * 16; const float rs = rstd[(u.pm & 1) * BM + lrow];
                bf16_t* rowp = O + (size_t)(u.pm * BM + lrow) * ldc + col0;
#pragma unroll
                for (int bj = 0; bj < 2; ++bj) { const f32x4 v0 = acc[ai][bj][m][0] * rs + bv[bj][0], v1 = acc[ai][bj][m][1] * rs + bv[bj][1];
                    u32x4 w; w.x = cvt_pk_bf16(v0[0], v0[1]); w.y = cvt_pk_bf16(v0[2], v0[3]); w.z = cvt_pk_bf16(v1[0], v1[1]); w.w = cvt_pk_bf16(v1[2], v1[3]);
                    *(u32x4*)(rowp + bj * HALF) = w; } }
    }
};
}
#ifndef PG8_SP2
#define PG8_SP2 true
#endif
#ifndef PG8_ALIGN
#define PG8_ALIGN true
#endif
constexpr int NWAVES = 8;
constexpr int M = 16384, D = 2048;
constexpr int IN_COLS = 6152, NWIN = 6144, NPROJ = 5120;
constexpr int C_UG = 0, C_VG = 1024, C_Q = 2048, C_K = 3072, C_OM = 4096;
constexpr int WROW_VM = 5120;
constexpr int NHEAD = 4, DH = 256, CH = 128, NCHUNK = M / CH;
constexpr int NEXP = 16384, PH = 8, TOPK = 16, NSEL = PH * TOPK;
constexpr float EPS = 1e-6f;
constexpr int MOD_SHM = 0, MOD_SCM = 2048, MOD_GM = 4096, MOD_SHF = 6144, MOD_SCF = 8192, MOD_GF = 10240, NMOD = 12288;
constexpr int ADA_KC = 16, ADA_KROWS = D / ADA_KC;

constexpr size_t MiB = 1u << 20;
constexpr size_t WS_CTL = 0, CTL_ZERO_BYTES = 1 * MiB;
constexpr size_t WS_MODP = 1 * MiB;
constexpr size_t WS_MODF = WS_MODP + (size_t)ADA_KC * NMOD * 4;
constexpr size_t WS_GATES = 2 * MiB;
constexpr size_t WS_SUMM = 2 * MiB + 512 * 1024;
constexpr size_t WS_MTAB = WS_SUMM + 8192;
constexpr size_t WS_NST = 3 * MiB;
constexpr size_t WS_WIN = 4 * MiB;
constexpr size_t WS_WOUT = 28 * MiB;
constexpr size_t WS_WQ = 36 * MiB;
constexpr size_t WS_IDX = 44 * MiB;
constexpr size_t WS_PG = 52 * MiB;
constexpr size_t WS_SSQP = 60 * MiB;
constexpr size_t WS_BQP = 62 * MiB, WS_BIASQ = 62 * MiB + 512 * 1024;
constexpr size_t WS_SW = 62 * MiB + 768 * 1024;
constexpr size_t WS_CMAXP = 63 * MiB;
constexpr size_t WS_SA = 3 * MiB + 512 * 1024 + 131072;
constexpr size_t WS_HA = 64 * MiB;
constexpr size_t WS_PROJ = 128 * MiB;
constexpr size_t WS_VT = 288 * MiB;
constexpr size_t WS_X1 = 192 * MiB;
constexpr size_t WS_STATE = 320 * MiB;
constexpr size_t WS_ED = 384 * MiB, WS_EU = 416 * MiB;
constexpr size_t WS_SD = 3 * MiB + 512 * 1024, WS_SU = WS_SD + 65536;
constexpr size_t WS_END = 512 * MiB;
constexpr int CW_TMO = 0, CW_CODE = 1, CW_BAR = 4096;

constexpr int RING_BYTES = 131072, LDSCTL_OFF = 163328, MISC_OFF = LDSCTL_OFF + 320, LDS_BYTES = 163840;

#define GAS __attribute__((address_space(1)))
#define LAS __attribute__((address_space(3)))
#define DI __device__ __forceinline__
typedef unsigned short bf16;
typedef unsigned v4u __attribute__((ext_vector_type(4)));
typedef unsigned v2u __attribute__((ext_vector_type(2)));
typedef float f32x4 __attribute__((ext_vector_type(4)));
typedef float f32x16 __attribute__((ext_vector_type(16)));
typedef short bf16x8 __attribute__((ext_vector_type(8)));
typedef GAS unsigned gu32;
#define RLX_AGENT __ATOMIC_RELAXED, __HIP_MEMORY_SCOPE_AGENT
#define LDS_WAIT() asm volatile("s_waitcnt lgkmcnt(0)" ::: "memory")
#define VM_WAIT() asm volatile("s_waitcnt vmcnt(0)" ::: "memory")
#define MFMA32(a, b, c) __builtin_amdgcn_mfma_f32_32x32x16_bf16((a), (b), (c), 0, 0, 0)
DI unsigned f2bf(float f) { unsigned u = __builtin_bit_cast(unsigned, f); return (u + 0x7fffu + ((u >> 16) & 1u)) >> 16; }
DI unsigned pk2(float lo, float hi) { return f2bf(lo) | (f2bf(hi) << 16); }
DI float bflo(unsigned w) { return __builtin_bit_cast(float, w << 16); }
DI float bfhi(unsigned w) { return __builtin_bit_cast(float, w & 0xffff0000u); }
DI float bf2f(unsigned short h) { return __builtin_bit_cast(float, (unsigned)h << 16); }
DI int crow(int reg, int h) { return (reg & 3) + 8 * (reg >> 2) + 4 * h; }
DI float wave_sum(float v) {
#pragma unroll
    for (int o = 1; o < 64; o <<= 1) v += __shfl_xor(v, o);
    return v;
}
DI float wave_max(float v) {
#pragma unroll
    for (int o = 1; o < 64; o <<= 1) v = fmaxf(v, __shfl_xor(v, o));
    return v;
}
DI float silu_f(float v) { return v / (1.0f + __expf(-v)); }
DI float sigmoid_f(float v) { return 1.0f / (1.0f + __expf(-v)); }
DI float gelu_f(float v) { return 0.5f * v * (1.0f + erff(v * 0.70710678118654752f)); }
typedef __bf16 bf16v2 __attribute__((ext_vector_type(2)));
#define DOT2(a, b, c) __builtin_amdgcn_fdot2_f32_bf16(__builtin_bit_cast(bf16v2, (unsigned)(a)), __builtin_bit_cast(bf16v2, (unsigned)(b)), (c), false)
DI f32x16 zero16() { f32x16 z; for (int i = 0; i < 16; ++i) z[i] = 0.f; return z; }
#define XB_TMO      128
#define XB_XCNT(j)  (256  + 64 * (j))
#define XB_XSUB(j)  (1280 + 64 * (j))
#define XB_XGEN(j)  (2304 + 64 * (j))
#define XB_TOP      3328
#define XB_TOPGEN   3392
#define XCD_BAR_WORDS 3456
#define XB_SPIN_CAP (1u << 18)

__device__ __forceinline__ unsigned xb_ld(unsigned* p)              { return __hip_atomic_load(p, __ATOMIC_RELAXED, __HIP_MEMORY_SCOPE_AGENT); }
__device__ __forceinline__ unsigned xb_add(unsigned* p, unsigned v) { return __hip_atomic_fetch_add(p, v, __ATOMIC_RELAXED, __HIP_MEMORY_SCOPE_AGENT); }
__device__ __forceinline__ unsigned xb_xcc_id() { return (unsigned)__builtin_amdgcn_s_getreg((3 << 11) | 20) & 0xFu; }
#define XB_SPIN(cond, bar) do { unsigned _sp = 0; while (cond) { __builtin_amdgcn_s_sleep(1); \
    if ((++_sp & 255u) == 0u) { if (xb_ld(&(bar)[XB_TMO])) break; if (_sp > XB_SPIN_CAP) { atomicAdd(&(bar)[XB_TMO], 1u); break; } } } } while (0)

struct XcdBarrier {
    unsigned* bar; unsigned x;
    volatile LAS unsigned* st;
};

__device__ __forceinline__ XcdBarrier xcd_barrier_post(unsigned* bar, volatile LAS unsigned* st) {
    XcdBarrier b; b.bar = bar; b.x = xb_xcc_id(); b.st = st;
    if (threadIdx.x == 0) (void)xb_add(&bar[XB_XCNT(b.x)], 1u);
    return b;
}
__device__ __forceinline__ void xcd_barrier_complete(unsigned* bar, unsigned x, unsigned& nloc, unsigned& nx) {
    const unsigned G = gridDim.x * gridDim.y * gridDim.z;
    unsigned sum, cnt, mine, sp = 0u;
    for (;;) {
        sum = 0u; cnt = 0u; mine = 0u;
#pragma unroll
        for (unsigned j = 0; j < 16; ++j) { const unsigned c = xb_ld(&bar[XB_XCNT(j)]); sum += c; cnt += (c > 0u) ? 1u : 0u; mine = (j == x) ? c : mine; }
        if (sum == G) break;
        __builtin_amdgcn_s_sleep(1);
        if ((++sp & 255u) == 0u) { if (xb_ld(&bar[XB_TMO])) break; if (sp > XB_SPIN_CAP) { atomicAdd(&bar[XB_TMO], 1u); break; } }
    }
    nloc = mine > 0u ? mine : 1u; nx = cnt > 0u ? cnt : 1u;
}

__device__ __forceinline__ void xcd_barrier(const XcdBarrier& b) {
    asm volatile("s_waitcnt vmcnt(0)" ::: "memory");
    __syncthreads();
    if (threadIdx.x == 0) {
        unsigned* bar = b.bar;
        __builtin_amdgcn_s_waitcnt(0);
        unsigned nloc = b.st[0], nx = b.st[1];
        if (nloc == 0u) { xcd_barrier_complete(bar, b.x, nloc, nx); b.st[0] = nloc; b.st[1] = nx; }
        const unsigned old = xb_add(&bar[XB_XSUB(b.x)], 1u);
        const unsigned gen = old / nloc;
        if (old + 1u == (gen + 1u) * nloc) {
            __builtin_amdgcn_fence(__ATOMIC_RELEASE, "agent");
            asm volatile("s_waitcnt vmcnt(0)" ::: "memory");
            const unsigned og = xb_add(&bar[XB_TOP], 1u);
            const unsigned tg = og / nx;
            if (og + 1u == (tg + 1u) * nx) xb_add(&bar[XB_TOPGEN], 1u);
            else XB_SPIN(xb_ld(&bar[XB_TOPGEN]) == tg, bar);
            __builtin_amdgcn_fence(__ATOMIC_ACQUIRE, "agent");
            xb_add(&bar[XB_XGEN(b.x)], 1u);
            asm volatile("s_waitcnt vmcnt(0)" ::: "memory");
        } else {
            XB_SPIN(xb_ld(&bar[XB_XGEN(b.x)]) == gen, bar);
            __builtin_amdgcn_fence(__ATOMIC_ACQUIRE, "agent");
            asm volatile("s_waitcnt vmcnt(0)" ::: "memory");
        }
    }
    __syncthreads();
}
struct Frame {
    LAS unsigned char* lds;
    volatile LAS unsigned* MISC;
    gu32* ctl;
    int tid, lane, wave, vcu, G;
    const float *x, *c, *ada_w, *ada_b, *norm_mix_g, *w_in, *b_gates, *conv_w, *conv_b, *gmlp_norm_g, *gmlp_w, *gmlp_b, *mlstm_norm_g, *w_out, *norm_ffn_g,
                *wq, *keys1, *keys2, *e_down, *e_up, *final_g;
    float* out;
    float *MODP, *MODF, *GATES, *SUMM, *MTAB, *NST, *PG;
    int* IDX;
    bf16 *WIN, *WOUT, *WQ, *HA, *PROJ, *QB, *STATE, *QC, *KC, *VT;
    unsigned char *ED, *EU, *H1Q; float *SD, *SU;
    float *SSQP, *BQP, *BIASQ, *SW, *CMAXP, *SA; bf16* X1B;
};

DI void p0_transpose_item(const float* W, int K, int ldw, int nblk, bf16* WT, LAS float* scr, int item, int lane, bool vm_last = false) {
    const int kb = item / nblk, nb = item % nblk, k0 = 64 * kb, n0 = 32 * nb;
    const int d0 = !vm_last ? n0 : (n0 < 4096 ? n0 : (n0 < 5120 ? n0 + 1024 : n0 - 1024));
#pragma unroll 8
    for (int i = 0; i < 32; ++i) { const int kk = 2 * i + (lane >> 5); scr[kk * 33 + (lane & 31)] = W[(size_t)(k0 + kk) * ldw + n0 + (lane & 31)]; }
    LDS_WAIT(); asm volatile("" ::: "memory");
    const int c = lane & 7;
#pragma unroll
    for (int j = 0; j < 4; ++j) { const int n = (lane >> 3) + 8 * j; const LAS float* s = scr + (8 * c) * 33 + n;
        v4u o; o.x = pk2(s[0 * 33], s[1 * 33]); o.y = pk2(s[2 * 33], s[3 * 33]); o.z = pk2(s[4 * 33], s[5 * 33]); o.w = pk2(s[6 * 33], s[7 * 33]);
        *(GAS v4u*)(WT + (size_t)(d0 + n) * K + k0 + 8 * c) = o; }
    LDS_WAIT(); asm volatile("" ::: "memory");
}
DI void p0_colmax_item(Frame& F, int item) {
    const int lane = F.lane, nblk = NWIN / 32, kb = item / nblk, nb = item % nblk, k0 = 64 * kb, n0 = 32 * nb;
    float m = 0.f;
#pragma unroll 8
    for (int i = 0; i < 32; ++i) { const int kk = 2 * i + (lane >> 5); m = fmaxf(m, fabsf(F.w_in[(size_t)(k0 + kk) * IN_COLS + n0 + (lane & 31)])); }
    m = fmaxf(m, __shfl_xor(m, 32));
    if (lane < 32) F.CMAXP[(size_t)kb * NWIN + n0 + lane] = m;
}
DI void p0_ada_item(Frame& F, LAS float* scr, int item) {
    const int cc = item % (NMOD / 256), kc = item / (NMOD / 256), k0 = kc * ADA_KROWS, col = cc * 256 + F.lane * 4;
#pragma unroll
    for (int j = 0; j < ADA_KROWS / 64; ++j) scr[F.lane + 64 * j] = silu_f(F.c[k0 + F.lane + 64 * j]);
    LDS_WAIT(); asm volatile("" ::: "memory");
    f32x4 acc = {0.f, 0.f, 0.f, 0.f};
    const float* wp = F.ada_w + (size_t)k0 * NMOD + col;
#pragma unroll 8
    for (int kk = 0; kk < ADA_KROWS; ++kk) { const float s = scr[kk]; const f32x4 w = *(const GAS f32x4*)(wp + (size_t)kk * NMOD); acc += w * s; }
    *(GAS f32x4*)(F.MODP + (size_t)kc * NMOD + col) = acc;
    LDS_WAIT(); asm volatile("" ::: "memory");
}
DI void p0a_phase(Frame& F) {
    LAS float* scr = (LAS float*)(F.lds + F.wave * 16384);
    const int gw = F.wave * F.G + F.vcu, NGW = F.G * NWAVES;
    constexpr int I_ADA = (NMOD / 256) * ADA_KC;
    constexpr int I_WIN = (D / 64) * (NWIN / 32), I_WO = (D / 64) * (D / 32);
    constexpr int NITEMS = I_ADA + I_WIN + I_WO;
    for (int it = gw; it < NITEMS; it += NGW) {
        int r = it;
        if (r < I_ADA) { p0_ada_item(F, scr, r); continue; } r -= I_ADA;
        if (r < I_WIN) { p0_colmax_item(F, r); continue; } r -= I_WIN;
        p0_transpose_item(F.w_out, D, D, D / 32, F.WOUT, scr, r, F.lane);
    }
#pragma unroll 1
    for (int row = gw; row < 2 * NEXP; row += NGW) {
        const int tb = row >= NEXP, e = row - tb * NEXP;
        const GAS f32x4* src = (const GAS f32x4*)((tb ? F.e_up : F.e_down) + (size_t)e * D) + F.lane;
        f32x4 v[8]; float am = 0.f;
#pragma unroll
        for (int j = 0; j < 8; ++j) { v[j] = src[64 * j]; am = fmaxf(am, fmaxf(fmaxf(fabsf(v[j].x), fabsf(v[j].y)), fmaxf(fabsf(v[j].z), fabsf(v[j].w)))); }
        am = fmaxf(wave_max(am), 1e-30f);
        const float sc = am * (1.0f / 127.0f), inv = 127.0f / am;
        GAS unsigned* dst = (GAS unsigned*)((tb ? F.EU : F.ED) + (size_t)e * D) + F.lane;
        const int off = tb ? 128 : 0;
#pragma unroll
        for (int j = 0; j < 8; ++j) {
            const int q0 = (int)__builtin_rintf(v[j].x * inv) + off, q1 = (int)__builtin_rintf(v[j].y * inv) + off, q2 = (int)__builtin_rintf(v[j].z * inv) + off, q3 = (int)__builtin_rintf(v[j].w * inv) + off;
            dst[64 * j] = (unsigned)(q0 & 255) | ((unsigned)(q1 & 255) << 8) | ((unsigned)(q2 & 255) << 16) | ((unsigned)(q3 & 255) << 24);
        }
        if (F.lane == 0) (tb ? F.SU : F.SD)[e] = sc;
    }
}
DI float mod_final(Frame& F, int col) { float s = F.ada_b[col];
#pragma unroll
    for (int k = 0; k < ADA_KC; ++k) s += F.MODP[(size_t)k * NMOD + col];
    return s; }
DI void norm_tables(Frame& F, const float* g, int col_scale, int col_shift) {
    LAS float* A1 = (LAS float*)(F.lds); LAS float* B1 = (LAS float*)(F.lds + 8192);
#pragma unroll
    for (int i = 0; i < 4; ++i) { const int c = F.tid + 512 * i; A1[c] = g[c] * (1.0f + F.MODF[col_scale + c]); B1[c] = F.MODF[col_shift + c]; }
}
DI void p0_wq_item(Frame& F, LAS float* scr, int item) {
    const int lane = F.lane, nblk = D / 32, kb = item / nblk, nb = item % nblk, k0 = 64 * kb, n0 = 32 * nb;
    LAS float* gsl = scr + 64 * 33; LAS float* shl = gsl + 64;
    gsl[lane] = F.norm_ffn_g[k0 + lane] * (1.0f + mod_final(F, MOD_SCF + k0 + lane)); shl[lane] = mod_final(F, MOD_SHF + k0 + lane);
    LDS_WAIT(); asm volatile("" ::: "memory");
    float bp = 0.f;
#pragma unroll 8
    for (int i = 0; i < 32; ++i) { const int kk = 2 * i + (lane >> 5); const float w = F.wq[(size_t)(k0 + kk) * D + n0 + (lane & 31)]; scr[kk * 33 + (lane & 31)] = w * gsl[kk]; bp += w * shl[kk]; }
    bp += __shfl_xor(bp, 32);
    if (lane < 32) F.BQP[(size_t)kb * D + n0 + lane] = bp;
    LDS_WAIT(); asm volatile("" ::: "memory");
    const int c = lane & 7;
#pragma unroll
    for (int j = 0; j < 4; ++j) { const int n = (lane >> 3) + 8 * j; const LAS float* sp = scr + (8 * c) * 33 + n;
        v4u o; o.x = pk2(sp[0 * 33], sp[1 * 33]); o.y = pk2(sp[2 * 33], sp[3 * 33]); o.z = pk2(sp[4 * 33], sp[5 * 33]); o.w = pk2(sp[6 * 33], sp[7 * 33]);
        *(GAS v4u*)(F.WQ + (size_t)(n0 + n) * D + k0 + 8 * c) = o; }
    LDS_WAIT(); asm volatile("" ::: "memory");
}
DI void p0_winq_item(Frame& F, LAS float* scr, int item) {
    const int lane = F.lane, nblk = NWIN / 32, kb = item / nblk, nb = item % nblk, k0 = 64 * kb, n0 = 32 * nb;
    const int d0 = n0 < 4096 ? n0 : (n0 < 5120 ? n0 + 1024 : n0 - 1024);
    LAS float* inv = scr + 64 * 33;
    if (lane < 32) { float m = 0.f;
#pragma unroll 8
        for (int q = 0; q < D / 64; ++q) m = fmaxf(m, F.CMAXP[(size_t)q * NWIN + n0 + lane]);
        m = fmaxf(m, 1e-30f); inv[lane] = 127.0f / m; if (kb == 0) F.SW[d0 + lane] = m * (1.0f / 127.0f); }
#pragma unroll 8
    for (int i = 0; i < 32; ++i) { const int kk = 2 * i + (lane >> 5); scr[kk * 33 + (lane & 31)] = F.w_in[(size_t)(k0 + kk) * IN_COLS + n0 + (lane & 31)]; }
    LDS_WAIT(); asm volatile("" ::: "memory");
    unsigned char* WQ = (unsigned char*)F.WIN;
#pragma unroll
    for (int i = 0; i < 2; ++i) { const int q = lane + 64 * i, n = q >> 2, c = q & 3; const float iv = inv[n]; const LAS float* sp = scr + (16 * c) * 33 + n; v4u o;
#pragma unroll
        for (int w = 0; w < 4; ++w) { const int q0 = (int)__builtin_rintf(sp[(4 * w) * 33] * iv), q1 = (int)__builtin_rintf(sp[(4 * w + 1) * 33] * iv), q2 = (int)__builtin_rintf(sp[(4 * w + 2) * 33] * iv), q3 = (int)__builtin_rintf(sp[(4 * w + 3) * 33] * iv);
            o[w] = (unsigned)(q0 & 255) | ((unsigned)(q1 & 255) << 8) | ((unsigned)(q2 & 255) << 16) | ((unsigned)(q3 & 255) << 24); }
        *(GAS v4u*)(WQ + (size_t)(d0 + n) * D + k0 + 16 * c) = o; }
    LDS_WAIT(); asm volatile("" ::: "memory");
}
DI void p0b_phase(Frame& F) {
    LAS float* A1 = (LAS float*)(F.lds); LAS float* B1 = (LAS float*)(F.lds + 8192); LAS float* WG = (LAS float*)(F.lds + 16384);
#pragma unroll
    for (int i = 0; i < 4; ++i) { const int c = F.tid + 512 * i; A1[c] = F.norm_mix_g[c] * (1.0f + mod_final(F, MOD_SCM + c)); B1[c] = mod_final(F, MOD_SHM + c); }
    { const int per = (NMOD + F.G - 1) / F.G; const int c = (int)blockIdx.x * per + F.tid; if (F.tid < per && c < NMOD) F.MODF[c] = mod_final(F, c); }
#pragma unroll
    for (int i = 0; i < 4; ++i) { const int k = F.tid + 512 * i; const f32x4 a = *(const GAS f32x4*)(F.w_in + (size_t)k * IN_COLS + NWIN), b = *(const GAS f32x4*)(F.w_in + (size_t)k * IN_COLS + NWIN + 4);
        WG[0 * 2048 + k] = a.x; WG[1 * 2048 + k] = a.y; WG[2 * 2048 + k] = a.z; WG[3 * 2048 + k] = a.w; WG[4 * 2048 + k] = b.x; WG[5 * 2048 + k] = b.y; WG[6 * 2048 + k] = b.z; WG[7 * 2048 + k] = b.w; }
    __syncthreads();
    const int gw = F.vcu * NWAVES + F.wave, NGW = F.G * NWAVES;
    f32x4 vn[8];
    { const GAS f32x4* xr = (const GAS f32x4*)(F.x + (size_t)gw * D) + F.lane;
#pragma unroll
      for (int j = 0; j < 8; ++j) vn[j] = xr[64 * j]; }
#pragma unroll 1
    for (int row = gw; row < M; row += NGW) {
        f32x4 v[8]; float ss = 0.f;
#pragma unroll
        for (int j = 0; j < 8; ++j) { v[j] = vn[j]; ss += (v[j].x * v[j].x + v[j].y * v[j].y) + (v[j].z * v[j].z + v[j].w * v[j].w); }
        if (row + NGW < M) { const GAS f32x4* xr = (const GAS f32x4*)(F.x + (size_t)(row + NGW) * D) + F.lane;
#pragma unroll
            for (int j = 0; j < 8; ++j) vn[j] = xr[64 * j]; }
        const float rstd = 1.0f / sqrtf(wave_sum(ss) * (1.0f / D) + EPS);
        float gd[8];
#pragma unroll
        for (int g = 0; g < 8; ++g) gd[g] = 0.f;
        LAS v2u* o8 = (LAS v2u*)(F.lds + 81920 + F.wave * 4096) + F.lane; float am = 0.f;
#pragma unroll
        for (int j = 0; j < 8; ++j) {
            const f32x4 a = *(const LAS f32x4*)(A1 + 256 * j + 4 * F.lane), b = *(const LAS f32x4*)(B1 + 256 * j + 4 * F.lane);
            const f32x4 h = v[j] * rstd * a + b;
            v2u o; o.x = pk2(h.x, h.y); o.y = pk2(h.z, h.w); o8[64 * j] = o; am = fmaxf(am, fmaxf(fmaxf(fabsf(h.x), fabsf(h.y)), fmaxf(fabsf(h.z), fabsf(h.w))));
#pragma unroll
            for (int g = 0; g < 8; ++g) { const f32x4 w = *(const LAS f32x4*)(WG + g * 2048 + 256 * j + 4 * F.lane); gd[g] += (h.x * w.x + h.y * w.y) + (h.z * w.z + h.w * w.w); }
            asm volatile("" ::: "memory");
        }
#pragma unroll
        for (int g = 0; g < 8; ++g) gd[g] = wave_sum(gd[g]);
        if (F.lane == 0) {
#pragma unroll
            for (int g = 0; g < 8; ++g) { float p = gd[g] + F.b_gates[g];
                if (g >= 4) { p = fminf(p, 0.f) - log1pf(__expf(-fabsf(p))); }
                F.GATES[(size_t)row * 8 + g] = p; }
        }
            {
            am = fmaxf(wave_max(am), 1e-30f); const float qinv = 127.0f / am;
            LDS_WAIT(); asm volatile("" ::: "memory");
            GAS unsigned* qr = (GAS unsigned*)(F.H1Q + (size_t)row * D) + F.lane;
#pragma unroll
            for (int j = 0; j < 8; ++j) { const v2u w = o8[64 * j];
                const int q0 = (int)__builtin_rintf(bflo(w.x) * qinv), q1 = (int)__builtin_rintf(bfhi(w.x) * qinv), q2 = (int)__builtin_rintf(bflo(w.y) * qinv), q3 = (int)__builtin_rintf(bfhi(w.y) * qinv);
                qr[64 * j] = (unsigned)(q0 & 255) | ((unsigned)(q1 & 255) << 8) | ((unsigned)(q2 & 255) << 16) | ((unsigned)(q3 & 255) << 24); }
            if (F.lane == 0) F.SA[row] = am * (1.0f / 127.0f);
            LDS_WAIT(); asm volatile("" ::: "memory");
        }
    }
    __syncthreads();
    {
        LAS float* scr = (LAS float*)(F.lds + F.wave * 8960);
        for (int it = F.wave * F.G + F.vcu; it < (D / 64) * (D / 32); it += NGW) p0_wq_item(F, scr, it);
        for (int it = F.wave * F.G + F.vcu; it < (D / 64) * (NWIN / 32); it += NGW) p0_winq_item(F, scr, it);
    }
}
constexpr int IMG_PITCH = 576, M1_WL = 73728, M1_RED = 74240, M1_OB = 90624;
typedef short s16x4 __attribute__((ext_vector_type(4)));
DI bf16x8 tr_frag(const LAS unsigned char* p, int off_lo, int off_hi) {
    const s16x4 lo = __builtin_amdgcn_ds_read_tr16_b64_v4i16((LAS s16x4*)(p + off_lo));
    const s16x4 hi = __builtin_amdgcn_ds_read_tr16_b64_v4i16((LAS s16x4*)(p + off_hi));
    return __builtin_shufflevector(lo, hi, 0, 1, 2, 3, 4, 5, 6, 7);
}
DI float bfel(const v4u& w, int e) { const unsigned d = w[e >> 1]; return (e & 1) ? bfhi(d) : bflo(d); }
DI void m1_item(Frame& F, int hh, int kc) {
    LAS unsigned char* IMG = F.lds; LAS float* WL = (LAS float*)(F.lds + M1_WL); LAS float* RED = (LAS float*)(F.lds + M1_RED);
    const int t0 = kc * CH, lane = F.lane, tid = F.tid;
    if (F.wave == 0) {
        const float* gp = F.GATES + (size_t)(t0 + 2 * lane) * 8;
        const float i0 = gp[hh], lf0 = gp[4 + hh], i1 = gp[8 + hh], lf1 = gp[12 + hh];
        const float p = lf0 + lf1; float inc = p;
#pragma unroll
        for (int o = 1; o < 64; o <<= 1) { const float t = __shfl_up(inc, o); if (lane >= o) inc += t; }
        const float A = __shfl(inc, 63), ex = inc - p, b0 = ex + lf0, b1 = ex + p;
        const float lw0 = A - b0 + i0, lw1 = A - b1 + i1;
        const float B = wave_max(fmaxf(lw0, lw1));
        WL[2 * lane] = __expf(lw0 - B); WL[2 * lane + 1] = __expf(lw1 - B);
        if (lane == 0) { F.SUMM[(hh * NCHUNK + kc) * 2] = A; F.SUMM[(hh * NCHUNK + kc) * 2 + 1] = B; }
    }
    __syncthreads();
    const int dg = tid & 31, sg = tid >> 5;
#pragma unroll 1
    for (int which = 0; which < 2; ++which) {
        const int chb = (which == 0 ? 1024 : 0) + hh * DH + dg * 8;
        const int colb = (which == 0 ? C_K : C_Q) + hh * DH + dg * 8;
        v4u raw[11];
#pragma unroll
        for (int rr = 0; rr < 11; ++rr) { const int tt = t0 + sg * 8 - 3 + rr; raw[rr] = (v4u){0u, 0u, 0u, 0u}; if (tt >= 0) raw[rr] = *(const GAS v4u*)(F.PROJ + (size_t)tt * NPROJ + colb); }
        float wl[8];
#pragma unroll
        for (int i = 0; i < 8; ++i) wl[i] = (which == 0) ? WL[sg * 8 + i] : 0.0625f;
        v4u o1[8], o2[8];
#pragma unroll
        for (int dw = 0; dw < 4; ++dw) {
            typedef float f32x2 __attribute__((ext_vector_type(2)));
            f32x2 cw[4];
#pragma unroll
            for (int j = 0; j < 4; ++j) cw[j] = *(const GAS f32x2*)(F.conv_w + j * 2048 + chb + 2 * dw);
            const f32x2 cb = *(const GAS f32x2*)(F.conv_b + chb + 2 * dw);
            float xl[11], xh[11];
#pragma unroll
            for (int rr = 0; rr < 11; ++rr) { xl[rr] = bflo(raw[rr][dw]); xh[rr] = bfhi(raw[rr][dw]); }
            float d0 = 0.f, d1 = 0.f;
#pragma unroll
            for (int i = 0; i < 8; ++i) {
                float a0 = cb.x, a1 = cb.y;
#pragma unroll
                for (int j = 0; j < 4; ++j) { a0 += cw[j].x * xl[i + j]; a1 += cw[j].y * xh[i + j]; }
                a0 = silu_f(a0); a1 = silu_f(a1);
                if (which == 0) { o1[i][dw] = pk2(a0, a1); a0 *= wl[i]; a1 *= wl[i]; d0 += a0; d1 += a1; o2[i][dw] = pk2(a0, a1); }
                else { o1[i][dw] = pk2(a0 * wl[i], a1 * wl[i]); }
            }
            if (which == 0) { RED[sg * 256 + dg * 8 + 2 * dw] = d0; RED[sg * 256 + dg * 8 + 2 * dw + 1] = d1; }
            asm volatile("" ::: "memory");
        }
#pragma unroll
        for (int i = 0; i < 8; ++i) { const int s = sg * 8 + i, t = t0 + s;
            if (which == 0) { *(GAS v4u*)(F.KC + (size_t)t * 1024 + hh * DH + dg * 8) = o1[i]; *(LAS v4u*)(IMG + s * IMG_PITCH + dg * 16) = o2[i]; }
            else { *(GAS v4u*)(F.QC + (size_t)t * 1024 + hh * DH + dg * 8) = o1[i]; } }
    }
    __syncthreads();
    if (tid < 256) { float s = 0.f;
#pragma unroll
        for (int i = 0; i < 16; ++i) s += RED[i * 256 + tid];
        F.NST[(size_t)(hh * NCHUNK + kc) * DH + tid] = s; }
    const int r = lane & 31, h = lane >> 5, e0 = F.wave * 32;
    bf16x8 bf[8];
#pragma unroll
    for (int ks = 0; ks < 8; ++ks) {
        bf[ks] = *(const GAS bf16x8*)(F.VT + (size_t)(hh * DH + e0 + r) * M + t0 + ks * 16 + 8 * h);
    }
    const LAS unsigned char* trb = IMG + (8 * h + ((lane & 15) >> 2)) * IMG_PITCH + (16 * ((lane >> 4) & 1) + 4 * (lane & 3)) * 2;
    LAS unsigned char* OB = F.lds + M1_OB + F.wave * (32 * 144);
#pragma unroll 1
    for (int dp = 0; dp < 4; ++dp) {
#pragma unroll
        for (int d2 = 0; d2 < 2; ++d2) {
            const int dt = 2 * dp + d2;
            f32x16 acc = zero16();
#pragma unroll
            for (int ks = 0; ks < 8; ++ks) { const bf16x8 af = tr_frag(trb + dt * 64, ks * 16 * IMG_PITCH, ks * 16 * IMG_PITCH + 4 * IMG_PITCH); acc = MFMA32(af, bf[ks], acc); }
#pragma unroll
            for (int g = 0; g < 4; ++g) { v2u o; o.x = pk2(acc[4 * g], acc[4 * g + 1]); o.y = pk2(acc[4 * g + 2], acc[4 * g + 3]);
                *(LAS v2u*)(OB + r * 144 + (d2 * 32 + 8 * g + 4 * h) * 2) = o; }
        }
        LDS_WAIT(); asm volatile("" ::: "memory");
#pragma unroll
        for (int i = 0; i < 4; ++i) { const int q = lane + 64 * i, row = q >> 3, c16 = q & 7;
            *(GAS v4u*)(F.STATE + (size_t)(hh * NCHUNK + kc) * (DH * DH) + (size_t)(e0 + row) * DH + dp * 64 + c16 * 8) = *(const LAS v4u*)(OB + row * 144 + c16 * 16); }
        LDS_WAIT(); asm volatile("" ::: "memory");
    }
    __syncthreads();
}
constexpr int G_WI = 0, G_VI = 34816, G_UI = 75776, G_WP = 272, G_VP = 320, G_UP = 272;
DI void gmlp_block(Frame& F, int g, int n0, int nch) {
    LAS unsigned char* WI = F.lds + G_WI; LAS unsigned char* VI = F.lds + G_VI; LAS unsigned char* UI = F.lds + G_UI;
    const int c0 = g * 128, lane = F.lane, tid = F.tid;
    {
#pragma unroll
        for (int i = 0; i < 8; ++i) { const int p = tid + 512 * i, t = p >> 5, s4 = (p & 31) * 4;
            const f32x4 w = *(const GAS f32x4*)(F.gmlp_w + (size_t)(g * 128 + t) * 128 + s4);
            v2u o; o.x = pk2(s4 <= t ? w.x : 0.f, s4 + 1 <= t ? w.y : 0.f); o.y = pk2(s4 + 2 <= t ? w.z : 0.f, s4 + 3 <= t ? w.w : 0.f);
            *(LAS v2u*)(WI + t * G_WP + s4 * 2) = o; }
    }
    v4u tv[4], tu[4];
#define G_LOAD(N) do { _Pragma("unroll") for (int i = 0; i < 4; ++i) { const int p = tid + 512 * i; const bf16* rowp = F.PROJ + (size_t)((N) * CH + (p >> 4)) * NPROJ + c0 + (p & 15) * 8; \
        tv[i] = *(const GAS v4u*)(rowp + C_VG); tu[i] = *(const GAS v4u*)(rowp + C_UG); } } while (0)
    G_LOAD(n0);
    const int r = lane & 31, h = lane >> 5, ct = F.wave & 3, tp = F.wave >> 2;
    float ng[16];
#pragma unroll
    for (int reg = 0; reg < 16; ++reg) ng[reg] = F.gmlp_norm_g[g * 128 + ct * 32 + crow(reg, h)];
    const LAS unsigned char* trb = VI + (8 * h + ((lane & 15) >> 2)) * G_VP + (ct * 32 + 16 * ((lane >> 4) & 1) + 4 * (lane & 3)) * 2;
#pragma unroll 1
    for (int ci = 0; ci < nch; ++ci) {
        const int n = n0 + ci, t0 = n * CH;
#pragma unroll
        for (int i = 0; i < 4; ++i) { const int p = tid + 512 * i, row = p >> 4, c16 = p & 15; const v4u w = tv[i];
            float a[8] = {bflo(w.x), bfhi(w.x), bflo(w.y), bfhi(w.y), bflo(w.z), bfhi(w.z), bflo(w.w), bfhi(w.w)};
            float ss = (a[0] * a[0] + a[1] * a[1]) + (a[2] * a[2] + a[3] * a[3]) + (a[4] * a[4] + a[5] * a[5]) + (a[6] * a[6] + a[7] * a[7]);
            ss += __shfl_xor(ss, 1); ss += __shfl_xor(ss, 2); ss += __shfl_xor(ss, 4); ss += __shfl_xor(ss, 8);
            const float rs = 1.0f / sqrtf(ss * (1.0f / 128.0f) + EPS);
            v4u o; o.x = pk2(a[0] * rs, a[1] * rs); o.y = pk2(a[2] * rs, a[3] * rs); o.z = pk2(a[4] * rs, a[5] * rs); o.w = pk2(a[6] * rs, a[7] * rs);
            *(LAS v4u*)(VI + row * G_VP + c16 * 16) = o; *(LAS v4u*)(UI + row * G_UP + c16 * 16) = tu[i]; }
        __syncthreads();
        if (ci + 1 < nch) G_LOAD(n + 1);
#pragma unroll 1
        for (int ti = 0; ti < 2; ++ti) {
            const int tt = (ti == 0) ? tp : 3 - tp;
            const int t = tt * 32 + r;
            const LAS unsigned char* wrow = WI + t * G_WP + 16 * h;
            f32x16 acc = zero16();
#pragma unroll
            for (int ks = 0; ks < 8; ++ks) if (ks <= 2 * tt + 1) {
                const bf16x8 af = tr_frag(trb, ks * 16 * G_VP, ks * 16 * G_VP + 4 * G_VP);
                const bf16x8 bw = *(const LAS bf16x8*)(wrow + 32 * ks);
                acc = MFMA32(af, bw, acc);
            }
            const float bsp = F.gmlp_b[g * 128 + t];
            LAS unsigned char* urow = UI + t * G_UP + (ct * 32 + 4 * h) * 2;
#pragma unroll
            for (int gq = 0; gq < 4; ++gq) { LAS v2u* up = (LAS v2u*)(urow + 16 * gq);
                const v2u uw = *up;
                const float y0 = bflo(uw.x) * (ng[4 * gq] * acc[4 * gq] + bsp), y1 = bfhi(uw.x) * (ng[4 * gq + 1] * acc[4 * gq + 1] + bsp);
                const float y2 = bflo(uw.y) * (ng[4 * gq + 2] * acc[4 * gq + 2] + bsp), y3 = bfhi(uw.y) * (ng[4 * gq + 3] * acc[4 * gq + 3] + bsp);
                v2u o; o.x = pk2(y0, y1); o.y = pk2(y2, y3); *up = o; }
        }
        __syncthreads();
#pragma unroll
        for (int i = 0; i < 4; ++i) { const int p = tid + 512 * i, row = p >> 4, c16 = p & 15;
            *(GAS v4u*)(F.HA + (size_t)(t0 + row) * D + c0 + c16 * 8) = *(const LAS v4u*)(UI + row * G_UP + c16 * 16); }
        __syncthreads();
    }
#undef G_LOAD
}
DI void p2_phase(Frame& F) {
    constexpr int N_M1 = NHEAD * NCHUNK;
#pragma unroll 1
    for (int it = (int)blockIdx.x; it < N_M1; it += F.G) m1_item(F, it / NCHUNK, it % NCHUNK);
    { const int per = (8 * (M / CH) + F.G - 1) / F.G;
      const int first = (int)blockIdx.x * per;
      if (first < 8 * (M / CH)) { const int g = first / (M / CH), n0 = first % (M / CH); int nch = per; if (n0 + nch > M / CH) nch = M / CH - n0; gmlp_block(F, g, n0, nch); } }
}
DI void p3_phase(Frame& F) {
    LAS float* TAB = (LAS float*)F.lds;
    const int lane = F.lane;
    if (F.wave < NHEAD) {
        const int hh = F.wave; const float* sp = F.SUMM + (size_t)(hh * NCHUNK + 2 * lane) * 2;
        const float A0 = sp[0], B0 = sp[1], A1 = sp[2], B1 = sp[3];
        float ca = A0 + A1, cb = fmaxf(B0 + A1, B1);
        const float pa = ca, pb = cb;
#pragma unroll
        for (int o = 1; o < 64; o <<= 1) { const float ta = __shfl_up(ca, o), tb = __shfl_up(cb, o); if (lane >= o) { cb = fmaxf(tb + ca, cb); ca = ta + ca; } }
        (void)pa; (void)pb;
        float ea = __shfl_up(ca, 1), eb = __shfl_up(cb, 1);
        float m0 = (lane == 0) ? 0.f : fmaxf(ea, eb);
        const float m1 = fmaxf(m0 + A0, B0), m2 = fmaxf(m1 + A1, B1);
        TAB[(hh * NCHUNK + 2 * lane) * 2] = __expf(A0 + m0 - m1); TAB[(hh * NCHUNK + 2 * lane) * 2 + 1] = __expf(B0 - m1);
        TAB[(hh * NCHUNK + 2 * lane + 1) * 2] = __expf(A1 + m1 - m2); TAB[(hh * NCHUNK + 2 * lane + 1) * 2 + 1] = __expf(B1 - m2);
        if (blockIdx.x == 0) { F.MTAB[hh * NCHUNK + 2 * lane] = m0; F.MTAB[hh * NCHUNK + 2 * lane + 1] = m1; }
    }
    __syncthreads();
    const int NT = F.G * NWAVES * 64, gt = (int)blockIdx.x * (NWAVES * 64) + F.tid;
    if (gt < D) { float b = 0.f;
#pragma unroll 8
        for (int k = 0; k < D / 64; ++k) b += F.BQP[(size_t)k * D + gt];
        F.BIASQ[gt] = b; }
    for (int p = gt; p < NHEAD * (DH * DH / 2); p += NT) {
        const int hh = p / (DH * DH / 2), q = p % (DH * DH / 2);
        GAS unsigned* sp = (GAS unsigned*)(F.STATE + (size_t)hh * NCHUNK * (DH * DH)) + q;
        float s0 = 0.f, s1 = 0.f;
#pragma unroll 1
        for (int k0 = 0; k0 < NCHUNK; k0 += 16) {
            unsigned ld[16];
#pragma unroll
            for (int k = 0; k < 16; ++k) ld[k] = sp[(size_t)(k0 + k) * (DH * DH / 2)];
#pragma unroll
            for (int k = 0; k < 16; ++k) {
                sp[(size_t)(k0 + k) * (DH * DH / 2)] = pk2(s0, s1);
                const float dec = TAB[(hh * NCHUNK + k0 + k) * 2], wb = TAB[(hh * NCHUNK + k0 + k) * 2 + 1];
                s0 = dec * s0 + wb * bflo(ld[k]); s1 = dec * s1 + wb * bfhi(ld[k]);
            }
        }
    }
    for (int p = gt; p < NHEAD * DH; p += NT) {
        const int hh = p / DH, d = p % DH; float* np = F.NST + (size_t)hh * NCHUNK * DH + d; float s = 0.f;
#pragma unroll 8
        for (int k = 0; k < NCHUNK; ++k) { const float ld = np[(size_t)k * DH]; np[(size_t)k * DH] = s; s = TAB[(hh * NCHUNK + k) * 2] * s + TAB[(hh * NCHUNK + k) * 2 + 1] * ld; }
    }
}
constexpr int M3_QI = 8192, M3_R2 = 75776, M3_QP = 528, M3_CP = 272, M3_VP = 264;
static_assert(M3_R2 + 256 * M3_CP <= LDSCTL_OFF, "P4 LDS map");
DI void m3_item(Frame& F, int hh, int kc) {
    LAS float* GS = (LAS float*)F.lds; LAS float* MX = GS + 128; LAS float* BT = GS + 256; LAS float* NK = GS + 384; LAS float* XCH = GS + 640;
    LAS unsigned char* QI = F.lds + M3_QI; LAS unsigned char* R2 = F.lds + M3_R2;
    int tid = F.tid; asm volatile("" : "+v"(tid));
    const int t0 = kc * CH, lane = F.lane, item = hh * NCHUNK + kc;
    const float mk = F.MTAB[item];
    const bf16* cbase = F.STATE + (size_t)item * (DH * DH);
    const bf16* kbase = F.KC + (size_t)t0 * 1024 + hh * DH;
    const bf16* qbase = F.QC + (size_t)t0 * 1024 + hh * DH;
    const bf16* vbase = F.VT + (size_t)(hh * DH) * M + t0;
    {
        v4u tk[8], tq[8];
#pragma unroll
        for (int i = 0; i < 8; ++i) { const int p = tid + 512 * i; tk[i] = *(const GAS v4u*)(kbase + (size_t)(p >> 5) * 1024 + (p & 31) * 8); tq[i] = *(const GAS v4u*)(qbase + (size_t)(p >> 5) * 1024 + (p & 31) * 8); }
        if (F.wave == 0) {
            const float* gp = F.GATES + (size_t)(t0 + 2 * lane) * 8;
            const float i0 = gp[hh], lf0 = gp[4 + hh], i1 = gp[8 + hh], lf1 = gp[12 + hh];
            const float p = lf0 + lf1; float inc = p;
#pragma unroll
            for (int o = 1; o < 64; o <<= 1) { const float t = __shfl_up(inc, o); if (lane >= o) inc += t; }
            const float ex = inc - p, b0 = ex + lf0, b1 = ex + p;
            const float g0 = i0 - b0, g1 = i1 - b1;
            float cm = fmaxf(g0, g1);
#pragma unroll
            for (int o = 1; o < 64; o <<= 1) { const float t = __shfl_up(cm, o); if (lane >= o) cm = fmaxf(cm, t); }
            float pm = __shfl_up(cm, 1); if (lane == 0) pm = -INFINITY;
            const float M0 = fmaxf(mk, fmaxf(pm, g0)), M1 = fmaxf(M0, g1);
            GS[2 * lane] = g0; GS[2 * lane + 1] = g1; MX[2 * lane] = M0; MX[2 * lane + 1] = M1; BT[2 * lane] = b0; BT[2 * lane + 1] = b1;
        }
        if (tid < 256) NK[tid] = F.NST[(size_t)item * DH + tid];
#pragma unroll
        for (int i = 0; i < 8; ++i) { const int p = tid + 512 * i; *(LAS v4u*)(R2 + (p >> 5) * M3_QP + (p & 31) * 16) = tk[i]; *(LAS v4u*)(QI + (p >> 5) * M3_QP + (p & 31) * 16) = tq[i]; }
    }
    __syncthreads();
    const int r = lane & 31, h = lane >> 5, tt = F.wave & 3, eh = F.wave >> 2;
    const int tl = tt * 32 + r, t = t0 + tl;
    const float Mt = MX[tl], winter = __expf(mk - Mt);
    const LAS unsigned char* qrow = QI + tl * M3_QP + 16 * h;
    const LAS float* GSh = GS + 4 * h; int tlo = tl - 4 * h; asm volatile("" : "+v"(tlo));
    bf16x8 xs[4][2]; float den = 0.f;
#pragma unroll
    for (int st = 0; st < 4; ++st) {
        if (st <= tt) {
            f32x16 accS = zero16();
            const LAS unsigned char* krow = R2 + (st * 32 + r) * M3_QP + 16 * h;
#pragma unroll 4
            for (int ks = 0; ks < 16; ++ks) { const bf16x8 kf = *(const LAS bf16x8*)(krow + 32 * ks); const bf16x8 qf = *(const LAS bf16x8*)(qrow + 32 * ks); accS = MFMA32(kf, qf, accS); }
            float xv[16];
#pragma unroll
            for (int reg = 0; reg < 16; ++reg) { const int sc = st * 32 + (reg & 3) + 8 * (reg >> 2); float v = accS[reg] * __expf(GSh[sc] - Mt); if (sc > tlo) v = 0.f; xv[reg] = v; den += v; }
#pragma unroll
            for (int k2 = 0; k2 < 2; ++k2) { v4u xw; xw.x = pk2(xv[8 * k2], xv[8 * k2 + 1]); xw.y = pk2(xv[8 * k2 + 2], xv[8 * k2 + 3]); xw.z = pk2(xv[8 * k2 + 4], xv[8 * k2 + 5]); xw.w = pk2(xv[8 * k2 + 6], xv[8 * k2 + 7]);
                xs[st][k2] = __builtin_bit_cast(bf16x8, xw); }
        } else { xs[st][0] = (bf16x8){0, 0, 0, 0, 0, 0, 0, 0}; xs[st][1] = xs[st][0]; }
        asm volatile("" ::: "memory");
    }
    f32x16 accH[4];
#pragma unroll
    for (int i = 0; i < 4; ++i) accH[i] = zero16();
    float qn = 0.f;
#pragma unroll 1
    for (int hf = 0; hf < 2; ++hf) {
        v4u tc[8];
#pragma unroll
        for (int i = 0; i < 8; ++i) { const int p = tid + 512 * i; tc[i] = *(const GAS v4u*)(cbase + (size_t)(p >> 4) * DH + hf * 128 + (p & 15) * 8); }
        __syncthreads();
#pragma unroll
        for (int i = 0; i < 8; ++i) { const int p = tid + 512 * i; *(LAS v4u*)(R2 + (p >> 4) * M3_CP + (p & 15) * 16) = tc[i]; }
        __syncthreads();
        const LAS unsigned char* crow0 = R2 + (eh * 128 + r) * M3_CP + 16 * h;
#pragma unroll 2
        for (int ks = 0; ks < 8; ++ks) {
            const int kg = hf * 8 + ks;
            const v4u qw = *(const LAS v4u*)(qrow + 32 * kg);
            float qv[8] = {bflo(qw.x), bfhi(qw.x), bflo(qw.y), bfhi(qw.y), bflo(qw.z), bfhi(qw.z), bflo(qw.w), bfhi(qw.w)};
            const f32x4 na = *(const LAS f32x4*)(NK + kg * 16 + 8 * h), nb = *(const LAS f32x4*)(NK + kg * 16 + 8 * h + 4);
            qn += (qv[0] * na.x + qv[1] * na.y) + (qv[2] * na.z + qv[3] * na.w) + (qv[4] * nb.x + qv[5] * nb.y) + (qv[6] * nb.z + qv[7] * nb.w);
            v4u q2; q2.x = pk2(qv[0] * winter, qv[1] * winter); q2.y = pk2(qv[2] * winter, qv[3] * winter); q2.z = pk2(qv[4] * winter, qv[5] * winter); q2.w = pk2(qv[6] * winter, qv[7] * winter);
            const bf16x8 q2f = __builtin_bit_cast(bf16x8, q2);
#pragma unroll
            for (int et = 0; et < 4; ++et) { const bf16x8 cf = *(const LAS bf16x8*)(crow0 + et * 32 * M3_CP + 32 * ks); accH[et] = MFMA32(cf, q2f, accH[et]); }
        }
    }
    qn += __shfl_xor(qn, 32);
    {
        v4u tv[8];
#pragma unroll
        for (int i = 0; i < 8; ++i) { const int p = tid + 512 * i; tv[i] = *(const GAS v4u*)(vbase + (size_t)(p >> 4) * M + (p & 15) * 8); }
        __syncthreads();
#pragma unroll
        for (int i = 0; i < 8; ++i) { const int p = tid + 512 * i; LAS unsigned char* d = R2 + (p >> 4) * M3_VP + (p & 15) * 16;
            *(LAS v2u*)d = (v2u){tv[i].x, tv[i].y}; *(LAS v2u*)(d + 8) = (v2u){tv[i].z, tv[i].w}; }
    }
    __syncthreads();
    const LAS unsigned char* vrow0 = R2 + (eh * 128 + r) * M3_VP + 8 * h;
#pragma unroll
    for (int st = 0; st < 4; ++st) if (st <= tt) {
#pragma unroll
        for (int k2 = 0; k2 < 2; ++k2)
#pragma unroll
            for (int et = 0; et < 4; ++et) {
                const LAS unsigned char* vp = vrow0 + et * 32 * M3_VP + (st * 32 + 16 * k2) * 2;
                const v2u lo = *(const LAS v2u*)vp, hi = *(const LAS v2u*)(vp + 16);
                v4u vw; vw.x = lo.x; vw.y = lo.y; vw.z = hi.x; vw.w = hi.y;
                accH[et] = MFMA32(__builtin_bit_cast(bf16x8, vw), xs[st][k2], accH[et]);
                asm volatile("" ::: "memory");
            }
    }
    v4u to[8];
    { const bf16* obase = F.PROJ + (size_t)t0 * NPROJ + C_OM + hh * DH;
#pragma unroll
      for (int i = 0; i < 8; ++i) { const int p = tid + 512 * i; to[i] = *(const GAS v4u*)(obase + (size_t)(p >> 5) * NPROJ + (p & 31) * 8); } }
    den += __shfl_xor(den, 32);
    den += winter * qn;
    const float dnm = fmaxf(fabsf(den), __expf(-(BT[tl] + Mt))), inv = 1.0f / dnm;
    float ss = 0.f;
#pragma unroll
    for (int et = 0; et < 4; ++et)
#pragma unroll
        for (int reg = 0; reg < 16; ++reg) { accH[et][reg] *= inv; ss += accH[et][reg] * accH[et][reg]; }
    ss += __shfl_xor(ss, 32);
    if (h == 0) XCH[eh * 128 + tl] = ss;
#pragma unroll
    for (int i = 0; i < 8; ++i) { const int p = tid + 512 * i; *(LAS v4u*)(QI + (p >> 5) * M3_QP + (p & 31) * 16) = to[i]; }
    __syncthreads();
    const float rstd = 1.0f / sqrtf((XCH[tl] + XCH[128 + tl]) * (1.0f / DH) + EPS);
    LAS unsigned char* orow = QI + tl * M3_QP + (eh * 128 + 4 * h) * 2;
    const float* ngp = F.mlstm_norm_g + hh * DH + eh * 128;
#pragma unroll
    for (int et = 0; et < 4; ++et)
#pragma unroll
        for (int gq = 0; gq < 4; ++gq) { const int el = et * 32 + 8 * gq + 4 * h; LAS v2u* op = (LAS v2u*)(orow + (et * 32 + 8 * gq) * 2);
            const v2u ow = *op; const f32x4 gn = *(const GAS f32x4*)(ngp + el);
            const float y0 = accH[et][4 * gq] * rstd * gn.x * sigmoid_f(bflo(ow.x)), y1 = accH[et][4 * gq + 1] * rstd * gn.y * sigmoid_f(bfhi(ow.x));
            const float y2 = accH[et][4 * gq + 2] * rstd * gn.z * sigmoid_f(bflo(ow.y)), y3 = accH[et][4 * gq + 3] * rstd * gn.w * sigmoid_f(bfhi(ow.y));
            v2u o; o.x = pk2(y0, y1); o.y = pk2(y2, y3); *op = o; }
    __syncthreads();
#pragma unroll
    for (int i = 0; i < 8; ++i) { const int p = tid + 512 * i, row = p >> 5, c16 = p & 31;
        *(GAS v4u*)(F.HA + (size_t)(t0 + row) * D + 1024 + hh * DH + c16 * 8) = *(const LAS v4u*)(QI + row * M3_QP + c16 * 16); }
    __syncthreads();
}
DI void p4_phase(Frame& F) {
    for (int it = (int)blockIdx.x; it < NHEAD * NCHUNK; it += F.G) m3_item(F, it / NCHUNK, it % NCHUNK);
}
constexpr int KPITCH = 272, P8_TBL = 69632;
DI void topk_insert(float (&L)[16], float x) {
#pragma unroll
    for (int i = 15; i >= 1; --i) L[i] = __builtin_amdgcn_fmed3f(x, L[i - 1], L[i]);
    L[0] = fmaxf(L[0], x);
}
DI void p8_phase(Frame& F) {
    LAS unsigned char* KIMG = F.lds; LAS unsigned char* TBL = F.lds + P8_TBL + F.wave * 1024;
    const int lane = F.lane, tid = F.tid, r = lane & 31, h = lane >> 5;
#pragma unroll 4
    for (int i = 0; i < 16; ++i) { const int idx = tid * 4 + 2048 * i, side = idx >> 14, rem = idx & 16383, row = rem >> 7, col = rem & 127;
        const f32x4 a = *(const GAS f32x4*)((side ? F.keys2 : F.keys1) + rem);
        v2u o; o.x = pk2(a.x, a.y); o.y = pk2(a.z, a.w); *(LAS v2u*)(KIMG + (side * 128 + row) * KPITCH + col * 2) = o; }
    __syncthreads();
    for (int it = (int)blockIdx.x; it < (M / 256) * PH; it += F.G) {
        const int tile = it / PH, hd = it % PH;
        const int t = tile * 256 + F.wave * 32 + r;
        float L1[16], L2[16];
#pragma unroll 1
        for (int side = 0; side < 2; ++side) {
            f32x16 acc[4];
#pragma unroll
            for (int kt = 0; kt < 4; ++kt) acc[kt] = zero16();
            const bf16* qp = F.QB + (size_t)t * D + hd * 256 + side * 128 + 8 * h;
#pragma unroll
            for (int ks = 0; ks < 8; ++ks) {
                const bf16x8 qf = *(const GAS bf16x8*)(qp + ks * 16);
#pragma unroll
                for (int kt = 0; kt < 4; ++kt) { const bf16x8 kf = *(const LAS bf16x8*)(KIMG + (side * 128 + kt * 32 + r) * KPITCH + (ks * 16 + 8 * h) * 2); acc[kt] = MFMA32(kf, qf, acc[kt]); }
            }
            float L[16];
#pragma unroll
            for (int i = 0; i < 16; ++i) L[i] = -3.0e38f;
#pragma unroll
            for (int kt = 0; kt < 4; ++kt)
#pragma unroll
                for (int reg = 0; reg < 16; ++reg) { const unsigned key = (unsigned)(kt * 32 + crow(reg, h)); const float sv = acc[kt][reg];
                    topk_insert(L, __uint_as_float((__float_as_uint(sv) & ~127u) | key)); }
            float P[16];
#pragma unroll
            for (int i = 0; i < 16; ++i) P[i] = __shfl_xor(L[i], 32);
#pragma unroll
            for (int i = 0; i < 16; ++i) topk_insert(L, P[i]);
            if (side == 0) {
#pragma unroll
                for (int i = 0; i < 16; ++i) L1[i] = L[i];
            } else {
#pragma unroll
                for (int i = 0; i < 16; ++i) L2[i] = L[i];
            }
        }
        if (h == 0) {
#pragma unroll
            for (int w = 0; w < 4; ++w) {
                const unsigned a = (__builtin_bit_cast(unsigned, L1[4 * w]) & 127u) | ((__builtin_bit_cast(unsigned, L1[4 * w + 1]) & 127u) << 8) | ((__builtin_bit_cast(unsigned, L1[4 * w + 2]) & 127u) << 16) | ((__builtin_bit_cast(unsigned, L1[4 * w + 3]) & 127u) << 24);
                const unsigned b = (__builtin_bit_cast(unsigned, L2[4 * w]) & 127u) | ((__builtin_bit_cast(unsigned, L2[4 * w + 1]) & 127u) << 8) | ((__builtin_bit_cast(unsigned, L2[4 * w + 2]) & 127u) << 16) | ((__builtin_bit_cast(unsigned, L2[4 * w + 3]) & 127u) << 24);
                *(LAS unsigned*)(TBL + r * 32 + 4 * w) = a; *(LAS unsigned*)(TBL + r * 32 + 16 + 4 * w) = b;
            }
        }
        float T[16];
#pragma unroll
        for (int i = 0; i < 16; ++i) T[i] = -3.0e38f;
#pragma unroll
        for (int i = 0; i < 16; ++i) {
            const float v1 = __builtin_bit_cast(float, __builtin_bit_cast(unsigned, L1[i]) & ~127u);
#pragma unroll
            for (int j = 0; j < 16; ++j) if ((i + 1) * (j + 1) <= 16) {
                const float v2 = __builtin_bit_cast(float, __builtin_bit_cast(unsigned, L2[j]) & ~127u);
                topk_insert(T, __builtin_bit_cast(float, (__builtin_bit_cast(unsigned, v1 + v2) & ~255u) | (unsigned)(i * 16 + j)));
            }
        }
        LDS_WAIT(); asm volatile("" ::: "memory");
        float ev[16], esum = 0.f;
        const float mx = __builtin_bit_cast(float, __builtin_bit_cast(unsigned, T[0]) & ~255u);
#pragma unroll
        for (int i = 0; i < 16; ++i) { ev[i] = __expf(__builtin_bit_cast(float, __builtin_bit_cast(unsigned, T[i]) & ~255u) - mx); esum += ev[i]; }
        const float einv = 1.0f / esum;
        int eid[8]; float gt[8];
#pragma unroll
        for (int i = 0; i < 8; ++i) { const float tv = h ? T[8 + i] : T[i]; const float e = h ? ev[8 + i] : ev[i];
            const unsigned p = __builtin_bit_cast(unsigned, tv) & 255u;
            const unsigned i1 = *(const LAS unsigned char*)(TBL + r * 32 + (p >> 4)), i2 = *(const LAS unsigned char*)(TBL + r * 32 + 16 + (p & 15u));
            eid[i] = (int)(i1 * 128u + i2); gt[i] = e * einv; }
        int* ip = F.IDX + (size_t)t * NSEL + hd * 16 + 8 * h; float* gp = F.PG + (size_t)t * NSEL + hd * 16 + 8 * h;
        *(GAS v4u*)ip = (v4u){(unsigned)eid[0], (unsigned)eid[1], (unsigned)eid[2], (unsigned)eid[3]}; *(GAS v4u*)(ip + 4) = (v4u){(unsigned)eid[4], (unsigned)eid[5], (unsigned)eid[6], (unsigned)eid[7]};
        *(GAS f32x4*)gp = (f32x4){gt[0], gt[1], gt[2], gt[3]}; *(GAS f32x4*)(gp + 4) = (f32x4){gt[4], gt[5], gt[6], gt[7]};
        LDS_WAIT(); asm volatile("" ::: "memory");
    }
}
constexpr int P9_IDX = 131072, P9_SH = 147456, P9_CORR = 147712, P9_GF = 32768, P9_FG = 40960, P9_SSQ = 49152, P9_CQ = 65536, P9_CT = 81920, P9_CSQ = 82176, NSLICE = 16, SLICE_B = 128;
#ifndef NSLICE_A
#define NSLICE_A NSLICE
#endif
#ifndef NSLICE_C
#define NSLICE_C NSLICE
#endif
template <int N, int MASK> DI void red_step_i(int (&v)[8], int lane) {
#pragma unroll
    for (int i = 0; i < N / 2; ++i) { const bool up = (lane & MASK) != 0; const int keep = up ? v[i + N / 2] : v[i], send = up ? v[i] : v[i + N / 2]; v[i] = keep + __shfl_xor(send, MASK); }
}
template <int N, int MASK> DI void red_step_f(float (&v)[16], int lane) {
#pragma unroll
    for (int i = 0; i < N / 2; ++i) { const bool up = (lane & MASK) != 0; const float keep = up ? v[i + N / 2] : v[i], send = up ? v[i] : v[i + N / 2]; v[i] = keep + __shfl_xor(send, MASK); }
}
typedef _Float16 h2v __attribute__((ext_vector_type(2)));
DI void acc4(float& o0, float& o1, float& o2, float& o3, unsigned u, float c) {
    const h2v p = __builtin_bit_cast(h2v, __builtin_amdgcn_perm(u, 0x64646464u, 0x01050004u));
    const h2v q = __builtin_bit_cast(h2v, __builtin_amdgcn_perm(u, 0x64646464u, 0x01070006u));
    o0 = __builtin_fmaf((float)p.x, c, o0); o1 = __builtin_fmaf((float)p.y, c, o1); o2 = __builtin_fmaf((float)q.x, c, o2); o3 = __builtin_fmaf((float)q.y, c, o3);
}
template <int N> DI void red32_f(float (&v)[16]) {
#pragma unroll
    for (int i = 0; i < N / 2; ++i) { const auto rr = __builtin_amdgcn_permlane32_swap(__float_as_uint(v[i]), __float_as_uint(v[i + N / 2]), false, false); v[i] = __uint_as_float(rr[0]) + __uint_as_float(rr[1]); }
}
template <int N> DI void red16_f(float (&v)[16]) {
#pragma unroll
    for (int i = 0; i < N / 2; ++i) { const auto rr = __builtin_amdgcn_permlane16_swap(__float_as_uint(v[i]), __float_as_uint(v[i + N / 2]), false, false); v[i] = __uint_as_float(rr[0]) + __uint_as_float(rr[1]); }
}
template <int N> DI void red8_f(float (&v)[16], int lane) {
#pragma unroll
    for (int i = 0; i < N / 2; ++i) { const bool up = (lane & 8) != 0; const float keep = up ? v[i + N / 2] : v[i], send = up ? v[i] : v[i + N / 2];
        v[i] = keep + __builtin_bit_cast(float, __builtin_amdgcn_mov_dpp(__builtin_bit_cast(int, send), 0x128, 0xf, 0xf, true)); }
}
template <int N> DI void redi32(int (&v)[16]) {
#pragma unroll
    for (int i = 0; i < N / 2; ++i) { const auto rr = __builtin_amdgcn_permlane32_swap((unsigned)v[i], (unsigned)v[i + N / 2], false, false); v[i] = (int)(rr[0] + rr[1]); }
}
template <int N> DI void redi16(int (&v)[16]) {
#pragma unroll
    for (int i = 0; i < N / 2; ++i) { const auto rr = __builtin_amdgcn_permlane16_swap((unsigned)v[i], (unsigned)v[i + N / 2], false, false); v[i] = (int)(rr[0] + rr[1]); }
}
template <int N> DI void redi8(int (&v)[16], int lane) {
#pragma unroll
    for (int i = 0; i < N / 2; ++i) { const bool up = (lane & 8) != 0; const int keep = up ? v[i + N / 2] : v[i], send = up ? v[i] : v[i + N / 2]; v[i] = keep + __builtin_amdgcn_mov_dpp(send, 0x128, 0xf, 0xf, true); }
}
DI void p9v2_phase(Frame& F) {
    LAS unsigned char* HQ = F.lds; LAS float* A2 = (LAS float*)(F.lds + P9_IDX); LAS float* B2 = (LAS float*)(F.lds + P9_IDX + 8192);
    LAS unsigned short* IDX16 = (LAS unsigned short*)(F.lds + P9_IDX); LAS float* SH = (LAS float*)(F.lds + P9_SH); LAS float* CORR = (LAS float*)(F.lds + P9_CORR);
    LAS float* GF = (LAS float*)(F.lds + P9_GF); LAS float* FG = (LAS float*)(F.lds + P9_FG);
    const int lane = F.lane, tid = F.tid, c8 = lane & 7, g = lane >> 3;
#pragma unroll 1
    for (int tb = (int)blockIdx.x * 64; tb < M; tb += F.G * 64) {
#pragma unroll
        for (int i = 0; i < 4; ++i) { const int c = tid + 512 * i; A2[c] = F.norm_ffn_g[c] * (1.0f + F.MODF[MOD_SCF + c]); B2[c] = F.MODF[MOD_SHF + c]; }
        __syncthreads();
#pragma unroll 1
        for (int j = 0; j < 8; ++j) {
            const int tl = F.wave * 8 + j, t = tb + tl;
            float hv[32]; float ss = 0.f;
            const bf16* xr = F.X1B + (size_t)t * D + 16 * lane;
#pragma unroll
            for (int jj = 0; jj < 2; ++jj)
#pragma unroll
                for (int q = 0; q < 2; ++q) { const v4u a = *(const GAS v4u*)(xr + 1024 * jj + 8 * q); const int o = 16 * jj + 8 * q;
                    hv[o] = bflo(a.x); hv[o + 1] = bfhi(a.x); hv[o + 2] = bflo(a.y); hv[o + 3] = bfhi(a.y); hv[o + 4] = bflo(a.z); hv[o + 5] = bfhi(a.z); hv[o + 6] = bflo(a.w); hv[o + 7] = bfhi(a.w); }
#pragma unroll
            for (int i = 0; i < 32; ++i) ss += hv[i] * hv[i];
            const float rstd = 1.0f / sqrtf(wave_sum(ss) * (1.0f / D) + EPS);
            float am = 0.f;
#pragma unroll
            for (int jj = 0; jj < 2; ++jj)
#pragma unroll
                for (int q = 0; q < 4; ++q) { const f32x4 a = *(const LAS f32x4*)(A2 + 1024 * jj + 16 * lane + 4 * q), b = *(const LAS f32x4*)(B2 + 1024 * jj + 16 * lane + 4 * q);
                    const int o = 16 * jj + 4 * q;
                    hv[o] = hv[o] * rstd * a.x + b.x; hv[o + 1] = hv[o + 1] * rstd * a.y + b.y; hv[o + 2] = hv[o + 2] * rstd * a.z + b.z; hv[o + 3] = hv[o + 3] * rstd * a.w + b.w;
                    am = fmaxf(am, fmaxf(fmaxf(fabsf(hv[o]), fabsf(hv[o + 1])), fmaxf(fabsf(hv[o + 2]), fabsf(hv[o + 3])))); }
            am = fmaxf(wave_max(am), 1e-30f); const float inv = 127.0f / am;
            if (lane == 0) SH[tl] = am * (1.0f / 127.0f);
#pragma unroll
            for (int jj = 0; jj < 2; ++jj) { v4u o;
#pragma unroll
                for (int q = 0; q < 4; ++q) { const int b = 16 * jj + 4 * q;
                    const int q0 = (int)__builtin_rintf(hv[b] * inv), q1 = (int)__builtin_rintf(hv[b + 1] * inv), q2 = (int)__builtin_rintf(hv[b + 2] * inv), q3 = (int)__builtin_rintf(hv[b + 3] * inv);
                    o[q] = (unsigned)(q0 & 255) | ((unsigned)(q1 & 255) << 8) | ((unsigned)(q2 & 255) << 16) | ((unsigned)(q3 & 255) << 24); }
                *(LAS v4u*)(HQ + tl * 2048 + 1024 * jj + 16 * lane) = o; }
        }
        __syncthreads();
#pragma unroll
        for (int i = 0; i < 16; ++i) { const int q = tid + 512 * i, k = q & 127; IDX16[(q & ~127) + (k & 64) + 8 * (k & 7) + ((k >> 3) & 7)] = (unsigned short)F.IDX[(size_t)tb * NSEL + q]; }
        __syncthreads();
        int P[8][2];
#pragma unroll
        for (int j = 0; j < 8; ++j) { P[j][0] = 0; P[j][1] = 0; }
#pragma unroll 1
        for (int s = 0; s < NSLICE_A; ++s) {
            if (((s ^ (F.wave >> 2)) & 1) != 0) __builtin_amdgcn_s_setprio(1); else __builtin_amdgcn_s_setprio(0);
            const unsigned char* eb = F.ED + s * SLICE_B;
            const unsigned lo = (unsigned)(c8 * 16);
            v4u wA[8], wB[8];
#define P9A_LOAD(W, J, H) do { _Pragma("unroll") for (int i = 0; i < 8; ++i) { const unsigned e = IDX16[(F.wave * 8 + (J)) * 128 + 64 * (H) + 8 * g + i]; W[i] = *(const GAS v4u*)(eb + (e * 2048u + lo)); } } while (0)
#define P9A_COMP(W, J, H) do { const v4u hq = *(const LAS v4u*)(HQ + (F.wave * 8 + (J)) * 2048 + s * SLICE_B + c8 * 16); int a[8]; \
                _Pragma("unroll") for (int i = 0; i < 8; ++i) { int d = 0; const v4u ww = W[i]; \
                    d = __builtin_amdgcn_sdot4((int)hq.x, (int)ww.x, d, false); d = __builtin_amdgcn_sdot4((int)hq.y, (int)ww.y, d, false); d = __builtin_amdgcn_sdot4((int)hq.z, (int)ww.z, d, false); d = __builtin_amdgcn_sdot4((int)hq.w, (int)ww.w, d, false); a[i] = d; } \
                red_step_i<8, 4>(a, lane); red_step_i<4, 2>(a, lane); red_step_i<2, 1>(a, lane); P[J][H] += a[0]; asm volatile("" ::: "memory"); } while (0)
            P9A_LOAD(wA, 0, 0);
#pragma unroll
            for (int j = 0; j < 8; ++j) {
                P9A_LOAD(wB, j, 1);
                P9A_COMP(wA, j, 0);
                if (j < 7) P9A_LOAD(wA, j + 1, 0);
                P9A_COMP(wB, j, 1);
            }
#undef P9A_LOAD
#undef P9A_COMP
        }
        __builtin_amdgcn_s_setprio(0);
        __syncthreads();
        LAS int* PI = (LAS int*)F.lds;
#pragma unroll
        for (int j = 0; j < 8; ++j) { const int tl = F.wave * 8 + j; PI[tl * 128 + 8 * c8 + g] = P[j][0]; PI[tl * 128 + 64 + 8 * c8 + g] = P[j][1]; }
#pragma unroll
        for (int i = 0; i < 4; ++i) { const int c = tid + 512 * i; GF[c] = F.MODF[MOD_GF + c]; FG[c] = F.final_g[c]; }
        LAS float* SSQL = (LAS float*)(F.lds + P9_SSQ); LAS short* CQ = (LAS short*)(F.lds + P9_CQ); LAS float* CT = (LAS float*)(F.lds + P9_CT); LAS int* CSQ = (LAS int*)(F.lds + P9_CSQ);
#pragma unroll 1
        for (int j = 0; j < 8; ++j) { const int tl = F.wave * 8 + j, t = tb + tl; const float sh = SH[tl]; float cf[2]; float am = 0.f;
#pragma unroll
            for (int h = 0; h < 2; ++h) { const int k = 64 * h + lane; const unsigned e = IDX16[tl * 128 + 64 * h + 8 * (lane & 7) + (lane >> 3)];
                const float act = (float)PI[tl * 128 + k] * (sh * F.SD[e]); cf[h] = F.PG[(size_t)t * NSEL + k] * gelu_f(act) * F.SU[e]; am = fmaxf(am, fabsf(cf[h])); }
            am = fmaxf(wave_max(am), 1e-30f); const float inv = 32767.0f / am; int qs = 0;
#pragma unroll
            for (int h = 0; h < 2; ++h) { const int q = (int)__builtin_rintf(cf[h] * inv); qs += q; CQ[tl * 128 + 64 * h + 8 * (lane & 7) + (lane >> 3)] = (short)q; }
#pragma unroll
            for (int o = 1; o < 64; o <<= 1) qs += __shfl_xor(qs, o);
            if (lane == 0) { CT[tl] = am * (1.0f / 32767.0f); CSQ[tl] = 128 * qs; }
            }
        __syncthreads();
        const int cb = c8 * 16 + ((lane >> 5) & 1) * 8 + ((lane >> 4) & 1) * 4 + ((lane >> 3) & 1) * 2;
        typedef short s16x2 __attribute__((ext_vector_type(2)));
#pragma unroll 1
        for (int s = 0; s < NSLICE_C; ++s) {
            if (((s ^ (F.wave >> 2)) & 1) != 0) __builtin_amdgcn_s_setprio(1); else __builtin_amdgcn_s_setprio(0);
            const unsigned char* eb = F.EU + s * SLICE_B;
            const unsigned lo = (unsigned)(c8 * 16);
            v4u wA[8], wB[8]; unsigned cA[4], cB[4];
#define P9C_LOAD(W, C, TL, H) do { const LAS unsigned* ip = (const LAS unsigned*)(IDX16 + (TL) * 128 + 64 * (H) + 8 * g); const LAS unsigned* cp = (const LAS unsigned*)(CQ + (TL) * 128 + 64 * (H) + 8 * g); \
                _Pragma("unroll") for (int i2 = 0; i2 < 4; ++i2) { const unsigned ee = ip[i2]; C[i2] = cp[i2]; \
                    W[2 * i2] = *(const GAS v4u*)(eb + ((ee & 0xffffu) * 2048u + lo)); W[2 * i2 + 1] = *(const GAS v4u*)(eb + ((ee >> 16) * 2048u + lo)); } } while (0)
#define P9C_D4(O, UA, UB, CC) do { O[0] = __builtin_amdgcn_sdot2(__builtin_bit_cast(s16x2, __builtin_amdgcn_perm(UB, UA, 0x0c040c00u)), __builtin_bit_cast(s16x2, CC), O[0], false); \
                O[1] = __builtin_amdgcn_sdot2(__builtin_bit_cast(s16x2, __builtin_amdgcn_perm(UB, UA, 0x0c050c01u)), __builtin_bit_cast(s16x2, CC), O[1], false); \
                O[2] = __builtin_amdgcn_sdot2(__builtin_bit_cast(s16x2, __builtin_amdgcn_perm(UB, UA, 0x0c060c02u)), __builtin_bit_cast(s16x2, CC), O[2], false); \
                O[3] = __builtin_amdgcn_sdot2(__builtin_bit_cast(s16x2, __builtin_amdgcn_perm(UB, UA, 0x0c070c03u)), __builtin_bit_cast(s16x2, CC), O[3], false); } while (0)
#define P9C_ACC(W, C) do { _Pragma("unroll") for (int i2 = 0; i2 < 4; ++i2) { const v4u ua = W[2 * i2], ub = W[2 * i2 + 1]; const unsigned cc = C[i2]; \
                P9C_D4((o + 0), ua.x, ub.x, cc); P9C_D4((o + 4), ua.y, ub.y, cc); P9C_D4((o + 8), ua.z, ub.z, cc); P9C_D4((o + 12), ua.w, ub.w, cc); } asm volatile("" ::: "memory"); } while (0)
            P9C_LOAD(wA, cA, F.wave * 8, 0);
#pragma unroll 1
            for (int j = 0; j < 8; ++j) {
                const int tl = F.wave * 8 + j, t = tb + tl;
                int o[16];
#pragma unroll
                for (int b = 0; b < 16; ++b) o[b] = 0;
                P9C_LOAD(wB, cB, tl, 1);
                P9C_ACC(wA, cA);
                if (j < 7) P9C_LOAD(wA, cA, tl + 1, 0);
                P9C_ACC(wB, cB);
                redi32<16>(o); redi16<8>(o); redi8<4>(o, lane);
                const int col = s * SLICE_B + cb; const int csq = CSQ[tl]; const float ct = CT[tl];
                GAS unsigned* xp = (GAS unsigned*)(F.X1B + (size_t)t * D + col);
                const unsigned xw = *xp;
                const float y0 = bflo(xw) + GF[col] * ((float)(o[0] - csq) * ct), y1 = bfhi(xw) + GF[col + 1] * ((float)(o[1] - csq) * ct);
                *xp = pk2(y0, y1);
            }
#undef P9C_LOAD
#undef P9C_ACC
#undef P9C_D4
        }
        __builtin_amdgcn_s_setprio(0);
#pragma unroll 1
        for (int j = 0; j < 8; ++j) {
            const int tl = F.wave * 8 + j, t = tb + tl;
            const GAS v2u* xrow = (const GAS v2u*)(F.X1B + (size_t)t * D) + lane; GAS f32x4* orow = (GAS f32x4*)(F.out + (size_t)t * D) + lane;
            v2u xw[8]; float sq = 0.f;
#pragma unroll
            for (int q = 0; q < 8; ++q) { xw[q] = xrow[64 * q]; const float a0 = bflo(xw[q].x), a1 = bfhi(xw[q].x), a2 = bflo(xw[q].y), a3 = bfhi(xw[q].y); sq += (a0 * a0 + a1 * a1) + (a2 * a2 + a3 * a3); }
            const float rstd2 = 1.0f / sqrtf(wave_sum(sq) * (1.0f / D) + EPS);
#pragma unroll
            for (int q = 0; q < 8; ++q) { const f32x4 f = *(const LAS f32x4*)(FG + 256 * q + 4 * lane);
                orow[64 * q] = (f32x4){bflo(xw[q].x) * rstd2 * f.x, bfhi(xw[q].x) * rstd2 * f.y, bflo(xw[q].y) * rstd2 * f.z, bfhi(xw[q].y) * rstd2 * f.w}; }
        }
        __syncthreads();
    }
}
struct Args { const float* in[21]; float* out; unsigned char* ws; int ph_lo, ph_hi, li, pad; };
constexpr int N_PHASES = 10;
__global__ void __launch_bounds__(NWAVES * 64, 2) mk_fwd(Args args) {
    extern __shared__ __attribute__((aligned(16))) unsigned char lds[];
    Frame F;
    F.lds = (LAS unsigned char*)lds;
    F.MISC = (volatile LAS unsigned*)(F.lds + MISC_OFF);
    F.tid = threadIdx.x; F.lane = F.tid & 63; F.wave = __builtin_amdgcn_readfirstlane(F.tid >> 6);
    F.G = gridDim.x; { const int bx = blockIdx.x; F.vcu = (F.G % 8 == 0) ? (bx % 8) * (F.G / 8) + bx / 8 : bx; }
    unsigned char* ws = args.ws;
    F.ctl = (gu32*)(ws + WS_CTL);
    F.x = args.in[0]; F.c = args.in[1]; F.ada_w = args.in[2]; F.ada_b = args.in[3]; F.norm_mix_g = args.in[4]; F.w_in = args.in[5]; F.b_gates = args.in[6];
    F.conv_w = args.in[7]; F.conv_b = args.in[8]; F.gmlp_norm_g = args.in[9]; F.gmlp_w = args.in[10]; F.gmlp_b = args.in[11]; F.mlstm_norm_g = args.in[12];
    F.w_out = args.in[13]; F.norm_ffn_g = args.in[14]; F.wq = args.in[15]; F.keys1 = args.in[16]; F.keys2 = args.in[17]; F.e_down = args.in[18]; F.e_up = args.in[19]; F.final_g = args.in[20];
    F.out = args.out;
    F.MODP = (float*)(ws + WS_MODP); F.MODF = (float*)(ws + WS_MODF); F.GATES = (float*)(ws + WS_GATES); F.SUMM = (float*)(ws + WS_SUMM); F.MTAB = (float*)(ws + WS_MTAB);
    F.NST = (float*)(ws + WS_NST); F.PG = (float*)(ws + WS_PG); F.IDX = (int*)(ws + WS_IDX);
    F.WIN = (bf16*)(ws + WS_WIN); F.WOUT = (bf16*)(ws + WS_WOUT); F.WQ = (bf16*)(ws + WS_WQ); F.HA = (bf16*)(ws + WS_HA); F.PROJ = (bf16*)(ws + WS_PROJ); F.QB = (bf16*)(ws + WS_PROJ);
    F.STATE = (bf16*)(ws + WS_STATE); F.VT = (bf16*)(ws + WS_VT); F.ED = ws + WS_ED; F.EU = ws + WS_EU; F.SD = (float*)(ws + WS_SD); F.SU = (float*)(ws + WS_SU);
    F.H1Q = ws + WS_STATE;
    F.SW = (float*)(ws + WS_SW); F.CMAXP = (float*)(ws + WS_CMAXP); F.SA = (float*)(ws + WS_SA);
    F.SSQP = (float*)(ws + WS_SSQP); F.BQP = (float*)(ws + WS_BQP); F.BIASQ = (float*)(ws + WS_BIASQ); F.X1B = (bf16*)(ws + WS_STATE);
    F.QC = (bf16*)args.out; F.KC = (bf16*)args.out + (size_t)M * 1024;
    for (int u = F.tid; u < (LDS_BYTES - LDSCTL_OFF) / 4; u += NWAVES * 64) ((LAS unsigned*)(F.lds + LDSCTL_OFF))[u] = 0u;
    __syncthreads();
    const int lo = args.ph_lo, hi = args.ph_hi;
    const bool multi = (hi - lo) > 1;
    XcdBarrier bar; bar.bar = (unsigned*)(F.ctl + CW_BAR) + args.li * XCD_BAR_WORDS; bar.x = 0; bar.st = nullptr;
    if (multi) bar = xcd_barrier_post((unsigned*)(F.ctl + CW_BAR) + args.li * XCD_BAR_WORDS, F.MISC + 8);
#ifndef PH_MASK
#define PH_MASK 0x7ff
#endif
#define IN(k) (((PH_MASK >> (k)) & 1) && lo <= (k) && (k) < hi)
#define SEAM(k) do { if (IN(k) && IN((k) + 1)) xcd_barrier(bar); } while (0)
    if (IN(0)) { p0a_phase(F); } SEAM(0);
    if (IN(1)) { p0b_phase(F); } SEAM(1);
    if (IN(2)) {
        { pg8::Gemm g{(const pg8::bf16_t*)F.H1Q, F.WIN, M, NPROJ, D / 2}; pg8::StaticOrder S; S.init(M, NPROJ, F.G, (int)blockIdx.x);
          pg8::EpiQ8 E{F.PROJ, NPROJ, 2048 / 256, F.SA, F.SW};
          pg8::gemm_phase<pg8::EpiQ8, pg8::StaticOrder, PG8_ALIGN, PG8_SP2, true>(F.lds, g, S, E); }
        {
          pg8::Gemm g{(const pg8::bf16_t*)((const unsigned char*)F.WIN + (size_t)WROW_VM * D), (const pg8::bf16_t*)F.H1Q, 1024, M, D / 2}; pg8::StaticOrder S; S.init(1024, M, F.G, (int)blockIdx.x);
          pg8::EpiQ8 E{F.VT, M, 0, F.SW + WROW_VM, F.SA};
          pg8::gemm_phase<pg8::EpiQ8, pg8::StaticOrder, PG8_ALIGN, PG8_SP2, true>(F.lds, g, S, E); }
    } SEAM(2);
    if (IN(3)) { p2_phase(F); } SEAM(3);
    if (IN(4)) { p3_phase(F); } SEAM(4);
    if (IN(5)) { p4_phase(F); } SEAM(5);
    if (IN(6)) {
        pg8::Gemm g{F.HA, F.WOUT, M, D, D}; pg8::StaticOrder S; S.init(M, D, F.G, (int)blockIdx.x);
        pg8::EpiResid2 E{F.x, F.MODF + MOD_GM, F.X1B, F.SSQP, D};
        pg8::gemm_phase<pg8::EpiResid2, pg8::StaticOrder, PG8_ALIGN, PG8_SP2>(F.lds, g, S, E);
    } SEAM(6);
    if (IN(7)) {
        pg8::Gemm g{F.X1B, F.WQ, M, D, D}; pg8::StaticOrder S; S.init(M, D, F.G, (int)blockIdx.x);
        LAS float* RSTDL = (LAS float*)(F.lds + RING_BYTES);
        { pg8::Unit u; for (int i = 0; S.next(i, u); ++i) { if (F.tid < 256) { const float* sp = F.SSQP + (size_t)(u.pm * 256 + F.tid) * 32; float ss = 0.f;
#pragma unroll
                    for (int q = 0; q < 8; ++q) { const f32x4 v = *(const GAS f32x4*)(sp + 4 * q); ss += (v.x + v.y) + (v.z + v.w); }
                    RSTDL[(u.pm & 1) * 256 + F.tid] = 1.0f / sqrtf(ss * (1.0f / D) + EPS); } } }
        __syncthreads();
        pg8::EpiQ E{F.QB, D, F.BIASQ, RSTDL};
        pg8::gemm_phase<pg8::EpiQ, pg8::StaticOrder, PG8_ALIGN, PG8_SP2>(F.lds, g, S, E);
    } SEAM(7);
#ifndef P8_ALT
#define P8_ALT 0
#endif
    if (IN(8)) { p8_phase(F); } SEAM(8);
#ifndef P9_V2
#define P9_V2 1
#endif
    if (IN(9)) { p9v2_phase(F); }
#undef IN
#undef SEAM
}

#ifndef MK_N_LAUNCHES
#define MK_N_LAUNCHES 1
#endif
extern "C" void kernel_launch(void* const* d_in, const int* in_sizes, int n_in, void* d_out, int out_size, void* d_ws, size_t ws_size, hipStream_t stream) {
    static int grid = 0;
    if (grid == 0) {
        if (n_in != 21 || in_sizes[0] != M * D || out_size != M * D || ws_size < WS_END) { fprintf(stderr, "kernel_launch: unexpected shapes (n_in %d, in0 %d, out %d, ws %zu); nothing launched\n", n_in, n_in > 0 ? in_sizes[0] : -1, out_size, ws_size); grid = -1; return; }
        int dev = 0, cus = 0, per_cu = 0;
        if (hipGetDevice(&dev) != hipSuccess || hipDeviceGetAttribute(&cus, hipDeviceAttributeMultiprocessorCount, dev) != hipSuccess) { grid = -1; return; }
        if (hipFuncSetAttribute((const void*)mk_fwd, hipFuncAttributeMaxDynamicSharedMemorySize, LDS_BYTES) != hipSuccess) { fprintf(stderr, "kernel_launch: hipFuncSetAttribute failed\n"); grid = -1; return; }
        if (hipOccupancyMaxActiveBlocksPerMultiprocessor(&per_cu, (const void*)mk_fwd, NWAVES * 64, LDS_BYTES) != hipSuccess || per_cu < 1) { fprintf(stderr, "kernel_launch: occupancy query says %d blocks per CU\n", per_cu); }
        (void)hipGetLastError();
        grid = cus;
    }
    if (grid < 0) return;
    (void)hipMemsetAsync((char*)d_ws + WS_CTL, 0, CTL_ZERO_BYTES, stream);
    Args a{};
    for (int i = 0; i < 21; ++i) a.in[i] = (const float*)d_in[i];
    a.out = (float*)d_out; a.ws = (unsigned char*)d_ws;
    if (MK_N_LAUNCHES == 1) { a.ph_lo = 0; a.ph_hi = N_PHASES; a.li = 0; hipLaunchKernelGGL(mk_fwd, dim3(grid), dim3(NWAVES * 64), LDS_BYTES, stream, a); }
    else for (int li = 0; li < N_PHASES; ++li) { a.ph_lo = li; a.ph_hi = li + 1; a.li = 0; hipLaunchKernelGGL(mk_fwd, dim3(grid), dim3(NWAVES * 64), LDS_BYTES, stream, a); }
}
```

```cpp
#include <hip/hip_runtime.h>
#include <cstdio>
#include <cstdint>
namespace pg8 {
#define PG8_LAS __attribute__((address_space(3)))
typedef unsigned short bf16_t;
typedef short bf16x8 __attribute__((ext_vector_type(8)));
typedef float f32x4 __attribute__((ext_vector_type(4)));
typedef unsigned u32x4 __attribute__((ext_vector_type(4)));
constexpr int BM = 256, BK = 64, HALF = 128, HTB = HALF * BK * 2  , STAGE_BYTES = 8 * HTB, NXCD = 8, WGM = 8;

__host__ __device__ __forceinline__ int lds_byte(int r, int c) { const int st = (r >> 4) * 2 + (c >> 5), rr = r & 15, cc = c & 31, ob = rr * 64 + cc * 2; return st * 1024 + (ob ^ (((ob >> 9) & 1) << 5)); }
__host__ __device__ __forceinline__ void stage_rc(int b, int& R, int& C) { const int st = b / 1024, sb = b % 1024, swz = sb ^ (((sb >> 9) & 1) << 5); R = (st >> 1) * 16 + swz / 64; C = (st & 1) * 32 + (swz % 64) / 2; }
__host__ __device__ __forceinline__ int perm32(int rho) { const int n = rho >> 4, i = rho & 15; return 8 * (i >> 2) + 4 * n + (i & 3); }

struct Unit { int pm, pn; };
struct Gemm { const bf16_t* A; const bf16_t* Bt; int M, N, K; };

struct StaticOrder {
    int nM, nN, nwg, G, c;
    __host__ __device__ void init(int M, int N, int G_, int c_) { nM = M / BM; nN = N / BM; nwg = nM * nN; G = G_; c = c_; }
    __host__ __device__ bool next(int i, Unit& u) const {
        const long L = (long)i * G + c; if (L >= nwg) return false;
        int wgid = (int)L; { const int q = nwg / NXCD, r = nwg % NXCD, xcd = wgid % NXCD, off = wgid / NXCD; wgid = (xcd < r ? xcd * (q + 1) : r * (q + 1) + (xcd - r) * q) + off; }
        const int nig = WGM * nN, gid = wgid / nig, fm = gid * WGM, gsz = (nM - fm) < WGM ? (nM - fm) : WGM;
        u.pm = fm + ((wgid % nig) % gsz); u.pn = (wgid % nig) / gsz; return true;
    }
    __device__ __forceinline__ void a_ready(const Unit&) const {}
    __device__ __forceinline__ void done(const Unit&) const {}
};

__device__ __forceinline__ unsigned cvt_pk_bf16(float lo, float hi) { unsigned r; asm volatile("v_cvt_pk_bf16_f32 %0, %1, %2" : "=v"(r) : "v"(lo), "v"(hi)); return r; }
typedef float f32x2 __attribute__((ext_vector_type(2)));
__device__ __forceinline__ f32x2 gelu_pk(f32x2 v) {
    const f32x2 av = __builtin_elementwise_abs(v), d = av * 0.2316418882f + 1.0f;
    f32x2 t; t.x = __builtin_amdgcn_rcpf(d.x); t.y = __builtin_amdgcn_rcpf(d.y);
    f32x2 q = t * 0.5307027145f + (-0.7265760135f); q = q * t + 0.7107068705f; q = q * t + (-0.142248368f); q = q * t + 0.127414796f; q = q * t;
    const f32x2 s = (v * v) * (-0.72134752044f);
    f32x2 e; e.x = __builtin_amdgcn_exp2f(s.x); e.y = __builtin_amdgcn_exp2f(s.y);
    const f32x2 m = v * (q * e), r = v - m;
    f32x2 o; o.x = v.x < 0.f ? m.x : r.x; o.y = v.y < 0.f ? m.y : r.y; return o;
}

template <int ACT  > struct EpiBf16 {
    static constexpr bool PERM = true, AFTER_DRAIN = false; static_assert(ACT == 0 || ACT == 1, "EpiBf16: ACT is 0 (none) or 1 (gelu_pk)");
    bf16_t* O; int ldc; const float* bias; int split_cols; size_t split_stride; float scale0;
    __device__ __forceinline__ void operator()(const f32x4 (&acc)[2][2][4][2], const Unit& u, int wr, int wc, int fr, int fq) const {
        const int row0 = u.pm * BM + wr * 64 + fr; int colt = u.pn * BM; bf16_t* base = O;
        float sc = 1.f; if (split_cols) { const int t = colt / split_cols; base += (size_t)t * split_stride; colt -= t * split_cols; if (t == 0) sc = scale0; }
        const int col0 = colt + wc * 32 + 8 * fq, bcol0 = u.pn * BM + wc * 32 + 8 * fq;
        f32x4 bv[2][2];
#pragma unroll
        for (int bj = 0; bj < 2; ++bj)
#pragma unroll
            for (int n = 0; n < 2; ++n) bv[bj][n] = bias ? *(const f32x4*)(bias + bcol0 + bj * HALF + 4 * n) : (f32x4){0.f, 0.f, 0.f, 0.f};
#pragma unroll
        for (int ai = 0; ai < 2; ++ai)
#pragma unroll
            for (int m = 0; m < 4; ++m) { bf16_t* rowp = base + (size_t)(row0 + ai * HALF + m * 16) * ldc + col0;
#pragma unroll
                for (int bj = 0; bj < 2; ++bj) { f32x4 v0 = acc[ai][bj][m][0] + bv[bj][0], v1 = acc[ai][bj][m][1] + bv[bj][1];
                    if (ACT == 1) { f32x2 a = gelu_pk((f32x2){v0[0], v0[1]}), b = gelu_pk((f32x2){v0[2], v0[3]}), c = gelu_pk((f32x2){v1[0], v1[1]}), d = gelu_pk((f32x2){v1[2], v1[3]});
                        v0 = (f32x4){a.x, a.y, b.x, b.y}; v1 = (f32x4){c.x, c.y, d.x, d.y}; }
                    v0 = v0 * sc; v1 = v1 * sc; u32x4 w; w.x = cvt_pk_bf16(v0[0], v0[1]); w.y = cvt_pk_bf16(v0[2], v0[3]); w.z = cvt_pk_bf16(v1[0], v1[1]); w.w = cvt_pk_bf16(v1[2], v1[3]);
                    *(u32x4*)(rowp + bj * HALF) = w; } }
    }
};

typedef int i32x4 __attribute__((ext_vector_type(4)));
template <bool I8> __device__ __forceinline__ f32x4 mma16(bf16x8 a, bf16x8 b, f32x4 c) {
    if constexpr (I8) return __builtin_bit_cast(f32x4, __builtin_amdgcn_mfma_i32_16x16x64_i8(__builtin_bit_cast(i32x4, a), __builtin_bit_cast(i32x4, b), __builtin_bit_cast(i32x4, c), 0, 0, 0));
    else return __builtin_amdgcn_mfma_f32_16x16x32_bf16(a, b, c, 0, 0, 0);
}
template <class Epi, class Sched, bool ALIGN_EPI = false, bool SP2 = false, bool I8 = false>
__device__ __forceinline__ void gemm_phase(PG8_LAS unsigned char* lds, const Gemm g, const Sched& S, const Epi& E) {
    const int tid = threadIdx.x, wid = __builtin_amdgcn_readfirstlane(tid >> 6), lane = tid & 63, wr = wid >> 2, wc = wid & 3, fr = lane & 15, fq = lane >> 4;
    const int K = g.K, nt = K / BK;
    unsigned voffA[2], voffB[2];
#pragma unroll
    for (int i = 0; i < 2; ++i) { int R, C; stage_rc(tid * 16 + i * 8192, R, C); const int Rb = Epi::PERM ? ((R & ~31) + perm32(R & 31)) : R;
        voffA[i] = (unsigned)(R * K + C) * 2u; voffB[i] = (unsigned)(Rb * K + C) * 2u; }
    const size_t kstep = (size_t)(BK * 2);
    const size_t hstep = (size_t)HALF * K * 2;
    const size_t tstep = 2 * hstep;
    const unsigned ldsw = (unsigned)wid * 1024u;
    const int aoff = lds_byte(wr * 64 + fr, fq * 8), boff = lds_byte(wc * 32 + fr, fq * 8);
#define PG8_SA(b, h) (((b) * 2 + (h)) * HTB)
#define PG8_SB(b, h) ((4 + (b) * 2 + (h)) * HTB)
#define PG8_STAGE(bufoff, gbase, voff) do { _Pragma("unroll") for (int _i = 0; _i < 2; ++_i) \
        __builtin_amdgcn_global_load_lds((const unsigned*)((const char*)(gbase) + (voff)[_i]), (PG8_LAS unsigned*)(lds + (bufoff) + ldsw + _i * 8192), 16, 0, 0); } while (0)
#define PG8_LDA(dst, b, h) do { _Pragma("unroll") for (int m = 0; m < 4; ++m) _Pragma("unroll") for (int k = 0; k < 2; ++k) dst[m][k] = *(const PG8_LAS bf16x8*)(lds + PG8_SA(b, h) + aoff + m * 2048 + k * 1024); } while (0)
#define PG8_LDB(dst, b, h) do { _Pragma("unroll") for (int n = 0; n < 2; ++n) _Pragma("unroll") for (int k = 0; k < 2; ++k) dst[n][k] = *(const PG8_LAS bf16x8*)(lds + PG8_SB(b, h) + boff + n * 2048 + k * 1024); } while (0)
#define PG8_MMA(ai, bj, At, Bt) do { __builtin_amdgcn_s_setprio(1); _Pragma("unroll") for (int m = 0; m < 4; ++m) _Pragma("unroll") for (int n = 0; n < 2; ++n) _Pragma("unroll") for (int k = 0; k < 2; ++k) \
        acc[ai][bj][m][n] = mma16<I8>(Bt[n][k], At[m][k], acc[ai][bj][m][n]); __builtin_amdgcn_s_setprio(0); } while (0)
#define PG8_WAIT_V(n) asm volatile("s_waitcnt vmcnt(" #n ")" ::: "memory")
#define PG8_WAIT_L(n) asm volatile("s_waitcnt lgkmcnt(" #n ")" ::: "memory")
#define PG8_BAR __builtin_amdgcn_s_barrier()
#define PG8_SCHED __builtin_amdgcn_sched_barrier(0)
    Unit cur, nxt; int ui = 0;
    if (!S.next(0, cur)) return;
    f32x4 acc[2][2][4][2];
#pragma unroll
    for (int a = 0; a < 2; ++a)
#pragma unroll
        for (int b = 0; b < 2; ++b)
#pragma unroll
            for (int m = 0; m < 4; ++m)
#pragma unroll
                for (int n = 0; n < 2; ++n) acc[a][b][m][n] = (f32x4){0.f, 0.f, 0.f, 0.f};
    bf16x8 At[4][2], B0[2][2], B1[2][2];
    const char* cA = (const char*)g.A + (size_t)cur.pm * tstep; const char* cB = (const char*)g.Bt + (size_t)cur.pn * tstep;
    S.a_ready(cur);
    if constexpr (SP2) {
        PG8_STAGE(PG8_SB(0, 0), cB, voffB); PG8_STAGE(PG8_SB(0, 1), cB + hstep, voffB); PG8_STAGE(PG8_SA(0, 0), cA, voffA); PG8_STAGE(PG8_SA(0, 1), cA + hstep, voffA);
        if (wr == 1) PG8_BAR;
        PG8_WAIT_V(2); PG8_BAR;
        PG8_STAGE(PG8_SB(1, 0), cB + kstep, voffB); PG8_STAGE(PG8_SA(1, 0), cA + kstep, voffA); PG8_STAGE(PG8_SB(1, 1), cB + hstep + kstep, voffB);
        PG8_WAIT_V(6); PG8_BAR;
    } else {
        PG8_STAGE(PG8_SB(0, 0), cB, voffB); PG8_STAGE(PG8_SA(0, 0), cA, voffA); PG8_STAGE(PG8_SB(0, 1), cB + hstep, voffB); PG8_STAGE(PG8_SA(0, 1), cA + hstep, voffA);
        if (wr == 1) PG8_BAR;
        PG8_WAIT_V(4); PG8_BAR;
        PG8_STAGE(PG8_SB(1, 0), cB + kstep, voffB); PG8_STAGE(PG8_SA(1, 0), cA + kstep, voffA); PG8_STAGE(PG8_SB(1, 1), cB + hstep + kstep, voffB);
        PG8_WAIT_V(6); PG8_BAR;
    }
    for (;;) {
        const bool has_next = S.next(ui + 1, nxt);
        const char* nA = has_next ? (const char*)g.A + (size_t)nxt.pm * tstep : cA; const char* nB = has_next ? (const char*)g.Bt + (size_t)nxt.pn * tstep : cB;
        for (int t = 0; t < nt; t += 2) {
            const bool last = (t == nt - 2);
            const char* a1 = cA + (size_t)(t + 1) * kstep;
            const char* a2 = last ? nA : cA + (size_t)(t + 2) * kstep; const char* b2 = last ? nB : cB + (size_t)(t + 2) * kstep;
            const char* a3 = a2 + kstep; const char* b3 = b2 + kstep;
            if (last && has_next) S.a_ready(nxt);
            if constexpr (SP2) {
            PG8_LDB(B0, 0, 0); PG8_LDB(B1, 0, 1); PG8_SCHED; PG8_LDA(At, 0, 0); PG8_STAGE(PG8_SA(1, 1), a1 + hstep, voffA);
            PG8_WAIT_V(8); PG8_WAIT_L(0); PG8_BAR; PG8_MMA(0, 0, At, B0); PG8_MMA(0, 1, At, B1); PG8_BAR; PG8_SCHED;
            PG8_LDA(At, 0, 1); PG8_STAGE(PG8_SB(0, 0), b2, voffB); PG8_STAGE(PG8_SB(0, 1), b2 + hstep, voffB); PG8_STAGE(PG8_SA(0, 0), a2, voffA);
            PG8_WAIT_V(8); PG8_WAIT_L(0); PG8_BAR; PG8_MMA(1, 0, At, B0); PG8_MMA(1, 1, At, B1); PG8_BAR; PG8_SCHED;
            PG8_LDB(B0, 1, 0); PG8_LDB(B1, 1, 1); PG8_SCHED; PG8_LDA(At, 1, 0); PG8_STAGE(PG8_SA(0, 1), a2 + hstep, voffA);
            PG8_WAIT_V(8); PG8_WAIT_L(0); PG8_BAR; PG8_MMA(0, 0, At, B0); PG8_MMA(0, 1, At, B1); PG8_BAR; PG8_SCHED;
            PG8_LDA(At, 1, 1); PG8_STAGE(PG8_SB(1, 0), b3, voffB); PG8_STAGE(PG8_SB(1, 1), b3 + hstep, voffB); PG8_STAGE(PG8_SA(1, 0), a3, voffA);
            PG8_WAIT_V(8); PG8_WAIT_L(0); PG8_BAR; PG8_MMA(1, 0, At, B0); PG8_MMA(1, 1, At, B1); PG8_BAR; PG8_SCHED;
            } else {
            PG8_LDB(B0, 0, 0); PG8_SCHED; PG8_LDA(At, 0, 0); PG8_STAGE(PG8_SA(1, 1), a1 + hstep, voffA);
            PG8_WAIT_L(8); PG8_BAR; PG8_WAIT_L(0); PG8_MMA(0, 0, At, B0); PG8_BAR; PG8_SCHED;
            PG8_LDB(B1, 0, 1); PG8_STAGE(PG8_SB(0, 0), b2, voffB);
            PG8_BAR; PG8_WAIT_L(0); PG8_MMA(0, 1, At, B1); PG8_BAR;
            PG8_LDA(At, 0, 1); PG8_STAGE(PG8_SA(0, 0), a2, voffA);
            PG8_BAR; PG8_WAIT_L(0); PG8_MMA(1, 0, At, B0); PG8_BAR; PG8_SCHED;
            PG8_STAGE(PG8_SB(0, 1), b2 + hstep, voffB);
            PG8_WAIT_V(6); PG8_BAR; PG8_MMA(1, 1, At, B1); PG8_BAR;
            PG8_LDB(B0, 1, 0); PG8_SCHED; PG8_LDA(At, 1, 0); PG8_STAGE(PG8_SA(0, 1), a2 + hstep, voffA);
            PG8_WAIT_L(8); PG8_BAR; PG8_WAIT_L(0); PG8_MMA(0, 0, At, B0); PG8_BAR; PG8_SCHED;
            PG8_LDB(B1, 1, 1); PG8_STAGE(PG8_SB(1, 0), b3, voffB);
            PG8_BAR; PG8_WAIT_L(0); PG8_MMA(0, 1, At, B1); PG8_BAR;
            PG8_LDA(At, 1, 1); PG8_STAGE(PG8_SA(1, 0), a3, voffA);
            PG8_BAR; PG8_WAIT_L(0); PG8_MMA(1, 0, At, B0); PG8_BAR; PG8_SCHED;
            PG8_STAGE(PG8_SB(1, 1), b3 + hstep, voffB);
            PG8_WAIT_V(6); PG8_BAR; PG8_MMA(1, 1, At, B1); PG8_BAR;
            }
        }
        if constexpr (ALIGN_EPI) { if (wr == 0) PG8_BAR; }
        if constexpr (!Epi::AFTER_DRAIN) { E(acc, cur, wr, wc, fr, fq); S.done(cur); }
        if (!has_next) break;
#pragma unroll
        for (int a = 0; a < 2; ++a)
#pragma unroll
            for (int b = 0; b < 2; ++b)
#pragma unroll
                for (int m = 0; m < 4; ++m)
#pragma unroll
                    for (int n = 0; n < 2; ++n) acc[a][b][m][n] = (f32x4){0.f, 0.f, 0.f, 0.f};
        cur = nxt; cA = nA; cB = nB; ++ui;
        if constexpr (ALIGN_EPI) { if (wr == 1) PG8_BAR; }
    }
    PG8_WAIT_V(0);
    if constexpr (!ALIGN_EPI) { if (wr == 0) PG8_BAR; }
    PG8_BAR;
    if constexpr (Epi::AFTER_DRAIN) { E.fused(acc, cur, wr, wc, fr, fq, lds, wid, lane); S.done(cur); }
#undef PG8_SA
#undef PG8_SB
#undef PG8_STAGE
#undef PG8_LDA
#undef PG8_LDB
#undef PG8_MMA
#undef PG8_WAIT_V
#undef PG8_WAIT_L
#undef PG8_BAR
#undef PG8_SCHED
}
}
namespace pg8 {
struct EpiProj {
    static constexpr bool PERM = true, AFTER_DRAIN = false;
    bf16_t* O; int ldc; int gelu_tiles;
    __device__ __forceinline__ void operator()(const f32x4 (&acc)[2][2][4][2], const Unit& u, int wr, int wc, int fr, int fq) const {
        const int row0 = u.pm * BM + wr * 64 + fr; const int col0 = u.pn * BM + wc * 32 + 8 * fq;
        const bool act = u.pn < gelu_tiles;
#pragma unroll
        for (int ai = 0; ai < 2; ++ai)
#pragma unroll
            for (int m = 0; m < 4; ++m) { bf16_t* rowp = O + (size_t)(row0 + ai * HALF + m * 16) * ldc + col0;
#pragma unroll
                for (int bj = 0; bj < 2; ++bj) { f32x4 v0 = acc[ai][bj][m][0], v1 = acc[ai][bj][m][1];
                    if (act) { f32x2 a = gelu_pk((f32x2){v0[0], v0[1]}), b = gelu_pk((f32x2){v0[2], v0[3]}), c = gelu_pk((f32x2){v1[0], v1[1]}), d = gelu_pk((f32x2){v1[2], v1[3]});
                        v0 = (f32x4){a.x, a.y, b.x, b.y}; v1 = (f32x4){c.x, c.y, d.x, d.y}; }
                    u32x4 w; w.x = cvt_pk_bf16(v0[0], v0[1]); w.y = cvt_pk_bf16(v0[2], v0[3]); w.z = cvt_pk_bf16(v1[0], v1[1]); w.w = cvt_pk_bf16(v1[2], v1[3]);
                    *(u32x4*)(rowp + bj * HALF) = w; } }
    }
};
struct EpiResid {
    static constexpr bool PERM = false, AFTER_DRAIN = false;
    const float* base; const float* gate; float* out; int ldc;
    __device__ __forceinline__ void operator()(const f32x4 (&acc)[2][2][4][2], const Unit& u, int wr, int wc, int fr, int fq) const {
        const int row0 = u.pm * BM + wr * 64 + fr, col0 = u.pn * BM + wc * 32 + 4 * fq;
        f32x4 gv[2][2];
#pragma unroll
        for (int bj = 0; bj < 2; ++bj)
#pragma unroll
            for (int n = 0; n < 2; ++n) gv[bj][n] = *(const f32x4*)(gate + col0 + bj * HALF + n * 16);
#pragma unroll
        for (int ai = 0; ai < 2; ++ai)
#pragma unroll
            for (int m = 0; m < 4; ++m) { const size_t off = (size_t)(row0 + ai * HALF + m * 16) * ldc + col0;
#pragma unroll
                for (int bj = 0; bj < 2; ++bj)
#pragma unroll
                    for (int n = 0; n < 2; ++n) { const f32x4 b = *(const f32x4*)(base + off + bj * HALF + n * 16); *(f32x4*)(out + off + bj * HALF + n * 16) = b + gv[bj][n] * acc[ai][bj][m][n]; } }
    }
};
struct EpiQ8 {
    static constexpr bool PERM = true, AFTER_DRAIN = false;
    bf16_t* O; int ldc; int gelu_tiles; const float* rs; const float* cs;
    __device__ __forceinline__ void operator()(const f32x4 (&acc)[2][2][4][2], const Unit& u, int wr, int wc, int fr, int fq) const {
        const int row0 = u.pm * BM + wr * 64 + fr; const int col0 = u.pn * BM + wc * 32 + 8 * fq;
        const bool act = u.pn < gelu_tiles;
        f32x4 cv[2][2];
#pragma unroll
        for (int bj = 0; bj < 2; ++bj)
#pragma unroll
            for (int n = 0; n < 2; ++n) cv[bj][n] = *(const f32x4*)(cs + col0 + bj * HALF + 4 * n);
#pragma unroll
        for (int ai = 0; ai < 2; ++ai)
#pragma unroll
            for (int m = 0; m < 4; ++m) { const int row = row0 + ai * HALF + m * 16; const float rsc = rs[row]; bf16_t* rowp = O + (size_t)row * ldc + col0;
#pragma unroll
                for (int bj = 0; bj < 2; ++bj) { const i32x4 a0 = __builtin_bit_cast(i32x4, acc[ai][bj][m][0]), a1 = __builtin_bit_cast(i32x4, acc[ai][bj][m][1]);
                    f32x4 v0 = (f32x4){(float)a0[0], (float)a0[1], (float)a0[2], (float)a0[3]} * rsc * cv[bj][0], v1 = (f32x4){(float)a1[0], (float)a1[1], (float)a1[2], (float)a1[3]} * rsc * cv[bj][1];
                    if (act) { f32x2 a = gelu_pk((f32x2){v0[0], v0[1]}), b = gelu_pk((f32x2){v0[2], v0[3]}), c = gelu_pk((f32x2){v1[0], v1[1]}), d = gelu_pk((f32x2){v1[2], v1[3]});
                        v0 = (f32x4){a.x, a.y, b.x, b.y}; v1 = (f32x4){c.x, c.y, d.x, d.y}; }
                    u32x4 w; w.x = cvt_pk_bf16(v0[0], v0[1]); w.y = cvt_pk_bf16(v0[2], v0[3]); w.z = cvt_pk_bf16(v1[0], v1[1]); w.w = cvt_pk_bf16(v1[2], v1[3]);
                    *(u32x4*)(rowp + bj * HALF) = w; } }
    }
};
struct EpiResid2 {
    static constexpr bool PERM = true, AFTER_DRAIN = false;
    const float* base; const float* gate; bf16_t* xb; float* ssq; int ldc;
    __device__ __forceinline__ void operator()(const f32x4 (&acc)[2][2][4][2], const Unit& u, int wr, int wc, int fr, int fq) const {
        const int row0 = u.pm * BM + wr * 64 + fr, col0 = u.pn * BM + wc * 32 + 8 * fq;
        f32x4 gv[2][2];
#pragma unroll
        for (int bj = 0; bj < 2; ++bj)
#pragma unroll
            for (int n = 0; n < 2; ++n) gv[bj][n] = *(const f32x4*)(gate + col0 + bj * HALF + 4 * n);
#pragma unroll
        for (int ai = 0; ai < 2; ++ai)
#pragma unroll
            for (int m = 0; m < 4; ++m) { const int row = row0 + ai * HALF + m * 16; const size_t off = (size_t)row * ldc + col0; float ss = 0.f;
#pragma unroll
                for (int bj = 0; bj < 2; ++bj) {
                    const f32x4 b0 = *(const f32x4*)(base + off + bj * HALF), b1 = *(const f32x4*)(base + off + bj * HALF + 4);
                    const f32x4 v0 = b0 + gv[bj][0] * acc[ai][bj][m][0], v1 = b1 + gv[bj][1] * acc[ai][bj][m][1];
                    ss += (v0[0] * v0[0] + v0[1] * v0[1]) + (v0[2] * v0[2] + v0[3] * v0[3]) + (v1[0] * v1[0] + v1[1] * v1[1]) + (v1[2] * v1[2] + v1[3] * v1[3]);
                    u32x4 w; w.x = cvt_pk_bf16(v0[0], v0[1]); w.y = cvt_pk_bf16(v0[2], v0[3]); w.z = cvt_pk_bf16(v1[0], v1[1]); w.w = cvt_pk_bf16(v1[2], v1[3]);
                    *(u32x4*)(xb + off + bj * HALF) = w; }
                ss += __shfl_xor(ss, 16); ss += __shfl_xor(ss, 32);
                if (fq == 0) ssq[(size_t)row * 32 + u.pn * 4 + wc] = ss; }
    }
};
struct EpiQ {
    static constexpr bool PERM = true, AFTER_DRAIN = false;
    bf16_t* O; int ldc; const float* bias; const PG8_LAS float* rstd;
    __device__ __forceinline__ void operator()(const f32x4 (&acc)[2][2][4][2], const Unit& u, int wr, int wc, int fr, int fq) const {
        const int lrow0 = wr * 64 + fr, col0 = u.pn * BM + wc * 32 + 8 * fq;
        f32x4 bv[2][2];
#pragma unroll
        for (int bj = 0; bj < 2; ++bj)
#pragma unroll
            for (int n = 0; n < 2; ++n) bv[bj][n] = *(const f32x4*)(bias + col0 + bj * HALF + 4 * n);
#pragma unroll
        for (int ai = 0; ai < 2; ++ai)
#pragma unroll
            for (int m = 0; m < 4; ++m) { const int lrow = lrow0 + ai * HALF + m * 16; const float rs = rstd[(u.pm & 1) * BM + lrow];
                bf16_t* rowp = O + (size_t)(u.pm * BM + lrow) * ldc + col0;
#pragma unroll
                for (int bj = 0; bj < 2; ++bj) { const f32x4 v0 = acc[ai][bj][m][0] * rs + bv[bj][0], v1 = acc[ai][bj][m][1] * rs + bv[bj][1];
                    u32x4 w; w.x = cvt_pk_bf16(v0[0], v0[1]); w.y = cvt_pk_bf16(v0[2], v0[3]); w.z = cvt_pk_bf16(v1[0], v1[1]); w.w = cvt_pk_bf16(v1[2], v1[3]);
                    *(u32x4*)(rowp + bj * HALF) = w; } }
    }
};
}
#ifndef PG8_SP2
#define PG8_SP2 true
#endif
#ifndef PG8_ALIGN
#define PG8_ALIGN true
#endif
constexpr int NWAVES = 8;
constexpr int M = 16384, D = 2048;
constexpr int IN_COLS = 6152, NWIN = 6144, NPROJ = 5120;
constexpr int C_UG = 0, C_VG = 1024, C_Q = 2048, C_K = 3072, C_OM = 4096;
constexpr int WROW_VM = 5120;
constexpr int NHEAD = 4, DH = 256, CH = 128, NCHUNK = M / CH;
constexpr int NEXP = 16384, PH = 8, TOPK = 16, NSEL = PH * TOPK;
constexpr float EPS = 1e-6f;
constexpr int MOD_SHM = 0, MOD_SCM = 2048, MOD_GM = 4096, MOD_SHF = 6144, MOD_SCF = 8192, MOD_GF = 10240, NMOD = 12288;
constexpr int ADA_KC = 16, ADA_KROWS = D / ADA_KC;

constexpr size_t MiB = 1u << 20;
constexpr size_t WS_CTL = 0, CTL_ZERO_BYTES = 1 * MiB;
constexpr size_t WS_MODP = 1 * MiB;
constexpr size_t WS_MODF = WS_MODP + (size_t)ADA_KC * NMOD * 4;
constexpr size_t WS_GATES = 2 * MiB;
constexpr size_t WS_SUMM = 2 * MiB + 512 * 1024;
constexpr size_t WS_MTAB = WS_SUMM + 8192;
constexpr size_t WS_NST = 3 * MiB;
constexpr size_t WS_WIN = 4 * MiB;
constexpr size_t WS_WOUT = 28 * MiB;
constexpr size_t WS_WQ = 36 * MiB;
constexpr size_t WS_IDX = 44 * MiB;
constexpr size_t WS_PG = 52 * MiB;
constexpr size_t WS_SSQP = 60 * MiB;
constexpr size_t WS_BQP = 62 * MiB, WS_BIASQ = 62 * MiB + 512 * 1024;
constexpr size_t WS_SW = 62 * MiB + 768 * 1024;
constexpr size_t WS_CMAXP = 63 * MiB;
constexpr size_t WS_SA = 3 * MiB + 512 * 1024 + 131072;
constexpr size_t WS_HA = 64 * MiB;
constexpr size_t WS_PROJ = 128 * MiB;
constexpr size_t WS_VT = 288 * MiB;
constexpr size_t WS_X1 = 192 * MiB;
constexpr size_t WS_STATE = 320 * MiB;
constexpr size_t WS_ED = 384 * MiB, WS_EU = 416 * MiB;
constexpr size_t WS_SD = 3 * MiB + 512 * 1024, WS_SU = WS_SD + 65536;
constexpr size_t WS_END = 512 * MiB;
constexpr int CW_TMO = 0, CW_CODE = 1, CW_BAR = 4096;

constexpr int RING_BYTES = 131072, LDSCTL_OFF = 163328, MISC_OFF = LDSCTL_OFF + 320, LDS_BYTES = 163840;

#define GAS __attribute__((address_space(1)))
#define LAS __attribute__((address_space(3)))
#define DI __device__ __forceinline__
typedef unsigned short bf16;
typedef unsigned v4u __attribute__((ext_vector_type(4)));
typedef unsigned v2u __attribute__((ext_vector_type(2)));
typedef float f32x4 __attribute__((ext_vector_type(4)));
typedef float f32x16 __attribute__((ext_vector_type(16)));
typedef short bf16x8 __attribute__((ext_vector_type(8)));
typedef GAS unsigned gu32;
#define RLX_AGENT __ATOMIC_RELAXED, __HIP_MEMORY_SCOPE_AGENT
#define LDS_WAIT() asm volatile("s_waitcnt lgkmcnt(0)" ::: "memory")
#define VM_WAIT() asm volatile("s_waitcnt vmcnt(0)" ::: "memory")
#define MFMA32(a, b, c) __builtin_amdgcn_mfma_f32_32x32x16_bf16((a), (b), (c), 0, 0, 0)
DI unsigned f2bf(float f) { unsigned u = __builtin_bit_cast(unsigned, f); return (u + 0x7fffu + ((u >> 16) & 1u)) >> 16; }
DI unsigned pk2(float lo, float hi) { return f2bf(lo) | (f2bf(hi) << 16); }
DI float bflo(unsigned w) { return __builtin_bit_cast(float, w << 16); }
DI float bfhi(unsigned w) { return __builtin_bit_cast(float, w & 0xffff0000u); }
DI float bf2f(unsigned short h) { return __builtin_bit_cast(float, (unsigned)h << 16); }
DI int crow(int reg, int h) { return (reg & 3) + 8 * (reg >> 2) + 4 * h; }
DI float wave_sum(float v) {
#pragma unroll
    for (int o = 1; o < 64; o <<= 1) v += __shfl_xor(v, o);
    return v;
}
DI float wave_max(float v) {
#pragma unroll
    for (int o = 1; o < 64; o <<= 1) v = fmaxf(v, __shfl_xor(v, o));
    return v;
}
DI float silu_f(float v) { return v / (1.0f + __expf(-v)); }
DI float sigmoid_f(float v) { return 1.0f / (1.0f + __expf(-v)); }
DI float gelu_f(float v) { return 0.5f * v * (1.0f + erff(v * 0.70710678118654752f)); }
typedef __bf16 bf16v2 __attribute__((ext_vector_type(2)));
#define DOT2(a, b, c) __builtin_amdgcn_fdot2_f32_bf16(__builtin_bit_cast(bf16v2, (unsigned)(a)), __builtin_bit_cast(bf16v2, (unsigned)(b)), (c), false)
DI f32x16 zero16() { f32x16 z; for (int i = 0; i < 16; ++i) z[i] = 0.f; return z; }
#define XB_TMO      128
#define XB_XCNT(j)  (256  + 64 * (j))
#define XB_XSUB(j)  (1280 + 64 * (j))
#define XB_XGEN(j)  (2304 + 64 * (j))
#define XB_TOP      3328
#define XB_TOPGEN   3392
#define XCD_BAR_WORDS 3456
#define XB_SPIN_CAP (1u << 18)

__device__ __forceinline__ unsigned xb_ld(unsigned* p)              { return __hip_atomic_load(p, __ATOMIC_RELAXED, __HIP_MEMORY_SCOPE_AGENT); }
__device__ __forceinline__ unsigned xb_add(unsigned* p, unsigned v) { return __hip_atomic_fetch_add(p, v, __ATOMIC_RELAXED, __HIP_MEMORY_SCOPE_AGENT); }
__device__ __forceinline__ unsigned xb_xcc_id() { return (unsigned)__builtin_amdgcn_s_getreg((3 << 11) | 20) & 0xFu; }
#define XB_SPIN(cond, bar) do { unsigned _sp = 0; while (cond) { __builtin_amdgcn_s_sleep(1); \
    if ((++_sp & 255u) == 0u) { if (xb_ld(&(bar)[XB_TMO])) break; if (_sp > XB_SPIN_CAP) { atomicAdd(&(bar)[XB_TMO], 1u); break; } } } } while (0)

struct XcdBarrier {
    unsigned* bar; unsigned x;
    volatile LAS unsigned* st;
};

__device__ __forceinline__ XcdBarrier xcd_barrier_post(unsigned* bar, volatile LAS unsigned* st) {
    XcdBarrier b; b.bar = bar; b.x = xb_xcc_id(); b.st = st;
    if (threadIdx.x == 0) (void)xb_add(&bar[XB_XCNT(b.x)], 1u);
    return b;
}
__device__ __forceinline__ void xcd_barrier_complete(unsigned* bar, unsigned x, unsigned& nloc, unsigned& nx) {
    const unsigned G = gridDim.x * gridDim.y * gridDim.z;
    unsigned sum, cnt, mine, sp = 0u;
    for (;;) {
        sum = 0u; cnt = 0u; mine = 0u;
#pragma unroll
        for (unsigned j = 0; j < 16; ++j) { const unsigned c = xb_ld(&bar[XB_XCNT(j)]); sum += c; cnt += (c > 0u) ? 1u : 0u; mine = (j == x) ? c : mine; }
        if (sum == G) break;
        __builtin_amdgcn_s_sleep(1);
        if ((++sp & 255u) == 0u) { if (xb_ld(&bar[XB_TMO])) break; if (sp > XB_SPIN_CAP) { atomicAdd(&bar[XB_TMO], 1u); break; } }
    }
    nloc = mine > 0u ? mine : 1u; nx = cnt > 0u ? cnt : 1u;
}

__device__ __forceinline__ void xcd_barrier(const XcdBarrier& b) {
    asm volatile("s_waitcnt vmcnt(0)" ::: "memory");
    __syncthreads();
    if (threadIdx.x == 0) {
        unsigned* bar = b.bar;
        __builtin_amdgcn_s_waitcnt(0);
        unsigned nloc = b.st[0], nx = b.st[1];
        if (nloc == 0u) { xcd_barrier_complete(bar, b.x, nloc, nx); b.st[0] = nloc; b.st[1] = nx; }
        const unsigned old = xb_add(&bar[XB_XSUB(b.x)], 1u);
        const unsigned gen = old / nloc;
        if (old + 1u == (gen + 1u) * nloc) {
            __builtin_amdgcn_fence(__ATOMIC_RELEASE, "agent");
            asm volatile("s_waitcnt vmcnt(0)" ::: "memory");
            const unsigned og = xb_add(&bar[XB_TOP], 1u);
            const unsigned tg = og / nx;
            if (og + 1u == (tg + 1u) * nx) xb_add(&bar[XB_TOPGEN], 1u);
            else XB_SPIN(xb_ld(&bar[XB_TOPGEN]) == tg, bar);
            __builtin_amdgcn_fence(__ATOMIC_ACQUIRE, "agent");
            xb_add(&bar[XB_XGEN(b.x)], 1u);
            asm volatile("s_waitcnt vmcnt(0)" ::: "memory");
        } else {
            XB_SPIN(xb_ld(&bar[XB_XGEN(b.x)]) == gen, bar);
            __builtin_amdgcn_fence(__ATOMIC_ACQUIRE, "agent");
            asm volatile("s_waitcnt vmcnt(0)" ::: "memory");
        }
    }
    __syncthreads();
}
struct Frame {
    LAS unsigned char* lds;
    volatile LAS unsigned* MISC;
    gu32* ctl;
    int tid, lane, wave, vcu, G;
    const float *x, *c, *ada_w, *ada_b, *norm_mix_g, *w_in, *b_gates, *conv_w, *conv_b, *gmlp_norm_g, *gmlp_w, *gmlp_b, *mlstm_norm_g, *w_out, *norm_ffn_g,
                *wq, *keys1, *keys2, *e_down, *e_up, *final_g;
    float* out;
    float *MODP, *MODF, *GATES, *SUMM, *MTAB, *NST, *PG;
    int* IDX;
    bf16 *WIN, *WOUT, *WQ, *HA, *PROJ, *QB, *STATE, *QC, *KC, *VT;
    unsigned char *ED, *EU, *H1Q; float *SD, *SU;
    float *SSQP, *BQP, *BIASQ, *SW, *CMAXP, *SA; bf16* X1B;
};

DI void p0_transpose_item(const float* W, int K, int ldw, int nblk, bf16* WT, LAS float* scr, int item, int lane, bool vm_last = false) {
    const int kb = item / nblk, nb = item % nblk, k0 = 64 * kb, n0 = 32 * nb;
    const int d0 = !vm_last ? n0 : (n0 < 4096 ? n0 : (n0 < 5120 ? n0 + 1024 : n0 - 1024));
#pragma unroll 8
    for (int i = 0; i < 32; ++i) { const int kk = 2 * i + (lane >> 5); scr[kk * 33 + (lane & 31)] = __builtin_nontemporal_load(W + (size_t)(k0 + kk) * ldw + n0 + (lane & 31)); }
    LDS_WAIT(); asm volatile("" ::: "memory");
    const int c = lane & 7;
#pragma unroll
    for (int j = 0; j < 4; ++j) { const int n = (lane >> 3) + 8 * j; const LAS float* s = scr + (8 * c) * 33 + n;
        v4u o; o.x = pk2(s[0 * 33], s[1 * 33]); o.y = pk2(s[2 * 33], s[3 * 33]); o.z = pk2(s[4 * 33], s[5 * 33]); o.w = pk2(s[6 * 33], s[7 * 33]);
        *(GAS v4u*)(WT + (size_t)(d0 + n) * K + k0 + 8 * c) = o; }
    LDS_WAIT(); asm volatile("" ::: "memory");
}
DI void p0_colmax_item(Frame& F, int item) {
    const int lane = F.lane, nblk = NWIN / 32, kb = item / nblk, nb = item % nblk, k0 = 64 * kb, n0 = 32 * nb;
    float m = 0.f;
#pragma unroll 8
    for (int i = 0; i < 32; ++i) { const int kk = 2 * i + (lane >> 5); m = fmaxf(m, fabsf(F.w_in[(size_t)(k0 + kk) * IN_COLS + n0 + (lane & 31)])); }
    m = fmaxf(m, __shfl_xor(m, 32));
    if (lane < 32) F.CMAXP[(size_t)kb * NWIN + n0 + lane] = m;
}
DI void p0_ada_item(Frame& F, LAS float* scr, int item) {
    const int cc = item % (NMOD / 256), kc = item / (NMOD / 256), k0 = kc * ADA_KROWS, col = cc * 256 + F.lane * 4;
#pragma unroll
    for (int j = 0; j < ADA_KROWS / 64; ++j) scr[F.lane + 64 * j] = silu_f(F.c[k0 + F.lane + 64 * j]);
    LDS_WAIT(); asm volatile("" ::: "memory");
    f32x4 acc = {0.f, 0.f, 0.f, 0.f};
    const float* wp = F.ada_w + (size_t)k0 * NMOD + col;
#pragma unroll 8
    for (int kk = 0; kk < ADA_KROWS; ++kk) { const float s = scr[kk]; const f32x4 w = __builtin_nontemporal_load((const GAS f32x4*)(wp + (size_t)kk * NMOD)); acc += w * s; }
    *(GAS f32x4*)(F.MODP + (size_t)kc * NMOD + col) = acc;
    LDS_WAIT(); asm volatile("" ::: "memory");
}
DI void p0a_phase(Frame& F) {
    LAS float* scr = (LAS float*)(F.lds + F.wave * 16384);
    const int gw = F.wave * F.G + F.vcu, NGW = F.G * NWAVES;
    constexpr int I_ADA = (NMOD / 256) * ADA_KC;
    constexpr int I_WIN = (D / 64) * (NWIN / 32), I_WO = (D / 64) * (D / 32);
    constexpr int NITEMS = I_ADA + I_WIN + I_WO;
    for (int it = gw; it < NITEMS; it += NGW) {
        int r = it;
        if (r < I_ADA) { p0_ada_item(F, scr, r); continue; } r -= I_ADA;
        if (r < I_WIN) { p0_colmax_item(F, r); continue; } r -= I_WIN;
        p0_transpose_item(F.w_out, D, D, D / 32, F.WOUT, scr, r, F.lane);
    }
#pragma unroll 1
    for (int row = gw; row < 2 * NEXP; row += NGW) {
        const int tb = row >= NEXP, e = row - tb * NEXP;
        const GAS f32x4* src = (const GAS f32x4*)((tb ? F.e_up : F.e_down) + (size_t)e * D) + F.lane;
        f32x4 v[8]; float am = 0.f;
#pragma unroll
        for (int j = 0; j < 8; ++j) { v[j] = __builtin_nontemporal_load(src + 64 * j); am = fmaxf(am, fmaxf(fmaxf(fabsf(v[j].x), fabsf(v[j].y)), fmaxf(fabsf(v[j].z), fabsf(v[j].w)))); }
        am = fmaxf(wave_max(am), 1e-30f);
        const float sc = am * (1.0f / 127.0f), inv = 127.0f / am;
        GAS unsigned* dst = (GAS unsigned*)((tb ? F.EU : F.ED) + (size_t)e * D) + F.lane;
        const int off = tb ? 128 : 0;
#pragma unroll
        for (int j = 0; j < 8; ++j) {
            const int q0 = (int)__builtin_rintf(v[j].x * inv) + off, q1 = (int)__builtin_rintf(v[j].y * inv) + off, q2 = (int)__builtin_rintf(v[j].z * inv) + off, q3 = (int)__builtin_rintf(v[j].w * inv) + off;
            __builtin_nontemporal_store((unsigned)(q0 & 255) | ((unsigned)(q1 & 255) << 8) | ((unsigned)(q2 & 255) << 16) | ((unsigned)(q3 & 255) << 24), dst + 64 * j);
        }
        if (F.lane == 0) (tb ? F.SU : F.SD)[e] = sc;
    }
}
DI float mod_final(Frame& F, int col) { float s = F.ada_b[col];
#pragma unroll
    for (int k = 0; k < ADA_KC; ++k) s += F.MODP[(size_t)k * NMOD + col];
    return s; }
DI void norm_tables(Frame& F, const float* g, int col_scale, int col_shift) {
    LAS float* A1 = (LAS float*)(F.lds); LAS float* B1 = (LAS float*)(F.lds + 8192);
#pragma unroll
    for (int i = 0; i < 4; ++i) { const int c = F.tid + 512 * i; A1[c] = g[c] * (1.0f + F.MODF[col_scale + c]); B1[c] = F.MODF[col_shift + c]; }
}
DI void p0_wq_item(Frame& F, LAS float* scr, int item) {
    const int lane = F.lane, nblk = D / 32, kb = item / nblk, nb = item % nblk, k0 = 64 * kb, n0 = 32 * nb;
    LAS float* gsl = scr + 64 * 33; LAS float* shl = gsl + 64;
    gsl[lane] = F.norm_ffn_g[k0 + lane] * (1.0f + mod_final(F, MOD_SCF + k0 + lane)); shl[lane] = mod_final(F, MOD_SHF + k0 + lane);
    LDS_WAIT(); asm volatile("" ::: "memory");
    float bp = 0.f;
#pragma unroll 8
    for (int i = 0; i < 32; ++i) { const int kk = 2 * i + (lane >> 5); const float w = __builtin_nontemporal_load(F.wq + (size_t)(k0 + kk) * D + n0 + (lane & 31)); scr[kk * 33 + (lane & 31)] = w * gsl[kk]; bp += w * shl[kk]; }
    bp += __shfl_xor(bp, 32);
    if (lane < 32) F.BQP[(size_t)kb * D + n0 + lane] = bp;
    LDS_WAIT(); asm volatile("" ::: "memory");
    const int c = lane & 7;
#pragma unroll
    for (int j = 0; j < 4; ++j) { const int n = (lane >> 3) + 8 * j; const LAS float* sp = scr + (8 * c) * 33 + n;
        v4u o; o.x = pk2(sp[0 * 33], sp[1 * 33]); o.y = pk2(sp[2 * 33], sp[3 * 33]); o.z = pk2(sp[4 * 33], sp[5 * 33]); o.w = pk2(sp[6 * 33], sp[7 * 33]);
        *(GAS v4u*)(F.WQ + (size_t)(n0 + n) * D + k0 + 8 * c) = o; }
    LDS_WAIT(); asm volatile("" ::: "memory");
}
DI void p0_winq_item(Frame& F, LAS float* scr, int item) {
    const int lane = F.lane, nblk = NWIN / 32, kb = item / nblk, nb = item % nblk, k0 = 64 * kb, n0 = 32 * nb;
    const int d0 = n0 < 4096 ? n0 : (n0 < 5120 ? n0 + 1024 : n0 - 1024);
    LAS float* inv = scr + 64 * 33;
    if (lane < 32) { float m = 0.f;
#pragma unroll 8
        for (int q = 0; q < D / 64; ++q) m = fmaxf(m, F.CMAXP[(size_t)q * NWIN + n0 + lane]);
        m = fmaxf(m, 1e-30f); inv[lane] = 127.0f / m; if (kb == 0) F.SW[d0 + lane] = m * (1.0f / 127.0f); }
#pragma unroll 8
    for (int i = 0; i < 32; ++i) { const int kk = 2 * i + (lane >> 5); scr[kk * 33 + (lane & 31)] = F.w_in[(size_t)(k0 + kk) * IN_COLS + n0 + (lane & 31)]; }
    LDS_WAIT(); asm volatile("" ::: "memory");
    unsigned char* WQ = (unsigned char*)F.WIN;
#pragma unroll
    for (int i = 0; i < 2; ++i) { const int q = lane + 64 * i, n = q >> 2, c = q & 3; const float iv = inv[n]; const LAS float* sp = scr + (16 * c) * 33 + n; v4u o;
#pragma unroll
        for (int w = 0; w < 4; ++w) { const int q0 = (int)__builtin_rintf(sp[(4 * w) * 33] * iv), q1 = (int)__builtin_rintf(sp[(4 * w + 1) * 33] * iv), q2 = (int)__builtin_rintf(sp[(4 * w + 2) * 33] * iv), q3 = (int)__builtin_rintf(sp[(4 * w + 3) * 33] * iv);
            o[w] = (unsigned)(q0 & 255) | ((unsigned)(q1 & 255) << 8) | ((unsigned)(q2 & 255) << 16) | ((unsigned)(q3 & 255) << 24); }
        *(GAS v4u*)(WQ + (size_t)(d0 + n) * D + k0 + 16 * c) = o; }
    LDS_WAIT(); asm volatile("" ::: "memory");
}
DI void p0b_phase(Frame& F) {
    LAS float* A1 = (LAS float*)(F.lds); LAS float* B1 = (LAS float*)(F.lds + 8192); LAS float* WG = (LAS float*)(F.lds + 16384);
#pragma unroll
    for (int i = 0; i < 4; ++i) { const int c = F.tid + 512 * i; A1[c] = F.norm_mix_g[c] * (1.0f + mod_final(F, MOD_SCM + c)); B1[c] = mod_final(F, MOD_SHM + c); }
    { const int per = (NMOD + F.G - 1) / F.G; const int c = (int)blockIdx.x * per + F.tid; if (F.tid < per && c < NMOD) F.MODF[c] = mod_final(F, c); }
#pragma unroll
    for (int i = 0; i < 4; ++i) { const int k = F.tid + 512 * i; const f32x4 a = *(const GAS f32x4*)(F.w_in + (size_t)k * IN_COLS + NWIN), b = *(const GAS f32x4*)(F.w_in + (size_t)k * IN_COLS + NWIN + 4);
        WG[0 * 2048 + k] = a.x; WG[1 * 2048 + k] = a.y; WG[2 * 2048 + k] = a.z; WG[3 * 2048 + k] = a.w; WG[4 * 2048 + k] = b.x; WG[5 * 2048 + k] = b.y; WG[6 * 2048 + k] = b.z; WG[7 * 2048 + k] = b.w; }
    __syncthreads();
    const int gw = F.vcu * NWAVES + F.wave, NGW = F.G * NWAVES;
    f32x4 vn[8];
    { const GAS f32x4* xr = (const GAS f32x4*)(F.x + (size_t)gw * D) + F.lane;
#pragma unroll
      for (int j = 0; j < 8; ++j) vn[j] = __builtin_nontemporal_load(xr + 64 * j); }
#pragma unroll 1
    for (int row = gw; row < M; row += NGW) {
        f32x4 v[8]; float ss = 0.f;
#pragma unroll
        for (int j = 0; j < 8; ++j) { v[j] = vn[j]; ss += (v[j].x * v[j].x + v[j].y * v[j].y) + (v[j].z * v[j].z + v[j].w * v[j].w); }
        if (row + NGW < M) { const GAS f32x4* xr = (const GAS f32x4*)(F.x + (size_t)(row + NGW) * D) + F.lane;
#pragma unroll
            for (int j = 0; j < 8; ++j) vn[j] = __builtin_nontemporal_load(xr + 64 * j); }
        const float rstd = 1.0f / sqrtf(wave_sum(ss) * (1.0f / D) + EPS);
        float gd[8];
#pragma unroll
        for (int g = 0; g < 8; ++g) gd[g] = 0.f;
        LAS v2u* o8 = (LAS v2u*)(F.lds + 81920 + F.wave * 4096) + F.lane; float am = 0.f;
#pragma unroll
        for (int j = 0; j < 8; ++j) {
            const f32x4 a = *(const LAS f32x4*)(A1 + 256 * j + 4 * F.lane), b = *(const LAS f32x4*)(B1 + 256 * j + 4 * F.lane);
            const f32x4 h = v[j] * rstd * a + b;
            v2u o; o.x = pk2(h.x, h.y); o.y = pk2(h.z, h.w); o8[64 * j] = o; am = fmaxf(am, fmaxf(fmaxf(fabsf(h.x), fabsf(h.y)), fmaxf(fabsf(h.z), fabsf(h.w))));
#pragma unroll
            for (int g = 0; g < 8; ++g) { const f32x4 w = *(const LAS f32x4*)(WG + g * 2048 + 256 * j + 4 * F.lane); gd[g] += (h.x * w.x + h.y * w.y) + (h.z * w.z + h.w * w.w); }
            asm volatile("" ::: "memory");
        }
#pragma unroll
        for (int g = 0; g < 8; ++g) gd[g] = wave_sum(gd[g]);
        if (F.lane == 0) {
#pragma unroll
            for (int g = 0; g < 8; ++g) { float p = gd[g] + F.b_gates[g];
                if (g >= 4) { p = fminf(p, 0.f) - log1pf(__expf(-fabsf(p))); }
                F.GATES[(size_t)row * 8 + g] = p; }
        }
            {
            am = fmaxf(wave_max(am), 1e-30f); const float qinv = 127.0f / am;
            LDS_WAIT(); asm volatile("" ::: "memory");
            GAS unsigned* qr = (GAS unsigned*)(F.H1Q + (size_t)row * D) + F.lane;
#pragma unroll
            for (int j = 0; j < 8; ++j) { const v2u w = o8[64 * j];
                const int q0 = (int)__builtin_rintf(bflo(w.x) * qinv), q1 = (int)__builtin_rintf(bfhi(w.x) * qinv), q2 = (int)__builtin_rintf(bflo(w.y) * qinv), q3 = (int)__builtin_rintf(bfhi(w.y) * qinv);
                qr[64 * j] = (unsigned)(q0 & 255) | ((unsigned)(q1 & 255) << 8) | ((unsigned)(q2 & 255) << 16) | ((unsigned)(q3 & 255) << 24); }
            if (F.lane == 0) F.SA[row] = am * (1.0f / 127.0f);
            LDS_WAIT(); asm volatile("" ::: "memory");
        }
    }
    __syncthreads();
    {
        LAS float* scr = (LAS float*)(F.lds + F.wave * 8960);
        for (int it = F.wave * F.G + F.vcu; it < (D / 64) * (D / 32); it += NGW) p0_wq_item(F, scr, it);
        for (int it = F.wave * F.G + F.vcu; it < (D / 64) * (NWIN / 32); it += NGW) p0_winq_item(F, scr, it);
    }
}
constexpr int IMG_PITCH = 576, M1_WL = 73728, M1_RED = 74240, M1_OB = 90624;
typedef short s16x4 __attribute__((ext_vector_type(4)));
DI bf16x8 tr_frag(const LAS unsigned char* p, int off_lo, int off_hi) {
    const s16x4 lo = __builtin_amdgcn_ds_read_tr16_b64_v4i16((LAS s16x4*)(p + off_lo));
    const s16x4 hi = __builtin_amdgcn_ds_read_tr16_b64_v4i16((LAS s16x4*)(p + off_hi));
    return __builtin_shufflevector(lo, hi, 0, 1, 2, 3, 4, 5, 6, 7);
}
DI float bfel(const v4u& w, int e) { const unsigned d = w[e >> 1]; return (e & 1) ? bfhi(d) : bflo(d); }
DI void m1_item(Frame& F, int hh, int kc) {
    LAS unsigned char* IMG = F.lds; LAS float* WL = (LAS float*)(F.lds + M1_WL); LAS float* RED = (LAS float*)(F.lds + M1_RED);
    const int t0 = kc * CH, lane = F.lane, tid = F.tid;
    if (F.wave == 0) {
        const float* gp = F.GATES + (size_t)(t0 + 2 * lane) * 8;
        const float i0 = gp[hh], lf0 = gp[4 + hh], i1 = gp[8 + hh], lf1 = gp[12 + hh];
        const float p = lf0 + lf1; float inc = p;
#pragma unroll
        for (int o = 1; o < 64; o <<= 1) { const float t = __shfl_up(inc, o); if (lane >= o) inc += t; }
        const float A = __shfl(inc, 63), ex = inc - p, b0 = ex + lf0, b1 = ex + p;
        const float lw0 = A - b0 + i0, lw1 = A - b1 + i1;
        const float B = wave_max(fmaxf(lw0, lw1));
        WL[2 * lane] = __expf(lw0 - B); WL[2 * lane + 1] = __expf(lw1 - B);
        if (lane == 0) { F.SUMM[(hh * NCHUNK + kc) * 2] = A; F.SUMM[(hh * NCHUNK + kc) * 2 + 1] = B; }
    }
    __syncthreads();
    const int dg = tid & 31, sg = tid >> 5;
#pragma unroll 1
    for (int which = 0; which < 2; ++which) {
        const int chb = (which == 0 ? 1024 : 0) + hh * DH + dg * 8;
        const int colb = (which == 0 ? C_K : C_Q) + hh * DH + dg * 8;
        v4u raw[11];
#pragma unroll
        for (int rr = 0; rr < 11; ++rr) { const int tt = t0 + sg * 8 - 3 + rr; raw[rr] = (v4u){0u, 0u, 0u, 0u}; if (tt >= 0) raw[rr] = *(const GAS v4u*)(F.PROJ + (size_t)tt * NPROJ + colb); }
        float wl[8];
#pragma unroll
        for (int i = 0; i < 8; ++i) wl[i] = (which == 0) ? WL[sg * 8 + i] : 0.0625f;
        v4u o1[8], o2[8];
#pragma unroll
        for (int dw = 0; dw < 4; ++dw) {
            typedef float f32x2 __attribute__((ext_vector_type(2)));
            f32x2 cw[4];
#pragma unroll
            for (int j = 0; j < 4; ++j) cw[j] = *(const GAS f32x2*)(F.conv_w + j * 2048 + chb + 2 * dw);
            const f32x2 cb = *(const GAS f32x2*)(F.conv_b + chb + 2 * dw);
            float xl[11], xh[11];
#pragma unroll
            for (int rr = 0; rr < 11; ++rr) { xl[rr] = bflo(raw[rr][dw]); xh[rr] = bfhi(raw[rr][dw]); }
            float d0 = 0.f, d1 = 0.f;
#pragma unroll
            for (int i = 0; i < 8; ++i) {
                float a0 = cb.x, a1 = cb.y;
#pragma unroll
                for (int j = 0; j < 4; ++j) { a0 += cw[j].x * xl[i + j]; a1 += cw[j].y * xh[i + j]; }
                a0 = silu_f(a0); a1 = silu_f(a1);
                if (which == 0) { o1[i][dw] = pk2(a0, a1); a0 *= wl[i]; a1 *= wl[i]; d0 += a0; d1 += a1; o2[i][dw] = pk2(a0, a1); }
                else { o1[i][dw] = pk2(a0 * wl[i], a1 * wl[i]); }
            }
            if (which == 0) { RED[sg * 256 + dg * 8 + 2 * dw] = d0; RED[sg * 256 + dg * 8 + 2 * dw + 1] = d1; }
            asm volatile("" ::: "memory");
        }
#pragma unroll
        for (int i = 0; i < 8; ++i) { const int s = sg * 8 + i, t = t0 + s;
            if (which == 0) { *(GAS v4u*)(F.KC + (size_t)t * 1024 + hh * DH + dg * 8) = o1[i]; *(LAS v4u*)(IMG + s * IMG_PITCH + dg * 16) = o2[i]; }
            else { *(GAS v4u*)(F.QC + (size_t)t * 1024 + hh * DH + dg * 8) = o1[i]; } }
    }
    __syncthreads();
    if (tid < 256) { float s = 0.f;
#pragma unroll
        for (int i = 0; i < 16; ++i) s += RED[i * 256 + tid];
        F.NST[(size_t)(hh * NCHUNK + kc) * DH + tid] = s; }
    const int r = lane & 31, h = lane >> 5, e0 = F.wave * 32;
    bf16x8 bf[8];
#pragma unroll
    for (int ks = 0; ks < 8; ++ks) {
        bf[ks] = *(const GAS bf16x8*)(F.VT + (size_t)(hh * DH + e0 + r) * M + t0 + ks * 16 + 8 * h);
    }
    const LAS unsigned char* trb = IMG + (8 * h + ((lane & 15) >> 2)) * IMG_PITCH + (16 * ((lane >> 4) & 1) + 4 * (lane & 3)) * 2;
    LAS unsigned char* OB = F.lds + M1_OB + F.wave * (32 * 144);
#pragma unroll 1
    for (int dp = 0; dp < 4; ++dp) {
#pragma unroll
        for (int d2 = 0; d2 < 2; ++d2) {
            const int dt = 2 * dp + d2;
            f32x16 acc = zero16();
#pragma unroll
            for (int ks = 0; ks < 8; ++ks) { const bf16x8 af = tr_frag(trb + dt * 64, ks * 16 * IMG_PITCH, ks * 16 * IMG_PITCH + 4 * IMG_PITCH); acc = MFMA32(af, bf[ks], acc); }
#pragma unroll
            for (int g = 0; g < 4; ++g) { v2u o; o.x = pk2(acc[4 * g], acc[4 * g + 1]); o.y = pk2(acc[4 * g + 2], acc[4 * g + 3]);
                *(LAS v2u*)(OB + r * 144 + (d2 * 32 + 8 * g + 4 * h) * 2) = o; }
        }
        LDS_WAIT(); asm volatile("" ::: "memory");
#pragma unroll
        for (int i = 0; i < 4; ++i) { const int q = lane + 64 * i, row = q >> 3, c16 = q & 7;
            *(GAS v4u*)(F.STATE + (size_t)(hh * NCHUNK + kc) * (DH * DH) + (size_t)(e0 + row) * DH + dp * 64 + c16 * 8) = *(const LAS v4u*)(OB + row * 144 + c16 * 16); }
        LDS_WAIT(); asm volatile("" ::: "memory");
    }
    __syncthreads();
}
constexpr int G_WI = 0, G_VI = 34816, G_UI = 75776, G_WP = 272, G_VP = 320, G_UP = 272;
DI void gmlp_block(Frame& F, int g, int n0, int nch) {
    LAS unsigned char* WI = F.lds + G_WI; LAS unsigned char* VI = F.lds + G_VI; LAS unsigned char* UI = F.lds + G_UI;
    const int c0 = g * 128, lane = F.lane, tid = F.tid;
    {
#pragma unroll
        for (int i = 0; i < 8; ++i) { const int p = tid + 512 * i, t = p >> 5, s4 = (p & 31) * 4;
            const f32x4 w = *(const GAS f32x4*)(F.gmlp_w + (size_t)(g * 128 + t) * 128 + s4);
            v2u o; o.x = pk2(s4 <= t ? w.x : 0.f, s4 + 1 <= t ? w.y : 0.f); o.y = pk2(s4 + 2 <= t ? w.z : 0.f, s4 + 3 <= t ? w.w : 0.f);
            *(LAS v2u*)(WI + t * G_WP + s4 * 2) = o; }
    }
    v4u tv[4], tu[4];
#define G_LOAD(N) do { _Pragma("unroll") for (int i = 0; i < 4; ++i) { const int p = tid + 512 * i; const bf16* rowp = F.PROJ + (size_t)((N) * CH + (p >> 4)) * NPROJ + c0 + (p & 15) * 8; \
        tv[i] = *(const GAS v4u*)(rowp + C_VG); tu[i] = *(const GAS v4u*)(rowp + C_UG); } } while (0)
    G_LOAD(n0);
    const int r = lane & 31, h = lane >> 5, ct = F.wave & 3, tp = F.wave >> 2;
    float ng[16];
#pragma unroll
    for (int reg = 0; reg < 16; ++reg) ng[reg] = F.gmlp_norm_g[g * 128 + ct * 32 + crow(reg, h)];
    const LAS unsigned char* trb = VI + (8 * h + ((lane & 15) >> 2)) * G_VP + (ct * 32 + 16 * ((lane >> 4) & 1) + 4 * (lane & 3)) * 2;
#pragma unroll 1
    for (int ci = 0; ci < nch; ++ci) {
        const int n = n0 + ci, t0 = n * CH;
#pragma unroll
        for (int i = 0; i < 4; ++i) { const int p = tid + 512 * i, row = p >> 4, c16 = p & 15; const v4u w = tv[i];
            float a[8] = {bflo(w.x), bfhi(w.x), bflo(w.y), bfhi(w.y), bflo(w.z), bfhi(w.z), bflo(w.w), bfhi(w.w)};
            float ss = (a[0] * a[0] + a[1] * a[1]) + (a[2] * a[2] + a[3] * a[3]) + (a[4] * a[4] + a[5] * a[5]) + (a[6] * a[6] + a[7] * a[7]);
            ss += __shfl_xor(ss, 1); ss += __shfl_xor(ss, 2); ss += __shfl_xor(ss, 4); ss += __shfl_xor(ss, 8);
            const float rs = 1.0f / sqrtf(ss * (1.0f / 128.0f) + EPS);
            v4u o; o.x = pk2(a[0] * rs, a[1] * rs); o.y = pk2(a[2] * rs, a[3] * rs); o.z = pk2(a[4] * rs, a[5] * rs); o.w = pk2(a[6] * rs, a[7] * rs);
            *(LAS v4u*)(VI + row * G_VP + c16 * 16) = o; *(LAS v4u*)(UI + row * G_UP + c16 * 16) = tu[i]; }
        __syncthreads();
        if (ci + 1 < nch) G_LOAD(n + 1);
#pragma unroll 1
        for (int ti = 0; ti < 2; ++ti) {
            const int tt = (ti == 0) ? tp : 3 - tp;
            const int t = tt * 32 + r;
            const LAS unsigned char* wrow = WI + t * G_WP + 16 * h;
            f32x16 acc = zero16();
#pragma unroll
            for (int ks = 0; ks < 8; ++ks) if (ks <= 2 * tt + 1) {
                const bf16x8 af = tr_frag(trb, ks * 16 * G_VP, ks * 16 * G_VP + 4 * G_VP);
                const bf16x8 bw = *(const LAS bf16x8*)(wrow + 32 * ks);
                acc = MFMA32(af, bw, acc);
            }
            const float bsp = F.gmlp_b[g * 128 + t];
            LAS unsigned char* urow = UI + t * G_UP + (ct * 32 + 4 * h) * 2;
#pragma unroll
            for (int gq = 0; gq < 4; ++gq) { LAS v2u* up = (LAS v2u*)(urow + 16 * gq);
                const v2u uw = *up;
                const float y0 = bflo(uw.x) * (ng[4 * gq] * acc[4 * gq] + bsp), y1 = bfhi(uw.x) * (ng[4 * gq + 1] * acc[4 * gq + 1] + bsp);
                const float y2 = bflo(uw.y) * (ng[4 * gq + 2] * acc[4 * gq + 2] + bsp), y3 = bfhi(uw.y) * (ng[4 * gq + 3] * acc[4 * gq + 3] + bsp);
                v2u o; o.x = pk2(y0, y1); o.y = pk2(y2, y3); *up = o; }
        }
        __syncthreads();
#pragma unroll
        for (int i = 0; i < 4; ++i) { const int p = tid + 512 * i, row = p >> 4, c16 = p & 15;
            *(GAS v4u*)(F.HA + (size_t)(t0 + row) * D + c0 + c16 * 8) = *(const LAS v4u*)(UI + row * G_UP + c16 * 16); }
        __syncthreads();
    }
#undef G_LOAD
}
DI void p2_phase(Frame& F) {
    constexpr int N_M1 = NHEAD * NCHUNK;
#pragma unroll 1
    for (int it = (int)blockIdx.x; it < N_M1; it += F.G) m1_item(F, it / NCHUNK, it % NCHUNK);
    { const int per = (8 * (M / CH) + F.G - 1) / F.G;
      const int first = (int)blockIdx.x * per;
      if (first < 8 * (M / CH)) { const int g = first / (M / CH), n0 = first % (M / CH); int nch = per; if (n0 + nch > M / CH) nch = M / CH - n0; gmlp_block(F, g, n0, nch); } }
}
DI void p3_phase(Frame& F) {
    LAS float* TAB = (LAS float*)F.lds;
    const int lane = F.lane;
    if (F.wave < NHEAD) {
        const int hh = F.wave; const float* sp = F.SUMM + (size_t)(hh * NCHUNK + 2 * lane) * 2;
        const float A0 = sp[0], B0 = sp[1], A1 = sp[2], B1 = sp[3];
        float ca = A0 + A1, cb = fmaxf(B0 + A1, B1);
        const float pa = ca, pb = cb;
#pragma unroll
        for (int o = 1; o < 64; o <<= 1) { const float ta = __shfl_up(ca, o), tb = __shfl_up(cb, o); if (lane >= o) { cb = fmaxf(tb + ca, cb); ca = ta + ca; } }
        (void)pa; (void)pb;
        float ea = __shfl_up(ca, 1), eb = __shfl_up(cb, 1);
        float m0 = (lane == 0) ? 0.f : fmaxf(ea, eb);
        const float m1 = fmaxf(m0 + A0, B0), m2 = fmaxf(m1 + A1, B1);
        TAB[(hh * NCHUNK + 2 * lane) * 2] = __expf(A0 + m0 - m1); TAB[(hh * NCHUNK + 2 * lane) * 2 + 1] = __expf(B0 - m1);
        TAB[(hh * NCHUNK + 2 * lane + 1) * 2] = __expf(A1 + m1 - m2); TAB[(hh * NCHUNK + 2 * lane + 1) * 2 + 1] = __expf(B1 - m2);
        if (blockIdx.x == 0) { F.MTAB[hh * NCHUNK + 2 * lane] = m0; F.MTAB[hh * NCHUNK + 2 * lane + 1] = m1; }
    }
    __syncthreads();
    const int NT = F.G * NWAVES * 64, gt = (int)blockIdx.x * (NWAVES * 64) + F.tid;
    if (gt < D) { float b = 0.f;
#pragma unroll 8
        for (int k = 0; k < D / 64; ++k) b += F.BQP[(size_t)k * D + gt];
        F.BIASQ[gt] = b; }
    for (int p = gt; p < NHEAD * (DH * DH / 2); p += NT) {
        const int hh = p / (DH * DH / 2), q = p % (DH * DH / 2);
        GAS unsigned* sp = (GAS unsigned*)(F.STATE + (size_t)hh * NCHUNK * (DH * DH)) + q;
        float s0 = 0.f, s1 = 0.f;
#pragma unroll 1
        for (int k0 = 0; k0 < NCHUNK; k0 += 16) {
            unsigned ld[16];
#pragma unroll
            for (int k = 0; k < 16; ++k) ld[k] = sp[(size_t)(k0 + k) * (DH * DH / 2)];
#pragma unroll
            for (int k = 0; k < 16; ++k) {
                sp[(size_t)(k0 + k) * (DH * DH / 2)] = pk2(s0, s1);
                const float dec = TAB[(hh * NCHUNK + k0 + k) * 2], wb = TAB[(hh * NCHUNK + k0 + k) * 2 + 1];
                s0 = dec * s0 + wb * bflo(ld[k]); s1 = dec * s1 + wb * bfhi(ld[k]);
            }
        }
    }
    for (int p = gt; p < NHEAD * DH; p += NT) {
        const int hh = p / DH, d = p % DH; float* np = F.NST + (size_t)hh * NCHUNK * DH + d; float s = 0.f;
#pragma unroll 8
        for (int k = 0; k < NCHUNK; ++k) { const float ld = np[(size_t)k * DH]; np[(size_t)k * DH] = s; s = TAB[(hh * NCHUNK + k) * 2] * s + TAB[(hh * NCHUNK + k) * 2 + 1] * ld; }
    }
}
constexpr int M3_QI = 8192, M3_R2 = 75776, M3_QP = 528, M3_CP = 272, M3_VP = 264;
static_assert(M3_R2 + 256 * M3_CP <= LDSCTL_OFF, "P4 LDS map");
DI void m3_item(Frame& F, int hh, int kc) {
    LAS float* GS = (LAS float*)F.lds; LAS float* MX = GS + 128; LAS float* BT = GS + 256; LAS float* NK = GS + 384; LAS float* XCH = GS + 640;
    LAS unsigned char* QI = F.lds + M3_QI; LAS unsigned char* R2 = F.lds + M3_R2;
    int tid = F.tid; asm volatile("" : "+v"(tid));
    const int t0 = kc * CH, lane = F.lane, item = hh * NCHUNK + kc;
    const float mk = F.MTAB[item];
    const bf16* cbase = F.STATE + (size_t)item * (DH * DH);
    const bf16* kbase = F.KC + (size_t)t0 * 1024 + hh * DH;
    const bf16* qbase = F.QC + (size_t)t0 * 1024 + hh * DH;
    const bf16* vbase = F.VT + (size_t)(hh * DH) * M + t0;
    {
        v4u tk[8], tq[8];
#pragma unroll
        for (int i = 0; i < 8; ++i) { const int p = tid + 512 * i; tk[i] = *(const GAS v4u*)(kbase + (size_t)(p >> 5) * 1024 + (p & 31) * 8); tq[i] = *(const GAS v4u*)(qbase + (size_t)(p >> 5) * 1024 + (p & 31) * 8); }
        if (F.wave == 0) {
            const float* gp = F.GATES + (size_t)(t0 + 2 * lane) * 8;
            const float i0 = gp[hh], lf0 = gp[4 + hh], i1 = gp[8 + hh], lf1 = gp[12 + hh];
            const float p = lf0 + lf1; float inc = p;
#pragma unroll
            for (int o = 1; o < 64; o <<= 1) { const float t = __shfl_up(inc, o); if (lane >= o) inc += t; }
            const float ex = inc - p, b0 = ex + lf0, b1 = ex + p;
            const float g0 = i0 - b0, g1 = i1 - b1;
            float cm = fmaxf(g0, g1);
#pragma unroll
            for (int o = 1; o < 64; o <<= 1) { const float t = __shfl_up(cm, o); if (lane >= o) cm = fmaxf(cm, t); }
            float pm = __shfl_up(cm, 1); if (lane == 0) pm = -INFINITY;
            const float M0 = fmaxf(mk, fmaxf(pm, g0)), M1 = fmaxf(M0, g1);
            GS[2 * lane] = g0; GS[2 * lane + 1] = g1; MX[2 * lane] = M0; MX[2 * lane + 1] = M1; BT[2 * lane] = b0; BT[2 * lane + 1] = b1;
        }
        if (tid < 256) NK[tid] = F.NST[(size_t)item * DH + tid];
#pragma unroll
        for (int i = 0; i < 8; ++i) { const int p = tid + 512 * i; *(LAS v4u*)(R2 + (p >> 5) * M3_QP + (p & 31) * 16) = tk[i]; *(LAS v4u*)(QI + (p >> 5) * M3_QP + (p & 31) * 16) = tq[i]; }
    }
    __syncthreads();
    const int r = lane & 31, h = lane >> 5, tt = F.wave & 3, eh = F.wave >> 2;
    const int tl = tt * 32 + r, t = t0 + tl;
    const float Mt = MX[tl], winter = __expf(mk - Mt);
    const LAS unsigned char* qrow = QI + tl * M3_QP + 16 * h;
    const LAS float* GSh = GS + 4 * h; int tlo = tl - 4 * h; asm volatile("" : "+v"(tlo));
    bf16x8 xs[4][2]; float den = 0.f;
#pragma unroll
    for (int st = 0; st < 4; ++st) {
        if (st <= tt) {
            f32x16 accS = zero16();
            const LAS unsigned char* krow = R2 + (st * 32 + r) * M3_QP + 16 * h;
#pragma unroll 4
            for (int ks = 0; ks < 16; ++ks) { const bf16x8 kf = *(const LAS bf16x8*)(krow + 32 * ks); const bf16x8 qf = *(const LAS bf16x8*)(qrow + 32 * ks); accS = MFMA32(kf, qf, accS); }
            float xv[16];
#pragma unroll
            for (int reg = 0; reg < 16; ++reg) { const int sc = st * 32 + (reg & 3) + 8 * (reg >> 2); float v = accS[reg] * __expf(GSh[sc] - Mt); if (sc > tlo) v = 0.f; xv[reg] = v; den += v; }
#pragma unroll
            for (int k2 = 0; k2 < 2; ++k2) { v4u xw; xw.x = pk2(xv[8 * k2], xv[8 * k2 + 1]); xw.y = pk2(xv[8 * k2 + 2], xv[8 * k2 + 3]); xw.z = pk2(xv[8 * k2 + 4], xv[8 * k2 + 5]); xw.w = pk2(xv[8 * k2 + 6], xv[8 * k2 + 7]);
                xs[st][k2] = __builtin_bit_cast(bf16x8, xw); }
        } else { xs[st][0] = (bf16x8){0, 0, 0, 0, 0, 0, 0, 0}; xs[st][1] = xs[st][0]; }
        asm volatile("" ::: "memory");
    }
    f32x16 accH[4];
#pragma unroll
    for (int i = 0; i < 4; ++i) accH[i] = zero16();
    float qn = 0.f;
#pragma unroll 1
    for (int hf = 0; hf < 2; ++hf) {
        v4u tc[8];
#pragma unroll
        for (int i = 0; i < 8; ++i) { const int p = tid + 512 * i; tc[i] = *(const GAS v4u*)(cbase + (size_t)(p >> 4) * DH + hf * 128 + (p & 15) * 8); }
        __syncthreads();
#pragma unroll
        for (int i = 0; i < 8; ++i) { const int p = tid + 512 * i; *(LAS v4u*)(R2 + (p >> 4) * M3_CP + (p & 15) * 16) = tc[i]; }
        __syncthreads();
        const LAS unsigned char* crow0 = R2 + (eh * 128 + r) * M3_CP + 16 * h;
#pragma unroll 2
        for (int ks = 0; ks < 8; ++ks) {
            const int kg = hf * 8 + ks;
            const v4u qw = *(const LAS v4u*)(qrow + 32 * kg);
            float qv[8] = {bflo(qw.x), bfhi(qw.x), bflo(qw.y), bfhi(qw.y), bflo(qw.z), bfhi(qw.z), bflo(qw.w), bfhi(qw.w)};
            const f32x4 na = *(const LAS f32x4*)(NK + kg * 16 + 8 * h), nb = *(const LAS f32x4*)(NK + kg * 16 + 8 * h + 4);
            qn += (qv[0] * na.x + qv[1] * na.y) + (qv[2] * na.z + qv[3] * na.w) + (qv[4] * nb.x + qv[5] * nb.y) + (qv[6] * nb.z + qv[7] * nb.w);
            v4u q2; q2.x = pk2(qv[0] * winter, qv[1] * winter); q2.y = pk2(qv[2] * winter, qv[3] * winter); q2.z = pk2(qv[4] * winter, qv[5] * winter); q2.w = pk2(qv[6] * winter, qv[7] * winter);
            const bf16x8 q2f = __builtin_bit_cast(bf16x8, q2);
#pragma unroll
            for (int et = 0; et < 4; ++et) { const bf16x8 cf = *(const LAS bf16x8*)(crow0 + et * 32 * M3_CP + 32 * ks); accH[et] = MFMA32(cf, q2f, accH[et]); }
        }
    }
    qn += __shfl_xor(qn, 32);
    {
        v4u tv[8];
#pragma unroll
        for (int i = 0; i < 8; ++i) { const int p = tid + 512 * i; tv[i] = *(const GAS v4u*)(vbase + (size_t)(p >> 4) * M + (p & 15) * 8); }
        __syncthreads();
#pragma unroll
        for (int i = 0; i < 8; ++i) { const int p = tid + 512 * i; LAS unsigned char* d = R2 + (p >> 4) * M3_VP + (p & 15) * 16;
            *(LAS v2u*)d = (v2u){tv[i].x, tv[i].y}; *(LAS v2u*)(d + 8) = (v2u){tv[i].z, tv[i].w}; }
    }
    __syncthreads();
    const LAS unsigned char* vrow0 = R2 + (eh * 128 + r) * M3_VP + 8 * h;
#pragma unroll
    for (int st = 0; st < 4; ++st) if (st <= tt) {
#pragma unroll
        for (int k2 = 0; k2 < 2; ++k2)
#pragma unroll
            for (int et = 0; et < 4; ++et) {
                const LAS unsigned char* vp = vrow0 + et * 32 * M3_VP + (st * 32 + 16 * k2) * 2;
                const v2u lo = *(const LAS v2u*)vp, hi = *(const LAS v2u*)(vp + 16);
                v4u vw; vw.x = lo.x; vw.y = lo.y; vw.z = hi.x; vw.w = hi.y;
                accH[et] = MFMA32(__builtin_bit_cast(bf16x8, vw), xs[st][k2], accH[et]);
                asm volatile("" ::: "memory");
            }
    }
    v4u to[8];
    { const bf16* obase = F.PROJ + (size_t)t0 * NPROJ + C_OM + hh * DH;
#pragma unroll
      for (int i = 0; i < 8; ++i) { const int p = tid + 512 * i; to[i] = *(const GAS v4u*)(obase + (size_t)(p >> 5) * NPROJ + (p & 31) * 8); } }
    den += __shfl_xor(den, 32);
    den += winter * qn;
    const float dnm = fmaxf(fabsf(den), __expf(-(BT[tl] + Mt))), inv = 1.0f / dnm;
    float ss = 0.f;
#pragma unroll
    for (int et = 0; et < 4; ++et)
#pragma unroll
        for (int reg = 0; reg < 16; ++reg) { accH[et][reg] *= inv; ss += accH[et][reg] * accH[et][reg]; }
    ss += __shfl_xor(ss, 32);
    if (h == 0) XCH[eh * 128 + tl] = ss;
#pragma unroll
    for (int i = 0; i < 8; ++i) { const int p = tid + 512 * i; *(LAS v4u*)(QI + (p >> 5) * M3_QP + (p & 31) * 16) = to[i]; }
    __syncthreads();
    const float rstd = 1.0f / sqrtf((XCH[tl] + XCH[128 + tl]) * (1.0f / DH) + EPS);
    LAS unsigned char* orow = QI + tl * M3_QP + (eh * 128 + 4 * h) * 2;
    const float* ngp = F.mlstm_norm_g + hh * DH + eh * 128;
#pragma unroll
    for (int et = 0; et < 4; ++et)
#pragma unroll
        for (int gq = 0; gq < 4; ++gq) { const int el = et * 32 + 8 * gq + 4 * h; LAS v2u* op = (LAS v2u*)(orow + (et * 32 + 8 * gq) * 2);
            const v2u ow = *op; const f32x4 gn = *(const GAS f32x4*)(ngp + el);
            const float y0 = accH[et][4 * gq] * rstd * gn.x * sigmoid_f(bflo(ow.x)), y1 = accH[et][4 * gq + 1] * rstd * gn.y * sigmoid_f(bfhi(ow.x));
            const float y2 = accH[et][4 * gq + 2] * rstd * gn.z * sigmoid_f(bflo(ow.y)), y3 = accH[et][4 * gq + 3] * rstd * gn.w * sigmoid_f(bfhi(ow.y));
            v2u o; o.x = pk2(y0, y1); o.y = pk2(y2, y3); *op = o; }
    __syncthreads();
#pragma unroll
    for (int i = 0; i < 8; ++i) { const int p = tid + 512 * i, row = p >> 5, c16 = p & 31;
        *(GAS v4u*)(F.HA + (size_t)(t0 + row) * D + 1024 + hh * DH + c16 * 8) = *(const LAS v4u*)(QI + row * M3_QP + c16 * 16); }
    __syncthreads();
}
DI void p4_phase(Frame& F) {
    for (int it = (int)blockIdx.x; it < NHEAD * NCHUNK; it += F.G) m3_item(F, it / NCHUNK, it % NCHUNK);
}
constexpr int KPITCH = 272, P8_TBL = 69632;
DI void topk_insert(float (&L)[16], float x) {
#pragma unroll
    for (int i = 15; i >= 1; --i) L[i] = __builtin_amdgcn_fmed3f(x, L[i - 1], L[i]);
    L[0] = fmaxf(L[0], x);
}
DI void p8_phase(Frame& F) {
    LAS unsigned char* KIMG = F.lds; LAS unsigned char* TBL = F.lds + P8_TBL + F.wave * 1024;
    const int lane = F.lane, tid = F.tid, r = lane & 31, h = lane >> 5;
#pragma unroll 4
    for (int i = 0; i < 16; ++i) { const int idx = tid * 4 + 2048 * i, side = idx >> 14, rem = idx & 16383, row = rem >> 7, col = rem & 127;
        const f32x4 a = *(const GAS f32x4*)((side ? F.keys2 : F.keys1) + rem);
        v2u o; o.x = pk2(a.x, a.y); o.y = pk2(a.z, a.w); *(LAS v2u*)(KIMG + (side * 128 + row) * KPITCH + col * 2) = o; }
    __syncthreads();
    for (int it = (int)blockIdx.x; it < (M / 256) * PH; it += F.G) {
        const int tile = it / PH, hd = it % PH;
        const int t = tile * 256 + F.wave * 32 + r;
        float L1[16], L2[16];
#pragma unroll 1
        for (int side = 0; side < 2; ++side) {
            f32x16 acc[4];
#pragma unroll
            for (int kt = 0; kt < 4; ++kt) acc[kt] = zero16();
            const bf16* qp = F.QB + (size_t)t * D + hd * 256 + side * 128 + 8 * h;
#pragma unroll
            for (int ks = 0; ks < 8; ++ks) {
                const bf16x8 qf = *(const GAS bf16x8*)(qp + ks * 16);
#pragma unroll
                for (int kt = 0; kt < 4; ++kt) { const bf16x8 kf = *(const LAS bf16x8*)(KIMG + (side * 128 + kt * 32 + r) * KPITCH + (ks * 16 + 8 * h) * 2); acc[kt] = MFMA32(kf, qf, acc[kt]); }
            }
            float L[16];
#pragma unroll
            for (int i = 0; i < 16; ++i) L[i] = -3.0e38f;
#pragma unroll
            for (int kt = 0; kt < 4; ++kt)
#pragma unroll
                for (int reg = 0; reg < 16; ++reg) { const unsigned key = (unsigned)(kt * 32 + crow(reg, h)); const float sv = acc[kt][reg];
                    topk_insert(L, __uint_as_float((__float_as_uint(sv) & ~127u) | key)); }
            float P[16];
#pragma unroll
            for (int i = 0; i < 16; ++i) P[i] = __shfl_xor(L[i], 32);
#pragma unroll
            for (int i = 0; i < 16; ++i) topk_insert(L, P[i]);
            if (side == 0) {
#pragma unroll
                for (int i = 0; i < 16; ++i) L1[i] = L[i];
            } else {
#pragma unroll
                for (int i = 0; i < 16; ++i) L2[i] = L[i];
            }
        }
        if (h == 0) {
#pragma unroll
            for (int w = 0; w < 4; ++w) {
                const unsigned a = (__builtin_bit_cast(unsigned, L1[4 * w]) & 127u) | ((__builtin_bit_cast(unsigned, L1[4 * w + 1]) & 127u) << 8) | ((__builtin_bit_cast(unsigned, L1[4 * w + 2]) & 127u) << 16) | ((__builtin_bit_cast(unsigned, L1[4 * w + 3]) & 127u) << 24);
                const unsigned b = (__builtin_bit_cast(unsigned, L2[4 * w]) & 127u) | ((__builtin_bit_cast(unsigned, L2[4 * w + 1]) & 127u) << 8) | ((__builtin_bit_cast(unsigned, L2[4 * w + 2]) & 127u) << 16) | ((__builtin_bit_cast(unsigned, L2[4 * w + 3]) & 127u) << 24);
                *(LAS unsigned*)(TBL + r * 32 + 4 * w) = a; *(LAS unsigned*)(TBL + r * 32 + 16 + 4 * w) = b;
            }
        }
        float T[16];
#pragma unroll
        for (int i = 0; i < 16; ++i) T[i] = -3.0e38f;
#pragma unroll
        for (int i = 0; i < 16; ++i) {
            const float v1 = __builtin_bit_cast(float, __builtin_bit_cast(unsigned, L1[i]) & ~127u);
#pragma unroll
            for (int j = 0; j < 16; ++j) if ((i + 1) * (j + 1) <= 16) {
                const float v2 = __builtin_bit_cast(float, __builtin_bit_cast(unsigned, L2[j]) & ~127u);
                topk_insert(T, __builtin_bit_cast(float, (__builtin_bit_cast(unsigned, v1 + v2) & ~255u) | (unsigned)(i * 16 + j)));
            }
        }
        LDS_WAIT(); asm volatile("" ::: "memory");
        float ev[16], esum = 0.f;
        const float mx = __builtin_bit_cast(float, __builtin_bit_cast(unsigned, T[0]) & ~255u);
#pragma unroll
        for (int i = 0; i < 16; ++i) { ev[i] = __expf(__builtin_bit_cast(float, __builtin_bit_cast(unsigned, T[i]) & ~255u) - mx); esum += ev[i]; }
        const float einv = 1.0f / esum;
        int eid[8]; float gt[8];
#pragma unroll
        for (int i = 0; i < 8; ++i) { const float tv = h ? T[8 + i] : T[i]; const float e = h ? ev[8 + i] : ev[i];
            const unsigned p = __builtin_bit_cast(unsigned, tv) & 255u;
            const unsigned i1 = *(const LAS unsigned char*)(TBL + r * 32 + (p >> 4)), i2 = *(const LAS unsigned char*)(TBL + r * 32 + 16 + (p & 15u));
            eid[i] = (int)(i1 * 128u + i2); gt[i] = e * einv; }
        int* ip = F.IDX + (size_t)t * NSEL + hd * 16 + 8 * h; float* gp = F.PG + (size_t)t * NSEL + hd * 16 + 8 * h;
        *(GAS v4u*)ip = (v4u){(unsigned)eid[0], (unsigned)eid[1], (unsigned)eid[2], (unsigned)eid[3]}; *(GAS v4u*)(ip + 4) = (v4u){(unsigned)eid[4], (unsigned)eid[5], (unsigned)eid[6], (unsigned)eid[7]};
        *(GAS f32x4*)gp = (f32x4){gt[0], gt[1], gt[2], gt[3]}; *(GAS f32x4*)(gp + 4) = (f32x4){gt[4], gt[5], gt[6], gt[7]};
        LDS_WAIT(); asm volatile("" ::: "memory");
    }
}
constexpr int P9_IDX = 131072, P9_SH = 147456, P9_CORR = 147712, P9_GF = 32768, P9_FG = 40960, P9_SSQ = 49152, P9_CQ = 65536, P9_CT = 81920, P9_CSQ = 82176, NSLICE = 16, SLICE_B = 128;
#ifndef NSLICE_A
#define NSLICE_A NSLICE
#endif
#ifndef NSLICE_C
#define NSLICE_C NSLICE
#endif
template <int N, int MASK> DI void red_step_i(int (&v)[8], int lane) {
#pragma unroll
    for (int i = 0; i < N / 2; ++i) { const bool up = (lane & MASK) != 0; const int keep = up ? v[i + N / 2] : v[i], send = up ? v[i] : v[i + N / 2]; v[i] = keep + __shfl_xor(send, MASK); }
}
template <int N, int MASK> DI void red_step_f(float (&v)[16], int lane) {
#pragma unroll
    for (int i = 0; i < N / 2; ++i) { const bool up = (lane & MASK) != 0; const float keep = up ? v[i + N / 2] : v[i], send = up ? v[i] : v[i + N / 2]; v[i] = keep + __shfl_xor(send, MASK); }
}
typedef _Float16 h2v __attribute__((ext_vector_type(2)));
DI void acc4(float& o0, float& o1, float& o2, float& o3, unsigned u, float c) {
    const h2v p = __builtin_bit_cast(h2v, __builtin_amdgcn_perm(u, 0x64646464u, 0x01050004u));
    const h2v q = __builtin_bit_cast(h2v, __builtin_amdgcn_perm(u, 0x64646464u, 0x01070006u));
    o0 = __builtin_fmaf((float)p.x, c, o0); o1 = __builtin_fmaf((float)p.y, c, o1); o2 = __builtin_fmaf((float)q.x, c, o2); o3 = __builtin_fmaf((float)q.y, c, o3);
}
template <int N> DI void red32_f(float (&v)[16]) {
#pragma unroll
    for (int i = 0; i < N / 2; ++i) { const auto rr = __builtin_amdgcn_permlane32_swap(__float_as_uint(v[i]), __float_as_uint(v[i + N / 2]), false, false); v[i] = __uint_as_float(rr[0]) + __uint_as_float(rr[1]); }
}
template <int N> DI void red16_f(float (&v)[16]) {
#pragma unroll
    for (int i = 0; i < N / 2; ++i) { const auto rr = __builtin_amdgcn_permlane16_swap(__float_as_uint(v[i]), __float_as_uint(v[i + N / 2]), false, false); v[i] = __uint_as_float(rr[0]) + __uint_as_float(rr[1]); }
}
template <int N> DI void red8_f(float (&v)[16], int lane) {
#pragma unroll
    for (int i = 0; i < N / 2; ++i) { const bool up = (lane & 8) != 0; const float keep = up ? v[i + N / 2] : v[i], send = up ? v[i] : v[i + N / 2];
        v[i] = keep + __builtin_bit_cast(float, __builtin_amdgcn_mov_dpp(__builtin_bit_cast(int, send), 0x128, 0xf, 0xf, true)); }
}
template <int N> DI void redi32(int (&v)[16]) {
#pragma unroll
    for (int i = 0; i < N / 2; ++i) { const auto rr = __builtin_amdgcn_permlane32_swap((unsigned)v[i], (unsigned)v[i + N / 2], false, false); v[i] = (int)(rr[0] + rr[1]); }
}
template <int N> DI void redi16(int (&v)[16]) {
#pragma unroll
    for (int i = 0; i < N / 2; ++i) { const auto rr = __builtin_amdgcn_permlane16_swap((unsigned)v[i], (unsigned)v[i + N / 2], false, false); v[i] = (int)(rr[0] + rr[1]); }
}
template <int N> DI void redi8(int (&v)[16], int lane) {
#pragma unroll
    for (int i = 0; i < N / 2; ++i) { const bool up = (lane & 8) != 0; const int keep = up ? v[i + N / 2] : v[i], send = up ? v[i] : v[i + N / 2]; v[i] = keep + __builtin_amdgcn_mov_dpp(send, 0x128, 0xf, 0xf, true); }
}
DI void p9v2_phase(Frame& F) {
    LAS unsigned char* HQ = F.lds; LAS float* A2 = (LAS float*)(F.lds + P9_IDX); LAS float* B2 = (LAS float*)(F.lds + P9_IDX + 8192);
    LAS unsigned short* IDX16 = (LAS unsigned short*)(F.lds + P9_IDX); LAS float* SH = (LAS float*)(F.lds + P9_SH); LAS float* CORR = (LAS float*)(F.lds + P9_CORR);
    LAS float* GF = (LAS float*)(F.lds + P9_GF); LAS float* FG = (LAS float*)(F.lds + P9_FG);
    const int lane = F.lane, tid = F.tid, c8 = lane & 7, g = lane >> 3;
#pragma unroll 1
    for (int tb = (int)blockIdx.x * 64; tb < M; tb += F.G * 64) {
#pragma unroll
        for (int i = 0; i < 4; ++i) { const int c = tid + 512 * i; A2[c] = F.norm_ffn_g[c] * (1.0f + F.MODF[MOD_SCF + c]); B2[c] = F.MODF[MOD_SHF + c]; }
        __syncthreads();
#pragma unroll 1
        for (int j = 0; j < 8; ++j) {
            const int tl = F.wave * 8 + j, t = tb + tl;
            float hv[32]; float ss = 0.f;
            const bf16* xr = F.X1B + (size_t)t * D + 16 * lane;
#pragma unroll
            for (int jj = 0; jj < 2; ++jj)
#pragma unroll
                for (int q = 0; q < 2; ++q) { const v4u a = *(const GAS v4u*)(xr + 1024 * jj + 8 * q); const int o = 16 * jj + 8 * q;
                    hv[o] = bflo(a.x); hv[o + 1] = bfhi(a.x); hv[o + 2] = bflo(a.y); hv[o + 3] = bfhi(a.y); hv[o + 4] = bflo(a.z); hv[o + 5] = bfhi(a.z); hv[o + 6] = bflo(a.w); hv[o + 7] = bfhi(a.w); }
#pragma unroll
            for (int i = 0; i < 32; ++i) ss += hv[i] * hv[i];
            const float rstd = 1.0f / sqrtf(wave_sum(ss) * (1.0f / D) + EPS);
            float am = 0.f;
#pragma unroll
            for (int jj = 0; jj < 2; ++jj)
#pragma unroll
                for (int q = 0; q < 4; ++q) { const f32x4 a = *(const LAS f32x4*)(A2 + 1024 * jj + 16 * lane + 4 * q), b = *(const LAS f32x4*)(B2 + 1024 * jj + 16 * lane + 4 * q);
                    const int o = 16 * jj + 4 * q;
                    hv[o] = hv[o] * rstd * a.x + b.x; hv[o + 1] = hv[o + 1] * rstd * a.y + b.y; hv[o + 2] = hv[o + 2] * rstd * a.z + b.z; hv[o + 3] = hv[o + 3] * rstd * a.w + b.w;
                    am = fmaxf(am, fmaxf(fmaxf(fabsf(hv[o]), fabsf(hv[o + 1])), fmaxf(fabsf(hv[o + 2]), fabsf(hv[o + 3])))); }
            am = fmaxf(wave_max(am), 1e-30f); const float inv = 127.0f / am;
            if (lane == 0) SH[tl] = am * (1.0f / 127.0f);
#pragma unroll
            for (int jj = 0; jj < 2; ++jj) { v4u o;
#pragma unroll
                for (int q = 0; q < 4; ++q) { const int b = 16 * jj + 4 * q;
                    const int q0 = (int)__builtin_rintf(hv[b] * inv), q1 = (int)__builtin_rintf(hv[b + 1] * inv), q2 = (int)__builtin_rintf(hv[b + 2] * inv), q3 = (int)__builtin_rintf(hv[b + 3] * inv);
                    o[q] = (unsigned)(q0 & 255) | ((unsigned)(q1 & 255) << 8) | ((unsigned)(q2 & 255) << 16) | ((unsigned)(q3 & 255) << 24); }
                *(LAS v4u*)(HQ + tl * 2048 + 1024 * jj + 16 * lane) = o; }
        }
        __syncthreads();
#pragma unroll
        for (int i = 0; i < 16; ++i) { const int q = tid + 512 * i, k = q & 127; IDX16[(q & ~127) + (k & 64) + 8 * (k & 7) + ((k >> 3) & 7)] = (unsigned short)F.IDX[(size_t)tb * NSEL + q]; }
        __syncthreads();
        int P[8][2];
#pragma unroll
        for (int j = 0; j < 8; ++j) { P[j][0] = 0; P[j][1] = 0; }
#pragma unroll 1
        for (int s = 0; s < NSLICE_A; ++s) {
            if (((s ^ (F.wave >> 2)) & 1) != 0) __builtin_amdgcn_s_setprio(1); else __builtin_amdgcn_s_setprio(0);
            const unsigned char* eb = F.ED + s * SLICE_B;
            const unsigned lo = (unsigned)(c8 * 16);
            v4u wA[8], wB[8];
#define P9A_LOAD(W, J, H) do { _Pragma("unroll") for (int i = 0; i < 8; ++i) { const unsigned e = IDX16[(F.wave * 8 + (J)) * 128 + 64 * (H) + 8 * g + i]; W[i] = *(const GAS v4u*)(eb + (e * 2048u + lo)); } } while (0)
#define P9A_COMP(W, J, H) do { const v4u hq = *(const LAS v4u*)(HQ + (F.wave * 8 + (J)) * 2048 + s * SLICE_B + c8 * 16); int a[8]; \
                _Pragma("unroll") for (int i = 0; i < 8; ++i) { int d = 0; const v4u ww = W[i]; \
                    d = __builtin_amdgcn_sdot4((int)hq.x, (int)ww.x, d, false); d = __builtin_amdgcn_sdot4((int)hq.y, (int)ww.y, d, false); d = __builtin_amdgcn_sdot4((int)hq.z, (int)ww.z, d, false); d = __builtin_amdgcn_sdot4((int)hq.w, (int)ww.w, d, false); a[i] = d; } \
                red_step_i<8, 4>(a, lane); red_step_i<4, 2>(a, lane); red_step_i<2, 1>(a, lane); P[J][H] += a[0]; asm volatile("" ::: "memory"); } while (0)
            P9A_LOAD(wA, 0, 0);
#pragma unroll
            for (int j = 0; j < 8; ++j) {
                P9A_LOAD(wB, j, 1);
                P9A_COMP(wA, j, 0);
                if (j < 7) P9A_LOAD(wA, j + 1, 0);
                P9A_COMP(wB, j, 1);
            }
#undef P9A_LOAD
#undef P9A_COMP
        }
        __builtin_amdgcn_s_setprio(0);
        __syncthreads();
        LAS int* PI = (LAS int*)F.lds;
#pragma unroll
        for (int j = 0; j < 8; ++j) { const int tl = F.wave * 8 + j; PI[tl * 128 + 8 * c8 + g] = P[j][0]; PI[tl * 128 + 64 + 8 * c8 + g] = P[j][1]; }
#pragma unroll
        for (int i = 0; i < 4; ++i) { const int c = tid + 512 * i; GF[c] = F.MODF[MOD_GF + c]; FG[c] = F.final_g[c]; }
        LAS float* SSQL = (LAS float*)(F.lds + P9_SSQ); LAS short* CQ = (LAS short*)(F.lds + P9_CQ); LAS float* CT = (LAS float*)(F.lds + P9_CT); LAS int* CSQ = (LAS int*)(F.lds + P9_CSQ);
#pragma unroll 1
        for (int j = 0; j < 8; ++j) { const int tl = F.wave * 8 + j, t = tb + tl; const float sh = SH[tl]; float cf[2]; float am = 0.f;
#pragma unroll
            for (int h = 0; h < 2; ++h) { const int k = 64 * h + lane; const unsigned e = IDX16[tl * 128 + 64 * h + 8 * (lane & 7) + (lane >> 3)];
                const float act = (float)PI[tl * 128 + k] * (sh * F.SD[e]); cf[h] = F.PG[(size_t)t * NSEL + k] * gelu_f(act) * F.SU[e]; am = fmaxf(am, fabsf(cf[h])); }
            am = fmaxf(wave_max(am), 1e-30f); const float inv = 32767.0f / am; int qs = 0;
#pragma unroll
            for (int h = 0; h < 2; ++h) { const int q = (int)__builtin_rintf(cf[h] * inv); qs += q; CQ[tl * 128 + 64 * h + 8 * (lane & 7) + (lane >> 3)] = (short)q; }
#pragma unroll
            for (int o = 1; o < 64; o <<= 1) qs += __shfl_xor(qs, o);
            if (lane == 0) { CT[tl] = am * (1.0f / 32767.0f); CSQ[tl] = 128 * qs; }
            }
        __syncthreads();
        const int cb = c8 * 16 + ((lane >> 5) & 1) * 8 + ((lane >> 4) & 1) * 4 + ((lane >> 3) & 1) * 2;
        typedef short s16x2 __attribute__((ext_vector_type(2)));
#pragma unroll 1
        for (int s = 0; s < NSLICE_C; ++s) {
            if (((s ^ (F.wave >> 2)) & 1) != 0) __builtin_amdgcn_s_setprio(1); else __builtin_amdgcn_s_setprio(0);
            const unsigned char* eb = F.EU + s * SLICE_B;
            const unsigned lo = (unsigned)(c8 * 16);
            v4u wA[8], wB[8]; unsigned cA[4], cB[4];
#define P9C_LOAD(W, C, TL, H) do { const LAS unsigned* ip = (const LAS unsigned*)(IDX16 + (TL) * 128 + 64 * (H) + 8 * g); const LAS unsigned* cp = (const LAS unsigned*)(CQ + (TL) * 128 + 64 * (H) + 8 * g); \
                _Pragma("unroll") for (int i2 = 0; i2 < 4; ++i2) { const unsigned ee = ip[i2]; C[i2] = cp[i2]; \
                    W[2 * i2] = *(const GAS v4u*)(eb + ((ee & 0xffffu) * 2048u + lo)); W[2 * i2 + 1] = *(const GAS v4u*)(eb + ((ee >> 16) * 2048u + lo)); } } while (0)
#define P9C_D4(O, UA, UB, CC) do { O[0] = __builtin_amdgcn_sdot2(__builtin_bit_cast(s16x2, __builtin_amdgcn_perm(UB, UA, 0x0c040c00u)), __builtin_bit_cast(s16x2, CC), O[0], false); \
                O[1] = __builtin_amdgcn_sdot2(__builtin_bit_cast(s16x2, __builtin_amdgcn_perm(UB, UA, 0x0c050c01u)), __builtin_bit_cast(s16x2, CC), O[1], false); \
                O[2] = __builtin_amdgcn_sdot2(__builtin_bit_cast(s16x2, __builtin_amdgcn_perm(UB, UA, 0x0c060c02u)), __builtin_bit_cast(s16x2, CC), O[2], false); \
                O[3] = __builtin_amdgcn_sdot2(__builtin_bit_cast(s16x2, __builtin_amdgcn_perm(UB, UA, 0x0c070c03u)), __builtin_bit_cast(s16x2, CC), O[3], false); } while (0)
#define P9C_ACC(W, C) do { _Pragma("unroll") for (int i2 = 0; i2 < 4; ++i2) { const v4u ua = W[2 * i2], ub = W[2 * i2 + 1]; const unsigned cc = C[i2]; \
                P9C_D4((o + 0), ua.x, ub.x, cc); P9C_D4((o + 4), ua.y, ub.y, cc); P9C_D4((o + 8), ua.z, ub.z, cc); P9C_D4((o + 12), ua.w, ub.w, cc); } asm volatile("" ::: "memory"); } while (0)
            P9C_LOAD(wA, cA, F.wave * 8, 0);
#pragma unroll 1
            for (int j = 0; j < 8; ++j) {
                const int tl = F.wave * 8 + j, t = tb + tl;
                int o[16];
#pragma unroll
                for (int b = 0; b < 16; ++b) o[b] = 0;
                P9C_LOAD(wB, cB, tl, 1);
                P9C_ACC(wA, cA);
                if (j < 7) P9C_LOAD(wA, cA, tl + 1, 0);
                P9C_ACC(wB, cB);
                redi32<16>(o); redi16<8>(o); redi8<4>(o, lane);
                const int col = s * SLICE_B + cb; const int csq = CSQ[tl]; const float ct = CT[tl];
                GAS unsigned* xp = (GAS unsigned*)(F.X1B + (size_t)t * D + col);
                const unsigned xw = *xp;
                const float y0 = bflo(xw) + GF[col] * ((float)(o[0] - csq) * ct), y1 = bfhi(xw) + GF[col + 1] * ((float)(o[1] - csq) * ct);
                *xp = pk2(y0, y1);
            }
#undef P9C_LOAD
#undef P9C_ACC
#undef P9C_D4
        }
        __builtin_amdgcn_s_setprio(0);
#pragma unroll 1
        for (int j = 0; j < 8; ++j) {
            const int tl = F.wave * 8 + j, t = tb + tl;
            const GAS v2u* xrow = (const GAS v2u*)(F.X1B + (size_t)t * D) + lane; GAS f32x4* orow = (GAS f32x4*)(F.out + (size_t)t * D) + lane;
            v2u xw[8]; float sq = 0.f;
#pragma unroll
            for (int q = 0; q < 8; ++q) { xw[q] = xrow[64 * q]; const float a0 = bflo(xw[q].x), a1 = bfhi(xw[q].x), a2 = bflo(xw[q].y), a3 = bfhi(xw[q].y); sq += (a0 * a0 + a1 * a1) + (a2 * a2 + a3 * a3); }
            const float rstd2 = 1.0f / sqrtf(wave_sum(sq) * (1.0f / D) + EPS);
#pragma unroll
            for (int q = 0; q < 8; ++q) { const f32x4 f = *(const LAS f32x4*)(FG + 256 * q + 4 * lane);
                orow[64 * q] = (f32x4){bflo(xw[q].x) * rstd2 * f.x, bfhi(xw[q].x) * rstd2 * f.y, bflo(xw[q].y) * rstd2 * f.z, bfhi(xw[q].y) * rstd2 * f.w}; }
        }
        __syncthreads();
    }
}
struct Args { const float* in[21]; float* out; unsigned char* ws; int ph_lo, ph_hi, li, pad; };
constexpr int N_PHASES = 10;
__global__ void __launch_bounds__(NWAVES * 64, 2) mk_fwd(Args args) {
    extern __shared__ __attribute__((aligned(16))) unsigned char lds[];
    Frame F;
    F.lds = (LAS unsigned char*)lds;
    F.MISC = (volatile LAS unsigned*)(F.lds + MISC_OFF);
    F.tid = threadIdx.x; F.lane = F.tid & 63; F.wave = __builtin_amdgcn_readfirstlane(F.tid >> 6);
    F.G = gridDim.x; { const int bx = blockIdx.x; F.vcu = (F.G % 8 == 0) ? (bx % 8) * (F.G / 8) + bx / 8 : bx; }
    unsigned char* ws = args.ws;
    F.ctl = (gu32*)(ws + WS_CTL);
    F.x = args.in[0]; F.c = args.in[1]; F.ada_w = args.in[2]; F.ada_b = args.in[3]; F.norm_mix_g = args.in[4]; F.w_in = args.in[5]; F.b_gates = args.in[6];
    F.conv_w = args.in[7]; F.conv_b = args.in[8]; F.gmlp_norm_g = args.in[9]; F.gmlp_w = args.in[10]; F.gmlp_b = args.in[11]; F.mlstm_norm_g = args.in[12];
    F.w_out = args.in[13]; F.norm_ffn_g = args.in[14]; F.wq = args.in[15]; F.keys1 = args.in[16]; F.keys2 = args.in[17]; F.e_down = args.in[18]; F.e_up = args.in[19]; F.final_g = args.in[20];
    F.out = args.out;
    F.MODP = (float*)(ws + WS_MODP); F.MODF = (float*)(ws + WS_MODF); F.GATES = (float*)(ws + WS_GATES); F.SUMM = (float*)(ws + WS_SUMM); F.MTAB = (float*)(ws + WS_MTAB);
    F.NST = (float*)(ws + WS_NST); F.PG = (float*)(ws + WS_PG); F.IDX = (int*)(ws + WS_IDX);
    F.WIN = (bf16*)(ws + WS_WIN); F.WOUT = (bf16*)(ws + WS_WOUT); F.WQ = (bf16*)(ws + WS_WQ); F.HA = (bf16*)(ws + WS_HA); F.PROJ = (bf16*)(ws + WS_PROJ); F.QB = (bf16*)(ws + WS_PROJ);
    F.STATE = (bf16*)(ws + WS_STATE); F.VT = (bf16*)(ws + WS_VT); F.ED = ws + WS_ED; F.EU = ws + WS_EU; F.SD = (float*)(ws + WS_SD); F.SU = (float*)(ws + WS_SU);
    F.H1Q = ws + WS_STATE;
    F.SW = (float*)(ws + WS_SW); F.CMAXP = (float*)(ws + WS_CMAXP); F.SA = (float*)(ws + WS_SA);
    F.SSQP = (float*)(ws + WS_SSQP); F.BQP = (float*)(ws + WS_BQP); F.BIASQ = (float*)(ws + WS_BIASQ); F.X1B = (bf16*)(ws + WS_STATE);
    F.QC = (bf16*)args.out; F.KC = (bf16*)args.out + (size_t)M * 1024;
    for (int u = F.tid; u < (LDS_BYTES - LDSCTL_OFF) / 4; u += NWAVES * 64) ((LAS unsigned*)(F.lds + LDSCTL_OFF))[u] = 0u;
    __syncthreads();
    const int lo = args.ph_lo, hi = args.ph_hi;
    const bool multi = (hi - lo) > 1;
    XcdBarrier bar; bar.bar = (unsigned*)(F.ctl + CW_BAR) + args.li * XCD_BAR_WORDS; bar.x = 0; bar.st = nullptr;
    if (multi) bar = xcd_barrier_post((unsigned*)(F.ctl + CW_BAR) + args.li * XCD_BAR_WORDS, F.MISC + 8);
#ifndef PH_MASK
#define PH_MASK 0x7ff
#endif
#define IN(k) (((PH_MASK >> (k)) & 1) && lo <= (k) && (k) < hi)
#define SEAM(k) do { if (IN(k) && IN((k) + 1)) xcd_barrier(bar); } while (0)
    if (IN(0)) { p0a_phase(F); } SEAM(0);
    if (IN(1)) { p0b_phase(F); } SEAM(1);
    if (IN(2)) {
        { pg8::Gemm g{(const pg8::bf16_t*)F.H1Q, F.WIN, M, NPROJ, D / 2}; pg8::StaticOrder S; S.init(M, NPROJ, F.G, (int)blockIdx.x);
          pg8::EpiQ8 E{F.PROJ, NPROJ, 2048 / 256, F.SA, F.SW};
          pg8::gemm_phase<pg8::EpiQ8, pg8::StaticOrder, PG8_ALIGN, PG8_SP2, true>(F.lds, g, S, E); }
        {
          pg8::Gemm g{(const pg8::bf16_t*)((const unsigned char*)F.WIN + (size_t)WROW_VM * D), (const pg8::bf16_t*)F.H1Q, 1024, M, D / 2}; pg8::StaticOrder S; S.init(1024, M, F.G, (int)blockIdx.x);
          pg8::EpiQ8 E{F.VT, M, 0, F.SW + WROW_VM, F.SA};
          pg8::gemm_phase<pg8::EpiQ8, pg8::StaticOrder, PG8_ALIGN, PG8_SP2, true>(F.lds, g, S, E); }
    } SEAM(2);
    if (IN(3)) { p2_phase(F); } SEAM(3);
    if (IN(4)) { p3_phase(F); } SEAM(4);
    if (IN(5)) { p4_phase(F); } SEAM(5);
    if (IN(6)) {
        pg8::Gemm g{F.HA, F.WOUT, M, D, D}; pg8::StaticOrder S; S.init(M, D, F.G, (int)blockIdx.x);
        pg8::EpiResid2 E{F.x, F.MODF + MOD_GM, F.X1B, F.SSQP, D};
        pg8::gemm_phase<pg8::EpiResid2, pg8::StaticOrder, PG8_ALIGN, PG8_SP2>(F.lds, g, S, E);
    } SEAM(6);
    if (IN(7)) {
        pg8::Gemm g{F.X1B, F.WQ, M, D, D}; pg8::StaticOrder S; S.init(M, D, F.G, (int)blockIdx.x);
        LAS float* RSTDL = (LAS float*)(F.lds + RING_BYTES);
        { pg8::Unit u; for (int i = 0; S.next(i, u); ++i) { if (F.tid < 256) { const float* sp = F.SSQP + (size_t)(u.pm * 256 + F.tid) * 32; float ss = 0.f;
#pragma unroll
                    for (int q = 0; q < 8; ++q) { const f32x4 v = *(const GAS f32x4*)(sp + 4 * q); ss += (v.x + v.y) + (v.z + v.w); }
                    RSTDL[(u.pm & 1) * 256 + F.tid] = 1.0f / sqrtf(ss * (1.0f / D) + EPS); } } }
        __syncthreads();
        pg8::EpiQ E{F.QB, D, F.BIASQ, RSTDL};
        pg8::gemm_phase<pg8::EpiQ, pg8::StaticOrder, PG8_ALIGN, PG8_SP2>(F.lds, g, S, E);
    } SEAM(7);
#ifndef P8_ALT
#define P8_ALT 0
#endif
    if (IN(8)) { p8_phase(F); } SEAM(8);
#ifndef P9_V2
#define P9_V2 1
#endif
    if (IN(9)) { p9v2_phase(F); }
#undef IN
#undef SEAM
}

#ifndef MK_N_LAUNCHES
#define MK_N_LAUNCHES 1
#endif
extern "C" void kernel_launch(void* const* d_in, const int* in_sizes, int n_in, void* d_out, int out_size, void* d_ws, size_t ws_size, hipStream_t stream) {
    static int grid = 0;
    if (grid == 0) {
        if (n_in != 21 || in_sizes[0] != M * D || out_size != M * D || ws_size < WS_END) { fprintf(stderr, "kernel_launch: unexpected shapes (n_in %d, in0 %d, out %d, ws %zu); nothing launched\n", n_in, n_in > 0 ? in_sizes[0] : -1, out_size, ws_size); grid = -1; return; }
        int dev = 0, cus = 0, per_cu = 0;
        if (hipGetDevice(&dev) != hipSuccess || hipDeviceGetAttribute(&cus, hipDeviceAttributeMultiprocessorCount, dev) != hipSuccess) { grid = -1; return; }
        if (hipFuncSetAttribute((const void*)mk_fwd, hipFuncAttributeMaxDynamicSharedMemorySize, LDS_BYTES) != hipSuccess) { fprintf(stderr, "kernel_launch: hipFuncSetAttribute failed\n"); grid = -1; return; }
        if (hipOccupancyMaxActiveBlocksPerMultiprocessor(&per_cu, (const void*)mk_fwd, NWAVES * 64, LDS_BYTES) != hipSuccess || per_cu < 1) { fprintf(stderr, "kernel_launch: occupancy query says %d blocks per CU\n", per_cu); }
        (void)hipGetLastError();
        grid = cus;
    }
    if (grid < 0) return;
    (void)hipMemsetAsync((char*)d_ws + WS_CTL, 0, CTL_ZERO_BYTES, stream);
    Args a{};
    for (int i = 0; i < 21; ++i) a.in[i] = (const float*)d_in[i];
    a.out = (float*)d_out; a.ws = (unsigned char*)d_ws;
    if (MK_N_LAUNCHES == 1) { a.ph_lo = 0; a.ph_hi = N_PHASES; a.li = 0; hipLaunchKernelGGL(mk_fwd, dim3(grid), dim3(NWAVES * 64), LDS_BYTES, stream, a); }
    else for (int li = 0; li < N_PHASES; ++li) { a.ph_lo = li; a.ph_hi = li + 1; a.li = 0; hipLaunchKernelGGL(mk_fwd, dim3(grid), dim3(NWAVES * 64), LDS_BYTES, stream, a); }
}
```

```cpp
#include <hip/hip_runtime.h>
#include <cstdio>
#include <cstdint>
namespace pg8 {
#define PG8_LAS __attribute__((address_space(3)))
typedef unsigned short bf16_t;
typedef short bf16x8 __attribute__((ext_vector_type(8)));
typedef float f32x4 __attribute__((ext_vector_type(4)));
typedef unsigned u32x4 __attribute__((ext_vector_type(4)));
constexpr int BM = 256, BK = 64, HALF = 128, HTB = HALF * BK * 2  , STAGE_BYTES = 8 * HTB, NXCD = 8, WGM = 8;

__host__ __device__ __forceinline__ int lds_byte(int r, int c) { const int st = (r >> 4) * 2 + (c >> 5), rr = r & 15, cc = c & 31, ob = rr * 64 + cc * 2; return st * 1024 + (ob ^ (((ob >> 9) & 1) << 5)); }
__host__ __device__ __forceinline__ void stage_rc(int b, int& R, int& C) { const int st = b / 1024, sb = b % 1024, swz = sb ^ (((sb >> 9) & 1) << 5); R = (st >> 1) * 16 + swz / 64; C = (st & 1) * 32 + (swz % 64) / 2; }
__host__ __device__ __forceinline__ int perm32(int rho) { const int n = rho >> 4, i = rho & 15; return 8 * (i >> 2) + 4 * n + (i & 3); }

struct Unit { int pm, pn; };
struct Gemm { const bf16_t* A; const bf16_t* Bt; int M, N, K; };

struct StaticOrder {
    int nM, nN, nwg, G, c;
    __host__ __device__ void init(int M, int N, int G_, int c_) { nM = M / BM; nN = N / BM; nwg = nM * nN; G = G_; c = c_; }
    __host__ __device__ bool next(int i, Unit& u) const {
        const long L = (long)i * G + c; if (L >= nwg) return false;
        int wgid = (int)L; { const int q = nwg / NXCD, r = nwg % NXCD, xcd = wgid % NXCD, off = wgid / NXCD; wgid = (xcd < r ? xcd * (q + 1) : r * (q + 1) + (xcd - r) * q) + off; }
        const int nig = WGM * nN, gid = wgid / nig, fm = gid * WGM, gsz = (nM - fm) < WGM ? (nM - fm) : WGM;
        u.pm = fm + ((wgid % nig) % gsz); u.pn = (wgid % nig) / gsz; return true;
    }
    __device__ __forceinline__ void a_ready(const Unit&) const {}
    __device__ __forceinline__ void done(const Unit&) const {}
};

__device__ __forceinline__ unsigned cvt_pk_bf16(float lo, float hi) { unsigned r; asm volatile("v_cvt_pk_bf16_f32 %0, %1, %2" : "=v"(r) : "v"(lo), "v"(hi)); return r; }
typedef float f32x2 __attribute__((ext_vector_type(2)));
__device__ __forceinline__ f32x2 gelu_pk(f32x2 v) {
    const f32x2 av = __builtin_elementwise_abs(v), d = av * 0.2316418882f + 1.0f;
    f32x2 t; t.x = __builtin_amdgcn_rcpf(d.x); t.y = __builtin_amdgcn_rcpf(d.y);
    f32x2 q = t * 0.5307027145f + (-0.7265760135f); q = q * t + 0.7107068705f; q = q * t + (-0.142248368f); q = q * t + 0.127414796f; q = q * t;
    const f32x2 s = (v * v) * (-0.72134752044f);
    f32x2 e; e.x = __builtin_amdgcn_exp2f(s.x); e.y = __builtin_amdgcn_exp2f(s.y);
    const f32x2 m = v * (q * e), r = v - m;
    f32x2 o; o.x = v.x < 0.f ? m.x : r.x; o.y = v.y < 0.f ? m.y : r.y; return o;
}

template <int ACT  > struct EpiBf16 {
    static constexpr bool PERM = true, AFTER_DRAIN = false; static_assert(ACT == 0 || ACT == 1, "EpiBf16: ACT is 0 (none) or 1 (gelu_pk)");
    bf16_t* O; int ldc; const float* bias; int split_cols; size_t split_stride; float scale0;
    __device__ __forceinline__ void operator()(const f32x4 (&acc)[2][2][4][2], const Unit& u, int wr, int wc, int fr, int fq) const {
        const int row0 = u.pm * BM + wr * 64 + fr; int colt = u.pn * BM; bf16_t* base = O;
        float sc = 1.f; if (split_cols) { const int t = colt / split_cols; base += (size_t)t * split_stride; colt -= t * split_cols; if (t == 0) sc = scale0; }
        const int col0 = colt + wc * 32 + 8 * fq, bcol0 = u.pn * BM + wc * 32 + 8 * fq;
        f32x4 bv[2][2];
#pragma unroll
        for (int bj = 0; bj < 2; ++bj)
#pragma unroll
            for (int n = 0; n < 2; ++n) bv[bj][n] = bias ? *(const f32x4*)(bias + bcol0 + bj * HALF + 4 * n) : (f32x4){0.f, 0.f, 0.f, 0.f};
#pragma unroll
        for (int ai = 0; ai < 2; ++ai)
#pragma unroll
            for (int m = 0; m < 4; ++m) { bf16_t* rowp = base + (size_t)(row0 + ai * HALF + m * 16) * ldc + col0;
#pragma unroll
                for (int bj = 0; bj < 2; ++bj) { f32x4 v0 = acc[ai][bj][m][0] + bv[bj][0], v1 = acc[ai][bj][m][1] + bv[bj][1];
                    if (ACT == 1) { f32x2 a = gelu_pk((f32x2){v0[0], v0[1]}), b = gelu_pk((f32x2){v0[2], v0[3]}), c = gelu_pk((f32x2){v1[0], v1[1]}), d = gelu_pk((f32x2){v1[2], v1[3]});
                        v0 = (f32x4){a.x, a.y, b.x, b.y}; v1 = (f32x4){c.x, c.y, d.x, d.y}; }
                    v0 = v0 * sc; v1 = v1 * sc; u32x4 w; w.x = cvt_pk_bf16(v0[0], v0[1]); w.y = cvt_pk_bf16(v0[2], v0[3]); w.z = cvt_pk_bf16(v1[0], v1[1]); w.w = cvt_pk_bf16(v1[2], v1[3]);
                    *(u32x4*)(rowp + bj * HALF) = w; } }
    }
};

typedef int i32x4 __attribute__((ext_vector_type(4)));
template <bool I8> __device__ __forceinline__ f32x4 mma16(bf16x8 a, bf16x8 b, f32x4 c) {
    if constexpr (I8) return __builtin_bit_cast(f32x4, __builtin_amdgcn_mfma_i32_16x16x64_i8(__builtin_bit_cast(i32x4, a), __builtin_bit_cast(i32x4, b), __builtin_bit_cast(i32x4, c), 0, 0, 0));
    else return __builtin_amdgcn_mfma_f32_16x16x32_bf16(a, b, c, 0, 0, 0);
}
template <class Epi, class Sched, bool ALIGN_EPI = false, bool SP2 = false, bool I8 = false>
__device__ __forceinline__ void gemm_phase(PG8_LAS unsigned char* lds, const Gemm g, const Sched& S, const Epi& E) {
    const int tid = threadIdx.x, wid = __builtin_amdgcn_readfirstlane(tid >> 6), lane = tid & 63, wr = wid >> 2, wc = wid & 3, fr = lane & 15, fq = lane >> 4;
    const int K = g.K, nt = K / BK;
    unsigned voffA[2], voffB[2];
#pragma unroll
    for (int i = 0; i < 2; ++i) { int R, C; stage_rc(tid * 16 + i * 8192, R, C); const int Rb = Epi::PERM ? ((R & ~31) + perm32(R & 31)) : R;
        voffA[i] = (unsigned)(R * K + C) * 2u; voffB[i] = (unsigned)(Rb * K + C) * 2u; }
    const size_t kstep = (size_t)(BK * 2);
    const size_t hstep = (size_t)HALF * K * 2;
    const size_t tstep = 2 * hstep;
    const unsigned ldsw = (unsigned)wid * 1024u;
    const int aoff = lds_byte(wr * 64 + fr, fq * 8), boff = lds_byte(wc * 32 + fr, fq * 8);
#define PG8_SA(b, h) (((b) * 2 + (h)) * HTB)
#define PG8_SB(b, h) ((4 + (b) * 2 + (h)) * HTB)
#define PG8_STAGE(bufoff, gbase, voff) do { _Pragma("unroll") for (int _i = 0; _i < 2; ++_i) \
        __builtin_amdgcn_global_load_lds((const unsigned*)((const char*)(gbase) + (voff)[_i]), (PG8_LAS unsigned*)(lds + (bufoff) + ldsw + _i * 8192), 16, 0, 0); } while (0)
#define PG8_LDA(dst, b, h) do { _Pragma("unroll") for (int m = 0; m < 4; ++m) _Pragma("unroll") for (int k = 0; k < 2; ++k) dst[m][k] = *(const PG8_LAS bf16x8*)(lds + PG8_SA(b, h) + aoff + m * 2048 + k * 1024); } while (0)
#define PG8_LDB(dst, b, h) do { _Pragma("unroll") for (int n = 0; n < 2; ++n) _Pragma("unroll") for (int k = 0; k < 2; ++k) dst[n][k] = *(const PG8_LAS bf16x8*)(lds + PG8_SB(b, h) + boff + n * 2048 + k * 1024); } while (0)
#define PG8_MMA(ai, bj, At, Bt) do { __builtin_amdgcn_s_setprio(1); _Pragma("unroll") for (int m = 0; m < 4; ++m) _Pragma("unroll") for (int n = 0; n < 2; ++n) _Pragma("unroll") for (int k = 0; k < 2; ++k) \
        acc[ai][bj][m][n] = mma16<I8>(Bt[n][k], At[m][k], acc[ai][bj][m][n]); __builtin_amdgcn_s_setprio(0); } while (0)
#define PG8_WAIT_V(n) asm volatile("s_waitcnt vmcnt(" #n ")" ::: "memory")
#define PG8_WAIT_L(n) asm volatile("s_waitcnt lgkmcnt(" #n ")" ::: "memory")
#define PG8_BAR __builtin_amdgcn_s_barrier()
#define PG8_SCHED __builtin_amdgcn_sched_barrier(0)
    Unit cur, nxt; int ui = 0;
    if (!S.next(0, cur)) return;
    f32x4 acc[2][2][4][2];
#pragma unroll
    for (int a = 0; a < 2; ++a)
#pragma unroll
        for (int b = 0; b < 2; ++b)
#pragma unroll
            for (int m = 0; m < 4; ++m)
#pragma unroll
                for (int n = 0; n < 2; ++n) acc[a][b][m][n] = (f32x4){0.f, 0.f, 0.f, 0.f};
    bf16x8 At[4][2], B0[2][2], B1[2][2];
    const char* cA = (const char*)g.A + (size_t)cur.pm * tstep; const char* cB = (const char*)g.Bt + (size_t)cur.pn * tstep;
    S.a_ready(cur);
    if constexpr (SP2) {
        PG8_STAGE(PG8_SB(0, 0), cB, voffB); PG8_STAGE(PG8_SB(0, 1), cB + hstep, voffB); PG8_STAGE(PG8_SA(0, 0), cA, voffA); PG8_STAGE(PG8_SA(0, 1), cA + hstep, voffA);
        if (wr == 1) PG8_BAR;
        PG8_WAIT_V(2); PG8_BAR;
        PG8_STAGE(PG8_SB(1, 0), cB + kstep, voffB); PG8_STAGE(PG8_SA(1, 0), cA + kstep, voffA); PG8_STAGE(PG8_SB(1, 1), cB + hstep + kstep, voffB);
        PG8_WAIT_V(6); PG8_BAR;
    } else {
        PG8_STAGE(PG8_SB(0, 0), cB, voffB); PG8_STAGE(PG8_SA(0, 0), cA, voffA); PG8_STAGE(PG8_SB(0, 1), cB + hstep, voffB); PG8_STAGE(PG8_SA(0, 1), cA + hstep, voffA);
        if (wr == 1) PG8_BAR;
        PG8_WAIT_V(4); PG8_BAR;
        PG8_STAGE(PG8_SB(1, 0), cB + kstep, voffB); PG8_STAGE(PG8_SA(1, 0), cA + kstep, voffA); PG8_STAGE(PG8_SB(1, 1), cB + hstep + kstep, voffB);
        PG8_WAIT_V(6); PG8_BAR;
    }
    for (;;) {
        const bool has_next = S.next(ui + 1, nxt);
        const char* nA = has_next ? (const char*)g.A + (size_t)nxt.pm * tstep : cA; const char* nB = has_next ? (const char*)g.Bt + (size_t)nxt.pn * tstep : cB;
        for (int t = 0; t < nt; t += 2) {
            const bool last = (t == nt - 2);
            const char* a1 = cA + (size_t)(t + 1) * kstep;
            const char* a2 = last ? nA : cA + (size_t)(t + 2) * kstep; const char* b2 = last ? nB : cB + (size_t)(t + 2) * kstep;
            const char* a3 = a2 + kstep; const char* b3 = b2 + kstep;
            if (last && has_next) S.a_ready(nxt);
            if constexpr (SP2) {
            PG8_LDB(B0, 0, 0); PG8_LDB(B1, 0, 1); PG8_SCHED; PG8_LDA(At, 0, 0); PG8_STAGE(PG8_SA(1, 1), a1 + hstep, voffA);
            PG8_WAIT_V(8); PG8_WAIT_L(0); PG8_BAR; PG8_MMA(0, 0, At, B0); PG8_MMA(0, 1, At, B1); PG8_BAR; PG8_SCHED;
            PG8_LDA(At, 0, 1); PG8_STAGE(PG8_SB(0, 0), b2, voffB); PG8_STAGE(PG8_SB(0, 1), b2 + hstep, voffB); PG8_STAGE(PG8_SA(0, 0), a2, voffA);
            PG8_WAIT_V(8); PG8_WAIT_L(0); PG8_BAR; PG8_MMA(1, 0, At, B0); PG8_MMA(1, 1, At, B1); PG8_BAR; PG8_SCHED;
            PG8_LDB(B0, 1, 0); PG8_LDB(B1, 1, 1); PG8_SCHED; PG8_LDA(At, 1, 0); PG8_STAGE(PG8_SA(0, 1), a2 + hstep, voffA);
            PG8_WAIT_V(8); PG8_WAIT_L(0); PG8_BAR; PG8_MMA(0, 0, At, B0); PG8_MMA(0, 1, At, B1); PG8_BAR; PG8_SCHED;
            PG8_LDA(At, 1, 1); PG8_STAGE(PG8_SB(1, 0), b3, voffB); PG8_STAGE(PG8_SB(1, 1), b3 + hstep, voffB); PG8_STAGE(PG8_SA(1, 0), a3, voffA);
            PG8_WAIT_V(8); PG8_WAIT_L(0); PG8_BAR; PG8_MMA(1, 0, At, B0); PG8_MMA(1, 1, At, B1); PG8_BAR; PG8_SCHED;
            } else {
            PG8_LDB(B0, 0, 0); PG8_SCHED; PG8_LDA(At, 0, 0); PG8_STAGE(PG8_SA(1, 1), a1 + hstep, voffA);
            PG8_WAIT_L(8); PG8_BAR; PG8_WAIT_L(0); PG8_MMA(0, 0, At, B0); PG8_BAR; PG8_SCHED;
            PG8_LDB(B1, 0, 1); PG8_STAGE(PG8_SB(0, 0), b2, voffB);
            PG8_BAR; PG8_WAIT_L(0); PG8_MMA(0, 1, At, B1); PG8_BAR;
            PG8_LDA(At, 0, 1); PG8_STAGE(PG8_SA(0, 0), a2, voffA);
            PG8_BAR; PG8_WAIT_L(0); PG8_MMA(1, 0, At, B0); PG8_BAR; PG8_SCHED;
            PG8_STAGE(PG8_SB(0, 1), b2 + hstep, voffB);
            PG8_WAIT_V(6); PG8_BAR; PG8_MMA(1, 1, At, B1); PG8_BAR;
            PG8_LDB(B0, 1, 0); PG8_SCHED; PG8_LDA(At, 1, 0); PG8_STAGE(PG8_SA(0, 1), a2 + hstep, voffA);
            PG8_WAIT_L(8); PG8_BAR; PG8_WAIT_L(0); PG8_MMA(0, 0, At, B0); PG8_BAR; PG8_SCHED;
            PG8_LDB(B1, 1, 1); PG8_STAGE(PG8_SB(1, 0), b3, voffB);
            PG8_BAR; PG8_WAIT_L(0); PG8_MMA(0, 1, At, B1); PG8_BAR;
            PG8_LDA(At, 1, 1); PG8_STAGE(PG8_SA(1, 0), a3, voffA);
            PG8_BAR; PG8_WAIT_L(0); PG8_MMA(1, 0, At, B0); PG8_BAR; PG8_SCHED;
            PG8_STAGE(PG8_SB(1, 1), b3 + hstep, voffB);
            PG8_WAIT_V(6); PG8_BAR; PG8_MMA(1, 1, At, B1); PG8_BAR;
            }
        }
        if constexpr (ALIGN_EPI) { if (wr == 0) PG8_BAR; }
        if constexpr (!Epi::AFTER_DRAIN) { E(acc, cur, wr, wc, fr, fq); S.done(cur); }
        if (!has_next) break;
#pragma unroll
        for (int a = 0; a < 2; ++a)
#pragma unroll
            for (int b = 0; b < 2; ++b)
#pragma unroll
                for (int m = 0; m < 4; ++m)
#pragma unroll
                    for (int n = 0; n < 2; ++n) acc[a][b][m][n] = (f32x4){0.f, 0.f, 0.f, 0.f};
        cur = nxt; cA = nA; cB = nB; ++ui;
        if constexpr (ALIGN_EPI) { if (wr == 1) PG8_BAR; }
    }
    PG8_WAIT_V(0);
    if constexpr (!ALIGN_EPI) { if (wr == 0) PG8_BAR; }
    PG8_BAR;
    if constexpr (Epi::AFTER_DRAIN) { E.fused(acc, cur, wr, wc, fr, fq, lds, wid, lane); S.done(cur); }
#undef PG8_SA
#undef PG8_SB
#undef PG8_STAGE
#undef PG8_LDA
#undef PG8_LDB
#undef PG8_MMA
#undef PG8_WAIT_V
#undef PG8_WAIT_L
#undef PG8_BAR
#undef PG8_SCHED
}
}
namespace pg8 {
struct EpiProj {
    static constexpr bool PERM = true, AFTER_DRAIN = false;
    bf16_t* O; int ldc; int gelu_tiles;
    __device__ __forceinline__ void operator()(const f32x4 (&acc)[2][2][4][2], const Unit& u, int wr, int wc, int fr, int fq) const {
        const int row0 = u.pm * BM + wr * 64 + fr; const int col0 = u.pn * BM + wc * 32 + 8 * fq;
        const bool act = u.pn < gelu_tiles;
#pragma unroll
        for (int ai = 0; ai < 2; ++ai)
#pragma unroll
            for (int m = 0; m < 4; ++m) { bf16_t* rowp = O + (size_t)(row0 + ai * HALF + m * 16) * ldc + col0;
#pragma unroll
                for (int bj = 0; bj < 2; ++bj) { f32x4 v0 = acc[ai][bj][m][0], v1 = acc[ai][bj][m][1];
                    if (act) { f32x2 a = gelu_pk((f32x2){v0[0], v0[1]}), b = gelu_pk((f32x2){v0[2], v0[3]}), c = gelu_pk((f32x2){v1[0], v1[1]}), d = gelu_pk((f32x2){v1[2], v1[3]});
                        v0 = (f32x4){a.x, a.y, b.x, b.y}; v1 = (f32x4){c.x, c.y, d.x, d.y}; }
                    u32x4 w; w.x = cvt_pk_bf16(v0[0], v0[1]); w.y = cvt_pk_bf16(v0[2], v0[3]); w.z = cvt_pk_bf16(v1[0], v1[1]); w.w = cvt_pk_bf16(v1[2], v1[3]);
                    *(u32x4*)(rowp + bj * HALF) = w; } }
    }
};
struct EpiResid {
    static constexpr bool PERM = false, AFTER_DRAIN = false;
    const float* base; const float* gate; float* out; int ldc;
    __device__ __forceinline__ void operator()(const f32x4 (&acc)[2][2][4][2], const Unit& u, int wr, int wc, int fr, int fq) const {
        const int row0 = u.pm * BM + wr * 64 + fr, col0 = u.pn * BM + wc * 32 + 4 * fq;
        f32x4 gv[2][2];
#pragma unroll
        for (int bj = 0; bj < 2; ++bj)
#pragma unroll
            for (int n = 0; n < 2; ++n) gv[bj][n] = *(const f32x4*)(gate + col0 + bj * HALF + n * 16);
#pragma unroll
        for (int ai = 0; ai < 2; ++ai)
#pragma unroll
            for (int m = 0; m < 4; ++m) { const size_t off = (size_t)(row0 + ai * HALF + m * 16) * ldc + col0;
#pragma unroll
                for (int bj = 0; bj < 2; ++bj)
#pragma unroll
                    for (int n = 0; n < 2; ++n) { const f32x4 b = *(const f32x4*)(base + off + bj * HALF + n * 16); *(f32x4*)(out + off + bj * HALF + n * 16) = b + gv[bj][n] * acc[ai][bj][m][n]; } }
    }
};
struct EpiQ8 {
    static constexpr bool PERM = true, AFTER_DRAIN = false;
    bf16_t* O; int ldc; int gelu_tiles; const float* rs; const float* cs;
    __device__ __forceinline__ void operator()(const f32x4 (&acc)[2][2][4][2], const Unit& u, int wr, int wc, int fr, int fq) const {
        const int row0 = u.pm * BM + wr * 64 + fr; const int col0 = u.pn * BM + wc * 32 + 8 * fq;
        const bool act = u.pn < gelu_tiles;
        f32x4 cv[2][2];
#pragma unroll
        for (int bj = 0; bj < 2; ++bj)
#pragma unroll
            for (int n = 0; n < 2; ++n) cv[bj][n] = *(const f32x4*)(cs + col0 + bj * HALF + 4 * n);
#pragma unroll
        for (int ai = 0; ai < 2; ++ai)
#pragma unroll
            for (int m = 0; m < 4; ++m) { const int row = row0 + ai * HALF + m * 16; const float rsc = rs[row]; bf16_t* rowp = O + (size_t)row * ldc + col0;
#pragma unroll
                for (int bj = 0; bj < 2; ++bj) { const i32x4 a0 = __builtin_bit_cast(i32x4, acc[ai][bj][m][0]), a1 = __builtin_bit_cast(i32x4, acc[ai][bj][m][1]);
                    f32x4 v0 = (f32x4){(float)a0[0], (float)a0[1], (float)a0[2], (float)a0[3]} * rsc * cv[bj][0], v1 = (f32x4){(float)a1[0], (float)a1[1], (float)a1[2], (float)a1[3]} * rsc * cv[bj][1];
                    if (act) { f32x2 a = gelu_pk((f32x2){v0[0], v0[1]}), b = gelu_pk((f32x2){v0[2], v0[3]}), c = gelu_pk((f32x2){v1[0], v1[1]}), d = gelu_pk((f32x2){v1[2], v1[3]});
                        v0 = (f32x4){a.x, a.y, b.x, b.y}; v1 = (f32x4){c.x, c.y, d.x, d.y}; }
                    u32x4 w; w.x = cvt_pk_bf16(v0[0], v0[1]); w.y = cvt_pk_bf16(v0[2], v0[3]); w.z = cvt_pk_bf16(v1[0], v1[1]); w.w = cvt_pk_bf16(v1[2], v1[3]);
                    __builtin_nontemporal_store(w, (u32x4*)(rowp + bj * HALF)); } }
    }
};
struct EpiResid2 {
    static constexpr bool PERM = true, AFTER_DRAIN = false;
    const float* base; const float* gate; bf16_t* xb; float* ssq; int ldc;
    __device__ __forceinline__ void operator()(const f32x4 (&acc)[2][2][4][2], const Unit& u, int wr, int wc, int fr, int fq) const {
        const int row0 = u.pm * BM + wr * 64 + fr, col0 = u.pn * BM + wc * 32 + 8 * fq;
        f32x4 gv[2][2];
#pragma unroll
        for (int bj = 0; bj < 2; ++bj)
#pragma unroll
            for (int n = 0; n < 2; ++n) gv[bj][n] = *(const f32x4*)(gate + col0 + bj * HALF + 4 * n);
#pragma unroll
        for (int ai = 0; ai < 2; ++ai)
#pragma unroll
            for (int m = 0; m < 4; ++m) { const int row = row0 + ai * HALF + m * 16; const size_t off = (size_t)row * ldc + col0; float ss = 0.f;
#pragma unroll
                for (int bj = 0; bj < 2; ++bj) {
                    const f32x4 b0 = __builtin_nontemporal_load((const f32x4*)(base + off + bj * HALF)), b1 = __builtin_nontemporal_load((const f32x4*)(base + off + bj * HALF + 4));
                    const f32x4 v0 = b0 + gv[bj][0] * acc[ai][bj][m][0], v1 = b1 + gv[bj][1] * acc[ai][bj][m][1];
                    ss += (v0[0] * v0[0] + v0[1] * v0[1]) + (v0[2] * v0[2] + v0[3] * v0[3]) + (v1[0] * v1[0] + v1[1] * v1[1]) + (v1[2] * v1[2] + v1[3] * v1[3]);
                    u32x4 w; w.x = cvt_pk_bf16(v0[0], v0[1]); w.y = cvt_pk_bf16(v0[2], v0[3]); w.z = cvt_pk_bf16(v1[0], v1[1]); w.w = cvt_pk_bf16(v1[2], v1[3]);
                    *(u32x4*)(xb + off + bj * HALF) = w; }
                ss += __shfl_xor(ss, 16); ss += __shfl_xor(ss, 32);
                if (fq == 0) ssq[(size_t)row * 32 + u.pn * 4 + wc] = ss; }
    }
};
struct EpiQ {
    static constexpr bool PERM = true, AFTER_DRAIN = false;
    bf16_t* O; int ldc; const float* bias; const PG8_LAS float* rstd;
    __device__ __forceinline__ void operator()(const f32x4 (&acc)[2][2][4][2], const Unit& u, int wr, int wc, int fr, int fq) const {
        const int lrow0 = wr * 64 + fr, col0 = u.pn * BM + wc * 32 + 8 * fq;
        f32x4 bv[2][2];
#pragma unroll
        for (int bj = 0; bj < 2; ++bj)
#pragma unroll
            for (int n = 0; n < 2; ++n) bv[bj][n] = *(const f32x4*)(bias + col0 + bj * HALF + 4 * n);
#pragma unroll
        for (int ai = 0; ai < 2; ++ai)
#pragma unroll
            for (int m = 0; m < 4; ++m) { const int lrow = lrow0 + ai * HALF + m * 16; const float rs = rstd[(u.pm & 1) * BM + lrow];
                bf16_t* rowp = O + (size_t)(u.pm * BM + lrow) * ldc + col0;
#pragma unroll
                for (int bj = 0; bj < 2; ++bj) { const f32x4 v0 = acc[ai][bj][m][0] * rs + bv[bj][0], v1 = acc[ai][bj][m][1] * rs + bv[bj][1];
                    u32x4 w; w.x = cvt_pk_bf16(v0[0], v0[1]); w.y = cvt_pk_bf16(v0[2], v0[3]); w.z = cvt_pk_bf16(v1[0], v1[1]); w.w = cvt_pk_bf16(v1[2], v1[3]);
                    *(u32x4*)(rowp + bj * HALF) = w; } }
    }
};
}
#ifndef PG8_SP2
#define PG8_SP2 true
#endif
#ifndef PG8_ALIGN
#define PG8_ALIGN true
#endif
constexpr int NWAVES = 8;
constexpr int M = 16384, D = 2048;
constexpr int IN_COLS = 6152, NWIN = 6144, NPROJ = 5120;
constexpr int C_UG = 0, C_VG = 1024, C_Q = 2048, C_K = 3072, C_OM = 4096;
constexpr int WROW_VM = 5120;
constexpr int NHEAD = 4, DH = 256, CH = 128, NCHUNK = M / CH;
constexpr int NEXP = 16384, PH = 8, TOPK = 16, NSEL = PH * TOPK;
constexpr float EPS = 1e-6f;
constexpr int MOD_SHM = 0, MOD_SCM = 2048, MOD_GM = 4096, MOD_SHF = 6144, MOD_SCF = 8192, MOD_GF = 10240, NMOD = 12288;
constexpr int ADA_KC = 16, ADA_KROWS = D / ADA_KC;

constexpr size_t MiB = 1u << 20;
constexpr size_t WS_CTL = 0, CTL_ZERO_BYTES = 1 * MiB;
constexpr size_t WS_MODP = 1 * MiB;
constexpr size_t WS_MODF = WS_MODP + (size_t)ADA_KC * NMOD * 4;
constexpr size_t WS_GATES = 2 * MiB;
constexpr size_t WS_SUMM = 2 * MiB + 512 * 1024;
constexpr size_t WS_MTAB = WS_SUMM + 8192;
constexpr size_t WS_NST = 3 * MiB;
constexpr size_t WS_WIN = 4 * MiB;
constexpr size_t WS_WOUT = 28 * MiB;
constexpr size_t WS_WQ = 36 * MiB;
constexpr size_t WS_IDX = 44 * MiB;
constexpr size_t WS_PG = 52 * MiB;
constexpr size_t WS_SSQP = 60 * MiB;
constexpr size_t WS_BQP = 62 * MiB, WS_BIASQ = 62 * MiB + 512 * 1024;
constexpr size_t WS_SW = 62 * MiB + 768 * 1024;
constexpr size_t WS_CMAXP = 63 * MiB;
constexpr size_t WS_SA = 3 * MiB + 512 * 1024 + 131072;
constexpr size_t WS_HA = 64 * MiB;
constexpr size_t WS_PROJ = 128 * MiB;
constexpr size_t WS_VT = 288 * MiB;
constexpr size_t WS_X1 = 192 * MiB;
constexpr size_t WS_STATE = 320 * MiB;
constexpr size_t WS_ED = 384 * MiB, WS_EU = 416 * MiB;
constexpr size_t WS_SD = 3 * MiB + 512 * 1024, WS_SU = WS_SD + 65536;
constexpr size_t WS_END = 512 * MiB;
constexpr int CW_TMO = 0, CW_CODE = 1, CW_BAR = 4096;

constexpr int RING_BYTES = 131072, LDSCTL_OFF = 163328, MISC_OFF = LDSCTL_OFF + 320, LDS_BYTES = 163840;

#define GAS __attribute__((address_space(1)))
#define LAS __attribute__((address_space(3)))
#define DI __device__ __forceinline__
typedef unsigned short bf16;
typedef unsigned v4u __attribute__((ext_vector_type(4)));
typedef unsigned v2u __attribute__((ext_vector_type(2)));
typedef float f32x4 __attribute__((ext_vector_type(4)));
typedef float f32x16 __attribute__((ext_vector_type(16)));
typedef short bf16x8 __attribute__((ext_vector_type(8)));
typedef GAS unsigned gu32;
#define RLX_AGENT __ATOMIC_RELAXED, __HIP_MEMORY_SCOPE_AGENT
#define LDS_WAIT() asm volatile("s_waitcnt lgkmcnt(0)" ::: "memory")
#define VM_WAIT() asm volatile("s_waitcnt vmcnt(0)" ::: "memory")
#define MFMA32(a, b, c) __builtin_amdgcn_mfma_f32_32x32x16_bf16((a), (b), (c), 0, 0, 0)
DI unsigned f2bf(float f) { unsigned u = __builtin_bit_cast(unsigned, f); return (u + 0x7fffu + ((u >> 16) & 1u)) >> 16; }
DI unsigned pk2(float lo, float hi) { return f2bf(lo) | (f2bf(hi) << 16); }
DI float bflo(unsigned w) { return __builtin_bit_cast(float, w << 16); }
DI float bfhi(unsigned w) { return __builtin_bit_cast(float, w & 0xffff0000u); }
DI float bf2f(unsigned short h) { return __builtin_bit_cast(float, (unsigned)h << 16); }
DI int crow(int reg, int h) { return (reg & 3) + 8 * (reg >> 2) + 4 * h; }
DI float wave_sum(float v) {
#pragma unroll
    for (int o = 1; o < 64; o <<= 1) v += __shfl_xor(v, o);
    return v;
}
DI float wave_max(float v) {
#pragma unroll
    for (int o = 1; o < 64; o <<= 1) v = fmaxf(v, __shfl_xor(v, o));
    return v;
}
DI float silu_f(float v) { return v / (1.0f + __expf(-v)); }
DI float sigmoid_f(float v) { return 1.0f / (1.0f + __expf(-v)); }
DI float gelu_f(float v) { return 0.5f * v * (1.0f + erff(v * 0.70710678118654752f)); }
typedef __bf16 bf16v2 __attribute__((ext_vector_type(2)));
#define DOT2(a, b, c) __builtin_amdgcn_fdot2_f32_bf16(__builtin_bit_cast(bf16v2, (unsigned)(a)), __builtin_bit_cast(bf16v2, (unsigned)(b)), (c), false)
DI f32x16 zero16() { f32x16 z; for (int i = 0; i < 16; ++i) z[i] = 0.f; return z; }
#define XB_TMO      128
#define XB_XCNT(j)  (256  + 64 * (j))
#define XB_XSUB(j)  (1280 + 64 * (j))
#define XB_XGEN(j)  (2304 + 64 * (j))
#define XB_TOP      3328
#define XB_TOPGEN   3392
#define XCD_BAR_WORDS 3456
#define XB_SPIN_CAP (1u << 18)

__device__ __forceinline__ unsigned xb_ld(unsigned* p)              { return __hip_atomic_load(p, __ATOMIC_RELAXED, __HIP_MEMORY_SCOPE_AGENT); }
__device__ __forceinline__ unsigned xb_add(unsigned* p, unsigned v) { return __hip_atomic_fetch_add(p, v, __ATOMIC_RELAXED, __HIP_MEMORY_SCOPE_AGENT); }
__device__ __forceinline__ unsigned xb_xcc_id() { return (unsigned)__builtin_amdgcn_s_getreg((3 << 11) | 20) & 0xFu; }
#define XB_SPIN(cond, bar) do { unsigned _sp = 0; while (cond) { __builtin_amdgcn_s_sleep(1); \
    if ((++_sp & 255u) == 0u) { if (xb_ld(&(bar)[XB_TMO])) break; if (_sp > XB_SPIN_CAP) { atomicAdd(&(bar)[XB_TMO], 1u); break; } } } } while (0)

struct XcdBarrier {
    unsigned* bar; unsigned x;
    volatile LAS unsigned* st;
};

__device__ __forceinline__ XcdBarrier xcd_barrier_post(unsigned* bar, volatile LAS unsigned* st) {
    XcdBarrier b; b.bar = bar; b.x = xb_xcc_id(); b.st = st;
    if (threadIdx.x == 0) (void)xb_add(&bar[XB_XCNT(b.x)], 1u);
    return b;
}
__device__ __forceinline__ void xcd_barrier_complete(unsigned* bar, unsigned x, unsigned& nloc, unsigned& nx) {
    const unsigned G = gridDim.x * gridDim.y * gridDim.z;
    unsigned sum, cnt, mine, sp = 0u;
    for (;;) {
        sum = 0u; cnt = 0u; mine = 0u;
#pragma unroll
        for (unsigned j = 0; j < 16; ++j) { const unsigned c = xb_ld(&bar[XB_XCNT(j)]); sum += c; cnt += (c > 0u) ? 1u : 0u; mine = (j == x) ? c : mine; }
        if (sum == G) break;
        __builtin_amdgcn_s_sleep(1);
        if ((++sp & 255u) == 0u) { if (xb_ld(&bar[XB_TMO])) break; if (sp > XB_SPIN_CAP) { atomicAdd(&bar[XB_TMO], 1u); break; } }
    }
    nloc = mine > 0u ? mine : 1u; nx = cnt > 0u ? cnt : 1u;
}

__device__ __forceinline__ void xcd_barrier(const XcdBarrier& b) {
    asm volatile("s_waitcnt vmcnt(0)" ::: "memory");
    __syncthreads();
    if (threadIdx.x == 0) {
        unsigned* bar = b.bar;
        __builtin_amdgcn_s_waitcnt(0);
        unsigned nloc = b.st[0], nx = b.st[1];
        if (nloc == 0u) { xcd_barrier_complete(bar, b.x, nloc, nx); b.st[0] = nloc; b.st[1] = nx; }
        const unsigned old = xb_add(&bar[XB_XSUB(b.x)], 1u);
        const unsigned gen = old / nloc;
        if (old + 1u == (gen + 1u) * nloc) {
            __builtin_amdgcn_fence(__ATOMIC_RELEASE, "agent");
            asm volatile("s_waitcnt vmcnt(0)" ::: "memory");
            const unsigned og = xb_add(&bar[XB_TOP], 1u);
            const unsigned tg = og / nx;
            if (og + 1u == (tg + 1u) * nx) xb_add(&bar[XB_TOPGEN], 1u);
            else XB_SPIN(xb_ld(&bar[XB_TOPGEN]) == tg, bar);
            __builtin_amdgcn_fence(__ATOMIC_ACQUIRE, "agent");
            xb_add(&bar[XB_XGEN(b.x)], 1u);
            asm volatile("s_waitcnt vmcnt(0)" ::: "memory");
        } else {
            XB_SPIN(xb_ld(&bar[XB_XGEN(b.x)]) == gen, bar);
            __builtin_amdgcn_fence(__ATOMIC_ACQUIRE, "agent");
            asm volatile("s_waitcnt vmcnt(0)" ::: "memory");
        }
    }
    __syncthreads();
}
struct Frame {
    LAS unsigned char* lds;
    volatile LAS unsigned* MISC;
    gu32* ctl;
    int tid, lane, wave, vcu, G;
    const float *x, *c, *ada_w, *ada_b, *norm_mix_g, *w_in, *b_gates, *conv_w, *conv_b, *gmlp_norm_g, *gmlp_w, *gmlp_b, *mlstm_norm_g, *w_out, *norm_ffn_g,
                *wq, *keys1, *keys2, *e_down, *e_up, *final_g;
    float* out;
    float *MODP, *MODF, *GATES, *SUMM, *MTAB, *NST, *PG;
    int* IDX;
    bf16 *WIN, *WOUT, *WQ, *HA, *PROJ, *QB, *STATE, *QC, *KC, *VT;
    unsigned char *ED, *EU, *H1Q; float *SD, *SU;
    float *SSQP, *BQP, *BIASQ, *SW, *CMAXP, *SA; bf16* X1B;
};

DI void p0_transpose_item(const float* W, int K, int ldw, int nblk, bf16* WT, LAS float* scr, int item, int lane, bool vm_last = false) {
    const int kb = item / nblk, nb = item % nblk, k0 = 64 * kb, n0 = 32 * nb;
    const int d0 = !vm_last ? n0 : (n0 < 4096 ? n0 : (n0 < 5120 ? n0 + 1024 : n0 - 1024));
#pragma unroll 8
    for (int i = 0; i < 32; ++i) { const int kk = 2 * i + (lane >> 5); scr[kk * 33 + (lane & 31)] = __builtin_nontemporal_load(W + (size_t)(k0 + kk) * ldw + n0 + (lane & 31)); }
    LDS_WAIT(); asm volatile("" ::: "memory");
    const int c = lane & 7;
#pragma unroll
    for (int j = 0; j < 4; ++j) { const int n = (lane >> 3) + 8 * j; const LAS float* s = scr + (8 * c) * 33 + n;
        v4u o; o.x = pk2(s[0 * 33], s[1 * 33]); o.y = pk2(s[2 * 33], s[3 * 33]); o.z = pk2(s[4 * 33], s[5 * 33]); o.w = pk2(s[6 * 33], s[7 * 33]);
        *(GAS v4u*)(WT + (size_t)(d0 + n) * K + k0 + 8 * c) = o; }
    LDS_WAIT(); asm volatile("" ::: "memory");
}
DI void p0_colmax_item(Frame& F, int item) {
    const int lane = F.lane, nblk = NWIN / 32, kb = item / nblk, nb = item % nblk, k0 = 64 * kb, n0 = 32 * nb;
    float m = 0.f;
#pragma unroll 8
    for (int i = 0; i < 32; ++i) { const int kk = 2 * i + (lane >> 5); m = fmaxf(m, fabsf(__builtin_nontemporal_load(F.w_in + (size_t)(k0 + kk) * IN_COLS + n0 + (lane & 31)))); }
    m = fmaxf(m, __shfl_xor(m, 32));
    if (lane < 32) F.CMAXP[(size_t)kb * NWIN + n0 + lane] = m;
}
DI void p0_ada_item(Frame& F, LAS float* scr, int item) {
    const int cc = item % (NMOD / 256), kc = item / (NMOD / 256), k0 = kc * ADA_KROWS, col = cc * 256 + F.lane * 4;
#pragma unroll
    for (int j = 0; j < ADA_KROWS / 64; ++j) scr[F.lane + 64 * j] = silu_f(F.c[k0 + F.lane + 64 * j]);
    LDS_WAIT(); asm volatile("" ::: "memory");
    f32x4 acc = {0.f, 0.f, 0.f, 0.f};
    const float* wp = F.ada_w + (size_t)k0 * NMOD + col;
#pragma unroll 8
    for (int kk = 0; kk < ADA_KROWS; ++kk) { const float s = scr[kk]; const f32x4 w = __builtin_nontemporal_load((const GAS f32x4*)(wp + (size_t)kk * NMOD)); acc += w * s; }
    *(GAS f32x4*)(F.MODP + (size_t)kc * NMOD + col) = acc;
    LDS_WAIT(); asm volatile("" ::: "memory");
}
DI void p0a_phase(Frame& F) {
    LAS float* scr = (LAS float*)(F.lds + F.wave * 16384);
    const int gw = F.wave * F.G + F.vcu, NGW = F.G * NWAVES;
    constexpr int I_ADA = (NMOD / 256) * ADA_KC;
    constexpr int I_WIN = (D / 64) * (NWIN / 32), I_WO = (D / 64) * (D / 32);
    constexpr int NITEMS = I_ADA + I_WIN + I_WO;
    for (int it = gw; it < NITEMS; it += NGW) {
        int r = it;
        if (r < I_ADA) { p0_ada_item(F, scr, r); continue; } r -= I_ADA;
        if (r < I_WIN) { p0_colmax_item(F, r); continue; } r -= I_WIN;
        p0_transpose_item(F.w_out, D, D, D / 32, F.WOUT, scr, r, F.lane);
    }
#pragma unroll 1
    for (int row = gw; row < 2 * NEXP; row += NGW) {
        const int tb = row >= NEXP, e = row - tb * NEXP;
        const GAS f32x4* src = (const GAS f32x4*)((tb ? F.e_up : F.e_down) + (size_t)e * D) + F.lane;
        f32x4 v[8]; float am = 0.f;
#pragma unroll
        for (int j = 0; j < 8; ++j) { v[j] = __builtin_nontemporal_load(src + 64 * j); am = fmaxf(am, fmaxf(fmaxf(fabsf(v[j].x), fabsf(v[j].y)), fmaxf(fabsf(v[j].z), fabsf(v[j].w)))); }
        am = fmaxf(wave_max(am), 1e-30f);
        const float sc = am * (1.0f / 127.0f), inv = 127.0f / am;
        GAS unsigned* dst = (GAS unsigned*)((tb ? F.EU : F.ED) + (size_t)e * D) + F.lane;
        const int off = tb ? 128 : 0;
#pragma unroll
        for (int j = 0; j < 8; ++j) {
            const int q0 = (int)__builtin_rintf(v[j].x * inv) + off, q1 = (int)__builtin_rintf(v[j].y * inv) + off, q2 = (int)__builtin_rintf(v[j].z * inv) + off, q3 = (int)__builtin_rintf(v[j].w * inv) + off;
            __builtin_nontemporal_store((unsigned)(q0 & 255) | ((unsigned)(q1 & 255) << 8) | ((unsigned)(q2 & 255) << 16) | ((unsigned)(q3 & 255) << 24), dst + 64 * j);
        }
        if (F.lane == 0) (tb ? F.SU : F.SD)[e] = sc;
    }
}
DI float mod_final(Frame& F, int col) { float s = F.ada_b[col];
#pragma unroll
    for (int k = 0; k < ADA_KC; ++k) s += F.MODP[(size_t)k * NMOD + col];
    return s; }
DI void norm_tables(Frame& F, const float* g, int col_scale, int col_shift) {
    LAS float* A1 = (LAS float*)(F.lds); LAS float* B1 = (LAS float*)(F.lds + 8192);
#pragma unroll
    for (int i = 0; i < 4; ++i) { const int c = F.tid + 512 * i; A1[c] = g[c] * (1.0f + F.MODF[col_scale + c]); B1[c] = F.MODF[col_shift + c]; }
}
DI void p0_wq_item(Frame& F, LAS float* scr, int item) {
    const int lane = F.lane, nblk = D / 32, kb = item / nblk, nb = item % nblk, k0 = 64 * kb, n0 = 32 * nb;
    LAS float* gsl = scr + 64 * 33; LAS float* shl = gsl + 64;
    gsl[lane] = F.norm_ffn_g[k0 + lane] * (1.0f + mod_final(F, MOD_SCF + k0 + lane)); shl[lane] = mod_final(F, MOD_SHF + k0 + lane);
    LDS_WAIT(); asm volatile("" ::: "memory");
    float bp = 0.f;
#pragma unroll 8
    for (int i = 0; i < 32; ++i) { const int kk = 2 * i + (lane >> 5); const float w = __builtin_nontemporal_load(F.wq + (size_t)(k0 + kk) * D + n0 + (lane & 31)); scr[kk * 33 + (lane & 31)] = w * gsl[kk]; bp += w * shl[kk]; }
    bp += __shfl_xor(bp, 32);
    if (lane < 32) F.BQP[(size_t)kb * D + n0 + lane] = bp;
    LDS_WAIT(); asm volatile("" ::: "memory");
    const int c = lane & 7;
#pragma unroll
    for (int j = 0; j < 4; ++j) { const int n = (lane >> 3) + 8 * j; const LAS float* sp = scr + (8 * c) * 33 + n;
        v4u o; o.x = pk2(sp[0 * 33], sp[1 * 33]); o.y = pk2(sp[2 * 33], sp[3 * 33]); o.z = pk2(sp[4 * 33], sp[5 * 33]); o.w = pk2(sp[6 * 33], sp[7 * 33]);
        *(GAS v4u*)(F.WQ + (size_t)(n0 + n) * D + k0 + 8 * c) = o; }
    LDS_WAIT(); asm volatile("" ::: "memory");
}
DI void p0_winq_item(Frame& F, LAS float* scr, int item) {
    const int lane = F.lane, nblk = NWIN / 32, kb = item / nblk, nb = item % nblk, k0 = 64 * kb, n0 = 32 * nb;
    const int d0 = n0 < 4096 ? n0 : (n0 < 5120 ? n0 + 1024 : n0 - 1024);
    LAS float* inv = scr + 64 * 33;
    if (lane < 32) { float m = 0.f;
#pragma unroll 8
        for (int q = 0; q < D / 64; ++q) m = fmaxf(m, F.CMAXP[(size_t)q * NWIN + n0 + lane]);
        m = fmaxf(m, 1e-30f); inv[lane] = 127.0f / m; if (kb == 0) F.SW[d0 + lane] = m * (1.0f / 127.0f); }
#pragma unroll 8
    for (int i = 0; i < 32; ++i) { const int kk = 2 * i + (lane >> 5); scr[kk * 33 + (lane & 31)] = __builtin_nontemporal_load(F.w_in + (size_t)(k0 + kk) * IN_COLS + n0 + (lane & 31)); }
    LDS_WAIT(); asm volatile("" ::: "memory");
    unsigned char* WQ = (unsigned char*)F.WIN;
#pragma unroll
    for (int i = 0; i < 2; ++i) { const int q = lane + 64 * i, n = q >> 2, c = q & 3; const float iv = inv[n]; const LAS float* sp = scr + (16 * c) * 33 + n; v4u o;
#pragma unroll
        for (int w = 0; w < 4; ++w) { const int q0 = (int)__builtin_rintf(sp[(4 * w) * 33] * iv), q1 = (int)__builtin_rintf(sp[(4 * w + 1) * 33] * iv), q2 = (int)__builtin_rintf(sp[(4 * w + 2) * 33] * iv), q3 = (int)__builtin_rintf(sp[(4 * w + 3) * 33] * iv);
            o[w] = (unsigned)(q0 & 255) | ((unsigned)(q1 & 255) << 8) | ((unsigned)(q2 & 255) << 16) | ((unsigned)(q3 & 255) << 24); }
        *(GAS v4u*)(WQ + (size_t)(d0 + n) * D + k0 + 16 * c) = o; }
    LDS_WAIT(); asm volatile("" ::: "memory");
}
DI void p0b_phase(Frame& F) {
    LAS float* A1 = (LAS float*)(F.lds); LAS float* B1 = (LAS float*)(F.lds + 8192); LAS float* WG = (LAS float*)(F.lds + 16384);
#pragma unroll
    for (int i = 0; i < 4; ++i) { const int c = F.tid + 512 * i; A1[c] = F.norm_mix_g[c] * (1.0f + mod_final(F, MOD_SCM + c)); B1[c] = mod_final(F, MOD_SHM + c); }
    { const int per = (NMOD + F.G - 1) / F.G; const int c = (int)blockIdx.x * per + F.tid; if (F.tid < per && c < NMOD) F.MODF[c] = mod_final(F, c); }
#pragma unroll
    for (int i = 0; i < 4; ++i) { const int k = F.tid + 512 * i; const f32x4 a = *(const GAS f32x4*)(F.w_in + (size_t)k * IN_COLS + NWIN), b = *(const GAS f32x4*)(F.w_in + (size_t)k * IN_COLS + NWIN + 4);
        WG[0 * 2048 + k] = a.x; WG[1 * 2048 + k] = a.y; WG[2 * 2048 + k] = a.z; WG[3 * 2048 + k] = a.w; WG[4 * 2048 + k] = b.x; WG[5 * 2048 + k] = b.y; WG[6 * 2048 + k] = b.z; WG[7 * 2048 + k] = b.w; }
    __syncthreads();
    const int gw = F.vcu * NWAVES + F.wave, NGW = F.G * NWAVES;
    f32x4 vn[8];
    { const GAS f32x4* xr = (const GAS f32x4*)(F.x + (size_t)gw * D) + F.lane;
#pragma unroll
      for (int j = 0; j < 8; ++j) vn[j] = __builtin_nontemporal_load(xr + 64 * j); }
#pragma unroll 1
    for (int row = gw; row < M; row += NGW) {
        f32x4 v[8]; float ss = 0.f;
#pragma unroll
        for (int j = 0; j < 8; ++j) { v[j] = vn[j]; ss += (v[j].x * v[j].x + v[j].y * v[j].y) + (v[j].z * v[j].z + v[j].w * v[j].w); }
        if (row + NGW < M) { const GAS f32x4* xr = (const GAS f32x4*)(F.x + (size_t)(row + NGW) * D) + F.lane;
#pragma unroll
            for (int j = 0; j < 8; ++j) vn[j] = __builtin_nontemporal_load(xr + 64 * j); }
        const float rstd = 1.0f / sqrtf(wave_sum(ss) * (1.0f / D) + EPS);
        float gd[8];
#pragma unroll
        for (int g = 0; g < 8; ++g) gd[g] = 0.f;
        LAS v2u* o8 = (LAS v2u*)(F.lds + 81920 + F.wave * 4096) + F.lane; float am = 0.f;
#pragma unroll
        for (int j = 0; j < 8; ++j) {
            const f32x4 a = *(const LAS f32x4*)(A1 + 256 * j + 4 * F.lane), b = *(const LAS f32x4*)(B1 + 256 * j + 4 * F.lane);
            const f32x4 h = v[j] * rstd * a + b;
            v2u o; o.x = pk2(h.x, h.y); o.y = pk2(h.z, h.w); o8[64 * j] = o; am = fmaxf(am, fmaxf(fmaxf(fabsf(h.x), fabsf(h.y)), fmaxf(fabsf(h.z), fabsf(h.w))));
#pragma unroll
            for (int g = 0; g < 8; ++g) { const f32x4 w = *(const LAS f32x4*)(WG + g * 2048 + 256 * j + 4 * F.lane); gd[g] += (h.x * w.x + h.y * w.y) + (h.z * w.z + h.w * w.w); }
            asm volatile("" ::: "memory");
        }
#pragma unroll
        for (int g = 0; g < 8; ++g) gd[g] = wave_sum(gd[g]);
        if (F.lane == 0) {
#pragma unroll
            for (int g = 0; g < 8; ++g) { float p = gd[g] + F.b_gates[g];
                if (g >= 4) { p = fminf(p, 0.f) - log1pf(__expf(-fabsf(p))); }
                F.GATES[(size_t)row * 8 + g] = p; }
        }
            {
            am = fmaxf(wave_max(am), 1e-30f); const float qinv = 127.0f / am;
            LDS_WAIT(); asm volatile("" ::: "memory");
            GAS unsigned* qr = (GAS unsigned*)(F.H1Q + (size_t)row * D) + F.lane;
#pragma unroll
            for (int j = 0; j < 8; ++j) { const v2u w = o8[64 * j];
                const int q0 = (int)__builtin_rintf(bflo(w.x) * qinv), q1 = (int)__builtin_rintf(bfhi(w.x) * qinv), q2 = (int)__builtin_rintf(bflo(w.y) * qinv), q3 = (int)__builtin_rintf(bfhi(w.y) * qinv);
                qr[64 * j] = (unsigned)(q0 & 255) | ((unsigned)(q1 & 255) << 8) | ((unsigned)(q2 & 255) << 16) | ((unsigned)(q3 & 255) << 24); }
            if (F.lane == 0) F.SA[row] = am * (1.0f / 127.0f);
            LDS_WAIT(); asm volatile("" ::: "memory");
        }
    }
    __syncthreads();
    {
        LAS float* scr = (LAS float*)(F.lds + F.wave * 8960);
        for (int it = F.wave * F.G + F.vcu; it < (D / 64) * (D / 32); it += NGW) p0_wq_item(F, scr, it);
        for (int it = F.wave * F.G + F.vcu; it < (D / 64) * (NWIN / 32); it += NGW) p0_winq_item(F, scr, it);
    }
}
constexpr int IMG_PITCH = 576, M1_WL = 73728, M1_RED = 74240, M1_OB = 90624;
typedef short s16x4 __attribute__((ext_vector_type(4)));
DI bf16x8 tr_frag(const LAS unsigned char* p, int off_lo, int off_hi) {
    const s16x4 lo = __builtin_amdgcn_ds_read_tr16_b64_v4i16((LAS s16x4*)(p + off_lo));
    const s16x4 hi = __builtin_amdgcn_ds_read_tr16_b64_v4i16((LAS s16x4*)(p + off_hi));
    return __builtin_shufflevector(lo, hi, 0, 1, 2, 3, 4, 5, 6, 7);
}
DI float bfel(const v4u& w, int e) { const unsigned d = w[e >> 1]; return (e & 1) ? bfhi(d) : bflo(d); }
DI void m1_item(Frame& F, int hh, int kc) {
    LAS unsigned char* IMG = F.lds; LAS float* WL = (LAS float*)(F.lds + M1_WL); LAS float* RED = (LAS float*)(F.lds + M1_RED);
    const int t0 = kc * CH, lane = F.lane, tid = F.tid;
    if (F.wave == 0) {
        const float* gp = F.GATES + (size_t)(t0 + 2 * lane) * 8;
        const float i0 = gp[hh], lf0 = gp[4 + hh], i1 = gp[8 + hh], lf1 = gp[12 + hh];
        const float p = lf0 + lf1; float inc = p;
#pragma unroll
        for (int o = 1; o < 64; o <<= 1) { const float t = __shfl_up(inc, o); if (lane >= o) inc += t; }
        const float A = __shfl(inc, 63), ex = inc - p, b0 = ex + lf0, b1 = ex + p;
        const float lw0 = A - b0 + i0, lw1 = A - b1 + i1;
        const float B = wave_max(fmaxf(lw0, lw1));
        WL[2 * lane] = __expf(lw0 - B); WL[2 * lane + 1] = __expf(lw1 - B);
        if (lane == 0) { F.SUMM[(hh * NCHUNK + kc) * 2] = A; F.SUMM[(hh * NCHUNK + kc) * 2 + 1] = B; }
    }
    __syncthreads();
    const int dg = tid & 31, sg = tid >> 5;
#pragma unroll 1
    for (int which = 0; which < 2; ++which) {
        const int chb = (which == 0 ? 1024 : 0) + hh * DH + dg * 8;
        const int colb = (which == 0 ? C_K : C_Q) + hh * DH + dg * 8;
        v4u raw[11];
#pragma unroll
        for (int rr = 0; rr < 11; ++rr) { const int tt = t0 + sg * 8 - 3 + rr; raw[rr] = (v4u){0u, 0u, 0u, 0u}; if (tt >= 0) raw[rr] = *(const GAS v4u*)(F.PROJ + (size_t)tt * NPROJ + colb); }
        float wl[8];
#pragma unroll
        for (int i = 0; i < 8; ++i) wl[i] = (which == 0) ? WL[sg * 8 + i] : 0.0625f;
        v4u o1[8], o2[8];
#pragma unroll
        for (int dw = 0; dw < 4; ++dw) {
            typedef float f32x2 __attribute__((ext_vector_type(2)));
            f32x2 cw[4];
#pragma unroll
            for (int j = 0; j < 4; ++j) cw[j] = *(const GAS f32x2*)(F.conv_w + j * 2048 + chb + 2 * dw);
            const f32x2 cb = *(const GAS f32x2*)(F.conv_b + chb + 2 * dw);
            float xl[11], xh[11];
#pragma unroll
            for (int rr = 0; rr < 11; ++rr) { xl[rr] = bflo(raw[rr][dw]); xh[rr] = bfhi(raw[rr][dw]); }
            float d0 = 0.f, d1 = 0.f;
#pragma unroll
            for (int i = 0; i < 8; ++i) {
                float a0 = cb.x, a1 = cb.y;
#pragma unroll
                for (int j = 0; j < 4; ++j) { a0 += cw[j].x * xl[i + j]; a1 += cw[j].y * xh[i + j]; }
                a0 = silu_f(a0); a1 = silu_f(a1);
                if (which == 0) { o1[i][dw] = pk2(a0, a1); a0 *= wl[i]; a1 *= wl[i]; d0 += a0; d1 += a1; o2[i][dw] = pk2(a0, a1); }
                else { o1[i][dw] = pk2(a0 * wl[i], a1 * wl[i]); }
            }
            if (which == 0) { RED[sg * 256 + dg * 8 + 2 * dw] = d0; RED[sg * 256 + dg * 8 + 2 * dw + 1] = d1; }
            asm volatile("" ::: "memory");
        }
#pragma unroll
        for (int i = 0; i < 8; ++i) { const int s = sg * 8 + i, t = t0 + s;
            if (which == 0) { *(GAS v4u*)(F.KC + (size_t)t * 1024 + hh * DH + dg * 8) = o1[i]; *(LAS v4u*)(IMG + s * IMG_PITCH + dg * 16) = o2[i]; }
            else { *(GAS v4u*)(F.QC + (size_t)t * 1024 + hh * DH + dg * 8) = o1[i]; } }
    }
    __syncthreads();
    if (tid < 256) { float s = 0.f;
#pragma unroll
        for (int i = 0; i < 16; ++i) s += RED[i * 256 + tid];
        F.NST[(size_t)(hh * NCHUNK + kc) * DH + tid] = s; }
    const int r = lane & 31, h = lane >> 5, e0 = F.wave * 32;
    bf16x8 bf[8];
#pragma unroll
    for (int ks = 0; ks < 8; ++ks) {
        bf[ks] = *(const GAS bf16x8*)(F.VT + (size_t)(hh * DH + e0 + r) * M + t0 + ks * 16 + 8 * h);
    }
    const LAS unsigned char* trb = IMG + (8 * h + ((lane & 15) >> 2)) * IMG_PITCH + (16 * ((lane >> 4) & 1) + 4 * (lane & 3)) * 2;
    LAS unsigned char* OB = F.lds + M1_OB + F.wave * (32 * 144);
#pragma unroll 1
    for (int dp = 0; dp < 4; ++dp) {
#pragma unroll
        for (int d2 = 0; d2 < 2; ++d2) {
            const int dt = 2 * dp + d2;
            f32x16 acc = zero16();
#pragma unroll
            for (int ks = 0; ks < 8; ++ks) { const bf16x8 af = tr_frag(trb + dt * 64, ks * 16 * IMG_PITCH, ks * 16 * IMG_PITCH + 4 * IMG_PITCH); acc = MFMA32(af, bf[ks], acc); }
#pragma unroll
            for (int g = 0; g < 4; ++g) { v2u o; o.x = pk2(acc[4 * g], acc[4 * g + 1]); o.y = pk2(acc[4 * g + 2], acc[4 * g + 3]);
                *(LAS v2u*)(OB + r * 144 + (d2 * 32 + 8 * g + 4 * h) * 2) = o; }
        }
        LDS_WAIT(); asm volatile("" ::: "memory");
#pragma unroll
        for (int i = 0; i < 4; ++i) { const int q = lane + 64 * i, row = q >> 3, c16 = q & 7;
            *(GAS v4u*)(F.STATE + (size_t)(hh * NCHUNK + kc) * (DH * DH) + (size_t)(e0 + row) * DH + dp * 64 + c16 * 8) = *(const LAS v4u*)(OB + row * 144 + c16 * 16); }
        LDS_WAIT(); asm volatile("" ::: "memory");
    }
    __syncthreads();
}
constexpr int G_WI = 0, G_VI = 34816, G_UI = 75776, G_WP = 272, G_VP = 320, G_UP = 272;
DI void gmlp_block(Frame& F, int g, int n0, int nch) {
    LAS unsigned char* WI = F.lds + G_WI; LAS unsigned char* VI = F.lds + G_VI; LAS unsigned char* UI = F.lds + G_UI;
    const int c0 = g * 128, lane = F.lane, tid = F.tid;
    {
#pragma unroll
        for (int i = 0; i < 8; ++i) { const int p = tid + 512 * i, t = p >> 5, s4 = (p & 31) * 4;
            const f32x4 w = *(const GAS f32x4*)(F.gmlp_w + (size_t)(g * 128 + t) * 128 + s4);
            v2u o; o.x = pk2(s4 <= t ? w.x : 0.f, s4 + 1 <= t ? w.y : 0.f); o.y = pk2(s4 + 2 <= t ? w.z : 0.f, s4 + 3 <= t ? w.w : 0.f);
            *(LAS v2u*)(WI + t * G_WP + s4 * 2) = o; }
    }
    v4u tv[4], tu[4];
#define G_LOAD(N) do { _Pragma("unroll") for (int i = 0; i < 4; ++i) { const int p = tid + 512 * i; const bf16* rowp = F.PROJ + (size_t)((N) * CH + (p >> 4)) * NPROJ + c0 + (p & 15) * 8; \
        tv[i] = __builtin_nontemporal_load((const GAS v4u*)(rowp + C_VG)); tu[i] = __builtin_nontemporal_load((const GAS v4u*)(rowp + C_UG)); } } while (0)
    G_LOAD(n0);
    const int r = lane & 31, h = lane >> 5, ct = F.wave & 3, tp = F.wave >> 2;
    float ng[16];
#pragma unroll
    for (int reg = 0; reg < 16; ++reg) ng[reg] = F.gmlp_norm_g[g * 128 + ct * 32 + crow(reg, h)];
    const LAS unsigned char* trb = VI + (8 * h + ((lane & 15) >> 2)) * G_VP + (ct * 32 + 16 * ((lane >> 4) & 1) + 4 * (lane & 3)) * 2;
#pragma unroll 1
    for (int ci = 0; ci < nch; ++ci) {
        const int n = n0 + ci, t0 = n * CH;
#pragma unroll
        for (int i = 0; i < 4; ++i) { const int p = tid + 512 * i, row = p >> 4, c16 = p & 15; const v4u w = tv[i];
            float a[8] = {bflo(w.x), bfhi(w.x), bflo(w.y), bfhi(w.y), bflo(w.z), bfhi(w.z), bflo(w.w), bfhi(w.w)};
            float ss = (a[0] * a[0] + a[1] * a[1]) + (a[2] * a[2] + a[3] * a[3]) + (a[4] * a[4] + a[5] * a[5]) + (a[6] * a[6] + a[7] * a[7]);
            ss += __shfl_xor(ss, 1); ss += __shfl_xor(ss, 2); ss += __shfl_xor(ss, 4); ss += __shfl_xor(ss, 8);
            const float rs = 1.0f / sqrtf(ss * (1.0f / 128.0f) + EPS);
            v4u o; o.x = pk2(a[0] * rs, a[1] * rs); o.y = pk2(a[2] * rs, a[3] * rs); o.z = pk2(a[4] * rs, a[5] * rs); o.w = pk2(a[6] * rs, a[7] * rs);
            *(LAS v4u*)(VI + row * G_VP + c16 * 16) = o; *(LAS v4u*)(UI + row * G_UP + c16 * 16) = tu[i]; }
        __syncthreads();
        if (ci + 1 < nch) G_LOAD(n + 1);
#pragma unroll 1
        for (int ti = 0; ti < 2; ++ti) {
            const int tt = (ti == 0) ? tp : 3 - tp;
            const int t = tt * 32 + r;
            const LAS unsigned char* wrow = WI + t * G_WP + 16 * h;
            f32x16 acc = zero16();
#pragma unroll
            for (int ks = 0; ks < 8; ++ks) if (ks <= 2 * tt + 1) {
                const bf16x8 af = tr_frag(trb, ks * 16 * G_VP, ks * 16 * G_VP + 4 * G_VP);
                const bf16x8 bw = *(const LAS bf16x8*)(wrow + 32 * ks);
                acc = MFMA32(af, bw, acc);
            }
            const float bsp = F.gmlp_b[g * 128 + t];
            LAS unsigned char* urow = UI + t * G_UP + (ct * 32 + 4 * h) * 2;
#pragma unroll
            for (int gq = 0; gq < 4; ++gq) { LAS v2u* up = (LAS v2u*)(urow + 16 * gq);
                const v2u uw = *up;
                const float y0 = bflo(uw.x) * (ng[4 * gq] * acc[4 * gq] + bsp), y1 = bfhi(uw.x) * (ng[4 * gq + 1] * acc[4 * gq + 1] + bsp);
                const float y2 = bflo(uw.y) * (ng[4 * gq + 2] * acc[4 * gq + 2] + bsp), y3 = bfhi(uw.y) * (ng[4 * gq + 3] * acc[4 * gq + 3] + bsp);
                v2u o; o.x = pk2(y0, y1); o.y = pk2(y2, y3); *up = o; }
        }
        __syncthreads();
#pragma unroll
        for (int i = 0; i < 4; ++i) { const int p = tid + 512 * i, row = p >> 4, c16 = p & 15;
            *(GAS v4u*)(F.HA + (size_t)(t0 + row) * D + c0 + c16 * 8) = *(const LAS v4u*)(UI + row * G_UP + c16 * 16); }
        __syncthreads();
    }
#undef G_LOAD
}
DI void p2_phase(Frame& F) {
    constexpr int N_M1 = NHEAD * NCHUNK;
#pragma unroll 1
    for (int it = (int)blockIdx.x; it < N_M1; it += F.G) m1_item(F, it / NCHUNK, it % NCHUNK);
    { const int per = (8 * (M / CH) + F.G - 1) / F.G;
      const int first = (int)blockIdx.x * per;
      if (first < 8 * (M / CH)) { const int g = first / (M / CH), n0 = first % (M / CH); int nch = per; if (n0 + nch > M / CH) nch = M / CH - n0; gmlp_block(F, g, n0, nch); } }
}
DI void p3_phase(Frame& F) {
    LAS float* TAB = (LAS float*)F.lds;
    const int lane = F.lane;
    if (F.wave < NHEAD) {
        const int hh = F.wave; const float* sp = F.SUMM + (size_t)(hh * NCHUNK + 2 * lane) * 2;
        const float A0 = sp[0], B0 = sp[1], A1 = sp[2], B1 = sp[3];
        float ca = A0 + A1, cb = fmaxf(B0 + A1, B1);
        const float pa = ca, pb = cb;
#pragma unroll
        for (int o = 1; o < 64; o <<= 1) { const float ta = __shfl_up(ca, o), tb = __shfl_up(cb, o); if (lane >= o) { cb = fmaxf(tb + ca, cb); ca = ta + ca; } }
        (void)pa; (void)pb;
        float ea = __shfl_up(ca, 1), eb = __shfl_up(cb, 1);
        float m0 = (lane == 0) ? 0.f : fmaxf(ea, eb);
        const float m1 = fmaxf(m0 + A0, B0), m2 = fmaxf(m1 + A1, B1);
        TAB[(hh * NCHUNK + 2 * lane) * 2] = __expf(A0 + m0 - m1); TAB[(hh * NCHUNK + 2 * lane) * 2 + 1] = __expf(B0 - m1);
        TAB[(hh * NCHUNK + 2 * lane + 1) * 2] = __expf(A1 + m1 - m2); TAB[(hh * NCHUNK + 2 * lane + 1) * 2 + 1] = __expf(B1 - m2);
        if (blockIdx.x == 0) { F.MTAB[hh * NCHUNK + 2 * lane] = m0; F.MTAB[hh * NCHUNK + 2 * lane + 1] = m1; }
    }
    __syncthreads();
    const int NT = F.G * NWAVES * 64, gt = (int)blockIdx.x * (NWAVES * 64) + F.tid;
    if (gt < D) { float b = 0.f;
#pragma unroll 8
        for (int k = 0; k < D / 64; ++k) b += F.BQP[(size_t)k * D + gt];
        F.BIASQ[gt] = b; }
    for (int p = gt; p < NHEAD * (DH * DH / 2); p += NT) {
        const int hh = p / (DH * DH / 2), q = p % (DH * DH / 2);
        GAS unsigned* sp = (GAS unsigned*)(F.STATE + (size_t)hh * NCHUNK * (DH * DH)) + q;
        float s0 = 0.f, s1 = 0.f;
#pragma unroll 1
        for (int k0 = 0; k0 < NCHUNK; k0 += 16) {
            unsigned ld[16];
#pragma unroll
            for (int k = 0; k < 16; ++k) ld[k] = sp[(size_t)(k0 + k) * (DH * DH / 2)];
#pragma unroll
            for (int k = 0; k < 16; ++k) {
                sp[(size_t)(k0 + k) * (DH * DH / 2)] = pk2(s0, s1);
                const float dec = TAB[(hh * NCHUNK + k0 + k) * 2], wb = TAB[(hh * NCHUNK + k0 + k) * 2 + 1];
                s0 = dec * s0 + wb * bflo(ld[k]); s1 = dec * s1 + wb * bfhi(ld[k]);
            }
        }
    }
    for (int p = gt; p < NHEAD * DH; p += NT) {
        const int hh = p / DH, d = p % DH; float* np = F.NST + (size_t)hh * NCHUNK * DH + d; float s = 0.f;
#pragma unroll 8
        for (int k = 0; k < NCHUNK; ++k) { const float ld = np[(size_t)k * DH]; np[(size_t)k * DH] = s; s = TAB[(hh * NCHUNK + k) * 2] * s + TAB[(hh * NCHUNK + k) * 2 + 1] * ld; }
    }
}
constexpr int M3_QI = 8192, M3_R2 = 75776, M3_QP = 528, M3_CP = 272, M3_VP = 264;
static_assert(M3_R2 + 256 * M3_CP <= LDSCTL_OFF, "P4 LDS map");
DI void m3_item(Frame& F, int hh, int kc) {
    LAS float* GS = (LAS float*)F.lds; LAS float* MX = GS + 128; LAS float* BT = GS + 256; LAS float* NK = GS + 384; LAS float* XCH = GS + 640;
    LAS unsigned char* QI = F.lds + M3_QI; LAS unsigned char* R2 = F.lds + M3_R2;
    int tid = F.tid; asm volatile("" : "+v"(tid));
    const int t0 = kc * CH, lane = F.lane, item = hh * NCHUNK + kc;
    const float mk = F.MTAB[item];
    const bf16* cbase = F.STATE + (size_t)item * (DH * DH);
    const bf16* kbase = F.KC + (size_t)t0 * 1024 + hh * DH;
    const bf16* qbase = F.QC + (size_t)t0 * 1024 + hh * DH;
    const bf16* vbase = F.VT + (size_t)(hh * DH) * M + t0;
    {
        v4u tk[8], tq[8];
#pragma unroll
        for (int i = 0; i < 8; ++i) { const int p = tid + 512 * i; tk[i] = __builtin_nontemporal_load((const GAS v4u*)(kbase + (size_t)(p >> 5) * 1024 + (p & 31) * 8)); tq[i] = __builtin_nontemporal_load((const GAS v4u*)(qbase + (size_t)(p >> 5) * 1024 + (p & 31) * 8)); }
        if (F.wave == 0) {
            const float* gp = F.GATES + (size_t)(t0 + 2 * lane) * 8;
            const float i0 = gp[hh], lf0 = gp[4 + hh], i1 = gp[8 + hh], lf1 = gp[12 + hh];
            const float p = lf0 + lf1; float inc = p;
#pragma unroll
            for (int o = 1; o < 64; o <<= 1) { const float t = __shfl_up(inc, o); if (lane >= o) inc += t; }
            const float ex = inc - p, b0 = ex + lf0, b1 = ex + p;
            const float g0 = i0 - b0, g1 = i1 - b1;
            float cm = fmaxf(g0, g1);
#pragma unroll
            for (int o = 1; o < 64; o <<= 1) { const float t = __shfl_up(cm, o); if (lane >= o) cm = fmaxf(cm, t); }
            float pm = __shfl_up(cm, 1); if (lane == 0) pm = -INFINITY;
            const float M0 = fmaxf(mk, fmaxf(pm, g0)), M1 = fmaxf(M0, g1);
            GS[2 * lane] = g0; GS[2 * lane + 1] = g1; MX[2 * lane] = M0; MX[2 * lane + 1] = M1; BT[2 * lane] = b0; BT[2 * lane + 1] = b1;
        }
        if (tid < 256) NK[tid] = F.NST[(size_t)item * DH + tid];
#pragma unroll
        for (int i = 0; i < 8; ++i) { const int p = tid + 512 * i; *(LAS v4u*)(R2 + (p >> 5) * M3_QP + (p & 31) * 16) = tk[i]; *(LAS v4u*)(QI + (p >> 5) * M3_QP + (p & 31) * 16) = tq[i]; }
    }
    __syncthreads();
    const int r = lane & 31, h = lane >> 5, tt = F.wave & 3, eh = F.wave >> 2;
    const int tl = tt * 32 + r, t = t0 + tl;
    const float Mt = MX[tl], winter = __expf(mk - Mt);
    const LAS unsigned char* qrow = QI + tl * M3_QP + 16 * h;
    const LAS float* GSh = GS + 4 * h; int tlo = tl - 4 * h; asm volatile("" : "+v"(tlo));
    bf16x8 xs[4][2]; float den = 0.f;
#pragma unroll
    for (int st = 0; st < 4; ++st) {
        if (st <= tt) {
            f32x16 accS = zero16();
            const LAS unsigned char* krow = R2 + (st * 32 + r) * M3_QP + 16 * h;
#pragma unroll 4
            for (int ks = 0; ks < 16; ++ks) { const bf16x8 kf = *(const LAS bf16x8*)(krow + 32 * ks); const bf16x8 qf = *(const LAS bf16x8*)(qrow + 32 * ks); accS = MFMA32(kf, qf, accS); }
            float xv[16];
#pragma unroll
            for (int reg = 0; reg < 16; ++reg) { const int sc = st * 32 + (reg & 3) + 8 * (reg >> 2); float v = accS[reg] * __expf(GSh[sc] - Mt); if (sc > tlo) v = 0.f; xv[reg] = v; den += v; }
#pragma unroll
            for (int k2 = 0; k2 < 2; ++k2) { v4u xw; xw.x = pk2(xv[8 * k2], xv[8 * k2 + 1]); xw.y = pk2(xv[8 * k2 + 2], xv[8 * k2 + 3]); xw.z = pk2(xv[8 * k2 + 4], xv[8 * k2 + 5]); xw.w = pk2(xv[8 * k2 + 6], xv[8 * k2 + 7]);
                xs[st][k2] = __builtin_bit_cast(bf16x8, xw); }
        } else { xs[st][0] = (bf16x8){0, 0, 0, 0, 0, 0, 0, 0}; xs[st][1] = xs[st][0]; }
        asm volatile("" ::: "memory");
    }
    f32x16 accH[4];
#pragma unroll
    for (int i = 0; i < 4; ++i) accH[i] = zero16();
    float qn = 0.f;
#pragma unroll 1
    for (int hf = 0; hf < 2; ++hf) {
        v4u tc[8];
#pragma unroll
        for (int i = 0; i < 8; ++i) { const int p = tid + 512 * i; tc[i] = __builtin_nontemporal_load((const GAS v4u*)(cbase + (size_t)(p >> 4) * DH + hf * 128 + (p & 15) * 8)); }
        __syncthreads();
#pragma unroll
        for (int i = 0; i < 8; ++i) { const int p = tid + 512 * i; *(LAS v4u*)(R2 + (p >> 4) * M3_CP + (p & 15) * 16) = tc[i]; }
        __syncthreads();
        const LAS unsigned char* crow0 = R2 + (eh * 128 + r) * M3_CP + 16 * h;
#pragma unroll 2
        for (int ks = 0; ks < 8; ++ks) {
            const int kg = hf * 8 + ks;
            const v4u qw = *(const LAS v4u*)(qrow + 32 * kg);
            float qv[8] = {bflo(qw.x), bfhi(qw.x), bflo(qw.y), bfhi(qw.y), bflo(qw.z), bfhi(qw.z), bflo(qw.w), bfhi(qw.w)};
            const f32x4 na = *(const LAS f32x4*)(NK + kg * 16 + 8 * h), nb = *(const LAS f32x4*)(NK + kg * 16 + 8 * h + 4);
            qn += (qv[0] * na.x + qv[1] * na.y) + (qv[2] * na.z + qv[3] * na.w) + (qv[4] * nb.x + qv[5] * nb.y) + (qv[6] * nb.z + qv[7] * nb.w);
            v4u q2; q2.x = pk2(qv[0] * winter, qv[1] * winter); q2.y = pk2(qv[2] * winter, qv[3] * winter); q2.z = pk2(qv[4] * winter, qv[5] * winter); q2.w = pk2(qv[6] * winter, qv[7] * winter);
            const bf16x8 q2f = __builtin_bit_cast(bf16x8, q2);
#pragma unroll
            for (int et = 0; et < 4; ++et) { const bf16x8 cf = *(const LAS bf16x8*)(crow0 + et * 32 * M3_CP + 32 * ks); accH[et] = MFMA32(cf, q2f, accH[et]); }
        }
    }
    qn += __shfl_xor(qn, 32);
    {
        v4u tv[8];
#pragma unroll
        for (int i = 0; i < 8; ++i) { const int p = tid + 512 * i; tv[i] = __builtin_nontemporal_load((const GAS v4u*)(vbase + (size_t)(p >> 4) * M + (p & 15) * 8)); }
        __syncthreads();
#pragma unroll
        for (int i = 0; i < 8; ++i) { const int p = tid + 512 * i; LAS unsigned char* d = R2 + (p >> 4) * M3_VP + (p & 15) * 16;
            *(LAS v2u*)d = (v2u){tv[i].x, tv[i].y}; *(LAS v2u*)(d + 8) = (v2u){tv[i].z, tv[i].w}; }
    }
    __syncthreads();
    const LAS unsigned char* vrow0 = R2 + (eh * 128 + r) * M3_VP + 8 * h;
#pragma unroll
    for (int st = 0; st < 4; ++st) if (st <= tt) {
#pragma unroll
        for (int k2 = 0; k2 < 2; ++k2)
#pragma unroll
            for (int et = 0; et < 4; ++et) {
                const LAS unsigned char* vp = vrow0 + et * 32 * M3_VP + (st * 32 + 16 * k2) * 2;
                const v2u lo = *(const LAS v2u*)vp, hi = *(const LAS v2u*)(vp + 16);
                v4u vw; vw.x = lo.x; vw.y = lo.y; vw.z = hi.x; vw.w = hi.y;
                accH[et] = MFMA32(__builtin_bit_cast(bf16x8, vw), xs[st][k2], accH[et]);
                asm volatile("" ::: "memory");
            }
    }
    v4u to[8];
    { const bf16* obase = F.PROJ + (size_t)t0 * NPROJ + C_OM + hh * DH;
#pragma unroll
      for (int i = 0; i < 8; ++i) { const int p = tid + 512 * i; to[i] = __builtin_nontemporal_load((const GAS v4u*)(obase + (size_t)(p >> 5) * NPROJ + (p & 31) * 8)); } }
    den += __shfl_xor(den, 32);
    den += winter * qn;
    const float dnm = fmaxf(fabsf(den), __expf(-(BT[tl] + Mt))), inv = 1.0f / dnm;
    float ss = 0.f;
#pragma unroll
    for (int et = 0; et < 4; ++et)
#pragma unroll
        for (int reg = 0; reg < 16; ++reg) { accH[et][reg] *= inv; ss += accH[et][reg] * accH[et][reg]; }
    ss += __shfl_xor(ss, 32);
    if (h == 0) XCH[eh * 128 + tl] = ss;
#pragma unroll
    for (int i = 0; i < 8; ++i) { const int p = tid + 512 * i; *(LAS v4u*)(QI + (p >> 5) * M3_QP + (p & 31) * 16) = to[i]; }
    __syncthreads();
    const float rstd = 1.0f / sqrtf((XCH[tl] + XCH[128 + tl]) * (1.0f / DH) + EPS);
    LAS unsigned char* orow = QI + tl * M3_QP + (eh * 128 + 4 * h) * 2;
    const float* ngp = F.mlstm_norm_g + hh * DH + eh * 128;
#pragma unroll
    for (int et = 0; et < 4; ++et)
#pragma unroll
        for (int gq = 0; gq < 4; ++gq) { const int el = et * 32 + 8 * gq + 4 * h; LAS v2u* op = (LAS v2u*)(orow + (et * 32 + 8 * gq) * 2);
            const v2u ow = *op; const f32x4 gn = *(const GAS f32x4*)(ngp + el);
            const float y0 = accH[et][4 * gq] * rstd * gn.x * sigmoid_f(bflo(ow.x)), y1 = accH[et][4 * gq + 1] * rstd * gn.y * sigmoid_f(bfhi(ow.x));
            const float y2 = accH[et][4 * gq + 2] * rstd * gn.z * sigmoid_f(bflo(ow.y)), y3 = accH[et][4 * gq + 3] * rstd * gn.w * sigmoid_f(bfhi(ow.y));
            v2u o; o.x = pk2(y0, y1); o.y = pk2(y2, y3); *op = o; }
    __syncthreads();
#pragma unroll
    for (int i = 0; i < 8; ++i) { const int p = tid + 512 * i, row = p >> 5, c16 = p & 31;
        *(GAS v4u*)(F.HA + (size_t)(t0 + row) * D + 1024 + hh * DH + c16 * 8) = *(const LAS v4u*)(QI + row * M3_QP + c16 * 16); }
    __syncthreads();
}
DI void p4_phase(Frame& F) {
    for (int it = (int)blockIdx.x; it < NHEAD * NCHUNK; it += F.G) m3_item(F, it / NCHUNK, it % NCHUNK);
}
constexpr int KPITCH = 272, P8_TBL = 69632;
DI void topk_insert(float (&L)[16], float x) {
#pragma unroll
    for (int i = 15; i >= 1; --i) L[i] = __builtin_amdgcn_fmed3f(x, L[i - 1], L[i]);
    L[0] = fmaxf(L[0], x);
}
DI void p8_phase(Frame& F) {
    LAS unsigned char* KIMG = F.lds; LAS unsigned char* TBL = F.lds + P8_TBL + F.wave * 1024;
    const int lane = F.lane, tid = F.tid, r = lane & 31, h = lane >> 5;
#pragma unroll 4
    for (int i = 0; i < 16; ++i) { const int idx = tid * 4 + 2048 * i, side = idx >> 14, rem = idx & 16383, row = rem >> 7, col = rem & 127;
        const f32x4 a = *(const GAS f32x4*)((side ? F.keys2 : F.keys1) + rem);
        v2u o; o.x = pk2(a.x, a.y); o.y = pk2(a.z, a.w); *(LAS v2u*)(KIMG + (side * 128 + row) * KPITCH + col * 2) = o; }
    __syncthreads();
    for (int it = (int)blockIdx.x; it < (M / 256) * PH; it += F.G) {
        const int tile = it / PH, hd = it % PH;
        const int t = tile * 256 + F.wave * 32 + r;
        float L1[16], L2[16];
#pragma unroll 1
        for (int side = 0; side < 2; ++side) {
            f32x16 acc[4];
#pragma unroll
            for (int kt = 0; kt < 4; ++kt) acc[kt] = zero16();
            const bf16* qp = F.QB + (size_t)t * D + hd * 256 + side * 128 + 8 * h;
#pragma unroll
            for (int ks = 0; ks < 8; ++ks) {
                const bf16x8 qf = *(const GAS bf16x8*)(qp + ks * 16);
#pragma unroll
                for (int kt = 0; kt < 4; ++kt) { const bf16x8 kf = *(const LAS bf16x8*)(KIMG + (side * 128 + kt * 32 + r) * KPITCH + (ks * 16 + 8 * h) * 2); acc[kt] = MFMA32(kf, qf, acc[kt]); }
            }
            float L[16];
#pragma unroll
            for (int i = 0; i < 16; ++i) L[i] = -3.0e38f;
#pragma unroll
            for (int kt = 0; kt < 4; ++kt)
#pragma unroll
                for (int reg = 0; reg < 16; ++reg) { const unsigned key = (unsigned)(kt * 32 + crow(reg, h)); const float sv = acc[kt][reg];
                    topk_insert(L, __uint_as_float((__float_as_uint(sv) & ~127u) | key)); }
            float P[16];
#pragma unroll
            for (int i = 0; i < 16; ++i) P[i] = __shfl_xor(L[i], 32);
#pragma unroll
            for (int i = 0; i < 16; ++i) topk_insert(L, P[i]);
            if (side == 0) {
#pragma unroll
                for (int i = 0; i < 16; ++i) L1[i] = L[i];
            } else {
#pragma unroll
                for (int i = 0; i < 16; ++i) L2[i] = L[i];
            }
        }
        if (h == 0) {
#pragma unroll
            for (int w = 0; w < 4; ++w) {
                const unsigned a = (__builtin_bit_cast(unsigned, L1[4 * w]) & 127u) | ((__builtin_bit_cast(unsigned, L1[4 * w + 1]) & 127u) << 8) | ((__builtin_bit_cast(unsigned, L1[4 * w + 2]) & 127u) << 16) | ((__builtin_bit_cast(unsigned, L1[4 * w + 3]) & 127u) << 24);
                const unsigned b = (__builtin_bit_cast(unsigned, L2[4 * w]) & 127u) | ((__builtin_bit_cast(unsigned, L2[4 * w + 1]) & 127u) << 8) | ((__builtin_bit_cast(unsigned, L2[4 * w + 2]) & 127u) << 16) | ((__builtin_bit_cast(unsigned, L2[4 * w + 3]) & 127u) << 24);
                *(LAS unsigned*)(TBL + r * 32 + 4 * w) = a; *(LAS unsigned*)(TBL + r * 32 + 16 + 4 * w) = b;
            }
        }
        float T[16];
#pragma unroll
        for (int i = 0; i < 16; ++i) T[i] = -3.0e38f;
#pragma unroll
        for (int i = 0; i < 16; ++i) {
            const float v1 = __builtin_bit_cast(float, __builtin_bit_cast(unsigned, L1[i]) & ~127u);
#pragma unroll
            for (int j = 0; j < 16; ++j) if ((i + 1) * (j + 1) <= 16) {
                const float v2 = __builtin_bit_cast(float, __builtin_bit_cast(unsigned, L2[j]) & ~127u);
                topk_insert(T, __builtin_bit_cast(float, (__builtin_bit_cast(unsigned, v1 + v2) & ~255u) | (unsigned)(i * 16 + j)));
            }
        }
        LDS_WAIT(); asm volatile("" ::: "memory");
        float ev[16], esum = 0.f;
        const float mx = __builtin_bit_cast(float, __builtin_bit_cast(unsigned, T[0]) & ~255u);
#pragma unroll
        for (int i = 0; i < 16; ++i) { ev[i] = __expf(__builtin_bit_cast(float, __builtin_bit_cast(unsigned, T[i]) & ~255u) - mx); esum += ev[i]; }
        const float einv = 1.0f / esum;
        int eid[8]; float gt[8];
#pragma unroll
        for (int i = 0; i < 8; ++i) { const float tv = h ? T[8 + i] : T[i]; const float e = h ? ev[8 + i] : ev[i];
            const unsigned p = __builtin_bit_cast(unsigned, tv) & 255u;
            const unsigned i1 = *(const LAS unsigned char*)(TBL + r * 32 + (p >> 4)), i2 = *(const LAS unsigned char*)(TBL + r * 32 + 16 + (p & 15u));
            eid[i] = (int)(i1 * 128u + i2); gt[i] = e * einv; }
        int* ip = F.IDX + (size_t)t * NSEL + hd * 16 + 8 * h; float* gp = F.PG + (size_t)t * NSEL + hd * 16 + 8 * h;
        *(GAS v4u*)ip = (v4u){(unsigned)eid[0], (unsigned)eid[1], (unsigned)eid[2], (unsigned)eid[3]}; *(GAS v4u*)(ip + 4) = (v4u){(unsigned)eid[4], (unsigned)eid[5], (unsigned)eid[6], (unsigned)eid[7]};
        *(GAS f32x4*)gp = (f32x4){gt[0], gt[1], gt[2], gt[3]}; *(GAS f32x4*)(gp + 4) = (f32x4){gt[4], gt[5], gt[6], gt[7]};
        LDS_WAIT(); asm volatile("" ::: "memory");
    }
}
constexpr int P9_IDX = 131072, P9_SH = 147456, P9_CORR = 147712, P9_GF = 32768, P9_FG = 40960, P9_SSQ = 49152, P9_CQ = 65536, P9_CT = 81920, P9_CSQ = 82176, NSLICE = 16, SLICE_B = 128;
#ifndef NSLICE_A
#define NSLICE_A NSLICE
#endif
#ifndef NSLICE_C
#define NSLICE_C NSLICE
#endif
template <int N, int MASK> DI void red_step_i(int (&v)[8], int lane) {
#pragma unroll
    for (int i = 0; i < N / 2; ++i) { const bool up = (lane & MASK) != 0; const int keep = up ? v[i + N / 2] : v[i], send = up ? v[i] : v[i + N / 2]; v[i] = keep + __shfl_xor(send, MASK); }
}
template <int N, int MASK> DI void red_step_f(float (&v)[16], int lane) {
#pragma unroll
    for (int i = 0; i < N / 2; ++i) { const bool up = (lane & MASK) != 0; const float keep = up ? v[i + N / 2] : v[i], send = up ? v[i] : v[i + N / 2]; v[i] = keep + __shfl_xor(send, MASK); }
}
typedef _Float16 h2v __attribute__((ext_vector_type(2)));
DI void acc4(float& o0, float& o1, float& o2, float& o3, unsigned u, float c) {
    const h2v p = __builtin_bit_cast(h2v, __builtin_amdgcn_perm(u, 0x64646464u, 0x01050004u));
    const h2v q = __builtin_bit_cast(h2v, __builtin_amdgcn_perm(u, 0x64646464u, 0x01070006u));
    o0 = __builtin_fmaf((float)p.x, c, o0); o1 = __builtin_fmaf((float)p.y, c, o1); o2 = __builtin_fmaf((float)q.x, c, o2); o3 = __builtin_fmaf((float)q.y, c, o3);
}
template <int N> DI void red32_f(float (&v)[16]) {
#pragma unroll
    for (int i = 0; i < N / 2; ++i) { const auto rr = __builtin_amdgcn_permlane32_swap(__float_as_uint(v[i]), __float_as_uint(v[i + N / 2]), false, false); v[i] = __uint_as_float(rr[0]) + __uint_as_float(rr[1]); }
}
template <int N> DI void red16_f(float (&v)[16]) {
#pragma unroll
    for (int i = 0; i < N / 2; ++i) { const auto rr = __builtin_amdgcn_permlane16_swap(__float_as_uint(v[i]), __float_as_uint(v[i + N / 2]), false, false); v[i] = __uint_as_float(rr[0]) + __uint_as_float(rr[1]); }
}
template <int N> DI void red8_f(float (&v)[16], int lane) {
#pragma unroll
    for (int i = 0; i < N / 2; ++i) { const bool up = (lane & 8) != 0; const float keep = up ? v[i + N / 2] : v[i], send = up ? v[i] : v[i + N / 2];
        v[i] = keep + __builtin_bit_cast(float, __builtin_amdgcn_mov_dpp(__builtin_bit_cast(int, send), 0x128, 0xf, 0xf, true)); }
}
template <int N> DI void redi32(int (&v)[16]) {
#pragma unroll
    for (int i = 0; i < N / 2; ++i) { const auto rr = __builtin_amdgcn_permlane32_swap((unsigned)v[i], (unsigned)v[i + N / 2], false, false); v[i] = (int)(rr[0] + rr[1]); }
}
template <int N> DI void redi16(int (&v)[16]) {
#pragma unroll
    for (int i = 0; i < N / 2; ++i) { const auto rr = __builtin_amdgcn_permlane16_swap((unsigned)v[i], (unsigned)v[i + N / 2], false, false); v[i] = (int)(rr[0] + rr[1]); }
}
template <int N> DI void redi8(int (&v)[16], int lane) {
#pragma unroll
    for (int i = 0; i < N / 2; ++i) { const bool up = (lane & 8) != 0; const int keep = up ? v[i + N / 2] : v[i], send = up ? v[i] : v[i + N / 2]; v[i] = keep + __builtin_amdgcn_mov_dpp(send, 0x128, 0xf, 0xf, true); }
}
DI void p9v2_phase(Frame& F) {
    LAS unsigned char* HQ = F.lds; LAS float* A2 = (LAS float*)(F.lds + P9_IDX); LAS float* B2 = (LAS float*)(F.lds + P9_IDX + 8192);
    LAS unsigned short* IDX16 = (LAS unsigned short*)(F.lds + P9_IDX); LAS float* SH = (LAS float*)(F.lds + P9_SH); LAS float* CORR = (LAS float*)(F.lds + P9_CORR);
    LAS float* GF = (LAS float*)(F.lds + P9_GF); LAS float* FG = (LAS float*)(F.lds + P9_FG);
    const int lane = F.lane, tid = F.tid, c8 = lane & 7, g = lane >> 3;
#pragma unroll 1
    for (int tb = (int)blockIdx.x * 64; tb < M; tb += F.G * 64) {
#pragma unroll
        for (int i = 0; i < 4; ++i) { const int c = tid + 512 * i; A2[c] = F.norm_ffn_g[c] * (1.0f + F.MODF[MOD_SCF + c]); B2[c] = F.MODF[MOD_SHF + c]; }
        __syncthreads();
#pragma unroll 1
        for (int j = 0; j < 8; ++j) {
            const int tl = F.wave * 8 + j, t = tb + tl;
            float hv[32]; float ss = 0.f;
            const bf16* xr = F.X1B + (size_t)t * D + 16 * lane;
#pragma unroll
            for (int jj = 0; jj < 2; ++jj)
#pragma unroll
                for (int q = 0; q < 2; ++q) { const v4u a = *(const GAS v4u*)(xr + 1024 * jj + 8 * q); const int o = 16 * jj + 8 * q;
                    hv[o] = bflo(a.x); hv[o + 1] = bfhi(a.x); hv[o + 2] = bflo(a.y); hv[o + 3] = bfhi(a.y); hv[o + 4] = bflo(a.z); hv[o + 5] = bfhi(a.z); hv[o + 6] = bflo(a.w); hv[o + 7] = bfhi(a.w); }
#pragma unroll
            for (int i = 0; i < 32; ++i) ss += hv[i] * hv[i];
            const float rstd = 1.0f / sqrtf(wave_sum(ss) * (1.0f / D) + EPS);
            float am = 0.f;
#pragma unroll
            for (int jj = 0; jj < 2; ++jj)
#pragma unroll
                for (int q = 0; q < 4; ++q) { const f32x4 a = *(const LAS f32x4*)(A2 + 1024 * jj + 16 * lane + 4 * q), b = *(const LAS f32x4*)(B2 + 1024 * jj + 16 * lane + 4 * q);
                    const int o = 16 * jj + 4 * q;
                    hv[o] = hv[o] * rstd * a.x + b.x; hv[o + 1] = hv[o + 1] * rstd * a.y + b.y; hv[o + 2] = hv[o + 2] * rstd * a.z + b.z; hv[o + 3] = hv[o + 3] * rstd * a.w + b.w;
                    am = fmaxf(am, fmaxf(fmaxf(fabsf(hv[o]), fabsf(hv[o + 1])), fmaxf(fabsf(hv[o + 2]), fabsf(hv[o + 3])))); }
            am = fmaxf(wave_max(am), 1e-30f); const float inv = 127.0f / am;
            if (lane == 0) SH[tl] = am * (1.0f / 127.0f);
#pragma unroll
            for (int jj = 0; jj < 2; ++jj) { v4u o;
#pragma unroll
                for (int q = 0; q < 4; ++q) { const int b = 16 * jj + 4 * q;
                    const int q0 = (int)__builtin_rintf(hv[b] * inv), q1 = (int)__builtin_rintf(hv[b + 1] * inv), q2 = (int)__builtin_rintf(hv[b + 2] * inv), q3 = (int)__builtin_rintf(hv[b + 3] * inv);
                    o[q] = (unsigned)(q0 & 255) | ((unsigned)(q1 & 255) << 8) | ((unsigned)(q2 & 255) << 16) | ((unsigned)(q3 & 255) << 24); }
                *(LAS v4u*)(HQ + tl * 2048 + 1024 * jj + 16 * lane) = o; }
        }
        __syncthreads();
#pragma unroll
        for (int i = 0; i < 16; ++i) { const int q = tid + 512 * i, k = q & 127; IDX16[(q & ~127) + (k & 64) + 8 * (k & 7) + ((k >> 3) & 7)] = (unsigned short)F.IDX[(size_t)tb * NSEL + q]; }
        __syncthreads();
        int P[8][2];
#pragma unroll
        for (int j = 0; j < 8; ++j) { P[j][0] = 0; P[j][1] = 0; }
#pragma unroll 1
        for (int s = 0; s < NSLICE_A; ++s) {
            if (((s ^ (F.wave >> 2)) & 1) != 0) __builtin_amdgcn_s_setprio(1); else __builtin_amdgcn_s_setprio(0);
            const unsigned char* eb = F.ED + s * SLICE_B;
            const unsigned lo = (unsigned)(c8 * 16);
            v4u wA[8], wB[8];
#define P9A_LOAD(W, J, H) do { _Pragma("unroll") for (int i = 0; i < 8; ++i) { const unsigned e = IDX16[(F.wave * 8 + (J)) * 128 + 64 * (H) + 8 * g + i]; W[i] = *(const GAS v4u*)(eb + (e * 2048u + lo)); } } while (0)
#define P9A_COMP(W, J, H) do { const v4u hq = *(const LAS v4u*)(HQ + (F.wave * 8 + (J)) * 2048 + s * SLICE_B + c8 * 16); int a[8]; \
                _Pragma("unroll") for (int i = 0; i < 8; ++i) { int d = 0; const v4u ww = W[i]; \
                    d = __builtin_amdgcn_sdot4((int)hq.x, (int)ww.x, d, false); d = __builtin_amdgcn_sdot4((int)hq.y, (int)ww.y, d, false); d = __builtin_amdgcn_sdot4((int)hq.z, (int)ww.z, d, false); d = __builtin_amdgcn_sdot4((int)hq.w, (int)ww.w, d, false); a[i] = d; } \
                red_step_i<8, 4>(a, lane); red_step_i<4, 2>(a, lane); red_step_i<2, 1>(a, lane); P[J][H] += a[0]; asm volatile("" ::: "memory"); } while (0)
            P9A_LOAD(wA, 0, 0);
#pragma unroll
            for (int j = 0; j < 8; ++j) {
                P9A_LOAD(wB, j, 1);
                P9A_COMP(wA, j, 0);
                if (j < 7) P9A_LOAD(wA, j + 1, 0);
                P9A_COMP(wB, j, 1);
            }
#undef P9A_LOAD
#undef P9A_COMP
        }
        __builtin_amdgcn_s_setprio(0);
        __syncthreads();
        LAS int* PI = (LAS int*)F.lds;
#pragma unroll
        for (int j = 0; j < 8; ++j) { const int tl = F.wave * 8 + j; PI[tl * 128 + 8 * c8 + g] = P[j][0]; PI[tl * 128 + 64 + 8 * c8 + g] = P[j][1]; }
#pragma unroll
        for (int i = 0; i < 4; ++i) { const int c = tid + 512 * i; GF[c] = F.MODF[MOD_GF + c]; FG[c] = F.final_g[c]; }
        LAS float* SSQL = (LAS float*)(F.lds + P9_SSQ); LAS short* CQ = (LAS short*)(F.lds + P9_CQ); LAS float* CT = (LAS float*)(F.lds + P9_CT); LAS int* CSQ = (LAS int*)(F.lds + P9_CSQ);
#pragma unroll 1
        for (int j = 0; j < 8; ++j) { const int tl = F.wave * 8 + j, t = tb + tl; const float sh = SH[tl]; float cf[2]; float am = 0.f;
#pragma unroll
            for (int h = 0; h < 2; ++h) { const int k = 64 * h + lane; const unsigned e = IDX16[tl * 128 + 64 * h + 8 * (lane & 7) + (lane >> 3)];
                const float act = (float)PI[tl * 128 + k] * (sh * F.SD[e]); cf[h] = F.PG[(size_t)t * NSEL + k] * gelu_f(act) * F.SU[e]; am = fmaxf(am, fabsf(cf[h])); }
            am = fmaxf(wave_max(am), 1e-30f); const float inv = 32767.0f / am; int qs = 0;
#pragma unroll
            for (int h = 0; h < 2; ++h) { const int q = (int)__builtin_rintf(cf[h] * inv); qs += q; CQ[tl * 128 + 64 * h + 8 * (lane & 7) + (lane >> 3)] = (short)q; }
#pragma unroll
            for (int o = 1; o < 64; o <<= 1) qs += __shfl_xor(qs, o);
            if (lane == 0) { CT[tl] = am * (1.0f / 32767.0f); CSQ[tl] = 128 * qs; }
            }
        __syncthreads();
        const int cb = c8 * 16 + ((lane >> 5) & 1) * 8 + ((lane >> 4) & 1) * 4 + ((lane >> 3) & 1) * 2;
        typedef short s16x2 __attribute__((ext_vector_type(2)));
#pragma unroll 1
        for (int s = 0; s < NSLICE_C; ++s) {
            if (((s ^ (F.wave >> 2)) & 1) != 0) __builtin_amdgcn_s_setprio(1); else __builtin_amdgcn_s_setprio(0);
            const unsigned char* eb = F.EU + s * SLICE_B;
            const unsigned lo = (unsigned)(c8 * 16);
            v4u wA[8], wB[8]; unsigned cA[4], cB[4];
#define P9C_LOAD(W, C, TL, H) do { const LAS unsigned* ip = (const LAS unsigned*)(IDX16 + (TL) * 128 + 64 * (H) + 8 * g); const LAS unsigned* cp = (const LAS unsigned*)(CQ + (TL) * 128 + 64 * (H) + 8 * g); \
                _Pragma("unroll") for (int i2 = 0; i2 < 4; ++i2) { const unsigned ee = ip[i2]; C[i2] = cp[i2]; \
                    W[2 * i2] = *(const GAS v4u*)(eb + ((ee & 0xffffu) * 2048u + lo)); W[2 * i2 + 1] = *(const GAS v4u*)(eb + ((ee >> 16) * 2048u + lo)); } } while (0)
#define P9C_D4(O, UA, UB, CC) do { O[0] = __builtin_amdgcn_sdot2(__builtin_bit_cast(s16x2, __builtin_amdgcn_perm(UB, UA, 0x0c040c00u)), __builtin_bit_cast(s16x2, CC), O[0], false); \
                O[1] = __builtin_amdgcn_sdot2(__builtin_bit_cast(s16x2, __builtin_amdgcn_perm(UB, UA, 0x0c050c01u)), __builtin_bit_cast(s16x2, CC), O[1], false); \
                O[2] = __builtin_amdgcn_sdot2(__builtin_bit_cast(s16x2, __builtin_amdgcn_perm(UB, UA, 0x0c060c02u)), __builtin_bit_cast(s16x2, CC), O[2], false); \
                O[3] = __builtin_amdgcn_sdot2(__builtin_bit_cast(s16x2, __builtin_amdgcn_perm(UB, UA, 0x0c070c03u)), __builtin_bit_cast(s16x2, CC), O[3], false); } while (0)
#define P9C_ACC(W, C) do { _Pragma("unroll") for (int i2 = 0; i2 < 4; ++i2) { const v4u ua = W[2 * i2], ub = W[2 * i2 + 1]; const unsigned cc = C[i2]; \
                P9C_D4((o + 0), ua.x, ub.x, cc); P9C_D4((o + 4), ua.y, ub.y, cc); P9C_D4((o + 8), ua.z, ub.z, cc); P9C_D4((o + 12), ua.w, ub.w, cc); } asm volatile("" ::: "memory"); } while (0)
            P9C_LOAD(wA, cA, F.wave * 8, 0);
#pragma unroll 1
            for (int j = 0; j < 8; ++j) {
                const int tl = F.wave * 8 + j, t = tb + tl;
                int o[16];
#pragma unroll
                for (int b = 0; b < 16; ++b) o[b] = 0;
                P9C_LOAD(wB, cB, tl, 1);
                P9C_ACC(wA, cA);
                if (j < 7) P9C_LOAD(wA, cA, tl + 1, 0);
                P9C_ACC(wB, cB);
                redi32<16>(o); redi16<8>(o); redi8<4>(o, lane);
                const int col = s * SLICE_B + cb; const int csq = CSQ[tl]; const float ct = CT[tl];
                GAS unsigned* xp = (GAS unsigned*)(F.X1B + (size_t)t * D + col);
                const unsigned xw = *xp;
                const float y0 = bflo(xw) + GF[col] * ((float)(o[0] - csq) * ct), y1 = bfhi(xw) + GF[col + 1] * ((float)(o[1] - csq) * ct);
                *xp = pk2(y0, y1);
            }
#undef P9C_LOAD
#undef P9C_ACC
#undef P9C_D4
        }
        __builtin_amdgcn_s_setprio(0);
#pragma unroll 1
        for (int j = 0; j < 8; ++j) {
            const int tl = F.wave * 8 + j, t = tb + tl;
            const GAS v2u* xrow = (const GAS v2u*)(F.X1B + (size_t)t * D) + lane; GAS f32x4* orow = (GAS f32x4*)(F.out + (size_t)t * D) + lane;
            v2u xw[8]; float sq = 0.f;
#pragma unroll
            for (int q = 0; q < 8; ++q) { xw[q] = xrow[64 * q]; const float a0 = bflo(xw[q].x), a1 = bfhi(xw[q].x), a2 = bflo(xw[q].y), a3 = bfhi(xw[q].y); sq += (a0 * a0 + a1 * a1) + (a2 * a2 + a3 * a3); }
            const float rstd2 = 1.0f / sqrtf(wave_sum(sq) * (1.0f / D) + EPS);
#pragma unroll
            for (int q = 0; q < 8; ++q) { const f32x4 f = *(const LAS f32x4*)(FG + 256 * q + 4 * lane);
                __builtin_nontemporal_store((f32x4){bflo(xw[q].x) * rstd2 * f.x, bfhi(xw[q].x) * rstd2 * f.y, bflo(xw[q].y) * rstd2 * f.z, bfhi(xw[q].y) * rstd2 * f.w}, orow + 64 * q); }
        }
        __syncthreads();
    }
}
struct Args { const float* in[21]; float* out; unsigned char* ws; int ph_lo, ph_hi, li, pad; };
constexpr int N_PHASES = 10;
__global__ void __launch_bounds__(NWAVES * 64, 2) mk_fwd(Args args) {
    extern __shared__ __attribute__((aligned(16))) unsigned char lds[];
    Frame F;
    F.lds = (LAS unsigned char*)lds;
    F.MISC = (volatile LAS unsigned*)(F.lds + MISC_OFF);
    F.tid = threadIdx.x; F.lane = F.tid & 63; F.wave = __builtin_amdgcn_readfirstlane(F.tid >> 6);
    F.G = gridDim.x; { const int bx = blockIdx.x; F.vcu = (F.G % 8 == 0) ? (bx % 8) * (F.G / 8) + bx / 8 : bx; }
    unsigned char* ws = args.ws;
    F.ctl = (gu32*)(ws + WS_CTL);
    F.x = args.in[0]; F.c = args.in[1]; F.ada_w = args.in[2]; F.ada_b = args.in[3]; F.norm_mix_g = args.in[4]; F.w_in = args.in[5]; F.b_gates = args.in[6];
    F.conv_w = args.in[7]; F.conv_b = args.in[8]; F.gmlp_norm_g = args.in[9]; F.gmlp_w = args.in[10]; F.gmlp_b = args.in[11]; F.mlstm_norm_g = args.in[12];
    F.w_out = args.in[13]; F.norm_ffn_g = args.in[14]; F.wq = args.in[15]; F.keys1 = args.in[16]; F.keys2 = args.in[17]; F.e_down = args.in[18]; F.e_up = args.in[19]; F.final_g = args.in[20];
    F.out = args.out;
    F.MODP = (float*)(ws + WS_MODP); F.MODF = (float*)(ws + WS_MODF); F.GATES = (float*)(ws + WS_GATES); F.SUMM = (float*)(ws + WS_SUMM); F.MTAB = (float*)(ws + WS_MTAB);
    F.NST = (float*)(ws + WS_NST); F.PG = (float*)(ws + WS_PG); F.IDX = (int*)(ws + WS_IDX);
    F.WIN = (bf16*)(ws + WS_WIN); F.WOUT = (bf16*)(ws + WS_WOUT); F.WQ = (bf16*)(ws + WS_WQ); F.HA = (bf16*)(ws + WS_HA); F.PROJ = (bf16*)(ws + WS_PROJ); F.QB = (bf16*)(ws + WS_PROJ);
    F.STATE = (bf16*)(ws + WS_STATE); F.VT = (bf16*)(ws + WS_VT); F.ED = ws + WS_ED; F.EU = ws + WS_EU; F.SD = (float*)(ws + WS_SD); F.SU = (float*)(ws + WS_SU);
    F.H1Q = ws + WS_STATE;
    F.SW = (float*)(ws + WS_SW); F.CMAXP = (float*)(ws + WS_CMAXP); F.SA = (float*)(ws + WS_SA);
    F.SSQP = (float*)(ws + WS_SSQP); F.BQP = (float*)(ws + WS_BQP); F.BIASQ = (float*)(ws + WS_BIASQ); F.X1B = (bf16*)(ws + WS_STATE);
    F.QC = (bf16*)args.out; F.KC = (bf16*)args.out + (size_t)M * 1024;
    for (int u = F.tid; u < (LDS_BYTES - LDSCTL_OFF) / 4; u += NWAVES * 64) ((LAS unsigned*)(F.lds + LDSCTL_OFF))[u] = 0u;
    __syncthreads();
    const int lo = args.ph_lo, hi = args.ph_hi;
    const bool multi = (hi - lo) > 1;
    XcdBarrier bar; bar.bar = (unsigned*)(F.ctl + CW_BAR) + args.li * XCD_BAR_WORDS; bar.x = 0; bar.st = nullptr;
    if (multi) bar = xcd_barrier_post((unsigned*)(F.ctl + CW_BAR) + args.li * XCD_BAR_WORDS, F.MISC + 8);
#ifndef PH_MASK
#define PH_MASK 0x7ff
#endif
#define IN(k) (((PH_MASK >> (k)) & 1) && lo <= (k) && (k) < hi)
#define SEAM(k) do { if (IN(k) && IN((k) + 1)) xcd_barrier(bar); } while (0)
    if (IN(0)) { p0a_phase(F); } SEAM(0);
    if (IN(1)) { p0b_phase(F); } SEAM(1);
    if (IN(2)) {
        { pg8::Gemm g{(const pg8::bf16_t*)F.H1Q, F.WIN, M, NPROJ, D / 2}; pg8::StaticOrder S; S.init(M, NPROJ, F.G, (int)blockIdx.x);
          pg8::EpiQ8 E{F.PROJ, NPROJ, 2048 / 256, F.SA, F.SW};
          pg8::gemm_phase<pg8::EpiQ8, pg8::StaticOrder, PG8_ALIGN, PG8_SP2, true>(F.lds, g, S, E); }
        {
          pg8::Gemm g{(const pg8::bf16_t*)((const unsigned char*)F.WIN + (size_t)WROW_VM * D), (const pg8::bf16_t*)F.H1Q, 1024, M, D / 2}; pg8::StaticOrder S; S.init(1024, M, F.G, (int)blockIdx.x);
          pg8::EpiQ8 E{F.VT, M, 0, F.SW + WROW_VM, F.SA};
          pg8::gemm_phase<pg8::EpiQ8, pg8::StaticOrder, PG8_ALIGN, PG8_SP2, true>(F.lds, g, S, E); }
    } SEAM(2);
    if (IN(3)) { p2_phase(F); } SEAM(3);
    if (IN(4)) { p3_phase(F); } SEAM(4);
    if (IN(5)) { p4_phase(F); } SEAM(5);
    if (IN(6)) {
        pg8::Gemm g{F.HA, F.WOUT, M, D, D}; pg8::StaticOrder S; S.init(M, D, F.G, (int)blockIdx.x);
        pg8::EpiResid2 E{F.x, F.MODF + MOD_GM, F.X1B, F.SSQP, D};
        pg8::gemm_phase<pg8::EpiResid2, pg8::StaticOrder, PG8_ALIGN, PG8_SP2>(F.lds, g, S, E);
    } SEAM(6);
    if (IN(7)) {
        pg8::Gemm g{F.X1B, F.WQ, M, D, D}; pg8::StaticOrder S; S.init(M, D, F.G, (int)blockIdx.x);
        LAS float* RSTDL = (LAS float*)(F.lds + RING_BYTES);
        { pg8::Unit u; for (int i = 0; S.next(i, u); ++i) { if (F.tid < 256) { const float* sp = F.SSQP + (size_t)(u.pm * 256 + F.tid) * 32; float ss = 0.f;
#pragma unroll
                    for (int q = 0; q < 8; ++q) { const f32x4 v = *(const GAS f32x4*)(sp + 4 * q); ss += (v.x + v.y) + (v.z + v.w); }
                    RSTDL[(u.pm & 1) * 256 + F.tid] = 1.0f / sqrtf(ss * (1.0f / D) + EPS); } } }
        __syncthreads();
        pg8::EpiQ E{F.QB, D, F.BIASQ, RSTDL};
        pg8::gemm_phase<pg8::EpiQ, pg8::StaticOrder, PG8_ALIGN, PG8_SP2>(F.lds, g, S, E);
    } SEAM(7);
#ifndef P8_ALT
#define P8_ALT 0
#endif
    if (IN(8)) { p8_phase(F); } SEAM(8);
#ifndef P9_V2
#define P9_V2 1
#endif
    if (IN(9)) { p9v2_phase(F); }
#undef IN
#undef SEAM
}

#ifndef MK_N_LAUNCHES
#define MK_N_LAUNCHES 1
#endif
extern "C" void kernel_launch(void* const* d_in, const int* in_sizes, int n_in, void* d_out, int out_size, void* d_ws, size_t ws_size, hipStream_t stream) {
    static int grid = 0;
    if (grid == 0) {
        if (n_in != 21 || in_sizes[0] != M * D || out_size != M * D || ws_size < WS_END) { fprintf(stderr, "kernel_launch: unexpected shapes (n_in %d, in0 %d, out %d, ws %zu); nothing launched\n", n_in, n_in > 0 ? in_sizes[0] : -1, out_size, ws_size); grid = -1; return; }
        int dev = 0, cus = 0, per_cu = 0;
        if (hipGetDevice(&dev) != hipSuccess || hipDeviceGetAttribute(&cus, hipDeviceAttributeMultiprocessorCount, dev) != hipSuccess) { grid = -1; return; }
        if (hipFuncSetAttribute((const void*)mk_fwd, hipFuncAttributeMaxDynamicSharedMemorySize, LDS_BYTES) != hipSuccess) { fprintf(stderr, "kernel_launch: hipFuncSetAttribute failed\n"); grid = -1; return; }
        if (hipOccupancyMaxActiveBlocksPerMultiprocessor(&per_cu, (const void*)mk_fwd, NWAVES * 64, LDS_BYTES) != hipSuccess || per_cu < 1) { fprintf(stderr, "kernel_launch: occupancy query says %d blocks per CU\n", per_cu); }
        (void)hipGetLastError();
        grid = cus;
    }
    if (grid < 0) return;
    (void)hipMemsetAsync((char*)d_ws + WS_CTL, 0, CTL_ZERO_BYTES, stream);
    Args a{};
    for (int i = 0; i < 21; ++i) a.in[i] = (const float*)d_in[i];
    a.out = (float*)d_out; a.ws = (unsigned char*)d_ws;
    if (MK_N_LAUNCHES == 1) { a.ph_lo = 0; a.ph_hi = N_PHASES; a.li = 0; hipLaunchKernelGGL(mk_fwd, dim3(grid), dim3(NWAVES * 64), LDS_BYTES, stream, a); }
    else for (int li = 0; li < N_PHASES; ++li) { a.ph_lo = li; a.ph_hi = li + 1; a.li = 0; hipLaunchKernelGGL(mk_fwd, dim3(grid), dim3(NWAVES * 64), LDS_BYTES, stream, a); }
}
```

```cpp
#include <hip/hip_runtime.h>
#include <cstdio>
#include <cstdint>
namespace pg8 {
#define PG8_LAS __attribute__((address_space(3)))
typedef unsigned short bf16_t;
typedef short bf16x8 __attribute__((ext_vector_type(8)));
typedef float f32x4 __attribute__((ext_vector_type(4)));
typedef unsigned u32x4 __attribute__((ext_vector_type(4)));
constexpr int BM = 256, BK = 64, HALF = 128, HTB = HALF * BK * 2  , STAGE_BYTES = 8 * HTB, NXCD = 8, WGM = 8;

__host__ __device__ __forceinline__ int lds_byte(int r, int c) { const int st = (r >> 4) * 2 + (c >> 5), rr = r & 15, cc = c & 31, ob = rr * 64 + cc * 2; return st * 1024 + (ob ^ (((ob >> 9) & 1) << 5)); }
__host__ __device__ __forceinline__ void stage_rc(int b, int& R, int& C) { const int st = b / 1024, sb = b % 1024, swz = sb ^ (((sb >> 9) & 1) << 5); R = (st >> 1) * 16 + swz / 64; C = (st & 1) * 32 + (swz % 64) / 2; }
__host__ __device__ __forceinline__ int perm32(int rho) { const int n = rho >> 4, i = rho & 15; return 8 * (i >> 2) + 4 * n + (i & 3); }

struct Unit { int pm, pn; };
struct Gemm { const bf16_t* A; const bf16_t* Bt; int M, N, K; };

struct StaticOrder {
    int nM, nN, nwg, G, c;
    __host__ __device__ void init(int M, int N, int G_, int c_) { nM = M / BM; nN = N / BM; nwg = nM * nN; G = G_; c = c_; }
    __host__ __device__ bool next(int i, Unit& u) const {
        const long L = (long)i * G + c; if (L >= nwg) return false;
        int wgid = (int)L; { const int q = nwg / NXCD, r = nwg % NXCD, xcd = wgid % NXCD, off = wgid / NXCD; wgid = (xcd < r ? xcd * (q + 1) : r * (q + 1) + (xcd - r) * q) + off; }
        const int nig = WGM * nN, gid = wgid / nig, fm = gid * WGM, gsz = (nM - fm) < WGM ? (nM - fm) : WGM;
        u.pm = fm + ((wgid % nig) % gsz); u.pn = (wgid % nig) / gsz; return true;
    }
    __device__ __forceinline__ void a_ready(const Unit&) const {}
    __device__ __forceinline__ void done(const Unit&) const {}
};

__device__ __forceinline__ unsigned cvt_pk_bf16(float lo, float hi) { unsigned r; asm volatile("v_cvt_pk_bf16_f32 %0, %1, %2" : "=v"(r) : "v"(lo), "v"(hi)); return r; }
typedef float f32x2 __attribute__((ext_vector_type(2)));
__device__ __forceinline__ f32x2 gelu_pk(f32x2 v) {
    const f32x2 av = __builtin_elementwise_abs(v), d = av * 0.2316418882f + 1.0f;
    f32x2 t; t.x = __builtin_amdgcn_rcpf(d.x); t.y = __builtin_amdgcn_rcpf(d.y);
    f32x2 q = t * 0.5307027145f + (-0.7265760135f); q = q * t + 0.7107068705f; q = q * t + (-0.142248368f); q = q * t + 0.127414796f; q = q * t;
    const f32x2 s = (v * v) * (-0.72134752044f);
    f32x2 e; e.x = __builtin_amdgcn_exp2f(s.x); e.y = __builtin_amdgcn_exp2f(s.y);
    const f32x2 m = v * (q * e), r = v - m;
    f32x2 o; o.x = v.x < 0.f ? m.x : r.x; o.y = v.y < 0.f ? m.y : r.y; return o;
}

template <int ACT  > struct EpiBf16 {
    static constexpr bool PERM = true, AFTER_DRAIN = false; static_assert(ACT == 0 || ACT == 1, "EpiBf16: ACT is 0 (none) or 1 (gelu_pk)");
    bf16_t* O; int ldc; const float* bias; int split_cols; size_t split_stride; float scale0;
    __device__ __forceinline__ void operator()(const f32x4 (&acc)[2][2][4][2], const Unit& u, int wr, int wc, int fr, int fq) const {
        const int row0 = u.pm * BM + wr * 64 + fr; int colt = u.pn * BM; bf16_t* base = O;
        float sc = 1.f; if (split_cols) { const int t = colt / split_cols; base += (size_t)t * split_stride; colt -= t * split_cols; if (t == 0) sc = scale0; }
        const int col0 = colt + wc * 32 + 8 * fq, bcol0 = u.pn * BM + wc * 32 + 8 * fq;
        f32x4 bv[2][2];
#pragma unroll
        for (int bj = 0; bj < 2; ++bj)
#pragma unroll
            for (int n = 0; n < 2; ++n) bv[bj][n] = bias ? *(const f32x4*)(bias + bcol0 + bj * HALF + 4 * n) : (f32x4){0.f, 0.f, 0.f, 0.f};
#pragma unroll
        for (int ai = 0; ai < 2; ++ai)
#pragma unroll
            for (int m = 0; m < 4; ++m) { bf16_t* rowp = base + (size_t)(row0 + ai * HALF + m * 16) * ldc + col0;
#pragma unroll
                for (int bj = 0; bj < 2; ++bj) { f32x4 v0 = acc[ai][bj][m][0] + bv[bj][0], v1 = acc[ai][bj][m][1] + bv[bj][1];
                    if (ACT == 1) { f32x2 a = gelu_pk((f32x2){v0[0], v0[1]}), b = gelu_pk((f32x2){v0[2], v0[3]}), c = gelu_pk((f32x2){v1[0], v1[1]}), d = gelu_pk((f32x2){v1[2], v1[3]});
                        v0 = (f32x4){a.x, a.y, b.x, b.y}; v1 = (f32x4){c.x, c.y, d.x, d.y}; }
                    v0 = v0 * sc; v1 = v1 * sc; u32x4 w; w.x = cvt_pk_bf16(v0[0], v0[1]); w.y = cvt_pk_bf16(v0[2], v0[3]); w.z = cvt_pk_bf16(v1[0], v1[1]); w.w = cvt_pk_bf16(v1[2], v1[3]);
                    *(u32x4*)(rowp + bj * HALF) = w; } }
    }
};

typedef int i32x4 __attribute__((ext_vector_type(4)));
template <bool I8> __device__ __forceinline__ f32x4 mma16(bf16x8 a, bf16x8 b, f32x4 c) {
    if constexpr (I8) return __builtin_bit_cast(f32x4, __builtin_amdgcn_mfma_i32_16x16x64_i8(__builtin_bit_cast(i32x4, a), __builtin_bit_cast(i32x4, b), __builtin_bit_cast(i32x4, c), 0, 0, 0));
    else return __builtin_amdgcn_mfma_f32_16x16x32_bf16(a, b, c, 0, 0, 0);
}
template <class Epi, class Sched, bool ALIGN_EPI = false, bool SP2 = false, bool I8 = false>
__device__ __forceinline__ void gemm_phase(PG8_LAS unsigned char* lds, const Gemm g, const Sched& S, const Epi& E) {
    const int tid = threadIdx.x, wid = __builtin_amdgcn_readfirstlane(tid >> 6), lane = tid & 63, wr = wid >> 2, wc = wid & 3, fr = lane & 15, fq = lane >> 4;
    const int K = g.K, nt = K / BK;
    unsigned voffA[2], voffB[2];
#pragma unroll
    for (int i = 0; i < 2; ++i) { int R, C; stage_rc(tid * 16 + i * 8192, R, C); const int Rb = Epi::PERM ? ((R & ~31) + perm32(R & 31)) : R;
        voffA[i] = (unsigned)(R * K + C) * 2u; voffB[i] = (unsigned)(Rb * K + C) * 2u; }
    const size_t kstep = (size_t)(BK * 2);
    const size_t hstep = (size_t)HALF * K * 2;
    const size_t tstep = 2 * hstep;
    const unsigned ldsw = (unsigned)wid * 1024u;
    const int aoff = lds_byte(wr * 64 + fr, fq * 8), boff = lds_byte(wc * 32 + fr, fq * 8);
#define PG8_SA(b, h) (((b) * 2 + (h)) * HTB)
#define PG8_SB(b, h) ((4 + (b) * 2 + (h)) * HTB)
#define PG8_STAGE(bufoff, gbase, voff) do { _Pragma("unroll") for (int _i = 0; _i < 2; ++_i) \
        __builtin_amdgcn_global_load_lds((const unsigned*)((const char*)(gbase) + (voff)[_i]), (PG8_LAS unsigned*)(lds + (bufoff) + ldsw + _i * 8192), 16, 0, 0); } while (0)
#define PG8_LDA(dst, b, h) do { _Pragma("unroll") for (int m = 0; m < 4; ++m) _Pragma("unroll") for (int k = 0; k < 2; ++k) dst[m][k] = *(const PG8_LAS bf16x8*)(lds + PG8_SA(b, h) + aoff + m * 2048 + k * 1024); } while (0)
#define PG8_LDB(dst, b, h) do { _Pragma("unroll") for (int n = 0; n < 2; ++n) _Pragma("unroll") for (int k = 0; k < 2; ++k) dst[n][k] = *(const PG8_LAS bf16x8*)(lds + PG8_SB(b, h) + boff + n * 2048 + k * 1024); } while (0)
#define PG8_MMA(ai, bj, At, Bt) do { __builtin_amdgcn_s_setprio(1); _Pragma("unroll") for (int m = 0; m < 4; ++m) _Pragma("unroll") for (int n = 0; n < 2; ++n) _Pragma("unroll") for (int k = 0; k < 2; ++k) \
        acc[ai][bj][m][n] = mma16<I8>(Bt[n][k], At[m][k], acc[ai][bj][m][n]); __builtin_amdgcn_s_setprio(0); } while (0)
#define PG8_WAIT_V(n) asm volatile("s_waitcnt vmcnt(" #n ")" ::: "memory")
#define PG8_WAIT_L(n) asm volatile("s_waitcnt lgkmcnt(" #n ")" ::: "memory")
#define PG8_BAR __builtin_amdgcn_s_barrier()
#define PG8_SCHED __builtin_amdgcn_sched_barrier(0)
    Unit cur, nxt; int ui = 0;
    if (!S.next(0, cur)) return;
    f32x4 acc[2][2][4][2];
#pragma unroll
    for (int a = 0; a < 2; ++a)
#pragma unroll
        for (int b = 0; b < 2; ++b)
#pragma unroll
            for (int m = 0; m < 4; ++m)
#pragma unroll
                for (int n = 0; n < 2; ++n) acc[a][b][m][n] = (f32x4){0.f, 0.f, 0.f, 0.f};
    bf16x8 At[4][2], B0[2][2], B1[2][2];
    const char* cA = (const char*)g.A + (size_t)cur.pm * tstep; const char* cB = (const char*)g.Bt + (size_t)cur.pn * tstep;
    S.a_ready(cur);
    if constexpr (SP2) {
        PG8_STAGE(PG8_SB(0, 0), cB, voffB); PG8_STAGE(PG8_SB(0, 1), cB + hstep, voffB); PG8_STAGE(PG8_SA(0, 0), cA, voffA); PG8_STAGE(PG8_SA(0, 1), cA + hstep, voffA);
        if (wr == 1) PG8_BAR;
        PG8_WAIT_V(2); PG8_BAR;
        PG8_STAGE(PG8_SB(1, 0), cB + kstep, voffB); PG8_STAGE(PG8_SA(1, 0), cA + kstep, voffA); PG8_STAGE(PG8_SB(1, 1), cB + hstep + kstep, voffB);
        PG8_WAIT_V(6); PG8_BAR;
    } else {
        PG8_STAGE(PG8_SB(0, 0), cB, voffB); PG8_STAGE(PG8_SA(0, 0), cA, voffA); PG8_STAGE(PG8_SB(0, 1), cB + hstep, voffB); PG8_STAGE(PG8_SA(0, 1), cA + hstep, voffA);
        if (wr == 1) PG8_BAR;
        PG8_WAIT_V(4); PG8_BAR;
        PG8_STAGE(PG8_SB(1, 0), cB + kstep, voffB); PG8_STAGE(PG8_SA(1, 0), cA + kstep, voffA); PG8_STAGE(PG8_SB(1, 1), cB + hstep + kstep, voffB);
        PG8_WAIT_V(6); PG8_BAR;
    }
    for (;;) {
        const bool has_next = S.next(ui + 1, nxt);
        const char* nA = has_next ? (const char*)g.A + (size_t)nxt.pm * tstep : cA; const char* nB = has_next ? (const char*)g.Bt + (size_t)nxt.pn * tstep : cB;
        for (int t = 0; t < nt; t += 2) {
            const bool last = (t == nt - 2);
            const char* a1 = cA + (size_t)(t + 1) * kstep;
            const char* a2 = last ? nA : cA + (size_t)(t + 2) * kstep; const char* b2 = last ? nB : cB + (size_t)(t + 2) * kstep;
            const char* a3 = a2 + kstep; const char* b3 = b2 + kstep;
            if (last && has_next) S.a_ready(nxt);
            if constexpr (SP2) {
            PG8_LDB(B0, 0, 0); PG8_LDB(B1, 0, 1); PG8_SCHED; PG8_LDA(At, 0, 0); PG8_STAGE(PG8_SA(1, 1), a1 + hstep, voffA);
            PG8_WAIT_V(8); PG8_WAIT_L(0); PG8_BAR; PG8_MMA(0, 0, At, B0); PG8_MMA(0, 1, At, B1); PG8_BAR; PG8_SCHED;
            PG8_LDA(At, 0, 1); PG8_STAGE(PG8_SB(0, 0), b2, voffB); PG8_STAGE(PG8_SB(0, 1), b2 + hstep, voffB); PG8_STAGE(PG8_SA(0, 0), a2, voffA);
            PG8_WAIT_V(8); PG8_WAIT_L(0); PG8_BAR; PG8_MMA(1, 0, At, B0); PG8_MMA(1, 1, At, B1); PG8_BAR; PG8_SCHED;
            PG8_LDB(B0, 1, 0); PG8_LDB(B1, 1, 1); PG8_SCHED; PG8_LDA(At, 1, 0); PG8_STAGE(PG8_SA(0, 1), a2 + hstep, voffA);
            PG8_WAIT_V(8); PG8_WAIT_L(0); PG8_BAR; PG8_MMA(0, 0, At, B0); PG8_MMA(0, 1, At, B1); PG8_BAR; PG8_SCHED;
            PG8_LDA(At, 1, 1); PG8_STAGE(PG8_SB(1, 0), b3, voffB); PG8_STAGE(PG8_SB(1, 1), b3 + hstep, voffB); PG8_STAGE(PG8_SA(1, 0), a3, voffA);
            PG8_WAIT_V(8); PG8_WAIT_L(0); PG8_BAR; PG8_MMA(1, 0, At, B0); PG8_MMA(1, 1, At, B1); PG8_BAR; PG8_SCHED;
            } else {
            PG8_LDB(B0, 0, 0); PG8_SCHED; PG8_LDA(At, 0, 0); PG8_STAGE(PG8_SA(1, 1), a1 + hstep, voffA);
            PG8_WAIT_L(8); PG8_BAR; PG8_WAIT_L(0); PG8_MMA(0, 0, At, B0); PG8_BAR; PG8_SCHED;
            PG8_LDB(B1, 0, 1); PG8_STAGE(PG8_SB(0, 0), b2, voffB);
            PG8_BAR; PG8_WAIT_L(0); PG8_MMA(0, 1, At, B1); PG8_BAR;
            PG8_LDA(At, 0, 1); PG8_STAGE(PG8_SA(0, 0), a2, voffA);
            PG8_BAR; PG8_WAIT_L(0); PG8_MMA(1, 0, At, B0); PG8_BAR; PG8_SCHED;
            PG8_STAGE(PG8_SB(0, 1), b2 + hstep, voffB);
            PG8_WAIT_V(6); PG8_BAR; PG8_MMA(1, 1, At, B1); PG8_BAR;
            PG8_LDB(B0, 1, 0); PG8_SCHED; PG8_LDA(At, 1, 0); PG8_STAGE(PG8_SA(0, 1), a2 + hstep, voffA);
            PG8_WAIT_L(8); PG8_BAR; PG8_WAIT_L(0); PG8_MMA(0, 0, At, B0); PG8_BAR; PG8_SCHED;
            PG8_LDB(B1, 1, 1); PG8_STAGE(PG8_SB(1, 0), b3, voffB);
            PG8_BAR; PG8_WAIT_L(0); PG8_MMA(0, 1, At, B1); PG8_BAR;
            PG8_LDA(At, 1, 1); PG8_STAGE(PG8_SA(1, 0), a3, voffA);
            PG8_BAR; PG8_WAIT_L(0); PG8_MMA(1, 0, At, B0); PG8_BAR; PG8_SCHED;
            PG8_STAGE(PG8_SB(1, 1), b3 + hstep, voffB);
            PG8_WAIT_V(6); PG8_BAR; PG8_MMA(1, 1, At, B1); PG8_BAR;
            }
        }
        if constexpr (ALIGN_EPI) { if (wr == 0) PG8_BAR; }
        if constexpr (!Epi::AFTER_DRAIN) { E(acc, cur, wr, wc, fr, fq); S.done(cur); }
        if (!has_next) break;
#pragma unroll
        for (int a = 0; a < 2; ++a)
#pragma unroll
            for (int b = 0; b < 2; ++b)
#pragma unroll
                for (int m = 0; m < 4; ++m)
#pragma unroll
                    for (int n = 0; n < 2; ++n) acc[a][b][m][n] = (f32x4){0.f, 0.f, 0.f, 0.f};
        cur = nxt; cA = nA; cB = nB; ++ui;
        if constexpr (ALIGN_EPI) { if (wr == 1) PG8_BAR; }
    }
    PG8_WAIT_V(0);
    if constexpr (!ALIGN_EPI) { if (wr == 0) PG8_BAR; }
    PG8_BAR;
    if constexpr (Epi::AFTER_DRAIN) { E.fused(acc, cur, wr, wc, fr, fq, lds, wid, lane); S.done(cur); }
#undef PG8_SA
#undef PG8_SB
#undef PG8_STAGE
#undef PG8_LDA
#undef PG8_LDB
#undef PG8_MMA
#undef PG8_WAIT_V
#undef PG8_WAIT_L
#undef PG8_BAR
#undef PG8_SCHED
}
}
namespace pg8 {
struct EpiProj {
    static constexpr bool PERM = true, AFTER_DRAIN = false;
    bf16_t* O; int ldc; int gelu_tiles;
    __device__ __forceinline__ void operator()(const f32x4 (&acc)[2][2][4][2], const Unit& u, int wr, int wc, int fr, int fq) const {
        const int row0 = u.pm * BM + wr * 64 + fr; const int col0 = u.pn * BM + wc * 32 + 8 * fq;
        const bool act = u.pn < gelu_tiles;
#pragma unroll
        for (int ai = 0; ai < 2; ++ai)
#pragma unroll
            for (int m = 0; m < 4; ++m) { bf16_t* rowp = O + (size_t)(row0 + ai * HALF + m * 16) * ldc + col0;
#pragma unroll
                for (int bj = 0; bj < 2; ++bj) { f32x4 v0 = acc[ai][bj][m][0], v1 = acc[ai][bj][m][1];
                    if (act) { f32x2 a = gelu_pk((f32x2){v0[0], v0[1]}), b = gelu_pk((f32x2){v0[2], v0[3]}), c = gelu_pk((f32x2){v1[0], v1[1]}), d = gelu_pk((f32x2){v1[2], v1[3]});
                        v0 = (f32x4){a.x, a.y, b.x, b.y}; v1 = (f32x4){c.x, c.y, d.x, d.y}; }
                    u32x4 w; w.x = cvt_pk_bf16(v0[0], v0[1]); w.y = cvt_pk_bf16(v0[2], v0[3]); w.z = cvt_pk_bf16(v1[0], v1[1]); w.w = cvt_pk_bf16(v1[2], v1[3]);
                    *(u32x4*)(rowp + bj * HALF) = w; } }
    }
};
struct EpiResid {
    static constexpr bool PERM = false, AFTER_DRAIN = false;
    const float* base; const float* gate; float* out; int ldc;
    __device__ __forceinline__ void operator()(const f32x4 (&acc)[2][2][4][2], const Unit& u, int wr, int wc, int fr, int fq) const {
        const int row0 = u.pm * BM + wr * 64 + fr, col0 = u.pn * BM + wc * 32 + 4 * fq;
        f32x4 gv[2][2];
#pragma unroll
        for (int bj = 0; bj < 2; ++bj)
#pragma unroll
            for (int n = 0; n < 2; ++n) gv[bj][n] = *(const f32x4*)(gate + col0 + bj * HALF + n * 16);
#pragma unroll
        for (int ai = 0; ai < 2; ++ai)
#pragma unroll
            for (int m = 0; m < 4; ++m) { const size_t off = (size_t)(row0 + ai * HALF + m * 16) * ldc + col0;
#pragma unroll
                for (int bj = 0; bj < 2; ++bj)
#pragma unroll
                    for (int n = 0; n < 2; ++n) { const f32x4 b = *(const f32x4*)(base + off + bj * HALF + n * 16); *(f32x4*)(out + off + bj * HALF + n * 16) = b + gv[bj][n] * acc[ai][bj][m][n]; } }
    }
};
struct EpiQ8 {
    static constexpr bool PERM = true, AFTER_DRAIN = false;
    bf16_t* O; int ldc; int gelu_tiles; const float* rs; const float* cs; int nt;
    __device__ __forceinline__ void operator()(const f32x4 (&acc)[2][2][4][2], const Unit& u, int wr, int wc, int fr, int fq) const {
        const int row0 = u.pm * BM + wr * 64 + fr; const int col0 = u.pn * BM + wc * 32 + 8 * fq;
        const bool act = u.pn < gelu_tiles;
        f32x4 cv[2][2];
#pragma unroll
        for (int bj = 0; bj < 2; ++bj)
#pragma unroll
            for (int n = 0; n < 2; ++n) cv[bj][n] = *(const f32x4*)(cs + col0 + bj * HALF + 4 * n);
        float rsv[2][4];
#pragma unroll
        for (int ai = 0; ai < 2; ++ai)
#pragma unroll
            for (int m = 0; m < 4; ++m) rsv[ai][m] = rs[row0 + ai * HALF + m * 16];
#pragma unroll
        for (int ai = 0; ai < 2; ++ai)
#pragma unroll
            for (int m = 0; m < 4; ++m) { const int row = row0 + ai * HALF + m * 16; const float rsc = rsv[ai][m]; bf16_t* rowp = O + (size_t)row * ldc + col0;
#pragma unroll
                for (int bj = 0; bj < 2; ++bj) { const i32x4 a0 = __builtin_bit_cast(i32x4, acc[ai][bj][m][0]), a1 = __builtin_bit_cast(i32x4, acc[ai][bj][m][1]);
                    f32x4 v0 = (f32x4){(float)a0[0], (float)a0[1], (float)a0[2], (float)a0[3]} * rsc * cv[bj][0], v1 = (f32x4){(float)a1[0], (float)a1[1], (float)a1[2], (float)a1[3]} * rsc * cv[bj][1];
                    if (act) { f32x2 a = gelu_pk((f32x2){v0[0], v0[1]}), b = gelu_pk((f32x2){v0[2], v0[3]}), c = gelu_pk((f32x2){v1[0], v1[1]}), d = gelu_pk((f32x2){v1[2], v1[3]});
                        v0 = (f32x4){a.x, a.y, b.x, b.y}; v1 = (f32x4){c.x, c.y, d.x, d.y}; }
                    u32x4 w; w.x = cvt_pk_bf16(v0[0], v0[1]); w.y = cvt_pk_bf16(v0[2], v0[3]); w.z = cvt_pk_bf16(v1[0], v1[1]); w.w = cvt_pk_bf16(v1[2], v1[3]);
                    if (nt) __builtin_nontemporal_store(w, (u32x4*)(rowp + bj * HALF)); else *(u32x4*)(rowp + bj * HALF) = w; } }
    }
};
struct EpiResid2 {
    static constexpr bool PERM = true, AFTER_DRAIN = false;
    const bf16_t* base; const float* gate; bf16_t* xb; float* ssq; int ldc; const float* rs; const float* cs;
    __device__ __forceinline__ void operator()(const f32x4 (&acc)[2][2][4][2], const Unit& u, int wr, int wc, int fr, int fq) const {
        const int row0 = u.pm * BM + wr * 64 + fr, col0 = u.pn * BM + wc * 32 + 8 * fq;
        f32x4 gv[2][2];
#pragma unroll
        for (int bj = 0; bj < 2; ++bj)
#pragma unroll
            for (int n = 0; n < 2; ++n) gv[bj][n] = *(const f32x4*)(gate + col0 + bj * HALF + 4 * n) * *(const f32x4*)(cs + col0 + bj * HALF + 4 * n);
        float rsv[2][4];
#pragma unroll
        for (int ai = 0; ai < 2; ++ai)
#pragma unroll
            for (int m = 0; m < 4; ++m) rsv[ai][m] = rs[row0 + ai * HALF + m * 16];
#pragma unroll
        for (int ai = 0; ai < 2; ++ai) {
            u32x4 bwv[4][2];
#pragma unroll
            for (int m = 0; m < 4; ++m)
#pragma unroll
                for (int bj = 0; bj < 2; ++bj) bwv[m][bj] = __builtin_nontemporal_load((const u32x4*)(base + (size_t)(row0 + ai * HALF + m * 16) * ldc + col0 + bj * HALF));
#pragma unroll
            for (int m = 0; m < 4; ++m) { const int row = row0 + ai * HALF + m * 16; const size_t off = (size_t)row * ldc + col0; const float rsc = rsv[ai][m];
#pragma unroll
                for (int bj = 0; bj < 2; ++bj) {
                    const u32x4 bw = bwv[m][bj];
                    const f32x4 b0 = {__uint_as_float(bw.x << 16), __uint_as_float(bw.x & 0xffff0000u), __uint_as_float(bw.y << 16), __uint_as_float(bw.y & 0xffff0000u)};
                    const f32x4 b1 = {__uint_as_float(bw.z << 16), __uint_as_float(bw.z & 0xffff0000u), __uint_as_float(bw.w << 16), __uint_as_float(bw.w & 0xffff0000u)};
                    const i32x4 a0 = __builtin_bit_cast(i32x4, acc[ai][bj][m][0]), a1 = __builtin_bit_cast(i32x4, acc[ai][bj][m][1]);
                    const f32x4 v0 = b0 + gv[bj][0] * ((f32x4){(float)a0[0], (float)a0[1], (float)a0[2], (float)a0[3]} * rsc), v1 = b1 + gv[bj][1] * ((f32x4){(float)a1[0], (float)a1[1], (float)a1[2], (float)a1[3]} * rsc);
                    u32x4 w; w.x = cvt_pk_bf16(v0[0], v0[1]); w.y = cvt_pk_bf16(v0[2], v0[3]); w.z = cvt_pk_bf16(v1[0], v1[1]); w.w = cvt_pk_bf16(v1[2], v1[3]);
                    *(u32x4*)(xb + off + bj * HALF) = w; }
                }
        }
    }
};
struct EpiQ {
    static constexpr bool PERM = true, AFTER_DRAIN = false;
    bf16_t* O; int ldc; const float* bias; const PG8_LAS float* rstd;
    __device__ __forceinline__ void operator()(const f32x4 (&acc)[2][2][4][2], const Unit& u, int wr, int wc, int fr, int fq) const {
        const int lrow0 = wr * 64 + fr, col0 = u.pn * BM + wc * 32 + 8 * fq;
        f32x4 bv[2][2];
#pragma unroll
        for (int bj = 0; bj < 2; ++bj)
#pragma unroll
            for (int n = 0; n < 2; ++n) bv[bj][n] = *(const f32x4*)(bias + col0 + bj * HALF + 4 * n);
#pragma unroll
        for (int ai = 0; ai < 2; ++ai)
#pragma unroll
            for (int m = 0; m < 4; ++m) { const int lrow = lrow0 + ai * HALF + m * 16; const float rs = rstd[(u.pm & 1) * BM + lrow];
                bf16_t* rowp = O + (size_t)(u.pm * BM + lrow) * ldc + col0;
#pragma unroll
                for (int bj = 0; bj < 2; ++bj) { const f32x4 v0 = acc[ai][bj][m][0] * rs + bv[bj][0], v1 = acc[ai][bj][m][1] * rs + bv[bj][1];
                    u32x4 w; w.x = cvt_pk_bf16(v0[0], v0[1]); w.y = cvt_pk_bf16(v0[2], v0[3]); w.z = cvt_pk_bf16(v1[0], v1[1]); w.w = cvt_pk_bf16(v1[2], v1[3]);
                    *(u32x4*)(rowp + bj * HALF) = w; } }
    }
};
}
#ifndef PG8_SP2
#define PG8_SP2 true
#endif
#ifndef PG8_ALIGN
#define PG8_ALIGN true
#endif
constexpr int NWAVES = 8;
constexpr int M = 16384, D = 2048;
constexpr int IN_COLS = 6152, NWIN = 6144, NPROJ = 5120;
constexpr int C_UG = 0, C_VG = 1024, C_Q = 2048, C_K = 3072, C_OM = 4096;
constexpr int WROW_VM = 5120;
constexpr int NHEAD = 4, DH = 256, CH = 128, NCHUNK = M / CH;
constexpr int NEXP = 16384, PH = 8, TOPK = 16, NSEL = PH * TOPK;
constexpr float EPS = 1e-6f;
constexpr int MOD_SHM = 0, MOD_SCM = 2048, MOD_GM = 4096, MOD_SHF = 6144, MOD_SCF = 8192, MOD_GF = 10240, NMOD = 12288;
constexpr int ADA_KC = 16, ADA_KROWS = D / ADA_KC;

constexpr size_t MiB = 1u << 20;
constexpr size_t WS_CTL = 0, CTL_ZERO_BYTES = 1 * MiB;
constexpr size_t WS_MODP = 1 * MiB;
constexpr size_t WS_MODF = WS_MODP + (size_t)ADA_KC * NMOD * 4;
constexpr size_t WS_GATES = 2 * MiB;
constexpr size_t WS_SUMM = 2 * MiB + 512 * 1024;
constexpr size_t WS_MTAB = WS_SUMM + 8192;
constexpr size_t WS_NST = 3 * MiB;
constexpr size_t WS_WIN = 4 * MiB;
constexpr size_t WS_WOUT = 28 * MiB;
constexpr size_t WS_WQ = 36 * MiB;
constexpr size_t WS_IDX = 44 * MiB;
constexpr size_t WS_PG = 52 * MiB;
constexpr size_t WS_SSQP = 60 * MiB;
constexpr size_t WS_BQP = 62 * MiB, WS_BIASQ = 62 * MiB + 512 * 1024;
constexpr size_t WS_SW = 62 * MiB + 768 * 1024;
constexpr size_t WS_CMAXP = 63 * MiB;
constexpr size_t WS_SA = 3 * MiB + 512 * 1024 + 131072;
constexpr size_t WS_HA = 64 * MiB;
constexpr size_t WS_PROJ = 128 * MiB;
constexpr size_t WS_VT = 288 * MiB;
constexpr size_t WS_X1 = 192 * MiB;
constexpr size_t WS_STATE = 320 * MiB;
constexpr size_t WS_XB = 448 * MiB;
constexpr size_t WS_ED = 384 * MiB, WS_EU = 416 * MiB;
constexpr size_t WS_SD = 3 * MiB + 512 * 1024, WS_SU = WS_SD + 65536;
constexpr size_t WS_END = 512 * MiB;
constexpr int CW_TMO = 0, CW_CODE = 1, CW_BAR = 4096;

constexpr int RING_BYTES = 131072, LDSCTL_OFF = 163328, MISC_OFF = LDSCTL_OFF + 320, LDS_BYTES = 163840;

#define GAS __attribute__((address_space(1)))
#define LAS __attribute__((address_space(3)))
#define DI __device__ __forceinline__
typedef unsigned short bf16;
typedef unsigned v4u __attribute__((ext_vector_type(4)));
typedef unsigned v2u __attribute__((ext_vector_type(2)));
typedef float f32x4 __attribute__((ext_vector_type(4)));
typedef float f32x16 __attribute__((ext_vector_type(16)));
typedef short bf16x8 __attribute__((ext_vector_type(8)));
typedef GAS unsigned gu32;
#define RLX_AGENT __ATOMIC_RELAXED, __HIP_MEMORY_SCOPE_AGENT
#define LDS_WAIT() asm volatile("s_waitcnt lgkmcnt(0)" ::: "memory")
#define VM_WAIT() asm volatile("s_waitcnt vmcnt(0)" ::: "memory")
#define MFMA32(a, b, c) __builtin_amdgcn_mfma_f32_32x32x16_bf16((a), (b), (c), 0, 0, 0)
DI unsigned f2bf(float f) { unsigned u = __builtin_bit_cast(unsigned, f); return (u + 0x7fffu + ((u >> 16) & 1u)) >> 16; }
DI unsigned pk2(float lo, float hi) { return f2bf(lo) | (f2bf(hi) << 16); }
DI float bflo(unsigned w) { return __builtin_bit_cast(float, w << 16); }
DI float bfhi(unsigned w) { return __builtin_bit_cast(float, w & 0xffff0000u); }
DI float bf2f(unsigned short h) { return __builtin_bit_cast(float, (unsigned)h << 16); }
DI int crow(int reg, int h) { return (reg & 3) + 8 * (reg >> 2) + 4 * h; }
DI float wave_sum(float v) {
#pragma unroll
    for (int o = 1; o < 64; o <<= 1) v += __shfl_xor(v, o);
    return v;
}
DI float wave_max(float v) {
#pragma unroll
    for (int o = 1; o < 64; o <<= 1) v = fmaxf(v, __shfl_xor(v, o));
    return v;
}
DI float silu_f(float v) { return v * __builtin_amdgcn_rcpf(1.0f + __expf(-v)); }
DI float sigmoid_f(float v) { return __builtin_amdgcn_rcpf(1.0f + __expf(-v)); }
DI float gelu_f(float v) { return 0.5f * v * (1.0f + erff(v * 0.70710678118654752f)); }
typedef __bf16 bf16v2 __attribute__((ext_vector_type(2)));
#define DOT2(a, b, c) __builtin_amdgcn_fdot2_f32_bf16(__builtin_bit_cast(bf16v2, (unsigned)(a)), __builtin_bit_cast(bf16v2, (unsigned)(b)), (c), false)
DI f32x16 zero16() { f32x16 z; for (int i = 0; i < 16; ++i) z[i] = 0.f; return z; }
#define XB_TMO      128
#define XB_XCNT(j)  (256  + 64 * (j))
#define XB_XSUB(j)  (1280 + 64 * (j))
#define XB_XGEN(j)  (2304 + 64 * (j))
#define XB_TOP      3328
#define XB_TOPGEN   3392
#define XCD_BAR_WORDS 3456
#define XB_SPIN_CAP (1u << 18)

__device__ __forceinline__ unsigned xb_ld(unsigned* p)              { return __hip_atomic_load(p, __ATOMIC_RELAXED, __HIP_MEMORY_SCOPE_AGENT); }
__device__ __forceinline__ unsigned xb_add(unsigned* p, unsigned v) { return __hip_atomic_fetch_add(p, v, __ATOMIC_RELAXED, __HIP_MEMORY_SCOPE_AGENT); }
__device__ __forceinline__ unsigned xb_xcc_id() { return (unsigned)__builtin_amdgcn_s_getreg((3 << 11) | 20) & 0xFu; }
#define XB_SPIN(cond, bar) do { unsigned _sp = 0; while (cond) { __builtin_amdgcn_s_sleep(1); \
    if ((++_sp & 255u) == 0u) { if (xb_ld(&(bar)[XB_TMO])) break; if (_sp > XB_SPIN_CAP) { atomicAdd(&(bar)[XB_TMO], 1u); break; } } } } while (0)

struct XcdBarrier {
    unsigned* bar; unsigned x;
    volatile LAS unsigned* st;
};

__device__ __forceinline__ XcdBarrier xcd_barrier_post(unsigned* bar, volatile LAS unsigned* st) {
    XcdBarrier b; b.bar = bar; b.x = xb_xcc_id(); b.st = st;
    if (threadIdx.x == 0) (void)xb_add(&bar[XB_XCNT(b.x)], 1u);
    return b;
}
__device__ __forceinline__ void xcd_barrier_complete(unsigned* bar, unsigned x, unsigned& nloc, unsigned& nx) {
    const unsigned G = gridDim.x * gridDim.y * gridDim.z;
    unsigned sum, cnt, mine, sp = 0u;
    for (;;) {
        sum = 0u; cnt = 0u; mine = 0u;
#pragma unroll
        for (unsigned j = 0; j < 16; ++j) { const unsigned c = xb_ld(&bar[XB_XCNT(j)]); sum += c; cnt += (c > 0u) ? 1u : 0u; mine = (j == x) ? c : mine; }
        if (sum == G) break;
        __builtin_amdgcn_s_sleep(1);
        if ((++sp & 255u) == 0u) { if (xb_ld(&bar[XB_TMO])) break; if (sp > XB_SPIN_CAP) { atomicAdd(&bar[XB_TMO], 1u); break; } }
    }
    nloc = mine > 0u ? mine : 1u; nx = cnt > 0u ? cnt : 1u;
}

__device__ __forceinline__ void xcd_barrier(const XcdBarrier& b) {
    asm volatile("s_waitcnt vmcnt(0)" ::: "memory");
    __syncthreads();
    if (threadIdx.x == 0) {
        unsigned* bar = b.bar;
        __builtin_amdgcn_s_waitcnt(0);
        unsigned nloc = b.st[0], nx = b.st[1];
        if (nloc == 0u) { xcd_barrier_complete(bar, b.x, nloc, nx); b.st[0] = nloc; b.st[1] = nx; }
        const unsigned old = xb_add(&bar[XB_XSUB(b.x)], 1u);
        const unsigned gen = old / nloc;
        if (old + 1u == (gen + 1u) * nloc) {
            __builtin_amdgcn_fence(__ATOMIC_RELEASE, "agent");
            asm volatile("s_waitcnt vmcnt(0)" ::: "memory");
            const unsigned og = xb_add(&bar[XB_TOP], 1u);
            const unsigned tg = og / nx;
            if (og + 1u == (tg + 1u) * nx) xb_add(&bar[XB_TOPGEN], 1u);
            else XB_SPIN(xb_ld(&bar[XB_TOPGEN]) == tg, bar);
            __builtin_amdgcn_fence(__ATOMIC_ACQUIRE, "agent");
            xb_add(&bar[XB_XGEN(b.x)], 1u);
            asm volatile("s_waitcnt vmcnt(0)" ::: "memory");
        } else {
            XB_SPIN(xb_ld(&bar[XB_XGEN(b.x)]) == gen, bar);
            __builtin_amdgcn_fence(__ATOMIC_ACQUIRE, "agent");
            asm volatile("s_waitcnt vmcnt(0)" ::: "memory");
        }
    }
    __syncthreads();
}
struct Frame {
    LAS unsigned char* lds;
    volatile LAS unsigned* MISC;
    gu32* ctl;
    int tid, lane, wave, vcu, G;
    const float *x, *c, *ada_w, *ada_b, *norm_mix_g, *w_in, *b_gates, *conv_w, *conv_b, *gmlp_norm_g, *gmlp_w, *gmlp_b, *mlstm_norm_g, *w_out, *norm_ffn_g,
                *wq, *keys1, *keys2, *e_down, *e_up, *final_g;
    float* out;
    float *MODP, *MODF, *GATES, *SUMM, *MTAB, *NST, *PG;
    int* IDX;
    bf16 *WIN, *WOUT, *WQ, *HA, *PROJ, *QB, *STATE, *QC, *KC, *VT;
    unsigned char *ED, *EU, *H1Q, *H2Q, *WQ8, *YQ, *WO8; float *SD, *SU, *CMAXQ, *SWQ, *SY, *CMAXO, *SWO; bf16* XB;
    float *SSQP, *BQP, *BIASQ, *SW, *CMAXP, *SA; bf16* X1B;
};

template <int N> DI void red32_f(float (&v)[16]) {
#pragma unroll
    for (int i = 0; i < N / 2; ++i) { const auto rr = __builtin_amdgcn_permlane32_swap(__float_as_uint(v[i]), __float_as_uint(v[i + N / 2]), false, false); v[i] = __uint_as_float(rr[0]) + __uint_as_float(rr[1]); }
}
template <int N> DI void red16_f(float (&v)[16]) {
#pragma unroll
    for (int i = 0; i < N / 2; ++i) { const auto rr = __builtin_amdgcn_permlane16_swap(__float_as_uint(v[i]), __float_as_uint(v[i + N / 2]), false, false); v[i] = __uint_as_float(rr[0]) + __uint_as_float(rr[1]); }
}
template <int N> DI void red8_f(float (&v)[16], int lane) {
#pragma unroll
    for (int i = 0; i < N / 2; ++i) { const bool up = (lane & 8) != 0; const float keep = up ? v[i + N / 2] : v[i], send = up ? v[i] : v[i + N / 2];
        v[i] = keep + __builtin_bit_cast(float, __builtin_amdgcn_mov_dpp(__builtin_bit_cast(int, send), 0x128, 0xf, 0xf, true)); }
}
template <int CTRL> DI float dpp_add(float v) { return v + __builtin_bit_cast(float, __builtin_amdgcn_mov_dpp(__builtin_bit_cast(int, v), CTRL, 0xf, 0xf, true)); }
template <int CTRL> DI float dpp_max(float v) { return fmaxf(v, __builtin_bit_cast(float, __builtin_amdgcn_mov_dpp(__builtin_bit_cast(int, v), CTRL, 0xf, 0xf, true))); }
DI float red2_sum(float a, float b) {
    const auto r = __builtin_amdgcn_permlane32_swap(__float_as_uint(a), __float_as_uint(b), false, false); float s = __uint_as_float(r[0]) + __uint_as_float(r[1]);
    const auto q = __builtin_amdgcn_permlane16_swap(__float_as_uint(s), __float_as_uint(s), false, false); s = __uint_as_float(q[0]) + __uint_as_float(q[1]);
    s = dpp_add<0x128>(s); s = dpp_add<0x141>(s); s = dpp_add<0xB1>(s); s = dpp_add<0x4E>(s); return s;
}
DI float red2_max(float a, float b) {
    const auto r = __builtin_amdgcn_permlane32_swap(__float_as_uint(a), __float_as_uint(b), false, false); float s = fmaxf(__uint_as_float(r[0]), __uint_as_float(r[1]));
    const auto q = __builtin_amdgcn_permlane16_swap(__float_as_uint(s), __float_as_uint(s), false, false); s = fmaxf(__uint_as_float(q[0]), __uint_as_float(q[1]));
    s = dpp_max<0x128>(s); s = dpp_max<0x141>(s); s = dpp_max<0xB1>(s); s = dpp_max<0x4E>(s); return s;
}
DI float lane_bcast(float v, int l) { return __uint_as_float((unsigned)__builtin_amdgcn_readlane((int)__float_as_uint(v), l)); }
DI void p0_transpose_item(const float* W, int K, int ldw, int nblk, bf16* WT, LAS float* scr, int item, int lane, bool vm_last = false) {
    const int kb = item / nblk, nb = item % nblk, k0 = 64 * kb, n0 = 32 * nb;
    const int d0 = !vm_last ? n0 : (n0 < 4096 ? n0 : (n0 < 5120 ? n0 + 1024 : n0 - 1024));
#pragma unroll 8
    for (int i = 0; i < 32; ++i) { const int kk = 2 * i + (lane >> 5); scr[kk * 33 + (lane & 31)] = __builtin_nontemporal_load(W + (size_t)(k0 + kk) * ldw + n0 + (lane & 31)); }
    LDS_WAIT(); asm volatile("" ::: "memory");
    const int c = lane & 7;
#pragma unroll
    for (int j = 0; j < 4; ++j) { const int n = (lane >> 3) + 8 * j; const LAS float* s = scr + (8 * c) * 33 + n;
        v4u o; o.x = pk2(s[0 * 33], s[1 * 33]); o.y = pk2(s[2 * 33], s[3 * 33]); o.z = pk2(s[4 * 33], s[5 * 33]); o.w = pk2(s[6 * 33], s[7 * 33]);
        *(GAS v4u*)(WT + (size_t)(d0 + n) * K + k0 + 8 * c) = o; }
    LDS_WAIT(); asm volatile("" ::: "memory");
}
DI void p0_colmaxq_item(Frame& F, int item) {
    const int lane = F.lane, nblk = D / 32, kb = item / nblk, nb = item % nblk, k0 = 64 * kb, n0 = 32 * nb;
    float m = 0.f;
#pragma unroll 8
    for (int i = 0; i < 32; ++i) { const int kk = 2 * i + (lane >> 5); m = fmaxf(m, fabsf(F.wq[(size_t)(k0 + kk) * D + n0 + (lane & 31)])); }
    m = fmaxf(m, __shfl_xor(m, 32));
    if (lane < 32) F.CMAXQ[(size_t)kb * D + n0 + lane] = m;
}
DI void p0_colmaxo_item(Frame& F, int item) {
    const int lane = F.lane, nblk = D / 32, kb = item / nblk, nb = item % nblk, k0 = 64 * kb, n0 = 32 * nb;
    float m = 0.f;
#pragma unroll 8
    for (int i = 0; i < 32; ++i) { const int kk = 2 * i + (lane >> 5); m = fmaxf(m, fabsf(F.w_out[(size_t)(k0 + kk) * D + n0 + (lane & 31)])); }
    m = fmaxf(m, __shfl_xor(m, 32));
    if (lane < 32) F.CMAXO[(size_t)kb * D + n0 + lane] = m;
}
DI void p0_colmax_item(Frame& F, int item) {
    const int lane = F.lane, nblk = NWIN / 32, kb = item / nblk, nb = item % nblk, k0 = 64 * kb, n0 = 32 * nb;
    float m = 0.f;
#pragma unroll 8
    for (int i = 0; i < 32; ++i) { const int kk = 2 * i + (lane >> 5); m = fmaxf(m, fabsf(__builtin_nontemporal_load(F.w_in + (size_t)(k0 + kk) * IN_COLS + n0 + (lane & 31)))); }
    m = fmaxf(m, __shfl_xor(m, 32));
    if (lane < 32) F.CMAXP[(size_t)kb * NWIN + n0 + lane] = m;
}
DI void p0_ada_item(Frame& F, LAS float* scr, int item) {
    const int cc = item % (NMOD / 256), kc = item / (NMOD / 256), k0 = kc * ADA_KROWS, col = cc * 256 + F.lane * 4;
#pragma unroll
    for (int j = 0; j < ADA_KROWS / 64; ++j) scr[F.lane + 64 * j] = silu_f(F.c[k0 + F.lane + 64 * j]);
    LDS_WAIT(); asm volatile("" ::: "memory");
    f32x4 acc = {0.f, 0.f, 0.f, 0.f};
    const float* wp = F.ada_w + (size_t)k0 * NMOD + col;
#pragma unroll 8
    for (int kk = 0; kk < ADA_KROWS; ++kk) { const float s = scr[kk]; const f32x4 w = __builtin_nontemporal_load((const GAS f32x4*)(wp + (size_t)kk * NMOD)); acc += w * s; }
    *(GAS f32x4*)(F.MODP + (size_t)kc * NMOD + col) = acc;
    LDS_WAIT(); asm volatile("" ::: "memory");
}
DI void p0a_phase(Frame& F) {
    LAS float* scr = (LAS float*)(F.lds + F.wave * 16384);
    const int gw = F.wave * F.G + F.vcu, NGW = F.G * NWAVES;
    constexpr int I_ADA = (NMOD / 256) * ADA_KC;
    constexpr int I_WIN = (D / 64) * (NWIN / 32), I_WO = (D / 64) * (D / 32);
    constexpr int NSMALL = I_WIN + I_WO + I_WO;
    const int nB = NGW - I_ADA;
    for (int it = gw; it < I_ADA; it += NGW) p0_ada_item(F, scr, it);
    if (nB <= 0 || gw >= I_ADA) {
        for (int r0 = nB > 0 ? gw - I_ADA : gw; r0 < NSMALL; r0 += nB > 0 ? nB : NGW) {
            int r = r0;
            if (r < I_WIN) { p0_colmax_item(F, r); continue; } r -= I_WIN;
            if (r < I_WO) { p0_colmaxo_item(F, r); continue; } r -= I_WO;
            p0_colmaxq_item(F, r);
        }
    }
}
DI float mod_final(Frame& F, int col) { float s = F.ada_b[col];
#pragma unroll
    for (int k = 0; k < ADA_KC; ++k) s += F.MODP[(size_t)k * NMOD + col];
    return s; }
DI void norm_tables(Frame& F, const float* g, int col_scale, int col_shift) {
    LAS float* A1 = (LAS float*)(F.lds); LAS float* B1 = (LAS float*)(F.lds + 8192);
#pragma unroll
    for (int i = 0; i < 4; ++i) { const int c = F.tid + 512 * i; A1[c] = g[c] * (1.0f + F.MODF[col_scale + c]); B1[c] = F.MODF[col_shift + c]; }
}
template <bool WO = false> DI void wq_issue(Frame& F, int item, float (&t)[32], float& m) {
    const int lane = F.lane, nblk = D / 32, kb = item / nblk, nb = item % nblk, k0 = 64 * kb, n0 = 32 * nb;
    float cm[16];
    const float* cp = (WO ? F.CMAXO : F.CMAXQ) + (size_t)(lane >> 5) * D + n0 + (lane & 31);
    const float* wp = (WO ? F.w_out : F.wq) + (size_t)(k0 + (lane >> 5)) * D + n0 + (lane & 31);
#pragma unroll
    for (int q = 0; q < 16; ++q) cm[q] = cp[(size_t)(2 * q) * D];
#pragma unroll
    for (int i = 0; i < 32; ++i) t[i] = __builtin_nontemporal_load(wp + (size_t)(2 * i) * D);
    m = 0.f;
#pragma unroll
    for (int q = 0; q < 16; ++q) m = fmaxf(m, cm[q]);
}
template <bool WO = false> DI void wq_finish(Frame& F, LAS float* scr, int item, const float (&t)[32], float m) {
    const int lane = F.lane, nblk = D / 32, kb = item / nblk, nb = item % nblk, k0 = 64 * kb, n0 = 32 * nb;
    LAS float* inv = scr + 64 * 33;
    m = fmaxf(m, __shfl_xor(m, 32)); m = fmaxf(m, 1e-30f);
    if (lane < 32) { inv[lane] = 127.0f / m; if (kb == 0) (WO ? F.SWO : F.SWQ)[n0 + lane] = m * (1.0f / 127.0f); }
#pragma unroll
    for (int i = 0; i < 32; ++i) scr[(2 * i + (lane >> 5)) * 33 + (lane & 31)] = t[i];
    LDS_WAIT(); asm volatile("" ::: "memory");
#pragma unroll
    for (int i = 0; i < 2; ++i) { const int q = lane + 64 * i, n = q >> 2, c = q & 3; const float iv = inv[n]; const LAS float* sp = scr + (16 * c) * 33 + n; v4u o;
#pragma unroll
        for (int w = 0; w < 4; ++w) { const int q0 = (int)__builtin_rintf(sp[(4 * w) * 33] * iv), q1 = (int)__builtin_rintf(sp[(4 * w + 1) * 33] * iv), q2 = (int)__builtin_rintf(sp[(4 * w + 2) * 33] * iv), q3 = (int)__builtin_rintf(sp[(4 * w + 3) * 33] * iv);
            o[w] = (unsigned)(q0 & 255) | ((unsigned)(q1 & 255) << 8) | ((unsigned)(q2 & 255) << 16) | ((unsigned)(q3 & 255) << 24); }
        *(GAS v4u*)((WO ? F.WO8 : F.WQ8) + (size_t)(n0 + n) * D + k0 + 16 * c) = o; }
    LDS_WAIT(); asm volatile("" ::: "memory");
}
DI void p0_winq_item(Frame& F, LAS float* scr, int item) {
    const int lane = F.lane, nblk = NWIN / 32, kb = item / nblk, nb = item % nblk, k0 = 64 * kb, n0 = 32 * nb;
    const int d0 = n0 < 4096 ? n0 : (n0 < 5120 ? n0 + 1024 : n0 - 1024);
    LAS float* inv = scr + 64 * 33;
    {
        float cm[16], t[32];
        const float* cp = F.CMAXP + (size_t)(lane >> 5) * NWIN + n0 + (lane & 31);
        const float* wp = F.w_in + (size_t)(k0 + (lane >> 5)) * IN_COLS + n0 + (lane & 31);
#pragma unroll
        for (int q = 0; q < 16; ++q) cm[q] = cp[(size_t)(2 * q) * NWIN];
#pragma unroll
        for (int i = 0; i < 32; ++i) t[i] = __builtin_nontemporal_load(wp + (size_t)(2 * i) * IN_COLS);
        float m = 0.f;
#pragma unroll
        for (int q = 0; q < 16; ++q) m = fmaxf(m, cm[q]);
        m = fmaxf(m, __shfl_xor(m, 32)); m = fmaxf(m, 1e-30f);
        if (lane < 32) { inv[lane] = 127.0f / m; if (kb == 0) F.SW[d0 + lane] = m * (1.0f / 127.0f); }
#pragma unroll
        for (int i = 0; i < 32; ++i) scr[(2 * i + (lane >> 5)) * 33 + (lane & 31)] = t[i];
    }
    LDS_WAIT(); asm volatile("" ::: "memory");
    unsigned char* WQ = (unsigned char*)F.WIN;
#pragma unroll
    for (int i = 0; i < 2; ++i) { const int q = lane + 64 * i, n = q >> 2, c = q & 3; const float iv = inv[n]; const LAS float* sp = scr + (16 * c) * 33 + n; v4u o;
#pragma unroll
        for (int w = 0; w < 4; ++w) { const int q0 = (int)__builtin_rintf(sp[(4 * w) * 33] * iv), q1 = (int)__builtin_rintf(sp[(4 * w + 1) * 33] * iv), q2 = (int)__builtin_rintf(sp[(4 * w + 2) * 33] * iv), q3 = (int)__builtin_rintf(sp[(4 * w + 3) * 33] * iv);
            o[w] = (unsigned)(q0 & 255) | ((unsigned)(q1 & 255) << 8) | ((unsigned)(q2 & 255) << 16) | ((unsigned)(q3 & 255) << 24); }
        *(GAS v4u*)(WQ + (size_t)(d0 + n) * D + k0 + 16 * c) = o; }
    LDS_WAIT(); asm volatile("" ::: "memory");
}
DI void p0b_phase(Frame& F) {
    LAS float* A1 = (LAS float*)(F.lds); LAS float* B1 = (LAS float*)(F.lds + 8192); LAS float* WG = (LAS float*)(F.lds + 16384);
    f32x4 vn0[8], vn1[8];
    { const GAS f32x4* xr = (const GAS f32x4*)(F.x + (size_t)(2 * (F.vcu * NWAVES + F.wave)) * D) + F.lane;
#pragma unroll
      for (int j = 0; j < 8; ++j) { vn0[j] = __builtin_nontemporal_load(xr + 64 * j); vn1[j] = __builtin_nontemporal_load(xr + 512 + 64 * j); } }
#pragma unroll
    for (int i = 0; i < 4; ++i) { const int c = F.tid + 512 * i; A1[c] = F.norm_mix_g[c] * (1.0f + mod_final(F, MOD_SCM + c)); B1[c] = mod_final(F, MOD_SHM + c); }
    { const int per = (NMOD + F.G - 1) / F.G; const int c = (int)blockIdx.x * per + F.tid; if (F.tid < per && c < NMOD) F.MODF[c] = mod_final(F, c); }
#pragma unroll
    for (int i = 0; i < 4; ++i) { const int k = F.tid + 512 * i; const f32x4 a = *(const GAS f32x4*)(F.w_in + (size_t)k * IN_COLS + NWIN), b = *(const GAS f32x4*)(F.w_in + (size_t)k * IN_COLS + NWIN + 4);
        WG[0 * 2048 + k] = a.x; WG[1 * 2048 + k] = a.y; WG[2 * 2048 + k] = a.z; WG[3 * 2048 + k] = a.w; WG[4 * 2048 + k] = b.x; WG[5 * 2048 + k] = b.y; WG[6 * 2048 + k] = b.z; WG[7 * 2048 + k] = b.w; }
    __syncthreads();
    const int gw = F.vcu * NWAVES + F.wave, NGW = F.G * NWAVES;
    const float bgate = F.b_gates[F.lane >> 3];
#pragma unroll 1
    for (int row = 2 * gw; row < M; row += 2 * NGW) {
        f32x4 v0[8], v1[8]; float ss0 = 0.f, ss1 = 0.f;
#pragma unroll
        for (int j = 0; j < 8; ++j) { v0[j] = vn0[j]; ss0 += (v0[j].x * v0[j].x + v0[j].y * v0[j].y) + (v0[j].z * v0[j].z + v0[j].w * v0[j].w);
                                      v1[j] = vn1[j]; ss1 += (v1[j].x * v1[j].x + v1[j].y * v1[j].y) + (v1[j].z * v1[j].z + v1[j].w * v1[j].w); }
        { GAS v2u* xb = (GAS v2u*)(F.XB + (size_t)row * D) + F.lane;
#pragma unroll
          for (int j = 0; j < 8; ++j) { v2u o; o.x = pk2(v0[j].x, v0[j].y); o.y = pk2(v0[j].z, v0[j].w); __builtin_nontemporal_store(o, xb + 64 * j);
                                        o.x = pk2(v1[j].x, v1[j].y); o.y = pk2(v1[j].z, v1[j].w); __builtin_nontemporal_store(o, xb + 512 + 64 * j); } }
        if (row + 2 * NGW < M) { const GAS f32x4* xr = (const GAS f32x4*)(F.x + (size_t)(row + 2 * NGW) * D) + F.lane;
#pragma unroll
            for (int j = 0; j < 8; ++j) { vn0[j] = __builtin_nontemporal_load(xr + 64 * j); vn1[j] = __builtin_nontemporal_load(xr + 512 + 64 * j); } }
        const float sst = red2_sum(ss0, ss1);
        const float rstd0 = __builtin_amdgcn_rsqf(lane_bcast(sst, 0) * (1.0f / D) + EPS), rstd1 = __builtin_amdgcn_rsqf(lane_bcast(sst, 32) * (1.0f / D) + EPS);
        float gd[16];
#pragma unroll
        for (int g = 0; g < 16; ++g) gd[g] = 0.f;
        LAS v2u* o8 = (LAS v2u*)(F.lds + 81920 + F.wave * 8192) + F.lane; float am0 = 0.f, am1 = 0.f;
#pragma unroll
        for (int j = 0; j < 8; ++j) {
            const f32x4 a = *(const LAS f32x4*)(A1 + 256 * j + 4 * F.lane), b = *(const LAS f32x4*)(B1 + 256 * j + 4 * F.lane);
            const f32x4 h0 = v0[j] * rstd0 * a + b, h1 = v1[j] * rstd1 * a + b;
            v2u o; o.x = pk2(h0.x, h0.y); o.y = pk2(h0.z, h0.w); o8[64 * j] = o; am0 = fmaxf(am0, fmaxf(fmaxf(fabsf(h0.x), fabsf(h0.y)), fmaxf(fabsf(h0.z), fabsf(h0.w))));
            o.x = pk2(h1.x, h1.y); o.y = pk2(h1.z, h1.w); o8[512 + 64 * j] = o; am1 = fmaxf(am1, fmaxf(fmaxf(fabsf(h1.x), fabsf(h1.y)), fmaxf(fabsf(h1.z), fabsf(h1.w))));
#pragma unroll
            for (int g = 0; g < 8; ++g) { const f32x4 w = *(const LAS f32x4*)(WG + g * 2048 + 256 * j + 4 * F.lane);
                gd[2 * g] += (h0.x * w.x + h0.y * w.y) + (h0.z * w.z + h0.w * w.w); gd[2 * g + 1] += (h1.x * w.x + h1.y * w.y) + (h1.z * w.z + h1.w * w.w); }
            asm volatile("" ::: "memory");
        }
        red32_f<16>(gd); red16_f<8>(gd); red8_f<4>(gd, F.lane);
#pragma unroll
        for (int r = 0; r < 2; ++r) { gd[r] = dpp_add<0x141>(gd[r]); gd[r] = dpp_add<0xB1>(gd[r]); gd[r] = dpp_add<0x4E>(gd[r]); }
        if ((F.lane & 7) == 0) { const int g = F.lane >> 3; const float bg = bgate;
#pragma unroll
            for (int r = 0; r < 2; ++r) { float p = gd[r] + bg;
                if (g >= 4) { p = fminf(p, 0.f) - log1pf(__expf(-fabsf(p))); }
                F.GATES[(size_t)(row + r) * 8 + g] = p; }
        }
        {
            const float amt = red2_max(am0, am1);
            LDS_WAIT(); asm volatile("" ::: "memory");
#pragma unroll
            for (int r = 0; r < 2; ++r) {
                const float am = fmaxf(lane_bcast(amt, 32 * r), 1e-30f), qinv = 127.0f / am;
                GAS unsigned* qr = (GAS unsigned*)(F.H1Q + (size_t)(row + r) * D) + F.lane;
#pragma unroll
                for (int j = 0; j < 8; ++j) { const v2u w = o8[512 * r + 64 * j];
                    const int q0 = (int)__builtin_rintf(bflo(w.x) * qinv), q1 = (int)__builtin_rintf(bfhi(w.x) * qinv), q2 = (int)__builtin_rintf(bflo(w.y) * qinv), q3 = (int)__builtin_rintf(bfhi(w.y) * qinv);
                    __builtin_nontemporal_store((unsigned)(q0 & 255) | ((unsigned)(q1 & 255) << 8) | ((unsigned)(q2 & 255) << 16) | ((unsigned)(q3 & 255) << 24), qr + 64 * j); }
                if (F.lane == 0) F.SA[row + r] = am * (1.0f / 127.0f);
            }
            LDS_WAIT(); asm volatile("" ::: "memory");
        }
    }
    __syncthreads();
    {
        LAS float* scr = (LAS float*)(F.lds + F.wave * 8960);
        for (int it = F.wave * F.G + F.vcu; it < (D / 64) * (NWIN / 32); it += NGW) p0_winq_item(F, scr, it);
    }
}
constexpr int IMG_PITCH = 576, M1_WL = 73728, M1_RED = 74240, M1_OB = 90624;
typedef short s16x4 __attribute__((ext_vector_type(4)));
DI bf16x8 tr_frag(const LAS unsigned char* p, int off_lo, int off_hi) {
    const s16x4 lo = __builtin_amdgcn_ds_read_tr16_b64_v4i16((LAS s16x4*)(p + off_lo));
    const s16x4 hi = __builtin_amdgcn_ds_read_tr16_b64_v4i16((LAS s16x4*)(p + off_hi));
    return __builtin_shufflevector(lo, hi, 0, 1, 2, 3, 4, 5, 6, 7);
}
DI float bfel(const v4u& w, int e) { const unsigned d = w[e >> 1]; return (e & 1) ? bfhi(d) : bflo(d); }
DI void m1_item(Frame& F, int hh, int kc) {
    LAS unsigned char* IMG = F.lds; LAS float* WL = (LAS float*)(F.lds + M1_WL); LAS float* RED = (LAS float*)(F.lds + M1_RED);
    const int t0 = kc * CH, lane = F.lane, tid = F.tid;
    if (F.wave == 0) {
        const float* gp = F.GATES + (size_t)(t0 + 2 * lane) * 8;
        const float i0 = gp[hh], lf0 = gp[4 + hh], i1 = gp[8 + hh], lf1 = gp[12 + hh];
        const float p = lf0 + lf1; float inc = p;
#pragma unroll
        for (int o = 1; o < 64; o <<= 1) { const float t = __shfl_up(inc, o); if (lane >= o) inc += t; }
        const float A = __shfl(inc, 63), ex = inc - p, b0 = ex + lf0, b1 = ex + p;
        const float lw0 = A - b0 + i0, lw1 = A - b1 + i1;
        const float B = wave_max(fmaxf(lw0, lw1));
        WL[2 * lane] = __expf(lw0 - B); WL[2 * lane + 1] = __expf(lw1 - B);
        if (lane == 0) { F.SUMM[(hh * NCHUNK + kc) * 2] = A; F.SUMM[(hh * NCHUNK + kc) * 2 + 1] = B; }
    }
    __syncthreads();
    const int dg = tid & 31, sg = tid >> 5;
#pragma unroll 1
    for (int which = 0; which < 2; ++which) {
        const int chb = (which == 0 ? 1024 : 0) + hh * DH + dg * 8;
        const int colb = (which == 0 ? C_K : C_Q) + hh * DH + dg * 8;
        v4u raw[11];
#pragma unroll
        for (int rr = 0; rr < 11; ++rr) { const int tt = t0 + sg * 8 - 3 + rr; raw[rr] = (v4u){0u, 0u, 0u, 0u}; if (tt >= 0) raw[rr] = *(const GAS v4u*)(F.PROJ + (size_t)tt * NPROJ + colb); }
        float wl[8];
#pragma unroll
        for (int i = 0; i < 8; ++i) wl[i] = (which == 0) ? WL[sg * 8 + i] : 0.0625f;
        v4u o1[8], o2[8];
        typedef float f32x2 __attribute__((ext_vector_type(2)));
        f32x2 cwn[4], cbn;
#pragma unroll
        for (int j = 0; j < 4; ++j) cwn[j] = *(const GAS f32x2*)(F.conv_w + j * 2048 + chb);
        cbn = *(const GAS f32x2*)(F.conv_b + chb);
#pragma unroll
        for (int dw = 0; dw < 4; ++dw) {
            f32x2 cw[4];
#pragma unroll
            for (int j = 0; j < 4; ++j) cw[j] = cwn[j];
            const f32x2 cb = cbn;
            if (dw < 3) {
#pragma unroll
                for (int j = 0; j < 4; ++j) cwn[j] = *(const GAS f32x2*)(F.conv_w + j * 2048 + chb + 2 * (dw + 1));
                cbn = *(const GAS f32x2*)(F.conv_b + chb + 2 * (dw + 1)); }
            float xl[11], xh[11];
#pragma unroll
            for (int rr = 0; rr < 11; ++rr) { xl[rr] = bflo(raw[rr][dw]); xh[rr] = bfhi(raw[rr][dw]); }
            float d0 = 0.f, d1 = 0.f;
#pragma unroll
            for (int i = 0; i < 8; ++i) {
                float a0 = cb.x, a1 = cb.y;
#pragma unroll
                for (int j = 0; j < 4; ++j) { a0 += cw[j].x * xl[i + j]; a1 += cw[j].y * xh[i + j]; }
                a0 = silu_f(a0); a1 = silu_f(a1);
                if (which == 0) { o1[i][dw] = pk2(a0, a1); a0 *= wl[i]; a1 *= wl[i]; d0 += a0; d1 += a1; o2[i][dw] = pk2(a0, a1); }
                else { o1[i][dw] = pk2(a0 * wl[i], a1 * wl[i]); }
            }
            if (which == 0) { RED[sg * 256 + dg * 8 + 2 * dw] = d0; RED[sg * 256 + dg * 8 + 2 * dw + 1] = d1; }
            asm volatile("" ::: "memory");
        }
#pragma unroll
        for (int i = 0; i < 8; ++i) { const int s = sg * 8 + i, t = t0 + s;
            if (which == 0) { *(GAS v4u*)(F.KC + (size_t)t * 1024 + hh * DH + dg * 8) = o1[i]; *(LAS v4u*)(IMG + s * IMG_PITCH + dg * 16) = o2[i]; }
            else { *(GAS v4u*)(F.QC + (size_t)t * 1024 + hh * DH + dg * 8) = o1[i]; } }
    }
    __syncthreads();
    if (tid < 256) { float s = 0.f;
#pragma unroll
        for (int i = 0; i < 16; ++i) s += RED[i * 256 + tid];
        F.NST[(size_t)(hh * NCHUNK + kc) * DH + tid] = s; }
    const int r = lane & 31, h = lane >> 5, e0 = F.wave * 32;
    bf16x8 bf[8];
#pragma unroll
    for (int ks = 0; ks < 8; ++ks) {
        bf[ks] = *(const GAS bf16x8*)(F.VT + (size_t)(hh * DH + e0 + r) * M + t0 + ks * 16 + 8 * h);
    }
    const LAS unsigned char* trb = IMG + (8 * h + ((lane & 15) >> 2)) * IMG_PITCH + (16 * ((lane >> 4) & 1) + 4 * (lane & 3)) * 2;
    LAS unsigned char* OB = F.lds + M1_OB + F.wave * (32 * 144);
#pragma unroll 1
    for (int dp = 0; dp < 4; ++dp) {
#pragma unroll
        for (int d2 = 0; d2 < 2; ++d2) {
            const int dt = 2 * dp + d2;
            f32x16 acc = zero16();
#pragma unroll
            for (int ks = 0; ks < 8; ++ks) { const bf16x8 af = tr_frag(trb + dt * 64, ks * 16 * IMG_PITCH, ks * 16 * IMG_PITCH + 4 * IMG_PITCH); acc = MFMA32(af, bf[ks], acc); }
#pragma unroll
            for (int g = 0; g < 4; ++g) { v2u o; o.x = pk2(acc[4 * g], acc[4 * g + 1]); o.y = pk2(acc[4 * g + 2], acc[4 * g + 3]);
                *(LAS v2u*)(OB + r * 144 + (d2 * 32 + 8 * g + 4 * h) * 2) = o; }
        }
        LDS_WAIT(); asm volatile("" ::: "memory");
#pragma unroll
        for (int i = 0; i < 4; ++i) { const int q = lane + 64 * i, row = q >> 3, c16 = q & 7;
            *(GAS v4u*)(F.STATE + (size_t)(hh * NCHUNK + kc) * (DH * DH) + (size_t)(e0 + row) * DH + dp * 64 + c16 * 8) = *(const LAS v4u*)(OB + row * 144 + c16 * 16); }
        LDS_WAIT(); asm volatile("" ::: "memory");
    }
    __syncthreads();
}
constexpr int G_WI = 0, G_VI = 34816, G_UI = 75776, G_WP = 272, G_VP = 320, G_UP = 272;
DI void gmlp_block(Frame& F, int g, int n0, int nch) {
    LAS unsigned char* WI = F.lds + G_WI; LAS unsigned char* VI = F.lds + G_VI; LAS unsigned char* UI = F.lds + G_UI;
    const int c0 = g * 128, lane = F.lane, tid = F.tid;
    {
#pragma unroll
        for (int i = 0; i < 8; ++i) { const int p = tid + 512 * i, t = p >> 5, s4 = (p & 31) * 4;
            const f32x4 w = *(const GAS f32x4*)(F.gmlp_w + (size_t)(g * 128 + t) * 128 + s4);
            v2u o; o.x = pk2(s4 <= t ? w.x : 0.f, s4 + 1 <= t ? w.y : 0.f); o.y = pk2(s4 + 2 <= t ? w.z : 0.f, s4 + 3 <= t ? w.w : 0.f);
            *(LAS v2u*)(WI + t * G_WP + s4 * 2) = o; }
    }
    v4u tv[4], tu[4];
#define G_LOAD(N) do { _Pragma("unroll") for (int i = 0; i < 4; ++i) { const int p = tid + 512 * i; const bf16* rowp = F.PROJ + (size_t)((N) * CH + (p >> 4)) * NPROJ + c0 + (p & 15) * 8; \
        tv[i] = __builtin_nontemporal_load((const GAS v4u*)(rowp + C_VG)); tu[i] = __builtin_nontemporal_load((const GAS v4u*)(rowp + C_UG)); } } while (0)
    G_LOAD(n0);
    const int r = lane & 31, h = lane >> 5, ct = F.wave & 3, tp = F.wave >> 2;
    float ng[16];
#pragma unroll
    for (int reg = 0; reg < 16; ++reg) ng[reg] = F.gmlp_norm_g[g * 128 + ct * 32 + crow(reg, h)];
    const LAS unsigned char* trb = VI + (8 * h + ((lane & 15) >> 2)) * G_VP + (ct * 32 + 16 * ((lane >> 4) & 1) + 4 * (lane & 3)) * 2;
#pragma unroll 1
    for (int ci = 0; ci < nch; ++ci) {
        const int n = n0 + ci, t0 = n * CH;
#pragma unroll
        for (int i = 0; i < 4; ++i) { const int p = tid + 512 * i, row = p >> 4, c16 = p & 15; const v4u w = tv[i];
            float a[8] = {bflo(w.x), bfhi(w.x), bflo(w.y), bfhi(w.y), bflo(w.z), bfhi(w.z), bflo(w.w), bfhi(w.w)};
            float ss = (a[0] * a[0] + a[1] * a[1]) + (a[2] * a[2] + a[3] * a[3]) + (a[4] * a[4] + a[5] * a[5]) + (a[6] * a[6] + a[7] * a[7]);
            ss = dpp_add<0x128>(ss); ss = dpp_add<0x124>(ss); ss = dpp_add<0x122>(ss); ss = dpp_add<0x121>(ss);
            const float rs = __builtin_amdgcn_rsqf(ss * (1.0f / 128.0f) + EPS);
            v4u o; o.x = pk2(a[0] * rs, a[1] * rs); o.y = pk2(a[2] * rs, a[3] * rs); o.z = pk2(a[4] * rs, a[5] * rs); o.w = pk2(a[6] * rs, a[7] * rs);
            *(LAS v4u*)(VI + row * G_VP + c16 * 16) = o; *(LAS v4u*)(UI + row * G_UP + c16 * 16) = tu[i]; }
        __syncthreads();
        if (ci + 1 < nch) G_LOAD(n + 1);
        const float bsp2[2] = {F.gmlp_b[g * 128 + tp * 32 + r], F.gmlp_b[g * 128 + (3 - tp) * 32 + r]};
#pragma unroll 1
        for (int ti = 0; ti < 2; ++ti) {
            const int tt = (ti == 0) ? tp : 3 - tp;
            const int t = tt * 32 + r;
            const LAS unsigned char* wrow = WI + t * G_WP + 16 * h;
            f32x16 acc = zero16();
#pragma unroll
            for (int ks = 0; ks < 8; ++ks) if (ks <= 2 * tt + 1) {
                const bf16x8 af = tr_frag(trb, ks * 16 * G_VP, ks * 16 * G_VP + 4 * G_VP);
                const bf16x8 bw = *(const LAS bf16x8*)(wrow + 32 * ks);
                acc = MFMA32(af, bw, acc);
            }
            const float bsp = (ti == 0) ? bsp2[0] : bsp2[1];
            LAS unsigned char* urow = UI + t * G_UP + (ct * 32 + 4 * h) * 2;
#pragma unroll
            for (int gq = 0; gq < 4; ++gq) { LAS v2u* up = (LAS v2u*)(urow + 16 * gq);
                const v2u uw = *up;
                const float y0 = bflo(uw.x) * (ng[4 * gq] * acc[4 * gq] + bsp), y1 = bfhi(uw.x) * (ng[4 * gq + 1] * acc[4 * gq + 1] + bsp);
                const float y2 = bflo(uw.y) * (ng[4 * gq + 2] * acc[4 * gq + 2] + bsp), y3 = bfhi(uw.y) * (ng[4 * gq + 3] * acc[4 * gq + 3] + bsp);
                v2u o; o.x = pk2(y0, y1); o.y = pk2(y2, y3); *up = o; }
        }
        __syncthreads();
#pragma unroll
        for (int i = 0; i < 4; ++i) { const int p = tid + 512 * i, row = p >> 4, c16 = p & 15;
            *(GAS v4u*)(F.HA + (size_t)(t0 + row) * D + c0 + c16 * 8) = *(const LAS v4u*)(UI + row * G_UP + c16 * 16); }
        __syncthreads();
    }
#undef G_LOAD
}
DI void p2_phase(Frame& F) {
    constexpr int N_M1 = NHEAD * NCHUNK;
#pragma unroll 1
    for (int it = (int)blockIdx.x; it < N_M1; it += F.G) m1_item(F, it / NCHUNK, it % NCHUNK);
    { const int per = (8 * (M / CH) + F.G - 1) / F.G;
      const int first = (int)blockIdx.x * per;
      if (first < 8 * (M / CH)) { const int g = first / (M / CH), n0 = first % (M / CH); int nch = per; if (n0 + nch > M / CH) nch = M / CH - n0; gmlp_block(F, g, n0, nch); } }
}
DI void p3_phase(Frame& F) {
    LAS float* TAB = (LAS float*)F.lds;
    const int lane = F.lane;
    const int wq_item0 = F.wave * F.G + F.vcu; float wqt[32]; float wqm = 0.f;
    if (wq_item0 < (D / 64) * (D / 32)) wq_issue(F, wq_item0, wqt, wqm);
    float wot[32]; float wom = 0.f;
    if (wq_item0 < (D / 64) * (D / 32)) wq_issue<true>(F, wq_item0, wot, wom);
    if (F.wave < NHEAD) {
        const int hh = F.wave; const float* sp = F.SUMM + (size_t)(hh * NCHUNK + 2 * lane) * 2;
        const float A0 = sp[0], B0 = sp[1], A1 = sp[2], B1 = sp[3];
        float ca = A0 + A1, cb = fmaxf(B0 + A1, B1);
        const float pa = ca, pb = cb;
#pragma unroll
        for (int o = 1; o < 64; o <<= 1) { const float ta = __shfl_up(ca, o), tb = __shfl_up(cb, o); if (lane >= o) { cb = fmaxf(tb + ca, cb); ca = ta + ca; } }
        (void)pa; (void)pb;
        float ea = __shfl_up(ca, 1), eb = __shfl_up(cb, 1);
        float m0 = (lane == 0) ? 0.f : fmaxf(ea, eb);
        const float m1 = fmaxf(m0 + A0, B0), m2 = fmaxf(m1 + A1, B1);
        TAB[(hh * NCHUNK + 2 * lane) * 2] = __expf(A0 + m0 - m1); TAB[(hh * NCHUNK + 2 * lane) * 2 + 1] = __expf(B0 - m1);
        TAB[(hh * NCHUNK + 2 * lane + 1) * 2] = __expf(A1 + m1 - m2); TAB[(hh * NCHUNK + 2 * lane + 1) * 2 + 1] = __expf(B1 - m2);
        if (blockIdx.x == 0) { F.MTAB[hh * NCHUNK + 2 * lane] = m0; F.MTAB[hh * NCHUNK + 2 * lane + 1] = m1; }
    }
    __syncthreads();
    const int NT = F.G * NWAVES * 64, gt = (int)blockIdx.x * (NWAVES * 64) + F.tid;
    for (int p = gt; p < NHEAD * (DH * DH / 2); p += NT) {
        const int hh = p / (DH * DH / 2), q = p % (DH * DH / 2);
        GAS unsigned* sp = (GAS unsigned*)(F.STATE + (size_t)hh * NCHUNK * (DH * DH)) + q;
        float s0 = 0.f, s1 = 0.f;
#pragma unroll 1
        for (int k0 = 0; k0 < NCHUNK; k0 += 16) {
            unsigned ld[16];
#pragma unroll
            for (int k = 0; k < 16; ++k) ld[k] = __builtin_nontemporal_load(sp + (size_t)(k0 + k) * (DH * DH / 2));
#pragma unroll
            for (int k = 0; k < 16; ++k) {
                sp[(size_t)(k0 + k) * (DH * DH / 2)] = pk2(s0, s1);
                const float dec = TAB[(hh * NCHUNK + k0 + k) * 2], wb = TAB[(hh * NCHUNK + k0 + k) * 2 + 1];
                s0 = dec * s0 + wb * bflo(ld[k]); s1 = dec * s1 + wb * bfhi(ld[k]);
            }
        }
    }
    for (int p = gt; p < NHEAD * DH; p += NT) {
        const int hh = p / DH, d = p % DH; float* np = F.NST + (size_t)hh * NCHUNK * DH + d; float s = 0.f;
#pragma unroll 8
        for (int k = 0; k < NCHUNK; ++k) { const float ld = np[(size_t)k * DH]; np[(size_t)k * DH] = s; s = TAB[(hh * NCHUNK + k) * 2] * s + TAB[(hh * NCHUNK + k) * 2 + 1] * ld; }
    }
    {
        LAS float* scr = (LAS float*)(F.lds + 16384 + F.wave * 8960);
        if (wq_item0 < (D / 64) * (D / 32)) { wq_finish(F, scr, wq_item0, wqt, wqm); wq_finish<true>(F, scr, wq_item0, wot, wom); }
#pragma unroll 1
        for (int it = wq_item0 + F.G * NWAVES; it < (D / 64) * (D / 32); it += F.G * NWAVES) { wq_issue(F, it, wqt, wqm); wq_finish(F, scr, it, wqt, wqm); wq_issue<true>(F, it, wot, wom); wq_finish<true>(F, scr, it, wot, wom); }
    }
}
constexpr int M3_QI = 8192, M3_R2 = 75776, M3_QP = 528, M3_CP = 272, M3_VP = 264;
static_assert(M3_R2 + 256 * M3_CP <= LDSCTL_OFF, "P4 LDS map");
DI void m3_item(Frame& F, int hh, int kc) {
    LAS float* GS = (LAS float*)F.lds; LAS float* MX = GS + 128; LAS float* BT = GS + 256; LAS float* NK = GS + 384; LAS float* XCH = GS + 640;
    LAS unsigned char* QI = F.lds + M3_QI; LAS unsigned char* R2 = F.lds + M3_R2;
    int tid = F.tid; asm volatile("" : "+v"(tid));
    const int t0 = kc * CH, lane = F.lane, item = hh * NCHUNK + kc;
    const float mk = F.MTAB[item];
    const bf16* cbase = F.STATE + (size_t)item * (DH * DH);
    const bf16* kbase = F.KC + (size_t)t0 * 1024 + hh * DH;
    const bf16* qbase = F.QC + (size_t)t0 * 1024 + hh * DH;
    const bf16* vbase = F.VT + (size_t)(hh * DH) * M + t0;
    {
        v4u tk[8], tq[8];
#pragma unroll
        for (int i = 0; i < 8; ++i) { const int p = tid + 512 * i; tk[i] = __builtin_nontemporal_load((const GAS v4u*)(kbase + (size_t)(p >> 5) * 1024 + (p & 31) * 8)); tq[i] = __builtin_nontemporal_load((const GAS v4u*)(qbase + (size_t)(p >> 5) * 1024 + (p & 31) * 8)); }
        if (F.wave == 0) {
            const float* gp = F.GATES + (size_t)(t0 + 2 * lane) * 8;
            const float i0 = gp[hh], lf0 = gp[4 + hh], i1 = gp[8 + hh], lf1 = gp[12 + hh];
            const float p = lf0 + lf1; float inc = p;
#pragma unroll
            for (int o = 1; o < 64; o <<= 1) { const float t = __shfl_up(inc, o); if (lane >= o) inc += t; }
            const float ex = inc - p, b0 = ex + lf0, b1 = ex + p;
            const float g0 = i0 - b0, g1 = i1 - b1;
            float cm = fmaxf(g0, g1);
#pragma unroll
            for (int o = 1; o < 64; o <<= 1) { const float t = __shfl_up(cm, o); if (lane >= o) cm = fmaxf(cm, t); }
            float pm = __shfl_up(cm, 1); if (lane == 0) pm = -INFINITY;
            const float M0 = fmaxf(mk, fmaxf(pm, g0)), M1 = fmaxf(M0, g1);
            GS[2 * lane] = g0; GS[2 * lane + 1] = g1; MX[2 * lane] = M0; MX[2 * lane + 1] = M1; BT[2 * lane] = b0; BT[2 * lane + 1] = b1;
        }
        if (tid < 256) NK[tid] = F.NST[(size_t)item * DH + tid];
#pragma unroll
        for (int i = 0; i < 8; ++i) { const int p = tid + 512 * i; *(LAS v4u*)(R2 + (p >> 5) * M3_QP + (p & 31) * 16) = tk[i]; *(LAS v4u*)(QI + (p >> 5) * M3_QP + (p & 31) * 16) = tq[i]; }
    }
    __syncthreads();
    const int r = lane & 31, h = lane >> 5, tt = F.wave & 3, eh = F.wave >> 2;
    const int tl = tt * 32 + r, t = t0 + tl;
    const float Mt = MX[tl], winter = __expf(mk - Mt);
    const LAS unsigned char* qrow = QI + tl * M3_QP + 16 * h;
    const LAS float* GSh = GS + 4 * h; int tlo = tl - 4 * h; asm volatile("" : "+v"(tlo));
    bf16x8 xs[4][2]; float den = 0.f;
#pragma unroll
    for (int st = 0; st < 4; ++st) {
        if (st <= tt) {
            f32x16 accS = zero16();
            const LAS unsigned char* krow = R2 + (st * 32 + r) * M3_QP + 16 * h;
#pragma unroll 4
            for (int ks = 0; ks < 16; ++ks) { const bf16x8 kf = *(const LAS bf16x8*)(krow + 32 * ks); const bf16x8 qf = *(const LAS bf16x8*)(qrow + 32 * ks); accS = MFMA32(kf, qf, accS); }
            float xv[16];
#pragma unroll
            for (int reg = 0; reg < 16; ++reg) { const int sc = st * 32 + (reg & 3) + 8 * (reg >> 2); float v = accS[reg] * __expf(GSh[sc] - Mt); if (sc > tlo) v = 0.f; xv[reg] = v; den += v; }
#pragma unroll
            for (int k2 = 0; k2 < 2; ++k2) { v4u xw; xw.x = pk2(xv[8 * k2], xv[8 * k2 + 1]); xw.y = pk2(xv[8 * k2 + 2], xv[8 * k2 + 3]); xw.z = pk2(xv[8 * k2 + 4], xv[8 * k2 + 5]); xw.w = pk2(xv[8 * k2 + 6], xv[8 * k2 + 7]);
                xs[st][k2] = __builtin_bit_cast(bf16x8, xw); }
        } else { xs[st][0] = (bf16x8){0, 0, 0, 0, 0, 0, 0, 0}; xs[st][1] = xs[st][0]; }
        asm volatile("" ::: "memory");
    }
    f32x16 accH[4];
#pragma unroll
    for (int i = 0; i < 4; ++i) accH[i] = zero16();
    float qn = 0.f;
#pragma unroll 1
    for (int hf = 0; hf < 2; ++hf) {
        v4u tc[8];
#pragma unroll
        for (int i = 0; i < 8; ++i) { const int p = tid + 512 * i; tc[i] = __builtin_nontemporal_load((const GAS v4u*)(cbase + (size_t)(p >> 4) * DH + hf * 128 + (p & 15) * 8)); }
        __syncthreads();
#pragma unroll
        for (int i = 0; i < 8; ++i) { const int p = tid + 512 * i; *(LAS v4u*)(R2 + (p >> 4) * M3_CP + (p & 15) * 16) = tc[i]; }
        __syncthreads();
        const LAS unsigned char* crow0 = R2 + (eh * 128 + r) * M3_CP + 16 * h;
#pragma unroll 2
        for (int ks = 0; ks < 8; ++ks) {
            const int kg = hf * 8 + ks;
            const v4u qw = *(const LAS v4u*)(qrow + 32 * kg);
            float qv[8] = {bflo(qw.x), bfhi(qw.x), bflo(qw.y), bfhi(qw.y), bflo(qw.z), bfhi(qw.z), bflo(qw.w), bfhi(qw.w)};
            const f32x4 na = *(const LAS f32x4*)(NK + kg * 16 + 8 * h), nb = *(const LAS f32x4*)(NK + kg * 16 + 8 * h + 4);
            qn += (qv[0] * na.x + qv[1] * na.y) + (qv[2] * na.z + qv[3] * na.w) + (qv[4] * nb.x + qv[5] * nb.y) + (qv[6] * nb.z + qv[7] * nb.w);
            v4u q2; q2.x = pk2(qv[0] * winter, qv[1] * winter); q2.y = pk2(qv[2] * winter, qv[3] * winter); q2.z = pk2(qv[4] * winter, qv[5] * winter); q2.w = pk2(qv[6] * winter, qv[7] * winter);
            const bf16x8 q2f = __builtin_bit_cast(bf16x8, q2);
#pragma unroll
            for (int et = 0; et < 4; ++et) { const bf16x8 cf = *(const LAS bf16x8*)(crow0 + et * 32 * M3_CP + 32 * ks); accH[et] = MFMA32(cf, q2f, accH[et]); }
        }
    }
    qn += __shfl_xor(qn, 32);
    {
        v4u tv[8];
#pragma unroll
        for (int i = 0; i < 8; ++i) { const int p = tid + 512 * i; tv[i] = __builtin_nontemporal_load((const GAS v4u*)(vbase + (size_t)(p >> 4) * M + (p & 15) * 8)); }
        __syncthreads();
#pragma unroll
        for (int i = 0; i < 8; ++i) { const int p = tid + 512 * i; LAS unsigned char* d = R2 + (p >> 4) * M3_VP + (p & 15) * 16;
            *(LAS v2u*)d = (v2u){tv[i].x, tv[i].y}; *(LAS v2u*)(d + 8) = (v2u){tv[i].z, tv[i].w}; }
    }
    __syncthreads();
    const LAS unsigned char* vrow0 = R2 + (eh * 128 + r) * M3_VP + 8 * h;
#pragma unroll
    for (int st = 0; st < 4; ++st) if (st <= tt) {
#pragma unroll
        for (int k2 = 0; k2 < 2; ++k2)
#pragma unroll
            for (int et = 0; et < 4; ++et) {
                const LAS unsigned char* vp = vrow0 + et * 32 * M3_VP + (st * 32 + 16 * k2) * 2;
                const v2u lo = *(const LAS v2u*)vp, hi = *(const LAS v2u*)(vp + 16);
                v4u vw; vw.x = lo.x; vw.y = lo.y; vw.z = hi.x; vw.w = hi.y;
                accH[et] = MFMA32(__builtin_bit_cast(bf16x8, vw), xs[st][k2], accH[et]);
                asm volatile("" ::: "memory");
            }
    }
    v4u to[8];
    { const bf16* obase = F.PROJ + (size_t)t0 * NPROJ + C_OM + hh * DH;
#pragma unroll
      for (int i = 0; i < 8; ++i) { const int p = tid + 512 * i; to[i] = __builtin_nontemporal_load((const GAS v4u*)(obase + (size_t)(p >> 5) * NPROJ + (p & 31) * 8)); } }
    den += __shfl_xor(den, 32);
    den += winter * qn;
    const float dnm = fmaxf(fabsf(den), __expf(-(BT[tl] + Mt))), inv = 1.0f / dnm;
    float ss = 0.f;
#pragma unroll
    for (int et = 0; et < 4; ++et)
#pragma unroll
        for (int reg = 0; reg < 16; ++reg) { accH[et][reg] *= inv; ss += accH[et][reg] * accH[et][reg]; }
    ss += __shfl_xor(ss, 32);
    if (h == 0) XCH[eh * 128 + tl] = ss;
#pragma unroll
    for (int i = 0; i < 8; ++i) { const int p = tid + 512 * i; *(LAS v4u*)(QI + (p >> 5) * M3_QP + (p & 31) * 16) = to[i]; }
    __syncthreads();
    const float rstd = __builtin_amdgcn_rsqf((XCH[tl] + XCH[128 + tl]) * (1.0f / DH) + EPS);
    LAS unsigned char* orow = QI + tl * M3_QP + (eh * 128 + 4 * h) * 2;
    const float* ngp = F.mlstm_norm_g + hh * DH + eh * 128;
#pragma unroll
    for (int et = 0; et < 4; ++et)
#pragma unroll
        for (int gq = 0; gq < 4; ++gq) { const int el = et * 32 + 8 * gq + 4 * h; LAS v2u* op = (LAS v2u*)(orow + (et * 32 + 8 * gq) * 2);
            const v2u ow = *op; const f32x4 gn = *(const GAS f32x4*)(ngp + el);
            const float y0 = accH[et][4 * gq] * rstd * gn.x * sigmoid_f(bflo(ow.x)), y1 = accH[et][4 * gq + 1] * rstd * gn.y * sigmoid_f(bfhi(ow.x));
            const float y2 = accH[et][4 * gq + 2] * rstd * gn.z * sigmoid_f(bflo(ow.y)), y3 = accH[et][4 * gq + 3] * rstd * gn.w * sigmoid_f(bfhi(ow.y));
            v2u o; o.x = pk2(y0, y1); o.y = pk2(y2, y3); *op = o; }
    __syncthreads();
#pragma unroll
    for (int i = 0; i < 8; ++i) { const int p = tid + 512 * i, row = p >> 5, c16 = p & 31;
        *(GAS v4u*)(F.HA + (size_t)(t0 + row) * D + 1024 + hh * DH + c16 * 8) = *(const LAS v4u*)(QI + row * M3_QP + c16 * 16); }
    __syncthreads();
}
DI void p4_phase(Frame& F) {
    for (int it = (int)blockIdx.x; it < NHEAD * NCHUNK; it += F.G) m3_item(F, it / NCHUNK, it % NCHUNK);
}
DI void trow_load(Frame& F, int row, f32x4 (&v)[8]) {
    if (row < 2 * NEXP) { const int tb = row >= NEXP, e = row - tb * NEXP; const GAS f32x4* src = (const GAS f32x4*)((tb ? F.e_up : F.e_down) + (size_t)e * D) + F.lane;
#pragma unroll
        for (int j = 0; j < 8; ++j) v[j] = __builtin_nontemporal_load(src + 64 * j); }
    else {
#pragma unroll
        for (int j = 0; j < 8; ++j) v[j] = (f32x4){0.f, 0.f, 0.f, 0.f}; }
}
DI void trow_store(Frame& F, int row, const f32x4 (&v)[8], float am) {
    if (row >= 2 * NEXP) return;
    const int tb = row >= NEXP, e = row - tb * NEXP; am = fmaxf(am, 1e-30f);
    const float sc = am * (1.0f / 127.0f), inv = 127.0f / am;
    GAS unsigned* dst = (GAS unsigned*)((tb ? F.EU : F.ED) + (size_t)e * D) + F.lane;
    const int off = 0;
#pragma unroll
    for (int j = 0; j < 8; ++j) {
        const int q0 = (int)__builtin_rintf(v[j].x * inv) + off, q1 = (int)__builtin_rintf(v[j].y * inv) + off, q2 = (int)__builtin_rintf(v[j].z * inv) + off, q3 = (int)__builtin_rintf(v[j].w * inv) + off;
        dst[64 * j] = (unsigned)(q0 & 255) | ((unsigned)(q1 & 255) << 8) | ((unsigned)(q2 & 255) << 16) | ((unsigned)(q3 & 255) << 24);
    }
    if (F.lane == 0) (tb ? F.SU : F.SD)[e] = sc;
}
DI float trow_absmax(const f32x4 (&v)[8]) { float am = 0.f;
#pragma unroll
    for (int j = 0; j < 8; ++j) am = fmaxf(am, fmaxf(fmaxf(fabsf(v[j].x), fabsf(v[j].y)), fmaxf(fabsf(v[j].z), fabsf(v[j].w))));
    return am; }
DI void trow_finish2(Frame& F, int rowA, int rowB, const f32x4 (&a)[8], const f32x4 (&b)[8]) {
    const float m = red2_max(trow_absmax(a), trow_absmax(b));
    trow_store(F, rowA, a, lane_bcast(m, 0)); trow_store(F, rowB, b, lane_bcast(m, 32));
}
constexpr int KPITCH = 272, P8_TBL = 69632;
DI void topk_insert(float (&L)[16], float x) {
#pragma unroll
    for (int i = 15; i >= 1; --i) L[i] = __builtin_amdgcn_fmed3f(x, L[i - 1], L[i]);
    L[0] = fmaxf(L[0], x);
}
DI void p8_phase(Frame& F) {
    LAS unsigned char* KIMG = F.lds; LAS unsigned char* TBL = F.lds + P8_TBL + F.wave * 1024;
    const int lane = F.lane, tid = F.tid, r = lane & 31, h = lane >> 5;
#pragma unroll 4
    for (int i = 0; i < 16; ++i) { const int idx = tid * 4 + 2048 * i, side = idx >> 14, rem = idx & 16383, row = rem >> 7, col = rem & 127;
        const f32x4 a = *(const GAS f32x4*)((side ? F.keys2 : F.keys1) + rem);
        v2u o; o.x = pk2(a.x, a.y); o.y = pk2(a.z, a.w); *(LAS v2u*)(KIMG + (side * 128 + row) * KPITCH + col * 2) = o; }
    __syncthreads();
    const int gcT = F.vcu * NWAVES + F.wave, NGWT = F.G * NWAVES; int trow_it = 0;
    for (int it = (int)blockIdx.x; it < (M / 256) * PH; it += F.G, ++trow_it) {
        const int tile = it / PH, hd = it % PH;
        const int t = tile * 256 + F.wave * 32 + r;
        float L1[16], L2[16];
#pragma unroll 1
        for (int side = 0; side < 2; ++side) {
            const int q0 = (trow_it * 2 + side) * 4; f32x4 ra[8], rb[8];
            f32x16 acc[4];
#pragma unroll
            for (int kt = 0; kt < 4; ++kt) acc[kt] = zero16();
            const bf16* qp = F.QB + (size_t)t * D + hd * 256 + side * 128 + 8 * h;
#pragma unroll
            for (int ks = 0; ks < 8; ++ks) {
                const bf16x8 qf = __builtin_nontemporal_load((const GAS bf16x8*)(qp + ks * 16));
#pragma unroll
                for (int kt = 0; kt < 4; ++kt) { const bf16x8 kf = *(const LAS bf16x8*)(KIMG + (side * 128 + kt * 32 + r) * KPITCH + (ks * 16 + 8 * h) * 2); acc[kt] = MFMA32(kf, qf, acc[kt]); }
            }
            trow_load(F, q0 * NGWT + gcT, ra); trow_load(F, (q0 + 1) * NGWT + gcT, rb);
            float L[16];
#pragma unroll
            for (int i = 0; i < 16; ++i) L[i] = -3.0e38f;
#pragma unroll
            for (int kt = 0; kt < 4; ++kt) {
                if (kt == 2) { trow_finish2(F, q0 * NGWT + gcT, (q0 + 1) * NGWT + gcT, ra, rb); trow_load(F, (q0 + 2) * NGWT + gcT, ra); trow_load(F, (q0 + 3) * NGWT + gcT, rb); }
#pragma unroll
                for (int reg = 0; reg < 16; ++reg) { const unsigned key = (unsigned)(kt * 32 + crow(reg, h)); const float sv = acc[kt][reg];
                    topk_insert(L, __uint_as_float((__float_as_uint(sv) & ~127u) | key)); }
            }
            float P[16];
#pragma unroll
            for (int i = 0; i < 16; ++i) P[i] = __shfl_xor(L[i], 32);
#pragma unroll
            for (int i = 0; i < 16; ++i) topk_insert(L, P[i]);
            trow_finish2(F, (q0 + 2) * NGWT + gcT, (q0 + 3) * NGWT + gcT, ra, rb);
            if (side == 0) {
#pragma unroll
                for (int i = 0; i < 16; ++i) L1[i] = L[i];
            } else {
#pragma unroll
                for (int i = 0; i < 16; ++i) L2[i] = L[i];
            }
        }
        if (h == 0) {
#pragma unroll
            for (int w = 0; w < 4; ++w) {
                const unsigned a = (__builtin_bit_cast(unsigned, L1[4 * w]) & 127u) | ((__builtin_bit_cast(unsigned, L1[4 * w + 1]) & 127u) << 8) | ((__builtin_bit_cast(unsigned, L1[4 * w + 2]) & 127u) << 16) | ((__builtin_bit_cast(unsigned, L1[4 * w + 3]) & 127u) << 24);
                const unsigned b = (__builtin_bit_cast(unsigned, L2[4 * w]) & 127u) | ((__builtin_bit_cast(unsigned, L2[4 * w + 1]) & 127u) << 8) | ((__builtin_bit_cast(unsigned, L2[4 * w + 2]) & 127u) << 16) | ((__builtin_bit_cast(unsigned, L2[4 * w + 3]) & 127u) << 24);
                *(LAS unsigned*)(TBL + r * 32 + 4 * w) = a; *(LAS unsigned*)(TBL + r * 32 + 16 + 4 * w) = b;
            }
        }
        float T[16];
#pragma unroll
        for (int i = 0; i < 16; ++i) T[i] = -3.0e38f;
#pragma unroll
        for (int i = 0; i < 16; ++i) {
            const float v1 = __builtin_bit_cast(float, __builtin_bit_cast(unsigned, L1[i]) & ~127u);
#pragma unroll
            for (int j = 0; j < 16; ++j) if ((i + 1) * (j + 1) <= 16) {
                const float v2 = __builtin_bit_cast(float, __builtin_bit_cast(unsigned, L2[j]) & ~127u);
                topk_insert(T, __builtin_bit_cast(float, (__builtin_bit_cast(unsigned, v1 + v2) & ~255u) | (unsigned)(i * 16 + j)));
            }
        }
        LDS_WAIT(); asm volatile("" ::: "memory");
        float ev[16], esum = 0.f;
        const float mx = __builtin_bit_cast(float, __builtin_bit_cast(unsigned, T[0]) & ~255u);
#pragma unroll
        for (int i = 0; i < 16; ++i) { ev[i] = __expf(__builtin_bit_cast(float, __builtin_bit_cast(unsigned, T[i]) & ~255u) - mx); esum += ev[i]; }
        const float einv = 1.0f / esum;
        int eid[8]; float gt[8];
#pragma unroll
        for (int i = 0; i < 8; ++i) { const float tv = h ? T[8 + i] : T[i]; const float e = h ? ev[8 + i] : ev[i];
            const unsigned p = __builtin_bit_cast(unsigned, tv) & 255u;
            const unsigned i1 = *(const LAS unsigned char*)(TBL + r * 32 + (p >> 4)), i2 = *(const LAS unsigned char*)(TBL + r * 32 + 16 + (p & 15u));
            eid[i] = (int)(i1 * 128u + i2); gt[i] = e * einv; }
        int* ip = F.IDX + (size_t)t * NSEL + hd * 16 + 8 * h; float* gp = F.PG + (size_t)t * NSEL + hd * 16 + 8 * h;
        *(GAS v4u*)ip = (v4u){(unsigned)eid[0], (unsigned)eid[1], (unsigned)eid[2], (unsigned)eid[3]}; *(GAS v4u*)(ip + 4) = (v4u){(unsigned)eid[4], (unsigned)eid[5], (unsigned)eid[6], (unsigned)eid[7]};
        *(GAS f32x4*)gp = (f32x4){gt[0], gt[1], gt[2], gt[3]}; *(GAS f32x4*)(gp + 4) = (f32x4){gt[4], gt[5], gt[6], gt[7]};
        LDS_WAIT(); asm volatile("" ::: "memory");
    }
#pragma unroll 1
    for (int q = trow_it * 8; q * NGWT < 2 * NEXP; ++q) { f32x4 ra[8]; trow_load(F, q * NGWT + gcT, ra); trow_store(F, q * NGWT + gcT, ra, wave_max(trow_absmax(ra))); }
}
constexpr int P9_IDX = 131072, P9_SH = 147456, P9_CORR = 147712, P9_GF = 32768, P9_FG = 40960, P9_SSQ = 49152, P9_CQ = 65536, P9_CT = 81920, P9_CSQ = 82176, NSLICE = 16, SLICE_B = 128;
#ifndef NSLICE_A
#define NSLICE_A NSLICE
#endif
#ifndef NSLICE_C
#define NSLICE_C NSLICE
#endif
template <int N, int MASK> DI void red_step_i(int (&v)[8], int lane) {
#pragma unroll
    for (int i = 0; i < N / 2; ++i) { const bool up = (lane & MASK) != 0; const int keep = up ? v[i + N / 2] : v[i], send = up ? v[i] : v[i + N / 2]; v[i] = keep + __shfl_xor(send, MASK); }
}
template <int N, int MASK> DI void red_step_f(float (&v)[16], int lane) {
#pragma unroll
    for (int i = 0; i < N / 2; ++i) { const bool up = (lane & MASK) != 0; const float keep = up ? v[i + N / 2] : v[i], send = up ? v[i] : v[i + N / 2]; v[i] = keep + __shfl_xor(send, MASK); }
}
template <int N> DI void redi32(int (&v)[16]) {
#pragma unroll
    for (int i = 0; i < N / 2; ++i) { const auto rr = __builtin_amdgcn_permlane32_swap((unsigned)v[i], (unsigned)v[i + N / 2], false, false); v[i] = (int)(rr[0] + rr[1]); }
}
template <int N> DI void redi16(int (&v)[16]) {
#pragma unroll
    for (int i = 0; i < N / 2; ++i) { const auto rr = __builtin_amdgcn_permlane16_swap((unsigned)v[i], (unsigned)v[i + N / 2], false, false); v[i] = (int)(rr[0] + rr[1]); }
}
template <int N> DI void redi8(int (&v)[16], int lane) {
#pragma unroll
    for (int i = 0; i < N / 2; ++i) { const bool up = (lane & 8) != 0; const int keep = up ? v[i + N / 2] : v[i], send = up ? v[i] : v[i + N / 2]; v[i] = keep + __builtin_amdgcn_mov_dpp(send, 0x128, 0xf, 0xf, true); }
}
DI void yq_pass(Frame& F) {
    const int lane = F.lane;
#pragma unroll 1
    for (int tb = (int)blockIdx.x * 64; tb < M; tb += F.G * 64) {
        v4u xn[2][4];
#define YQ_XLOAD(P) do { _Pragma("unroll") for (int u = 0; u < 2; ++u) { const bf16* xr = F.HA + (size_t)(tb + F.wave * 8 + 2 * (P) + u) * D + 16 * lane; \
            _Pragma("unroll") for (int jj = 0; jj < 2; ++jj) _Pragma("unroll") for (int q = 0; q < 2; ++q) xn[u][2 * jj + q] = __builtin_nontemporal_load((const GAS v4u*)(xr + 1024 * jj + 8 * q)); } } while (0)
        YQ_XLOAD(0);
#pragma unroll 1
        for (int p = 0; p < 4; ++p) {
            float hv[2][32]; float am[2] = {0.f, 0.f};
#pragma unroll
            for (int u = 0; u < 2; ++u)
#pragma unroll
                for (int w = 0; w < 4; ++w) { const v4u a = xn[u][w]; const int o = 8 * w;
                    hv[u][o] = bflo(a.x); hv[u][o + 1] = bfhi(a.x); hv[u][o + 2] = bflo(a.y); hv[u][o + 3] = bfhi(a.y); hv[u][o + 4] = bflo(a.z); hv[u][o + 5] = bfhi(a.z); hv[u][o + 6] = bflo(a.w); hv[u][o + 7] = bfhi(a.w); }
            if (p < 3) YQ_XLOAD(p + 1);
#pragma unroll
            for (int u = 0; u < 2; ++u)
#pragma unroll
                for (int i = 0; i < 32; ++i) am[u] = fmaxf(am[u], fabsf(hv[u][i]));
            const float amt = red2_max(am[0], am[1]);
#pragma unroll
            for (int u = 0; u < 2; ++u) { const int tl = F.wave * 8 + 2 * p + u;
                const float amu = fmaxf(lane_bcast(amt, 32 * u), 1e-30f), inv = 127.0f / amu;
                if (lane == 0) F.SY[tb + tl] = amu * (1.0f / 127.0f);
#pragma unroll
                for (int jj = 0; jj < 2; ++jj) { v4u o;
#pragma unroll
                    for (int q = 0; q < 4; ++q) { const int b = 16 * jj + 4 * q;
                        const int q0 = (int)__builtin_rintf(hv[u][b] * inv), q1 = (int)__builtin_rintf(hv[u][b + 1] * inv), q2 = (int)__builtin_rintf(hv[u][b + 2] * inv), q3 = (int)__builtin_rintf(hv[u][b + 3] * inv);
                        o[q] = (unsigned)(q0 & 255) | ((unsigned)(q1 & 255) << 8) | ((unsigned)(q2 & 255) << 16) | ((unsigned)(q3 & 255) << 24); }
                    *(GAS v4u*)(F.YQ + (size_t)(tb + tl) * D + 1024 * jj + 16 * lane) = o; } }
        }
#undef YQ_XLOAD
    }
}
DI void h2q_pass(Frame& F) {
    LAS float* A2 = (LAS float*)(F.lds + P9_IDX); LAS float* B2 = (LAS float*)(F.lds + P9_IDX + 8192);
    const int lane = F.lane, tid = F.tid;
#pragma unroll 1
    for (int tb = (int)blockIdx.x * 64; tb < M; tb += F.G * 64) {
        v4u xn[2][4];
#define P9_XLOAD(P) do { _Pragma("unroll") for (int u = 0; u < 2; ++u) { const bf16* xr = F.X1B + (size_t)(tb + F.wave * 8 + 2 * (P) + u) * D + 16 * lane; \
            _Pragma("unroll") for (int jj = 0; jj < 2; ++jj) _Pragma("unroll") for (int q = 0; q < 2; ++q) xn[u][2 * jj + q] = *(const GAS v4u*)(xr + 1024 * jj + 8 * q); } } while (0)
        P9_XLOAD(0);
#pragma unroll
        for (int i = 0; i < 4; ++i) { const int c = tid + 512 * i; A2[c] = F.norm_ffn_g[c] * (1.0f + F.MODF[MOD_SCF + c]); B2[c] = F.MODF[MOD_SHF + c]; }
        __syncthreads();
#pragma unroll 1
        for (int p = 0; p < 4; ++p) {
            float hv[2][32]; float ss[2] = {0.f, 0.f};
#pragma unroll
            for (int u = 0; u < 2; ++u)
#pragma unroll
                for (int w = 0; w < 4; ++w) { const v4u a = xn[u][w]; const int o = 8 * w;
                    hv[u][o] = bflo(a.x); hv[u][o + 1] = bfhi(a.x); hv[u][o + 2] = bflo(a.y); hv[u][o + 3] = bfhi(a.y); hv[u][o + 4] = bflo(a.z); hv[u][o + 5] = bfhi(a.z); hv[u][o + 6] = bflo(a.w); hv[u][o + 7] = bfhi(a.w); }
            if (p < 3) P9_XLOAD(p + 1);
#pragma unroll
            for (int u = 0; u < 2; ++u)
#pragma unroll
                for (int i = 0; i < 32; ++i) ss[u] += hv[u][i] * hv[u][i];
            const float sst = red2_sum(ss[0], ss[1]);
            const float rstd[2] = {__builtin_amdgcn_rsqf(lane_bcast(sst, 0) * (1.0f / D) + EPS), __builtin_amdgcn_rsqf(lane_bcast(sst, 32) * (1.0f / D) + EPS)};
            float am[2] = {0.f, 0.f};
#pragma unroll
            for (int jj = 0; jj < 2; ++jj)
#pragma unroll
                for (int q = 0; q < 4; ++q) { const f32x4 a = *(const LAS f32x4*)(A2 + 1024 * jj + 16 * lane + 4 * q), b = *(const LAS f32x4*)(B2 + 1024 * jj + 16 * lane + 4 * q);
                    const int o = 16 * jj + 4 * q;
#pragma unroll
                    for (int u = 0; u < 2; ++u) {
                        hv[u][o] = hv[u][o] * rstd[u] * a.x + b.x; hv[u][o + 1] = hv[u][o + 1] * rstd[u] * a.y + b.y; hv[u][o + 2] = hv[u][o + 2] * rstd[u] * a.z + b.z; hv[u][o + 3] = hv[u][o + 3] * rstd[u] * a.w + b.w;
                        am[u] = fmaxf(am[u], fmaxf(fmaxf(fabsf(hv[u][o]), fabsf(hv[u][o + 1])), fmaxf(fabsf(hv[u][o + 2]), fabsf(hv[u][o + 3])))); } }
            const float amt = red2_max(am[0], am[1]);
#pragma unroll
            for (int u = 0; u < 2; ++u) { const int tl = F.wave * 8 + 2 * p + u;
                const float amu = fmaxf(lane_bcast(amt, 32 * u), 1e-30f), inv = 127.0f / amu;
                if (lane == 0) F.SA[tb + tl] = amu * (1.0f / 127.0f);
#pragma unroll
                for (int jj = 0; jj < 2; ++jj) { v4u o;
#pragma unroll
                    for (int q = 0; q < 4; ++q) { const int b = 16 * jj + 4 * q;
                        const int q0 = (int)__builtin_rintf(hv[u][b] * inv), q1 = (int)__builtin_rintf(hv[u][b + 1] * inv), q2 = (int)__builtin_rintf(hv[u][b + 2] * inv), q3 = (int)__builtin_rintf(hv[u][b + 3] * inv);
                        o[q] = (unsigned)(q0 & 255) | ((unsigned)(q1 & 255) << 8) | ((unsigned)(q2 & 255) << 16) | ((unsigned)(q3 & 255) << 24); }
                    *(GAS v4u*)(F.H2Q + (size_t)(tb + tl) * D + 1024 * jj + 16 * lane) = o; } }
        }
#undef P9_XLOAD
        __syncthreads();
    }
}
DI void p9v2_phase(Frame& F) {
    LAS unsigned char* HQ = F.lds; LAS float* A2 = (LAS float*)(F.lds + P9_IDX); LAS float* B2 = (LAS float*)(F.lds + P9_IDX + 8192);
    LAS unsigned short* IDX16 = (LAS unsigned short*)(F.lds + P9_IDX); LAS float* SH = (LAS float*)(F.lds + P9_SH); LAS float* CORR = (LAS float*)(F.lds + P9_CORR);
    LAS float* GF = (LAS float*)(F.lds + P9_GF); LAS float* FG = (LAS float*)(F.lds + P9_FG);
    const int lane = F.lane, tid = F.tid, c8 = lane & 7, g = lane >> 3;
#pragma unroll 1
    for (int tb = (int)blockIdx.x * 64; tb < M; tb += F.G * 64) {
#pragma unroll
        for (int j = 0; j < 8; ++j) { const int tl = F.wave * 8 + j;
#pragma unroll
            for (int jj = 0; jj < 2; ++jj) *(LAS v4u*)(HQ + tl * 2048 + 1024 * jj + 16 * lane) = *(const GAS v4u*)(F.H2Q + (size_t)(tb + tl) * D + 1024 * jj + 16 * lane); }
        if (tid < 64) SH[tid] = F.SA[tb + tid];
        __syncthreads();
#pragma unroll
        for (int i = 0; i < 16; ++i) { const int q = tid + 512 * i, k = q & 127; IDX16[(q & ~127) + (k & 64) + 8 * (k & 7) + ((k >> 3) & 7)] = (unsigned short)F.IDX[(size_t)tb * NSEL + q]; }
        __syncthreads();
        int P[8][2];
#pragma unroll
        for (int j = 0; j < 8; ++j) { P[j][0] = 0; P[j][1] = 0; }
#pragma unroll 1
        for (int s = 0; s < NSLICE_A; ++s) {
            if (((s ^ (F.wave >> 2)) & 1) != 0) __builtin_amdgcn_s_setprio(1); else __builtin_amdgcn_s_setprio(0);
            const unsigned char* eb = F.ED + s * SLICE_B;
            const unsigned lo = (unsigned)(c8 * 16);
            v4u wA[8], wB[8];
#define P9A_LOAD(W, J, H) do { _Pragma("unroll") for (int i = 0; i < 8; ++i) { const unsigned e = IDX16[(F.wave * 8 + (J)) * 128 + 64 * (H) + 8 * g + i]; W[i] = *(const GAS v4u*)(eb + (e * 2048u + lo)); } } while (0)
#define P9A_COMP(W, J, H) do { const v4u hq = *(const LAS v4u*)(HQ + (F.wave * 8 + (J)) * 2048 + s * SLICE_B + c8 * 16); int a[8]; \
                _Pragma("unroll") for (int i = 0; i < 8; ++i) { int d = 0; const v4u ww = W[i]; \
                    d = __builtin_amdgcn_sdot4((int)hq.x, (int)ww.x, d, false); d = __builtin_amdgcn_sdot4((int)hq.y, (int)ww.y, d, false); d = __builtin_amdgcn_sdot4((int)hq.z, (int)ww.z, d, false); d = __builtin_amdgcn_sdot4((int)hq.w, (int)ww.w, d, false); a[i] = d; } \
                red_step_i<8, 4>(a, lane); red_step_i<4, 2>(a, lane); red_step_i<2, 1>(a, lane); P[J][H] += a[0]; asm volatile("" ::: "memory"); } while (0)
            P9A_LOAD(wA, 0, 0);
#pragma unroll
            for (int j = 0; j < 8; ++j) {
                P9A_LOAD(wB, j, 1);
                P9A_COMP(wA, j, 0);
                if (j < 7) P9A_LOAD(wA, j + 1, 0);
                P9A_COMP(wB, j, 1);
            }
#undef P9A_LOAD
#undef P9A_COMP
        }
        __builtin_amdgcn_s_setprio(0);
        __syncthreads();
        LAS int* PI = (LAS int*)F.lds;
#pragma unroll
        for (int j = 0; j < 8; ++j) { const int tl = F.wave * 8 + j; PI[tl * 128 + 8 * c8 + g] = P[j][0]; PI[tl * 128 + 64 + 8 * c8 + g] = P[j][1]; }
#pragma unroll
        for (int i = 0; i < 4; ++i) { const int c = tid + 512 * i; GF[c] = F.MODF[MOD_GF + c]; FG[c] = F.final_g[c]; }
        LAS float* SSQL = (LAS float*)(F.lds + P9_SSQ); LAS signed char* CQ = (LAS signed char*)(F.lds + P9_CQ); LAS float* CT = (LAS float*)(F.lds + P9_CT); LAS int* CSQ = (LAS int*)(F.lds + P9_CSQ);
        {
            const int slot = 8 * (lane & 7) + (lane >> 3);
            float sdn[2][2], sun[2][2], pgn[2][2];
#define P9B_LOAD(P) do { _Pragma("unroll") for (int u = 0; u < 2; ++u) { const int tl_ = F.wave * 8 + 2 * (P) + u; _Pragma("unroll") for (int h = 0; h < 2; ++h) { const unsigned e = IDX16[tl_ * 128 + 64 * h + slot]; \
                sdn[u][h] = F.SD[e]; sun[u][h] = F.SU[e]; pgn[u][h] = F.PG[(size_t)(tb + tl_) * NSEL + 64 * h + lane]; } } } while (0)
            P9B_LOAD(0);
#pragma unroll 1
            for (int p = 0; p < 4; ++p) {
                float sd[2][2], su[2][2], pg[2][2];
#pragma unroll
                for (int u = 0; u < 2; ++u)
#pragma unroll
                    for (int h = 0; h < 2; ++h) { sd[u][h] = sdn[u][h]; su[u][h] = sun[u][h]; pg[u][h] = pgn[u][h]; }
                if (p < 3) P9B_LOAD(p + 1);
                float cf[2][2], am[2] = {0.f, 0.f};
#pragma unroll
                for (int u = 0; u < 2; ++u) { const int tl = F.wave * 8 + 2 * p + u; const float sh = SH[tl];
#pragma unroll
                    for (int h = 0; h < 2; ++h) cf[u][h] = (float)PI[tl * 128 + 64 * h + lane] * (sh * sd[u][h]);
                    const pg8::f32x2 ge = pg8::gelu_pk((pg8::f32x2){cf[u][0], cf[u][1]});
                    cf[u][0] = pg[u][0] * ge.x * su[u][0]; cf[u][1] = pg[u][1] * ge.y * su[u][1]; am[u] = fmaxf(fabsf(cf[u][0]), fabsf(cf[u][1])); }
                const float amt = red2_max(am[0], am[1]);
                float qsf[2];
                float amu[2];
#pragma unroll
                for (int u = 0; u < 2; ++u) { const int tl = F.wave * 8 + 2 * p + u; amu[u] = fmaxf(lane_bcast(amt, 32 * u), 1e-30f); const float inv = 127.0f / amu[u]; int qs = 0;
#pragma unroll
                    for (int h = 0; h < 2; ++h) { const int q = (int)__builtin_rintf(cf[u][h] * inv); qs += q; CQ[tl * 128 + 64 * h + slot] = (signed char)q; }
                    qsf[u] = (float)qs; }
                const float qst = red2_sum(qsf[0], qsf[1]);
                if (lane == 0 || lane == 32) { const int u = lane >> 5, tl = F.wave * 8 + 2 * p + u; CT[tl] = (u ? amu[1] : amu[0]) * (1.0f / 127.0f); CSQ[tl] = (int)qst; }
            }
#undef P9B_LOAD
        }
        __syncthreads();
        const int cb = c8 * 16 + ((lane >> 5) & 1) * 8 + ((lane >> 4) & 1) * 4 + ((lane >> 3) & 1) * 2;
        typedef short s16x2 __attribute__((ext_vector_type(2)));
        {
            const unsigned lo = (unsigned)(c8 * 16);
            v4u wX[8], wY[8], wZ[8];
#define P9C_LOAD(W, V, H) do { const int tl_ = F.wave * 8 + ((V) & 7); const unsigned char* eb_ = F.EU + ((V) >> 3) * SLICE_B; \
                const LAS unsigned* ip = (const LAS unsigned*)(IDX16 + tl_ * 128 + 64 * (H) + 8 * g); \
                _Pragma("unroll") for (int i2 = 0; i2 < 4; ++i2) { const unsigned ee = ip[i2]; \
                    W[2 * i2] = *(const GAS v4u*)(eb_ + ((ee & 0xffffu) * 2048u + lo)); W[2 * i2 + 1] = *(const GAS v4u*)(eb_ + ((ee >> 16) * 2048u + lo)); } } while (0)
#define P9C_T4(O, A, B, C, Dd, CC, Z) do {   \
                const unsigned t01 = __builtin_amdgcn_perm(B, A, 0x05010400u), t23 = __builtin_amdgcn_perm(B, A, 0x07030602u), s01 = __builtin_amdgcn_perm(Dd, C, 0x05010400u), s23 = __builtin_amdgcn_perm(Dd, C, 0x07030602u); \
                O[0] = __builtin_amdgcn_sdot4((int)__builtin_amdgcn_perm(s01, t01, 0x05040100u), (int)(CC), (Z) ? 0 : O[0], false); O[1] = __builtin_amdgcn_sdot4((int)__builtin_amdgcn_perm(s01, t01, 0x07060302u), (int)(CC), (Z) ? 0 : O[1], false); \
                O[2] = __builtin_amdgcn_sdot4((int)__builtin_amdgcn_perm(s23, t23, 0x05040100u), (int)(CC), (Z) ? 0 : O[2], false); O[3] = __builtin_amdgcn_sdot4((int)__builtin_amdgcn_perm(s23, t23, 0x07060302u), (int)(CC), (Z) ? 0 : O[3], false); } while (0)
#define P9C_ACC(W, V, H) do { const v2u cq_ = *(const LAS v2u*)(CQ + (F.wave * 8 + ((V) & 7)) * 128 + 64 * (H) + 8 * g);   \
                P9C_T4((o + 0), W[0].x, W[1].x, W[2].x, W[3].x, cq_.x, (H) == 0); P9C_T4((o + 4), W[0].y, W[1].y, W[2].y, W[3].y, cq_.x, (H) == 0); P9C_T4((o + 8), W[0].z, W[1].z, W[2].z, W[3].z, cq_.x, (H) == 0); P9C_T4((o + 12), W[0].w, W[1].w, W[2].w, W[3].w, cq_.x, (H) == 0); \
                P9C_T4((o + 0), W[4].x, W[5].x, W[6].x, W[7].x, cq_.y, false); P9C_T4((o + 4), W[4].y, W[5].y, W[6].y, W[7].y, cq_.y, false); P9C_T4((o + 8), W[4].z, W[5].z, W[6].z, W[7].z, cq_.y, false); P9C_T4((o + 12), W[4].w, W[5].w, W[6].w, W[7].w, cq_.y, false); \
                asm volatile("" ::: "memory"); } while (0)
#define P9C_FINISH(V) do { redi32<16>(o); redi16<8>(o); redi8<4>(o, lane); \
                const int tl_ = F.wave * 8 + ((V) & 7), t_ = tb + tl_, col = ((V) >> 3) * SLICE_B + cb; const float ct = CT[tl_]; \
                GAS unsigned* xp = (GAS unsigned*)(F.X1B + (size_t)t_ * D + col);            \
                const unsigned xw = *xp; \
                const float y0 = bflo(xw) + GF[col] * ((float)o[0] * ct), y1 = bfhi(xw) + GF[col + 1] * ((float)o[1] * ct); \
                *xp = pk2(y0, y1); } while (0)
#define P9C_PF(W, N) do { if ((N) < NSLICE_C * 16) P9C_LOAD(W, (N) >> 1, (N) & 1); } while (0)
#define P9C_PRIO(V) do { if (((V) & 7) == 0) { if (((((V) >> 3) ^ (F.wave >> 2)) & 1) != 0) __builtin_amdgcn_s_setprio(1); else __builtin_amdgcn_s_setprio(0); } } while (0)
            P9C_LOAD(wX, 0, 0); P9C_LOAD(wY, 0, 1);
#pragma unroll 1
            for (int v = 0; v < NSLICE_C * 8; v += 3) {
                const int n0 = 2 * v; int o[16];
                P9C_PRIO(v);
                P9C_PF(wZ, n0 + 2); P9C_ACC(wX, v, 0);
                P9C_PF(wX, n0 + 3); P9C_ACC(wY, v, 1); P9C_FINISH(v);
                if (v + 1 < NSLICE_C * 8) {
                    P9C_PRIO(v + 1);
                    P9C_PF(wY, n0 + 4); P9C_ACC(wZ, v + 1, 0);
                    P9C_PF(wZ, n0 + 5); P9C_ACC(wX, v + 1, 1); P9C_FINISH(v + 1);
                }
                if (v + 2 < NSLICE_C * 8) {
                    P9C_PRIO(v + 2);
                    P9C_PF(wX, n0 + 6); P9C_ACC(wY, v + 2, 0);
                    P9C_PF(wY, n0 + 7); P9C_ACC(wZ, v + 2, 1); P9C_FINISH(v + 2);
                }
            }
#undef P9C_PF
#undef P9C_PRIO
#undef P9C_LOAD
#undef P9C_ACC
#undef P9C_T4
#undef P9C_FINISH
        }
        __builtin_amdgcn_s_setprio(0);
        {
            v2u xnx[2][8];
#define P9D_LOAD(P) do { _Pragma("unroll") for (int u = 0; u < 2; ++u) { const GAS v2u* xrow = (const GAS v2u*)(F.X1B + (size_t)(tb + F.wave * 8 + 2 * (P) + u) * D) + lane; \
                _Pragma("unroll") for (int q = 0; q < 8; ++q) xnx[u][q] = xrow[64 * q]; } } while (0)
            P9D_LOAD(0);
#pragma unroll 1
            for (int p = 0; p < 4; ++p) {
                v2u xw[2][8]; float sq[2] = {0.f, 0.f};
#pragma unroll
                for (int u = 0; u < 2; ++u)
#pragma unroll
                    for (int q = 0; q < 8; ++q) { xw[u][q] = xnx[u][q]; const float a0 = bflo(xw[u][q].x), a1 = bfhi(xw[u][q].x), a2 = bflo(xw[u][q].y), a3 = bfhi(xw[u][q].y); sq[u] += (a0 * a0 + a1 * a1) + (a2 * a2 + a3 * a3); }
                if (p < 3) P9D_LOAD(p + 1);
                const float sqt = red2_sum(sq[0], sq[1]);
#pragma unroll
                for (int u = 0; u < 2; ++u) { const float rstd2 = __builtin_amdgcn_rsqf(lane_bcast(sqt, 32 * u) * (1.0f / D) + EPS);
                    GAS f32x4* orow = (GAS f32x4*)(F.out + (size_t)(tb + F.wave * 8 + 2 * p + u) * D) + lane;
#pragma unroll
                    for (int q = 0; q < 8; ++q) { const f32x4 f = *(const LAS f32x4*)(FG + 256 * q + 4 * lane);
                        __builtin_nontemporal_store((f32x4){bflo(xw[u][q].x) * rstd2 * f.x, bfhi(xw[u][q].x) * rstd2 * f.y, bflo(xw[u][q].y) * rstd2 * f.z, bfhi(xw[u][q].y) * rstd2 * f.w}, orow + 64 * q); } }
            }
#undef P9D_LOAD
        }
        __syncthreads();
    }
}
struct Args { const float* in[21]; float* out; unsigned char* ws; int ph_lo, ph_hi, li, pad; };
constexpr int N_PHASES = 10;
__global__ void __launch_bounds__(NWAVES * 64, 2) mk_fwd(Args args) {
    extern __shared__ __attribute__((aligned(16))) unsigned char lds[];
    Frame F;
    F.lds = (LAS unsigned char*)lds;
    F.MISC = (volatile LAS unsigned*)(F.lds + MISC_OFF);
    F.tid = threadIdx.x; F.lane = F.tid & 63; F.wave = __builtin_amdgcn_readfirstlane(F.tid >> 6);
    F.G = gridDim.x; { const int bx = blockIdx.x; F.vcu = (F.G % 8 == 0) ? (bx % 8) * (F.G / 8) + bx / 8 : bx; }
    unsigned char* ws = args.ws;
    F.ctl = (gu32*)(ws + WS_CTL);
    F.x = args.in[0]; F.c = args.in[1]; F.ada_w = args.in[2]; F.ada_b = args.in[3]; F.norm_mix_g = args.in[4]; F.w_in = args.in[5]; F.b_gates = args.in[6];
    F.conv_w = args.in[7]; F.conv_b = args.in[8]; F.gmlp_norm_g = args.in[9]; F.gmlp_w = args.in[10]; F.gmlp_b = args.in[11]; F.mlstm_norm_g = args.in[12];
    F.w_out = args.in[13]; F.norm_ffn_g = args.in[14]; F.wq = args.in[15]; F.keys1 = args.in[16]; F.keys2 = args.in[17]; F.e_down = args.in[18]; F.e_up = args.in[19]; F.final_g = args.in[20];
    F.out = args.out;
    F.MODP = (float*)(ws + WS_MODP); F.MODF = (float*)(ws + WS_MODF); F.GATES = (float*)(ws + WS_GATES); F.SUMM = (float*)(ws + WS_SUMM); F.MTAB = (float*)(ws + WS_MTAB);
    F.NST = (float*)(ws + WS_NST); F.PG = (float*)(ws + WS_PG); F.IDX = (int*)(ws + WS_IDX);
    F.WIN = (bf16*)(ws + WS_WIN); F.WOUT = (bf16*)(ws + WS_WOUT); F.WQ = (bf16*)(ws + WS_WQ); F.HA = (bf16*)(ws + WS_HA); F.PROJ = (bf16*)(ws + WS_PROJ); F.QB = (bf16*)(ws + WS_PROJ);
    F.STATE = (bf16*)(ws + WS_STATE); F.VT = (bf16*)(ws + WS_VT); F.ED = ws + WS_ED; F.EU = ws + WS_EU; F.XB = (bf16*)(ws + WS_XB); F.SD = (float*)(ws + WS_SD); F.SU = (float*)(ws + WS_SU);
    F.H2Q = ws + WS_HA; F.WQ8 = ws + WS_WQ; F.CMAXQ = (float*)(ws + WS_BQP); F.SWQ = (float*)(ws + WS_BIASQ);
    F.YQ = ws + WS_PROJ + 64 * MiB; F.WO8 = ws + WS_WOUT; F.SY = (float*)(ws + WS_SSQP); F.CMAXO = (float*)(ws + WS_CMAXP + 768 * 1024); F.SWO = (float*)(ws + WS_BQP + 256 * 1024);
    F.H1Q = ws + WS_STATE;
    F.SW = (float*)(ws + WS_SW); F.CMAXP = (float*)(ws + WS_CMAXP); F.SA = (float*)(ws + WS_SA);
    F.SSQP = (float*)(ws + WS_SSQP); F.BQP = (float*)(ws + WS_BQP); F.BIASQ = (float*)(ws + WS_BIASQ); F.X1B = (bf16*)(ws + WS_STATE);
    F.QC = (bf16*)args.out; F.KC = (bf16*)args.out + (size_t)M * 1024;
    for (int u = F.tid; u < (LDS_BYTES - LDSCTL_OFF) / 4; u += NWAVES * 64) ((LAS unsigned*)(F.lds + LDSCTL_OFF))[u] = 0u;
    __syncthreads();
    const int lo = args.ph_lo, hi = args.ph_hi;
    const bool multi = (hi - lo) > 1;
    XcdBarrier bar; bar.bar = (unsigned*)(F.ctl + CW_BAR) + args.li * XCD_BAR_WORDS; bar.x = 0; bar.st = nullptr;
    if (multi) bar = xcd_barrier_post((unsigned*)(F.ctl + CW_BAR) + args.li * XCD_BAR_WORDS, F.MISC + 8);
#ifndef PH_MASK
#define PH_MASK 0x7ff
#endif
#define IN(k) (((PH_MASK >> (k)) & 1) && lo <= (k) && (k) < hi)
#define SEAM(k) do { if (IN(k) && IN((k) + 1)) xcd_barrier(bar); } while (0)
    if (IN(0)) { p0a_phase(F); } SEAM(0);
    if (IN(1)) { p0b_phase(F); } SEAM(1);
    if (IN(2)) {
        { pg8::Gemm g{(const pg8::bf16_t*)F.H1Q, F.WIN, M, NPROJ, D / 2}; pg8::StaticOrder S; S.init(M, NPROJ, F.G, (int)blockIdx.x);
          pg8::EpiQ8 E{F.PROJ, NPROJ, 2048 / 256, F.SA, F.SW, 1};
          pg8::gemm_phase<pg8::EpiQ8, pg8::StaticOrder, PG8_ALIGN, PG8_SP2, true>(F.lds, g, S, E); }
        {
          pg8::Gemm g{(const pg8::bf16_t*)((const unsigned char*)F.WIN + (size_t)WROW_VM * D), (const pg8::bf16_t*)F.H1Q, 1024, M, D / 2}; pg8::StaticOrder S; S.init(1024, M, F.G, (int)blockIdx.x);
          pg8::EpiQ8 E{F.VT, M, 0, F.SW + WROW_VM, F.SA, 1};
          pg8::gemm_phase<pg8::EpiQ8, pg8::StaticOrder, PG8_ALIGN, PG8_SP2, true>(F.lds, g, S, E); }
    } SEAM(2);
    if (IN(3)) { p2_phase(F); } SEAM(3);
    if (IN(4)) { p3_phase(F); } SEAM(4);
    if (IN(5)) { p4_phase(F); } SEAM(5);
    if (IN(6)) {
        yq_pass(F);
        if (multi) xcd_barrier(bar);
        pg8::Gemm g{(const pg8::bf16_t*)F.YQ, (const pg8::bf16_t*)F.WO8, M, D, D / 2}; pg8::StaticOrder S; S.init(M, D, F.G, (int)blockIdx.x);
        pg8::EpiResid2 E{(const pg8::bf16_t*)F.XB, F.MODF + MOD_GM, F.X1B, F.SSQP, D, F.SY, F.SWO};
        pg8::gemm_phase<pg8::EpiResid2, pg8::StaticOrder, PG8_ALIGN, PG8_SP2, true>(F.lds, g, S, E);
    } SEAM(6);
    if (IN(7)) {
        h2q_pass(F);
        if (multi) xcd_barrier(bar);
        pg8::Gemm g{(const pg8::bf16_t*)F.H2Q, (const pg8::bf16_t*)F.WQ8, M, D, D / 2}; pg8::StaticOrder S; S.init(M, D, F.G, (int)blockIdx.x);
        pg8::EpiQ8 E{F.QB, D, 0, F.SA, F.SWQ, 0};
        pg8::gemm_phase<pg8::EpiQ8, pg8::StaticOrder, PG8_ALIGN, PG8_SP2, true>(F.lds, g, S, E);
    } SEAM(7);
#ifndef P8_ALT
#define P8_ALT 0
#endif
    if (IN(8)) { p8_phase(F); } SEAM(8);
#ifndef P9_V2
#define P9_V2 1
#endif
    if (IN(9)) { p9v2_phase(F); }
#undef IN
#undef SEAM
}

#ifndef MK_N_LAUNCHES
#define MK_N_LAUNCHES 1
#endif
extern "C" void kernel_launch(void* const* d_in, const int* in_sizes, int n_in, void* d_out, int out_size, void* d_ws, size_t ws_size, hipStream_t stream) {
    static int grid = 0;
    if (grid == 0) {
        if (n_in != 21 || in_sizes[0] != M * D || out_size != M * D || ws_size < WS_END) { fprintf(stderr, "kernel_launch: unexpected shapes (n_in %d, in0 %d, out %d, ws %zu); nothing launched\n", n_in, n_in > 0 ? in_sizes[0] : -1, out_size, ws_size); grid = -1; return; }
        int dev = 0, cus = 0, per_cu = 0;
        if (hipGetDevice(&dev) != hipSuccess || hipDeviceGetAttribute(&cus, hipDeviceAttributeMultiprocessorCount, dev) != hipSuccess) { grid = -1; return; }
        if (hipFuncSetAttribute((const void*)mk_fwd, hipFuncAttributeMaxDynamicSharedMemorySize, LDS_BYTES) != hipSuccess) { fprintf(stderr, "kernel_launch: hipFuncSetAttribute failed\n"); grid = -1; return; }
        if (hipOccupancyMaxActiveBlocksPerMultiprocessor(&per_cu, (const void*)mk_fwd, NWAVES * 64, LDS_BYTES) != hipSuccess || per_cu < 1) { fprintf(stderr, "kernel_launch: occupancy query says %d blocks per CU\n", per_cu); }
        (void)hipGetLastError();
        grid = cus;
    }
    if (grid < 0) return;
    (void)hipMemsetAsync((char*)d_ws + WS_CTL, 0, CTL_ZERO_BYTES, stream);
    Args a{};
    for (int i = 0; i < 21; ++i) a.in[i] = (const float*)d_in[i];
    a.out = (float*)d_out; a.ws = (unsigned char*)d_ws;
    if (MK_N_LAUNCHES == 1) { a.ph_lo = 0; a.ph_hi = N_PHASES; a.li = 0; hipLaunchKernelGGL(mk_fwd, dim3(grid), dim3(NWAVES * 64), LDS_BYTES, stream, a); }
    else for (int li = 0; li < N_PHASES; ++li) { a.ph_lo = li; a.ph_hi = li + 1; a.li = 0; hipLaunchKernelGGL(mk_fwd, dim3(grid), dim3(NWAVES * 64), LDS_BYTES, stream, a); }
}
```
